# Optimizing an MI355X kernel written in HIP

```python
import math
import numpy as np
import jax
import jax.numpy as jnp
from jax import lax

D_MODEL = 2048
BATCH = 1
SEQ = 16384
DEPTH = 2

GRID_W = 64
CTX_LEN = 256
N_MOD = 6
EPS = 1e-6

POOL_WINDOWS = (2, 4, 8, 16)
N_POOL_GROUPS = 4
POOL_GROUP = 3 * D_MODEL // 16
W_POOL = N_POOL_GROUPS * POOL_GROUP
W_S5 = D_MODEL // 4
S5_CH = 16
S5_STATE = 64
S5_GROUPS = W_S5 // S5_CH
S5_DT_MIN = 1e-3
S5_DT_MAX = 1e-1
W_IN_EVEN = W_POOL + W_S5
W_OUT_EVEN = W_POOL + W_S5

GLA_HEADS = 4
GLA_DK = D_MODEL // 16
GLA_DV = D_MODEL // 8
GLA_RANK = 16
GLA_TAU = 16.0
GLA_CHUNK = 64
W_GLA_K = GLA_HEADS * GLA_DK
W_GLA_V = GLA_HEADS * GLA_DV
ATT_HEAD_DIM = 128
ATT_HEADS = D_MODEL // 2 // ATT_HEAD_DIM
ATT_KV_HEADS = ATT_HEADS // 4
ATT_GROUP = ATT_HEADS // ATT_KV_HEADS
W_ATT = ATT_HEADS * ATT_HEAD_DIM
W_ATT_KV = ATT_KV_HEADS * ATT_HEAD_DIM
Q_BLOCK = 128
ROPE_THETA = 10000.0
ODD_WIDTHS = (W_GLA_K, W_GLA_K, W_GLA_V, GLA_RANK, W_GLA_V, W_ATT, W_ATT_KV, W_ATT_KV)
W_IN_ODD = 2 * W_GLA_K + 2 * W_GLA_V + GLA_RANK + W_ATT + 2 * W_ATT_KV
W_OUT_ODD = W_GLA_V + W_ATT

D_FF = 7 * D_MODEL // 2
N_EXPERTS = 8
TOP_K = 2

N_EVEN = (DEPTH + 1) // 2
N_ODD = DEPTH // 2

kernel_name = 'hybrid_pool_s5_gla_gqa_moe_dit_trunk'


def rms_norm(x, g):
    xf = x.astype(jnp.float32)
    y = xf * lax.rsqrt(jnp.mean(xf * xf, axis=-1, keepdims=True) + EPS)
    return (y * g.astype(jnp.float32)).astype(x.dtype)


def modulation(v, w_mod, b_mod):
    m = jax.nn.silu(v) @ w_mod + b_mod
    return jnp.split(m[..., None, :], N_MOD, axis=-1)


def split_widths(z, widths):
    return jnp.split(z, np.cumsum(widths)[:-1].tolist(), axis=-1)


def identity(t):
    return t


def flip_seq(t):
    return jnp.flip(t, axis=1)


def centred_window_mean(z, w):
    L = z.shape[1]
    cs = jnp.pad(jnp.cumsum(z.astype(jnp.float32), axis=1), ((0, 0), (1, 0), (0, 0)))
    t = jnp.arange(L)
    lo = jnp.maximum(t - w // 2, 0)
    hi = jnp.minimum(t + (w - w // 2), L)
    cnt = (hi - lo).astype(jnp.float32)[None, :, None]
    return ((cs[:, hi] - cs[:, lo]) / cnt).astype(z.dtype)


def pool_mixer(z, pool_w, pool_scale):
    groups = jnp.split(z, N_POOL_GROUPS, axis=-1)
    d = jnp.stack([centred_window_mean(g, w) - g for g, w in zip(groups, POOL_WINDOWS)], axis=2)
    y = jnp.einsum('blgc,gcd->blgd', d, pool_w)
    return y.reshape(z.shape) * pool_scale


def s5_discretise(lam_re, lam_im, log_dt, b_re, b_im):
    dt = jnp.exp(log_dt.astype(jnp.float32))[:, None]
    lr, li = lam_re.astype(jnp.float32), lam_im.astype(jnp.float32)
    mag = jnp.exp(lr * dt)
    a_re, a_im = mag * jnp.cos(li * dt), mag * jnp.sin(li * dt)
    den = lr * lr + li * li
    nr, ni = a_re - 1.0, a_im
    k_re = (nr * lr + ni * li) / den
    k_im = (ni * lr - nr * li) / den
    br = k_re[..., None] * b_re - k_im[..., None] * b_im
    bi = k_re[..., None] * b_im + k_im[..., None] * b_re
    return a_re, a_im, br, bi


def complex_affine_combine(e1, e2):
    a1r, a1i, b1r, b1i = e1
    a2r, a2i, b2r, b2i = e2
    return (a2r * a1r - a2i * a1i, a2r * a1i + a2i * a1r,
            a2r * b1r - a2i * b1i + b2r, a2r * b1i + a2i * b1r + b2i)


def s5_scan(u, a_re, a_im, br, bi, h0_re, h0_im):
    x_re = jnp.einsum('blgn,gpn->blgp', u, br)
    x_im = jnp.einsum('blgn,gpn->blgp', u, bi)
    x_re = x_re.at[:, 0].add(a_re * h0_re - a_im * h0_im)
    x_im = x_im.at[:, 0].add(a_re * h0_im + a_im * h0_re)
    ar = jnp.broadcast_to(a_re, x_re.shape)
    ai = jnp.broadcast_to(a_im, x_re.shape)
    _, _, h_re, h_im = lax.associative_scan(complex_affine_combine, (ar, ai, x_re, x_im), axis=1)
    return h_re, h_im


def s5_readout(h_re, h_im, c_re, c_im):
    return (jnp.einsum('blgp,gnp->blgn', h_re, c_re.astype(jnp.float32))
            - jnp.einsum('blgp,gnp->blgn', h_im, c_im.astype(jnp.float32)))


def s5_mixer(z_ctx, z_lat, lam_re, lam_im, log_dt, b_re, b_im, c_re, c_im, d_skip, w_glu, need_ctx):
    def groups(z):
        return z.astype(jnp.float32).reshape(z.shape[0], z.shape[1], S5_GROUPS, S5_CH)
    uc, ul = groups(z_ctx), groups(z_lat)
    zero = jnp.zeros((ul.shape[0], S5_GROUPS, S5_STATE), jnp.float32)
    y_lat, y_ctx = 0.0, 0.0
    for d in range(2):
        f = flip_seq if d == 1 else identity
        a_re, a_im, br, bi = s5_discretise(lam_re[d], lam_im[d], log_dt[d], b_re[d], b_im[d])
        hc_re, hc_im = s5_scan(f(uc), a_re, a_im, br, bi, zero, zero)
        hl_re, hl_im = s5_scan(f(ul), a_re, a_im, br, bi, hc_re[:, -1], hc_im[:, -1])
        y_lat = y_lat + f(s5_readout(hl_re, hl_im, c_re[d], c_im[d]))
        if need_ctx:
            y_ctx = y_ctx + f(s5_readout(hc_re, hc_im, c_re[d], c_im[d]))
    dsk = d_skip.astype(jnp.float32).reshape(S5_GROUPS, S5_CH)

    def finish(y, u, z):
        y = jax.nn.gelu((y + u * dsk).reshape(z.shape))
        return (y * jax.nn.sigmoid(y @ w_glu.astype(jnp.float32))).astype(z.dtype)
    return finish(y_lat, ul, z_lat), (finish(y_ctx, uc, z_ctx) if need_ctx else None)


def pool_ssm_mixer(u_ctx, u_lat, w_in, w_out, pool_w, pool_scale, lam_re, lam_im, log_dt,
                   b_re, b_im, c_re, c_im, d_skip, w_glu, need_ctx):
    p_lat, s_lat = split_widths(u_lat @ w_in, (W_POOL, W_S5))
    p_ctx, s_ctx = split_widths(u_ctx @ w_in, (W_POOL, W_S5))
    s5_lat, s5_ctx = s5_mixer(s_ctx, s_lat, lam_re, lam_im, log_dt, b_re, b_im, c_re, c_im,
                              d_skip, w_glu, need_ctx)
    y_lat = jnp.concatenate([pool_mixer(p_lat, pool_w, pool_scale), s5_lat], axis=-1) @ w_out
    y_ctx = None
    if need_ctx:
        y_ctx = jnp.concatenate([pool_mixer(p_ctx, pool_w, pool_scale), s5_ctx], axis=-1) @ w_out
    return y_lat, y_ctx


def gla_heads(q, k, v):
    B_, L, _ = q.shape
    q = q.astype(jnp.float32).reshape(B_, L, GLA_HEADS, GLA_DK) * (GLA_DK ** -0.5)
    k = k.astype(jnp.float32).reshape(B_, L, GLA_HEADS, GLA_DK)
    v = v.astype(jnp.float32).reshape(B_, L, GLA_HEADS, GLA_DV)
    return q, k, v


def gla_log_gate(a, w_a, b_a):
    B_, L, _ = a.shape
    z = a.astype(jnp.float32) @ w_a.astype(jnp.float32) + b_a.astype(jnp.float32)
    return (jax.nn.log_sigmoid(z) / GLA_TAU).reshape(B_, L, GLA_HEADS, GLA_DK)


def gla_chunked(q, k, v, g, s0):
    B_, L, H, _ = q.shape
    n = L // GLA_CHUNK

    def to_chunks(t):
        return t.reshape(B_, n, GLA_CHUNK, H, t.shape[-1]).transpose(1, 0, 3, 2, 4)
    qc, kc, vc = to_chunks(q), to_chunks(k), to_chunks(v)
    bc = jnp.cumsum(to_chunks(g), axis=-2)
    mask = jnp.tril(jnp.ones((GLA_CHUNK, GLA_CHUNK), bool))

    def step(S, inp):
        qi, ki, vi, bi = inp
        qe = qi * jnp.exp(bi)
        ke = ki * jnp.exp(-bi)
        att = jnp.where(mask, jnp.einsum('bhik,bhjk->bhij', qe, ke), 0.0)
        o = jnp.einsum('bhij,bhjv->bhiv', att, vi) + jnp.einsum('bhik,bhkv->bhiv', qe, S)
        b_last = bi[:, :, -1:, :]
        S = (jnp.exp(b_last[:, :, 0, :, None]) * S
             + jnp.einsum('bhjk,bhjv->bhkv', ki * jnp.exp(b_last - bi), vi))
        return S, o
    s_fin, o = lax.scan(step, s0, (qc, kc, vc, bc))
    o = o.transpose(1, 0, 3, 2, 4).reshape(B_, L, H, v.shape[-1])
    return o, s_fin


def gla_output(o, r, norm_g):
    B_, L = o.shape[:2]
    o = rms_norm(o, norm_g.reshape(GLA_HEADS, GLA_DV)).reshape(B_, L, W_GLA_V)
    return (o * jax.nn.silu(r.astype(jnp.float32))).astype(r.dtype)


def gla_mixer(ctx_in, lat_in, w_a, b_a, norm_g, need_ctx):
    qc, kc, vc = gla_heads(*ctx_in[:3])
    ql, kl, vl = gla_heads(*lat_in[:3])
    s0 = jnp.zeros((ql.shape[0], GLA_HEADS, GLA_DK, GLA_DV), jnp.float32)
    o_lat, o_ctx = [], []
    for d in range(2):
        f = flip_seq if d == 1 else identity
        gc = gla_log_gate(ctx_in[3], w_a[d], b_a[d])
        gl = gla_log_gate(lat_in[3], w_a[d], b_a[d])
        oc, s_ctx = gla_chunked(f(qc), f(kc), f(vc), f(gc), s0)
        ol, _ = gla_chunked(f(ql), f(kl), f(vl), f(gl), s_ctx)
        o_lat.append(f(ol))
        if need_ctx:
            o_ctx.append(f(oc))
    y_lat = gla_output(o_lat[0] + o_lat[1], lat_in[4], norm_g)
    y_ctx = gla_output(o_ctx[0] + o_ctx[1], ctx_in[4], norm_g) if need_ctx else None
    return y_lat, y_ctx


def rope_1d(x, pos):
    half = x.shape[-1] // 2
    freqs = ROPE_THETA ** (-jnp.arange(half, dtype=jnp.float32) / half)
    ang = pos.astype(jnp.float32)[:, None] * freqs
    cos, sin = jnp.cos(ang)[:, None, :], jnp.sin(ang)[:, None, :]
    x1, x2 = x[..., :half].astype(jnp.float32), x[..., half:].astype(jnp.float32)
    return jnp.concatenate([x1 * cos - x2 * sin, x1 * sin + x2 * cos], axis=-1).astype(x.dtype)


def rope_2d(x, rows, cols):
    half = x.shape[-1] // 2
    return jnp.concatenate([rope_1d(x[..., :half], rows), rope_1d(x[..., half:], cols)], axis=-1)


def block_attention(q, k, v):
    B_, Lq = q.shape[:2]
    nb = Lq // Q_BLOCK
    qb = q.reshape(B_, nb, Q_BLOCK, ATT_KV_HEADS, ATT_GROUP, ATT_HEAD_DIM).transpose(1, 0, 2, 3, 4, 5)
    scale = ATT_HEAD_DIM ** -0.5

    def one_block(qi):
        s = jnp.einsum('bqhgd,bkhd->bhgqk', qi, k).astype(jnp.float32) * scale
        p = jax.nn.softmax(s, axis=-1).astype(v.dtype)
        return jnp.einsum('bhgqk,bkhd->bqhgd', p, v)
    o = lax.map(one_block, qb)
    return o.transpose(1, 0, 2, 3, 4, 5).reshape(B_, Lq, W_ATT)


def gqa_mixer(ctx_in, lat_in, q_norm, k_norm, rows, cols, need_ctx):
    def q_heads(q):
        return rms_norm(q.reshape(q.shape[0], q.shape[1], ATT_HEADS, ATT_HEAD_DIM), q_norm)

    def kv_heads(k, v):
        B_, L, _ = k.shape
        return (rms_norm(k.reshape(B_, L, ATT_KV_HEADS, ATT_HEAD_DIM), k_norm),
                v.reshape(B_, L, ATT_KV_HEADS, ATT_HEAD_DIM))
    kc, vc = kv_heads(ctx_in[1], ctx_in[2])
    kl, vl = kv_heads(lat_in[1], lat_in[2])
    ql = rope_2d(q_heads(lat_in[0]), rows, cols)
    kl = rope_2d(kl, rows, cols)
    y_lat = block_attention(ql, jnp.concatenate([kc, kl], axis=1), jnp.concatenate([vc, vl], axis=1))
    y_ctx = block_attention(q_heads(ctx_in[0]), kc, vc) if need_ctx else None
    return y_lat, y_ctx


def gla_gqa_mixer(u_ctx, u_lat, w_in, w_out, gla_w_a, gla_b_a, gla_norm, q_norm, k_norm,
                  rows, cols, need_ctx):
    zl = split_widths(u_lat @ w_in, ODD_WIDTHS)
    zc = split_widths(u_ctx @ w_in, ODD_WIDTHS)
    g_lat, g_ctx = gla_mixer(zc[:5], zl[:5], gla_w_a, gla_b_a, gla_norm, need_ctx)
    a_lat, a_ctx = gqa_mixer(zc[5:], zl[5:], q_norm, k_norm, rows, cols, need_ctx)
    y_lat = jnp.concatenate([g_lat, a_lat], axis=-1) @ w_out
    y_ctx = (jnp.concatenate([g_ctx, a_ctx], axis=-1) @ w_out) if need_ctx else None
    return y_lat, y_ctx


def swiglu(u, w_gate, w_up, w_down):
    return (jax.nn.silu(u @ w_gate) * (u @ w_up)) @ w_down


def moe_swiglu(u, w_router, b_router, w_gate, w_up, w_down):
    shp = u.shape
    t = u.reshape(-1, shp[-1])
    logits = (t @ w_router).astype(jnp.float32) + b_router.astype(jnp.float32)
    top_val, top_idx = lax.top_k(logits, TOP_K)
    gates = jax.nn.softmax(top_val, axis=-1)
    out = jnp.zeros(t.shape, jnp.float32)
    for e in range(N_EXPERTS):
        g_e = jnp.sum(jnp.where(top_idx == e, gates, 0.0), axis=-1)[:, None]
        out = out + g_e * swiglu(t, w_gate[e], w_up[e], w_down[e]).astype(jnp.float32)
    return out.astype(u.dtype).reshape(shp)


def setup_inputs(seed: int = 0) -> dict:
    key = jax.random.key(seed)
    ks = iter(jax.random.split(key, 48))
    f32 = jnp.float32

    def nrm(shape, scale):
        return jax.random.normal(next(ks), shape, f32) * scale
    D, NE, NO = D_MODEL, N_EVEN, N_ODD
    G, P, N = S5_GROUPS, S5_STATE, S5_CH
    lam_im_base = math.pi * jnp.arange(P, dtype=f32)
    return {
        'x': nrm((BATCH, SEQ, D), 1.0),
        'c': nrm((BATCH, D), 1.0),
        'ctx': nrm((BATCH, CTX_LEN, D), 1.0),
        'c_ctx': nrm((D,), 1.0),
        'w_mod': nrm((DEPTH, D, N_MOD * D), 0.5 * D ** -0.5),
        'b_mod': nrm((DEPTH, N_MOD * D), 0.02),
        'norms': 1.0 + nrm((DEPTH, 4, D), 0.05),
        'e_w_in': nrm((NE, D, W_IN_EVEN), D ** -0.5),
        'e_pool_w': nrm((NE, N_POOL_GROUPS, POOL_GROUP, POOL_GROUP), POOL_GROUP ** -0.5),
        'e_pool_scale': 1.0 + nrm((NE, W_POOL), 0.1),
        'e_s5_lam_re': -0.5 + nrm((NE, 2, G, P), 0.01),
        'e_s5_lam_im': lam_im_base + nrm((NE, 2, G, P), 0.01),
        'e_s5_log_dt': jax.random.uniform(next(ks), (NE, 2, G), f32,
                                          math.log(S5_DT_MIN), math.log(S5_DT_MAX)),
        'e_s5_b_re': nrm((NE, 2, G, P, N), (2 * N) ** -0.5),
        'e_s5_b_im': nrm((NE, 2, G, P, N), (2 * N) ** -0.5),
        'e_s5_c_re': nrm((NE, 2, G, N, P), (2 * P) ** -0.5),
        'e_s5_c_im': nrm((NE, 2, G, N, P), (2 * P) ** -0.5),
        'e_s5_d': nrm((NE, W_S5), 1.0),
        'e_s5_w_glu': nrm((NE, W_S5, W_S5), W_S5 ** -0.5),
        'e_w_out': nrm((NE, W_OUT_EVEN, D), W_OUT_EVEN ** -0.5),
        'e_ffn_gate': nrm((NE, D, D_FF), D ** -0.5),
        'e_ffn_up': nrm((NE, D, D_FF), D ** -0.5),
        'e_ffn_down': nrm((NE, D_FF, D), D_FF ** -0.5),
        'o_w_in': nrm((NO, D, W_IN_ODD), D ** -0.5),
        'o_gla_w_a': nrm((NO, 2, GLA_RANK, W_GLA_K), GLA_RANK ** -0.5),
        'o_gla_b_a': nrm((NO, 2, W_GLA_K), 0.1),
        'o_gla_norm': 1.0 + nrm((NO, W_GLA_V), 0.05),
        'o_q_norm': 1.0 + nrm((NO, ATT_HEAD_DIM), 0.05),
        'o_k_norm': 1.0 + nrm((NO, ATT_HEAD_DIM), 0.05),
        'o_w_out': nrm((NO, W_OUT_ODD, D), W_OUT_ODD ** -0.5),
        'o_router': nrm((NO, D, N_EXPERTS), D ** -0.5),
        'o_router_b': nrm((NO, N_EXPERTS), 0.01),
        'o_moe_gate': nrm((NO, N_EXPERTS, D, D_FF), D ** -0.5),
        'o_moe_up': nrm((NO, N_EXPERTS, D, D_FF), D ** -0.5),
        'o_moe_down': nrm((NO, N_EXPERTS, D_FF, D), D_FF ** -0.5),
    }


def reference(x, c, ctx, c_ctx, w_mod, b_mod, norms, e_w_in, e_pool_w, e_pool_scale,
              e_s5_lam_re, e_s5_lam_im, e_s5_log_dt, e_s5_b_re, e_s5_b_im, e_s5_c_re, e_s5_c_im,
              e_s5_d, e_s5_w_glu, e_w_out, e_ffn_gate, e_ffn_up, e_ffn_down,
              o_w_in, o_gla_w_a, o_gla_b_a, o_gla_norm, o_q_norm, o_k_norm, o_w_out,
              o_router, o_router_b, o_moe_gate, o_moe_up, o_moe_down):
    L = x.shape[1]
    n_ctx = ctx.shape[1]
    n_rows = L // GRID_W
    rows = jnp.repeat(jnp.arange(n_rows, dtype=jnp.int32), GRID_W, total_repeat_length=L)
    cols = jnp.arange(L, dtype=jnp.int32) % GRID_W
    h_lat, h_ctx = x, ctx
    for i in range(DEPTH):
        need_ctx = i < DEPTH - 1
        j = i // 2
        sh1, sc1, g1, sh2, sc2, g2 = modulation(c, w_mod[i], b_mod[i])
        sh1c, sc1c, g1c, sh2c, sc2c, g2c = modulation(c_ctx, w_mod[i], b_mod[i])
        u_lat = rms_norm(h_lat, norms[i, 0]) * (1.0 + sc1) + sh1
        u_ctx = rms_norm(h_ctx, norms[i, 0]) * (1.0 + sc1c) + sh1c
        if i % 2 == 0:
            y_lat, y_ctx = pool_ssm_mixer(u_ctx, u_lat, e_w_in[j], e_w_out[j], e_pool_w[j], e_pool_scale[j],
                                          e_s5_lam_re[j], e_s5_lam_im[j], e_s5_log_dt[j],
                                          e_s5_b_re[j], e_s5_b_im[j], e_s5_c_re[j], e_s5_c_im[j],
                                          e_s5_d[j], e_s5_w_glu[j], need_ctx)
        else:
            y_lat, y_ctx = gla_gqa_mixer(u_ctx, u_lat, o_w_in[j], o_w_out[j], o_gla_w_a[j], o_gla_b_a[j],
                                         o_gla_norm[j], o_q_norm[j], o_k_norm[j], rows, cols, need_ctx)
        h_lat = h_lat + g1 * rms_norm(y_lat, norms[i, 1])
        v_lat = rms_norm(h_lat, norms[i, 2]) * (1.0 + sc2) + sh2
        if need_ctx:
            h_ctx = h_ctx + g1c * rms_norm(y_ctx, norms[i, 1])
            v_ctx = rms_norm(h_ctx, norms[i, 2]) * (1.0 + sc2c) + sh2c
            v_all = jnp.concatenate([v_ctx, v_lat], axis=1)
        else:
            v_all = v_lat
        if i % 2 == 0:
            f_all = swiglu(v_all, e_ffn_gate[j], e_ffn_up[j], e_ffn_down[j])
        else:
            f_all = moe_swiglu(v_all, o_router[j], o_router_b[j], o_moe_gate[j], o_moe_up[j], o_moe_down[j])
        f_all = rms_norm(f_all, norms[i, 3])
        if need_ctx:
            h_ctx = h_ctx + g2c * f_all[:, :n_ctx]
            h_lat = h_lat + g2 * f_all[:, n_ctx:]
        else:
            h_lat = h_lat + g2 * f_all
    return h_lat
```

```cpp
#include <hip/hip_runtime.h>
#include <cstdio>
#include <cstdint>

#ifndef MK_STOP
#define MK_STOP 99
#endif
#ifndef FFN_FP8
#define FFN_FP8 2
#endif
#ifndef MK_SPLIT
#define MK_SPLIT 0
#endif

namespace pg8 {
#define PG8_LAS __attribute__((address_space(3)))
typedef unsigned short bf16_t;
typedef short bf16x8 __attribute__((ext_vector_type(8)));
typedef float f32x4 __attribute__((ext_vector_type(4)));
typedef unsigned u32x4 __attribute__((ext_vector_type(4)));
typedef int v4i __attribute__((ext_vector_type(4)));
typedef int v8i __attribute__((ext_vector_type(8)));
constexpr int BM = 256, BK = 64, HALF = 128, HTB = HALF * BK * 2, STAGE_BYTES = 8 * HTB, NXCD = 8, WGM = 8;

__host__ __device__ __forceinline__ int lds_byte(int r, int c) { const int st = (r >> 4) * 2 + (c >> 5), rr = r & 15, cc = c & 31, ob = rr * 64 + cc * 2; return st * 1024 + (ob ^ (((ob >> 9) & 1) << 5)); }
__host__ __device__ __forceinline__ void stage_rc(int b, int& R, int& C) { const int st = b / 1024, sb = b % 1024, swz = sb ^ (((sb >> 9) & 1) << 5); R = (st >> 1) * 16 + swz / 64; C = (st & 1) * 32 + (swz % 64) / 2; }
__host__ __device__ __forceinline__ int perm32(int rho) { const int n = rho >> 4, i = rho & 15; return 8 * (i >> 2) + 4 * n + (i & 3); }

struct Unit { int pm, pn, bz; unsigned aoff, boff; };
struct Gemm { const bf16_t* A; const bf16_t* Bt; int lda, ldb, K; };

struct TileOrder {
    int nM, nN, nB, nwg, G, c;
    __device__ void init(int nM_, int nN_, int nB_, int G_, int c_) { nM = nM_; nN = nN_; nB = nB_; nwg = nM * nN * nB; G = G_; c = c_; }
    __device__ bool decode(int i, int& bz, int& pm, int& pn) const {
        const long L = (long)i * G + c; if (L >= nwg) return false;
        int wgid = (int)L; { const int q = nwg / NXCD, r = nwg % NXCD, xcd = wgid % NXCD, off = wgid / NXCD; wgid = (xcd < r ? xcd * (q + 1) : r * (q + 1) + (xcd - r) * q) + off; }
        const int per = nM * nN; bz = wgid / per; const int w = wgid - bz * per;
        const int nig = WGM * nN, gid = w / nig, fm = gid * WGM, gsz = (nM - fm) < WGM ? (nM - fm) : WGM;
        pm = fm + ((w % nig) % gsz); pn = (w % nig) / gsz; return true;
    }
};
struct PlainSched {
    TileOrder o; size_t astr, bstr, zA, zB;
    __device__ bool next(int i, Unit& u) const { if (!o.decode(i, u.bz, u.pm, u.pn)) return false; u.aoff = (unsigned)((size_t)u.bz * zA + (size_t)u.pm * astr); u.boff = (unsigned)((size_t)u.bz * zB + (size_t)u.pn * bstr); return true; }
};
struct MoeSched {
    TileOrder o; size_t astr, bstr, zB; const int* tile_e;
    __device__ bool next(int i, Unit& u) const { int bz; if (!o.decode(i, bz, u.pm, u.pn)) return false; u.bz = __builtin_amdgcn_readfirstlane(tile_e[u.pm]); u.aoff = (unsigned)((size_t)u.pm * astr); u.boff = (unsigned)((size_t)u.bz * zB + (size_t)u.pn * bstr); return true; }
};

struct MoeSplitSched {
    int pm0, nun, G, c; size_t astr, bstr, zB; unsigned kslice; const int* tile_e;
    __device__ bool next(int i, Unit& u) const { const long L = (long)i * G + c; if (L >= nun) return false; const int l = (int)L, ks = l & 3, pn = (l >> 2) & 7, pm = pm0 + (l >> 5);
        u.pm = pm; u.pn = pn; u.bz = ks; const int e = __builtin_amdgcn_readfirstlane(tile_e[pm]);
        u.aoff = (unsigned)((size_t)pm * astr + (size_t)ks * kslice); u.boff = (unsigned)((size_t)e * zB + (size_t)pn * bstr + (size_t)ks * kslice); return true; }
};
__device__ __forceinline__ unsigned cvt_pk_bf16(float lo, float hi) { unsigned r; asm volatile("v_cvt_pk_bf16_f32 %0, %1, %2" : "=v"(r) : "v"(lo), "v"(hi)); return r; }
__device__ __forceinline__ u32x4 pack8(const f32x4& a, const f32x4& b) { u32x4 w; w.x = cvt_pk_bf16(a[0], a[1]); w.y = cvt_pk_bf16(a[2], a[3]); w.z = cvt_pk_bf16(b[0], b[1]); w.w = cvt_pk_bf16(b[2], b[3]); return w; }

template <class Epi, class Sched, bool FP8 = false>
__device__ __forceinline__ void gemm_phase(PG8_LAS unsigned char* lds, const Gemm g, const Sched& S, const Epi& E) {
    const int tid = threadIdx.x, wid = __builtin_amdgcn_readfirstlane(tid >> 6), lane = tid & 63, wr = wid >> 2, wc = wid & 3, fr = lane & 15, fq = lane >> 4;
    const int K = g.K, nt = K / BK;
    unsigned voffA[2], voffB[2];
#pragma unroll
    for (int i = 0; i < 2; ++i) { int R, C; stage_rc(tid * 16 + i * 8192, R, C); const int Rb = Epi::PERM ? ((R & ~31) + perm32(R & 31)) : R;
        voffA[i] = (unsigned)(R * g.lda + C) * 2u; voffB[i] = (unsigned)(Rb * g.ldb + C) * 2u; }
    const unsigned kstep = (unsigned)(BK * 2);
    const unsigned hstepA = (unsigned)HALF * (unsigned)g.lda * 2u, hstepB = (unsigned)HALF * (unsigned)g.ldb * 2u;
    const unsigned ldsw = (unsigned)wid * 1024u;
    const int aoff = lds_byte(wr * 64 + fr, fq * 8), boff = lds_byte(wc * 32 + fr, fq * 8);
    const char* const gA = (const char*)g.A; const char* const gB = (const char*)g.Bt;
#define PG8_SA(b, h) (((b) * 2 + (h)) * HTB)
#define PG8_SB(b, h) ((4 + (b) * 2 + (h)) * HTB)
#define PG8_STAGE(bufoff, gbase, soff, voff) do { _Pragma("unroll") for (int _i = 0; _i < 2; ++_i) \
        __builtin_amdgcn_global_load_lds((const unsigned*)((gbase) + (size_t)((soff) + (voff)[_i])), (PG8_LAS unsigned*)(lds + (bufoff) + ldsw + _i * 8192), 16, 0, 0); } while (0)
#define PG8_LDA(dst, b, h) do { _Pragma("unroll") for (int m = 0; m < 4; ++m) _Pragma("unroll") for (int k = 0; k < 2; ++k) dst[m][k] = *(const PG8_LAS bf16x8*)(lds + PG8_SA(b, h) + aoff + m * 2048 + k * 1024); } while (0)
#define PG8_LDB(dst, b, h) do { _Pragma("unroll") for (int n = 0; n < 2; ++n) _Pragma("unroll") for (int k = 0; k < 2; ++k) dst[n][k] = *(const PG8_LAS bf16x8*)(lds + PG8_SB(b, h) + boff + n * 2048 + k * 1024); } while (0)
#define PG8_CAT(x) __builtin_shufflevector(__builtin_bit_cast(v4i, (x)[0]), __builtin_bit_cast(v4i, (x)[1]), 0, 1, 2, 3, 4, 5, 6, 7)
#define PG8_MMA(ai, bj, At, Bt) do { __builtin_amdgcn_s_setprio(1); \
        if constexpr (FP8) {   \
            _Pragma("unroll") for (int m = 0; m < 4; ++m) { const v8i a8 = PG8_CAT(At[m]); _Pragma("unroll") for (int n = 0; n < 2; ++n) { const v8i b8 = PG8_CAT(Bt[n]); \
                  \
                asm volatile("s_nop 1\n\tv_mfma_scale_f32_16x16x128_f8f6f4 %0, %1, %2, %0, %3, %3 op_sel_hi:[0,0,0]" : "+v"(acc[ai][bj][m][n]) : "v"(b8), "v"(a8), "v"(sc1)); } } \
        } else { _Pragma("unroll") for (int m = 0; m < 4; ++m) _Pragma("unroll") for (int n = 0; n < 2; ++n) _Pragma("unroll") for (int k = 0; k < 2; ++k) \
            acc[ai][bj][m][n] = __builtin_amdgcn_mfma_f32_16x16x32_bf16(Bt[n][k], At[m][k], acc[ai][bj][m][n], 0, 0, 0); } \
        __builtin_amdgcn_s_setprio(0); } while (0)
#define PG8_WAIT_V(n) asm volatile("s_waitcnt vmcnt(" #n ")" ::: "memory")
#define PG8_WAIT_L(n) asm volatile("s_waitcnt lgkmcnt(" #n ")" ::: "memory")
#define PG8_BAR __builtin_amdgcn_s_barrier()
#define PG8_SCHED __builtin_amdgcn_sched_barrier(0)
    Unit cur, nxt; int ui = 0;
    if (!S.next(0, cur)) return;
    const int sc1 = 0x7f7f7f7f;
    f32x4 acc[2][2][4][2];
#pragma unroll
    for (int a = 0; a < 2; ++a)
#pragma unroll
        for (int b = 0; b < 2; ++b)
#pragma unroll
            for (int m = 0; m < 4; ++m)
#pragma unroll
                for (int n = 0; n < 2; ++n) acc[a][b][m][n] = (f32x4){0.f, 0.f, 0.f, 0.f};
    bf16x8 At[4][2], B0[2][2], B1[2][2];
    unsigned cA = cur.aoff, cB = cur.boff;
    PG8_STAGE(PG8_SB(0, 0), gB, cB, voffB); PG8_STAGE(PG8_SB(0, 1), gB, cB + hstepB, voffB); PG8_STAGE(PG8_SA(0, 0), gA, cA, voffA); PG8_STAGE(PG8_SA(0, 1), gA, cA + hstepA, voffA);
    if (wr == 1) PG8_BAR;
    PG8_WAIT_V(2); PG8_BAR;
    PG8_STAGE(PG8_SB(1, 0), gB, cB + kstep, voffB); PG8_STAGE(PG8_SA(1, 0), gA, cA + kstep, voffA); PG8_STAGE(PG8_SB(1, 1), gB, cB + hstepB + kstep, voffB);
    PG8_WAIT_V(6); PG8_BAR;
    for (;;) {
        const bool has_next = S.next(ui + 1, nxt);
        const unsigned nA = has_next ? nxt.aoff : cA, nB = has_next ? nxt.boff : cB;
#pragma unroll 1
        for (int t = 0; t < nt; t += 2) {
            const bool last = (t == nt - 2);
            const unsigned a1 = cA + (unsigned)(t + 1) * kstep;
            const unsigned a2 = last ? nA : cA + (unsigned)(t + 2) * kstep, b2 = last ? nB : cB + (unsigned)(t + 2) * kstep;
            const unsigned a3 = a2 + kstep, b3 = b2 + kstep;
            PG8_LDB(B0, 0, 0); PG8_LDB(B1, 0, 1); PG8_SCHED; PG8_LDA(At, 0, 0); PG8_STAGE(PG8_SA(1, 1), gA, a1 + hstepA, voffA);
            PG8_WAIT_V(8); PG8_WAIT_L(0); PG8_BAR; PG8_MMA(0, 0, At, B0); PG8_MMA(0, 1, At, B1); PG8_BAR; PG8_SCHED;
            PG8_LDA(At, 0, 1); PG8_STAGE(PG8_SB(0, 0), gB, b2, voffB); PG8_STAGE(PG8_SB(0, 1), gB, b2 + hstepB, voffB); PG8_STAGE(PG8_SA(0, 0), gA, a2, voffA);
            PG8_WAIT_V(8); PG8_WAIT_L(0); PG8_BAR; PG8_MMA(1, 0, At, B0); PG8_MMA(1, 1, At, B1); PG8_BAR; PG8_SCHED;
            PG8_LDB(B0, 1, 0); PG8_LDB(B1, 1, 1); PG8_SCHED; PG8_LDA(At, 1, 0); PG8_STAGE(PG8_SA(0, 1), gA, a2 + hstepA, voffA);
            PG8_WAIT_V(8); PG8_WAIT_L(0); PG8_BAR; PG8_MMA(0, 0, At, B0); PG8_MMA(0, 1, At, B1); PG8_BAR; PG8_SCHED;
            PG8_LDA(At, 1, 1); PG8_STAGE(PG8_SB(1, 0), gB, b3, voffB); PG8_STAGE(PG8_SB(1, 1), gB, b3 + hstepB, voffB); PG8_STAGE(PG8_SA(1, 0), gA, a3, voffA);
            PG8_WAIT_V(8); PG8_WAIT_L(0); PG8_BAR; PG8_MMA(1, 0, At, B0); PG8_MMA(1, 1, At, B1); PG8_BAR; PG8_SCHED;
        }
        if constexpr (FP8) {
            asm volatile("s_nop 15" : "+v"(acc[0][0][0][0]), "+v"(acc[0][0][0][1]), "+v"(acc[0][0][1][0]), "+v"(acc[0][0][1][1]), "+v"(acc[0][0][2][0]), "+v"(acc[0][0][2][1]), "+v"(acc[0][0][3][0]), "+v"(acc[0][0][3][1]),
                                      "+v"(acc[0][1][0][0]), "+v"(acc[0][1][0][1]), "+v"(acc[0][1][1][0]), "+v"(acc[0][1][1][1]), "+v"(acc[0][1][2][0]), "+v"(acc[0][1][2][1]), "+v"(acc[0][1][3][0]), "+v"(acc[0][1][3][1]));
            asm volatile("" : "+v"(acc[1][0][0][0]), "+v"(acc[1][0][0][1]), "+v"(acc[1][0][1][0]), "+v"(acc[1][0][1][1]), "+v"(acc[1][0][2][0]), "+v"(acc[1][0][2][1]), "+v"(acc[1][0][3][0]), "+v"(acc[1][0][3][1]),
                              "+v"(acc[1][1][0][0]), "+v"(acc[1][1][0][1]), "+v"(acc[1][1][1][0]), "+v"(acc[1][1][1][1]), "+v"(acc[1][1][2][0]), "+v"(acc[1][1][2][1]), "+v"(acc[1][1][3][0]), "+v"(acc[1][1][3][1]));
        }
        if (wr == 0) PG8_BAR;
        E(acc, cur, wr, wc, fr, fq);
        if (!has_next) break;
#pragma unroll
        for (int a = 0; a < 2; ++a)
#pragma unroll
            for (int b = 0; b < 2; ++b)
#pragma unroll
                for (int m = 0; m < 4; ++m)
#pragma unroll
                    for (int n = 0; n < 2; ++n) acc[a][b][m][n] = (f32x4){0.f, 0.f, 0.f, 0.f};
        cur = nxt; cA = nA; cB = nB; ++ui;
        if (wr == 1) PG8_BAR;
    }
    PG8_WAIT_V(0);
    PG8_BAR;
#undef PG8_SA
#undef PG8_SB
#undef PG8_STAGE
#undef PG8_LDA
#undef PG8_LDB
#undef PG8_MMA
#undef PG8_CAT
#undef PG8_WAIT_V
#undef PG8_WAIT_L
#undef PG8_BAR
#undef PG8_SCHED
}
}

constexpr int D = 2048, SEQ = 16384, CTX = 256, T = SEQ + CTX, DFF = 7168, NEXP = 8;
constexpr int NWAVES = 8, NTHR = 512;
constexpr int WPOOL = 1536, WS5 = 512, PG = 384, S5G = 32, S5P = 64, S5N = 16, LC = 64, NCH = T / LC  , NCH_CTX = CTX / LC  ;
constexpr int S5ROWS = 512, S5K = 1280;
constexpr int WINO_N = 4864;
constexpr float EPS = 1e-6f;
constexpr float MOE_WSC_GU = 64.f, MOE_WSC_DN = 128.f, MOE_HSC = 4.f;

enum { I_X = 0, I_C, I_CTX, I_CCTX, I_WMOD, I_BMOD, I_NORMS, I_EWIN, I_EPOOLW, I_EPOOLS, I_LAMRE, I_LAMIM, I_LOGDT, I_BRE, I_BIM, I_CRE, I_CIM, I_S5D, I_WGLU, I_EWOUT,
       I_FFG, I_FFU, I_FFD, I_OWIN, I_GLAWA, I_GLABA, I_GLANORM, I_QNORM, I_KNORM, I_OWOUT, I_ROUTER, I_ROUTERB, I_MOEG, I_MOEU, I_MOED, N_IN };

constexpr size_t MiB = 1u << 20;
constexpr size_t al256(size_t x) { return (x + 255) / 256 * 256; }
constexpr size_t WS_CTL = 0, CTL_ZERO_BYTES = 128 * 1024;
constexpr size_t WS_MODF = 1 * MiB;
constexpr size_t WS_ROPE = WS_MODF + al256(2 * 2 * 6 * 2048 * 4);
constexpr size_t WS_W0 = 2 * MiB;
constexpr size_t SZ_WINE = (size_t)2048 * 2048 * 2, SZ_WPOOL = (size_t)4 * 512 * 384 * 2, SZ_WGLU = (size_t)512 * 512 * 2, SZ_WGU = (size_t)14336 * 2048 * 2,
                 SZ_WDN = (size_t)2048 * 7168 * 2, SZ_WINO = (size_t)WINO_N * 2048 * 2;
constexpr size_t WS_WINE = WS_W0, WS_WPOOL = WS_WINE + SZ_WINE, WS_WGLU = WS_WPOOL + SZ_WPOOL, WS_WOUTE = WS_WGLU + SZ_WGLU, WS_WGU = WS_WOUTE + SZ_WINE,
                 WS_WDN = WS_WGU + SZ_WGU, WS_WINO = WS_WDN + SZ_WDN, WS_WOUTO = WS_WINO + SZ_WINO, WS_WMGU = WS_WOUTO + SZ_WINE, WS_WMDN = WS_WMGU + 8 * SZ_WGU,
                 WS_HRES = WS_WMDN + 8 * SZ_WDN;
constexpr size_t SZ_HRES = (size_t)T * D * 4;
constexpr size_t WS_ARENA = WS_HRES + SZ_HRES;
constexpr size_t SZ_ROWB = (size_t)T * D * 2;
constexpr size_t A_U = 0, A_ZP = A_U + SZ_ROWB, SZ_ZP = (size_t)T * WPOOL * 2, A_DP = A_ZP + SZ_ZP, A_AS5 = A_DP + SZ_ZP, SZ_AS5 = (size_t)S5G * S5ROWS * S5K * 2,
                 A_SLOC = A_AS5 + SZ_AS5, SZ_SLOC = (size_t)S5G * S5ROWS * 256 * 4, A_YG = A_SLOC + SZ_SLOC, SZ_YG = (size_t)T * WS5 * 2, A_YMIX = A_YG + SZ_YG,
                 A_YO = A_YMIX + SZ_ROWB, A_V = A_YO + SZ_ROWB, A_HID = A_V + SZ_ROWB, SZ_HID = (size_t)T * DFF * 2, A_F = A_HID + SZ_HID,
                 A_M1T = A_F + SZ_ROWB, SZ_M1T = (size_t)S5G * 256 * 1024 * 2, A_K3T = A_M1T + SZ_M1T, SZ_K3T = (size_t)S5G * 1024 * S5K * 2,
                 A_TBG = A_K3T + SZ_K3T, SZ_TBG = (size_t)S5G * 2 * 64 * 256 * 4, A_L0_END = A_TBG + SZ_TBG;
constexpr size_t WS_END_L0 = WS_ARENA + A_L0_END;
constexpr int MOE_ROWS = 2 * SEQ + NEXP * 256;
constexpr int MOE_MAIN_TILES = 128, MOE_SPLIT_TILES = MOE_ROWS / 256 - 128;
static_assert((size_t)4 * MOE_SPLIT_TILES * 256 * D * 4 <= (size_t)MOE_ROWS * D * 2, "split-K partials fit in the (dead) VG region");
constexpr size_t SZ_T512 = (size_t)T * 512 * 2, SZ_T1024 = (size_t)T * 1024 * 2, SZ_T256 = (size_t)T * 256 * 2, SZ_SEQB = (size_t)SEQ * D * 2;
constexpr size_t B_GQ = A_U + SZ_ROWB, B_GK = B_GQ + SZ_T512, B_GV = B_GK + SZ_T512, B_R = B_GV + SZ_T1024, B_AQ = B_R + SZ_T1024, B_AK = B_AQ + SZ_T1024, B_AV = B_AK + SZ_T256,
                 B_ALR = B_AV + SZ_T256, B_QE = B_ALR + al256((size_t)T * 16 * 4), B_KE = B_QE + 2 * SZ_T512, B_KDT = B_KE + 2 * SZ_T512, B_VT = B_KDT + 2 * SZ_T512,
                 B_DEC = B_VT + SZ_T1024, B_ST = B_DEC + al256((size_t)2 * NCH * 4 * 128 * 4), SZ_ST = (size_t)2 * NCH * 4 * 256 * 128 * 2, B_YMIX1 = B_ST + SZ_ST,
                 B_YO1 = B_YMIX1 + SZ_SEQB, B_REGA_END = B_YO1 + SZ_SEQB;
constexpr size_t B_HID2 = 0, SZ_HID2 = (size_t)MOE_ROWS * DFF * 2, B_FS = B_HID2 + SZ_HID2, SZ_FS = (size_t)MOE_ROWS * D * 2, B_OVL_END = B_FS + SZ_FS;
constexpr size_t B_REGB = al256(B_REGA_END > B_OVL_END ? B_REGA_END : B_OVL_END);
constexpr size_t B_V1 = B_REGB, B_VG = B_V1 + SZ_SEQB, B_RE = B_VG + SZ_FS, B_RG = B_RE + (size_t)SEQ * 8, B_SLOT = B_RG + (size_t)SEQ * 8, B_CNT = B_SLOT + (size_t)SEQ * 8,
                 B_TILE = B_CNT + 256 * 8 * 4, B_L1_END = B_TILE + 4096;
constexpr size_t WS_END_L1 = WS_ARENA + B_L1_END;
constexpr size_t WS_NEED = WS_END_L0 > WS_END_L1 ? WS_END_L0 : WS_END_L1;
static_assert(WS_NEED <= (size_t)1879048192, "workspace map exceeds the guaranteed size");

constexpr int CW_TMO = 0, CW_CODE = 1, CW_BAR = 4096;

#define GAS __attribute__((address_space(1)))
#define LAS __attribute__((address_space(3)))
typedef unsigned short bf16;
typedef unsigned v4u __attribute__((ext_vector_type(4)));
typedef unsigned v2u __attribute__((ext_vector_type(2)));
typedef float f32x4 __attribute__((ext_vector_type(4)));
typedef float f32x2 __attribute__((ext_vector_type(2)));
typedef short bf16x8 __attribute__((ext_vector_type(8)));
typedef GAS unsigned gu32;
#define RLX_AGENT __ATOMIC_RELAXED, __HIP_MEMORY_SCOPE_AGENT
#define LDS_WAIT() asm volatile("s_waitcnt lgkmcnt(0)" ::: "memory")
#define VM_WAIT() asm volatile("s_waitcnt vmcnt(0)" ::: "memory")
__device__ __forceinline__ unsigned f2bf(float f) { unsigned u = __builtin_bit_cast(unsigned, f); return (u + 0x7fffu + ((u >> 16) & 1u)) >> 16; }
typedef __bf16 bf16x2_t __attribute__((ext_vector_type(2)));
__device__ __forceinline__ unsigned pk2(float lo, float hi) { const f32x2 v = {lo, hi}; return __builtin_bit_cast(unsigned, __builtin_convertvector(v, bf16x2_t)); }
__device__ __forceinline__ float bflo(unsigned w) { return __builtin_bit_cast(float, w << 16); }
__device__ __forceinline__ float bfhi(unsigned w) { return __builtin_bit_cast(float, w & 0xffff0000u); }
__device__ __forceinline__ float bf2f(bf16 b) { return __builtin_bit_cast(float, (unsigned)b << 16); }
__device__ __forceinline__ float sigmoidf_(float x) { return __builtin_amdgcn_rcpf(1.f + __expf(-x)); }
__device__ __forceinline__ float siluf_(float x) { return x * __builtin_amdgcn_rcpf(1.f + __expf(-x)); }
__device__ __forceinline__ float swiglu_fast(float ag, float au, float negsg_log2e, float kk) { const float e = __builtin_amdgcn_exp2f(ag * negsg_log2e); return (ag * au) * (kk * __builtin_amdgcn_rcpf(1.f + e)); }
__device__ __forceinline__ float gelu_tanh(float y) { const float z = 0.7978845608028654f * (y + 0.044715f * y * y * y); const float e = __expf(2.f * z); const float th = 1.f - 2.f * __builtin_amdgcn_rcpf(e + 1.f); return 0.5f * y * (1.f + th); }

#define XB_TMO      128
#define XB_XCNT(j)  (256  + 64 * (j))
#define XB_XSUB(j)  (1280 + 64 * (j))
#define XB_XGEN(j)  (2304 + 64 * (j))
#define XB_TOP      3328
#define XB_TOPGEN   3392
#define XCD_BAR_WORDS 3456
#define XB_SPIN_CAP (1u << 22)
__device__ __forceinline__ unsigned xb_ld(unsigned* p)              { return __hip_atomic_load(p, __ATOMIC_RELAXED, __HIP_MEMORY_SCOPE_AGENT); }
__device__ __forceinline__ unsigned xb_add(unsigned* p, unsigned v) { return __hip_atomic_fetch_add(p, v, __ATOMIC_RELAXED, __HIP_MEMORY_SCOPE_AGENT); }
__device__ __forceinline__ unsigned xb_xcc_id() { return (unsigned)__builtin_amdgcn_s_getreg((3 << 11) | 20) & 0xFu; }
#define XB_SPIN(cond, bar) do { unsigned _sp = 0; while (cond) { __builtin_amdgcn_s_sleep(1); \
    if ((++_sp & 255u) == 0u) { if (xb_ld(&(bar)[XB_TMO])) break; if (_sp > XB_SPIN_CAP) { atomicAdd(&(bar)[XB_TMO], 1u); break; } } } } while (0)
struct XcdBarrier { unsigned* bar; unsigned x; volatile LAS unsigned* st; };
__device__ __forceinline__ XcdBarrier xcd_barrier_post(unsigned* bar, volatile LAS unsigned* st) {
    XcdBarrier b; b.bar = bar; b.x = xb_xcc_id(); b.st = st;
    if (threadIdx.x == 0) (void)xb_add(&bar[XB_XCNT(b.x)], 1u);
    return b;
}
__device__ __forceinline__ void xcd_barrier_complete(unsigned* bar, unsigned x, unsigned& nloc, unsigned& nx) {
    const unsigned G = gridDim.x * gridDim.y * gridDim.z;
    unsigned sum, cnt, mine, sp = 0u;
    for (;;) {
        sum = 0u; cnt = 0u; mine = 0u;
#pragma unroll
        for (unsigned j = 0; j < 16; ++j) { const unsigned c = xb_ld(&bar[XB_XCNT(j)]); sum += c; cnt += (c > 0u) ? 1u : 0u; mine = (j == x) ? c : mine; }
        if (sum == G) break;
        __builtin_amdgcn_s_sleep(1);
        if ((++sp & 255u) == 0u) { if (xb_ld(&bar[XB_TMO])) break; if (sp > XB_SPIN_CAP) { atomicAdd(&bar[XB_TMO], 1u); break; } }
    }
    nloc = mine > 0u ? mine : 1u; nx = cnt > 0u ? cnt : 1u;
}
__device__ __forceinline__ void xcd_barrier(const XcdBarrier& b) {
    asm volatile("s_waitcnt vmcnt(0)" ::: "memory");
    __syncthreads();
    if (threadIdx.x == 0) {
        unsigned* bar = b.bar;
        __builtin_amdgcn_s_waitcnt(0);
        unsigned nloc = b.st[0], nx = b.st[1];
        if (nloc == 0u) { xcd_barrier_complete(bar, b.x, nloc, nx); b.st[0] = nloc; b.st[1] = nx; }
        const unsigned old = xb_add(&bar[XB_XSUB(b.x)], 1u);
        const unsigned gen = old / nloc;
        if (old + 1u == (gen + 1u) * nloc) {
            __builtin_amdgcn_fence(__ATOMIC_RELEASE, "agent");
            asm volatile("s_waitcnt vmcnt(0)" ::: "memory");
            const unsigned og = xb_add(&bar[XB_TOP], 1u);
            const unsigned tg = og / nx;
            if (og + 1u == (tg + 1u) * nx) xb_add(&bar[XB_TOPGEN], 1u);
            else XB_SPIN(xb_ld(&bar[XB_TOPGEN]) == tg, bar);
            __builtin_amdgcn_fence(__ATOMIC_ACQUIRE, "agent");
            xb_add(&bar[XB_XGEN(b.x)], 1u);
            asm volatile("s_waitcnt vmcnt(0)" ::: "memory");
        } else {
            XB_SPIN(xb_ld(&bar[XB_XGEN(b.x)]) == gen, bar);
            __builtin_amdgcn_fence(__ATOMIC_ACQUIRE, "agent");
            asm volatile("s_waitcnt vmcnt(0)" ::: "memory");
        }
    }
    __syncthreads();
}

constexpr int RING_OFF = 0, RING_BYTES = 131072;
constexpr int LDSCTL_OFF = RING_BYTES, MISC_OFF = LDSCTL_OFF + 320;
constexpr int LDS_BYTES = 147456;

#define CAS __attribute__((address_space(4)))
__device__ __forceinline__ const float* inp(int k) { const CAS char* ka = (const CAS char*)__builtin_amdgcn_kernarg_segment_ptr(); return *(const float* const CAS*)(ka + 8 * k); }
__device__ __forceinline__ float* karg_out() { const CAS char* ka = (const CAS char*)__builtin_amdgcn_kernarg_segment_ptr(); return *(float* const CAS*)(ka + 8 * 35); }
__device__ __forceinline__ unsigned char* karg_ws() { const CAS char* ka = (const CAS char*)__builtin_amdgcn_kernarg_segment_ptr(); return *(unsigned char* const CAS*)(ka + 8 * 36); }
__device__ __forceinline__ int karg_i(int k) { const CAS char* ka = (const CAS char*)__builtin_amdgcn_kernarg_segment_ptr(); return *(const CAS int*)(ka + 8 * 37 + 4 * k); }
struct Frame {
    LAS unsigned char* lds;
    volatile LAS unsigned* MISC;
    gu32* ctl;
    int tid, lane, wave, vcu, G;
    unsigned char* ws;
};
__device__ __forceinline__ float wave_sum(float v) {
#pragma unroll
    for (int o = 1; o < 64; o <<= 1) v += __shfl_xor(v, o);
    return v;
}

struct RmIdent { int off; __device__ __forceinline__ int operator()(int n) const { return n + off; } };
struct RmGateUp { int which; __device__ __forceinline__ int operator()(int n) const { return (n >> 7) * 256 + which * 128 + (n & 127); } };
struct RmWinO { __device__ __forceinline__ int operator()(int n) const {
    if (n < 2048) return n; if (n < 2064) return 4608 + (n - 2048); return n - 16; } };
template <class RM> __device__ __forceinline__ void tr_item(const float* W, int K, int N, bf16* WT, int ldt, const RM rm, LAS float* scr, int item, int lane) {
    const int nblk = (N + 31) / 32, kb = item / nblk, nb = item - kb * nblk, k0 = 64 * kb, n0 = 32 * nb;
    const int c4 = (lane & 7) * 4, r8 = lane >> 3; const bool okc = (n0 + c4) < N;
    f32x4 v[8];
#pragma unroll
    for (int i = 0; i < 8; ++i) v[i] = okc ? *(const GAS f32x4*)(W + (size_t)(k0 + 8 * i + r8) * N + n0 + c4) : (f32x4){0.f, 0.f, 0.f, 0.f};
#pragma unroll
    for (int i = 0; i < 8; ++i) { LAS float* s = scr + (8 * i + r8) * 33 + c4; s[0] = v[i][0]; s[1] = v[i][1]; s[2] = v[i][2]; s[3] = v[i][3]; }
    LDS_WAIT(); asm volatile("" ::: "memory");
    const int c = lane & 7;
#pragma unroll
    for (int j = 0; j < 4; ++j) { const int n = (lane >> 3) + 8 * j; const LAS float* s = scr + (8 * c) * 33 + n;
        v4u o; o.x = pk2(s[0 * 33], s[1 * 33]); o.y = pk2(s[2 * 33], s[3 * 33]); o.z = pk2(s[4 * 33], s[5 * 33]); o.w = pk2(s[6 * 33], s[7 * 33]);
        if (n0 + n < N) *(GAS v4u*)(WT + (size_t)rm(n0 + n) * ldt + k0 + 8 * c) = o; }
    LDS_WAIT(); asm volatile("" ::: "memory");
}
__device__ __forceinline__ void zero_rows(bf16* p, size_t nbytes, int gt, int ngt) {
    for (size_t i = (size_t)gt; i < nbytes / 16; i += (size_t)ngt) ((GAS v4u*)p)[i] = (v4u){0u, 0u, 0u, 0u};
}
__device__ __forceinline__ unsigned pk4_fp8(float a, float b, float c, float d) { int w = 0; w = __builtin_amdgcn_cvt_pk_fp8_f32(a, b, w, false); w = __builtin_amdgcn_cvt_pk_fp8_f32(c, d, w, true); return (unsigned)w; }
template <class RM> __device__ __forceinline__ void tr_item8(const float* W, int K, int N, unsigned char* WT, int ldt, const RM rm, float sc, LAS float* scr, int item, int lane) {
    const int nblk = (N + 31) / 32, kb = item / nblk, nb = item - kb * nblk, k0 = 64 * kb, n0 = 32 * nb;
    const int c4 = (lane & 7) * 4, r8 = lane >> 3; const bool okc = (n0 + c4) < N;
    f32x4 v[8];
#pragma unroll
    for (int i = 0; i < 8; ++i) v[i] = okc ? *(const GAS f32x4*)(W + (size_t)(k0 + 8 * i + r8) * N + n0 + c4) : (f32x4){0.f, 0.f, 0.f, 0.f};
#pragma unroll
    for (int i = 0; i < 8; ++i) { LAS float* s = scr + (8 * i + r8) * 33 + c4; s[0] = v[i][0]; s[1] = v[i][1]; s[2] = v[i][2]; s[3] = v[i][3]; }
    LDS_WAIT(); asm volatile("" ::: "memory");
    const int c = lane & 7;
#pragma unroll
    for (int j = 0; j < 4; ++j) { const int n = (lane >> 3) + 8 * j; const LAS float* s = scr + (8 * c) * 33 + n;
        v2u o; o.x = pk4_fp8(s[0 * 33] * sc, s[1 * 33] * sc, s[2 * 33] * sc, s[3 * 33] * sc); o.y = pk4_fp8(s[4 * 33] * sc, s[5 * 33] * sc, s[6 * 33] * sc, s[7 * 33] * sc);
        if (n0 + n < N) *(GAS v2u*)(WT + (size_t)rm(n0 + n) * ldt + k0 + 8 * c) = o; }
    LDS_WAIT(); asm volatile("" ::: "memory");
}
constexpr int items_of(int K, int N) { return (K / 64) * ((N + 31) / 32); }

__device__ __forceinline__ void s5_small_tables(Frame& F, int g) {
    const float* lam_re = inp(I_LAMRE); const float* lam_im = inp(I_LAMIM); const float* log_dt = inp(I_LOGDT);
    const float* b_re = inp(I_BRE); const float* b_im = inp(I_BIM); const float* c_re = inp(I_CRE); const float* c_im = inp(I_CIM);
    LAS f32x2* APOW = (LAS f32x2*)(F.lds); LAS f32x2* BB = (LAS f32x2*)(F.lds + 2 * 64 * 65 * 8); LAS f32x2* CC = BB + 2 * 64 * 16;
    const int tid = F.tid;
    __syncthreads();
    if (tid < 128) {
        const int dir = tid >> 6, p = tid & 63; const int gi = (dir * S5G + g);
        const double dt = exp((double)log_dt[gi]); const double lr = (double)lam_re[gi * 64 + p], li = (double)lam_im[gi * 64 + p];
        const double mag = exp(lr * dt), ar = mag * cos(li * dt), ai = mag * sin(li * dt);
        double pr = 1.0, pi = 0.0;
        for (int k = 0; k <= 64; ++k) { APOW[(dir * 64 + p) * 65 + k] = (f32x2){(float)pr, (float)pi}; const double nr = pr * ar - pi * ai, ni = pr * ai + pi * ar; pr = nr; pi = ni; }
        const double den = lr * lr + li * li, nr = ar - 1.0, ni = ai;
        const double kr = (nr * lr + ni * li) / den, ki = (ni * lr - nr * li) / den;
        for (int n = 0; n < 16; ++n) { const double br = (double)b_re[(gi * 64 + p) * 16 + n], bi = (double)b_im[(gi * 64 + p) * 16 + n];
            BB[(dir * 64 + p) * 16 + n] = (f32x2){(float)(kr * br - ki * bi), (float)(kr * bi + ki * br)}; }
    }
    for (int i = tid; i < 2 * 16 * 64; i += NTHR) { const int dir = i >> 10, r = i & 1023; CC[i] = (f32x2){c_re[(size_t)(dir * S5G + g) * 1024 + r], c_im[(size_t)(dir * S5G + g) * 1024 + r]}; }
    __syncthreads();
}
__device__ __forceinline__ void s5_stage_a(Frame& F, int g, int part) {
    LAS f32x2* APOW = (LAS f32x2*)(F.lds); LAS f32x2* BB = (LAS f32x2*)(F.lds + 2 * 64 * 65 * 8); LAS f32x2* CC = BB + 2 * 64 * 16;
    float* TBG = (float*)(F.ws + WS_ARENA + A_TBG) + (size_t)g * (2 * 64 * 256);
    bf16* M1T = (bf16*)(F.ws + WS_ARENA + A_M1T) + (size_t)g * 256 * 1024;
    const int tid = F.tid;
    for (int i0 = tid; i0 < 2 * 8 * 256; i0 += NTHR) {
        const int dir = i0 >> 11, dl = 8 * part + ((i0 >> 8) & 7), np = (i0 >> 4) & 15, n = i0 & 15; float s = 0.f;
        for (int p = 0; p < 64; ++p) { const f32x2 c = CC[(dir * 16 + np) * 64 + p], a = APOW[(dir * 64 + p) * 65 + dl], b = BB[(dir * 64 + p) * 16 + n];
            const float zr = c.x * a.x - c.y * a.y, zi = c.x * a.y + c.y * a.x; s += zr * b.x - zi * b.y; }
        TBG[((dir * 64 + dl) * 16 + np) * 16 + n] = s;
    }
    for (int i = tid; i < 32 * 128; i += NTHR) {
        const int j = 32 * part + (i >> 7), c8 = (i & 127) * 8, sI = c8 >> 4, n0 = c8 & 15, dir = j >> 7, pt = (j >> 6) & 1, p = j & 63, e = dir ? sI : 63 - sI;
        const f32x2 a = APOW[(dir * 64 + p) * 65 + e]; float v[8];
#pragma unroll
        for (int q = 0; q < 8; ++q) { const f32x2 b = BB[(dir * 64 + p) * 16 + n0 + q]; v[q] = pt ? (a.x * b.y + a.y * b.x) : (a.x * b.x - a.y * b.y); }
        v4u o; o.x = pk2(v[0], v[1]); o.y = pk2(v[2], v[3]); o.z = pk2(v[4], v[5]); o.w = pk2(v[6], v[7]);
        *(GAS v4u*)(M1T + (size_t)j * 1024 + c8) = o;
    }
}
__device__ __forceinline__ void s5_stage_b(Frame& F, int g, int part) {
    LAS f32x2* APOW = (LAS f32x2*)(F.lds); LAS f32x2* CC = (LAS f32x2*)(F.lds + 2 * 64 * 65 * 8) + 2 * 64 * 16;
    const float* TBG = (const float*)(F.ws + WS_ARENA + A_TBG) + (size_t)g * (2 * 64 * 256);
    bf16* K3T = (bf16*)(F.ws + WS_ARENA + A_K3T) + (size_t)g * 1024 * S5K;
#pragma unroll 4
    for (int i = F.tid; i < 128 * (S5K / 8); i += NTHR) {
        const int row = 128 * part + i / (S5K / 8), c8 = (i % (S5K / 8)) * 8, tau = row >> 4, np = row & 15; float v[8];
        if (c8 < 1024) { const int sI = c8 >> 4, n0 = c8 & 15;
            f32x4 f0 = {0.f, 0.f, 0.f, 0.f}, f1 = f0, b0 = f0, b1 = f0;
            if (sI <= tau) { const GAS f32x4* tb = (const GAS f32x4*)(TBG + ((0 * 64 + (tau - sI)) * 16 + np) * 16 + n0); f0 = tb[0]; f1 = tb[1]; }
            if (sI >= tau) { const GAS f32x4* tb = (const GAS f32x4*)(TBG + ((1 * 64 + (sI - tau)) * 16 + np) * 16 + n0); b0 = tb[0]; b1 = tb[1]; }
            f0 += b0; f1 += b1; v[0] = f0[0]; v[1] = f0[1]; v[2] = f0[2]; v[3] = f0[3]; v[4] = f1[0]; v[5] = f1[1]; v[6] = f1[2]; v[7] = f1[3];
        } else { const int j0 = c8 - 1024, dir = j0 >> 7, pt = (j0 >> 6) & 1, e = dir ? 64 - tau : tau + 1;
#pragma unroll
            for (int q = 0; q < 8; ++q) { const int p = (j0 & 63) + q; const f32x2 c = CC[(dir * 16 + np) * 64 + p], a = APOW[(dir * 64 + p) * 65 + e];
                v[q] = pt ? -(c.x * a.y + c.y * a.x) : (c.x * a.x - c.y * a.y); } }
        v4u o; o.x = pk2(v[0], v[1]); o.y = pk2(v[2], v[3]); o.z = pk2(v[4], v[5]); o.w = pk2(v[6], v[7]);
        *(GAS v4u*)(K3T + (size_t)row * S5K + c8) = o;
    }
}

__device__ __forceinline__ void mod_item(Frame& F, int item) {
    const int l = item >> 7, slab = item & 127, col0 = 96 * slab;
    const float* wm = inp(I_WMOD) + (size_t)l * 2048 * 12288; const float* bm = inp(I_BMOD) + (size_t)l * 12288;
    LAS float* sv = (LAS float*)F.lds;
    LAS float* part = sv + 4096;
    __syncthreads();
    for (int i = F.tid; i < 4096; i += NTHR) { const float x = (i < 2048) ? inp(I_C)[i] : inp(I_CCTX)[i - 2048]; sv[i] = siluf_(x); }
    __syncthreads();
    const int sub = F.lane / 24, cl = F.lane % 24;
    f32x4 a0 = {0.f, 0.f, 0.f, 0.f}, a1 = {0.f, 0.f, 0.f, 0.f};
    if (sub < 2) {
        const float* wp = wm + (size_t)(256 * F.wave + sub) * 12288 + col0 + 4 * cl;
#pragma unroll 8
        for (int kk = 0; kk < 256; kk += 2) { const f32x4 w = *(const GAS f32x4*)(wp + (size_t)kk * 12288); const int k = 256 * F.wave + kk + sub;
            const float s0 = sv[k], s1 = sv[2048 + k]; a0 += w * s0; a1 += w * s1; }
        LAS float* pp = part + ((F.wave * 2 + sub) * 24 + cl) * 8;
        pp[0] = a0[0]; pp[1] = a0[1]; pp[2] = a0[2]; pp[3] = a0[3]; pp[4] = a1[0]; pp[5] = a1[1]; pp[6] = a1[2]; pp[7] = a1[3];
    }
    __syncthreads();
    if (F.tid < 192) { const int w = F.tid / 96, c = F.tid % 96; float s = 0.f;
        for (int q = 0; q < 16; ++q) s += part[(q * 24 + (c >> 2)) * 8 + w * 4 + (c & 3)];
        float* MODF = (float*)(F.ws + WS_MODF); MODF[(size_t)(l * 2 + w) * 12288 + col0 + c] = s + bm[col0 + c]; }
    __syncthreads();
}

constexpr int units_of(int K, int N) { return (K / 128) * ((N + 255) / 256); }
constexpr int CU_SQ = units_of(2048, 2048), CU_PW = units_of(384, 384), CU_GL = units_of(512, 512), CU_UP = units_of(2048, 7168), CU_DN = units_of(7168, 2048), CU_WO = units_of(2048, 4624);
constexpr int CQ_E0 = 0, CQ_E1 = CQ_E0 + CU_SQ  , CQ_E2 = CQ_E1 + 4 * CU_PW  , CQ_E3 = CQ_E2 + CU_GL  , CQ_E4 = CQ_E3 + CU_SQ  ,
              CQ_F1 = CQ_E4 + CU_UP  , CQ_F2 = CQ_F1 + CU_UP  , CQ_F3 = CQ_F2 + CU_DN  , CQ_O1 = CQ_F3 + CU_WO  , CQ_O2 = CQ_O1 + CU_SQ  ,
              CQ_M1 = CQ_O2 + 8 * CU_UP  , CQ_M2 = CQ_M1 + 8 * CU_UP  , CQ_M3 = CQ_M2 + 8 * CU_DN  , CQ_END = CQ_M3;
constexpr int CW_QUEUE = 2048;
struct ConvDesc { const float* W; unsigned char* WT; int N, ldt, kind, fp8, k0, n0; float sc; };
__device__ __forceinline__ void conv_decode(Frame& F, int it, ConvDesc& d) {
    int r = it; d.kind = 0; d.fp8 = 0; d.sc = 1.f;
    if (r < CQ_E1) { d.W = inp(I_EWIN); d.WT = F.ws + WS_WINE; d.N = 2048; d.ldt = 2048; }
    else if (r < CQ_E2) { r -= CQ_E1; const int g4 = r / CU_PW; d.W = inp(I_EPOOLW) + (size_t)g4 * 384 * 384; d.WT = F.ws + WS_WPOOL + (size_t)g4 * 512 * 384 * 2; d.N = 384; d.ldt = 384; r -= g4 * CU_PW; }
    else if (r < CQ_E3) { d.W = inp(I_WGLU); d.WT = F.ws + WS_WGLU; d.N = 512; d.ldt = 512; r -= CQ_E2; }
    else if (r < CQ_E4) { d.W = inp(I_EWOUT); d.WT = F.ws + WS_WOUTE; d.N = 2048; d.ldt = 2048; r -= CQ_E3; }
    else if (r < CQ_F2) { const int up = r >= CQ_F1; d.W = inp(up ? I_FFU : I_FFG); d.WT = F.ws + WS_WGU; d.N = 7168; d.ldt = 2048; d.kind = 1 + up; r -= (up ? CQ_F1 : CQ_E4);
        if (FFN_FP8 == 1) { d.fp8 = 1; d.sc = MOE_WSC_GU; } }
    else if (r < CQ_F3) { d.W = inp(I_FFD); d.WT = F.ws + WS_WDN; d.N = 2048; d.ldt = 7168; r -= CQ_F2; if (FFN_FP8 != 0) { d.fp8 = 1; d.sc = MOE_WSC_DN; } }
    else if (r < CQ_O1) { d.W = inp(I_OWIN); d.WT = F.ws + WS_WINO; d.N = 4624; d.ldt = 2048; d.kind = 3; r -= CQ_F3; }
    else if (r < CQ_O2) { d.W = inp(I_OWOUT); d.WT = F.ws + WS_WOUTO; d.N = 2048; d.ldt = 2048; r -= CQ_O1; }
    else if (r < CQ_M2) { d.fp8 = 1; const int up = r >= CQ_M1; r -= up ? CQ_M1 : CQ_O2; const int e = r / CU_UP; d.W = inp(up ? I_MOEU : I_MOEG) + (size_t)e * 2048 * 7168; d.WT = F.ws + WS_WMGU + (size_t)e * 14336 * 2048;
        d.N = 7168; d.ldt = 2048; d.kind = 1 + up; d.sc = MOE_WSC_GU; r -= e * CU_UP; }
    else { d.fp8 = 1; r -= CQ_M2; const int e = r / CU_DN; d.W = inp(I_MOED) + (size_t)e * 7168 * 2048; d.WT = F.ws + WS_WMDN + (size_t)e * 2048 * 7168; d.N = 2048; d.ldt = 7168; d.sc = MOE_WSC_DN; r -= e * CU_DN; }
    const int nblk = (d.N + 255) / 256, kb = r / nblk; d.k0 = 128 * kb; d.n0 = 256 * (r - kb * nblk);
}
__device__ __forceinline__ int conv_row(int kind, int n) {
    if (kind == 0) return n; if (kind == 3) return RmWinO{}(n); return (n >> 7) * 256 + (kind - 1) * 128 + (n & 127); }
__device__ __forceinline__ void conv_load(const ConvDesc& d, int wave, int lane, f32x4 (&v)[16]) {
    const bool okc = (d.n0 + 4 * lane) < d.N; const float* p = d.W + (size_t)(d.k0 + 16 * wave) * d.N + d.n0 + 4 * lane;
#pragma unroll
    for (int i = 0; i < 16; ++i) v[i] = okc ? __builtin_nontemporal_load((const GAS f32x4*)(p + (size_t)i * d.N)) : (f32x4){0.f, 0.f, 0.f, 0.f};
}
__device__ __forceinline__ void conv_to_lds(const f32x4 (&v)[16], LAS float* tile, int wave, int lane) {
#pragma unroll
    for (int i = 0; i < 16; ++i) *(LAS f32x4*)(tile + (16 * wave + i) * 256 + ((lane ^ ((2 * wave + (i >> 3)) & 7)) << 2)) = v[i];
}
__device__ __forceinline__ void conv_store(const ConvDesc& d, const LAS float* tile, int tid) {
    const int c = tid & 7;
    if (d.fp8) {
#pragma unroll
        for (int q = 0; q < 4; ++q) { const int nn = (tid >> 3) + 64 * q; float x[16];
#pragma unroll
            for (int j = 0; j < 16; ++j) { const int k = 16 * c + j; x[j] = tile[k * 256 + ((((nn >> 2) ^ ((k >> 3) & 7)) & 63) << 2) + (nn & 3)]; }
            if (d.n0 + nn < d.N) { const size_t row = (size_t)conv_row(d.kind, d.n0 + nn); v4u o;
                o.x = pk4_fp8(x[0] * d.sc, x[1] * d.sc, x[2] * d.sc, x[3] * d.sc); o.y = pk4_fp8(x[4] * d.sc, x[5] * d.sc, x[6] * d.sc, x[7] * d.sc);
                o.z = pk4_fp8(x[8] * d.sc, x[9] * d.sc, x[10] * d.sc, x[11] * d.sc); o.w = pk4_fp8(x[12] * d.sc, x[13] * d.sc, x[14] * d.sc, x[15] * d.sc);
                __builtin_nontemporal_store(o, (GAS v4u*)(d.WT + row * d.ldt + d.k0 + 16 * c)); } }
    } else {
#pragma unroll
        for (int q = 0; q < 8; ++q) { const int kh = q & 1, nn = (tid >> 3) + 64 * (q >> 1); const LAS float* s = tile + (64 * kh + 8 * c) * 256 + (((nn >> 2) ^ c) << 2) + (nn & 3);
            float x[8];
#pragma unroll
            for (int j = 0; j < 8; ++j) x[j] = s[j * 256];
            if (d.n0 + nn < d.N) { const size_t row = (size_t)conv_row(d.kind, d.n0 + nn); const int kk = d.k0 + 64 * kh + 8 * c;
                v4u o; o.x = pk2(x[0], x[1]); o.y = pk2(x[2], x[3]); o.z = pk2(x[4], x[5]); o.w = pk2(x[6], x[7]);
                __builtin_nontemporal_store(o, (GAS v4u*)((bf16*)d.WT + row * d.ldt + kk)); } }
    }
}
constexpr int CQ_NONE = 0x7fffffff;
__device__ __forceinline__ int conv_pull(Frame& F) { return (int)__hip_atomic_fetch_add((unsigned*)(F.ctl + CW_QUEUE), 1u, RLX_AGENT); }
__device__ __forceinline__ void conv_work(Frame& F, int dlimit, int quota) {
    LAS float* tile = (LAS float*)(F.lds + RING_OFF);
    volatile LAS int* QW = (volatile LAS int*)(F.lds + LDSCTL_OFF);
    __syncthreads();
    if (F.tid == 0) { int c0 = CQ_NONE, c1 = CQ_NONE; const int head = (int)__hip_atomic_load((unsigned*)(F.ctl + CW_QUEUE), RLX_AGENT);
        if (head < CQ_END && (quota > 0 || head < dlimit)) { c0 = conv_pull(F); if (c0 < CQ_END && (quota > 1 || c0 < dlimit)) c1 = conv_pull(F); }
        QW[0] = c0; QW[1] = c1; }
    __syncthreads();
    int cur = __builtin_amdgcn_readfirstlane(QW[0]), nxt = __builtin_amdgcn_readfirstlane(QW[1]);
    int npull = (cur != CQ_NONE) + (nxt != CQ_NONE);
    __syncthreads();
    if (cur >= CQ_END) return;
    ConvDesc d; f32x4 v[16]; conv_decode(F, cur, d); conv_load(d, F.wave, F.lane, v);
    for (;;) {
        conv_to_lds(v, tile, F.wave, F.lane); LDS_WAIT(); __syncthreads();
        const bool more = nxt < CQ_END; ConvDesc dn = d;
        if (more) { conv_decode(F, nxt, dn); conv_load(dn, F.wave, F.lane, v); }
        const bool pull = more && (npull < quota || nxt < dlimit);
        conv_store(d, tile, F.tid);
        if (pull && F.tid == 0) QW[0] = conv_pull(F);
        LDS_WAIT(); __syncthreads();
        if (!more) break;
        cur = nxt; nxt = pull ? __builtin_amdgcn_readfirstlane(QW[0]) : CQ_NONE; npull += pull ? 1 : 0; d = dn;
    }
}
__device__ __forceinline__ int fill_quota(int nunits, int G, int c, int Q) { const int mine = nunits > c ? (nunits - 1 - c) / G + 1 : 0, most = (nunits + G - 1) / G; return mine < most ? Q : 0; }
__device__ __forceinline__ void p0_prologue(Frame& F) {
    const int gw = F.vcu * NWAVES + F.wave, NGW = F.G * NWAVES, gt = gw * 64 + F.lane, ngt = NGW * 64;
    for (int it = blockIdx.x; it < 256; it += F.G) mod_item(F, it);
    for (int it = blockIdx.x; it < S5G * 8; it += F.G) { s5_small_tables(F, it >> 3); s5_stage_a(F, it >> 3, it & 7); }
    { float* rp = (float*)(F.ws + WS_ROPE); for (int i = gt; i < 256 * 32; i += ngt) { const int pos = i >> 5, fi = i & 31; const float fr = powf(10000.f, -(float)fi / 32.f), ang = (float)pos * fr;
        rp[2 * i] = cosf(ang); rp[2 * i + 1] = sinf(ang); } }
    for (int g4 = 0; g4 < 4; ++g4) zero_rows((bf16*)(F.ws + WS_WPOOL) + ((size_t)g4 * 512 + 384) * 384, (size_t)128 * 384 * 2, gt, ngt);
    zero_rows((bf16*)(F.ws + WS_WINO) + (size_t)4624 * 2048, (size_t)(WINO_N - 4624) * 2048 * 2, gt, ngt);
    __syncthreads();
    conv_work(F, CQ_E4, 0);
    __syncthreads();
}

#define PV(k) ((LAS float*)(F.lds + (k) * 8192))
__device__ __forceinline__ void ld_row_f32(const float* p, int lane, f32x4 (&v)[8]) {
#pragma unroll
    for (int j = 0; j < 8; ++j) v[j] = *(const GAS f32x4*)(p + 4 * lane + 256 * j);
}
__device__ __forceinline__ void st_row_f32(float* p, int lane, const f32x4 (&v)[8]) {
#pragma unroll
    for (int j = 0; j < 8; ++j) *(GAS f32x4*)(p + 4 * lane + 256 * j) = v[j];
}
__device__ __forceinline__ void ld_row_bf16(const bf16* p, int lane, f32x4 (&v)[8]) {
#pragma unroll
    for (int j = 0; j < 8; ++j) { const v2u w = *(const GAS v2u*)(p + 4 * lane + 256 * j); v[j] = (f32x4){bflo(w.x), bfhi(w.x), bflo(w.y), bfhi(w.y)}; }
}
__device__ __forceinline__ void st_row_bf16(bf16* p, int lane, const f32x4 (&v)[8]) {
#pragma unroll
    for (int j = 0; j < 8; ++j) { v2u w; w.x = pk2(v[j][0], v[j][1]); w.y = pk2(v[j][2], v[j][3]); *(GAS v2u*)(p + 4 * lane + 256 * j) = w; }
}
__device__ __forceinline__ float row_sumsq(const f32x4 (&v)[8]) {
    float s = 0.f;
#pragma unroll
    for (int j = 0; j < 8; ++j) s += (v[j][0] * v[j][0] + v[j][1] * v[j][1]) + (v[j][2] * v[j][2] + v[j][3] * v[j][3]);
    return wave_sum(s);
}
__device__ __forceinline__ f32x4 ldp(const LAS float* p, int lane, int j) { return *(const LAS f32x4*)(p + 4 * lane + 256 * j); }
__device__ __forceinline__ const float* modp(Frame& F, int layer, int w, int k) { return (const float*)(F.ws + WS_MODF) + (size_t)(layer * 2 + w) * 12288 + k * 2048; }
__device__ __forceinline__ const float* h0_row(Frame& F, int m) { return m < CTX ? inp(I_CTX) + (size_t)m * D : inp(I_X) + (size_t)(m - CTX) * D; }

__device__ __forceinline__ void ph_norm0(Frame& F) {
    __syncthreads();
    for (int i = F.tid; i < 2 * 2048; i += NTHR) { const int w = i >> 11, c = i & 2047;
        PV(2 * w)[c] = inp(I_NORMS)[0 * 2048 + c] * (1.f + modp(F, 0, w, 1)[c]); PV(2 * w + 1)[c] = modp(F, 0, w, 0)[c]; }
    __syncthreads();
    bf16* U = (bf16*)(F.ws + WS_ARENA + A_U);
    const int gw = F.vcu * NWAVES + F.wave, NGW = F.G * NWAVES;
    for (int m = gw; m < T; m += NGW) { const int w = m < CTX ? 1 : 0; f32x4 v[8]; ld_row_f32(h0_row(F, m), F.lane, v);
        const float rstd = 1.f / sqrtf(row_sumsq(v) * (1.f / D) + EPS);
#pragma unroll
        for (int j = 0; j < 8; ++j) v[j] = v[j] * rstd * ldp(PV(2 * w), F.lane, j) + ldp(PV(2 * w + 1), F.lane, j);
        st_row_bf16(U + (size_t)m * D, F.lane, v); }
}
__device__ __forceinline__ void ph_norm1(Frame& F) {
    __syncthreads();
    for (int i = F.tid; i < 2 * 2048; i += NTHR) { const int w = i >> 11, c = i & 2047;
        PV(3 * w)[c] = modp(F, 0, w, 2)[c] * inp(I_NORMS)[1 * 2048 + c]; PV(3 * w + 1)[c] = inp(I_NORMS)[2 * 2048 + c] * (1.f + modp(F, 0, w, 4)[c]); PV(3 * w + 2)[c] = modp(F, 0, w, 3)[c]; }
    __syncthreads();
    const bf16* YO = (const bf16*)(F.ws + WS_ARENA + A_YO); bf16* V = (bf16*)(F.ws + WS_ARENA + A_V); bf16* HR = (bf16*)(F.ws + WS_HRES);
    const int gw = F.vcu * NWAVES + F.wave, NGW = F.G * NWAVES;
    for (int m = gw; m < T; m += NGW) { const int w = m < CTX ? 1 : 0; f32x4 y[8], h[8]; ld_row_bf16(YO + (size_t)m * D, F.lane, y); ld_row_f32(h0_row(F, m), F.lane, h);
        const float ry = 1.f / sqrtf(row_sumsq(y) * (1.f / D) + EPS);
#pragma unroll
        for (int j = 0; j < 8; ++j) h[j] = h[j] + y[j] * ry * ldp(PV(3 * w), F.lane, j);
        st_row_bf16(HR + (size_t)m * D, F.lane, h);
        const float rh = 1.f / sqrtf(row_sumsq(h) * (1.f / D) + EPS);
#pragma unroll
        for (int j = 0; j < 8; ++j) y[j] = h[j] * rh * ldp(PV(3 * w + 1), F.lane, j) + ldp(PV(3 * w + 2), F.lane, j);
#if FFN_FP8 == 1
        { unsigned char* V8 = (unsigned char*)V + (size_t)m * D;
#pragma unroll
          for (int j = 0; j < 8; ++j) *(GAS unsigned*)(V8 + 4 * F.lane + 256 * j) = pk4_fp8(y[j][0], y[j][1], y[j][2], y[j][3]); }
#else
        st_row_bf16(V + (size_t)m * D, F.lane, y);
#endif
    }
}
__device__ __forceinline__ void ph_norm2(Frame& F) {
    __syncthreads();
    for (int i = F.tid; i < 2 * 2048; i += NTHR) { const int w = i >> 11, c = i & 2047;
        PV(3 * w)[c] = modp(F, 0, w, 5)[c] * inp(I_NORMS)[3 * 2048 + c]; PV(3 * w + 1)[c] = inp(I_NORMS)[(4 + 0) * 2048 + c] * (1.f + modp(F, 1, w, 1)[c]); PV(3 * w + 2)[c] = modp(F, 1, w, 0)[c]; }
    __syncthreads();
    const bf16* FB = (const bf16*)(F.ws + WS_ARENA + A_F); bf16* U = (bf16*)(F.ws + WS_ARENA + A_U); bf16* HR = (bf16*)(F.ws + WS_HRES);
    const int gw = F.vcu * NWAVES + F.wave, NGW = F.G * NWAVES;
    for (int m = gw; m < T; m += NGW) { const int w = m < CTX ? 1 : 0; f32x4 y[8], h[8]; ld_row_bf16(FB + (size_t)m * D, F.lane, y); ld_row_bf16(HR + (size_t)m * D, F.lane, h);
        const float ry = 1.f / sqrtf(row_sumsq(y) * (1.f / D) + EPS);
#pragma unroll
        for (int j = 0; j < 8; ++j) h[j] = h[j] + y[j] * ry * ldp(PV(3 * w), F.lane, j);
        st_row_bf16(HR + (size_t)m * D, F.lane, h);
        const float rh = 1.f / sqrtf(row_sumsq(h) * (1.f / D) + EPS);
#pragma unroll
        for (int j = 0; j < 8; ++j) y[j] = h[j] * rh * ldp(PV(3 * w + 1), F.lane, j) + ldp(PV(3 * w + 2), F.lane, j);
        st_row_bf16(U + (size_t)m * D, F.lane, y); }
}
__device__ __forceinline__ void ph_emit(Frame& F, float* out) {
    const bf16* HR = (const bf16*)(F.ws + WS_HRES) + (size_t)CTX * D;
    for (size_t i = (size_t)blockIdx.x * NTHR + F.tid; i < (size_t)SEQ * D / 4; i += (size_t)F.G * NTHR) { const v2u w = ((const GAS v2u*)HR)[i]; ((GAS f32x4*)out)[i] = (f32x4){bflo(w.x), bfhi(w.x), bflo(w.y), bfhi(w.y)}; }
}

__device__ __forceinline__ void ph_pooldiff(Frame& F) {
    const bf16* ZP = (const bf16*)(F.ws + WS_ARENA + A_ZP); bf16* DP = (bf16*)(F.ws + WS_ARENA + A_DP);
    const size_t nitem = (size_t)T * (WPOOL / 8);
    for (size_t it = (size_t)F.vcu * NTHR + F.tid; it < nitem; it += (size_t)F.G * NTHR) {
        const int t = (int)(it / (WPOOL / 8)), c8 = (int)(it % (WPOOL / 8)) * 8, gi = c8 / PG, w = 2 << gi;
        const int s0 = t < CTX ? 0 : CTX, L = t < CTX ? CTX : SEQ, tp = t - s0;
        int lo = tp - w / 2; lo = lo < 0 ? 0 : lo; int hi = tp + (w - w / 2); hi = hi > L ? L : hi;
        float s[8];
#pragma unroll
        for (int q = 0; q < 8; ++q) s[q] = 0.f;
        for (int r = lo; r < hi; ++r) { const v4u x = *(const GAS v4u*)(ZP + (size_t)(s0 + r) * WPOOL + c8);
            s[0] += bflo(x.x); s[1] += bfhi(x.x); s[2] += bflo(x.y); s[3] += bfhi(x.y); s[4] += bflo(x.z); s[5] += bfhi(x.z); s[6] += bflo(x.w); s[7] += bfhi(x.w); }
        const float inv = 1.f / (float)(hi - lo); const v4u z = *(const GAS v4u*)(ZP + (size_t)t * WPOOL + c8);
        v4u o; o.x = pk2(s[0] * inv - bflo(z.x), s[1] * inv - bfhi(z.x)); o.y = pk2(s[2] * inv - bflo(z.y), s[3] * inv - bfhi(z.y));
        o.z = pk2(s[4] * inv - bflo(z.z), s[5] * inv - bfhi(z.z)); o.w = pk2(s[6] * inv - bflo(z.w), s[7] * inv - bfhi(z.w));
        *(GAS v4u*)(DP + (size_t)t * WPOOL + c8) = o;
    }
}

__device__ __forceinline__ void ph_s5scan(Frame& F) {
    const int gth = blockIdx.x * NTHR + F.tid; if (gth >= S5G * 2 * 64) return;
    const int g = gth >> 7, dir = (gth >> 6) & 1, p = gth & 63, gi = dir * S5G + g;
    const double dt = exp((double)inp(I_LOGDT)[gi]), lr = (double)inp(I_LAMRE)[gi * 64 + p], li = (double)inp(I_LAMIM)[gi * 64 + p];
    const float aLr = (float)(exp(lr * dt * LC) * cos(li * dt * LC)), aLi = (float)(exp(lr * dt * LC) * sin(li * dt * LC));
    const float* SL = (const float*)(F.ws + WS_ARENA + A_SLOC) + (size_t)g * S5ROWS * 256 + dir * 128 + p;
    bf16* CA = (bf16*)(F.ws + WS_ARENA + A_AS5) + (size_t)g * S5ROWS * S5K + 1024 + dir * 128 + p;
    float er = 0.f, ei = 0.f;
    for (int i0 = 0; i0 < NCH; i0 += 4) {
        int cc[4]; float sr[4], si[4];
#pragma unroll
        for (int q = 0; q < 4; ++q) { const int i = i0 + q; cc[q] = dir == 0 ? i : (i < NCH_CTX ? NCH_CTX - 1 - i : NCH - 1 - (i - NCH_CTX));
            sr[q] = SL[(size_t)cc[q] * 256]; si[q] = SL[(size_t)cc[q] * 256 + 64]; }
#pragma unroll
        for (int q = 0; q < 4; ++q) { CA[(size_t)cc[q] * S5K] = (bf16)f2bf(er); CA[(size_t)cc[q] * S5K + 64] = (bf16)f2bf(ei);
            const float nr = aLr * er - aLi * ei + sr[q], ni = aLr * ei + aLi * er + si[q]; er = nr; ei = ni; }
    }
}

typedef unsigned u32x4 __attribute__((ext_vector_type(4)));
using pg8::Unit; using pg8::pack8;
typedef const pg8::f32x4 (&AccRef)[2][2][4][2];
#define EPI_ROWS(u) const int row0 = (u).pm * 256 + wr * 64 + fr
struct EpiPlain { static constexpr bool PERM = true; bf16* O; int ldc;
    __device__ __forceinline__ void operator()(AccRef acc, const Unit& u, int wr, int wc, int fr, int fq) const { EPI_ROWS(u); const int col0 = u.pn * 256 + wc * 32 + 8 * fq;
#pragma unroll
        for (int ai = 0; ai < 2; ++ai)
#pragma unroll
            for (int m = 0; m < 4; ++m) { bf16* rp = O + (size_t)(row0 + ai * 128 + m * 16) * ldc + col0;
#pragma unroll
                for (int bj = 0; bj < 2; ++bj) *(GAS u32x4*)(rp + bj * 128) = pack8(acc[ai][bj][m][0], acc[ai][bj][m][1]); } } };
struct EpiWinE { static constexpr bool PERM = true; bf16* ZP; bf16* AS5;
    __device__ __forceinline__ void operator()(AccRef acc, const Unit& u, int wr, int wc, int fr, int fq) const { EPI_ROWS(u); const int col0 = u.pn * 256 + wc * 32 + 8 * fq;
#pragma unroll
        for (int ai = 0; ai < 2; ++ai)
#pragma unroll
            for (int m = 0; m < 4; ++m) { const int row = row0 + ai * 128 + m * 16;
#pragma unroll
                for (int bj = 0; bj < 2; ++bj) { const int col = col0 + bj * 128; const u32x4 w = pack8(acc[ai][bj][m][0], acc[ai][bj][m][1]);
                    if (u.pn < 6) *(GAS u32x4*)(ZP + (size_t)row * WPOOL + col) = w;
                    else { const int cc = col - WPOOL, g = cc >> 4, n0 = cc & 15, c = row >> 6, s = row & 63; *(GAS u32x4*)(AS5 + ((size_t)(g * S5ROWS + c) * S5K + s * 16 + n0)) = w; } } } } };
struct EpiPool { static constexpr bool PERM = true; bf16* YMIX; const float* scale;
    __device__ __forceinline__ void operator()(AccRef acc, const Unit& u, int wr, int wc, int fr, int fq) const { EPI_ROWS(u); const int lc0 = u.pn * 256 + wc * 32 + 8 * fq;
#pragma unroll
        for (int bj = 0; bj < 2; ++bj) { const int lc = lc0 + bj * 128; if (lc >= PG) continue; const int gc = u.bz * PG + lc;
            const f32x4 s0 = *(const GAS f32x4*)(scale + gc), s1 = *(const GAS f32x4*)(scale + gc + 4);
#pragma unroll
            for (int ai = 0; ai < 2; ++ai)
#pragma unroll
                for (int m = 0; m < 4; ++m) { const int row = row0 + ai * 128 + m * 16; *(GAS u32x4*)(YMIX + (size_t)row * D + gc) = pack8(acc[ai][bj][m][0] * s0, acc[ai][bj][m][1] * s1); } } } };
struct EpiSloc { static constexpr bool PERM = false; float* SL;
    __device__ __forceinline__ void operator()(AccRef acc, const Unit& u, int wr, int wc, int fr, int fq) const { EPI_ROWS(u); const int col0 = u.pn * 256 + wc * 32 + 4 * fq;
#pragma unroll
        for (int ai = 0; ai < 2; ++ai)
#pragma unroll
            for (int m = 0; m < 4; ++m) { float* rp = SL + ((size_t)u.bz * S5ROWS + row0 + ai * 128 + m * 16) * 256 + col0;
#pragma unroll
                for (int bj = 0; bj < 2; ++bj)
#pragma unroll
                    for (int n = 0; n < 2; ++n) *(GAS f32x4*)(rp + bj * 128 + n * 16) = acc[ai][bj][m][n]; } } };
struct EpiS5Y { static constexpr bool PERM = true; const bf16* AS5; const float* dsk; bf16* YG;
    __device__ __forceinline__ void operator()(AccRef acc, const Unit& u, int wr, int wc, int fr, int fq) const { EPI_ROWS(u); const int col0 = u.pn * 256 + wc * 32 + 8 * fq;
#pragma unroll
        for (int bj = 0; bj < 2; ++bj) { const int col = col0 + bj * 128, tau = col >> 4, n0 = col & 15;
            const f32x4 d0 = *(const GAS f32x4*)(dsk + u.bz * 16 + n0), d1 = *(const GAS f32x4*)(dsk + u.bz * 16 + n0 + 4);
#pragma unroll
            for (int ai = 0; ai < 2; ++ai)
#pragma unroll
                for (int m = 0; m < 4; ++m) { const int c = row0 + ai * 128 + m * 16; if (c >= NCH) continue;
                    const v4u x = *(const GAS v4u*)(AS5 + ((size_t)(u.bz * S5ROWS + c) * S5K + col));
                    f32x4 a = acc[ai][bj][m][0], b = acc[ai][bj][m][1];
                    a[0] = gelu_tanh(a[0] + bflo(x.x) * d0[0]); a[1] = gelu_tanh(a[1] + bfhi(x.x) * d0[1]); a[2] = gelu_tanh(a[2] + bflo(x.y) * d0[2]); a[3] = gelu_tanh(a[3] + bfhi(x.y) * d0[3]);
                    b[0] = gelu_tanh(b[0] + bflo(x.z) * d1[0]); b[1] = gelu_tanh(b[1] + bfhi(x.z) * d1[1]); b[2] = gelu_tanh(b[2] + bflo(x.w) * d1[2]); b[3] = gelu_tanh(b[3] + bfhi(x.w) * d1[3]);
                    *(GAS u32x4*)(YG + ((size_t)(c * 64 + tau) * WS5 + u.bz * 16 + n0)) = pack8(a, b); } } } };
struct EpiGlu { static constexpr bool PERM = true; const bf16* YG; bf16* YMIX;
    __device__ __forceinline__ void operator()(AccRef acc, const Unit& u, int wr, int wc, int fr, int fq) const { EPI_ROWS(u); const int col0 = u.pn * 256 + wc * 32 + 8 * fq;
#pragma unroll
        for (int ai = 0; ai < 2; ++ai)
#pragma unroll
            for (int m = 0; m < 4; ++m) { const int row = row0 + ai * 128 + m * 16;
#pragma unroll
                for (int bj = 0; bj < 2; ++bj) { const int col = col0 + bj * 128; const v4u x = *(const GAS v4u*)(YG + (size_t)row * WS5 + col);
                    f32x4 a = acc[ai][bj][m][0], b = acc[ai][bj][m][1];
                    a[0] = bflo(x.x) * sigmoidf_(a[0]); a[1] = bfhi(x.x) * sigmoidf_(a[1]); a[2] = bflo(x.y) * sigmoidf_(a[2]); a[3] = bfhi(x.y) * sigmoidf_(a[3]);
                    b[0] = bflo(x.z) * sigmoidf_(b[0]); b[1] = bfhi(x.z) * sigmoidf_(b[1]); b[2] = bflo(x.w) * sigmoidf_(b[2]); b[3] = bfhi(x.w) * sigmoidf_(b[3]);
                    *(GAS u32x4*)(YMIX + (size_t)row * D + WPOOL + col) = pack8(a, b); } } } };
struct EpiGateUp { static constexpr bool PERM = true; bf16* HID; int ldc;
    __device__ __forceinline__ void operator()(AccRef acc, const Unit& u, int wr, int wc, int fr, int fq) const { EPI_ROWS(u); const int col0 = u.pn * 128 + wc * 32 + 8 * fq;
#pragma unroll
        for (int ai = 0; ai < 2; ++ai)
#pragma unroll
            for (int m = 0; m < 4; ++m) { const int row = row0 + ai * 128 + m * 16; f32x4 a, b;
#pragma unroll
                for (int q = 0; q < 4; ++q) { a[q] = swiglu_fast(acc[ai][0][m][0][q], acc[ai][1][m][0][q], -1.4426950408889634f, 1.f); b[q] = swiglu_fast(acc[ai][0][m][1][q], acc[ai][1][m][1][q], -1.4426950408889634f, 1.f); }
                *(GAS u32x4*)(HID + (size_t)row * ldc + col0) = pack8(a, b); } } };

struct EpiWinO { static constexpr bool PERM = true; unsigned char* ar;
    __device__ __forceinline__ void operator()(AccRef acc, const Unit& u, int wr, int wc, int fr, int fq) const { EPI_ROWS(u); const int pn = u.pn;
        if (pn == 18) { if (wc == 0 && fq < 2) { float* ALR = (float*)(ar + B_ALR);
#pragma unroll
                for (int ai = 0; ai < 2; ++ai)
#pragma unroll
                    for (int m = 0; m < 4; ++m) { float* rp = ALR + (size_t)(row0 + ai * 128 + m * 16) * 16 + 8 * fq; *(GAS f32x4*)rp = acc[ai][0][m][0]; *(GAS f32x4*)(rp + 4) = acc[ai][0][m][1]; } }
            return; }
        bf16* base; int ld, c0;
        if (pn < 2) { base = (bf16*)(ar + B_GQ); ld = 512; c0 = pn * 256; } else if (pn < 4) { base = (bf16*)(ar + B_GK); ld = 512; c0 = (pn - 2) * 256; }
        else if (pn < 8) { base = (bf16*)(ar + B_GV); ld = 1024; c0 = (pn - 4) * 256; } else if (pn < 12) { base = (bf16*)(ar + B_R); ld = 1024; c0 = (pn - 8) * 256; }
        else if (pn < 16) { base = (bf16*)(ar + B_AQ); ld = 1024; c0 = (pn - 12) * 256; } else if (pn == 16) { base = (bf16*)(ar + B_AK); ld = 256; c0 = 0; } else { base = (bf16*)(ar + B_AV); ld = 256; c0 = 0; }
        const int col0 = c0 + wc * 32 + 8 * fq;
#pragma unroll
        for (int ai = 0; ai < 2; ++ai)
#pragma unroll
            for (int m = 0; m < 4; ++m) { bf16* rp = base + (size_t)(row0 + ai * 128 + m * 16) * ld + col0;
#pragma unroll
                for (int bj = 0; bj < 2; ++bj) *(GAS u32x4*)(rp + bj * 128) = pack8(acc[ai][bj][m][0], acc[ai][bj][m][1]); } } };

__device__ __forceinline__ void ph_qknorm(Frame& F) {
    unsigned char* ar = F.ws + WS_ARENA; bf16* AQ = (bf16*)(ar + B_AQ); bf16* AK = (bf16*)(ar + B_AK);
    const float* qn = inp(I_QNORM); const float* kn = inp(I_KNORM); const f32x2* rope = (const f32x2*)(F.ws + WS_ROPE);
    const size_t NQ = (size_t)SEQ * 8 * 8, NK = (size_t)T * 2 * 8;
    for (size_t it = (size_t)F.vcu * NTHR + F.tid; it < NQ + NK; it += (size_t)F.G * NTHR) {
        const bool isq = it < NQ; const size_t r = isq ? it : it - NQ; const int j = (int)(r & 7), hf = j >> 2, sub = j & 3;
        int row, head; bf16* p; const float* nw;
        if (isq) { head = (int)((r >> 3) & 7); row = CTX + (int)(r >> 6); p = AQ + (size_t)row * 1024 + head * 128; nw = qn; }
        else { head = (int)((r >> 3) & 1); row = (int)(r >> 4); p = AK + (size_t)row * 256 + head * 128; nw = kn; }
        const int d1 = 64 * hf + 8 * sub, d2 = d1 + 32;
        const v4u a = *(const GAS v4u*)(p + d1), b = *(const GAS v4u*)(p + d2);
        float x1[8] = {bflo(a.x), bfhi(a.x), bflo(a.y), bfhi(a.y), bflo(a.z), bfhi(a.z), bflo(a.w), bfhi(a.w)};
        float x2[8] = {bflo(b.x), bfhi(b.x), bflo(b.y), bfhi(b.y), bflo(b.z), bfhi(b.z), bflo(b.w), bfhi(b.w)};
        float ss = 0.f;
#pragma unroll
        for (int e = 0; e < 8; ++e) ss += x1[e] * x1[e] + x2[e] * x2[e];
        ss += __shfl_xor(ss, 1); ss += __shfl_xor(ss, 2); ss += __shfl_xor(ss, 4);
        const float rstd = 1.f / sqrtf(ss * (1.f / 128.f) + EPS);
        const bool rot = row >= CTX; const int tl = row - CTX, pos = hf ? (tl & 63) : (tl >> 6);
        float o1[8], o2[8];
#pragma unroll
        for (int e = 0; e < 8; ++e) { const float y1 = x1[e] * rstd * nw[d1 + e], y2 = x2[e] * rstd * nw[d2 + e];
            f32x2 cs = {1.f, 0.f}; if (rot) cs = rope[pos * 32 + 8 * sub + e];
            o1[e] = y1 * cs.x - y2 * cs.y; o2[e] = y1 * cs.y + y2 * cs.x; }
        v4u w1, w2; w1.x = pk2(o1[0], o1[1]); w1.y = pk2(o1[2], o1[3]); w1.z = pk2(o1[4], o1[5]); w1.w = pk2(o1[6], o1[7]);
        w2.x = pk2(o2[0], o2[1]); w2.y = pk2(o2[2], o2[3]); w2.z = pk2(o2[4], o2[5]); w2.w = pk2(o2[6], o2[7]);
        *(GAS v4u*)(p + d1) = w1; *(GAS v4u*)(p + d2) = w2;
        if (!isq) {
            unsigned char* k8 = ar + B_KDT + (size_t)row * 256 + head * 128 + 64 * (sub & 1) + 8 * (4 * hf + (sub >> 1));
            v2u a8, b8; a8.x = pk4_fp8(o1[0], o1[1], o1[2], o1[3]); a8.y = pk4_fp8(o1[4], o1[5], o1[6], o1[7]); b8.x = pk4_fp8(o2[0], o2[1], o2[2], o2[3]); b8.y = pk4_fp8(o2[4], o2[5], o2[6], o2[7]);
            *(GAS v2u*)k8 = a8; *(GAS v2u*)(k8 + 16) = b8; }
    }
}

constexpr size_t VT8_OFF = 8 * MiB;
__device__ __forceinline__ void ph_vt8(Frame& F) {
    unsigned char* ar = F.ws + WS_ARENA; const bf16* AV = (const bf16*)(ar + B_AV); unsigned char* VT8 = ar + B_KDT + VT8_OFF;
    const int ntask = 2 * NCH * 128 * 4;
    for (int it = F.vcu * NTHR + F.tid; it < ntask; it += F.G * NTHR) {
        const int g = it & 3, d = (it >> 2) & 127, tl = (it >> 9) % NCH, kvh = (it >> 9) / NCH, hi = g >> 1, blk = g & 1;
        float x[16];
#pragma unroll
        for (int r = 0; r < 16; ++r) { const int key = 32 * blk + (r & 3) + 8 * (r >> 2) + 4 * hi; x[r] = bf2f(AV[(size_t)(tl * 64 + key) * 256 + kvh * 128 + d]); }
        v4u o; o.x = pk4_fp8(x[0], x[1], x[2], x[3]); o.y = pk4_fp8(x[4], x[5], x[6], x[7]); o.z = pk4_fp8(x[8], x[9], x[10], x[11]); o.w = pk4_fp8(x[12], x[13], x[14], x[15]);
        *(GAS v4u*)(VT8 + ((size_t)(kvh * NCH + tl) * 128 + d) * 64 + g * 16) = o;
    }
}

namespace tri {
using s16x4 = __attribute__((ext_vector_type(4))) short;
__device__ __forceinline__ int st(int k, int c) { const int kk = (k & ~0xC) | ((k & 4) << 1) | ((k & 8) >> 1); return ((kk >> 3) * 4 + (c >> 5)) * 512 + ((kk & 7) * 32 + (c & 31)) * 2; }
__device__ __forceinline__ int rd_base(int lane) { return ((lane & 3) << 3) | (((lane >> 2) & 3) << 6) | (((lane >> 4) & 1) << 5) | (((lane >> 5) & 1) << 8); }
constexpr int rd_off(int d0, int ks, int half) { return d0 * 512 + ks * 4096 + half * 2048; }
template <int OFF> __device__ __forceinline__ s16x4 tr_read(int vb) { s16x4 r; asm volatile("ds_read_b64_tr_b16 %0, %1 offset:%2" : "=&v"(r) : "v"(vb), "i"(OFF) : "memory"); return r; }
struct Frag2 { s16x4 lo, hi; };
template <int D0, int KS> __device__ __forceinline__ Frag2 ld(int vb) { Frag2 f; f.lo = tr_read<rd_off(D0, KS, 0)>(vb); f.hi = tr_read<rd_off(D0, KS, 1)>(vb); return f; }
__device__ __forceinline__ bf16x8 pk(const Frag2& f) { return (bf16x8){f.lo[0], f.lo[1], f.lo[2], f.lo[3], f.hi[0], f.hi[1], f.hi[2], f.hi[3]}; }
#define TRI_WAIT() do { asm volatile("s_waitcnt lgkmcnt(0)" ::: "memory"); __builtin_amdgcn_sched_barrier(0); } while (0)
}
typedef float f32x16 __attribute__((ext_vector_type(16)));
__device__ __forceinline__ int crow(int r, int hi) { return (r & 3) + 8 * (r >> 2) + 4 * hi; }

__device__ __forceinline__ float logsigmoidf_(float z) { return fminf(z, 0.f) - __logf(1.f + __expf(-fabsf(z))); }
__device__ __forceinline__ void gla_prepkv_unit(Frame& F, int c, int h) {
    unsigned char* ar = F.ws + WS_ARENA;
    const bf16* GQ = (const bf16*)(ar + B_GQ); const bf16* GK = (const bf16*)(ar + B_GK); const bf16* GV = (const bf16*)(ar + B_GV); const float* ALR = (const float*)(ar + B_ALR);
    LAS float* ALR_S = (LAS float*)(F.lds);
    LAS float* WA_S = (LAS float*)(F.lds + 4096);
    LAS float* BA_S = (LAS float*)(F.lds + 12288);
    LAS float* SEG_S = (LAS float*)(F.lds + 12800);
    LAS float* GB = (LAS float*)(F.lds + 14848);
    LAS unsigned char* QS = F.lds + 47616;
    LAS unsigned char* KS = F.lds + 64000;
    LAS unsigned char* VIMG = F.lds + 80384;
    LAS unsigned char* KIMG = F.lds + 113152;
    const int tid = F.tid, lane = F.lane, t0 = c * 64;
    __syncthreads();
    for (int i = tid; i < 1024; i += NTHR) ALR_S[i] = ALR[(size_t)t0 * 16 + i];
    for (int i = tid; i < 1024; i += NTHR) { const int r = i >> 4, k8 = (i & 15) * 8;
        *(LAS v4u*)(QS + (r * 128 + k8) * 2) = *(const GAS v4u*)(GQ + (size_t)(t0 + r) * 512 + h * 128 + k8); *(LAS v4u*)(KS + (r * 128 + k8) * 2) = *(const GAS v4u*)(GK + (size_t)(t0 + r) * 512 + h * 128 + k8); }
    for (int i = tid; i < 2048; i += NTHR) { const int r = i >> 5, v8 = (i & 31) * 8;
        *(LAS v4u*)(VIMG + (v8 >> 7) * 16384 + tri::st(r, v8 & 127)) = *(const GAS v4u*)(GV + (size_t)(t0 + r) * 1024 + h * 256 + v8); }
    for (int d = 0; d < 2; ++d) {
        const float* wa = inp(I_GLAWA) + (size_t)d * 16 * 512 + h * 128; const float* ba = inp(I_GLABA) + d * 512 + h * 128;
        __syncthreads();
        for (int i = tid; i < 2048; i += NTHR) WA_S[i] = wa[(size_t)(i >> 7) * 512 + (i & 127)];
        if (tid < 128) BA_S[tid] = ba[tid];
        __syncthreads();
        const int k = tid & 127, seg = tid >> 7;
        float gl[16];
        { float w[16];
#pragma unroll
          for (int r = 0; r < 16; ++r) w[r] = WA_S[r * 128 + k];
          const float b0 = BA_S[k];
#pragma unroll
          for (int ii = 0; ii < 16; ++ii) { const int i = seg * 16 + ii; float z = b0;
#pragma unroll
              for (int r = 0; r < 16; ++r) z += ALR_S[i * 16 + r] * w[r];
              gl[ii] = logsigmoidf_(z) * (1.f / 16.f); } }
        if (d == 0) {
#pragma unroll
            for (int ii = 1; ii < 16; ++ii) gl[ii] += gl[ii - 1];
            SEG_S[seg * 128 + k] = gl[15]; }
        else {
#pragma unroll
            for (int ii = 14; ii >= 0; --ii) gl[ii] += gl[ii + 1];
            SEG_S[seg * 128 + k] = gl[0]; }
        __syncthreads();
        const float s0 = SEG_S[k], s1 = SEG_S[128 + k], s2 = SEG_S[256 + k], s3 = SEG_S[384 + k], tot = (s0 + s1) + (s2 + s3);
        float off;
        if (d == 0) off = seg == 0 ? 0.f : (seg == 1 ? s0 : (seg == 2 ? s0 + s1 : s0 + s1 + s2));
        else off = seg == 3 ? 0.f : (seg == 2 ? s3 : (seg == 1 ? s3 + s2 : s3 + s2 + s1));
#pragma unroll
        for (int ii = 0; ii < 16; ++ii) GB[(seg * 16 + ii) * 128 + k] = gl[ii] + off;
        if (seg == 0) ((float*)(ar + B_DEC))[((size_t)(d * NCH + c) * 4 + h) * 128 + k] = __expf(tot);
        __syncthreads();
        { bf16* QE = (bf16*)(ar + B_QE) + (size_t)d * T * 512; bf16* KE = (bf16*)(ar + B_KE) + (size_t)d * T * 512;
          for (int i2 = tid; i2 < 1024; i2 += NTHR) { const int i = i2 >> 4, k8 = (i2 & 15) * 8; const v4u qw = *(const LAS v4u*)(QS + (i * 128 + k8) * 2), kw = *(const LAS v4u*)(KS + (i * 128 + k8) * 2);
              const f32x4 ba0 = *(const LAS f32x4*)(GB + i * 128 + k8), ba1 = *(const LAS f32x4*)(GB + i * 128 + k8 + 4);
              const f32x4 t0v = *(const LAS f32x4*)(SEG_S + k8), t1v = *(const LAS f32x4*)(SEG_S + 128 + k8), t2v = *(const LAS f32x4*)(SEG_S + 256 + k8), t3v = *(const LAS f32x4*)(SEG_S + 384 + k8);
              const f32x4 u0v = *(const LAS f32x4*)(SEG_S + k8 + 4), u1v = *(const LAS f32x4*)(SEG_S + 128 + k8 + 4), u2v = *(const LAS f32x4*)(SEG_S + 256 + k8 + 4), u3v = *(const LAS f32x4*)(SEG_S + 384 + k8 + 4);
              const f32x4 tt0 = (t0v + t1v) + (t2v + t3v), tt1 = (u0v + u1v) + (u2v + u3v);
              const float b[8] = {ba0[0], ba0[1], ba0[2], ba0[3], ba1[0], ba1[1], ba1[2], ba1[3]}; const float tt[8] = {tt0[0], tt0[1], tt0[2], tt0[3], tt1[0], tt1[1], tt1[2], tt1[3]};
              const unsigned qv[4] = {qw.x, qw.y, qw.z, qw.w}, kv[4] = {kw.x, kw.y, kw.z, kw.w}; float qe[8], ke[8], kd[8];
#pragma unroll
              for (int e = 0; e < 4; ++e) { const float q0 = bflo(qv[e]), q1 = bfhi(qv[e]), k0 = bflo(kv[e]), k1 = bfhi(kv[e]); const float e0 = __expf(b[2 * e]), e1 = __expf(b[2 * e + 1]);
                  const float r0 = __builtin_amdgcn_rcpf(e0), r1 = __builtin_amdgcn_rcpf(e1);
                  qe[2 * e] = q0 * 0.08838834764831845f * e0; qe[2 * e + 1] = q1 * 0.08838834764831845f * e1; ke[2 * e] = k0 * r0; ke[2 * e + 1] = k1 * r1;
                  kd[2 * e] = k0 * __expf(tt[2 * e] - b[2 * e]); kd[2 * e + 1] = k1 * __expf(tt[2 * e + 1] - b[2 * e + 1]); }
              v4u wq, wk, wd; wq.x = pk2(qe[0], qe[1]); wq.y = pk2(qe[2], qe[3]); wq.z = pk2(qe[4], qe[5]); wq.w = pk2(qe[6], qe[7]);
              wk.x = pk2(ke[0], ke[1]); wk.y = pk2(ke[2], ke[3]); wk.z = pk2(ke[4], ke[5]); wk.w = pk2(ke[6], ke[7]);
              wd.x = pk2(kd[0], kd[1]); wd.y = pk2(kd[2], kd[3]); wd.z = pk2(kd[4], kd[5]); wd.w = pk2(kd[6], kd[7]);
              *(GAS v4u*)(QE + (size_t)(t0 + i) * 512 + h * 128 + k8) = wq; *(GAS v4u*)(KE + (size_t)(t0 + i) * 512 + h * 128 + k8) = wk;
              *(LAS v4u*)(KIMG + tri::st(i, k8)) = wd; } }
        __syncthreads();
        {
            const int w = F.wave, r = lane & 31, hi = lane >> 5;
            const int kb_base = (int)(uintptr_t)KIMG + tri::rd_base(lane), vb_base = (int)(uintptr_t)VIMG + (w >> 2) * 16384 + (w & 3) * 512 + tri::rd_base(lane);
            const tri::Frag2 b0 = tri::ld<0, 0>(vb_base), b1 = tri::ld<0, 1>(vb_base), b2 = tri::ld<0, 2>(vb_base), b3 = tri::ld<0, 3>(vb_base);
            const tri::Frag2 a00 = tri::ld<0, 0>(kb_base), a01 = tri::ld<0, 1>(kb_base), a02 = tri::ld<0, 2>(kb_base), a03 = tri::ld<0, 3>(kb_base);
            const tri::Frag2 a10 = tri::ld<1, 0>(kb_base), a11 = tri::ld<1, 1>(kb_base), a12 = tri::ld<1, 2>(kb_base), a13 = tri::ld<1, 3>(kb_base);
            const tri::Frag2 a20 = tri::ld<2, 0>(kb_base), a21 = tri::ld<2, 1>(kb_base), a22 = tri::ld<2, 2>(kb_base), a23 = tri::ld<2, 3>(kb_base);
            const tri::Frag2 a30 = tri::ld<3, 0>(kb_base), a31 = tri::ld<3, 1>(kb_base), a32 = tri::ld<3, 2>(kb_base), a33 = tri::ld<3, 3>(kb_base);
            TRI_WAIT();
            const bf16x8 B0 = tri::pk(b0), B1 = tri::pk(b1), B2 = tri::pk(b2), B3 = tri::pk(b3);
            f32x16 acc[4] = {};
            acc[0] = __builtin_amdgcn_mfma_f32_32x32x16_bf16(tri::pk(a00), B0, acc[0], 0, 0, 0); acc[0] = __builtin_amdgcn_mfma_f32_32x32x16_bf16(tri::pk(a01), B1, acc[0], 0, 0, 0);
            acc[0] = __builtin_amdgcn_mfma_f32_32x32x16_bf16(tri::pk(a02), B2, acc[0], 0, 0, 0); acc[0] = __builtin_amdgcn_mfma_f32_32x32x16_bf16(tri::pk(a03), B3, acc[0], 0, 0, 0);
            acc[1] = __builtin_amdgcn_mfma_f32_32x32x16_bf16(tri::pk(a10), B0, acc[1], 0, 0, 0); acc[1] = __builtin_amdgcn_mfma_f32_32x32x16_bf16(tri::pk(a11), B1, acc[1], 0, 0, 0);
            acc[1] = __builtin_amdgcn_mfma_f32_32x32x16_bf16(tri::pk(a12), B2, acc[1], 0, 0, 0); acc[1] = __builtin_amdgcn_mfma_f32_32x32x16_bf16(tri::pk(a13), B3, acc[1], 0, 0, 0);
            acc[2] = __builtin_amdgcn_mfma_f32_32x32x16_bf16(tri::pk(a20), B0, acc[2], 0, 0, 0); acc[2] = __builtin_amdgcn_mfma_f32_32x32x16_bf16(tri::pk(a21), B1, acc[2], 0, 0, 0);
            acc[2] = __builtin_amdgcn_mfma_f32_32x32x16_bf16(tri::pk(a22), B2, acc[2], 0, 0, 0); acc[2] = __builtin_amdgcn_mfma_f32_32x32x16_bf16(tri::pk(a23), B3, acc[2], 0, 0, 0);
            acc[3] = __builtin_amdgcn_mfma_f32_32x32x16_bf16(tri::pk(a30), B0, acc[3], 0, 0, 0); acc[3] = __builtin_amdgcn_mfma_f32_32x32x16_bf16(tri::pk(a31), B1, acc[3], 0, 0, 0);
            acc[3] = __builtin_amdgcn_mfma_f32_32x32x16_bf16(tri::pk(a32), B2, acc[3], 0, 0, 0); acc[3] = __builtin_amdgcn_mfma_f32_32x32x16_bf16(tri::pk(a33), B3, acc[3], 0, 0, 0);
            bf16* ST = (bf16*)(ar + B_ST) + ((size_t)(d * NCH + c) * 4 + h) * 256 * 128;
#pragma unroll
            for (int kb = 0; kb < 4; ++kb)
#pragma unroll
                for (int q4 = 0; q4 < 4; ++q4) { v2u o; o.x = pk2(acc[kb][4 * q4], acc[kb][4 * q4 + 1]); o.y = pk2(acc[kb][4 * q4 + 2], acc[kb][4 * q4 + 3]);
                    *(GAS v2u*)(ST + (size_t)(32 * w + r) * 128 + 32 * kb + 8 * q4 + 4 * hi) = o; }
        }
    }
}

__device__ __forceinline__ void ph_gla_scan(Frame& F) {
    unsigned char* ar = F.ws + WS_ARENA; const float* DEC = (const float*)(ar + B_DEC);
    for (int gth = blockIdx.x * NTHR + F.tid; gth < 2 * 4 * 256 * 64; gth += F.G * NTHR) {
        const int kp = gth & 63, v = (gth >> 6) & 255, h = (gth >> 14) & 3, d = gth >> 16;
        unsigned* ST = (unsigned*)(ar + B_ST) + ((((size_t)d * NCH) * 4 + h) * 256 + v) * 64 + kp;
        const f32x2* DC = (const f32x2*)DEC + (((size_t)d * NCH) * 4 + h) * 64 + kp;
        float s0 = 0.f, s1 = 0.f;
        for (int i0 = 0; i0 < NCH; i0 += 4) { int cc[4]; unsigned kv[4]; f32x2 dc[4];
#pragma unroll
            for (int q = 0; q < 4; ++q) { const int i = i0 + q; cc[q] = d == 0 ? i : (i < NCH_CTX ? NCH_CTX - 1 - i : NCH - 1 - (i - NCH_CTX));
                kv[q] = ST[(size_t)cc[q] * (4 * 256 * 64)]; dc[q] = DC[(size_t)cc[q] * (4 * 64)]; }
#pragma unroll
            for (int q = 0; q < 4; ++q) { ST[(size_t)cc[q] * (4 * 256 * 64)] = pk2(s0, s1); s0 = dc[q].x * s0 + bflo(kv[q]); s1 = dc[q].y * s1 + bfhi(kv[q]); } }
    }
}

__device__ __forceinline__ void gla_out_unit(Frame& F, int cl, int h) {
    unsigned char* ar = F.ws + WS_ARENA; const int c = cl + NCH_CTX, t0 = c * 64;
    LAS unsigned char* ATT = F.lds;
    LAS float* OS = (LAS float*)(F.lds + 18432);
    LAS unsigned char* VIMG = F.lds + 86016;
    const int lane = F.lane, r = lane & 31, hi = lane >> 5, w = F.wave;
    __syncthreads();
    { const bf16* GV = (const bf16*)(ar + B_GV);
      for (int i = F.tid; i < 2048; i += NTHR) { const int rr = i >> 5, v8 = (i & 31) * 8;
          *(LAS v4u*)(VIMG + (v8 >> 7) * 16384 + tri::st(rr, v8 & 127)) = *(const GAS v4u*)(GV + (size_t)(t0 + rr) * 1024 + h * 256 + v8); } }
    {
        const int d = w >> 2, ib = (w >> 1) & 1, jb = w & 1;
        const bf16* QE = (const bf16*)(ar + B_QE) + (size_t)d * T * 512 + (size_t)(t0 + ib * 32 + r) * 512 + h * 128 + 8 * hi;
        const bf16* KE = (const bf16*)(ar + B_KE) + (size_t)d * T * 512 + (size_t)(t0 + jb * 32 + r) * 512 + h * 128 + 8 * hi;
        bf16x8 a[8], b[8];
#pragma unroll
        for (int s = 0; s < 8; ++s) { a[s] = *(const GAS bf16x8*)(KE + 16 * s); b[s] = *(const GAS bf16x8*)(QE + 16 * s); }
        f32x16 acc = {};
#pragma unroll
        for (int s = 0; s < 8; ++s) acc = __builtin_amdgcn_mfma_f32_32x32x16_bf16(a[s], b[s], acc, 0, 0, 0);
        const int i = ib * 32 + r;
#pragma unroll
        for (int q4 = 0; q4 < 4; ++q4) { float x[4];
#pragma unroll
            for (int e = 0; e < 4; ++e) { const int j = jb * 32 + 8 * q4 + 4 * hi + e; const bool keep = d == 0 ? (j <= i) : (j >= i); x[e] = keep ? acc[4 * q4 + e] : 0.f; }
            v2u o; o.x = pk2(x[0], x[1]); o.y = pk2(x[2], x[3]);
            *(LAS v2u*)(ATT + ((size_t)(d * 64 + i) * 72 + jb * 32 + 8 * q4 + 4 * hi) * 2) = o; }
    }
    __syncthreads();
    {
        const int ib = w >> 2, vq = w & 3; f32x16 o0 = {}, o1 = {};
        const int vb_base = (int)(uintptr_t)VIMG + (vq >> 1) * 16384 + (2 * (vq & 1)) * 512 + tri::rd_base(lane);
        const tri::Frag2 p0 = tri::ld<0, 0>(vb_base), p1 = tri::ld<0, 1>(vb_base), p2 = tri::ld<0, 2>(vb_base), p3 = tri::ld<0, 3>(vb_base);
        const tri::Frag2 q0 = tri::ld<1, 0>(vb_base), q1 = tri::ld<1, 1>(vb_base), q2 = tri::ld<1, 2>(vb_base), q3 = tri::ld<1, 3>(vb_base);
        TRI_WAIT();
        const bf16x8 vb0[4] = {tri::pk(p0), tri::pk(p1), tri::pk(p2), tri::pk(p3)}, vb1[4] = {tri::pk(q0), tri::pk(q1), tri::pk(q2), tri::pk(q3)};
#pragma unroll
        for (int d = 0; d < 2; ++d) {
            bf16x8 a[4];
#pragma unroll
            for (int s = 0; s < 4; ++s) a[s] = *(const LAS bf16x8*)(ATT + ((size_t)(d * 64 + ib * 32 + r) * 72 + 16 * s + 8 * hi) * 2);
#pragma unroll
            for (int s = 0; s < 4; ++s) { o0 = __builtin_amdgcn_mfma_f32_32x32x16_bf16(a[s], vb0[s], o0, 0, 0, 0); o1 = __builtin_amdgcn_mfma_f32_32x32x16_bf16(a[s], vb1[s], o1, 0, 0, 0); }
            const bf16* QE = (const bf16*)(ar + B_QE) + (size_t)d * T * 512 + (size_t)(t0 + ib * 32 + r) * 512 + h * 128 + 8 * hi;
            const bf16* ST = (const bf16*)(ar + B_ST) + ((size_t)(d * NCH + c) * 4 + h) * 256 * 128 + (size_t)(64 * vq + r) * 128 + 8 * hi;
            bf16x8 qa[8], s0[8], s1[8];
#pragma unroll
            for (int s = 0; s < 8; ++s) { qa[s] = *(const GAS bf16x8*)(QE + 16 * s); s0[s] = *(const GAS bf16x8*)(ST + 16 * s); s1[s] = *(const GAS bf16x8*)(ST + 32 * 128 + 16 * s); }
#pragma unroll
            for (int s = 0; s < 8; ++s) { o0 = __builtin_amdgcn_mfma_f32_32x32x16_bf16(qa[s], s0[s], o0, 0, 0, 0); o1 = __builtin_amdgcn_mfma_f32_32x32x16_bf16(qa[s], s1[s], o1, 0, 0, 0); }
        }
#pragma unroll
        for (int q = 0; q < 16; ++q) { const int i = ib * 32 + crow(q, hi); OS[i * 260 + 64 * vq + r] = o0[q]; OS[i * 260 + 64 * vq + 32 + r] = o1[q]; }
    }
    __syncthreads();
    {
        const int i = F.tid >> 3, seg = F.tid & 7; const LAS float* op = OS + i * 260 + 32 * seg; f32x4 x[8]; float ss = 0.f;
#pragma unroll
        for (int e = 0; e < 8; ++e) { x[e] = *(const LAS f32x4*)(op + 4 * e); ss += (x[e][0] * x[e][0] + x[e][1] * x[e][1]) + (x[e][2] * x[e][2] + x[e][3] * x[e][3]); }
        ss += __shfl_xor(ss, 1); ss += __shfl_xor(ss, 2); ss += __shfl_xor(ss, 4);
        const float rstd = 1.f / sqrtf(ss * (1.f / 256.f) + EPS);
        const float* gn = inp(I_GLANORM) + h * 256 + 32 * seg; const bf16* R = (const bf16*)(ar + B_R) + (size_t)(t0 + i) * 1024 + h * 256 + 32 * seg;
        bf16* YM = (bf16*)(ar + B_YMIX1) + (size_t)(t0 - CTX + i) * D + h * 256 + 32 * seg;
#pragma unroll
        for (int e2 = 0; e2 < 4; ++e2) { const v4u rr = *(const GAS v4u*)(R + 8 * e2); const f32x4 g0 = *(const GAS f32x4*)(gn + 8 * e2), g1 = *(const GAS f32x4*)(gn + 8 * e2 + 4);
            const f32x4 a = x[2 * e2] * rstd * g0, b = x[2 * e2 + 1] * rstd * g1; v4u o;
            o.x = pk2(a[0] * siluf_(bflo(rr.x)), a[1] * siluf_(bfhi(rr.x))); o.y = pk2(a[2] * siluf_(bflo(rr.y)), a[3] * siluf_(bfhi(rr.y)));
            o.z = pk2(b[0] * siluf_(bflo(rr.z)), b[1] * siluf_(bfhi(rr.z))); o.w = pk2(b[2] * siluf_(bflo(rr.w)), b[3] * siluf_(bfhi(rr.w)));
            *(GAS v4u*)(YM + 8 * e2) = o; }
    }
}

namespace att {
constexpr int HD = 128, NW = 8, QBLK = 32, KVBLK = 64;
constexpr float SCALE = 0.088388347648318440f;
constexpr float THR = 8.f;
constexpr int LDQ = 1024, LDK = 256, LDO = 2048;
constexpr size_t SHM_V = KVBLK * HD * 2, SHM_K = KVBLK * HD * 2, SHM_ATTN = 2 * SHM_V + 2 * SHM_K + NW * 64 * 4;
using s16x4 = __attribute__((ext_vector_type(4))) short;
#define KSWZ(row, colB) ((row) * 256 + ((colB) ^ (((row) & 7) << 4)))
#define SBAR() __builtin_amdgcn_sched_barrier(0)
__device__ __forceinline__ unsigned cvtpk(float lo, float hi) { unsigned r; asm volatile("v_cvt_pk_bf16_f32 %0, %1, %2" : "=v"(r) : "v"(lo), "v"(hi)); return r; }
__device__ __forceinline__ void partialSM(f32x16& p0, f32x16& p1, float& m_reg, float& mn, float& alpha) {
  constexpr float C = SCALE * 1.4426950408889634f;
  float pmax = p0[0];
#pragma unroll
  for (int r = 1; r < 16; ++r) pmax = fmaxf(pmax, p0[r]);
#pragma unroll
  for (int r = 0; r < 16; ++r) pmax = fmaxf(pmax, p1[r]);
  { auto rr = __builtin_amdgcn_permlane32_swap(__float_as_uint(pmax), __float_as_uint(pmax), false, false);
    pmax = fmaxf(__uint_as_float(rr[0]), __uint_as_float(rr[1])); }
  if (__builtin_expect(__all(pmax - m_reg <= THR / SCALE), 1)) { mn = m_reg; alpha = 1.f; }
  else { mn = fmaxf(m_reg, pmax); alpha = __builtin_amdgcn_exp2f((m_reg - mn) * C); m_reg = mn; }
  float mnC = -mn * C;
#pragma unroll
  for (int r = 0; r < 16; ++r) p0[r] = fmaf(p0[r], C, mnC);
#pragma unroll
  for (int r = 0; r < 16; ++r) p1[r] = fmaf(p1[r], C, mnC);
#pragma unroll
  for (int r = 0; r < 16; ++r) p0[r] = __builtin_amdgcn_exp2f(p0[r]);
}
__device__ __forceinline__ void finishSM(f32x16& p0, f32x16& p1, float alpha, float& l_reg, bf16x8& pa0, bf16x8& pa1, bf16x8& pa2, bf16x8& pa3) {
#pragma unroll
  for (int r = 0; r < 16; ++r) p1[r] = __builtin_amdgcn_exp2f(p1[r]);
  float ps = 0;
#pragma unroll
  for (int r = 0; r < 16; ++r) ps += p0[r];
#pragma unroll
  for (int r = 0; r < 16; ++r) ps += p1[r];
  { auto rr = __builtin_amdgcn_permlane32_swap(__float_as_uint(ps), __float_as_uint(ps), false, false);
    ps = __uint_as_float(rr[0]) + __uint_as_float(rr[1]); }
  l_reg = l_reg * alpha + ps;
#define PK4(P, BASE, OUT) do { unsigned a0 = cvtpk(P[BASE + 0], P[BASE + 1]), a1 = cvtpk(P[BASE + 2], P[BASE + 3]);   \
    unsigned b0 = cvtpk(P[BASE + 4], P[BASE + 5]), b1 = cvtpk(P[BASE + 6], P[BASE + 7]);                              \
    auto r0 = __builtin_amdgcn_permlane32_swap(a0, b0, false, false); auto r1 = __builtin_amdgcn_permlane32_swap(a1, b1, false, false); \
    u32x4 w = {r0[0], r1[0], r0[1], r1[1]}; OUT = *reinterpret_cast<bf16x8*>(&w); } while (0)
  PK4(p0, 0, pa0); PK4(p0, 8, pa1); PK4(p1, 0, pa2); PK4(p1, 8, pa3);
#undef PK4
}
__device__ __forceinline__ void qkt(f32x16& p0, f32x16& p1, const bf16* Ks, const bf16x8* qr, int r32, int hi) {
  p0 = f32x16{}; p1 = f32x16{};
#pragma unroll
  for (int d0 = 0; d0 < 8; ++d0) { int cb = (d0 * 16 + hi * 8) * 2;
    bf16x8 b0 = *reinterpret_cast<const bf16x8*>((const char*)Ks + KSWZ(r32, cb));
    bf16x8 b1 = *reinterpret_cast<const bf16x8*>((const char*)Ks + KSWZ(32 + r32, cb));
    p0 = __builtin_amdgcn_mfma_f32_32x32x16_bf16(b0, qr[d0], p0, 0, 0, 0);
    p1 = __builtin_amdgcn_mfma_f32_32x32x16_bf16(b1, qr[d0], p1, 0, 0, 0); }
}
__device__ __forceinline__ int v_st(int k, int c) { const int kk = (k & ~0xC) | ((k & 4) << 1) | ((k & 8) >> 1); return ((kk >> 3) * 4 + (c >> 5)) * 512 + ((kk & 7) * 32 + (c & 31)) * 2; }
__device__ __forceinline__ int v_rd_base(int lane) { return ((lane & 3) << 3) | (((lane >> 2) & 3) << 6) | (((lane >> 4) & 1) << 5) | (((lane >> 5) & 1) << 8); }
constexpr int v_rd_off(int d0, int ks, int half) { return d0 * 512 + ks * 4096 + half * 2048; }
template <int OFF> __device__ __forceinline__ s16x4 tr_read(int vb) {
  s16x4 r; asm volatile("ds_read_b64_tr_b16 %0, %1 offset:%2" : "=&v"(r) : "v"(vb), "i"(OFF) : "memory"); return r;
}
template <int D0> __device__ __forceinline__ void pv_one(f32x16& od, int vb, bf16x8 pa0, bf16x8 pa1, bf16x8 pa2, bf16x8 pa3) {
  const s16x4 l0 = tr_read<v_rd_off(D0, 0, 0)>(vb), h0 = tr_read<v_rd_off(D0, 0, 1)>(vb), l1 = tr_read<v_rd_off(D0, 1, 0)>(vb), h1 = tr_read<v_rd_off(D0, 1, 1)>(vb);
  const s16x4 l2 = tr_read<v_rd_off(D0, 2, 0)>(vb), h2 = tr_read<v_rd_off(D0, 2, 1)>(vb), l3 = tr_read<v_rd_off(D0, 3, 0)>(vb), h3 = tr_read<v_rd_off(D0, 3, 1)>(vb);
  asm volatile("s_waitcnt lgkmcnt(0)" ::: "memory"); SBAR();
#define PK(L, H) (bf16x8){L[0], L[1], L[2], L[3], H[0], H[1], H[2], H[3]}
  od = __builtin_amdgcn_mfma_f32_32x32x16_bf16(pa0, PK(l0, h0), od, 0, 0, 0);
  od = __builtin_amdgcn_mfma_f32_32x32x16_bf16(pa1, PK(l1, h1), od, 0, 0, 0);
  od = __builtin_amdgcn_mfma_f32_32x32x16_bf16(pa2, PK(l2, h2), od, 0, 0, 0);
  od = __builtin_amdgcn_mfma_f32_32x32x16_bf16(pa3, PK(l3, h3), od, 0, 0, 0);
#undef PK
}
__device__ __forceinline__ void pv_d0(f32x16* o, int vb, bf16x8 pa0, bf16x8 pa1, bf16x8 pa2, bf16x8 pa3) {
  pv_one<0>(o[0], vb, pa0, pa1, pa2, pa3); pv_one<1>(o[1], vb, pa0, pa1, pa2, pa3); pv_one<2>(o[2], vb, pa0, pa1, pa2, pa3); pv_one<3>(o[3], vb, pa0, pa1, pa2, pa3);
}
typedef int v8i __attribute__((ext_vector_type(8)));
typedef int v4i __attribute__((ext_vector_type(4)));
constexpr size_t SHM_K8 = KVBLK * 128;
#define K8ADDR(row, g) ((row) * 128 + ((((g) ^ ((row) >> 1)) & 7) << 4))
__device__ __forceinline__ void qkt8(f32x16& p0, f32x16& p1, const char* Ks, const v8i& q0, const v8i& q1, int r32, int hi, int sc1) {
  p0 = f32x16{}; p1 = f32x16{};
  const int g0 = 4 * hi;
  { const v4i a00 = *reinterpret_cast<const v4i*>(Ks + K8ADDR(r32, g0)), a01 = *reinterpret_cast<const v4i*>(Ks + K8ADDR(r32, g0 + 1));
    const v4i b00 = *reinterpret_cast<const v4i*>(Ks + K8ADDR(32 + r32, g0)), b01 = *reinterpret_cast<const v4i*>(Ks + K8ADDR(32 + r32, g0 + 1));
    const v8i ka0 = __builtin_shufflevector(a00, a01, 0, 1, 2, 3, 4, 5, 6, 7), kb0 = __builtin_shufflevector(b00, b01, 0, 1, 2, 3, 4, 5, 6, 7);
    asm volatile("s_nop 1\n\tv_mfma_scale_f32_32x32x64_f8f6f4 %0, %1, %2, %0, %3, %3 op_sel_hi:[0,0,0]" : "+v"(p0) : "v"(ka0), "v"(q0), "v"(sc1));
    asm volatile("s_nop 1\n\tv_mfma_scale_f32_32x32x64_f8f6f4 %0, %1, %2, %0, %3, %3 op_sel_hi:[0,0,0]" : "+v"(p1) : "v"(kb0), "v"(q0), "v"(sc1) : "memory"); }
  { const v4i a10 = *reinterpret_cast<const v4i*>(Ks + K8ADDR(r32, g0 + 2)), a11 = *reinterpret_cast<const v4i*>(Ks + K8ADDR(r32, g0 + 3));
    const v4i b10 = *reinterpret_cast<const v4i*>(Ks + K8ADDR(32 + r32, g0 + 2)), b11 = *reinterpret_cast<const v4i*>(Ks + K8ADDR(32 + r32, g0 + 3));
    const v8i ka1 = __builtin_shufflevector(a10, a11, 0, 1, 2, 3, 4, 5, 6, 7), kb1 = __builtin_shufflevector(b10, b11, 0, 1, 2, 3, 4, 5, 6, 7);
    asm volatile("s_nop 1\n\tv_mfma_scale_f32_32x32x64_f8f6f4 %0, %1, %2, %0, %3, %3 op_sel_hi:[0,0,0]" : "+v"(p0) : "v"(ka1), "v"(q1), "v"(sc1));
    asm volatile("s_nop 1\n\tv_mfma_scale_f32_32x32x64_f8f6f4 %0, %1, %2, %0, %3, %3 op_sel_hi:[0,0,0]" : "+v"(p1) : "v"(kb1), "v"(q1), "v"(sc1)); }
  asm volatile("s_nop 15\n\ts_nop 7" : "+v"(p0), "+v"(p1));
}
__device__ __forceinline__ void attn_dense_body(const bf16* __restrict__ Qb, const unsigned char* __restrict__ Kh8, const bf16* __restrict__ Vh, bf16* __restrict__ Ob, int seq, char* lds) {
  constexpr int SDEPTH = 2;
  const int tid = threadIdx.x, wid = tid >> 6, lane = tid & 63, r32 = lane & 31, hi = lane >> 5;
  bf16* V_lds = (bf16*)lds; char* K_lds = lds + 2 * SHM_V;
  float* ws = (float*)(lds + 2 * SHM_V + 2 * SHM_K8) + wid * 64; float* li_l = ws; float* al_l = ws + 32;
  float m_reg = -1e30f, l_reg = 0; f32x16 o[4] = {}; bf16x8 qr[8];
  const bf16* Qw = Qb + (long)(wid * QBLK + r32) * LDQ + hi * 8;
#pragma unroll
  for (int d0 = 0; d0 < 8; ++d0) qr[d0] = *reinterpret_cast<const bf16x8*>(Qw + d0 * 16);
  v8i q8a, q8b; const int sc1 = 0x7f7f7f7f;
  { int w[16];
#pragma unroll
    for (int d0 = 0; d0 < 8; ++d0) { const u32x4 x = *reinterpret_cast<const u32x4*>(&qr[d0]);
      w[2 * d0] = (int)pk4_fp8(bflo(x.x), bfhi(x.x), bflo(x.y), bfhi(x.y)); w[2 * d0 + 1] = (int)pk4_fp8(bflo(x.z), bfhi(x.z), bflo(x.w), bfhi(x.w)); }
    q8a = (v8i){w[0], w[1], w[2], w[3], w[4], w[5], w[6], w[7]}; q8b = (v8i){w[8], w[9], w[10], w[11], w[12], w[13], w[14], w[15]}; }
  const int krow = tid >> 3, kg = tid & 7, kst = K8ADDR(krow, kg);
  const int sr = tid >> 4, sc = (tid & 15) * 8, vst0 = v_st(sr, sc), vst1 = v_st(32 + sr, sc);
  const int vb0 = (int)(uintptr_t)V_lds + v_rd_base(lane);
  struct { bf16x8 vs0, vs1; v4i ks; } sr_[SDEPTH];
#define SLOAD(i, k0) do { sr_[i].vs0 = *reinterpret_cast<const bf16x8*>(&Vh[(long)((k0) + sr) * LDK + sc]); sr_[i].vs1 = *reinterpret_cast<const bf16x8*>(&Vh[(long)((k0) + 32 + sr) * LDK + sc]); \
    sr_[i].ks = *reinterpret_cast<const v4i*>(&Kh8[(long)((k0) + krow) * 256 + kg * 16]); } while (0)
#define SWRITE(b, i) do { *(bf16x8*)((char*)V_lds + (b) * SHM_V + vst0) = sr_[i].vs0;          \
    *(bf16x8*)((char*)V_lds + (b) * SHM_V + vst1) = sr_[i].vs1;                                \
    *(v4i*)(K_lds + (b) * SHM_K8 + kst) = sr_[i].ks; } while (0)
#define SWAIT() do { asm volatile("s_waitcnt vmcnt(3)" ::: "memory"); } while (0)
#define RESC(a) do { if (__any((a) < 1.f)) { if (hi == 0) al_l[r32] = (a); asm volatile("s_waitcnt lgkmcnt(0)" ::: "memory"); \
    _Pragma("unroll") for (int d = 0; d < 4; ++d) _Pragma("unroll") for (int r = 0; r < 16; ++r) o[d][r] *= al_l[crow(r, hi)]; } } while (0)
  f32x16 pA0, pA1, pB0, pB1; float mnA, mnB, alA, alB; bf16x8 pa0, pa1, pa2, pa3; const int NT = seq / KVBLK;
  constexpr int SE = 0, SO = SDEPTH - 1;
  SLOAD(SE, 0); asm volatile("s_waitcnt vmcnt(0)" ::: "memory"); SWRITE(0, SE); __syncthreads();
  qkt8(pA0, pA1, K_lds, q8a, q8b, r32, hi, sc1); partialSM(pA0, pA1, m_reg, mnA, alA);
  SLOAD(SO, KVBLK); if (2 < NT) SLOAD(SE, 2 * KVBLK);
  SWAIT(); SWRITE(1, SO); __syncthreads();
  for (int j = 1; j + 1 < NT; j += 2) {
    SBAR(); qkt8(pB0, pB1, K_lds + SHM_K8, q8a, q8b, r32, hi, sc1);
    finishSM(pA0, pA1, alA, l_reg, pa0, pa1, pa2, pa3); SBAR();
    SLOAD(SO, (j + SDEPTH) * KVBLK); SBAR();
    pv_d0(o, vb0, pa0, pa1, pa2, pa3); partialSM(pB0, pB1, m_reg, mnB, alB);
    __syncthreads(); SWAIT(); SWRITE(0, SE);
    RESC(alB); __syncthreads();
    SBAR(); qkt8(pA0, pA1, K_lds, q8a, q8b, r32, hi, sc1);
    finishSM(pB0, pB1, alB, l_reg, pa0, pa1, pa2, pa3); SBAR();
    if (j + 3 < NT) SLOAD(SE, (j + 1 + SDEPTH) * KVBLK); SBAR();
    pv_d0(o, vb0 + (int)SHM_V, pa0, pa1, pa2, pa3); partialSM(pA0, pA1, m_reg, mnA, alA);
    __syncthreads(); SWAIT(); SWRITE(1, SO);
    RESC(alA); __syncthreads();
  }
  SBAR(); qkt8(pB0, pB1, K_lds + SHM_K8, q8a, q8b, r32, hi, sc1);
  finishSM(pA0, pA1, alA, l_reg, pa0, pa1, pa2, pa3); SBAR();
  pv_d0(o, vb0, pa0, pa1, pa2, pa3); partialSM(pB0, pB1, m_reg, mnB, alB);
  __syncthreads(); RESC(alB);
  finishSM(pB0, pB1, alB, l_reg, pa0, pa1, pa2, pa3); SBAR();
  pv_d0(o, vb0 + (int)SHM_V, pa0, pa1, pa2, pa3);
  if (hi == 0) li_l[r32] = l_reg; asm volatile("s_waitcnt lgkmcnt(0)" ::: "memory");
  float rli[16];
#pragma unroll
  for (int r = 0; r < 16; ++r) rli[r] = __builtin_amdgcn_rcpf(li_l[crow(r, hi)]);
  bf16* Ow = Ob + (long)(wid * QBLK) * LDO;
#pragma unroll
  for (int r = 0; r < 16; ++r) { int orow = crow(r, hi);
#pragma unroll
    for (int d0 = 0; d0 < 4; ++d0) Ow[(long)orow * LDO + d0 * 32 + r32] = (bf16)f2bf(o[d0][r] * rli[r]); }
  __syncthreads();
#undef SLOAD
#undef SWRITE
#undef SWAIT
#undef RESC
}
constexpr float THR8 = 6.f;
#define V8ADDR(d, g) ((d) * 64 + ((((g) ^ ((d) >> 2)) & 3) << 4))
__device__ __forceinline__ void partialSM8(f32x16& p0, f32x16& p1, float& m_reg, float& mn, float& alpha) {
  constexpr float C = SCALE * 1.4426950408889634f;
  float pmax = p0[0];
#pragma unroll
  for (int r = 1; r < 16; ++r) pmax = fmaxf(pmax, p0[r]);
#pragma unroll
  for (int r = 0; r < 16; ++r) pmax = fmaxf(pmax, p1[r]);
  { auto rr = __builtin_amdgcn_permlane32_swap(__float_as_uint(pmax), __float_as_uint(pmax), false, false);
    pmax = fmaxf(__uint_as_float(rr[0]), __uint_as_float(rr[1])); }
  if (__builtin_expect(__all(pmax - m_reg <= THR8 / SCALE), 1)) { mn = m_reg; alpha = 1.f; }
  else { mn = fmaxf(m_reg, pmax); alpha = __builtin_amdgcn_exp2f((m_reg - mn) * C); m_reg = mn; }
  float mnC = -mn * C;
#pragma unroll
  for (int r = 0; r < 16; ++r) p0[r] = fmaf(p0[r], C, mnC);
#pragma unroll
  for (int r = 0; r < 16; ++r) p1[r] = fmaf(p1[r], C, mnC);
#pragma unroll
  for (int r = 0; r < 16; ++r) p0[r] = __builtin_amdgcn_exp2f(p0[r]);
}
__device__ __forceinline__ void finishSM8(f32x16& p0, f32x16& p1, float alpha, float& l_reg, v8i& pa) {
#pragma unroll
  for (int r = 0; r < 16; ++r) p1[r] = __builtin_amdgcn_exp2f(p1[r]);
  float ps = 0;
#pragma unroll
  for (int r = 0; r < 16; ++r) ps += p0[r];
#pragma unroll
  for (int r = 0; r < 16; ++r) ps += p1[r];
  { auto rr = __builtin_amdgcn_permlane32_swap(__float_as_uint(ps), __float_as_uint(ps), false, false);
    ps = __uint_as_float(rr[0]) + __uint_as_float(rr[1]); }
  l_reg = l_reg * alpha + ps;
  pa = (v8i){(int)pk4_fp8(p0[0], p0[1], p0[2], p0[3]), (int)pk4_fp8(p0[4], p0[5], p0[6], p0[7]), (int)pk4_fp8(p0[8], p0[9], p0[10], p0[11]), (int)pk4_fp8(p0[12], p0[13], p0[14], p0[15]),
             (int)pk4_fp8(p1[0], p1[1], p1[2], p1[3]), (int)pk4_fp8(p1[4], p1[5], p1[6], p1[7]), (int)pk4_fp8(p1[8], p1[9], p1[10], p1[11]), (int)pk4_fp8(p1[12], p1[13], p1[14], p1[15])};
}
__device__ __forceinline__ void pv8(f32x16* o, const char* Vs, const v8i& pa, int r32, int hi, int sc1) {
#pragma unroll
  for (int d0 = 0; d0 < 4; ++d0) { const int d = 32 * d0 + r32;
    const v4i x0 = *reinterpret_cast<const v4i*>(Vs + V8ADDR(d, 2 * hi)), x1 = *reinterpret_cast<const v4i*>(Vs + V8ADDR(d, 2 * hi + 1));
    const v8i vb = __builtin_shufflevector(x0, x1, 0, 1, 2, 3, 4, 5, 6, 7);
    asm volatile("s_nop 1\n\tv_mfma_scale_f32_32x32x64_f8f6f4 %0, %1, %2, %0, %3, %3 op_sel_hi:[0,0,0]" : "+v"(o[d0]) : "v"(pa), "v"(vb), "v"(sc1)); }
  asm volatile("s_nop 15\n\ts_nop 7" : "+v"(o[0]), "+v"(o[1]), "+v"(o[2]), "+v"(o[3]));
}
__device__ __forceinline__ void attn_dense_body_pv8(const bf16* __restrict__ Qb, const unsigned char* __restrict__ Kh8, const unsigned char* __restrict__ Vt8, bf16* __restrict__ Ob, int seq, char* lds) {
  constexpr int SDEPTH = 2; constexpr size_t SHM_V8 = 8192;
  const int tid = threadIdx.x, wid = tid >> 6, lane = tid & 63, r32 = lane & 31, hi = lane >> 5;
  char* V_lds = lds; char* K_lds = lds + 2 * SHM_V8;
  float* ws = (float*)(lds + 2 * SHM_V8 + 2 * SHM_K8) + wid * 64; float* li_l = ws; float* al_l = ws + 32;
  float m_reg = -1e30f, l_reg = 0; f32x16 o[4] = {}; bf16x8 qr[8];
  const bf16* Qw = Qb + (long)(wid * QBLK + r32) * LDQ + hi * 8;
#pragma unroll
  for (int d0 = 0; d0 < 8; ++d0) qr[d0] = *reinterpret_cast<const bf16x8*>(Qw + d0 * 16);
  v8i q8a, q8b; const int sc1 = 0x7f7f7f7f;
  { int w[16];
#pragma unroll
    for (int d0 = 0; d0 < 8; ++d0) { const u32x4 x = *reinterpret_cast<const u32x4*>(&qr[d0]);
      w[2 * d0] = (int)pk4_fp8(bflo(x.x), bfhi(x.x), bflo(x.y), bfhi(x.y)); w[2 * d0 + 1] = (int)pk4_fp8(bflo(x.z), bfhi(x.z), bflo(x.w), bfhi(x.w)); }
    q8a = (v8i){w[0], w[1], w[2], w[3], w[4], w[5], w[6], w[7]}; q8b = (v8i){w[8], w[9], w[10], w[11], w[12], w[13], w[14], w[15]}; }
  const int krow = tid >> 3, kg = tid & 7, kst = K8ADDR(krow, kg);
  const int vrow = tid >> 2, vg = tid & 3, vst = V8ADDR(vrow, vg);
  struct { v4i vs, ks; } sr_[SDEPTH];
#define SLOAD(i, k0) do { sr_[i].vs = *reinterpret_cast<const v4i*>(&Vt8[(long)((k0) / KVBLK) * 8192 + tid * 16]); sr_[i].ks = *reinterpret_cast<const v4i*>(&Kh8[(long)((k0) + krow) * 256 + kg * 16]); } while (0)
#define SWRITE(b, i) do { *(v4i*)(V_lds + (b) * SHM_V8 + vst) = sr_[i].vs; *(v4i*)(K_lds + (b) * SHM_K8 + kst) = sr_[i].ks; } while (0)
#define SWAIT() do { asm volatile("s_waitcnt vmcnt(2)" ::: "memory"); } while (0)
#define RESC(a) do { if (__any((a) < 1.f)) { if (hi == 0) al_l[r32] = (a); asm volatile("s_waitcnt lgkmcnt(0)" ::: "memory"); \
    _Pragma("unroll") for (int d = 0; d < 4; ++d) _Pragma("unroll") for (int r = 0; r < 16; ++r) o[d][r] *= al_l[crow(r, hi)]; } } while (0)
  f32x16 pA0, pA1, pB0, pB1; float mnA, mnB, alA, alB; v8i pa; const int NT = seq / KVBLK;
  constexpr int SE = 0, SO = SDEPTH - 1;
  SLOAD(SE, 0); asm volatile("s_waitcnt vmcnt(0)" ::: "memory"); SWRITE(0, SE); __syncthreads();
  qkt8(pA0, pA1, K_lds, q8a, q8b, r32, hi, sc1); partialSM8(pA0, pA1, m_reg, mnA, alA);
  SLOAD(SO, KVBLK); if (2 < NT) SLOAD(SE, 2 * KVBLK);
  SWAIT(); SWRITE(1, SO); __syncthreads();
  for (int j = 1; j + 1 < NT; j += 2) {
    SBAR(); qkt8(pB0, pB1, K_lds + SHM_K8, q8a, q8b, r32, hi, sc1);
    finishSM8(pA0, pA1, alA, l_reg, pa); SBAR();
    SLOAD(SO, (j + SDEPTH) * KVBLK); SBAR();
    pv8(o, V_lds, pa, r32, hi, sc1); partialSM8(pB0, pB1, m_reg, mnB, alB);
    __syncthreads(); SWAIT(); SWRITE(0, SE);
    RESC(alB); __syncthreads();
    SBAR(); qkt8(pA0, pA1, K_lds, q8a, q8b, r32, hi, sc1);
    finishSM8(pB0, pB1, alB, l_reg, pa); SBAR();
    if (j + 3 < NT) SLOAD(SE, (j + 1 + SDEPTH) * KVBLK); SBAR();
    pv8(o, V_lds + SHM_V8, pa, r32, hi, sc1); partialSM8(pA0, pA1, m_reg, mnA, alA);
    __syncthreads(); SWAIT(); SWRITE(1, SO);
    RESC(alA); __syncthreads();
  }
  SBAR(); qkt8(pB0, pB1, K_lds + SHM_K8, q8a, q8b, r32, hi, sc1);
  finishSM8(pA0, pA1, alA, l_reg, pa); SBAR();
  pv8(o, V_lds, pa, r32, hi, sc1); partialSM8(pB0, pB1, m_reg, mnB, alB);
  __syncthreads(); RESC(alB);
  finishSM8(pB0, pB1, alB, l_reg, pa); SBAR();
  pv8(o, V_lds + SHM_V8, pa, r32, hi, sc1);
  if (hi == 0) li_l[r32] = l_reg; asm volatile("s_waitcnt lgkmcnt(0)" ::: "memory");
  float rli[16];
#pragma unroll
  for (int r = 0; r < 16; ++r) rli[r] = __builtin_amdgcn_rcpf(li_l[crow(r, hi)]);
  bf16* Ow = Ob + (long)(wid * QBLK) * LDO;
#pragma unroll
  for (int r = 0; r < 16; ++r) { int orow = crow(r, hi);
#pragma unroll
    for (int d0 = 0; d0 < 4; ++d0) Ow[(long)orow * LDO + d0 * 32 + r32] = (bf16)f2bf(o[d0][r] * rli[r]); }
  __syncthreads();
#undef SLOAD
#undef SWRITE
#undef SWAIT
#undef RESC
}
}

__device__ __forceinline__ void ph_norm3(Frame& F) {
    unsigned char* ar = F.ws + WS_ARENA;
    LAS float* RT = (LAS float*)(F.lds + 3 * 8192);
    LAS int* HIST = (LAS int*)(F.lds + 11 * 8192);
    __syncthreads();
    for (int i = F.tid; i < 2048; i += NTHR) { PV(0)[i] = modp(F, 1, 0, 2)[i] * inp(I_NORMS)[(4 + 1) * 2048 + i]; PV(1)[i] = inp(I_NORMS)[(4 + 2) * 2048 + i] * (1.f + modp(F, 1, 0, 4)[i]); PV(2)[i] = modp(F, 1, 0, 3)[i]; }
    for (int i = F.tid; i < 2048 * 8; i += NTHR) RT[(i & 7) * 2048 + (i >> 3)] = inp(I_ROUTER)[i];
    __syncthreads();
    const bf16* YO = (const bf16*)(ar + B_YO1); bf16* V1 = (bf16*)(ar + B_V1); bf16* HR = (bf16*)(F.ws + WS_HRES) + (size_t)CTX * D;
    int* RE = (int*)(ar + B_RE); float* RG = (float*)(ar + B_RG); int* CNT = (int*)(ar + B_CNT);
    for (int blk = blockIdx.x; blk < SEQ / 64; blk += F.G) {
        if (F.tid < 8) HIST[F.tid] = 0;
        __syncthreads();
        for (int rr = 0; rr < 8; ++rr) { const int t = blk * 64 + F.wave * 8 + rr; f32x4 y[8], h[8];
            ld_row_bf16(YO + (size_t)t * D, F.lane, y); ld_row_bf16(HR + (size_t)t * D, F.lane, h);
            const float ry = 1.f / sqrtf(row_sumsq(y) * (1.f / D) + EPS);
#pragma unroll
            for (int j = 0; j < 8; ++j) h[j] = h[j] + y[j] * ry * ldp(PV(0), F.lane, j);
            st_row_bf16(HR + (size_t)t * D, F.lane, h);
            const float rh = 1.f / sqrtf(row_sumsq(h) * (1.f / D) + EPS);
#pragma unroll
            for (int j = 0; j < 8; ++j) y[j] = h[j] * rh * ldp(PV(1), F.lane, j) + ldp(PV(2), F.lane, j);
            { unsigned char* V8 = (unsigned char*)V1 + (size_t)t * D;
#pragma unroll
              for (int j = 0; j < 8; ++j) *(GAS unsigned*)(V8 + 4 * F.lane + 256 * j) = pk4_fp8(y[j][0], y[j][1], y[j][2], y[j][3]); }
            float lg[8];
#pragma unroll
            for (int e = 0; e < 8; ++e) { float s = 0.f;
#pragma unroll
                for (int j = 0; j < 8; ++j) { const f32x4 w = ldp(RT + e * 2048, F.lane, j); s += (y[j][0] * w[0] + y[j][1] * w[1]) + (y[j][2] * w[2] + y[j][3] * w[3]); }
                lg[e] = wave_sum(s) + inp(I_ROUTERB)[e]; }
            if (F.lane == 0) { int e0 = 0; float v0 = lg[0];
#pragma unroll
                for (int e = 1; e < 8; ++e) if (lg[e] > v0) { v0 = lg[e]; e0 = e; }
                int e1 = -1; float v1 = -3.0e38f;
#pragma unroll
                for (int e = 0; e < 8; ++e) if (e != e0 && lg[e] > v1) { v1 = lg[e]; e1 = e; }
                const float g0 = 1.f / (1.f + __expf(v1 - v0));
                RE[2 * t] = e0; RE[2 * t + 1] = e1; RG[2 * t] = g0; RG[2 * t + 1] = 1.f - g0;
                __hip_atomic_fetch_add((int*)(HIST + e0), 1, __ATOMIC_RELAXED, __HIP_MEMORY_SCOPE_WORKGROUP); __hip_atomic_fetch_add((int*)(HIST + e1), 1, __ATOMIC_RELAXED, __HIP_MEMORY_SCOPE_WORKGROUP); }
        }
        __syncthreads();
        if (F.tid < 8) CNT[blk * 8 + F.tid] = HIST[F.tid];
        __syncthreads();
    }
}
__device__ __forceinline__ void ph_route(Frame& F) {
    unsigned char* ar = F.ws + WS_ARENA;
    LAS int* TOT = (LAS int*)(F.lds); LAS int* PRE = TOT + 8; LAS int* BASE = TOT + 16; LAS int* POS = TOT + 32;
    const int* CNT = (const int*)(ar + B_CNT); const int* RE = (const int*)(ar + B_RE); int* SLOT = (int*)(ar + B_SLOT); int* TILE = (int*)(ar + B_TILE);
    const bf16* V1 = (const bf16*)(ar + B_V1); unsigned char* VG = ar + B_VG;
    for (int blk = blockIdx.x; blk < SEQ / 64; blk += F.G) {
        __syncthreads();
        { const int e = F.wave; int tot = 0, pre = 0;
          for (int q = 0; q < 4; ++q) { const int b = 4 * F.lane + q; const int cv = CNT[b * 8 + e]; tot += cv; pre += (b < blk) ? cv : 0; }
#pragma unroll
          for (int o = 1; o < 64; o <<= 1) { tot += __shfl_xor(tot, o); pre += __shfl_xor(pre, o); }
          if (F.lane == 0) { TOT[e] = tot; PRE[e] = pre; } }
        __syncthreads();
        if (F.tid == 0) { int b = 0; for (int e = 0; e < 8; ++e) { BASE[e] = b; b += (TOT[e] + 255) / 256 * 256; } BASE[8] = b; }
        __syncthreads();
        if (F.wave == 0) { const int t = blk * 64 + F.lane; const int e0 = RE[2 * t], e1 = RE[2 * t + 1]; int p0 = 0, p1 = 0;
            const unsigned long long lt = (1ull << F.lane) - 1ull;
#pragma unroll
            for (int e = 0; e < 8; ++e) { const unsigned long long m0 = __ballot(e0 == e), m1 = __ballot(e1 == e); const int rk = __popcll(m0 & lt) + __popcll(m1 & lt);
                if (e0 == e) p0 = BASE[e] + PRE[e] + rk; if (e1 == e) p1 = BASE[e] + PRE[e] + rk; }
            SLOT[2 * t] = p0; SLOT[2 * t + 1] = p1; POS[2 * F.lane] = p0; POS[2 * F.lane + 1] = p1; }
        __syncthreads();
        for (int idx = F.tid; idx < 128 * 128; idx += NTHR) { const int ri = idx >> 7, seg = idx & 127;
            *(GAS v4u*)(VG + (size_t)POS[ri] * D + seg * 16) = *(const GAS v4u*)((const unsigned char*)V1 + (size_t)(blk * 64 + (ri >> 1)) * D + seg * 16); }
        if (blk < 8) { const int e = blk, r0 = BASE[e] + TOT[e], r1 = BASE[e + 1];
            for (int idx = F.tid; idx < (r1 - r0) * 128; idx += NTHR) *(GAS v4u*)(VG + (size_t)(r0 + (idx >> 7)) * D + (idx & 127) * 16) = (v4u){0u, 0u, 0u, 0u}; }
        if (blk == 0 && F.tid == 0) { int nt = 0; for (int e = 0; e < 8; ++e) { const int n = (BASE[e + 1] - BASE[e]) / 256; for (int q = 0; q < n; ++q) TILE[1 + nt++] = e; } TILE[0] = nt; }
    }
}
__device__ __forceinline__ void ph_norm4(Frame& F, float* out) {
    unsigned char* ar = F.ws + WS_ARENA;
    __syncthreads();
    for (int i = F.tid; i < 2048; i += NTHR) PV(0)[i] = modp(F, 1, 0, 5)[i] * inp(I_NORMS)[(4 + 3) * 2048 + i];
    __syncthreads();
    const bf16* FS = (const bf16*)(ar + B_FS); const bf16* HR = (const bf16*)(F.ws + WS_HRES) + (size_t)CTX * D; const int* SLOT = (const int*)(ar + B_SLOT); const float* RG = (const float*)(ar + B_RG);
    const int gw = F.vcu * NWAVES + F.wave, NGW = F.G * NWAVES;
    for (int t = gw; t < SEQ; t += NGW) { f32x4 a[8], b[8], h[8]; const int p0 = SLOT[2 * t], p1 = SLOT[2 * t + 1]; const float g0 = RG[2 * t], g1 = RG[2 * t + 1];
        const float* PART = (const float*)(ar + B_VG); constexpr size_t PSTR = (size_t)MOE_SPLIT_TILES * 256 * D;
        if (p0 < MOE_MAIN_TILES * 256) ld_row_bf16(FS + (size_t)p0 * D, F.lane, a);
        else { const float* pp = PART + (size_t)(p0 - MOE_MAIN_TILES * 256) * D; f32x4 q1[8], q2[8], q3[8]; ld_row_f32(pp, F.lane, a); ld_row_f32(pp + PSTR, F.lane, q1); ld_row_f32(pp + 2 * PSTR, F.lane, q2); ld_row_f32(pp + 3 * PSTR, F.lane, q3);
#pragma unroll
            for (int j = 0; j < 8; ++j) a[j] = (a[j] + q1[j]) + (q2[j] + q3[j]); }
        if (p1 < MOE_MAIN_TILES * 256) ld_row_bf16(FS + (size_t)p1 * D, F.lane, b);
        else { const float* pp = PART + (size_t)(p1 - MOE_MAIN_TILES * 256) * D; f32x4 q1[8], q2[8], q3[8]; ld_row_f32(pp, F.lane, b); ld_row_f32(pp + PSTR, F.lane, q1); ld_row_f32(pp + 2 * PSTR, F.lane, q2); ld_row_f32(pp + 3 * PSTR, F.lane, q3);
#pragma unroll
            for (int j = 0; j < 8; ++j) b[j] = (b[j] + q1[j]) + (q2[j] + q3[j]); }
        ld_row_bf16(HR + (size_t)t * D, F.lane, h);
#pragma unroll
        for (int j = 0; j < 8; ++j) a[j] = a[j] * g0 + b[j] * g1;
        const float rf = 1.f / sqrtf(row_sumsq(a) * (1.f / D) + EPS);
#pragma unroll
        for (int j = 0; j < 8; ++j) h[j] = h[j] + a[j] * rf * ldp(PV(0), F.lane, j);
        st_row_f32(out + (size_t)t * D, F.lane, h); }
}

struct EpiGateUp8 { static constexpr bool PERM = true; unsigned char* HID; int ldc; float is;
    __device__ __forceinline__ void operator()(AccRef acc, const Unit& u, int wr, int wc, int fr, int fq) const { EPI_ROWS(u); const int col0 = u.pn * 128 + wc * 32 + 8 * fq; const float c1 = -1.4426950408889634f * is, kk = is * is * MOE_HSC;
#pragma unroll
        for (int ai = 0; ai < 2; ++ai)
#pragma unroll
            for (int m = 0; m < 4; ++m) { const int row = row0 + ai * 128 + m * 16; float a[4], b[4];
#pragma unroll
                for (int q = 0; q < 4; ++q) { a[q] = __builtin_amdgcn_fmed3f(swiglu_fast(acc[ai][0][m][0][q], acc[ai][1][m][0][q], c1, kk), -448.f, 448.f);
                                              b[q] = __builtin_amdgcn_fmed3f(swiglu_fast(acc[ai][0][m][1][q], acc[ai][1][m][1][q], c1, kk), -448.f, 448.f); }
                v2u o; o.x = pk4_fp8(a[0], a[1], a[2], a[3]); o.y = pk4_fp8(b[0], b[1], b[2], b[3]);
                *(GAS v2u*)(HID + (size_t)row * ldc + col0) = o; } } };
struct EpiPlainSc { static constexpr bool PERM = true; bf16* O; int ldc; float sc;
    __device__ __forceinline__ void operator()(AccRef acc, const Unit& u, int wr, int wc, int fr, int fq) const { EPI_ROWS(u); const int col0 = u.pn * 256 + wc * 32 + 8 * fq;
#pragma unroll
        for (int ai = 0; ai < 2; ++ai)
#pragma unroll
            for (int m = 0; m < 4; ++m) { bf16* rp = O + (size_t)(row0 + ai * 128 + m * 16) * ldc + col0;
#pragma unroll
                for (int bj = 0; bj < 2; ++bj) *(GAS u32x4*)(rp + bj * 128) = pack8(acc[ai][bj][m][0] * sc, acc[ai][bj][m][1] * sc); } } };

struct EpiPart { static constexpr bool PERM = false; float* P; int pm0; float sc;
    __device__ __forceinline__ void operator()(AccRef acc, const Unit& u, int wr, int wc, int fr, int fq) const { const int row0 = (u.pm - pm0) * 256 + wr * 64 + fr, col0 = u.pn * 256 + wc * 32 + 4 * fq;
        float* base = P + (size_t)u.bz * ((size_t)MOE_SPLIT_TILES * 256 * D);
#pragma unroll
        for (int ai = 0; ai < 2; ++ai)
#pragma unroll
            for (int m = 0; m < 4; ++m) { float* rp = base + (size_t)(row0 + ai * 128 + m * 16) * D + col0;
#pragma unroll
                for (int bj = 0; bj < 2; ++bj)
#pragma unroll
                    for (int n = 0; n < 2; ++n) *(GAS f32x4*)(rp + bj * 128 + n * 16) = acc[ai][bj][m][n] * sc; } } };

enum { PH_PRO = 0, PH_N0, PH_WINE, PH_POOLD, PH_SCAN, PH_S5Y, PH_GLU, PH_WOUTE, PH_N1, PH_FFNU, PH_FFND, PH_N2,
       PH_WINO, PH_PREP, PH_GLA1, PH_GLA2, PH_GLA3, PH_ATT, PH_WOUTO, PH_N3, PH_ROUTE, PH_MOEU, PH_MOED, PH_N4, NPH };
constexpr int PH_EMIT = 100;
struct Args { const float* in[N_IN]; float* out; unsigned char* ws; int ph_lo, ph_hi, li, pad; };

__global__ void __launch_bounds__(NTHR, 2) mk_fwd(Args args) {
    extern __shared__ __attribute__((aligned(16))) unsigned char lds[];
    Frame F;
    F.lds = (LAS unsigned char*)lds; F.MISC = (volatile LAS unsigned*)(F.lds + MISC_OFF);
    F.tid = threadIdx.x; F.lane = F.tid & 63; F.wave = __builtin_amdgcn_readfirstlane(F.tid >> 6);
    F.G = gridDim.x; { const int bx = blockIdx.x; F.vcu = (F.G % 8 == 0) ? (bx % 8) * (F.G / 8) + bx / 8 : bx; }
    F.ws = karg_ws(); F.ctl = (gu32*)(F.ws + WS_CTL);
    for (int u = F.tid; u < (LDS_BYTES - LDSCTL_OFF) / 4; u += NTHR) ((LAS unsigned*)(F.lds + LDSCTL_OFF))[u] = 0u;
    __syncthreads();
    XcdBarrier bar = xcd_barrier_post((unsigned*)(F.ctl + CW_BAR) + (karg_i(2) & 7) * XCD_BAR_WORDS, F.MISC + 8);
    const int lo = karg_i(0), hi = karg_i(1);
#define IN(k) (lo <= (k) && (k) < hi)
#define SEAM(k) do { if (IN(k) && IN((k) + 1)) xcd_barrier(bar); } while (0)
    PG8_LAS unsigned char* ring = (PG8_LAS unsigned char*)(F.lds + RING_OFF);
    unsigned char* ar = F.ws + WS_ARENA;
    const int bid = (int)blockIdx.x;

    if (lo == PH_EMIT) { ph_emit(F, karg_out()); return; }

    if (IN(PH_PRO)) { p0_prologue(F); } SEAM(PH_PRO);
    if (IN(PH_N0)) { for (int it = bid; it < S5G * 8; it += F.G) { s5_small_tables(F, it >> 3); s5_stage_b(F, it >> 3, it & 7); } ph_norm0(F); } SEAM(PH_N0);
    if (IN(PH_WINE)) {
        pg8::Gemm g{(const bf16*)(ar + A_U), (const bf16*)(F.ws + WS_WINE), D, D, D};
        pg8::PlainSched S; S.o.init(T / 256, D / 256, 1, F.G, bid); S.astr = (size_t)256 * D * 2; S.bstr = (size_t)256 * D * 2; S.zA = 0; S.zB = 0;
        EpiWinE E{(bf16*)(ar + A_ZP), (bf16*)(ar + A_AS5)};
        pg8::gemm_phase(ring, g, S, E);
        conv_work(F, 0, fill_quota(S.o.nwg, F.G, bid, 6));
    } SEAM(PH_WINE);
    if (IN(PH_POOLD)) {
        ph_pooldiff(F);
        __syncthreads();
        pg8::Gemm g{(const bf16*)(ar + A_AS5), (const bf16*)(ar + A_M1T), S5K, 1024, 1024};
        pg8::PlainSched S; S.o.init(S5ROWS / 256, 1, S5G, F.G, bid); S.astr = (size_t)256 * S5K * 2; S.bstr = 0; S.zA = (size_t)S5ROWS * S5K * 2; S.zB = (size_t)256 * 1024 * 2;
        EpiSloc E{(float*)(ar + A_SLOC)};
        pg8::gemm_phase(ring, g, S, E);
        conv_work(F, 0, fill_quota(S.o.nwg, F.G, bid, 3));
    } SEAM(PH_POOLD);
    if (IN(PH_SCAN)) {
        ph_s5scan(F);
        __syncthreads();
        pg8::Gemm g{(const bf16*)(ar + A_DP), (const bf16*)(F.ws + WS_WPOOL), WPOOL, PG, PG};
        pg8::PlainSched S; S.o.init(T / 256, 2, 4, F.G, bid); S.astr = (size_t)256 * WPOOL * 2; S.bstr = (size_t)256 * PG * 2; S.zA = (size_t)PG * 2; S.zB = (size_t)512 * PG * 2;
        EpiPool E{(bf16*)(ar + A_YMIX), inp(I_EPOOLS)};
        pg8::gemm_phase(ring, g, S, E);
        conv_work(F, 0, fill_quota(S.o.nwg, F.G, bid, 1));
    } SEAM(PH_SCAN);
    if (IN(PH_S5Y)) {
        pg8::Gemm g{(const bf16*)(ar + A_AS5), (const bf16*)(ar + A_K3T), S5K, S5K, S5K};
        pg8::PlainSched S; S.o.init(S5ROWS / 256, 4, S5G, F.G, bid); S.astr = (size_t)256 * S5K * 2; S.bstr = (size_t)256 * S5K * 2; S.zA = (size_t)S5ROWS * S5K * 2; S.zB = (size_t)1024 * S5K * 2;
        EpiS5Y E{(const bf16*)(ar + A_AS5), inp(I_S5D), (bf16*)(ar + A_YG)};
        pg8::gemm_phase(ring, g, S, E);
    } SEAM(PH_S5Y);
    if (IN(PH_GLU)) {
        pg8::Gemm g{(const bf16*)(ar + A_YG), (const bf16*)(F.ws + WS_WGLU), WS5, WS5, WS5};
        pg8::PlainSched S; S.o.init(T / 256, 2, 1, F.G, bid); S.astr = (size_t)256 * WS5 * 2; S.bstr = (size_t)256 * WS5 * 2; S.zA = 0; S.zB = 0;
        EpiGlu E{(const bf16*)(ar + A_YG), (bf16*)(ar + A_YMIX)};
        pg8::gemm_phase(ring, g, S, E);
        conv_work(F, 0, fill_quota(S.o.nwg, F.G, bid, 2));
    } SEAM(PH_GLU);
    if (IN(PH_WOUTE)) {
        pg8::Gemm g{(const bf16*)(ar + A_YMIX), (const bf16*)(F.ws + WS_WOUTE), D, D, D};
        pg8::PlainSched S; S.o.init(T / 256, D / 256, 1, F.G, bid); S.astr = (size_t)256 * D * 2; S.bstr = (size_t)256 * D * 2; S.zA = 0; S.zB = 0;
        EpiPlain E{(bf16*)(ar + A_YO), D};
        pg8::gemm_phase(ring, g, S, E);
        conv_work(F, 0, fill_quota(S.o.nwg, F.G, bid, 6));
    } SEAM(PH_WOUTE);
    if (IN(PH_N1)) { ph_norm1(F); conv_work(F, CQ_F2, 0); } SEAM(PH_N1);
    if (IN(PH_FFNU)) {
#if FFN_FP8 == 1
        pg8::Gemm g{(const bf16*)(ar + A_V), (const bf16*)(F.ws + WS_WGU), D / 2, D / 2, D / 2};
        pg8::PlainSched S; S.o.init(T / 256, 14336 / 256, 1, F.G, bid); S.astr = (size_t)256 * D; S.bstr = (size_t)256 * D; S.zA = 0; S.zB = 0;
        EpiGateUp8 E{ar + A_HID, DFF, 1.f / MOE_WSC_GU};
        pg8::gemm_phase<EpiGateUp8, pg8::PlainSched, true>(ring, g, S, E);
#elif FFN_FP8 == 2
        pg8::Gemm g{(const bf16*)(ar + A_V), (const bf16*)(F.ws + WS_WGU), D, D, D};
        pg8::PlainSched S; S.o.init(T / 256, 14336 / 256, 1, F.G, bid); S.astr = (size_t)256 * D * 2; S.bstr = (size_t)256 * D * 2; S.zA = 0; S.zB = 0;
        EpiGateUp8 E{ar + A_HID, DFF, 1.f};
        pg8::gemm_phase(ring, g, S, E);
#else
        pg8::Gemm g{(const bf16*)(ar + A_V), (const bf16*)(F.ws + WS_WGU), D, D, D};
        pg8::PlainSched S; S.o.init(T / 256, 14336 / 256, 1, F.G, bid); S.astr = (size_t)256 * D * 2; S.bstr = (size_t)256 * D * 2; S.zA = 0; S.zB = 0;
        EpiGateUp E{(bf16*)(ar + A_HID), DFF};
        pg8::gemm_phase(ring, g, S, E);
#endif
        conv_work(F, CQ_F3, fill_quota((T / 256) * (14336 / 256), F.G, bid, 6));
    } SEAM(PH_FFNU);
    if (IN(PH_FFND)) {
#if FFN_FP8
        pg8::Gemm g{(const bf16*)(ar + A_HID), (const bf16*)(F.ws + WS_WDN), DFF / 2, DFF / 2, DFF / 2};
        pg8::PlainSched S; S.o.init(T / 256, D / 256, 1, F.G, bid); S.astr = (size_t)256 * DFF; S.bstr = (size_t)256 * DFF; S.zA = 0; S.zB = 0;
        EpiPlainSc E{(bf16*)(ar + A_F), D, 1.f / (MOE_WSC_DN * MOE_HSC)};
        pg8::gemm_phase<EpiPlainSc, pg8::PlainSched, true>(ring, g, S, E);
#else
        pg8::Gemm g{(const bf16*)(ar + A_HID), (const bf16*)(F.ws + WS_WDN), DFF, DFF, DFF};
        pg8::PlainSched S; S.o.init(T / 256, D / 256, 1, F.G, bid); S.astr = (size_t)256 * DFF * 2; S.bstr = (size_t)256 * DFF * 2; S.zA = 0; S.zB = 0;
        EpiPlain E{(bf16*)(ar + A_F), D};
        pg8::gemm_phase(ring, g, S, E);
#endif
        conv_work(F, CQ_O1, fill_quota((T / 256) * (D / 256), F.G, bid, 11));
    } SEAM(PH_FFND);
    if (IN(PH_N2)) { ph_norm2(F); conv_work(F, CQ_O1, 0); } SEAM(PH_N2);
    if (IN(PH_WINO)) {
        pg8::Gemm g{(const bf16*)(ar + A_U), (const bf16*)(F.ws + WS_WINO), D, D, D};
        pg8::PlainSched S; S.o.init(T / 256, WINO_N / 256, 1, F.G, bid); S.astr = (size_t)256 * D * 2; S.bstr = (size_t)256 * D * 2; S.zA = 0; S.zB = 0;
        EpiWinO E{ar};
        pg8::gemm_phase(ring, g, S, E);
        conv_work(F, CQ_O2, fill_quota(S.o.nwg, F.G, bid, 5));
    } SEAM(PH_WINO);
    if (IN(PH_PREP)) { ph_qknorm(F); ph_vt8(F); for (int u = bid; u < NCH * 4; u += F.G) gla_prepkv_unit(F, u >> 2, u & 3); conv_work(F, 0, fill_quota(NCH * 4, F.G, bid, 4)); } SEAM(PH_PREP);
    if (IN(PH_GLA2)) { ph_gla_scan(F); } SEAM(PH_GLA2);
    if (IN(PH_GLA3)) { for (int u = bid; u < (SEQ / 64) * 4; u += F.G) gla_out_unit(F, u >> 2, u & 3); __syncthreads(); }
    if (IN(PH_ATT)) {
        for (int L = bid; L < 8 * (SEQ / 256); L += F.G) { const int h = L >> 6, qb = L & 63;
            const bf16* Q = (const bf16*)(ar + B_AQ) + (size_t)(CTX + qb * 256) * 1024 + h * 128;
            const unsigned char* Kp = ar + B_KDT + (h >> 2) * 128; const bf16* Vp = (const bf16*)(ar + B_AV) + (h >> 2) * 128;
            bf16* O = (bf16*)(ar + B_YMIX1) + (size_t)(qb * 256) * D + 1024 + h * 128;
            att::attn_dense_body_pv8(Q, Kp, ar + B_KDT + VT8_OFF + (size_t)(h >> 2) * NCH * 8192, O, T, (char*)lds); }
    } SEAM(PH_ATT);
    if (IN(PH_WOUTO)) {
        pg8::Gemm g{(const bf16*)(ar + B_YMIX1), (const bf16*)(F.ws + WS_WOUTO), D, D, D};
        pg8::PlainSched S; S.o.init(SEQ / 256, D / 256, 1, F.G, bid); S.astr = (size_t)256 * D * 2; S.bstr = (size_t)256 * D * 2; S.zA = 0; S.zB = 0;
        EpiPlain E{(bf16*)(ar + B_YO1), D};
        pg8::gemm_phase(ring, g, S, E);
    } SEAM(PH_WOUTO);
    if (IN(PH_N3)) { ph_norm3(F); } SEAM(PH_N3);
    if (IN(PH_ROUTE)) { ph_route(F); conv_work(F, CQ_M2, 0); } SEAM(PH_ROUTE);
    if (IN(PH_MOEU)) {
        const int* TILE = (const int*)(ar + B_TILE); const int nt = __builtin_amdgcn_readfirstlane(TILE[0]);
        pg8::Gemm g{(const bf16*)(ar + B_VG), (const bf16*)(F.ws + WS_WMGU), D / 2, D / 2, D / 2};
        pg8::MoeSched S; S.o.init(nt, 14336 / 256, 1, F.G, bid); S.astr = (size_t)256 * D; S.bstr = (size_t)256 * D; S.zB = (size_t)14336 * D; S.tile_e = TILE + 1;
        EpiGateUp8 E{ar + B_HID2, DFF, 1.f / MOE_WSC_GU};
        pg8::gemm_phase<EpiGateUp8, pg8::MoeSched, true>(ring, g, S, E);
        conv_work(F, CQ_M3, fill_quota(S.o.nwg, F.G, bid, 5));
    } SEAM(PH_MOEU);
    if (IN(PH_MOED)) {
        const int* TILE = (const int*)(ar + B_TILE); const int nt = __builtin_amdgcn_readfirstlane(TILE[0]);
        pg8::Gemm g{(const bf16*)(ar + B_HID2), (const bf16*)(F.ws + WS_WMDN), DFF / 2, DFF / 2, DFF / 2};
        const int nmain = nt < MOE_MAIN_TILES ? nt : MOE_MAIN_TILES;
        pg8::MoeSched S; S.o.init(nmain, D / 256, 1, F.G, bid); S.astr = (size_t)256 * DFF; S.bstr = (size_t)256 * DFF; S.zB = (size_t)D * DFF; S.tile_e = TILE + 1;
        EpiPlainSc E{(bf16*)(ar + B_FS), D, 1.f / (MOE_WSC_DN * MOE_HSC)};
        pg8::gemm_phase<EpiPlainSc, pg8::MoeSched, true>(ring, g, S, E);
        if (nt > MOE_MAIN_TILES) {
            pg8::Gemm g2{(const bf16*)(ar + B_HID2), (const bf16*)(F.ws + WS_WMDN), DFF / 2, DFF / 2, DFF / 8};
            pg8::MoeSplitSched S2; S2.pm0 = MOE_MAIN_TILES; S2.nun = (nt - MOE_MAIN_TILES) * 32; S2.G = F.G; S2.c = bid; S2.astr = (size_t)256 * DFF; S2.bstr = (size_t)256 * DFF; S2.zB = (size_t)D * DFF; S2.kslice = DFF / 4; S2.tile_e = TILE + 1;
            EpiPart E2{(float*)(ar + B_VG), MOE_MAIN_TILES, 1.f / (MOE_WSC_DN * MOE_HSC)};
            pg8::gemm_phase<EpiPart, pg8::MoeSplitSched, true>(ring, g2, S2, E2);
        }
    } SEAM(PH_MOED);
    if (IN(PH_N4)) { ph_norm4(F, karg_out()); }
#undef IN
#undef SEAM
}

extern "C" void kernel_launch(void* const* d_in, const int* in_sizes, int n_in, void* d_out, int out_size, void* d_ws, size_t ws_size, hipStream_t stream) {
    static int grid = 0;
    if (grid == 0) {
        if (n_in != N_IN || out_size != SEQ * D || ws_size < WS_NEED) { fprintf(stderr, "kernel_launch: shape/workspace mismatch (n_in %d out %d ws %zu need %zu)\n", n_in, out_size, ws_size, (size_t)WS_NEED); grid = -1; return; }
        int dev = 0, cus = 0, per_cu = 0;
        if (hipGetDevice(&dev) != hipSuccess || hipDeviceGetAttribute(&cus, hipDeviceAttributeMultiprocessorCount, dev) != hipSuccess) { grid = -1; return; }
        if (hipFuncSetAttribute((const void*)mk_fwd, hipFuncAttributeMaxDynamicSharedMemorySize, LDS_BYTES) != hipSuccess) { fprintf(stderr, "kernel_launch: hipFuncSetAttribute failed\n"); grid = -1; return; }
        if (hipOccupancyMaxActiveBlocksPerMultiprocessor(&per_cu, (const void*)mk_fwd, NTHR, LDS_BYTES) != hipSuccess || per_cu < 1) { fprintf(stderr, "kernel_launch: occupancy query says %d\n", per_cu); }
        (void)hipGetLastError();
        grid = cus;
    }
    if (grid < 0) return;
    (void)hipMemsetAsync((char*)d_ws + WS_CTL, 0, CTL_ZERO_BYTES, stream);
    Args a{};
    for (int i = 0; i < N_IN; ++i) a.in[i] = (const float*)d_in[i];
    a.out = (float*)d_out; a.ws = (unsigned char*)d_ws; a.pad = 0;
    const int last = (MK_STOP < NPH - 1) ? MK_STOP : NPH - 1;
#if MK_SPLIT
    for (int p = 0; p <= last; ++p) { a.ph_lo = p; a.ph_hi = p + 1; a.li = p; hipLaunchKernelGGL(mk_fwd, dim3(grid), dim3(NTHR), LDS_BYTES, stream, a); }
#else
    a.ph_lo = 0; a.ph_hi = last + 1; a.li = 0; hipLaunchKernelGGL(mk_fwd, dim3(grid), dim3(NTHR), LDS_BYTES, stream, a);
#endif
    if (last < NPH - 1) { a.ph_lo = PH_EMIT; a.ph_hi = PH_EMIT + 1; a.li = 7; hipLaunchKernelGGL(mk_fwd, dim3(grid), dim3(NTHR), LDS_BYTES, stream, a); }
    const hipError_t le = hipPeekAtLastError();
    if (le != hipSuccess) fprintf(stderr, "kernel_launch: launch failed: %s\n", hipGetErrorName(le));
}
```

```cpp
#include <hip/hip_runtime.h>
#include <cstdio>
#include <cstdint>

#ifndef MK_STOP
#define MK_STOP 99
#endif
#ifndef FFN_FP8
#define FFN_FP8 2
#endif
#ifndef FFNU_K1
#define FFNU_K1 1536
#endif
#ifndef MK_SPLIT
#define MK_SPLIT 0
#endif

namespace pg8 {
#define PG8_LAS __attribute__((address_space(3)))
typedef unsigned short bf16_t;
typedef short bf16x8 __attribute__((ext_vector_type(8)));
typedef float f32x4 __attribute__((ext_vector_type(4)));
typedef unsigned u32x4 __attribute__((ext_vector_type(4)));
typedef int v4i __attribute__((ext_vector_type(4)));
typedef int v8i __attribute__((ext_vector_type(8)));
constexpr int BM = 256, BK = 64, HALF = 128, HTB = HALF * BK * 2, STAGE_BYTES = 8 * HTB, NXCD = 8, WGM = 8;

__host__ __device__ __forceinline__ int lds_byte(int r, int c) { const int st = (r >> 4) * 2 + (c >> 5), rr = r & 15, cc = c & 31, ob = rr * 64 + cc * 2; return st * 1024 + (ob ^ (((ob >> 9) & 1) << 5)); }
__host__ __device__ __forceinline__ void stage_rc(int b, int& R, int& C) { const int st = b / 1024, sb = b % 1024, swz = sb ^ (((sb >> 9) & 1) << 5); R = (st >> 1) * 16 + swz / 64; C = (st & 1) * 32 + (swz % 64) / 2; }
__host__ __device__ __forceinline__ int perm32(int rho) { const int n = rho >> 4, i = rho & 15; return 8 * (i >> 2) + 4 * n + (i & 3); }

struct Unit { int pm, pn, bz; unsigned aoff, boff; };
struct Gemm { const bf16_t* A; const bf16_t* Bt; int lda, ldb, K; };

struct TileOrder {
    int nM, nN, nB, nwg, G, c;
    __device__ void init(int nM_, int nN_, int nB_, int G_, int c_) { nM = nM_; nN = nN_; nB = nB_; nwg = nM * nN * nB; G = G_; c = c_; }
    __device__ bool decode(int i, int& bz, int& pm, int& pn) const {
        const long L = (long)i * G + c; if (L >= nwg) return false;
        int wgid = (int)L; { const int q = nwg / NXCD, r = nwg % NXCD, xcd = wgid % NXCD, off = wgid / NXCD; wgid = (xcd < r ? xcd * (q + 1) : r * (q + 1) + (xcd - r) * q) + off; }
        const int per = nM * nN; bz = wgid / per; const int w = wgid - bz * per;
        const int nig = WGM * nN, gid = w / nig, fm = gid * WGM, gsz = (nM - fm) < WGM ? (nM - fm) : WGM;
        pm = fm + ((w % nig) % gsz); pn = (w % nig) / gsz; return true;
    }
};
struct PlainSched {
    TileOrder o; size_t astr, bstr, zA, zB;
    __device__ bool next(int i, Unit& u) const { if (!o.decode(i, u.bz, u.pm, u.pn)) return false; u.aoff = (unsigned)((size_t)u.bz * zA + (size_t)u.pm * astr); u.boff = (unsigned)((size_t)u.bz * zB + (size_t)u.pn * bstr); return true; }
};
struct MoeSched {
    TileOrder o; size_t astr, bstr, zB; const int* tile_e;
    __device__ bool next(int i, Unit& u) const { int bz; if (!o.decode(i, bz, u.pm, u.pn)) return false; u.bz = __builtin_amdgcn_readfirstlane(tile_e[u.pm]); u.aoff = (unsigned)((size_t)u.pm * astr); u.boff = (unsigned)((size_t)u.bz * zB + (size_t)u.pn * bstr); return true; }
};

struct MoeSplitSched {
    int pm0, nun, G, c; size_t astr, bstr, zB; unsigned kslice; const int* tile_e;
    __device__ bool next(int i, Unit& u) const { const long L = (long)i * G + c; if (L >= nun) return false; const int l = (int)L, ks = l & 3, pn = (l >> 2) & 7, pm = pm0 + (l >> 5);
        u.pm = pm; u.pn = pn; u.bz = ks; const int e = __builtin_amdgcn_readfirstlane(tile_e[pm]);
        u.aoff = (unsigned)((size_t)pm * astr + (size_t)ks * kslice); u.boff = (unsigned)((size_t)e * zB + (size_t)pn * bstr + (size_t)ks * kslice); return true; }
};
__device__ __forceinline__ unsigned cvt_pk_bf16(float lo, float hi) { unsigned r; asm volatile("v_cvt_pk_bf16_f32 %0, %1, %2" : "=v"(r) : "v"(lo), "v"(hi)); return r; }
__device__ __forceinline__ u32x4 pack8(const f32x4& a, const f32x4& b) { u32x4 w; w.x = cvt_pk_bf16(a[0], a[1]); w.y = cvt_pk_bf16(a[2], a[3]); w.z = cvt_pk_bf16(b[0], b[1]); w.w = cvt_pk_bf16(b[2], b[3]); return w; }

template <class Epi, class Sched, bool FP8 = false, int MIXT = -1>
__device__ __forceinline__ void gemm_phase(PG8_LAS unsigned char* lds, const Gemm g, const Sched& S, const Epi& E) {
    const int tid = threadIdx.x, wid = __builtin_amdgcn_readfirstlane(tid >> 6), lane = tid & 63, wr = wid >> 2, wc = wid & 3, fr = lane & 15, fq = lane >> 4;
    const int K = g.K, nt = K / BK;
    unsigned voffA[2], voffB[2];
#pragma unroll
    for (int i = 0; i < 2; ++i) { int R, C; stage_rc(tid * 16 + i * 8192, R, C); const int Rb = Epi::PERM ? ((R & ~31) + perm32(R & 31)) : R;
        voffA[i] = (unsigned)(R * g.lda + C) * 2u; voffB[i] = (unsigned)(Rb * g.ldb + C) * 2u; }
    const unsigned kstep = (unsigned)(BK * 2);
    const unsigned hstepA = (unsigned)HALF * (unsigned)g.lda * 2u, hstepB = (unsigned)HALF * (unsigned)g.ldb * 2u;
    const unsigned ldsw = (unsigned)wid * 1024u;
    const int aoff = lds_byte(wr * 64 + fr, fq * 8), boff = lds_byte(wc * 32 + fr, fq * 8);
    const char* const gA = (const char*)g.A; const char* const gB = (const char*)g.Bt;
#define PG8_SA(b, h) (((b) * 2 + (h)) * HTB)
#define PG8_SB(b, h) ((4 + (b) * 2 + (h)) * HTB)
#define PG8_STAGE(bufoff, gbase, soff, voff) do { _Pragma("unroll") for (int _i = 0; _i < 2; ++_i) \
        __builtin_amdgcn_global_load_lds((const unsigned*)((gbase) + (size_t)((soff) + (voff)[_i])), (PG8_LAS unsigned*)(lds + (bufoff) + ldsw + _i * 8192), 16, 0, 0); } while (0)
#define PG8_LDA(dst, b, h) do { _Pragma("unroll") for (int m = 0; m < 4; ++m) _Pragma("unroll") for (int k = 0; k < 2; ++k) dst[m][k] = *(const PG8_LAS bf16x8*)(lds + PG8_SA(b, h) + aoff + m * 2048 + k * 1024); } while (0)
#define PG8_LDB(dst, b, h) do { _Pragma("unroll") for (int n = 0; n < 2; ++n) _Pragma("unroll") for (int k = 0; k < 2; ++k) dst[n][k] = *(const PG8_LAS bf16x8*)(lds + PG8_SB(b, h) + boff + n * 2048 + k * 1024); } while (0)
#define PG8_CAT(x) __builtin_shufflevector(__builtin_bit_cast(v4i, (x)[0]), __builtin_bit_cast(v4i, (x)[1]), 0, 1, 2, 3, 4, 5, 6, 7)
#define PG8_MMA(ai, bj, At, Bt, IS8) do { __builtin_amdgcn_s_setprio(1); \
        if constexpr (MIXT >= 0) { if (IS8) { \
            _Pragma("unroll") for (int m = 0; m < 4; ++m) { const v8i a8 = PG8_CAT(At[m]); _Pragma("unroll") for (int n = 0; n < 2; ++n) { const v8i b8 = PG8_CAT(Bt[n]); \
                asm volatile("s_nop 1\n\tv_mfma_scale_f32_16x16x128_f8f6f4 %0, %1, %2, %0, %3, %4 op_sel_hi:[0,0,0]" : "+v"(acc[ai][bj][m][n]) : "v"(b8), "v"(a8), "v"(scw), "v"(sc1)); } } \
          } else { _Pragma("unroll") for (int m = 0; m < 4; ++m) _Pragma("unroll") for (int n = 0; n < 2; ++n) _Pragma("unroll") for (int k = 0; k < 2; ++k) \
            acc[ai][bj][m][n] = __builtin_amdgcn_mfma_f32_16x16x32_bf16(Bt[n][k], At[m][k], acc[ai][bj][m][n], 0, 0, 0); } \
        } else if constexpr (FP8) {   \
            _Pragma("unroll") for (int m = 0; m < 4; ++m) { const v8i a8 = PG8_CAT(At[m]); _Pragma("unroll") for (int n = 0; n < 2; ++n) { const v8i b8 = PG8_CAT(Bt[n]); \
                  \
                asm volatile("s_nop 1\n\tv_mfma_scale_f32_16x16x128_f8f6f4 %0, %1, %2, %0, %3, %3 op_sel_hi:[0,0,0]" : "+v"(acc[ai][bj][m][n]) : "v"(b8), "v"(a8), "v"(sc1)); } } \
        } else { _Pragma("unroll") for (int m = 0; m < 4; ++m) _Pragma("unroll") for (int n = 0; n < 2; ++n) _Pragma("unroll") for (int k = 0; k < 2; ++k) \
            acc[ai][bj][m][n] = __builtin_amdgcn_mfma_f32_16x16x32_bf16(Bt[n][k], At[m][k], acc[ai][bj][m][n], 0, 0, 0); } \
        __builtin_amdgcn_s_setprio(0); } while (0)
#define PG8_WAIT_V(n) asm volatile("s_waitcnt vmcnt(" #n ")" ::: "memory")
#define PG8_WAIT_L(n) asm volatile("s_waitcnt lgkmcnt(" #n ")" ::: "memory")
#define PG8_BAR __builtin_amdgcn_s_barrier()
#define PG8_SCHED __builtin_amdgcn_sched_barrier(0)
    Unit cur, nxt; int ui = 0;
    if (!S.next(0, cur)) return;
    const int sc1 = 0x7f7f7f7f, scw = 0x79797979;
    f32x4 acc[2][2][4][2];
#pragma unroll
    for (int a = 0; a < 2; ++a)
#pragma unroll
        for (int b = 0; b < 2; ++b)
#pragma unroll
            for (int m = 0; m < 4; ++m)
#pragma unroll
                for (int n = 0; n < 2; ++n) acc[a][b][m][n] = (f32x4){0.f, 0.f, 0.f, 0.f};
    bf16x8 At[4][2], B0[2][2], B1[2][2];
    unsigned cA = cur.aoff, cB = cur.boff;
    PG8_STAGE(PG8_SB(0, 0), gB, cB, voffB); PG8_STAGE(PG8_SB(0, 1), gB, cB + hstepB, voffB); PG8_STAGE(PG8_SA(0, 0), gA, cA, voffA); PG8_STAGE(PG8_SA(0, 1), gA, cA + hstepA, voffA);
    if (wr == 1) PG8_BAR;
    PG8_WAIT_V(2); PG8_BAR;
    PG8_STAGE(PG8_SB(1, 0), gB, cB + kstep, voffB); PG8_STAGE(PG8_SA(1, 0), gA, cA + kstep, voffA); PG8_STAGE(PG8_SB(1, 1), gB, cB + hstepB + kstep, voffB);
    PG8_WAIT_V(6); PG8_BAR;
    for (;;) {
        const bool has_next = S.next(ui + 1, nxt);
        const unsigned nA = has_next ? nxt.aoff : cA, nB = has_next ? nxt.boff : cB;
#define PG8_KBODY(IS8) do { \
            const bool last = (t == nt - 2); \
            const unsigned a1 = cA + (unsigned)(t + 1) * kstep; \
            const unsigned a2 = last ? nA : cA + (unsigned)(t + 2) * kstep, b2 = last ? nB : cB + (unsigned)(t + 2) * kstep; \
            const unsigned a3 = a2 + kstep, b3 = b2 + kstep; \
            PG8_LDB(B0, 0, 0); PG8_LDB(B1, 0, 1); PG8_SCHED; PG8_LDA(At, 0, 0); PG8_STAGE(PG8_SA(1, 1), gA, a1 + hstepA, voffA); \
            PG8_WAIT_V(8); PG8_WAIT_L(0); PG8_BAR; PG8_MMA(0, 0, At, B0, IS8); PG8_MMA(0, 1, At, B1, IS8); PG8_BAR; PG8_SCHED; \
            PG8_LDA(At, 0, 1); PG8_STAGE(PG8_SB(0, 0), gB, b2, voffB); PG8_STAGE(PG8_SB(0, 1), gB, b2 + hstepB, voffB); PG8_STAGE(PG8_SA(0, 0), gA, a2, voffA); \
            PG8_WAIT_V(8); PG8_WAIT_L(0); PG8_BAR; PG8_MMA(1, 0, At, B0, IS8); PG8_MMA(1, 1, At, B1, IS8); PG8_BAR; PG8_SCHED; \
            PG8_LDB(B0, 1, 0); PG8_LDB(B1, 1, 1); PG8_SCHED; PG8_LDA(At, 1, 0); PG8_STAGE(PG8_SA(0, 1), gA, a2 + hstepA, voffA); \
            PG8_WAIT_V(8); PG8_WAIT_L(0); PG8_BAR; PG8_MMA(0, 0, At, B0, IS8); PG8_MMA(0, 1, At, B1, IS8); PG8_BAR; PG8_SCHED; \
            PG8_LDA(At, 1, 1); PG8_STAGE(PG8_SB(1, 0), gB, b3, voffB); PG8_STAGE(PG8_SB(1, 1), gB, b3 + hstepB, voffB); PG8_STAGE(PG8_SA(1, 0), gA, a3, voffA); \
            PG8_WAIT_V(8); PG8_WAIT_L(0); PG8_BAR; PG8_MMA(1, 0, At, B0, IS8); PG8_MMA(1, 1, At, B1, IS8); PG8_BAR; PG8_SCHED; \
        } while (0)
        if constexpr (MIXT >= 0) {
#pragma unroll 1
            for (int t = 0; t < MIXT; t += 2) PG8_KBODY(false);
#pragma unroll 1
            for (int t = MIXT; t < nt; t += 2) PG8_KBODY(true);
        } else {
#pragma unroll 1
            for (int t = 0; t < nt; t += 2) PG8_KBODY(false);
        }
#undef PG8_KBODY
        if constexpr (FP8 || MIXT >= 0) {
            asm volatile("s_nop 15" : "+v"(acc[0][0][0][0]), "+v"(acc[0][0][0][1]), "+v"(acc[0][0][1][0]), "+v"(acc[0][0][1][1]), "+v"(acc[0][0][2][0]), "+v"(acc[0][0][2][1]), "+v"(acc[0][0][3][0]), "+v"(acc[0][0][3][1]),
                                      "+v"(acc[0][1][0][0]), "+v"(acc[0][1][0][1]), "+v"(acc[0][1][1][0]), "+v"(acc[0][1][1][1]), "+v"(acc[0][1][2][0]), "+v"(acc[0][1][2][1]), "+v"(acc[0][1][3][0]), "+v"(acc[0][1][3][1]));
            asm volatile("" : "+v"(acc[1][0][0][0]), "+v"(acc[1][0][0][1]), "+v"(acc[1][0][1][0]), "+v"(acc[1][0][1][1]), "+v"(acc[1][0][2][0]), "+v"(acc[1][0][2][1]), "+v"(acc[1][0][3][0]), "+v"(acc[1][0][3][1]),
                              "+v"(acc[1][1][0][0]), "+v"(acc[1][1][0][1]), "+v"(acc[1][1][1][0]), "+v"(acc[1][1][1][1]), "+v"(acc[1][1][2][0]), "+v"(acc[1][1][2][1]), "+v"(acc[1][1][3][0]), "+v"(acc[1][1][3][1]));
        }
        if (wr == 0) PG8_BAR;
        E(acc, cur, wr, wc, fr, fq);
        if (!has_next) break;
#pragma unroll
        for (int a = 0; a < 2; ++a)
#pragma unroll
            for (int b = 0; b < 2; ++b)
#pragma unroll
                for (int m = 0; m < 4; ++m)
#pragma unroll
                    for (int n = 0; n < 2; ++n) acc[a][b][m][n] = (f32x4){0.f, 0.f, 0.f, 0.f};
        cur = nxt; cA = nA; cB = nB; ++ui;
        if (wr == 1) PG8_BAR;
    }
    PG8_WAIT_V(0);
    PG8_BAR;
#undef PG8_SA
#undef PG8_SB
#undef PG8_STAGE
#undef PG8_LDA
#undef PG8_LDB
#undef PG8_MMA
#undef PG8_CAT
#undef PG8_WAIT_V
#undef PG8_WAIT_L
#undef PG8_BAR
#undef PG8_SCHED
}
}

constexpr int D = 2048, SEQ = 16384, CTX = 256, T = SEQ + CTX, DFF = 7168, NEXP = 8;
constexpr int NWAVES = 8, NTHR = 512;
constexpr int WPOOL = 1536, WS5 = 512, PG = 384, S5G = 32, S5P = 64, S5N = 16, LC = 64, NCH = T / LC  , NCH_CTX = CTX / LC  ;
constexpr int S5ROWS = 512, S5K = 1280;
constexpr int WINO_N = 4864;
constexpr float EPS = 1e-6f;
constexpr float MOE_WSC_GU = 64.f, MOE_WSC_DN = 128.f, MOE_HSC = 4.f;

enum { I_X = 0, I_C, I_CTX, I_CCTX, I_WMOD, I_BMOD, I_NORMS, I_EWIN, I_EPOOLW, I_EPOOLS, I_LAMRE, I_LAMIM, I_LOGDT, I_BRE, I_BIM, I_CRE, I_CIM, I_S5D, I_WGLU, I_EWOUT,
       I_FFG, I_FFU, I_FFD, I_OWIN, I_GLAWA, I_GLABA, I_GLANORM, I_QNORM, I_KNORM, I_OWOUT, I_ROUTER, I_ROUTERB, I_MOEG, I_MOEU, I_MOED, N_IN };

constexpr size_t MiB = 1u << 20;
constexpr size_t al256(size_t x) { return (x + 255) / 256 * 256; }
constexpr size_t WS_CTL = 0, CTL_ZERO_BYTES = 128 * 1024;
constexpr size_t WS_MODF = 1 * MiB;
constexpr size_t WS_ROPE = WS_MODF + al256(2 * 2 * 6 * 2048 * 4);
constexpr size_t WS_W0 = 2 * MiB;
constexpr size_t SZ_WINE = (size_t)2048 * 2048 * 2, SZ_WPOOL = (size_t)4 * 512 * 384 * 2, SZ_WGLU = (size_t)512 * 512 * 2, SZ_WGU = (size_t)14336 * 2048 * 2,
                 SZ_WDN = (size_t)2048 * 7168 * 2, SZ_WINO = (size_t)WINO_N * 2048 * 2;
constexpr size_t WS_WINE = WS_W0, WS_WPOOL = WS_WINE + SZ_WINE, WS_WGLU = WS_WPOOL + SZ_WPOOL, WS_WOUTE = WS_WGLU + SZ_WGLU, WS_WGU = WS_WOUTE + SZ_WINE,
                 WS_WDN = WS_WGU + SZ_WGU, WS_WINO = WS_WDN + SZ_WDN, WS_WOUTO = WS_WINO + SZ_WINO, WS_WMGU = WS_WOUTO + SZ_WINE, WS_WMDN = WS_WMGU + 8 * SZ_WGU,
                 WS_HRES = WS_WMDN + 8 * SZ_WDN;
constexpr size_t SZ_HRES = (size_t)T * D * 4;
constexpr size_t WS_ARENA = WS_HRES + SZ_HRES;
constexpr size_t SZ_ROWB = (size_t)T * D * 2;
constexpr size_t A_U = 0, A_ZP = A_U + SZ_ROWB, SZ_ZP = (size_t)T * WPOOL * 2, A_DP = A_ZP + SZ_ZP, A_AS5 = A_DP + SZ_ZP, SZ_AS5 = (size_t)S5G * S5ROWS * S5K * 2,
                 A_SLOC = A_AS5 + SZ_AS5, SZ_SLOC = (size_t)S5G * S5ROWS * 256 * 4, A_YG = A_SLOC + SZ_SLOC, SZ_YG = (size_t)T * WS5 * 2, A_YMIX = A_YG + SZ_YG,
                 A_YO = A_YMIX + SZ_ROWB, A_V = A_YO + SZ_ROWB, A_HID = A_V + SZ_ROWB, SZ_HID = (size_t)T * DFF * 2, A_F = A_HID + SZ_HID,
                 A_M1T = A_F + SZ_ROWB, SZ_M1T = (size_t)S5G * 256 * 1024 * 2, A_K3T = A_M1T + SZ_M1T, SZ_K3T = (size_t)S5G * 1024 * S5K * 2,
                 A_TBG = A_K3T + SZ_K3T, SZ_TBG = (size_t)S5G * 2 * 64 * 256 * 4, A_L0_END = A_TBG + SZ_TBG;
constexpr size_t WS_END_L0 = WS_ARENA + A_L0_END;
constexpr int MOE_ROWS = 2 * SEQ + NEXP * 256;
constexpr int MOE_MAIN_TILES = 128, MOE_SPLIT_TILES = MOE_ROWS / 256 - 128;
static_assert((size_t)4 * MOE_SPLIT_TILES * 256 * D * 4 <= (size_t)MOE_ROWS * D * 2, "split-K partials fit in the (dead) VG region");
constexpr size_t SZ_T512 = (size_t)T * 512 * 2, SZ_T1024 = (size_t)T * 1024 * 2, SZ_T256 = (size_t)T * 256 * 2, SZ_SEQB = (size_t)SEQ * D * 2;
constexpr size_t B_GQ = A_U + SZ_ROWB, B_GK = B_GQ + SZ_T512, B_GV = B_GK + SZ_T512, B_R = B_GV + SZ_T1024, B_AQ = B_R + SZ_T1024, B_AK = B_AQ + SZ_T1024, B_AV = B_AK + SZ_T256,
                 B_ALR = B_AV + SZ_T256, B_QE = B_ALR + al256((size_t)T * 16 * 4), B_KE = B_QE + 2 * SZ_T512, B_KDT = B_KE + 2 * SZ_T512, B_VT = B_KDT + 2 * SZ_T512,
                 B_DEC = B_VT + SZ_T1024, B_ST = B_DEC + al256((size_t)2 * NCH * 4 * 128 * 4), SZ_ST = (size_t)2 * NCH * 4 * 256 * 128 * 2, B_YMIX1 = B_ST + SZ_ST,
                 B_YO1 = B_YMIX1 + SZ_SEQB, B_REGA_END = B_YO1 + SZ_SEQB;
constexpr size_t B_HID2 = 0, SZ_HID2 = (size_t)MOE_ROWS * DFF * 2, B_FS = B_HID2 + SZ_HID2, SZ_FS = (size_t)MOE_ROWS * D * 2, B_OVL_END = B_FS + SZ_FS;
constexpr size_t B_REGB = al256(B_REGA_END > B_OVL_END ? B_REGA_END : B_OVL_END);
constexpr size_t B_V1 = B_REGB, B_VG = B_V1 + SZ_SEQB, B_RE = B_VG + SZ_FS, B_RG = B_RE + (size_t)SEQ * 8, B_SLOT = B_RG + (size_t)SEQ * 8, B_CNT = B_SLOT + (size_t)SEQ * 8,
                 B_TILE = B_CNT + 256 * 8 * 4, B_L1_END = B_TILE + 4096;
constexpr size_t WS_END_L1 = WS_ARENA + B_L1_END;
constexpr size_t WS_NEED = WS_END_L0 > WS_END_L1 ? WS_END_L0 : WS_END_L1;
static_assert(WS_NEED <= (size_t)1879048192, "workspace map exceeds the guaranteed size");

constexpr int CW_TMO = 0, CW_CODE = 1, CW_BAR = 4096;

#define GAS __attribute__((address_space(1)))
#define LAS __attribute__((address_space(3)))
typedef unsigned short bf16;
typedef unsigned v4u __attribute__((ext_vector_type(4)));
typedef unsigned v2u __attribute__((ext_vector_type(2)));
typedef float f32x4 __attribute__((ext_vector_type(4)));
typedef float f32x2 __attribute__((ext_vector_type(2)));
typedef short bf16x8 __attribute__((ext_vector_type(8)));
typedef GAS unsigned gu32;
#define RLX_AGENT __ATOMIC_RELAXED, __HIP_MEMORY_SCOPE_AGENT
#define LDS_WAIT() asm volatile("s_waitcnt lgkmcnt(0)" ::: "memory")
#define VM_WAIT() asm volatile("s_waitcnt vmcnt(0)" ::: "memory")
__device__ __forceinline__ unsigned f2bf(float f) { unsigned u = __builtin_bit_cast(unsigned, f); return (u + 0x7fffu + ((u >> 16) & 1u)) >> 16; }
typedef __bf16 bf16x2_t __attribute__((ext_vector_type(2)));
__device__ __forceinline__ unsigned pk2(float lo, float hi) { const f32x2 v = {lo, hi}; return __builtin_bit_cast(unsigned, __builtin_convertvector(v, bf16x2_t)); }
__device__ __forceinline__ float bflo(unsigned w) { return __builtin_bit_cast(float, w << 16); }
__device__ __forceinline__ float bfhi(unsigned w) { return __builtin_bit_cast(float, w & 0xffff0000u); }
__device__ __forceinline__ float bf2f(bf16 b) { return __builtin_bit_cast(float, (unsigned)b << 16); }
__device__ __forceinline__ float sigmoidf_(float x) { return __builtin_amdgcn_rcpf(1.f + __expf(-x)); }
__device__ __forceinline__ float siluf_(float x) { return x * __builtin_amdgcn_rcpf(1.f + __expf(-x)); }
__device__ __forceinline__ float swiglu_fast(float ag, float au, float negsg_log2e, float kk) { const float e = __builtin_amdgcn_exp2f(ag * negsg_log2e); return (ag * au) * (kk * __builtin_amdgcn_rcpf(1.f + e)); }
__device__ __forceinline__ float gelu_tanh(float y) { const float z = 0.7978845608028654f * (y + 0.044715f * y * y * y); const float e = __expf(2.f * z); const float th = 1.f - 2.f * __builtin_amdgcn_rcpf(e + 1.f); return 0.5f * y * (1.f + th); }

#define XB_TMO      128
#define XB_XCNT(j)  (256  + 64 * (j))
#define XB_XSUB(j)  (1280 + 64 * (j))
#define XB_XGEN(j)  (2304 + 64 * (j))
#define XB_TOP      3328
#define XB_TOPGEN   3392
#define XCD_BAR_WORDS 3456
#define XB_SPIN_CAP (1u << 22)
__device__ __forceinline__ unsigned xb_ld(unsigned* p)              { return __hip_atomic_load(p, __ATOMIC_RELAXED, __HIP_MEMORY_SCOPE_AGENT); }
__device__ __forceinline__ unsigned xb_add(unsigned* p, unsigned v) { return __hip_atomic_fetch_add(p, v, __ATOMIC_RELAXED, __HIP_MEMORY_SCOPE_AGENT); }
__device__ __forceinline__ unsigned xb_xcc_id() { return (unsigned)__builtin_amdgcn_s_getreg((3 << 11) | 20) & 0xFu; }
#define XB_SPIN(cond, bar) do { unsigned _sp = 0; while (cond) { __builtin_amdgcn_s_sleep(1); \
    if ((++_sp & 255u) == 0u) { if (xb_ld(&(bar)[XB_TMO])) break; if (_sp > XB_SPIN_CAP) { atomicAdd(&(bar)[XB_TMO], 1u); break; } } } } while (0)
struct XcdBarrier { unsigned* bar; unsigned x; volatile LAS unsigned* st; };
__device__ __forceinline__ XcdBarrier xcd_barrier_post(unsigned* bar, volatile LAS unsigned* st) {
    XcdBarrier b; b.bar = bar; b.x = xb_xcc_id(); b.st = st;
    if (threadIdx.x == 0) (void)xb_add(&bar[XB_XCNT(b.x)], 1u);
    return b;
}
__device__ __forceinline__ void xcd_barrier_complete(unsigned* bar, unsigned x, unsigned& nloc, unsigned& nx) {
    const unsigned G = gridDim.x * gridDim.y * gridDim.z;
    unsigned sum, cnt, mine, sp = 0u;
    for (;;) {
        sum = 0u; cnt = 0u; mine = 0u;
#pragma unroll
        for (unsigned j = 0; j < 16; ++j) { const unsigned c = xb_ld(&bar[XB_XCNT(j)]); sum += c; cnt += (c > 0u) ? 1u : 0u; mine = (j == x) ? c : mine; }
        if (sum == G) break;
        __builtin_amdgcn_s_sleep(1);
        if ((++sp & 255u) == 0u) { if (xb_ld(&bar[XB_TMO])) break; if (sp > XB_SPIN_CAP) { atomicAdd(&bar[XB_TMO], 1u); break; } }
    }
    nloc = mine > 0u ? mine : 1u; nx = cnt > 0u ? cnt : 1u;
}
__device__ __forceinline__ void xcd_barrier(const XcdBarrier& b) {
    asm volatile("s_waitcnt vmcnt(0)" ::: "memory");
    __syncthreads();
    if (threadIdx.x == 0) {
        unsigned* bar = b.bar;
        __builtin_amdgcn_s_waitcnt(0);
        unsigned nloc = b.st[0], nx = b.st[1];
        if (nloc == 0u) { xcd_barrier_complete(bar, b.x, nloc, nx); b.st[0] = nloc; b.st[1] = nx; }
        const unsigned old = xb_add(&bar[XB_XSUB(b.x)], 1u);
        const unsigned gen = old / nloc;
        if (old + 1u == (gen + 1u) * nloc) {
            __builtin_amdgcn_fence(__ATOMIC_RELEASE, "agent");
            asm volatile("s_waitcnt vmcnt(0)" ::: "memory");
            const unsigned og = xb_add(&bar[XB_TOP], 1u);
            const unsigned tg = og / nx;
            if (og + 1u == (tg + 1u) * nx) xb_add(&bar[XB_TOPGEN], 1u);
            else XB_SPIN(xb_ld(&bar[XB_TOPGEN]) == tg, bar);
            __builtin_amdgcn_fence(__ATOMIC_ACQUIRE, "agent");
            xb_add(&bar[XB_XGEN(b.x)], 1u);
            asm volatile("s_waitcnt vmcnt(0)" ::: "memory");
        } else {
            XB_SPIN(xb_ld(&bar[XB_XGEN(b.x)]) == gen, bar);
            __builtin_amdgcn_fence(__ATOMIC_ACQUIRE, "agent");
            asm volatile("s_waitcnt vmcnt(0)" ::: "memory");
        }
    }
    __syncthreads();
}

constexpr int RING_OFF = 0, RING_BYTES = 131072;
constexpr int LDSCTL_OFF = RING_BYTES, MISC_OFF = LDSCTL_OFF + 320;
constexpr int LDS_BYTES = 147456;

#define CAS __attribute__((address_space(4)))
__device__ __forceinline__ const float* inp(int k) { const CAS char* ka = (const CAS char*)__builtin_amdgcn_kernarg_segment_ptr(); return *(const float* const CAS*)(ka + 8 * k); }
__device__ __forceinline__ float* karg_out() { const CAS char* ka = (const CAS char*)__builtin_amdgcn_kernarg_segment_ptr(); return *(float* const CAS*)(ka + 8 * 35); }
__device__ __forceinline__ unsigned char* karg_ws() { const CAS char* ka = (const CAS char*)__builtin_amdgcn_kernarg_segment_ptr(); return *(unsigned char* const CAS*)(ka + 8 * 36); }
__device__ __forceinline__ int karg_i(int k) { const CAS char* ka = (const CAS char*)__builtin_amdgcn_kernarg_segment_ptr(); return *(const CAS int*)(ka + 8 * 37 + 4 * k); }
struct Frame {
    LAS unsigned char* lds;
    volatile LAS unsigned* MISC;
    gu32* ctl;
    int tid, lane, wave, vcu, G;
    unsigned char* ws;
};
__device__ __forceinline__ float wave_sum(float v) {
#pragma unroll
    for (int o = 1; o < 64; o <<= 1) v += __shfl_xor(v, o);
    return v;
}

struct RmIdent { int off; __device__ __forceinline__ int operator()(int n) const { return n + off; } };
struct RmGateUp { int which; __device__ __forceinline__ int operator()(int n) const { return (n >> 7) * 256 + which * 128 + (n & 127); } };
struct RmWinO { __device__ __forceinline__ int operator()(int n) const {
    if (n < 2048) return n; if (n < 2064) return 4608 + (n - 2048); return n - 16; } };
template <class RM> __device__ __forceinline__ void tr_item(const float* W, int K, int N, bf16* WT, int ldt, const RM rm, LAS float* scr, int item, int lane) {
    const int nblk = (N + 31) / 32, kb = item / nblk, nb = item - kb * nblk, k0 = 64 * kb, n0 = 32 * nb;
    const int c4 = (lane & 7) * 4, r8 = lane >> 3; const bool okc = (n0 + c4) < N;
    f32x4 v[8];
#pragma unroll
    for (int i = 0; i < 8; ++i) v[i] = okc ? *(const GAS f32x4*)(W + (size_t)(k0 + 8 * i + r8) * N + n0 + c4) : (f32x4){0.f, 0.f, 0.f, 0.f};
#pragma unroll
    for (int i = 0; i < 8; ++i) { LAS float* s = scr + (8 * i + r8) * 33 + c4; s[0] = v[i][0]; s[1] = v[i][1]; s[2] = v[i][2]; s[3] = v[i][3]; }
    LDS_WAIT(); asm volatile("" ::: "memory");
    const int c = lane & 7;
#pragma unroll
    for (int j = 0; j < 4; ++j) { const int n = (lane >> 3) + 8 * j; const LAS float* s = scr + (8 * c) * 33 + n;
        v4u o; o.x = pk2(s[0 * 33], s[1 * 33]); o.y = pk2(s[2 * 33], s[3 * 33]); o.z = pk2(s[4 * 33], s[5 * 33]); o.w = pk2(s[6 * 33], s[7 * 33]);
        if (n0 + n < N) *(GAS v4u*)(WT + (size_t)rm(n0 + n) * ldt + k0 + 8 * c) = o; }
    LDS_WAIT(); asm volatile("" ::: "memory");
}
__device__ __forceinline__ void zero_rows(bf16* p, size_t nbytes, int gt, int ngt) {
    for (size_t i = (size_t)gt; i < nbytes / 16; i += (size_t)ngt) ((GAS v4u*)p)[i] = (v4u){0u, 0u, 0u, 0u};
}
__device__ __forceinline__ unsigned pk4_fp8(float a, float b, float c, float d) { int w = 0; w = __builtin_amdgcn_cvt_pk_fp8_f32(a, b, w, false); w = __builtin_amdgcn_cvt_pk_fp8_f32(c, d, w, true); return (unsigned)w; }
template <class RM> __device__ __forceinline__ void tr_item8(const float* W, int K, int N, unsigned char* WT, int ldt, const RM rm, float sc, LAS float* scr, int item, int lane) {
    const int nblk = (N + 31) / 32, kb = item / nblk, nb = item - kb * nblk, k0 = 64 * kb, n0 = 32 * nb;
    const int c4 = (lane & 7) * 4, r8 = lane >> 3; const bool okc = (n0 + c4) < N;
    f32x4 v[8];
#pragma unroll
    for (int i = 0; i < 8; ++i) v[i] = okc ? *(const GAS f32x4*)(W + (size_t)(k0 + 8 * i + r8) * N + n0 + c4) : (f32x4){0.f, 0.f, 0.f, 0.f};
#pragma unroll
    for (int i = 0; i < 8; ++i) { LAS float* s = scr + (8 * i + r8) * 33 + c4; s[0] = v[i][0]; s[1] = v[i][1]; s[2] = v[i][2]; s[3] = v[i][3]; }
    LDS_WAIT(); asm volatile("" ::: "memory");
    const int c = lane & 7;
#pragma unroll
    for (int j = 0; j < 4; ++j) { const int n = (lane >> 3) + 8 * j; const LAS float* s = scr + (8 * c) * 33 + n;
        v2u o; o.x = pk4_fp8(s[0 * 33] * sc, s[1 * 33] * sc, s[2 * 33] * sc, s[3 * 33] * sc); o.y = pk4_fp8(s[4 * 33] * sc, s[5 * 33] * sc, s[6 * 33] * sc, s[7 * 33] * sc);
        if (n0 + n < N) *(GAS v2u*)(WT + (size_t)rm(n0 + n) * ldt + k0 + 8 * c) = o; }
    LDS_WAIT(); asm volatile("" ::: "memory");
}
constexpr int items_of(int K, int N) { return (K / 64) * ((N + 31) / 32); }

__device__ __forceinline__ void s5_small_tables(Frame& F, int g) {
    const float* lam_re = inp(I_LAMRE); const float* lam_im = inp(I_LAMIM); const float* log_dt = inp(I_LOGDT);
    const float* b_re = inp(I_BRE); const float* b_im = inp(I_BIM); const float* c_re = inp(I_CRE); const float* c_im = inp(I_CIM);
    LAS f32x2* APOW = (LAS f32x2*)(F.lds); LAS f32x2* BB = (LAS f32x2*)(F.lds + 2 * 64 * 65 * 8); LAS f32x2* CC = BB + 2 * 64 * 16;
    const int tid = F.tid;
    __syncthreads();
    if (tid < 128) {
        const int dir = tid >> 6, p = tid & 63; const int gi = (dir * S5G + g);
        const double dt = exp((double)log_dt[gi]); const double lr = (double)lam_re[gi * 64 + p], li = (double)lam_im[gi * 64 + p];
        const double mag = exp(lr * dt), ar = mag * cos(li * dt), ai = mag * sin(li * dt);
        double pr = 1.0, pi = 0.0;
        for (int k = 0; k <= 64; ++k) { APOW[(dir * 64 + p) * 65 + k] = (f32x2){(float)pr, (float)pi}; const double nr = pr * ar - pi * ai, ni = pr * ai + pi * ar; pr = nr; pi = ni; }
        const double den = lr * lr + li * li, nr = ar - 1.0, ni = ai;
        const double kr = (nr * lr + ni * li) / den, ki = (ni * lr - nr * li) / den;
        for (int n = 0; n < 16; ++n) { const double br = (double)b_re[(gi * 64 + p) * 16 + n], bi = (double)b_im[(gi * 64 + p) * 16 + n];
            BB[(dir * 64 + p) * 16 + n] = (f32x2){(float)(kr * br - ki * bi), (float)(kr * bi + ki * br)}; }
    }
    for (int i = tid; i < 2 * 16 * 64; i += NTHR) { const int dir = i >> 10, r = i & 1023; CC[i] = (f32x2){c_re[(size_t)(dir * S5G + g) * 1024 + r], c_im[(size_t)(dir * S5G + g) * 1024 + r]}; }
    __syncthreads();
}
__device__ __forceinline__ void s5_stage_a(Frame& F, int g, int part) {
    LAS f32x2* APOW = (LAS f32x2*)(F.lds); LAS f32x2* BB = (LAS f32x2*)(F.lds + 2 * 64 * 65 * 8); LAS f32x2* CC = BB + 2 * 64 * 16;
    float* TBG = (float*)(F.ws + WS_ARENA + A_TBG) + (size_t)g * (2 * 64 * 256);
    bf16* M1T = (bf16*)(F.ws + WS_ARENA + A_M1T) + (size_t)g * 256 * 1024;
    const int tid = F.tid;
    for (int i0 = tid; i0 < 2 * 8 * 256; i0 += NTHR) {
        const int dir = i0 >> 11, dl = 8 * part + ((i0 >> 8) & 7), np = (i0 >> 4) & 15, n = i0 & 15; float s = 0.f;
        for (int p = 0; p < 64; ++p) { const f32x2 c = CC[(dir * 16 + np) * 64 + p], a = APOW[(dir * 64 + p) * 65 + dl], b = BB[(dir * 64 + p) * 16 + n];
            const float zr = c.x * a.x - c.y * a.y, zi = c.x * a.y + c.y * a.x; s += zr * b.x - zi * b.y; }
        TBG[((dir * 64 + dl) * 16 + np) * 16 + n] = s;
    }
    for (int i = tid; i < 32 * 128; i += NTHR) {
        const int j = 32 * part + (i >> 7), c8 = (i & 127) * 8, sI = c8 >> 4, n0 = c8 & 15, dir = j >> 7, pt = (j >> 6) & 1, p = j & 63, e = dir ? sI : 63 - sI;
        const f32x2 a = APOW[(dir * 64 + p) * 65 + e]; float v[8];
#pragma unroll
        for (int q = 0; q < 8; ++q) { const f32x2 b = BB[(dir * 64 + p) * 16 + n0 + q]; v[q] = pt ? (a.x * b.y + a.y * b.x) : (a.x * b.x - a.y * b.y); }
        v4u o; o.x = pk2(v[0], v[1]); o.y = pk2(v[2], v[3]); o.z = pk2(v[4], v[5]); o.w = pk2(v[6], v[7]);
        *(GAS v4u*)(M1T + (size_t)j * 1024 + c8) = o;
    }
}
__device__ __forceinline__ void s5_stage_b(Frame& F, int g, int part) {
    LAS f32x2* APOW = (LAS f32x2*)(F.lds); LAS f32x2* CC = (LAS f32x2*)(F.lds + 2 * 64 * 65 * 8) + 2 * 64 * 16;
    const float* TBG = (const float*)(F.ws + WS_ARENA + A_TBG) + (size_t)g * (2 * 64 * 256);
    bf16* K3T = (bf16*)(F.ws + WS_ARENA + A_K3T) + (size_t)g * 1024 * S5K;
#pragma unroll 4
    for (int i = F.tid; i < 128 * (S5K / 8); i += NTHR) {
        const int row = 128 * part + i / (S5K / 8), c8 = (i % (S5K / 8)) * 8, tau = row >> 4, np = row & 15; float v[8];
        if (c8 < 1024) { const int sI = c8 >> 4, n0 = c8 & 15;
            f32x4 f0 = {0.f, 0.f, 0.f, 0.f}, f1 = f0, b0 = f0, b1 = f0;
            if (sI <= tau) { const GAS f32x4* tb = (const GAS f32x4*)(TBG + ((0 * 64 + (tau - sI)) * 16 + np) * 16 + n0); f0 = tb[0]; f1 = tb[1]; }
            if (sI >= tau) { const GAS f32x4* tb = (const GAS f32x4*)(TBG + ((1 * 64 + (sI - tau)) * 16 + np) * 16 + n0); b0 = tb[0]; b1 = tb[1]; }
            f0 += b0; f1 += b1; v[0] = f0[0]; v[1] = f0[1]; v[2] = f0[2]; v[3] = f0[3]; v[4] = f1[0]; v[5] = f1[1]; v[6] = f1[2]; v[7] = f1[3];
        } else { const int j0 = c8 - 1024, dir = j0 >> 7, pt = (j0 >> 6) & 1, e = dir ? 64 - tau : tau + 1;
#pragma unroll
            for (int q = 0; q < 8; ++q) { const int p = (j0 & 63) + q; const f32x2 c = CC[(dir * 16 + np) * 64 + p], a = APOW[(dir * 64 + p) * 65 + e];
                v[q] = pt ? -(c.x * a.y + c.y * a.x) : (c.x * a.x - c.y * a.y); } }
        v4u o; o.x = pk2(v[0], v[1]); o.y = pk2(v[2], v[3]); o.z = pk2(v[4], v[5]); o.w = pk2(v[6], v[7]);
        *(GAS v4u*)(K3T + (size_t)row * S5K + c8) = o;
    }
}

__device__ __forceinline__ void mod_item(Frame& F, int item) {
    const int l = item >> 7, slab = item & 127, col0 = 96 * slab;
    const float* wm = inp(I_WMOD) + (size_t)l * 2048 * 12288; const float* bm = inp(I_BMOD) + (size_t)l * 12288;
    LAS float* sv = (LAS float*)F.lds;
    LAS float* part = sv + 4096;
    __syncthreads();
    for (int i = F.tid; i < 4096; i += NTHR) { const float x = (i < 2048) ? inp(I_C)[i] : inp(I_CCTX)[i - 2048]; sv[i] = siluf_(x); }
    __syncthreads();
    const int sub = F.lane / 24, cl = F.lane % 24;
    f32x4 a0 = {0.f, 0.f, 0.f, 0.f}, a1 = {0.f, 0.f, 0.f, 0.f};
    if (sub < 2) {
        const float* wp = wm + (size_t)(256 * F.wave + sub) * 12288 + col0 + 4 * cl;
#pragma unroll 8
        for (int kk = 0; kk < 256; kk += 2) { const f32x4 w = *(const GAS f32x4*)(wp + (size_t)kk * 12288); const int k = 256 * F.wave + kk + sub;
            const float s0 = sv[k], s1 = sv[2048 + k]; a0 += w * s0; a1 += w * s1; }
        LAS float* pp = part + ((F.wave * 2 + sub) * 24 + cl) * 8;
        pp[0] = a0[0]; pp[1] = a0[1]; pp[2] = a0[2]; pp[3] = a0[3]; pp[4] = a1[0]; pp[5] = a1[1]; pp[6] = a1[2]; pp[7] = a1[3];
    }
    __syncthreads();
    if (F.tid < 192) { const int w = F.tid / 96, c = F.tid % 96; float s = 0.f;
        for (int q = 0; q < 16; ++q) s += part[(q * 24 + (c >> 2)) * 8 + w * 4 + (c & 3)];
        float* MODF = (float*)(F.ws + WS_MODF); MODF[(size_t)(l * 2 + w) * 12288 + col0 + c] = s + bm[col0 + c]; }
    __syncthreads();
}

constexpr int units_of(int K, int N) { return (K / 128) * ((N + 255) / 256); }
constexpr int CU_SQ = units_of(2048, 2048), CU_PW = units_of(384, 384), CU_GL = units_of(512, 512), CU_UP = units_of(2048, 7168), CU_DN = units_of(7168, 2048), CU_WO = units_of(2048, 4624);
constexpr int CQ_E0 = 0, CQ_E1 = CQ_E0 + CU_SQ  , CQ_E2 = CQ_E1 + 4 * CU_PW  , CQ_E3 = CQ_E2 + CU_GL  , CQ_E4 = CQ_E3 + CU_SQ  ,
              CQ_F1 = CQ_E4 + CU_UP  , CQ_F2 = CQ_F1 + CU_UP  , CQ_F3 = CQ_F2 + CU_DN  , CQ_O1 = CQ_F3 + CU_WO  , CQ_O2 = CQ_O1 + CU_SQ  ,
              CQ_M1 = CQ_O2 + 8 * CU_UP  , CQ_M2 = CQ_M1 + 8 * CU_UP  , CQ_M3 = CQ_M2 + 8 * CU_DN  , CQ_END = CQ_M3;
constexpr int CW_QUEUE = 2048;
struct ConvDesc { const float* W; unsigned char* WT; int N, ldt, kind, fp8, k0, n0, pitch, kbyte; float sc; };
__device__ __forceinline__ void conv_decode(Frame& F, int it, ConvDesc& d) {
    int r = it; d.kind = 0; d.fp8 = 0; d.sc = 1.f;
    if (r < CQ_E1) { d.W = inp(I_EWIN); d.WT = F.ws + WS_WINE; d.N = 2048; d.ldt = 2048; }
    else if (r < CQ_E2) { r -= CQ_E1; const int g4 = r / CU_PW; d.W = inp(I_EPOOLW) + (size_t)g4 * 384 * 384; d.WT = F.ws + WS_WPOOL + (size_t)g4 * 512 * 384 * 2; d.N = 384; d.ldt = 384; r -= g4 * CU_PW; }
    else if (r < CQ_E3) { d.W = inp(I_WGLU); d.WT = F.ws + WS_WGLU; d.N = 512; d.ldt = 512; r -= CQ_E2; }
    else if (r < CQ_E4) { d.W = inp(I_EWOUT); d.WT = F.ws + WS_WOUTE; d.N = 2048; d.ldt = 2048; r -= CQ_E3; }
    else if (r < CQ_F2) { const int up = r >= CQ_F1; d.W = inp(up ? I_FFU : I_FFG); d.WT = F.ws + WS_WGU; d.N = 7168; d.ldt = 2048; d.kind = 1 + up; r -= (up ? CQ_F1 : CQ_E4);
        if (FFN_FP8 == 1) { d.fp8 = 1; d.sc = MOE_WSC_GU; } }
    else if (r < CQ_F3) { d.W = inp(I_FFD); d.WT = F.ws + WS_WDN; d.N = 2048; d.ldt = 7168; r -= CQ_F2; if (FFN_FP8 != 0) { d.fp8 = 1; d.sc = MOE_WSC_DN; } }
    else if (r < CQ_O1) { d.W = inp(I_OWIN); d.WT = F.ws + WS_WINO; d.N = 4624; d.ldt = 2048; d.kind = 3; r -= CQ_F3; }
    else if (r < CQ_O2) { d.W = inp(I_OWOUT); d.WT = F.ws + WS_WOUTO; d.N = 2048; d.ldt = 2048; r -= CQ_O1; }
    else if (r < CQ_M2) { d.fp8 = 1; const int up = r >= CQ_M1; r -= up ? CQ_M1 : CQ_O2; const int e = r / CU_UP; d.W = inp(up ? I_MOEU : I_MOEG) + (size_t)e * 2048 * 7168; d.WT = F.ws + WS_WMGU + (size_t)e * 14336 * 2048;
        d.N = 7168; d.ldt = 2048; d.kind = 1 + up; d.sc = MOE_WSC_GU; r -= e * CU_UP; }
    else { d.fp8 = 1; r -= CQ_M2; const int e = r / CU_DN; d.W = inp(I_MOED) + (size_t)e * 7168 * 2048; d.WT = F.ws + WS_WMDN + (size_t)e * 2048 * 7168; d.N = 2048; d.ldt = 7168; d.sc = MOE_WSC_DN; r -= e * CU_DN; }
    const int nblk = (d.N + 255) / 256, kb = r / nblk; d.k0 = 128 * kb; d.n0 = 256 * (r - kb * nblk);
    d.pitch = d.fp8 ? d.ldt : 2 * d.ldt; d.kbyte = d.fp8 ? d.k0 : 2 * d.k0;
    if (FFN_FP8 == 2 && FFNU_K1 < 2048 && it >= CQ_E4 && it < CQ_F2) {
        d.pitch = 2 * FFNU_K1 + (2048 - FFNU_K1);
        if (d.k0 >= FFNU_K1) { d.fp8 = 1; d.sc = MOE_WSC_GU; d.kbyte = 2 * FFNU_K1 + (d.k0 - FFNU_K1); } }
}
__device__ __forceinline__ int conv_row(int kind, int n) {
    if (kind == 0) return n; if (kind == 3) return RmWinO{}(n); return (n >> 7) * 256 + (kind - 1) * 128 + (n & 127); }
__device__ __forceinline__ void conv_load(const ConvDesc& d, int wave, int lane, f32x4 (&v)[16]) {
    const bool okc = (d.n0 + 4 * lane) < d.N; const float* p = d.W + (size_t)(d.k0 + 16 * wave) * d.N + d.n0 + 4 * lane;
#pragma unroll
    for (int i = 0; i < 16; ++i) v[i] = okc ? __builtin_nontemporal_load((const GAS f32x4*)(p + (size_t)i * d.N)) : (f32x4){0.f, 0.f, 0.f, 0.f};
}
__device__ __forceinline__ void conv_to_lds(const f32x4 (&v)[16], LAS float* tile, int wave, int lane) {
#pragma unroll
    for (int i = 0; i < 16; ++i) *(LAS f32x4*)(tile + (16 * wave + i) * 256 + ((lane ^ ((2 * wave + (i >> 3)) & 7)) << 2)) = v[i];
}
__device__ __forceinline__ void conv_store(const ConvDesc& d, const LAS float* tile, int tid) {
    const int c = tid & 7;
    if (d.fp8) {
#pragma unroll
        for (int q = 0; q < 4; ++q) { const int nn = (tid >> 3) + 64 * q; float x[16];
#pragma unroll
            for (int j = 0; j < 16; ++j) { const int k = 16 * c + j; x[j] = tile[k * 256 + ((((nn >> 2) ^ ((k >> 3) & 7)) & 63) << 2) + (nn & 3)]; }
            if (d.n0 + nn < d.N) { const size_t row = (size_t)conv_row(d.kind, d.n0 + nn); v4u o;
                o.x = pk4_fp8(x[0] * d.sc, x[1] * d.sc, x[2] * d.sc, x[3] * d.sc); o.y = pk4_fp8(x[4] * d.sc, x[5] * d.sc, x[6] * d.sc, x[7] * d.sc);
                o.z = pk4_fp8(x[8] * d.sc, x[9] * d.sc, x[10] * d.sc, x[11] * d.sc); o.w = pk4_fp8(x[12] * d.sc, x[13] * d.sc, x[14] * d.sc, x[15] * d.sc);
                __builtin_nontemporal_store(o, (GAS v4u*)(d.WT + row * d.pitch + d.kbyte + 16 * c)); } }
    } else {
#pragma unroll
        for (int q = 0; q < 8; ++q) { const int kh = q & 1, nn = (tid >> 3) + 64 * (q >> 1); const LAS float* s = tile + (64 * kh + 8 * c) * 256 + (((nn >> 2) ^ c) << 2) + (nn & 3);
            float x[8];
#pragma unroll
            for (int j = 0; j < 8; ++j) x[j] = s[j * 256];
            if (d.n0 + nn < d.N) { const size_t row = (size_t)conv_row(d.kind, d.n0 + nn);
                v4u o; o.x = pk2(x[0], x[1]); o.y = pk2(x[2], x[3]); o.z = pk2(x[4], x[5]); o.w = pk2(x[6], x[7]);
                __builtin_nontemporal_store(o, (GAS v4u*)(d.WT + row * d.pitch + d.kbyte + (64 * kh + 8 * c) * 2)); } }
    }
}
constexpr int CQ_NONE = 0x7fffffff;
__device__ __forceinline__ int conv_pull(Frame& F) { return (int)__hip_atomic_fetch_add((unsigned*)(F.ctl + CW_QUEUE), 1u, RLX_AGENT); }
__device__ __forceinline__ void conv_work(Frame& F, int dlimit, int quota) {
    LAS float* tile = (LAS float*)(F.lds + RING_OFF);
    volatile LAS int* QW = (volatile LAS int*)(F.lds + LDSCTL_OFF);
    __syncthreads();
    if (F.tid == 0) { int c0 = CQ_NONE, c1 = CQ_NONE; const int head = (int)__hip_atomic_load((unsigned*)(F.ctl + CW_QUEUE), RLX_AGENT);
        if (head < CQ_END && (quota > 0 || head < dlimit)) { c0 = conv_pull(F); if (c0 < CQ_END && (quota > 1 || c0 < dlimit)) c1 = conv_pull(F); }
        QW[0] = c0; QW[1] = c1; }
    __syncthreads();
    int cur = __builtin_amdgcn_readfirstlane(QW[0]), nxt = __builtin_amdgcn_readfirstlane(QW[1]);
    int npull = (cur != CQ_NONE) + (nxt != CQ_NONE);
    __syncthreads();
    if (cur >= CQ_END) return;
    ConvDesc d; f32x4 v[16]; conv_decode(F, cur, d); conv_load(d, F.wave, F.lane, v);
    for (;;) {
        conv_to_lds(v, tile, F.wave, F.lane); LDS_WAIT(); __syncthreads();
        const bool more = nxt < CQ_END; ConvDesc dn = d;
        if (more) { conv_decode(F, nxt, dn); conv_load(dn, F.wave, F.lane, v); }
        const bool pull = more && (npull < quota || nxt < dlimit);
        conv_store(d, tile, F.tid);
        if (pull && F.tid == 0) QW[0] = conv_pull(F);
        LDS_WAIT(); __syncthreads();
        if (!more) break;
        cur = nxt; nxt = pull ? __builtin_amdgcn_readfirstlane(QW[0]) : CQ_NONE; npull += pull ? 1 : 0; d = dn;
    }
}
__device__ __forceinline__ int fill_quota(int nunits, int G, int c, int Q) { const int mine = nunits > c ? (nunits - 1 - c) / G + 1 : 0, most = (nunits + G - 1) / G; return mine < most ? Q : 0; }
__device__ __forceinline__ void p0_prologue(Frame& F) {
    const int gw = F.vcu * NWAVES + F.wave, NGW = F.G * NWAVES, gt = gw * 64 + F.lane, ngt = NGW * 64;
    for (int it = blockIdx.x; it < 256; it += F.G) mod_item(F, it);
    for (int it = blockIdx.x; it < S5G * 8; it += F.G) { s5_small_tables(F, it >> 3); s5_stage_a(F, it >> 3, it & 7); }
    { float* rp = (float*)(F.ws + WS_ROPE); for (int i = gt; i < 256 * 32; i += ngt) { const int pos = i >> 5, fi = i & 31; const float fr = powf(10000.f, -(float)fi / 32.f), ang = (float)pos * fr;
        rp[2 * i] = cosf(ang); rp[2 * i + 1] = sinf(ang); } }
    for (int g4 = 0; g4 < 4; ++g4) zero_rows((bf16*)(F.ws + WS_WPOOL) + ((size_t)g4 * 512 + 384) * 384, (size_t)128 * 384 * 2, gt, ngt);
    zero_rows((bf16*)(F.ws + WS_WINO) + (size_t)4624 * 2048, (size_t)(WINO_N - 4624) * 2048 * 2, gt, ngt);
    __syncthreads();
    conv_work(F, CQ_E4, 0);
    __syncthreads();
}

#define PV(k) ((LAS float*)(F.lds + (k) * 8192))
__device__ __forceinline__ void ld_row_f32(const float* p, int lane, f32x4 (&v)[8]) {
#pragma unroll
    for (int j = 0; j < 8; ++j) v[j] = *(const GAS f32x4*)(p + 4 * lane + 256 * j);
}
__device__ __forceinline__ void st_row_f32(float* p, int lane, const f32x4 (&v)[8]) {
#pragma unroll
    for (int j = 0; j < 8; ++j) *(GAS f32x4*)(p + 4 * lane + 256 * j) = v[j];
}
__device__ __forceinline__ void ld_row_bf16(const bf16* p, int lane, f32x4 (&v)[8]) {
#pragma unroll
    for (int j = 0; j < 8; ++j) { const v2u w = *(const GAS v2u*)(p + 4 * lane + 256 * j); v[j] = (f32x4){bflo(w.x), bfhi(w.x), bflo(w.y), bfhi(w.y)}; }
}
__device__ __forceinline__ void st_row_bf16(bf16* p, int lane, const f32x4 (&v)[8]) {
#pragma unroll
    for (int j = 0; j < 8; ++j) { v2u w; w.x = pk2(v[j][0], v[j][1]); w.y = pk2(v[j][2], v[j][3]); *(GAS v2u*)(p + 4 * lane + 256 * j) = w; }
}
__device__ __forceinline__ float row_sumsq(const f32x4 (&v)[8]) {
    float s = 0.f;
#pragma unroll
    for (int j = 0; j < 8; ++j) s += (v[j][0] * v[j][0] + v[j][1] * v[j][1]) + (v[j][2] * v[j][2] + v[j][3] * v[j][3]);
    return wave_sum(s);
}
__device__ __forceinline__ f32x4 ldp(const LAS float* p, int lane, int j) { return *(const LAS f32x4*)(p + 4 * lane + 256 * j); }
__device__ __forceinline__ const float* modp(Frame& F, int layer, int w, int k) { return (const float*)(F.ws + WS_MODF) + (size_t)(layer * 2 + w) * 12288 + k * 2048; }
__device__ __forceinline__ const float* h0_row(Frame& F, int m) { return m < CTX ? inp(I_CTX) + (size_t)m * D : inp(I_X) + (size_t)(m - CTX) * D; }

__device__ __forceinline__ void ph_norm0(Frame& F) {
    __syncthreads();
    for (int i = F.tid; i < 2 * 2048; i += NTHR) { const int w = i >> 11, c = i & 2047;
        PV(2 * w)[c] = inp(I_NORMS)[0 * 2048 + c] * (1.f + modp(F, 0, w, 1)[c]); PV(2 * w + 1)[c] = modp(F, 0, w, 0)[c]; }
    __syncthreads();
    bf16* U = (bf16*)(F.ws + WS_ARENA + A_U);
    const int gw = F.vcu * NWAVES + F.wave, NGW = F.G * NWAVES;
    for (int m = gw; m < T; m += NGW) { const int w = m < CTX ? 1 : 0; f32x4 v[8]; ld_row_f32(h0_row(F, m), F.lane, v);
        const float rstd = 1.f / sqrtf(row_sumsq(v) * (1.f / D) + EPS);
#pragma unroll
        for (int j = 0; j < 8; ++j) v[j] = v[j] * rstd * ldp(PV(2 * w), F.lane, j) + ldp(PV(2 * w + 1), F.lane, j);
        st_row_bf16(U + (size_t)m * D, F.lane, v); }
}
__device__ __forceinline__ void ph_norm1(Frame& F) {
    __syncthreads();
    for (int i = F.tid; i < 2 * 2048; i += NTHR) { const int w = i >> 11, c = i & 2047;
        PV(3 * w)[c] = modp(F, 0, w, 2)[c] * inp(I_NORMS)[1 * 2048 + c]; PV(3 * w + 1)[c] = inp(I_NORMS)[2 * 2048 + c] * (1.f + modp(F, 0, w, 4)[c]); PV(3 * w + 2)[c] = modp(F, 0, w, 3)[c]; }
    __syncthreads();
    const bf16* YO = (const bf16*)(F.ws + WS_ARENA + A_YO); bf16* V = (bf16*)(F.ws + WS_ARENA + A_V); bf16* HR = (bf16*)(F.ws + WS_HRES);
    const int gw = F.vcu * NWAVES + F.wave, NGW = F.G * NWAVES;
    for (int m = gw; m < T; m += NGW) { const int w = m < CTX ? 1 : 0; f32x4 y[8], h[8]; ld_row_bf16(YO + (size_t)m * D, F.lane, y); ld_row_f32(h0_row(F, m), F.lane, h);
        const float ry = 1.f / sqrtf(row_sumsq(y) * (1.f / D) + EPS);
#pragma unroll
        for (int j = 0; j < 8; ++j) h[j] = h[j] + y[j] * ry * ldp(PV(3 * w), F.lane, j);
        st_row_bf16(HR + (size_t)m * D, F.lane, h);
        const float rh = 1.f / sqrtf(row_sumsq(h) * (1.f / D) + EPS);
#pragma unroll
        for (int j = 0; j < 8; ++j) y[j] = h[j] * rh * ldp(PV(3 * w + 1), F.lane, j) + ldp(PV(3 * w + 2), F.lane, j);
#if FFN_FP8 == 1
        { unsigned char* V8 = (unsigned char*)V + (size_t)m * D;
#pragma unroll
          for (int j = 0; j < 8; ++j) *(GAS unsigned*)(V8 + 4 * F.lane + 256 * j) = pk4_fp8(y[j][0], y[j][1], y[j][2], y[j][3]); }
#elif FFN_FP8 == 2 && FFNU_K1 < 2048
        { unsigned char* Vr = (unsigned char*)V + (size_t)m * (2 * FFNU_K1 + (2048 - FFNU_K1));
#pragma unroll
          for (int j = 0; j < 8; ++j) { const int col = 4 * F.lane + 256 * j;
              if (256 * j < FFNU_K1) { v2u w; w.x = pk2(y[j][0], y[j][1]); w.y = pk2(y[j][2], y[j][3]); *(GAS v2u*)(Vr + 2 * col) = w; }
              else *(GAS unsigned*)(Vr + 2 * FFNU_K1 + (col - FFNU_K1)) = pk4_fp8(y[j][0], y[j][1], y[j][2], y[j][3]); } }
#else
        st_row_bf16(V + (size_t)m * D, F.lane, y);
#endif
    }
}
__device__ __forceinline__ void ph_norm2(Frame& F) {
    __syncthreads();
    for (int i = F.tid; i < 2 * 2048; i += NTHR) { const int w = i >> 11, c = i & 2047;
        PV(3 * w)[c] = modp(F, 0, w, 5)[c] * inp(I_NORMS)[3 * 2048 + c]; PV(3 * w + 1)[c] = inp(I_NORMS)[(4 + 0) * 2048 + c] * (1.f + modp(F, 1, w, 1)[c]); PV(3 * w + 2)[c] = modp(F, 1, w, 0)[c]; }
    __syncthreads();
    const bf16* FB = (const bf16*)(F.ws + WS_ARENA + A_F); bf16* U = (bf16*)(F.ws + WS_ARENA + A_U); bf16* HR = (bf16*)(F.ws + WS_HRES);
    const int gw = F.vcu * NWAVES + F.wave, NGW = F.G * NWAVES;
    for (int m = gw; m < T; m += NGW) { const int w = m < CTX ? 1 : 0; f32x4 y[8], h[8]; ld_row_bf16(FB + (size_t)m * D, F.lane, y); ld_row_bf16(HR + (size_t)m * D, F.lane, h);
        const float ry = 1.f / sqrtf(row_sumsq(y) * (1.f / D) + EPS);
#pragma unroll
        for (int j = 0; j < 8; ++j) h[j] = h[j] + y[j] * ry * ldp(PV(3 * w), F.lane, j);
        st_row_bf16(HR + (size_t)m * D, F.lane, h);
        const float rh = 1.f / sqrtf(row_sumsq(h) * (1.f / D) + EPS);
#pragma unroll
        for (int j = 0; j < 8; ++j) y[j] = h[j] * rh * ldp(PV(3 * w + 1), F.lane, j) + ldp(PV(3 * w + 2), F.lane, j);
        st_row_bf16(U + (size_t)m * D, F.lane, y); }
}
__device__ __forceinline__ void ph_emit(Frame& F, float* out) {
    const bf16* HR = (const bf16*)(F.ws + WS_HRES) + (size_t)CTX * D;
    for (size_t i = (size_t)blockIdx.x * NTHR + F.tid; i < (size_t)SEQ * D / 4; i += (size_t)F.G * NTHR) { const v2u w = ((const GAS v2u*)HR)[i]; ((GAS f32x4*)out)[i] = (f32x4){bflo(w.x), bfhi(w.x), bflo(w.y), bfhi(w.y)}; }
}

__device__ __forceinline__ void ph_pooldiff(Frame& F) {
    const bf16* ZP = (const bf16*)(F.ws + WS_ARENA + A_ZP); bf16* DP = (bf16*)(F.ws + WS_ARENA + A_DP);
    const size_t nitem = (size_t)T * (WPOOL / 8);
    for (size_t it = (size_t)F.vcu * NTHR + F.tid; it < nitem; it += (size_t)F.G * NTHR) {
        const int t = (int)(it / (WPOOL / 8)), c8 = (int)(it % (WPOOL / 8)) * 8, gi = c8 / PG, w = 2 << gi;
        const int s0 = t < CTX ? 0 : CTX, L = t < CTX ? CTX : SEQ, tp = t - s0;
        int lo = tp - w / 2; lo = lo < 0 ? 0 : lo; int hi = tp + (w - w / 2); hi = hi > L ? L : hi;
        float s[8];
#pragma unroll
        for (int q = 0; q < 8; ++q) s[q] = 0.f;
        for (int r = lo; r < hi; ++r) { const v4u x = *(const GAS v4u*)(ZP + (size_t)(s0 + r) * WPOOL + c8);
            s[0] += bflo(x.x); s[1] += bfhi(x.x); s[2] += bflo(x.y); s[3] += bfhi(x.y); s[4] += bflo(x.z); s[5] += bfhi(x.z); s[6] += bflo(x.w); s[7] += bfhi(x.w); }
        const float inv = 1.f / (float)(hi - lo); const v4u z = *(const GAS v4u*)(ZP + (size_t)t * WPOOL + c8);
        v4u o; o.x = pk2(s[0] * inv - bflo(z.x), s[1] * inv - bfhi(z.x)); o.y = pk2(s[2] * inv - bflo(z.y), s[3] * inv - bfhi(z.y));
        o.z = pk2(s[4] * inv - bflo(z.z), s[5] * inv - bfhi(z.z)); o.w = pk2(s[6] * inv - bflo(z.w), s[7] * inv - bfhi(z.w));
        *(GAS v4u*)(DP + (size_t)t * WPOOL + c8) = o;
    }
}

__device__ __forceinline__ void ph_s5scan(Frame& F) {
    const int gth = blockIdx.x * NTHR + F.tid; if (gth >= S5G * 2 * 64) return;
    const int g = gth >> 7, dir = (gth >> 6) & 1, p = gth & 63, gi = dir * S5G + g;
    const double dt = exp((double)inp(I_LOGDT)[gi]), lr = (double)inp(I_LAMRE)[gi * 64 + p], li = (double)inp(I_LAMIM)[gi * 64 + p];
    const float aLr = (float)(exp(lr * dt * LC) * cos(li * dt * LC)), aLi = (float)(exp(lr * dt * LC) * sin(li * dt * LC));
    const float* SL = (const float*)(F.ws + WS_ARENA + A_SLOC) + (size_t)g * S5ROWS * 256 + dir * 128 + p;
    bf16* CA = (bf16*)(F.ws + WS_ARENA + A_AS5) + (size_t)g * S5ROWS * S5K + 1024 + dir * 128 + p;
    float er = 0.f, ei = 0.f;
    for (int i0 = 0; i0 < NCH; i0 += 4) {
        int cc[4]; float sr[4], si[4];
#pragma unroll
        for (int q = 0; q < 4; ++q) { const int i = i0 + q; cc[q] = dir == 0 ? i : (i < NCH_CTX ? NCH_CTX - 1 - i : NCH - 1 - (i - NCH_CTX));
            sr[q] = SL[(size_t)cc[q] * 256]; si[q] = SL[(size_t)cc[q] * 256 + 64]; }
#pragma unroll
        for (int q = 0; q < 4; ++q) { CA[(size_t)cc[q] * S5K] = (bf16)f2bf(er); CA[(size_t)cc[q] * S5K + 64] = (bf16)f2bf(ei);
            const float nr = aLr * er - aLi * ei + sr[q], ni = aLr * ei + aLi * er + si[q]; er = nr; ei = ni; }
    }
}

typedef unsigned u32x4 __attribute__((ext_vector_type(4)));
using pg8::Unit; using pg8::pack8;
typedef const pg8::f32x4 (&AccRef)[2][2][4][2];
#define EPI_ROWS(u) const int row0 = (u).pm * 256 + wr * 64 + fr
struct EpiPlain { static constexpr bool PERM = true; bf16* O; int ldc;
    __device__ __forceinline__ void operator()(AccRef acc, const Unit& u, int wr, int wc, int fr, int fq) const { EPI_ROWS(u); const int col0 = u.pn * 256 + wc * 32 + 8 * fq;
#pragma unroll
        for (int ai = 0; ai < 2; ++ai)
#pragma unroll
            for (int m = 0; m < 4; ++m) { bf16* rp = O + (size_t)(row0 + ai * 128 + m * 16) * ldc + col0;
#pragma unroll
                for (int bj = 0; bj < 2; ++bj) *(GAS u32x4*)(rp + bj * 128) = pack8(acc[ai][bj][m][0], acc[ai][bj][m][1]); } } };
struct EpiWinE { static constexpr bool PERM = true; bf16* ZP; bf16* AS5;
    __device__ __forceinline__ void operator()(AccRef acc, const Unit& u, int wr, int wc, int fr, int fq) const { EPI_ROWS(u); const int col0 = u.pn * 256 + wc * 32 + 8 * fq;
#pragma unroll
        for (int ai = 0; ai < 2; ++ai)
#pragma unroll
            for (int m = 0; m < 4; ++m) { const int row = row0 + ai * 128 + m * 16;
#pragma unroll
                for (int bj = 0; bj < 2; ++bj) { const int col = col0 + bj * 128; const u32x4 w = pack8(acc[ai][bj][m][0], acc[ai][bj][m][1]);
                    if (u.pn < 6) *(GAS u32x4*)(ZP + (size_t)row * WPOOL + col) = w;
                    else { const int cc = col - WPOOL, g = cc >> 4, n0 = cc & 15, c = row >> 6, s = row & 63; *(GAS u32x4*)(AS5 + ((size_t)(g * S5ROWS + c) * S5K + s * 16 + n0)) = w; } } } } };
struct EpiPool { static constexpr bool PERM = true; bf16* YMIX; const float* scale;
    __device__ __forceinline__ void operator()(AccRef acc, const Unit& u, int wr, int wc, int fr, int fq) const { EPI_ROWS(u); const int lc0 = u.pn * 256 + wc * 32 + 8 * fq;
#pragma unroll
        for (int bj = 0; bj < 2; ++bj) { const int lc = lc0 + bj * 128; if (lc >= PG) continue; const int gc = u.bz * PG + lc;
            const f32x4 s0 = *(const GAS f32x4*)(scale + gc), s1 = *(const GAS f32x4*)(scale + gc + 4);
#pragma unroll
            for (int ai = 0; ai < 2; ++ai)
#pragma unroll
                for (int m = 0; m < 4; ++m) { const int row = row0 + ai * 128 + m * 16; *(GAS u32x4*)(YMIX + (size_t)row * D + gc) = pack8(acc[ai][bj][m][0] * s0, acc[ai][bj][m][1] * s1); } } } };
struct EpiSloc { static constexpr bool PERM = false; float* SL;
    __device__ __forceinline__ void operator()(AccRef acc, const Unit& u, int wr, int wc, int fr, int fq) const { EPI_ROWS(u); const int col0 = u.pn * 256 + wc * 32 + 4 * fq;
#pragma unroll
        for (int ai = 0; ai < 2; ++ai)
#pragma unroll
            for (int m = 0; m < 4; ++m) { float* rp = SL + ((size_t)u.bz * S5ROWS + row0 + ai * 128 + m * 16) * 256 + col0;
#pragma unroll
                for (int bj = 0; bj < 2; ++bj)
#pragma unroll
                    for (int n = 0; n < 2; ++n) *(GAS f32x4*)(rp + bj * 128 + n * 16) = acc[ai][bj][m][n]; } } };
struct EpiS5Y { static constexpr bool PERM = true; const bf16* AS5; const float* dsk; bf16* YG;
    __device__ __forceinline__ void operator()(AccRef acc, const Unit& u, int wr, int wc, int fr, int fq) const { EPI_ROWS(u); const int col0 = u.pn * 256 + wc * 32 + 8 * fq;
#pragma unroll
        for (int bj = 0; bj < 2; ++bj) { const int col = col0 + bj * 128, tau = col >> 4, n0 = col & 15;
            const f32x4 d0 = *(const GAS f32x4*)(dsk + u.bz * 16 + n0), d1 = *(const GAS f32x4*)(dsk + u.bz * 16 + n0 + 4);
#pragma unroll
            for (int ai = 0; ai < 2; ++ai)
#pragma unroll
                for (int m = 0; m < 4; ++m) { const int c = row0 + ai * 128 + m * 16; if (c >= NCH) continue;
                    const v4u x = *(const GAS v4u*)(AS5 + ((size_t)(u.bz * S5ROWS + c) * S5K + col));
                    f32x4 a = acc[ai][bj][m][0], b = acc[ai][bj][m][1];
                    a[0] = gelu_tanh(a[0] + bflo(x.x) * d0[0]); a[1] = gelu_tanh(a[1] + bfhi(x.x) * d0[1]); a[2] = gelu_tanh(a[2] + bflo(x.y) * d0[2]); a[3] = gelu_tanh(a[3] + bfhi(x.y) * d0[3]);
                    b[0] = gelu_tanh(b[0] + bflo(x.z) * d1[0]); b[1] = gelu_tanh(b[1] + bfhi(x.z) * d1[1]); b[2] = gelu_tanh(b[2] + bflo(x.w) * d1[2]); b[3] = gelu_tanh(b[3] + bfhi(x.w) * d1[3]);
                    *(GAS u32x4*)(YG + ((size_t)(c * 64 + tau) * WS5 + u.bz * 16 + n0)) = pack8(a, b); } } } };
struct EpiGlu { static constexpr bool PERM = true; const bf16* YG; bf16* YMIX;
    __device__ __forceinline__ void operator()(AccRef acc, const Unit& u, int wr, int wc, int fr, int fq) const { EPI_ROWS(u); const int col0 = u.pn * 256 + wc * 32 + 8 * fq;
#pragma unroll
        for (int ai = 0; ai < 2; ++ai)
#pragma unroll
            for (int m = 0; m < 4; ++m) { const int row = row0 + ai * 128 + m * 16;
#pragma unroll
                for (int bj = 0; bj < 2; ++bj) { const int col = col0 + bj * 128; const v4u x = *(const GAS v4u*)(YG + (size_t)row * WS5 + col);
                    f32x4 a = acc[ai][bj][m][0], b = acc[ai][bj][m][1];
                    a[0] = bflo(x.x) * sigmoidf_(a[0]); a[1] = bfhi(x.x) * sigmoidf_(a[1]); a[2] = bflo(x.y) * sigmoidf_(a[2]); a[3] = bfhi(x.y) * sigmoidf_(a[3]);
                    b[0] = bflo(x.z) * sigmoidf_(b[0]); b[1] = bfhi(x.z) * sigmoidf_(b[1]); b[2] = bflo(x.w) * sigmoidf_(b[2]); b[3] = bfhi(x.w) * sigmoidf_(b[3]);
                    *(GAS u32x4*)(YMIX + (size_t)row * D + WPOOL + col) = pack8(a, b); } } } };
struct EpiGateUp { static constexpr bool PERM = true; bf16* HID; int ldc;
    __device__ __forceinline__ void operator()(AccRef acc, const Unit& u, int wr, int wc, int fr, int fq) const { EPI_ROWS(u); const int col0 = u.pn * 128 + wc * 32 + 8 * fq;
#pragma unroll
        for (int ai = 0; ai < 2; ++ai)
#pragma unroll
            for (int m = 0; m < 4; ++m) { const int row = row0 + ai * 128 + m * 16; f32x4 a, b;
#pragma unroll
                for (int q = 0; q < 4; ++q) { a[q] = swiglu_fast(acc[ai][0][m][0][q], acc[ai][1][m][0][q], -1.4426950408889634f, 1.f); b[q] = swiglu_fast(acc[ai][0][m][1][q], acc[ai][1][m][1][q], -1.4426950408889634f, 1.f); }
                *(GAS u32x4*)(HID + (size_t)row * ldc + col0) = pack8(a, b); } } };

struct EpiWinO { static constexpr bool PERM = true; unsigned char* ar;
    __device__ __forceinline__ void operator()(AccRef acc, const Unit& u, int wr, int wc, int fr, int fq) const { EPI_ROWS(u); const int pn = u.pn;
        if (pn == 18) { if (wc == 0 && fq < 2) { float* ALR = (float*)(ar + B_ALR);
#pragma unroll
                for (int ai = 0; ai < 2; ++ai)
#pragma unroll
                    for (int m = 0; m < 4; ++m) { float* rp = ALR + (size_t)(row0 + ai * 128 + m * 16) * 16 + 8 * fq; *(GAS f32x4*)rp = acc[ai][0][m][0]; *(GAS f32x4*)(rp + 4) = acc[ai][0][m][1]; } }
            return; }
        bf16* base; int ld, c0;
        if (pn < 2) { base = (bf16*)(ar + B_GQ); ld = 512; c0 = pn * 256; } else if (pn < 4) { base = (bf16*)(ar + B_GK); ld = 512; c0 = (pn - 2) * 256; }
        else if (pn < 8) { base = (bf16*)(ar + B_GV); ld = 1024; c0 = (pn - 4) * 256; } else if (pn < 12) { base = (bf16*)(ar + B_R); ld = 1024; c0 = (pn - 8) * 256; }
        else if (pn < 16) { base = (bf16*)(ar + B_AQ); ld = 1024; c0 = (pn - 12) * 256; } else if (pn == 16) { base = (bf16*)(ar + B_AK); ld = 256; c0 = 0; } else { base = (bf16*)(ar + B_AV); ld = 256; c0 = 0; }
        const int col0 = c0 + wc * 32 + 8 * fq;
#pragma unroll
        for (int ai = 0; ai < 2; ++ai)
#pragma unroll
            for (int m = 0; m < 4; ++m) { bf16* rp = base + (size_t)(row0 + ai * 128 + m * 16) * ld + col0;
#pragma unroll
                for (int bj = 0; bj < 2; ++bj) *(GAS u32x4*)(rp + bj * 128) = pack8(acc[ai][bj][m][0], acc[ai][bj][m][1]); } } };

__device__ __forceinline__ void ph_qknorm(Frame& F) {
    unsigned char* ar = F.ws + WS_ARENA; bf16* AQ = (bf16*)(ar + B_AQ); bf16* AK = (bf16*)(ar + B_AK);
    const float* qn = inp(I_QNORM); const float* kn = inp(I_KNORM); const f32x2* rope = (const f32x2*)(F.ws + WS_ROPE);
    const size_t NQ = (size_t)SEQ * 8 * 8, NK = (size_t)T * 2 * 8;
    for (size_t it = (size_t)F.vcu * NTHR + F.tid; it < NQ + NK; it += (size_t)F.G * NTHR) {
        const bool isq = it < NQ; const size_t r = isq ? it : it - NQ; const int j = (int)(r & 7), hf = j >> 2, sub = j & 3;
        int row, head; bf16* p; const float* nw;
        if (isq) { head = (int)((r >> 3) & 7); row = CTX + (int)(r >> 6); p = AQ + (size_t)row * 1024 + head * 128; nw = qn; }
        else { head = (int)((r >> 3) & 1); row = (int)(r >> 4); p = AK + (size_t)row * 256 + head * 128; nw = kn; }
        const int d1 = 64 * hf + 8 * sub, d2 = d1 + 32;
        const v4u a = *(const GAS v4u*)(p + d1), b = *(const GAS v4u*)(p + d2);
        float x1[8] = {bflo(a.x), bfhi(a.x), bflo(a.y), bfhi(a.y), bflo(a.z), bfhi(a.z), bflo(a.w), bfhi(a.w)};
        float x2[8] = {bflo(b.x), bfhi(b.x), bflo(b.y), bfhi(b.y), bflo(b.z), bfhi(b.z), bflo(b.w), bfhi(b.w)};
        float ss = 0.f;
#pragma unroll
        for (int e = 0; e < 8; ++e) ss += x1[e] * x1[e] + x2[e] * x2[e];
        ss += __shfl_xor(ss, 1); ss += __shfl_xor(ss, 2); ss += __shfl_xor(ss, 4);
        const float rstd = 1.f / sqrtf(ss * (1.f / 128.f) + EPS);
        const bool rot = row >= CTX; const int tl = row - CTX, pos = hf ? (tl & 63) : (tl >> 6);
        float o1[8], o2[8];
#pragma unroll
        for (int e = 0; e < 8; ++e) { const float y1 = x1[e] * rstd * nw[d1 + e], y2 = x2[e] * rstd * nw[d2 + e];
            f32x2 cs = {1.f, 0.f}; if (rot) cs = rope[pos * 32 + 8 * sub + e];
            o1[e] = y1 * cs.x - y2 * cs.y; o2[e] = y1 * cs.y + y2 * cs.x; }
        v4u w1, w2; w1.x = pk2(o1[0], o1[1]); w1.y = pk2(o1[2], o1[3]); w1.z = pk2(o1[4], o1[5]); w1.w = pk2(o1[6], o1[7]);
        w2.x = pk2(o2[0], o2[1]); w2.y = pk2(o2[2], o2[3]); w2.z = pk2(o2[4], o2[5]); w2.w = pk2(o2[6], o2[7]);
        *(GAS v4u*)(p + d1) = w1; *(GAS v4u*)(p + d2) = w2;
        if (!isq) {
            unsigned char* k8 = ar + B_KDT + (size_t)row * 256 + head * 128 + 64 * (sub & 1) + 8 * (4 * hf + (sub >> 1));
            v2u a8, b8; a8.x = pk4_fp8(o1[0], o1[1], o1[2], o1[3]); a8.y = pk4_fp8(o1[4], o1[5], o1[6], o1[7]); b8.x = pk4_fp8(o2[0], o2[1], o2[2], o2[3]); b8.y = pk4_fp8(o2[4], o2[5], o2[6], o2[7]);
            *(GAS v2u*)k8 = a8; *(GAS v2u*)(k8 + 16) = b8; }
    }
}

constexpr size_t VT8_OFF = 8 * MiB;
__device__ __forceinline__ void ph_vt8(Frame& F) {
    unsigned char* ar = F.ws + WS_ARENA; const bf16* AV = (const bf16*)(ar + B_AV); unsigned char* VT8 = ar + B_KDT + VT8_OFF;
    const int ntask = 2 * NCH * 128 * 4;
    for (int it = F.vcu * NTHR + F.tid; it < ntask; it += F.G * NTHR) {
        const int g = it & 3, d = (it >> 2) & 127, tl = (it >> 9) % NCH, kvh = (it >> 9) / NCH, hi = g >> 1, blk = g & 1;
        float x[16];
#pragma unroll
        for (int r = 0; r < 16; ++r) { const int key = 32 * blk + (r & 3) + 8 * (r >> 2) + 4 * hi; x[r] = bf2f(AV[(size_t)(tl * 64 + key) * 256 + kvh * 128 + d]); }
        v4u o; o.x = pk4_fp8(x[0], x[1], x[2], x[3]); o.y = pk4_fp8(x[4], x[5], x[6], x[7]); o.z = pk4_fp8(x[8], x[9], x[10], x[11]); o.w = pk4_fp8(x[12], x[13], x[14], x[15]);
        *(GAS v4u*)(VT8 + ((size_t)(kvh * NCH + tl) * 128 + d) * 64 + g * 16) = o;
    }
}

namespace tri {
using s16x4 = __attribute__((ext_vector_type(4))) short;
__device__ __forceinline__ int st(int k, int c) { const int kk = (k & ~0xC) | ((k & 4) << 1) | ((k & 8) >> 1); return ((kk >> 3) * 4 + (c >> 5)) * 512 + ((kk & 7) * 32 + (c & 31)) * 2; }
__device__ __forceinline__ int rd_base(int lane) { return ((lane & 3) << 3) | (((lane >> 2) & 3) << 6) | (((lane >> 4) & 1) << 5) | (((lane >> 5) & 1) << 8); }
constexpr int rd_off(int d0, int ks, int half) { return d0 * 512 + ks * 4096 + half * 2048; }
template <int OFF> __device__ __forceinline__ s16x4 tr_read(int vb) { s16x4 r; asm volatile("ds_read_b64_tr_b16 %0, %1 offset:%2" : "=&v"(r) : "v"(vb), "i"(OFF) : "memory"); return r; }
struct Frag2 { s16x4 lo, hi; };
template <int D0, int KS> __device__ __forceinline__ Frag2 ld(int vb) { Frag2 f; f.lo = tr_read<rd_off(D0, KS, 0)>(vb); f.hi = tr_read<rd_off(D0, KS, 1)>(vb); return f; }
__device__ __forceinline__ bf16x8 pk(const Frag2& f) { return (bf16x8){f.lo[0], f.lo[1], f.lo[2], f.lo[3], f.hi[0], f.hi[1], f.hi[2], f.hi[3]}; }
#define TRI_WAIT() do { asm volatile("s_waitcnt lgkmcnt(0)" ::: "memory"); __builtin_amdgcn_sched_barrier(0); } while (0)
}
typedef float f32x16 __attribute__((ext_vector_type(16)));
__device__ __forceinline__ int crow(int r, int hi) { return (r & 3) + 8 * (r >> 2) + 4 * hi; }

__device__ __forceinline__ float logsigmoidf_(float z) { return fminf(z, 0.f) - __logf(1.f + __expf(-fabsf(z))); }
__device__ __forceinline__ void gla_prepkv_unit(Frame& F, int c, int h) {
    unsigned char* ar = F.ws + WS_ARENA;
    const bf16* GQ = (const bf16*)(ar + B_GQ); const bf16* GK = (const bf16*)(ar + B_GK); const bf16* GV = (const bf16*)(ar + B_GV); const float* ALR = (const float*)(ar + B_ALR);
    LAS float* ALR_S = (LAS float*)(F.lds);
    LAS float* WA_S = (LAS float*)(F.lds + 4096);
    LAS float* BA_S = (LAS float*)(F.lds + 12288);
    LAS float* SEG_S = (LAS float*)(F.lds + 12800);
    LAS float* GB = (LAS float*)(F.lds + 14848);
    LAS unsigned char* QS = F.lds + 47616;
    LAS unsigned char* KS = F.lds + 64000;
    LAS unsigned char* VIMG = F.lds + 80384;
    LAS unsigned char* KIMG = F.lds + 113152;
    const int tid = F.tid, lane = F.lane, t0 = c * 64;
    __syncthreads();
    for (int i = tid; i < 1024; i += NTHR) ALR_S[i] = ALR[(size_t)t0 * 16 + i];
    for (int i = tid; i < 1024; i += NTHR) { const int r = i >> 4, k8 = (i & 15) * 8;
        *(LAS v4u*)(QS + (r * 128 + k8) * 2) = *(const GAS v4u*)(GQ + (size_t)(t0 + r) * 512 + h * 128 + k8); *(LAS v4u*)(KS + (r * 128 + k8) * 2) = *(const GAS v4u*)(GK + (size_t)(t0 + r) * 512 + h * 128 + k8); }
    for (int i = tid; i < 2048; i += NTHR) { const int r = i >> 5, v8 = (i & 31) * 8;
        *(LAS v4u*)(VIMG + (v8 >> 7) * 16384 + tri::st(r, v8 & 127)) = *(const GAS v4u*)(GV + (size_t)(t0 + r) * 1024 + h * 256 + v8); }
    for (int d = 0; d < 2; ++d) {
        const float* wa = inp(I_GLAWA) + (size_t)d * 16 * 512 + h * 128; const float* ba = inp(I_GLABA) + d * 512 + h * 128;
        __syncthreads();
        for (int i = tid; i < 2048; i += NTHR) WA_S[i] = wa[(size_t)(i >> 7) * 512 + (i & 127)];
        if (tid < 128) BA_S[tid] = ba[tid];
        __syncthreads();
        const int k = tid & 127, seg = tid >> 7;
        float gl[16];
        { float w[16];
#pragma unroll
          for (int r = 0; r < 16; ++r) w[r] = WA_S[r * 128 + k];
          const float b0 = BA_S[k];
#pragma unroll
          for (int ii = 0; ii < 16; ++ii) { const int i = seg * 16 + ii; float z = b0;
#pragma unroll
              for (int r = 0; r < 16; ++r) z += ALR_S[i * 16 + r] * w[r];
              gl[ii] = logsigmoidf_(z) * (1.f / 16.f); } }
        if (d == 0) {
#pragma unroll
            for (int ii = 1; ii < 16; ++ii) gl[ii] += gl[ii - 1];
            SEG_S[seg * 128 + k] = gl[15]; }
        else {
#pragma unroll
            for (int ii = 14; ii >= 0; --ii) gl[ii] += gl[ii + 1];
            SEG_S[seg * 128 + k] = gl[0]; }
        __syncthreads();
        const float s0 = SEG_S[k], s1 = SEG_S[128 + k], s2 = SEG_S[256 + k], s3 = SEG_S[384 + k], tot = (s0 + s1) + (s2 + s3);
        float off;
        if (d == 0) off = seg == 0 ? 0.f : (seg == 1 ? s0 : (seg == 2 ? s0 + s1 : s0 + s1 + s2));
        else off = seg == 3 ? 0.f : (seg == 2 ? s3 : (seg == 1 ? s3 + s2 : s3 + s2 + s1));
#pragma unroll
        for (int ii = 0; ii < 16; ++ii) GB[(seg * 16 + ii) * 128 + k] = gl[ii] + off;
        if (seg == 0) ((float*)(ar + B_DEC))[((size_t)(d * NCH + c) * 4 + h) * 128 + k] = __expf(tot);
        __syncthreads();
        { bf16* QE = (bf16*)(ar + B_QE) + (size_t)d * T * 512; bf16* KE = (bf16*)(ar + B_KE) + (size_t)d * T * 512;
          for (int i2 = tid; i2 < 1024; i2 += NTHR) { const int i = i2 >> 4, k8 = (i2 & 15) * 8; const v4u qw = *(const LAS v4u*)(QS + (i * 128 + k8) * 2), kw = *(const LAS v4u*)(KS + (i * 128 + k8) * 2);
              const f32x4 ba0 = *(const LAS f32x4*)(GB + i * 128 + k8), ba1 = *(const LAS f32x4*)(GB + i * 128 + k8 + 4);
              const f32x4 t0v = *(const LAS f32x4*)(SEG_S + k8), t1v = *(const LAS f32x4*)(SEG_S + 128 + k8), t2v = *(const LAS f32x4*)(SEG_S + 256 + k8), t3v = *(const LAS f32x4*)(SEG_S + 384 + k8);
              const f32x4 u0v = *(const LAS f32x4*)(SEG_S + k8 + 4), u1v = *(const LAS f32x4*)(SEG_S + 128 + k8 + 4), u2v = *(const LAS f32x4*)(SEG_S + 256 + k8 + 4), u3v = *(const LAS f32x4*)(SEG_S + 384 + k8 + 4);
              const f32x4 tt0 = (t0v + t1v) + (t2v + t3v), tt1 = (u0v + u1v) + (u2v + u3v);
              const float b[8] = {ba0[0], ba0[1], ba0[2], ba0[3], ba1[0], ba1[1], ba1[2], ba1[3]}; const float tt[8] = {tt0[0], tt0[1], tt0[2], tt0[3], tt1[0], tt1[1], tt1[2], tt1[3]};
              const unsigned qv[4] = {qw.x, qw.y, qw.z, qw.w}, kv[4] = {kw.x, kw.y, kw.z, kw.w}; float qe[8], ke[8], kd[8];
#pragma unroll
              for (int e = 0; e < 4; ++e) { const float q0 = bflo(qv[e]), q1 = bfhi(qv[e]), k0 = bflo(kv[e]), k1 = bfhi(kv[e]); const float e0 = __expf(b[2 * e]), e1 = __expf(b[2 * e + 1]);
                  const float r0 = __builtin_amdgcn_rcpf(e0), r1 = __builtin_amdgcn_rcpf(e1);
                  qe[2 * e] = q0 * 0.08838834764831845f * e0; qe[2 * e + 1] = q1 * 0.08838834764831845f * e1; ke[2 * e] = k0 * r0; ke[2 * e + 1] = k1 * r1;
                  kd[2 * e] = k0 * __expf(tt[2 * e] - b[2 * e]); kd[2 * e + 1] = k1 * __expf(tt[2 * e + 1] - b[2 * e + 1]); }
              v4u wq, wk, wd; wq.x = pk2(qe[0], qe[1]); wq.y = pk2(qe[2], qe[3]); wq.z = pk2(qe[4], qe[5]); wq.w = pk2(qe[6], qe[7]);
              wk.x = pk2(ke[0], ke[1]); wk.y = pk2(ke[2], ke[3]); wk.z = pk2(ke[4], ke[5]); wk.w = pk2(ke[6], ke[7]);
              wd.x = pk2(kd[0], kd[1]); wd.y = pk2(kd[2], kd[3]); wd.z = pk2(kd[4], kd[5]); wd.w = pk2(kd[6], kd[7]);
              *(GAS v4u*)(QE + (size_t)(t0 + i) * 512 + h * 128 + k8) = wq; *(GAS v4u*)(KE + (size_t)(t0 + i) * 512 + h * 128 + k8) = wk;
              *(LAS v4u*)(KIMG + tri::st(i, k8)) = wd; } }
        __syncthreads();
        {
            const int w = F.wave, r = lane & 31, hi = lane >> 5;
            const int kb_base = (int)(uintptr_t)KIMG + tri::rd_base(lane), vb_base = (int)(uintptr_t)VIMG + (w >> 2) * 16384 + (w & 3) * 512 + tri::rd_base(lane);
            const tri::Frag2 b0 = tri::ld<0, 0>(vb_base), b1 = tri::ld<0, 1>(vb_base), b2 = tri::ld<0, 2>(vb_base), b3 = tri::ld<0, 3>(vb_base);
            const tri::Frag2 a00 = tri::ld<0, 0>(kb_base), a01 = tri::ld<0, 1>(kb_base), a02 = tri::ld<0, 2>(kb_base), a03 = tri::ld<0, 3>(kb_base);
            const tri::Frag2 a10 = tri::ld<1, 0>(kb_base), a11 = tri::ld<1, 1>(kb_base), a12 = tri::ld<1, 2>(kb_base), a13 = tri::ld<1, 3>(kb_base);
            const tri::Frag2 a20 = tri::ld<2, 0>(kb_base), a21 = tri::ld<2, 1>(kb_base), a22 = tri::ld<2, 2>(kb_base), a23 = tri::ld<2, 3>(kb_base);
            const tri::Frag2 a30 = tri::ld<3, 0>(kb_base), a31 = tri::ld<3, 1>(kb_base), a32 = tri::ld<3, 2>(kb_base), a33 = tri::ld<3, 3>(kb_base);
            TRI_WAIT();
            const bf16x8 B0 = tri::pk(b0), B1 = tri::pk(b1), B2 = tri::pk(b2), B3 = tri::pk(b3);
            f32x16 acc[4] = {};
            acc[0] = __builtin_amdgcn_mfma_f32_32x32x16_bf16(tri::pk(a00), B0, acc[0], 0, 0, 0); acc[0] = __builtin_amdgcn_mfma_f32_32x32x16_bf16(tri::pk(a01), B1, acc[0], 0, 0, 0);
            acc[0] = __builtin_amdgcn_mfma_f32_32x32x16_bf16(tri::pk(a02), B2, acc[0], 0, 0, 0); acc[0] = __builtin_amdgcn_mfma_f32_32x32x16_bf16(tri::pk(a03), B3, acc[0], 0, 0, 0);
            acc[1] = __builtin_amdgcn_mfma_f32_32x32x16_bf16(tri::pk(a10), B0, acc[1], 0, 0, 0); acc[1] = __builtin_amdgcn_mfma_f32_32x32x16_bf16(tri::pk(a11), B1, acc[1], 0, 0, 0);
            acc[1] = __builtin_amdgcn_mfma_f32_32x32x16_bf16(tri::pk(a12), B2, acc[1], 0, 0, 0); acc[1] = __builtin_amdgcn_mfma_f32_32x32x16_bf16(tri::pk(a13), B3, acc[1], 0, 0, 0);
            acc[2] = __builtin_amdgcn_mfma_f32_32x32x16_bf16(tri::pk(a20), B0, acc[2], 0, 0, 0); acc[2] = __builtin_amdgcn_mfma_f32_32x32x16_bf16(tri::pk(a21), B1, acc[2], 0, 0, 0);
            acc[2] = __builtin_amdgcn_mfma_f32_32x32x16_bf16(tri::pk(a22), B2, acc[2], 0, 0, 0); acc[2] = __builtin_amdgcn_mfma_f32_32x32x16_bf16(tri::pk(a23), B3, acc[2], 0, 0, 0);
            acc[3] = __builtin_amdgcn_mfma_f32_32x32x16_bf16(tri::pk(a30), B0, acc[3], 0, 0, 0); acc[3] = __builtin_amdgcn_mfma_f32_32x32x16_bf16(tri::pk(a31), B1, acc[3], 0, 0, 0);
            acc[3] = __builtin_amdgcn_mfma_f32_32x32x16_bf16(tri::pk(a32), B2, acc[3], 0, 0, 0); acc[3] = __builtin_amdgcn_mfma_f32_32x32x16_bf16(tri::pk(a33), B3, acc[3], 0, 0, 0);
            bf16* ST = (bf16*)(ar + B_ST) + ((size_t)(d * NCH + c) * 4 + h) * 256 * 128;
#pragma unroll
            for (int kb = 0; kb < 4; ++kb)
#pragma unroll
                for (int q4 = 0; q4 < 4; ++q4) { v2u o; o.x = pk2(acc[kb][4 * q4], acc[kb][4 * q4 + 1]); o.y = pk2(acc[kb][4 * q4 + 2], acc[kb][4 * q4 + 3]);
                    *(GAS v2u*)(ST + (size_t)(32 * w + r) * 128 + 32 * kb + 8 * q4 + 4 * hi) = o; }
        }
    }
}

__device__ __forceinline__ void ph_gla_scan(Frame& F) {
    unsigned char* ar = F.ws + WS_ARENA; const float* DEC = (const float*)(ar + B_DEC);
    for (int gth = blockIdx.x * NTHR + F.tid; gth < 2 * 4 * 256 * 64; gth += F.G * NTHR) {
        const int kp = gth & 63, v = (gth >> 6) & 255, h = (gth >> 14) & 3, d = gth >> 16;
        unsigned* ST = (unsigned*)(ar + B_ST) + ((((size_t)d * NCH) * 4 + h) * 256 + v) * 64 + kp;
        const f32x2* DC = (const f32x2*)DEC + (((size_t)d * NCH) * 4 + h) * 64 + kp;
        float s0 = 0.f, s1 = 0.f;
        for (int i0 = 0; i0 < NCH; i0 += 4) { int cc[4]; unsigned kv[4]; f32x2 dc[4];
#pragma unroll
            for (int q = 0; q < 4; ++q) { const int i = i0 + q; cc[q] = d == 0 ? i : (i < NCH_CTX ? NCH_CTX - 1 - i : NCH - 1 - (i - NCH_CTX));
                kv[q] = ST[(size_t)cc[q] * (4 * 256 * 64)]; dc[q] = DC[(size_t)cc[q] * (4 * 64)]; }
#pragma unroll
            for (int q = 0; q < 4; ++q) { ST[(size_t)cc[q] * (4 * 256 * 64)] = pk2(s0, s1); s0 = dc[q].x * s0 + bflo(kv[q]); s1 = dc[q].y * s1 + bfhi(kv[q]); } }
    }
}

__device__ __forceinline__ void gla_out_unit(Frame& F, int cl, int h) {
    unsigned char* ar = F.ws + WS_ARENA; const int c = cl + NCH_CTX, t0 = c * 64;
    LAS unsigned char* ATT = F.lds;
    LAS float* OS = (LAS float*)(F.lds + 18432);
    LAS unsigned char* VIMG = F.lds + 86016;
    const int lane = F.lane, r = lane & 31, hi = lane >> 5, w = F.wave;
    __syncthreads();
    { const bf16* GV = (const bf16*)(ar + B_GV);
      for (int i = F.tid; i < 2048; i += NTHR) { const int rr = i >> 5, v8 = (i & 31) * 8;
          *(LAS v4u*)(VIMG + (v8 >> 7) * 16384 + tri::st(rr, v8 & 127)) = *(const GAS v4u*)(GV + (size_t)(t0 + rr) * 1024 + h * 256 + v8); } }
    {
        const int d = w >> 2, ib = (w >> 1) & 1, jb = w & 1;
        const bf16* QE = (const bf16*)(ar + B_QE) + (size_t)d * T * 512 + (size_t)(t0 + ib * 32 + r) * 512 + h * 128 + 8 * hi;
        const bf16* KE = (const bf16*)(ar + B_KE) + (size_t)d * T * 512 + (size_t)(t0 + jb * 32 + r) * 512 + h * 128 + 8 * hi;
        bf16x8 a[8], b[8];
#pragma unroll
        for (int s = 0; s < 8; ++s) { a[s] = *(const GAS bf16x8*)(KE + 16 * s); b[s] = *(const GAS bf16x8*)(QE + 16 * s); }
        f32x16 acc = {};
#pragma unroll
        for (int s = 0; s < 8; ++s) acc = __builtin_amdgcn_mfma_f32_32x32x16_bf16(a[s], b[s], acc, 0, 0, 0);
        const int i = ib * 32 + r;
#pragma unroll
        for (int q4 = 0; q4 < 4; ++q4) { float x[4];
#pragma unroll
            for (int e = 0; e < 4; ++e) { const int j = jb * 32 + 8 * q4 + 4 * hi + e; const bool keep = d == 0 ? (j <= i) : (j >= i); x[e] = keep ? acc[4 * q4 + e] : 0.f; }
            v2u o; o.x = pk2(x[0], x[1]); o.y = pk2(x[2], x[3]);
            *(LAS v2u*)(ATT + ((size_t)(d * 64 + i) * 72 + jb * 32 + 8 * q4 + 4 * hi) * 2) = o; }
    }
    __syncthreads();
    {
        const int ib = w >> 2, vq = w & 3; f32x16 o0 = {}, o1 = {};
        const int vb_base = (int)(uintptr_t)VIMG + (vq >> 1) * 16384 + (2 * (vq & 1)) * 512 + tri::rd_base(lane);
        const tri::Frag2 p0 = tri::ld<0, 0>(vb_base), p1 = tri::ld<0, 1>(vb_base), p2 = tri::ld<0, 2>(vb_base), p3 = tri::ld<0, 3>(vb_base);
        const tri::Frag2 q0 = tri::ld<1, 0>(vb_base), q1 = tri::ld<1, 1>(vb_base), q2 = tri::ld<1, 2>(vb_base), q3 = tri::ld<1, 3>(vb_base);
        TRI_WAIT();
        const bf16x8 vb0[4] = {tri::pk(p0), tri::pk(p1), tri::pk(p2), tri::pk(p3)}, vb1[4] = {tri::pk(q0), tri::pk(q1), tri::pk(q2), tri::pk(q3)};
#pragma unroll
        for (int d = 0; d < 2; ++d) {
            bf16x8 a[4];
#pragma unroll
            for (int s = 0; s < 4; ++s) a[s] = *(const LAS bf16x8*)(ATT + ((size_t)(d * 64 + ib * 32 + r) * 72 + 16 * s + 8 * hi) * 2);
#pragma unroll
            for (int s = 0; s < 4; ++s) { o0 = __builtin_amdgcn_mfma_f32_32x32x16_bf16(a[s], vb0[s], o0, 0, 0, 0); o1 = __builtin_amdgcn_mfma_f32_32x32x16_bf16(a[s], vb1[s], o1, 0, 0, 0); }
            const bf16* QE = (const bf16*)(ar + B_QE) + (size_t)d * T * 512 + (size_t)(t0 + ib * 32 + r) * 512 + h * 128 + 8 * hi;
            const bf16* ST = (const bf16*)(ar + B_ST) + ((size_t)(d * NCH + c) * 4 + h) * 256 * 128 + (size_t)(64 * vq + r) * 128 + 8 * hi;
            bf16x8 qa[8], s0[8], s1[8];
#pragma unroll
            for (int s = 0; s < 8; ++s) { qa[s] = *(const GAS bf16x8*)(QE + 16 * s); s0[s] = *(const GAS bf16x8*)(ST + 16 * s); s1[s] = *(const GAS bf16x8*)(ST + 32 * 128 + 16 * s); }
#pragma unroll
            for (int s = 0; s < 8; ++s) { o0 = __builtin_amdgcn_mfma_f32_32x32x16_bf16(qa[s], s0[s], o0, 0, 0, 0); o1 = __builtin_amdgcn_mfma_f32_32x32x16_bf16(qa[s], s1[s], o1, 0, 0, 0); }
        }
#pragma unroll
        for (int q = 0; q < 16; ++q) { const int i = ib * 32 + crow(q, hi); OS[i * 260 + 64 * vq + r] = o0[q]; OS[i * 260 + 64 * vq + 32 + r] = o1[q]; }
    }
    __syncthreads();
    {
        const int i = F.tid >> 3, seg = F.tid & 7; const LAS float* op = OS + i * 260 + 32 * seg; f32x4 x[8]; float ss = 0.f;
#pragma unroll
        for (int e = 0; e < 8; ++e) { x[e] = *(const LAS f32x4*)(op + 4 * e); ss += (x[e][0] * x[e][0] + x[e][1] * x[e][1]) + (x[e][2] * x[e][2] + x[e][3] * x[e][3]); }
        ss += __shfl_xor(ss, 1); ss += __shfl_xor(ss, 2); ss += __shfl_xor(ss, 4);
        const float rstd = 1.f / sqrtf(ss * (1.f / 256.f) + EPS);
        const float* gn = inp(I_GLANORM) + h * 256 + 32 * seg; const bf16* R = (const bf16*)(ar + B_R) + (size_t)(t0 + i) * 1024 + h * 256 + 32 * seg;
        bf16* YM = (bf16*)(ar + B_YMIX1) + (size_t)(t0 - CTX + i) * D + h * 256 + 32 * seg;
#pragma unroll
        for (int e2 = 0; e2 < 4; ++e2) { const v4u rr = *(const GAS v4u*)(R + 8 * e2); const f32x4 g0 = *(const GAS f32x4*)(gn + 8 * e2), g1 = *(const GAS f32x4*)(gn + 8 * e2 + 4);
            const f32x4 a = x[2 * e2] * rstd * g0, b = x[2 * e2 + 1] * rstd * g1; v4u o;
            o.x = pk2(a[0] * siluf_(bflo(rr.x)), a[1] * siluf_(bfhi(rr.x))); o.y = pk2(a[2] * siluf_(bflo(rr.y)), a[3] * siluf_(bfhi(rr.y)));
            o.z = pk2(b[0] * siluf_(bflo(rr.z)), b[1] * siluf_(bfhi(rr.z))); o.w = pk2(b[2] * siluf_(bflo(rr.w)), b[3] * siluf_(bfhi(rr.w)));
            *(GAS v4u*)(YM + 8 * e2) = o; }
    }
}

namespace att {
constexpr int HD = 128, NW = 8, QBLK = 32, KVBLK = 64;
constexpr float SCALE = 0.088388347648318440f;
constexpr float THR = 8.f;
constexpr int LDQ = 1024, LDK = 256, LDO = 2048;
constexpr size_t SHM_V = KVBLK * HD * 2, SHM_K = KVBLK * HD * 2, SHM_ATTN = 2 * SHM_V + 2 * SHM_K + NW * 64 * 4;
using s16x4 = __attribute__((ext_vector_type(4))) short;
#define KSWZ(row, colB) ((row) * 256 + ((colB) ^ (((row) & 7) << 4)))
#define SBAR() __builtin_amdgcn_sched_barrier(0)
__device__ __forceinline__ unsigned cvtpk(float lo, float hi) { unsigned r; asm volatile("v_cvt_pk_bf16_f32 %0, %1, %2" : "=v"(r) : "v"(lo), "v"(hi)); return r; }
__device__ __forceinline__ void partialSM(f32x16& p0, f32x16& p1, float& m_reg, float& mn, float& alpha) {
  constexpr float C = SCALE * 1.4426950408889634f;
  float pmax = p0[0];
#pragma unroll
  for (int r = 1; r < 16; ++r) pmax = fmaxf(pmax, p0[r]);
#pragma unroll
  for (int r = 0; r < 16; ++r) pmax = fmaxf(pmax, p1[r]);
  { auto rr = __builtin_amdgcn_permlane32_swap(__float_as_uint(pmax), __float_as_uint(pmax), false, false);
    pmax = fmaxf(__uint_as_float(rr[0]), __uint_as_float(rr[1])); }
  if (__builtin_expect(__all(pmax - m_reg <= THR / SCALE), 1)) { mn = m_reg; alpha = 1.f; }
  else { mn = fmaxf(m_reg, pmax); alpha = __builtin_amdgcn_exp2f((m_reg - mn) * C); m_reg = mn; }
  float mnC = -mn * C;
#pragma unroll
  for (int r = 0; r < 16; ++r) p0[r] = fmaf(p0[r], C, mnC);
#pragma unroll
  for (int r = 0; r < 16; ++r) p1[r] = fmaf(p1[r], C, mnC);
#pragma unroll
  for (int r = 0; r < 16; ++r) p0[r] = __builtin_amdgcn_exp2f(p0[r]);
}
__device__ __forceinline__ void finishSM(f32x16& p0, f32x16& p1, float alpha, float& l_reg, bf16x8& pa0, bf16x8& pa1, bf16x8& pa2, bf16x8& pa3) {
#pragma unroll
  for (int r = 0; r < 16; ++r) p1[r] = __builtin_amdgcn_exp2f(p1[r]);
  float ps = 0;
#pragma unroll
  for (int r = 0; r < 16; ++r) ps += p0[r];
#pragma unroll
  for (int r = 0; r < 16; ++r) ps += p1[r];
  { auto rr = __builtin_amdgcn_permlane32_swap(__float_as_uint(ps), __float_as_uint(ps), false, false);
    ps = __uint_as_float(rr[0]) + __uint_as_float(rr[1]); }
  l_reg = l_reg * alpha + ps;
#define PK4(P, BASE, OUT) do { unsigned a0 = cvtpk(P[BASE + 0], P[BASE + 1]), a1 = cvtpk(P[BASE + 2], P[BASE + 3]);   \
    unsigned b0 = cvtpk(P[BASE + 4], P[BASE + 5]), b1 = cvtpk(P[BASE + 6], P[BASE + 7]);                              \
    auto r0 = __builtin_amdgcn_permlane32_swap(a0, b0, false, false); auto r1 = __builtin_amdgcn_permlane32_swap(a1, b1, false, false); \
    u32x4 w = {r0[0], r1[0], r0[1], r1[1]}; OUT = *reinterpret_cast<bf16x8*>(&w); } while (0)
  PK4(p0, 0, pa0); PK4(p0, 8, pa1); PK4(p1, 0, pa2); PK4(p1, 8, pa3);
#undef PK4
}
__device__ __forceinline__ void qkt(f32x16& p0, f32x16& p1, const bf16* Ks, const bf16x8* qr, int r32, int hi) {
  p0 = f32x16{}; p1 = f32x16{};
#pragma unroll
  for (int d0 = 0; d0 < 8; ++d0) { int cb = (d0 * 16 + hi * 8) * 2;
    bf16x8 b0 = *reinterpret_cast<const bf16x8*>((const char*)Ks + KSWZ(r32, cb));
    bf16x8 b1 = *reinterpret_cast<const bf16x8*>((const char*)Ks + KSWZ(32 + r32, cb));
    p0 = __builtin_amdgcn_mfma_f32_32x32x16_bf16(b0, qr[d0], p0, 0, 0, 0);
    p1 = __builtin_amdgcn_mfma_f32_32x32x16_bf16(b1, qr[d0], p1, 0, 0, 0); }
}
__device__ __forceinline__ int v_st(int k, int c) { const int kk = (k & ~0xC) | ((k & 4) << 1) | ((k & 8) >> 1); return ((kk >> 3) * 4 + (c >> 5)) * 512 + ((kk & 7) * 32 + (c & 31)) * 2; }
__device__ __forceinline__ int v_rd_base(int lane) { return ((lane & 3) << 3) | (((lane >> 2) & 3) << 6) | (((lane >> 4) & 1) << 5) | (((lane >> 5) & 1) << 8); }
constexpr int v_rd_off(int d0, int ks, int half) { return d0 * 512 + ks * 4096 + half * 2048; }
template <int OFF> __device__ __forceinline__ s16x4 tr_read(int vb) {
  s16x4 r; asm volatile("ds_read_b64_tr_b16 %0, %1 offset:%2" : "=&v"(r) : "v"(vb), "i"(OFF) : "memory"); return r;
}
template <int D0> __device__ __forceinline__ void pv_one(f32x16& od, int vb, bf16x8 pa0, bf16x8 pa1, bf16x8 pa2, bf16x8 pa3) {
  const s16x4 l0 = tr_read<v_rd_off(D0, 0, 0)>(vb), h0 = tr_read<v_rd_off(D0, 0, 1)>(vb), l1 = tr_read<v_rd_off(D0, 1, 0)>(vb), h1 = tr_read<v_rd_off(D0, 1, 1)>(vb);
  const s16x4 l2 = tr_read<v_rd_off(D0, 2, 0)>(vb), h2 = tr_read<v_rd_off(D0, 2, 1)>(vb), l3 = tr_read<v_rd_off(D0, 3, 0)>(vb), h3 = tr_read<v_rd_off(D0, 3, 1)>(vb);
  asm volatile("s_waitcnt lgkmcnt(0)" ::: "memory"); SBAR();
#define PK(L, H) (bf16x8){L[0], L[1], L[2], L[3], H[0], H[1], H[2], H[3]}
  od = __builtin_amdgcn_mfma_f32_32x32x16_bf16(pa0, PK(l0, h0), od, 0, 0, 0);
  od = __builtin_amdgcn_mfma_f32_32x32x16_bf16(pa1, PK(l1, h1), od, 0, 0, 0);
  od = __builtin_amdgcn_mfma_f32_32x32x16_bf16(pa2, PK(l2, h2), od, 0, 0, 0);
  od = __builtin_amdgcn_mfma_f32_32x32x16_bf16(pa3, PK(l3, h3), od, 0, 0, 0);
#undef PK
}
__device__ __forceinline__ void pv_d0(f32x16* o, int vb, bf16x8 pa0, bf16x8 pa1, bf16x8 pa2, bf16x8 pa3) {
  pv_one<0>(o[0], vb, pa0, pa1, pa2, pa3); pv_one<1>(o[1], vb, pa0, pa1, pa2, pa3); pv_one<2>(o[2], vb, pa0, pa1, pa2, pa3); pv_one<3>(o[3], vb, pa0, pa1, pa2, pa3);
}
typedef int v8i __attribute__((ext_vector_type(8)));
typedef int v4i __attribute__((ext_vector_type(4)));
constexpr size_t SHM_K8 = KVBLK * 128;
#define K8ADDR(row, g) ((row) * 128 + ((((g) ^ ((row) >> 1)) & 7) << 4))
__device__ __forceinline__ void qkt8(f32x16& p0, f32x16& p1, const char* Ks, const v8i& q0, const v8i& q1, int r32, int hi, int sc1) {
  p0 = f32x16{}; p1 = f32x16{};
  const int g0 = 4 * hi;
  { const v4i a00 = *reinterpret_cast<const v4i*>(Ks + K8ADDR(r32, g0)), a01 = *reinterpret_cast<const v4i*>(Ks + K8ADDR(r32, g0 + 1));
    const v4i b00 = *reinterpret_cast<const v4i*>(Ks + K8ADDR(32 + r32, g0)), b01 = *reinterpret_cast<const v4i*>(Ks + K8ADDR(32 + r32, g0 + 1));
    const v8i ka0 = __builtin_shufflevector(a00, a01, 0, 1, 2, 3, 4, 5, 6, 7), kb0 = __builtin_shufflevector(b00, b01, 0, 1, 2, 3, 4, 5, 6, 7);
    asm volatile("s_nop 1\n\tv_mfma_scale_f32_32x32x64_f8f6f4 %0, %1, %2, %0, %3, %3 op_sel_hi:[0,0,0]" : "+v"(p0) : "v"(ka0), "v"(q0), "v"(sc1));
    asm volatile("s_nop 1\n\tv_mfma_scale_f32_32x32x64_f8f6f4 %0, %1, %2, %0, %3, %3 op_sel_hi:[0,0,0]" : "+v"(p1) : "v"(kb0), "v"(q0), "v"(sc1) : "memory"); }
  { const v4i a10 = *reinterpret_cast<const v4i*>(Ks + K8ADDR(r32, g0 + 2)), a11 = *reinterpret_cast<const v4i*>(Ks + K8ADDR(r32, g0 + 3));
    const v4i b10 = *reinterpret_cast<const v4i*>(Ks + K8ADDR(32 + r32, g0 + 2)), b11 = *reinterpret_cast<const v4i*>(Ks + K8ADDR(32 + r32, g0 + 3));
    const v8i ka1 = __builtin_shufflevector(a10, a11, 0, 1, 2, 3, 4, 5, 6, 7), kb1 = __builtin_shufflevector(b10, b11, 0, 1, 2, 3, 4, 5, 6, 7);
    asm volatile("s_nop 1\n\tv_mfma_scale_f32_32x32x64_f8f6f4 %0, %1, %2, %0, %3, %3 op_sel_hi:[0,0,0]" : "+v"(p0) : "v"(ka1), "v"(q1), "v"(sc1));
    asm volatile("s_nop 1\n\tv_mfma_scale_f32_32x32x64_f8f6f4 %0, %1, %2, %0, %3, %3 op_sel_hi:[0,0,0]" : "+v"(p1) : "v"(kb1), "v"(q1), "v"(sc1)); }
  asm volatile("s_nop 15\n\ts_nop 7" : "+v"(p0), "+v"(p1));
}
__device__ __forceinline__ void attn_dense_body(const bf16* __restrict__ Qb, const unsigned char* __restrict__ Kh8, const bf16* __restrict__ Vh, bf16* __restrict__ Ob, int seq, char* lds) {
  constexpr int SDEPTH = 2;
  const int tid = threadIdx.x, wid = tid >> 6, lane = tid & 63, r32 = lane & 31, hi = lane >> 5;
  bf16* V_lds = (bf16*)lds; char* K_lds = lds + 2 * SHM_V;
  float* ws = (float*)(lds + 2 * SHM_V + 2 * SHM_K8) + wid * 64; float* li_l = ws; float* al_l = ws + 32;
  float m_reg = -1e30f, l_reg = 0; f32x16 o[4] = {}; bf16x8 qr[8];
  const bf16* Qw = Qb + (long)(wid * QBLK + r32) * LDQ + hi * 8;
#pragma unroll
  for (int d0 = 0; d0 < 8; ++d0) qr[d0] = *reinterpret_cast<const bf16x8*>(Qw + d0 * 16);
  v8i q8a, q8b; const int sc1 = 0x7f7f7f7f;
  { int w[16];
#pragma unroll
    for (int d0 = 0; d0 < 8; ++d0) { const u32x4 x = *reinterpret_cast<const u32x4*>(&qr[d0]);
      w[2 * d0] = (int)pk4_fp8(bflo(x.x), bfhi(x.x), bflo(x.y), bfhi(x.y)); w[2 * d0 + 1] = (int)pk4_fp8(bflo(x.z), bfhi(x.z), bflo(x.w), bfhi(x.w)); }
    q8a = (v8i){w[0], w[1], w[2], w[3], w[4], w[5], w[6], w[7]}; q8b = (v8i){w[8], w[9], w[10], w[11], w[12], w[13], w[14], w[15]}; }
  const int krow = tid >> 3, kg = tid & 7, kst = K8ADDR(krow, kg);
  const int sr = tid >> 4, sc = (tid & 15) * 8, vst0 = v_st(sr, sc), vst1 = v_st(32 + sr, sc);
  const int vb0 = (int)(uintptr_t)V_lds + v_rd_base(lane);
  struct { bf16x8 vs0, vs1; v4i ks; } sr_[SDEPTH];
#define SLOAD(i, k0) do { sr_[i].vs0 = *reinterpret_cast<const bf16x8*>(&Vh[(long)((k0) + sr) * LDK + sc]); sr_[i].vs1 = *reinterpret_cast<const bf16x8*>(&Vh[(long)((k0) + 32 + sr) * LDK + sc]); \
    sr_[i].ks = *reinterpret_cast<const v4i*>(&Kh8[(long)((k0) + krow) * 256 + kg * 16]); } while (0)
#define SWRITE(b, i) do { *(bf16x8*)((char*)V_lds + (b) * SHM_V + vst0) = sr_[i].vs0;          \
    *(bf16x8*)((char*)V_lds + (b) * SHM_V + vst1) = sr_[i].vs1;                                \
    *(v4i*)(K_lds + (b) * SHM_K8 + kst) = sr_[i].ks; } while (0)
#define SWAIT() do { asm volatile("s_waitcnt vmcnt(3)" ::: "memory"); } while (0)
#define RESC(a) do { if (__any((a) < 1.f)) { if (hi == 0) al_l[r32] = (a); asm volatile("s_waitcnt lgkmcnt(0)" ::: "memory"); \
    _Pragma("unroll") for (int d = 0; d < 4; ++d) _Pragma("unroll") for (int r = 0; r < 16; ++r) o[d][r] *= al_l[crow(r, hi)]; } } while (0)
  f32x16 pA0, pA1, pB0, pB1; float mnA, mnB, alA, alB; bf16x8 pa0, pa1, pa2, pa3; const int NT = seq / KVBLK;
  constexpr int SE = 0, SO = SDEPTH - 1;
  SLOAD(SE, 0); asm volatile("s_waitcnt vmcnt(0)" ::: "memory"); SWRITE(0, SE); __syncthreads();
  qkt8(pA0, pA1, K_lds, q8a, q8b, r32, hi, sc1); partialSM(pA0, pA1, m_reg, mnA, alA);
  SLOAD(SO, KVBLK); if (2 < NT) SLOAD(SE, 2 * KVBLK);
  SWAIT(); SWRITE(1, SO); __syncthreads();
  for (int j = 1; j + 1 < NT; j += 2) {
    SBAR(); qkt8(pB0, pB1, K_lds + SHM_K8, q8a, q8b, r32, hi, sc1);
    finishSM(pA0, pA1, alA, l_reg, pa0, pa1, pa2, pa3); SBAR();
    SLOAD(SO, (j + SDEPTH) * KVBLK); SBAR();
    pv_d0(o, vb0, pa0, pa1, pa2, pa3); partialSM(pB0, pB1, m_reg, mnB, alB);
    __syncthreads(); SWAIT(); SWRITE(0, SE);
    RESC(alB); __syncthreads();
    SBAR(); qkt8(pA0, pA1, K_lds, q8a, q8b, r32, hi, sc1);
    finishSM(pB0, pB1, alB, l_reg, pa0, pa1, pa2, pa3); SBAR();
    if (j + 3 < NT) SLOAD(SE, (j + 1 + SDEPTH) * KVBLK); SBAR();
    pv_d0(o, vb0 + (int)SHM_V, pa0, pa1, pa2, pa3); partialSM(pA0, pA1, m_reg, mnA, alA);
    __syncthreads(); SWAIT(); SWRITE(1, SO);
    RESC(alA); __syncthreads();
  }
  SBAR(); qkt8(pB0, pB1, K_lds + SHM_K8, q8a, q8b, r32, hi, sc1);
  finishSM(pA0, pA1, alA, l_reg, pa0, pa1, pa2, pa3); SBAR();
  pv_d0(o, vb0, pa0, pa1, pa2, pa3); partialSM(pB0, pB1, m_reg, mnB, alB);
  __syncthreads(); RESC(alB);
  finishSM(pB0, pB1, alB, l_reg, pa0, pa1, pa2, pa3); SBAR();
  pv_d0(o, vb0 + (int)SHM_V, pa0, pa1, pa2, pa3);
  if (hi == 0) li_l[r32] = l_reg; asm volatile("s_waitcnt lgkmcnt(0)" ::: "memory");
  float rli[16];
#pragma unroll
  for (int r = 0; r < 16; ++r) rli[r] = __builtin_amdgcn_rcpf(li_l[crow(r, hi)]);
  bf16* Ow = Ob + (long)(wid * QBLK) * LDO;
#pragma unroll
  for (int r = 0; r < 16; ++r) { int orow = crow(r, hi);
#pragma unroll
    for (int d0 = 0; d0 < 4; ++d0) Ow[(long)orow * LDO + d0 * 32 + r32] = (bf16)f2bf(o[d0][r] * rli[r]); }
  __syncthreads();
#undef SLOAD
#undef SWRITE
#undef SWAIT
#undef RESC
}
constexpr float THR8 = 6.f;
#define V8ADDR(d, g) ((d) * 64 + ((((g) ^ ((d) >> 2)) & 3) << 4))
__device__ __forceinline__ void partialSM8(f32x16& p0, f32x16& p1, float& m_reg, float& mn, float& alpha) {
  constexpr float C = SCALE * 1.4426950408889634f;
  float pmax = p0[0];
#pragma unroll
  for (int r = 1; r < 16; ++r) pmax = fmaxf(pmax, p0[r]);
#pragma unroll
  for (int r = 0; r < 16; ++r) pmax = fmaxf(pmax, p1[r]);
  { auto rr = __builtin_amdgcn_permlane32_swap(__float_as_uint(pmax), __float_as_uint(pmax), false, false);
    pmax = fmaxf(__uint_as_float(rr[0]), __uint_as_float(rr[1])); }
  if (__builtin_expect(__all(pmax - m_reg <= THR8 / SCALE), 1)) { mn = m_reg; alpha = 1.f; }
  else { mn = fmaxf(m_reg, pmax); alpha = __builtin_amdgcn_exp2f((m_reg - mn) * C); m_reg = mn; }
  float mnC = -mn * C;
#pragma unroll
  for (int r = 0; r < 16; ++r) p0[r] = fmaf(p0[r], C, mnC);
#pragma unroll
  for (int r = 0; r < 16; ++r) p1[r] = fmaf(p1[r], C, mnC);
#pragma unroll
  for (int r = 0; r < 16; ++r) p0[r] = __builtin_amdgcn_exp2f(p0[r]);
}
__device__ __forceinline__ void finishSM8(f32x16& p0, f32x16& p1, float alpha, float& l_reg, v8i& pa) {
#pragma unroll
  for (int r = 0; r < 16; ++r) p1[r] = __builtin_amdgcn_exp2f(p1[r]);
  float ps = 0;
#pragma unroll
  for (int r = 0; r < 16; ++r) ps += p0[r];
#pragma unroll
  for (int r = 0; r < 16; ++r) ps += p1[r];
  { auto rr = __builtin_amdgcn_permlane32_swap(__float_as_uint(ps), __float_as_uint(ps), false, false);
    ps = __uint_as_float(rr[0]) + __uint_as_float(rr[1]); }
  l_reg = l_reg * alpha + ps;
  pa = (v8i){(int)pk4_fp8(p0[0], p0[1], p0[2], p0[3]), (int)pk4_fp8(p0[4], p0[5], p0[6], p0[7]), (int)pk4_fp8(p0[8], p0[9], p0[10], p0[11]), (int)pk4_fp8(p0[12], p0[13], p0[14], p0[15]),
             (int)pk4_fp8(p1[0], p1[1], p1[2], p1[3]), (int)pk4_fp8(p1[4], p1[5], p1[6], p1[7]), (int)pk4_fp8(p1[8], p1[9], p1[10], p1[11]), (int)pk4_fp8(p1[12], p1[13], p1[14], p1[15])};
}
__device__ __forceinline__ void pv8(f32x16* o, const char* Vs, const v8i& pa, int r32, int hi, int sc1) {
#pragma unroll
  for (int d0 = 0; d0 < 4; ++d0) { const int d = 32 * d0 + r32;
    const v4i x0 = *reinterpret_cast<const v4i*>(Vs + V8ADDR(d, 2 * hi)), x1 = *reinterpret_cast<const v4i*>(Vs + V8ADDR(d, 2 * hi + 1));
    const v8i vb = __builtin_shufflevector(x0, x1, 0, 1, 2, 3, 4, 5, 6, 7);
    asm volatile("s_nop 1\n\tv_mfma_scale_f32_32x32x64_f8f6f4 %0, %1, %2, %0, %3, %3 op_sel_hi:[0,0,0]" : "+v"(o[d0]) : "v"(pa), "v"(vb), "v"(sc1)); }
  asm volatile("s_nop 15\n\ts_nop 7" : "+v"(o[0]), "+v"(o[1]), "+v"(o[2]), "+v"(o[3]));
}
__device__ __forceinline__ void attn_dense_body_pv8(const bf16* __restrict__ Qb, const unsigned char* __restrict__ Kh8, const unsigned char* __restrict__ Vt8, bf16* __restrict__ Ob, int seq, char* lds) {
  constexpr int SDEPTH = 2; constexpr size_t SHM_V8 = 8192;
  const int tid = threadIdx.x, wid = tid >> 6, lane = tid & 63, r32 = lane & 31, hi = lane >> 5;
  char* V_lds = lds; char* K_lds = lds + 2 * SHM_V8;
  float* ws = (float*)(lds + 2 * SHM_V8 + 2 * SHM_K8) + wid * 64; float* li_l = ws; float* al_l = ws + 32;
  float m_reg = -1e30f, l_reg = 0; f32x16 o[4] = {}; bf16x8 qr[8];
  const bf16* Qw = Qb + (long)(wid * QBLK + r32) * LDQ + hi * 8;
#pragma unroll
  for (int d0 = 0; d0 < 8; ++d0) qr[d0] = *reinterpret_cast<const bf16x8*>(Qw + d0 * 16);
  v8i q8a, q8b; const int sc1 = 0x7f7f7f7f;
  { int w[16];
#pragma unroll
    for (int d0 = 0; d0 < 8; ++d0) { const u32x4 x = *reinterpret_cast<const u32x4*>(&qr[d0]);
      w[2 * d0] = (int)pk4_fp8(bflo(x.x), bfhi(x.x), bflo(x.y), bfhi(x.y)); w[2 * d0 + 1] = (int)pk4_fp8(bflo(x.z), bfhi(x.z), bflo(x.w), bfhi(x.w)); }
    q8a = (v8i){w[0], w[1], w[2], w[3], w[4], w[5], w[6], w[7]}; q8b = (v8i){w[8], w[9], w[10], w[11], w[12], w[13], w[14], w[15]}; }
  const int krow = tid >> 3, kg = tid & 7, kst = K8ADDR(krow, kg);
  const int vrow = tid >> 2, vg = tid & 3, vst = V8ADDR(vrow, vg);
  struct { v4i vs, ks; } sr_[SDEPTH];
#define SLOAD(i, k0) do { sr_[i].vs = *reinterpret_cast<const v4i*>(&Vt8[(long)((k0) / KVBLK) * 8192 + tid * 16]); sr_[i].ks = *reinterpret_cast<const v4i*>(&Kh8[(long)((k0) + krow) * 256 + kg * 16]); } while (0)
#define SWRITE(b, i) do { *(v4i*)(V_lds + (b) * SHM_V8 + vst) = sr_[i].vs; *(v4i*)(K_lds + (b) * SHM_K8 + kst) = sr_[i].ks; } while (0)
#define SWAIT() do { asm volatile("s_waitcnt vmcnt(2)" ::: "memory"); } while (0)
#define RESC(a) do { if (__any((a) < 1.f)) { if (hi == 0) al_l[r32] = (a); asm volatile("s_waitcnt lgkmcnt(0)" ::: "memory"); \
    _Pragma("unroll") for (int d = 0; d < 4; ++d) _Pragma("unroll") for (int r = 0; r < 16; ++r) o[d][r] *= al_l[crow(r, hi)]; } } while (0)
  f32x16 pA0, pA1, pB0, pB1; float mnA, mnB, alA, alB; v8i pa; const int NT = seq / KVBLK;
  constexpr int SE = 0, SO = SDEPTH - 1;
  SLOAD(SE, 0); asm volatile("s_waitcnt vmcnt(0)" ::: "memory"); SWRITE(0, SE); __syncthreads();
  qkt8(pA0, pA1, K_lds, q8a, q8b, r32, hi, sc1); partialSM8(pA0, pA1, m_reg, mnA, alA);
  SLOAD(SO, KVBLK); if (2 < NT) SLOAD(SE, 2 * KVBLK);
  SWAIT(); SWRITE(1, SO); __syncthreads();
  for (int j = 1; j + 1 < NT; j += 2) {
    SBAR(); qkt8(pB0, pB1, K_lds + SHM_K8, q8a, q8b, r32, hi, sc1);
    finishSM8(pA0, pA1, alA, l_reg, pa); SBAR();
    SLOAD(SO, (j + SDEPTH) * KVBLK); SBAR();
    pv8(o, V_lds, pa, r32, hi, sc1); partialSM8(pB0, pB1, m_reg, mnB, alB);
    __syncthreads(); SWAIT(); SWRITE(0, SE);
    RESC(alB); __syncthreads();
    SBAR(); qkt8(pA0, pA1, K_lds, q8a, q8b, r32, hi, sc1);
    finishSM8(pB0, pB1, alB, l_reg, pa); SBAR();
    if (j + 3 < NT) SLOAD(SE, (j + 1 + SDEPTH) * KVBLK); SBAR();
    pv8(o, V_lds + SHM_V8, pa, r32, hi, sc1); partialSM8(pA0, pA1, m_reg, mnA, alA);
    __syncthreads(); SWAIT(); SWRITE(1, SO);
    RESC(alA); __syncthreads();
  }
  SBAR(); qkt8(pB0, pB1, K_lds + SHM_K8, q8a, q8b, r32, hi, sc1);
  finishSM8(pA0, pA1, alA, l_reg, pa); SBAR();
  pv8(o, V_lds, pa, r32, hi, sc1); partialSM8(pB0, pB1, m_reg, mnB, alB);
  __syncthreads(); RESC(alB);
  finishSM8(pB0, pB1, alB, l_reg, pa); SBAR();
  pv8(o, V_lds + SHM_V8, pa, r32, hi, sc1);
  if (hi == 0) li_l[r32] = l_reg; asm volatile("s_waitcnt lgkmcnt(0)" ::: "memory");
  float rli[16];
#pragma unroll
  for (int r = 0; r < 16; ++r) rli[r] = __builtin_amdgcn_rcpf(li_l[crow(r, hi)]);
  bf16* Ow = Ob + (long)(wid * QBLK) * LDO;
#pragma unroll
  for (int r = 0; r < 16; ++r) { int orow = crow(r, hi);
#pragma unroll
    for (int d0 = 0; d0 < 4; ++d0) Ow[(long)orow * LDO + d0 * 32 + r32] = (bf16)f2bf(o[d0][r] * rli[r]); }
  __syncthreads();
#undef SLOAD
#undef SWRITE
#undef SWAIT
#undef RESC
}
}

__device__ __forceinline__ void ph_norm3(Frame& F) {
    unsigned char* ar = F.ws + WS_ARENA;
    LAS float* RT = (LAS float*)(F.lds + 3 * 8192);
    LAS int* HIST = (LAS int*)(F.lds + 11 * 8192);
    __syncthreads();
    for (int i = F.tid; i < 2048; i += NTHR) { PV(0)[i] = modp(F, 1, 0, 2)[i] * inp(I_NORMS)[(4 + 1) * 2048 + i]; PV(1)[i] = inp(I_NORMS)[(4 + 2) * 2048 + i] * (1.f + modp(F, 1, 0, 4)[i]); PV(2)[i] = modp(F, 1, 0, 3)[i]; }
    for (int i = F.tid; i < 2048 * 8; i += NTHR) RT[(i & 7) * 2048 + (i >> 3)] = inp(I_ROUTER)[i];
    __syncthreads();
    const bf16* YO = (const bf16*)(ar + B_YO1); bf16* V1 = (bf16*)(ar + B_V1); bf16* HR = (bf16*)(F.ws + WS_HRES) + (size_t)CTX * D;
    int* RE = (int*)(ar + B_RE); float* RG = (float*)(ar + B_RG); int* CNT = (int*)(ar + B_CNT);
    for (int blk = blockIdx.x; blk < SEQ / 64; blk += F.G) {
        if (F.tid < 8) HIST[F.tid] = 0;
        __syncthreads();
        for (int rr = 0; rr < 8; ++rr) { const int t = blk * 64 + F.wave * 8 + rr; f32x4 y[8], h[8];
            ld_row_bf16(YO + (size_t)t * D, F.lane, y); ld_row_bf16(HR + (size_t)t * D, F.lane, h);
            const float ry = 1.f / sqrtf(row_sumsq(y) * (1.f / D) + EPS);
#pragma unroll
            for (int j = 0; j < 8; ++j) h[j] = h[j] + y[j] * ry * ldp(PV(0), F.lane, j);
            st_row_bf16(HR + (size_t)t * D, F.lane, h);
            const float rh = 1.f / sqrtf(row_sumsq(h) * (1.f / D) + EPS);
#pragma unroll
            for (int j = 0; j < 8; ++j) y[j] = h[j] * rh * ldp(PV(1), F.lane, j) + ldp(PV(2), F.lane, j);
            { unsigned char* V8 = (unsigned char*)V1 + (size_t)t * D;
#pragma unroll
              for (int j = 0; j < 8; ++j) *(GAS unsigned*)(V8 + 4 * F.lane + 256 * j) = pk4_fp8(y[j][0], y[j][1], y[j][2], y[j][3]); }
            float lg[8];
#pragma unroll
            for (int e = 0; e < 8; ++e) { float s = 0.f;
#pragma unroll
                for (int j = 0; j < 8; ++j) { const f32x4 w = ldp(RT + e * 2048, F.lane, j); s += (y[j][0] * w[0] + y[j][1] * w[1]) + (y[j][2] * w[2] + y[j][3] * w[3]); }
                lg[e] = wave_sum(s) + inp(I_ROUTERB)[e]; }
            if (F.lane == 0) { int e0 = 0; float v0 = lg[0];
#pragma unroll
                for (int e = 1; e < 8; ++e) if (lg[e] > v0) { v0 = lg[e]; e0 = e; }
                int e1 = -1; float v1 = -3.0e38f;
#pragma unroll
                for (int e = 0; e < 8; ++e) if (e != e0 && lg[e] > v1) { v1 = lg[e]; e1 = e; }
                const float g0 = 1.f / (1.f + __expf(v1 - v0));
                RE[2 * t] = e0; RE[2 * t + 1] = e1; RG[2 * t] = g0; RG[2 * t + 1] = 1.f - g0;
                __hip_atomic_fetch_add((int*)(HIST + e0), 1, __ATOMIC_RELAXED, __HIP_MEMORY_SCOPE_WORKGROUP); __hip_atomic_fetch_add((int*)(HIST + e1), 1, __ATOMIC_RELAXED, __HIP_MEMORY_SCOPE_WORKGROUP); }
        }
        __syncthreads();
        if (F.tid < 8) CNT[blk * 8 + F.tid] = HIST[F.tid];
        __syncthreads();
    }
}
__device__ __forceinline__ void ph_route(Frame& F) {
    unsigned char* ar = F.ws + WS_ARENA;
    LAS int* TOT = (LAS int*)(F.lds); LAS int* PRE = TOT + 8; LAS int* BASE = TOT + 16; LAS int* POS = TOT + 32;
    const int* CNT = (const int*)(ar + B_CNT); const int* RE = (const int*)(ar + B_RE); int* SLOT = (int*)(ar + B_SLOT); int* TILE = (int*)(ar + B_TILE);
    const bf16* V1 = (const bf16*)(ar + B_V1); unsigned char* VG = ar + B_VG;
    for (int blk = blockIdx.x; blk < SEQ / 64; blk += F.G) {
        __syncthreads();
        { const int e = F.wave; int tot = 0, pre = 0;
          for (int q = 0; q < 4; ++q) { const int b = 4 * F.lane + q; const int cv = CNT[b * 8 + e]; tot += cv; pre += (b < blk) ? cv : 0; }
#pragma unroll
          for (int o = 1; o < 64; o <<= 1) { tot += __shfl_xor(tot, o); pre += __shfl_xor(pre, o); }
          if (F.lane == 0) { TOT[e] = tot; PRE[e] = pre; } }
        __syncthreads();
        if (F.tid == 0) { int b = 0; for (int e = 0; e < 8; ++e) { BASE[e] = b; b += (TOT[e] + 255) / 256 * 256; } BASE[8] = b; }
        __syncthreads();
        if (F.wave == 0) { const int t = blk * 64 + F.lane; const int e0 = RE[2 * t], e1 = RE[2 * t + 1]; int p0 = 0, p1 = 0;
            const unsigned long long lt = (1ull << F.lane) - 1ull;
#pragma unroll
            for (int e = 0; e < 8; ++e) { const unsigned long long m0 = __ballot(e0 == e), m1 = __ballot(e1 == e); const int rk = __popcll(m0 & lt) + __popcll(m1 & lt);
                if (e0 == e) p0 = BASE[e] + PRE[e] + rk; if (e1 == e) p1 = BASE[e] + PRE[e] + rk; }
            SLOT[2 * t] = p0; SLOT[2 * t + 1] = p1; POS[2 * F.lane] = p0; POS[2 * F.lane + 1] = p1; }
        __syncthreads();
        for (int idx = F.tid; idx < 128 * 128; idx += NTHR) { const int ri = idx >> 7, seg = idx & 127;
            *(GAS v4u*)(VG + (size_t)POS[ri] * D + seg * 16) = *(const GAS v4u*)((const unsigned char*)V1 + (size_t)(blk * 64 + (ri >> 1)) * D + seg * 16); }
        if (blk < 8) { const int e = blk, r0 = BASE[e] + TOT[e], r1 = BASE[e + 1];
            for (int idx = F.tid; idx < (r1 - r0) * 128; idx += NTHR) *(GAS v4u*)(VG + (size_t)(r0 + (idx >> 7)) * D + (idx & 127) * 16) = (v4u){0u, 0u, 0u, 0u}; }
        if (blk == 0 && F.tid == 0) { int nt = 0; for (int e = 0; e < 8; ++e) { const int n = (BASE[e + 1] - BASE[e]) / 256; for (int q = 0; q < n; ++q) TILE[1 + nt++] = e; } TILE[0] = nt; }
    }
}
__device__ __forceinline__ void ph_norm4(Frame& F, float* out) {
    unsigned char* ar = F.ws + WS_ARENA;
    __syncthreads();
    for (int i = F.tid; i < 2048; i += NTHR) PV(0)[i] = modp(F, 1, 0, 5)[i] * inp(I_NORMS)[(4 + 3) * 2048 + i];
    __syncthreads();
    const bf16* FS = (const bf16*)(ar + B_FS); const bf16* HR = (const bf16*)(F.ws + WS_HRES) + (size_t)CTX * D; const int* SLOT = (const int*)(ar + B_SLOT); const float* RG = (const float*)(ar + B_RG);
    const int gw = F.vcu * NWAVES + F.wave, NGW = F.G * NWAVES;
    for (int t = gw; t < SEQ; t += NGW) { f32x4 a[8], b[8], h[8]; const int p0 = SLOT[2 * t], p1 = SLOT[2 * t + 1]; const float g0 = RG[2 * t], g1 = RG[2 * t + 1];
        const float* PART = (const float*)(ar + B_VG); constexpr size_t PSTR = (size_t)MOE_SPLIT_TILES * 256 * D;
        if (p0 < MOE_MAIN_TILES * 256) ld_row_bf16(FS + (size_t)p0 * D, F.lane, a);
        else { const float* pp = PART + (size_t)(p0 - MOE_MAIN_TILES * 256) * D; f32x4 q1[8], q2[8], q3[8]; ld_row_f32(pp, F.lane, a); ld_row_f32(pp + PSTR, F.lane, q1); ld_row_f32(pp + 2 * PSTR, F.lane, q2); ld_row_f32(pp + 3 * PSTR, F.lane, q3);
#pragma unroll
            for (int j = 0; j < 8; ++j) a[j] = (a[j] + q1[j]) + (q2[j] + q3[j]); }
        if (p1 < MOE_MAIN_TILES * 256) ld_row_bf16(FS + (size_t)p1 * D, F.lane, b);
        else { const float* pp = PART + (size_t)(p1 - MOE_MAIN_TILES * 256) * D; f32x4 q1[8], q2[8], q3[8]; ld_row_f32(pp, F.lane, b); ld_row_f32(pp + PSTR, F.lane, q1); ld_row_f32(pp + 2 * PSTR, F.lane, q2); ld_row_f32(pp + 3 * PSTR, F.lane, q3);
#pragma unroll
            for (int j = 0; j < 8; ++j) b[j] = (b[j] + q1[j]) + (q2[j] + q3[j]); }
        ld_row_bf16(HR + (size_t)t * D, F.lane, h);
#pragma unroll
        for (int j = 0; j < 8; ++j) a[j] = a[j] * g0 + b[j] * g1;
        const float rf = 1.f / sqrtf(row_sumsq(a) * (1.f / D) + EPS);
#pragma unroll
        for (int j = 0; j < 8; ++j) h[j] = h[j] + a[j] * rf * ldp(PV(0), F.lane, j);
        st_row_f32(out + (size_t)t * D, F.lane, h); }
}

struct EpiGateUp8 { static constexpr bool PERM = true; unsigned char* HID; int ldc; float is;
    __device__ __forceinline__ void operator()(AccRef acc, const Unit& u, int wr, int wc, int fr, int fq) const { EPI_ROWS(u); const int col0 = u.pn * 128 + wc * 32 + 8 * fq; const float c1 = -1.4426950408889634f * is, kk = is * is * MOE_HSC;
#pragma unroll
        for (int ai = 0; ai < 2; ++ai)
#pragma unroll
            for (int m = 0; m < 4; ++m) { const int row = row0 + ai * 128 + m * 16; float a[4], b[4];
#pragma unroll
                for (int q = 0; q < 4; ++q) { a[q] = __builtin_amdgcn_fmed3f(swiglu_fast(acc[ai][0][m][0][q], acc[ai][1][m][0][q], c1, kk), -448.f, 448.f);
                                              b[q] = __builtin_amdgcn_fmed3f(swiglu_fast(acc[ai][0][m][1][q], acc[ai][1][m][1][q], c1, kk), -448.f, 448.f); }
                v2u o; o.x = pk4_fp8(a[0], a[1], a[2], a[3]); o.y = pk4_fp8(b[0], b[1], b[2], b[3]);
                *(GAS v2u*)(HID + (size_t)row * ldc + col0) = o; } } };
struct EpiPlainSc { static constexpr bool PERM = true; bf16* O; int ldc; float sc;
    __device__ __forceinline__ void operator()(AccRef acc, const Unit& u, int wr, int wc, int fr, int fq) const { EPI_ROWS(u); const int col0 = u.pn * 256 + wc * 32 + 8 * fq;
#pragma unroll
        for (int ai = 0; ai < 2; ++ai)
#pragma unroll
            for (int m = 0; m < 4; ++m) { bf16* rp = O + (size_t)(row0 + ai * 128 + m * 16) * ldc + col0;
#pragma unroll
                for (int bj = 0; bj < 2; ++bj) *(GAS u32x4*)(rp + bj * 128) = pack8(acc[ai][bj][m][0] * sc, acc[ai][bj][m][1] * sc); } } };

struct EpiPart { static constexpr bool PERM = false; float* P; int pm0; float sc;
    __device__ __forceinline__ void operator()(AccRef acc, const Unit& u, int wr, int wc, int fr, int fq) const { const int row0 = (u.pm - pm0) * 256 + wr * 64 + fr, col0 = u.pn * 256 + wc * 32 + 4 * fq;
        float* base = P + (size_t)u.bz * ((size_t)MOE_SPLIT_TILES * 256 * D);
#pragma unroll
        for (int ai = 0; ai < 2; ++ai)
#pragma unroll
            for (int m = 0; m < 4; ++m) { float* rp = base + (size_t)(row0 + ai * 128 + m * 16) * D + col0;
#pragma unroll
                for (int bj = 0; bj < 2; ++bj)
#pragma unroll
                    for (int n = 0; n < 2; ++n) *(GAS f32x4*)(rp + bj * 128 + n * 16) = acc[ai][bj][m][n] * sc; } } };

enum { PH_PRO = 0, PH_N0, PH_WINE, PH_POOLD, PH_SCAN, PH_S5Y, PH_GLU, PH_WOUTE, PH_N1, PH_FFNU, PH_FFND, PH_N2,
       PH_WINO, PH_PREP, PH_GLA1, PH_GLA2, PH_GLA3, PH_ATT, PH_WOUTO, PH_N3, PH_ROUTE, PH_MOEU, PH_MOED, PH_N4, NPH };
constexpr int PH_EMIT = 100;
struct Args { const float* in[N_IN]; float* out; unsigned char* ws; int ph_lo, ph_hi, li, pad; };

__global__ void __launch_bounds__(NTHR, 2) mk_fwd(Args args) {
    extern __shared__ __attribute__((aligned(16))) unsigned char lds[];
    Frame F;
    F.lds = (LAS unsigned char*)lds; F.MISC = (volatile LAS unsigned*)(F.lds + MISC_OFF);
    F.tid = threadIdx.x; F.lane = F.tid & 63; F.wave = __builtin_amdgcn_readfirstlane(F.tid >> 6);
    F.G = gridDim.x; { const int bx = blockIdx.x; F.vcu = (F.G % 8 == 0) ? (bx % 8) * (F.G / 8) + bx / 8 : bx; }
    F.ws = karg_ws(); F.ctl = (gu32*)(F.ws + WS_CTL);
    for (int u = F.tid; u < (LDS_BYTES - LDSCTL_OFF) / 4; u += NTHR) ((LAS unsigned*)(F.lds + LDSCTL_OFF))[u] = 0u;
    __syncthreads();
    XcdBarrier bar = xcd_barrier_post((unsigned*)(F.ctl + CW_BAR) + (karg_i(2) & 7) * XCD_BAR_WORDS, F.MISC + 8);
    const int lo = karg_i(0), hi = karg_i(1);
#define IN(k) (lo <= (k) && (k) < hi)
#define SEAM(k) do { if (IN(k) && IN((k) + 1)) xcd_barrier(bar); } while (0)
    PG8_LAS unsigned char* ring = (PG8_LAS unsigned char*)(F.lds + RING_OFF);
    unsigned char* ar = F.ws + WS_ARENA;
    const int bid = (int)blockIdx.x;

    if (lo == PH_EMIT) { ph_emit(F, karg_out()); return; }

    if (IN(PH_PRO)) { p0_prologue(F); } SEAM(PH_PRO);
    if (IN(PH_N0)) { for (int it = bid; it < S5G * 8; it += F.G) { s5_small_tables(F, it >> 3); s5_stage_b(F, it >> 3, it & 7); } ph_norm0(F); } SEAM(PH_N0);
    if (IN(PH_WINE)) {
        pg8::Gemm g{(const bf16*)(ar + A_U), (const bf16*)(F.ws + WS_WINE), D, D, D};
        pg8::PlainSched S; S.o.init(T / 256, D / 256, 1, F.G, bid); S.astr = (size_t)256 * D * 2; S.bstr = (size_t)256 * D * 2; S.zA = 0; S.zB = 0;
        EpiWinE E{(bf16*)(ar + A_ZP), (bf16*)(ar + A_AS5)};
        pg8::gemm_phase(ring, g, S, E);
        conv_work(F, 0, fill_quota(S.o.nwg, F.G, bid, 6));
    } SEAM(PH_WINE);
    if (IN(PH_POOLD)) {
        ph_pooldiff(F);
        __syncthreads();
        pg8::Gemm g{(const bf16*)(ar + A_AS5), (const bf16*)(ar + A_M1T), S5K, 1024, 1024};
        pg8::PlainSched S; S.o.init(S5ROWS / 256, 1, S5G, F.G, bid); S.astr = (size_t)256 * S5K * 2; S.bstr = 0; S.zA = (size_t)S5ROWS * S5K * 2; S.zB = (size_t)256 * 1024 * 2;
        EpiSloc E{(float*)(ar + A_SLOC)};
        pg8::gemm_phase(ring, g, S, E);
        conv_work(F, 0, fill_quota(S.o.nwg, F.G, bid, 3));
    } SEAM(PH_POOLD);
    if (IN(PH_SCAN)) {
        ph_s5scan(F);
        __syncthreads();
        pg8::Gemm g{(const bf16*)(ar + A_DP), (const bf16*)(F.ws + WS_WPOOL), WPOOL, PG, PG};
        pg8::PlainSched S; S.o.init(T / 256, 2, 4, F.G, bid); S.astr = (size_t)256 * WPOOL * 2; S.bstr = (size_t)256 * PG * 2; S.zA = (size_t)PG * 2; S.zB = (size_t)512 * PG * 2;
        EpiPool E{(bf16*)(ar + A_YMIX), inp(I_EPOOLS)};
        pg8::gemm_phase(ring, g, S, E);
        conv_work(F, 0, fill_quota(S.o.nwg, F.G, bid, 1));
    } SEAM(PH_SCAN);
    if (IN(PH_S5Y)) {
        pg8::Gemm g{(const bf16*)(ar + A_AS5), (const bf16*)(ar + A_K3T), S5K, S5K, S5K};
        pg8::PlainSched S; S.o.init(S5ROWS / 256, 4, S5G, F.G, bid); S.astr = (size_t)256 * S5K * 2; S.bstr = (size_t)256 * S5K * 2; S.zA = (size_t)S5ROWS * S5K * 2; S.zB = (size_t)1024 * S5K * 2;
        EpiS5Y E{(const bf16*)(ar + A_AS5), inp(I_S5D), (bf16*)(ar + A_YG)};
        pg8::gemm_phase(ring, g, S, E);
    } SEAM(PH_S5Y);
    if (IN(PH_GLU)) {
        pg8::Gemm g{(const bf16*)(ar + A_YG), (const bf16*)(F.ws + WS_WGLU), WS5, WS5, WS5};
        pg8::PlainSched S; S.o.init(T / 256, 2, 1, F.G, bid); S.astr = (size_t)256 * WS5 * 2; S.bstr = (size_t)256 * WS5 * 2; S.zA = 0; S.zB = 0;
        EpiGlu E{(const bf16*)(ar + A_YG), (bf16*)(ar + A_YMIX)};
        pg8::gemm_phase(ring, g, S, E);
        conv_work(F, 0, fill_quota(S.o.nwg, F.G, bid, 2));
    } SEAM(PH_GLU);
    if (IN(PH_WOUTE)) {
        pg8::Gemm g{(const bf16*)(ar + A_YMIX), (const bf16*)(F.ws + WS_WOUTE), D, D, D};
        pg8::PlainSched S; S.o.init(T / 256, D / 256, 1, F.G, bid); S.astr = (size_t)256 * D * 2; S.bstr = (size_t)256 * D * 2; S.zA = 0; S.zB = 0;
        EpiPlain E{(bf16*)(ar + A_YO), D};
        pg8::gemm_phase(ring, g, S, E);
        conv_work(F, 0, fill_quota(S.o.nwg, F.G, bid, 6));
    } SEAM(PH_WOUTE);
    if (IN(PH_N1)) { ph_norm1(F); conv_work(F, CQ_F2, 0); } SEAM(PH_N1);
    if (IN(PH_FFNU)) {
#if FFN_FP8 == 1
        pg8::Gemm g{(const bf16*)(ar + A_V), (const bf16*)(F.ws + WS_WGU), D / 2, D / 2, D / 2};
        pg8::PlainSched S; S.o.init(T / 256, 14336 / 256, 1, F.G, bid); S.astr = (size_t)256 * D; S.bstr = (size_t)256 * D; S.zA = 0; S.zB = 0;
        EpiGateUp8 E{ar + A_HID, DFF, 1.f / MOE_WSC_GU};
        pg8::gemm_phase<EpiGateUp8, pg8::PlainSched, true>(ring, g, S, E);
#elif FFN_FP8 == 2 && FFNU_K1 < 2048
        constexpr int KEQ = FFNU_K1 + (2048 - FFNU_K1) / 2;
        static_assert(FFNU_K1 % 128 == 0 && (2048 - FFNU_K1) % 256 == 0 && KEQ % 128 == 0 && FFNU_K1 % 256 == 0, "mixed-precision split");
        pg8::Gemm g{(const bf16*)(ar + A_V), (const bf16*)(F.ws + WS_WGU), KEQ, KEQ, KEQ};
        pg8::PlainSched S; S.o.init(T / 256, 14336 / 256, 1, F.G, bid); S.astr = (size_t)256 * KEQ * 2; S.bstr = (size_t)256 * KEQ * 2; S.zA = 0; S.zB = 0;
        EpiGateUp8 E{ar + A_HID, DFF, 1.f};
        pg8::gemm_phase<EpiGateUp8, pg8::PlainSched, false, FFNU_K1 / 64>(ring, g, S, E);
#elif FFN_FP8 == 2
        pg8::Gemm g{(const bf16*)(ar + A_V), (const bf16*)(F.ws + WS_WGU), D, D, D};
        pg8::PlainSched S; S.o.init(T / 256, 14336 / 256, 1, F.G, bid); S.astr = (size_t)256 * D * 2; S.bstr = (size_t)256 * D * 2; S.zA = 0; S.zB = 0;
        EpiGateUp8 E{ar + A_HID, DFF, 1.f};
        pg8::gemm_phase(ring, g, S, E);
#else
        pg8::Gemm g{(const bf16*)(ar + A_V), (const bf16*)(F.ws + WS_WGU), D, D, D};
        pg8::PlainSched S; S.o.init(T / 256, 14336 / 256, 1, F.G, bid); S.astr = (size_t)256 * D * 2; S.bstr = (size_t)256 * D * 2; S.zA = 0; S.zB = 0;
        EpiGateUp E{(bf16*)(ar + A_HID), DFF};
        pg8::gemm_phase(ring, g, S, E);
#endif
        conv_work(F, CQ_F3, fill_quota((T / 256) * (14336 / 256), F.G, bid, 6));
    } SEAM(PH_FFNU);
    if (IN(PH_FFND)) {
#if FFN_FP8
        pg8::Gemm g{(const bf16*)(ar + A_HID), (const bf16*)(F.ws + WS_WDN), DFF / 2, DFF / 2, DFF / 2};
        pg8::PlainSched S; S.o.init(T / 256, D / 256, 1, F.G, bid); S.astr = (size_t)256 * DFF; S.bstr = (size_t)256 * DFF; S.zA = 0; S.zB = 0;
        EpiPlainSc E{(bf16*)(ar + A_F), D, 1.f / (MOE_WSC_DN * MOE_HSC)};
        pg8::gemm_phase<EpiPlainSc, pg8::PlainSched, true>(ring, g, S, E);
#else
        pg8::Gemm g{(const bf16*)(ar + A_HID), (const bf16*)(F.ws + WS_WDN), DFF, DFF, DFF};
        pg8::PlainSched S; S.o.init(T / 256, D / 256, 1, F.G, bid); S.astr = (size_t)256 * DFF * 2; S.bstr = (size_t)256 * DFF * 2; S.zA = 0; S.zB = 0;
        EpiPlain E{(bf16*)(ar + A_F), D};
        pg8::gemm_phase(ring, g, S, E);
#endif
        conv_work(F, CQ_O1, fill_quota((T / 256) * (D / 256), F.G, bid, 11));
    } SEAM(PH_FFND);
    if (IN(PH_N2)) { ph_norm2(F); conv_work(F, CQ_O1, 0); } SEAM(PH_N2);
    if (IN(PH_WINO)) {
        pg8::Gemm g{(const bf16*)(ar + A_U), (const bf16*)(F.ws + WS_WINO), D, D, D};
        pg8::PlainSched S; S.o.init(T / 256, WINO_N / 256, 1, F.G, bid); S.astr = (size_t)256 * D * 2; S.bstr = (size_t)256 * D * 2; S.zA = 0; S.zB = 0;
        EpiWinO E{ar};
        pg8::gemm_phase(ring, g, S, E);
        conv_work(F, CQ_O2, fill_quota(S.o.nwg, F.G, bid, 5));
    } SEAM(PH_WINO);
    if (IN(PH_PREP)) { ph_qknorm(F); ph_vt8(F); for (int u = bid; u < NCH * 4; u += F.G) gla_prepkv_unit(F, u >> 2, u & 3); conv_work(F, 0, fill_quota(NCH * 4, F.G, bid, 4)); } SEAM(PH_PREP);
    if (IN(PH_GLA2)) { ph_gla_scan(F); } SEAM(PH_GLA2);
    if (IN(PH_GLA3)) { for (int u = bid; u < (SEQ / 64) * 4; u += F.G) gla_out_unit(F, u >> 2, u & 3); __syncthreads(); }
    if (IN(PH_ATT)) {
        for (int L = bid; L < 8 * (SEQ / 256); L += F.G) { const int h = L >> 6, qb = L & 63;
            const bf16* Q = (const bf16*)(ar + B_AQ) + (size_t)(CTX + qb * 256) * 1024 + h * 128;
            const unsigned char* Kp = ar + B_KDT + (h >> 2) * 128; const bf16* Vp = (const bf16*)(ar + B_AV) + (h >> 2) * 128;
            bf16* O = (bf16*)(ar + B_YMIX1) + (size_t)(qb * 256) * D + 1024 + h * 128;
            att::attn_dense_body_pv8(Q, Kp, ar + B_KDT + VT8_OFF + (size_t)(h >> 2) * NCH * 8192, O, T, (char*)lds); }
    } SEAM(PH_ATT);
    if (IN(PH_WOUTO)) {
        pg8::Gemm g{(const bf16*)(ar + B_YMIX1), (const bf16*)(F.ws + WS_WOUTO), D, D, D};
        pg8::PlainSched S; S.o.init(SEQ / 256, D / 256, 1, F.G, bid); S.astr = (size_t)256 * D * 2; S.bstr = (size_t)256 * D * 2; S.zA = 0; S.zB = 0;
        EpiPlain E{(bf16*)(ar + B_YO1), D};
        pg8::gemm_phase(ring, g, S, E);
    } SEAM(PH_WOUTO);
    if (IN(PH_N3)) { ph_norm3(F); } SEAM(PH_N3);
    if (IN(PH_ROUTE)) { ph_route(F); conv_work(F, CQ_M2, 0); } SEAM(PH_ROUTE);
    if (IN(PH_MOEU)) {
        const int* TILE = (const int*)(ar + B_TILE); const int nt = __builtin_amdgcn_readfirstlane(TILE[0]);
        pg8::Gemm g{(const bf16*)(ar + B_VG), (const bf16*)(F.ws + WS_WMGU), D / 2, D / 2, D / 2};
        pg8::MoeSched S; S.o.init(nt, 14336 / 256, 1, F.G, bid); S.astr = (size_t)256 * D; S.bstr = (size_t)256 * D; S.zB = (size_t)14336 * D; S.tile_e = TILE + 1;
        EpiGateUp8 E{ar + B_HID2, DFF, 1.f / MOE_WSC_GU};
        pg8::gemm_phase<EpiGateUp8, pg8::MoeSched, true>(ring, g, S, E);
        conv_work(F, CQ_M3, fill_quota(S.o.nwg, F.G, bid, 5));
    } SEAM(PH_MOEU);
    if (IN(PH_MOED)) {
        const int* TILE = (const int*)(ar + B_TILE); const int nt = __builtin_amdgcn_readfirstlane(TILE[0]);
        pg8::Gemm g{(const bf16*)(ar + B_HID2), (const bf16*)(F.ws + WS_WMDN), DFF / 2, DFF / 2, DFF / 2};
        const int nmain = nt < MOE_MAIN_TILES ? nt : MOE_MAIN_TILES;
        pg8::MoeSched S; S.o.init(nmain, D / 256, 1, F.G, bid); S.astr = (size_t)256 * DFF; S.bstr = (size_t)256 * DFF; S.zB = (size_t)D * DFF; S.tile_e = TILE + 1;
        EpiPlainSc E{(bf16*)(ar + B_FS), D, 1.f / (MOE_WSC_DN * MOE_HSC)};
        pg8::gemm_phase<EpiPlainSc, pg8::MoeSched, true>(ring, g, S, E);
        if (nt > MOE_MAIN_TILES) {
            pg8::Gemm g2{(const bf16*)(ar + B_HID2), (const bf16*)(F.ws + WS_WMDN), DFF / 2, DFF / 2, DFF / 8};
            pg8::MoeSplitSched S2; S2.pm0 = MOE_MAIN_TILES; S2.nun = (nt - MOE_MAIN_TILES) * 32; S2.G = F.G; S2.c = bid; S2.astr = (size_t)256 * DFF; S2.bstr = (size_t)256 * DFF; S2.zB = (size_t)D * DFF; S2.kslice = DFF / 4; S2.tile_e = TILE + 1;
            EpiPart E2{(float*)(ar + B_VG), MOE_MAIN_TILES, 1.f / (MOE_WSC_DN * MOE_HSC)};
            pg8::gemm_phase<EpiPart, pg8::MoeSplitSched, true>(ring, g2, S2, E2);
        }
    } SEAM(PH_MOED);
    if (IN(PH_N4)) { ph_norm4(F, karg_out()); }
#undef IN
#undef SEAM
}

extern "C" void kernel_launch(void* const* d_in, const int* in_sizes, int n_in, void* d_out, int out_size, void* d_ws, size_t ws_size, hipStream_t stream) {
    static int grid = 0;
    if (grid == 0) {
        if (n_in != N_IN || out_size != SEQ * D || ws_size < WS_NEED) { fprintf(stderr, "kernel_launch: shape/workspace mismatch (n_in %d out %d ws %zu need %zu)\n", n_in, out_size, ws_size, (size_t)WS_NEED); grid = -1; return; }
        int dev = 0, cus = 0, per_cu = 0;
        if (hipGetDevice(&dev) != hipSuccess || hipDeviceGetAttribute(&cus, hipDeviceAttributeMultiprocessorCount, dev) != hipSuccess) { grid = -1; return; }
        if (hipFuncSetAttribute((const void*)mk_fwd, hipFuncAttributeMaxDynamicSharedMemorySize, LDS_BYTES) != hipSuccess) { fprintf(stderr, "kernel_launch: hipFuncSetAttribute failed\n"); grid = -1; return; }
        if (hipOccupancyMaxActiveBlocksPerMultiprocessor(&per_cu, (const void*)mk_fwd, NTHR, LDS_BYTES) != hipSuccess || per_cu < 1) { fprintf(stderr, "kernel_launch: occupancy query says %d\n", per_cu); }
        (void)hipGetLastError();
        grid = cus;
    }
    if (grid < 0) return;
    (void)hipMemsetAsync((char*)d_ws + WS_CTL, 0, CTL_ZERO_BYTES, stream);
    Args a{};
    for (int i = 0; i < N_IN; ++i) a.in[i] = (const float*)d_in[i];
    a.out = (float*)d_out; a.ws = (unsigned char*)d_ws; a.pad = 0;
    const int last = (MK_STOP < NPH - 1) ? MK_STOP : NPH - 1;
#if MK_SPLIT
    for (int p = 0; p <= last; ++p) { a.ph_lo = p; a.ph_hi = p + 1; a.li = p; hipLaunchKernelGGL(mk_fwd, dim3(grid), dim3(NTHR), LDS_BYTES, stream, a); }
#else
    a.ph_lo = 0; a.ph_hi = last + 1; a.li = 0; hipLaunchKernelGGL(mk_fwd, dim3(grid), dim3(NTHR), LDS_BYTES, stream, a);
#endif
    if (last < NPH - 1) { a.ph_lo = PH_EMIT; a.ph_hi = PH_EMIT + 1; a.li = 7; hipLaunchKernelGGL(mk_fwd, dim3(grid), dim3(NTHR), LDS_BYTES, stream, a); }
    const hipError_t le = hipPeekAtLastError();
    if (le != hipSuccess) fprintf(stderr, "kernel_launch: launch failed: %s\n", hipGetErrorName(le));
}
```

```cpp
#include <hip/hip_runtime.h>
#include <cstdio>
#include <cstdint>

#ifndef MK_STOP
#define MK_STOP 99
#endif
#ifndef FFN_FP8
#define FFN_FP8 2
#endif
#ifndef FFNU_K1
#define FFNU_K1 1536
#endif
#ifndef MK_SPLIT
#define MK_SPLIT 0
#endif

namespace pg8 {
#define PG8_LAS __attribute__((address_space(3)))
typedef unsigned short bf16_t;
typedef short bf16x8 __attribute__((ext_vector_type(8)));
typedef float f32x4 __attribute__((ext_vector_type(4)));
typedef unsigned u32x4 __attribute__((ext_vector_type(4)));
typedef int v4i __attribute__((ext_vector_type(4)));
typedef int v8i __attribute__((ext_vector_type(8)));
constexpr int BM = 256, BK = 64, HALF = 128, HTB = HALF * BK * 2, STAGE_BYTES = 8 * HTB, NXCD = 8, WGM = 8;

__host__ __device__ __forceinline__ int lds_byte(int r, int c) { const int st = (r >> 4) * 2 + (c >> 5), rr = r & 15, cc = c & 31, ob = rr * 64 + cc * 2; return st * 1024 + (ob ^ (((ob >> 9) & 1) << 5)); }
__host__ __device__ __forceinline__ void stage_rc(int b, int& R, int& C) { const int st = b / 1024, sb = b % 1024, swz = sb ^ (((sb >> 9) & 1) << 5); R = (st >> 1) * 16 + swz / 64; C = (st & 1) * 32 + (swz % 64) / 2; }
__host__ __device__ __forceinline__ int perm32(int rho) { const int n = rho >> 4, i = rho & 15; return 8 * (i >> 2) + 4 * n + (i & 3); }

struct Unit { int pm, pn, bz; unsigned aoff, boff; };
struct Gemm { const bf16_t* A; const bf16_t* Bt; int lda, ldb, K; };

struct TileOrder {
    int nM, nN, nB, nwg, G, c;
    __device__ void init(int nM_, int nN_, int nB_, int G_, int c_) { nM = nM_; nN = nN_; nB = nB_; nwg = nM * nN * nB; G = G_; c = c_; }
    __device__ bool decode(int i, int& bz, int& pm, int& pn) const {
        const long L = (long)i * G + c; if (L >= nwg) return false;
        int wgid = (int)L; { const int q = nwg / NXCD, r = nwg % NXCD, xcd = wgid % NXCD, off = wgid / NXCD; wgid = (xcd < r ? xcd * (q + 1) : r * (q + 1) + (xcd - r) * q) + off; }
        const int per = nM * nN; bz = wgid / per; const int w = wgid - bz * per;
        const int nig = WGM * nN, gid = w / nig, fm = gid * WGM, gsz = (nM - fm) < WGM ? (nM - fm) : WGM;
        pm = fm + ((w % nig) % gsz); pn = (w % nig) / gsz; return true;
    }
};
struct PlainSched {
    TileOrder o; size_t astr, bstr, zA, zB;
    __device__ bool next(int i, Unit& u) const { if (!o.decode(i, u.bz, u.pm, u.pn)) return false; u.aoff = (unsigned)((size_t)u.bz * zA + (size_t)u.pm * astr); u.boff = (unsigned)((size_t)u.bz * zB + (size_t)u.pn * bstr); return true; }
};
struct MoeSched {
    TileOrder o; size_t astr, bstr, zB; const int* tile_e;
    __device__ bool next(int i, Unit& u) const { int bz; if (!o.decode(i, bz, u.pm, u.pn)) return false; u.bz = __builtin_amdgcn_readfirstlane(tile_e[u.pm]); u.aoff = (unsigned)((size_t)u.pm * astr); u.boff = (unsigned)((size_t)u.bz * zB + (size_t)u.pn * bstr); return true; }
};

struct MoeSplitSched {
    int pm0, nun, G, c; size_t astr, bstr, zB; unsigned kslice; const int* tile_e;
    __device__ bool next(int i, Unit& u) const { const long L = (long)i * G + c; if (L >= nun) return false; const int l = (int)L, ks = l & 3, pn = (l >> 2) & 7, pm = pm0 + (l >> 5);
        u.pm = pm; u.pn = pn; u.bz = ks; const int e = __builtin_amdgcn_readfirstlane(tile_e[pm]);
        u.aoff = (unsigned)((size_t)pm * astr + (size_t)ks * kslice); u.boff = (unsigned)((size_t)e * zB + (size_t)pn * bstr + (size_t)ks * kslice); return true; }
};
__device__ __forceinline__ unsigned cvt_pk_bf16(float lo, float hi) { unsigned r; asm volatile("v_cvt_pk_bf16_f32 %0, %1, %2" : "=v"(r) : "v"(lo), "v"(hi)); return r; }
__device__ __forceinline__ u32x4 pack8(const f32x4& a, const f32x4& b) { u32x4 w; w.x = cvt_pk_bf16(a[0], a[1]); w.y = cvt_pk_bf16(a[2], a[3]); w.z = cvt_pk_bf16(b[0], b[1]); w.w = cvt_pk_bf16(b[2], b[3]); return w; }

template <class Epi, class Sched, bool FP8 = false, int MIXT = -1>
__device__ __forceinline__ void gemm_phase(PG8_LAS unsigned char* lds, const Gemm g, const Sched& S, const Epi& E) {
    const int tid = threadIdx.x, wid = __builtin_amdgcn_readfirstlane(tid >> 6), lane = tid & 63, wr = wid >> 2, wc = wid & 3, fr = lane & 15, fq = lane >> 4;
    const int K = g.K, nt = K / BK;
    unsigned voffA[2], voffB[2];
#pragma unroll
    for (int i = 0; i < 2; ++i) { int R, C; stage_rc(tid * 16 + i * 8192, R, C); const int Rb = Epi::PERM ? ((R & ~31) + perm32(R & 31)) : R;
        voffA[i] = (unsigned)(R * g.lda + C) * 2u; voffB[i] = (unsigned)(Rb * g.ldb + C) * 2u; }
    const unsigned kstep = (unsigned)(BK * 2);
    const unsigned hstepA = (unsigned)HALF * (unsigned)g.lda * 2u, hstepB = (unsigned)HALF * (unsigned)g.ldb * 2u;
    const unsigned ldsw = (unsigned)wid * 1024u;
    const int aoff = lds_byte(wr * 64 + fr, fq * 8), boff = lds_byte(wc * 32 + fr, fq * 8);
    const char* const gA = (const char*)g.A; const char* const gB = (const char*)g.Bt;
#define PG8_SA(b, h) (((b) * 2 + (h)) * HTB)
#define PG8_SB(b, h) ((4 + (b) * 2 + (h)) * HTB)
#define PG8_STAGE(bufoff, gbase, soff, voff) do { _Pragma("unroll") for (int _i = 0; _i < 2; ++_i) \
        __builtin_amdgcn_global_load_lds((const unsigned*)((gbase) + (size_t)((soff) + (voff)[_i])), (PG8_LAS unsigned*)(lds + (bufoff) + ldsw + _i * 8192), 16, 0, 0); } while (0)
#define PG8_LDA(dst, b, h) do { _Pragma("unroll") for (int m = 0; m < 4; ++m) _Pragma("unroll") for (int k = 0; k < 2; ++k) dst[m][k] = *(const PG8_LAS bf16x8*)(lds + PG8_SA(b, h) + aoff + m * 2048 + k * 1024); } while (0)
#define PG8_LDB(dst, b, h) do { _Pragma("unroll") for (int n = 0; n < 2; ++n) _Pragma("unroll") for (int k = 0; k < 2; ++k) dst[n][k] = *(const PG8_LAS bf16x8*)(lds + PG8_SB(b, h) + boff + n * 2048 + k * 1024); } while (0)
#define PG8_CAT(x) __builtin_shufflevector(__builtin_bit_cast(v4i, (x)[0]), __builtin_bit_cast(v4i, (x)[1]), 0, 1, 2, 3, 4, 5, 6, 7)
#define PG8_MMA(ai, bj, At, Bt, IS8) do { __builtin_amdgcn_s_setprio(1); \
        if constexpr (MIXT >= 0) { if (IS8) { \
            _Pragma("unroll") for (int m = 0; m < 4; ++m) { const v8i a8 = PG8_CAT(At[m]); _Pragma("unroll") for (int n = 0; n < 2; ++n) { const v8i b8 = PG8_CAT(Bt[n]); \
                asm volatile("s_nop 1\n\tv_mfma_scale_f32_16x16x128_f8f6f4 %0, %1, %2, %0, %3, %4 op_sel_hi:[0,0,0]" : "+v"(acc[ai][bj][m][n]) : "v"(b8), "v"(a8), "v"(scw), "v"(sc1)); } } \
          } else { _Pragma("unroll") for (int m = 0; m < 4; ++m) _Pragma("unroll") for (int n = 0; n < 2; ++n) _Pragma("unroll") for (int k = 0; k < 2; ++k) \
            acc[ai][bj][m][n] = __builtin_amdgcn_mfma_f32_16x16x32_bf16(Bt[n][k], At[m][k], acc[ai][bj][m][n], 0, 0, 0); } \
        } else if constexpr (FP8) {   \
            _Pragma("unroll") for (int m = 0; m < 4; ++m) { const v8i a8 = PG8_CAT(At[m]); _Pragma("unroll") for (int n = 0; n < 2; ++n) { const v8i b8 = PG8_CAT(Bt[n]); \
                  \
                asm volatile("s_nop 1\n\tv_mfma_scale_f32_16x16x128_f8f6f4 %0, %1, %2, %0, %3, %3 op_sel_hi:[0,0,0]" : "+v"(acc[ai][bj][m][n]) : "v"(b8), "v"(a8), "v"(sc1)); } } \
        } else { _Pragma("unroll") for (int m = 0; m < 4; ++m) _Pragma("unroll") for (int n = 0; n < 2; ++n) _Pragma("unroll") for (int k = 0; k < 2; ++k) \
            acc[ai][bj][m][n] = __builtin_amdgcn_mfma_f32_16x16x32_bf16(Bt[n][k], At[m][k], acc[ai][bj][m][n], 0, 0, 0); } \
        __builtin_amdgcn_s_setprio(0); } while (0)
#define PG8_WAIT_V(n) asm volatile("s_waitcnt vmcnt(" #n ")" ::: "memory")
#define PG8_WAIT_L(n) asm volatile("s_waitcnt lgkmcnt(" #n ")" ::: "memory")
#define PG8_BAR __builtin_amdgcn_s_barrier()
#define PG8_SCHED __builtin_amdgcn_sched_barrier(0)
    Unit cur, nxt; int ui = 0;
    if (!S.next(0, cur)) return;
    const int sc1 = 0x7f7f7f7f, scw = 0x79797979;
    f32x4 acc[2][2][4][2];
#pragma unroll
    for (int a = 0; a < 2; ++a)
#pragma unroll
        for (int b = 0; b < 2; ++b)
#pragma unroll
            for (int m = 0; m < 4; ++m)
#pragma unroll
                for (int n = 0; n < 2; ++n) acc[a][b][m][n] = (f32x4){0.f, 0.f, 0.f, 0.f};
    bf16x8 At[4][2], B0[2][2], B1[2][2];
    unsigned cA = cur.aoff, cB = cur.boff;
    PG8_STAGE(PG8_SB(0, 0), gB, cB, voffB); PG8_STAGE(PG8_SB(0, 1), gB, cB + hstepB, voffB); PG8_STAGE(PG8_SA(0, 0), gA, cA, voffA); PG8_STAGE(PG8_SA(0, 1), gA, cA + hstepA, voffA);
    if (wr == 1) PG8_BAR;
    PG8_WAIT_V(2); PG8_BAR;
    PG8_STAGE(PG8_SB(1, 0), gB, cB + kstep, voffB); PG8_STAGE(PG8_SA(1, 0), gA, cA + kstep, voffA); PG8_STAGE(PG8_SB(1, 1), gB, cB + hstepB + kstep, voffB);
    PG8_WAIT_V(6); PG8_BAR;
    for (;;) {
        const bool has_next = S.next(ui + 1, nxt);
        const unsigned nA = has_next ? nxt.aoff : cA, nB = has_next ? nxt.boff : cB;
#define PG8_KBODY(IS8) do { \
            const bool last = (t == nt - 2); \
            const unsigned a1 = cA + (unsigned)(t + 1) * kstep; \
            const unsigned a2 = last ? nA : cA + (unsigned)(t + 2) * kstep, b2 = last ? nB : cB + (unsigned)(t + 2) * kstep; \
            const unsigned a3 = a2 + kstep, b3 = b2 + kstep; \
            PG8_LDB(B0, 0, 0); PG8_LDB(B1, 0, 1); PG8_SCHED; PG8_LDA(At, 0, 0); PG8_STAGE(PG8_SA(1, 1), gA, a1 + hstepA, voffA); \
            PG8_WAIT_V(8); PG8_WAIT_L(0); PG8_BAR; PG8_MMA(0, 0, At, B0, IS8); PG8_MMA(0, 1, At, B1, IS8); PG8_BAR; PG8_SCHED; \
            PG8_LDA(At, 0, 1); PG8_STAGE(PG8_SB(0, 0), gB, b2, voffB); PG8_STAGE(PG8_SB(0, 1), gB, b2 + hstepB, voffB); PG8_STAGE(PG8_SA(0, 0), gA, a2, voffA); \
            PG8_WAIT_V(8); PG8_WAIT_L(0); PG8_BAR; PG8_MMA(1, 0, At, B0, IS8); PG8_MMA(1, 1, At, B1, IS8); PG8_BAR; PG8_SCHED; \
            PG8_LDB(B0, 1, 0); PG8_LDB(B1, 1, 1); PG8_SCHED; PG8_LDA(At, 1, 0); PG8_STAGE(PG8_SA(0, 1), gA, a2 + hstepA, voffA); \
            PG8_WAIT_V(8); PG8_WAIT_L(0); PG8_BAR; PG8_MMA(0, 0, At, B0, IS8); PG8_MMA(0, 1, At, B1, IS8); PG8_BAR; PG8_SCHED; \
            PG8_LDA(At, 1, 1); PG8_STAGE(PG8_SB(1, 0), gB, b3, voffB); PG8_STAGE(PG8_SB(1, 1), gB, b3 + hstepB, voffB); PG8_STAGE(PG8_SA(1, 0), gA, a3, voffA); \
            PG8_WAIT_V(8); PG8_WAIT_L(0); PG8_BAR; PG8_MMA(1, 0, At, B0, IS8); PG8_MMA(1, 1, At, B1, IS8); PG8_BAR; PG8_SCHED; \
        } while (0)
        if constexpr (MIXT >= 0) {
#pragma unroll 1
            for (int t = 0; t < MIXT; t += 2) PG8_KBODY(false);
#pragma unroll 1
            for (int t = MIXT; t < nt; t += 2) PG8_KBODY(true);
        } else {
#pragma unroll 1
            for (int t = 0; t < nt; t += 2) PG8_KBODY(false);
        }
#undef PG8_KBODY
        if constexpr (FP8 || MIXT >= 0) {
            asm volatile("s_nop 15" : "+v"(acc[0][0][0][0]), "+v"(acc[0][0][0][1]), "+v"(acc[0][0][1][0]), "+v"(acc[0][0][1][1]), "+v"(acc[0][0][2][0]), "+v"(acc[0][0][2][1]), "+v"(acc[0][0][3][0]), "+v"(acc[0][0][3][1]),
                                      "+v"(acc[0][1][0][0]), "+v"(acc[0][1][0][1]), "+v"(acc[0][1][1][0]), "+v"(acc[0][1][1][1]), "+v"(acc[0][1][2][0]), "+v"(acc[0][1][2][1]), "+v"(acc[0][1][3][0]), "+v"(acc[0][1][3][1]));
            asm volatile("" : "+v"(acc[1][0][0][0]), "+v"(acc[1][0][0][1]), "+v"(acc[1][0][1][0]), "+v"(acc[1][0][1][1]), "+v"(acc[1][0][2][0]), "+v"(acc[1][0][2][1]), "+v"(acc[1][0][3][0]), "+v"(acc[1][0][3][1]),
                              "+v"(acc[1][1][0][0]), "+v"(acc[1][1][0][1]), "+v"(acc[1][1][1][0]), "+v"(acc[1][1][1][1]), "+v"(acc[1][1][2][0]), "+v"(acc[1][1][2][1]), "+v"(acc[1][1][3][0]), "+v"(acc[1][1][3][1]));
        }
        if (wr == 0) PG8_BAR;
        E(acc, cur, wr, wc, fr, fq);
        if (!has_next) break;
#pragma unroll
        for (int a = 0; a < 2; ++a)
#pragma unroll
            for (int b = 0; b < 2; ++b)
#pragma unroll
                for (int m = 0; m < 4; ++m)
#pragma unroll
                    for (int n = 0; n < 2; ++n) acc[a][b][m][n] = (f32x4){0.f, 0.f, 0.f, 0.f};
        cur = nxt; cA = nA; cB = nB; ++ui;
        if (wr == 1) PG8_BAR;
    }
    PG8_WAIT_V(0);
    PG8_BAR;
#undef PG8_SA
#undef PG8_SB
#undef PG8_STAGE
#undef PG8_LDA
#undef PG8_LDB
#undef PG8_MMA
#undef PG8_CAT
#undef PG8_WAIT_V
#undef PG8_WAIT_L
#undef PG8_BAR
#undef PG8_SCHED
}
}

constexpr int D = 2048, SEQ = 16384, CTX = 256, T = SEQ + CTX, DFF = 7168, NEXP = 8;
constexpr int NWAVES = 8, NTHR = 512;
constexpr int WPOOL = 1536, WS5 = 512, PG = 384, S5G = 32, S5P = 64, S5N = 16, LC = 64, NCH = T / LC  , NCH_CTX = CTX / LC  ;
constexpr int S5ROWS = 512, S5K = 1280;
constexpr int WINO_N = 4864;
constexpr float EPS = 1e-6f;
constexpr float MOE_WSC_GU = 64.f, MOE_WSC_DN = 128.f, MOE_HSC = 4.f;

enum { I_X = 0, I_C, I_CTX, I_CCTX, I_WMOD, I_BMOD, I_NORMS, I_EWIN, I_EPOOLW, I_EPOOLS, I_LAMRE, I_LAMIM, I_LOGDT, I_BRE, I_BIM, I_CRE, I_CIM, I_S5D, I_WGLU, I_EWOUT,
       I_FFG, I_FFU, I_FFD, I_OWIN, I_GLAWA, I_GLABA, I_GLANORM, I_QNORM, I_KNORM, I_OWOUT, I_ROUTER, I_ROUTERB, I_MOEG, I_MOEU, I_MOED, N_IN };

constexpr size_t MiB = 1u << 20;
constexpr size_t al256(size_t x) { return (x + 255) / 256 * 256; }
constexpr size_t WS_CTL = 0, CTL_ZERO_BYTES = 128 * 1024;
constexpr size_t WS_MODF = 1 * MiB;
constexpr size_t WS_ROPE = WS_MODF + al256(2 * 2 * 6 * 2048 * 4);
constexpr size_t WS_W0 = 2 * MiB;
constexpr size_t SZ_WINE = (size_t)2048 * 2048 * 2, SZ_WPOOL = (size_t)4 * 512 * 384 * 2, SZ_WGLU = (size_t)512 * 512 * 2, SZ_WGU = (size_t)14336 * 2048 * 2,
                 SZ_WDN = (size_t)2048 * 7168 * 2, SZ_WINO = (size_t)WINO_N * 2048 * 2;
constexpr size_t WS_WINE = WS_W0, WS_WPOOL = WS_WINE + SZ_WINE, WS_WGLU = WS_WPOOL + SZ_WPOOL, WS_WOUTE = WS_WGLU + SZ_WGLU, WS_WGU = WS_WOUTE + SZ_WINE,
                 WS_WDN = WS_WGU + SZ_WGU, WS_WINO = WS_WDN + SZ_WDN, WS_WOUTO = WS_WINO + SZ_WINO, WS_WMGU = WS_WOUTO + SZ_WINE, WS_WMDN = WS_WMGU + 8 * SZ_WGU,
                 WS_HRES = WS_WMDN + 8 * SZ_WDN;
constexpr size_t SZ_HRES = (size_t)T * D * 4;
constexpr size_t WS_ARENA = WS_HRES + SZ_HRES;
constexpr size_t SZ_ROWB = (size_t)T * D * 2;
constexpr size_t A_U = 0, A_ZP = A_U + SZ_ROWB, SZ_ZP = (size_t)T * WPOOL * 2, A_DP = A_ZP + SZ_ZP, A_AS5 = A_DP + SZ_ZP, SZ_AS5 = (size_t)S5G * S5ROWS * S5K * 2,
                 A_SLOC = A_AS5 + SZ_AS5, SZ_SLOC = (size_t)S5G * S5ROWS * 256 * 4, A_YG = A_SLOC + SZ_SLOC, SZ_YG = (size_t)T * WS5 * 2, A_YMIX = A_YG + SZ_YG,
                 A_YO = A_YMIX + SZ_ROWB, A_V = A_YO + SZ_ROWB, A_HID = A_V + SZ_ROWB, SZ_HID = (size_t)T * DFF * 2, A_F = A_HID + SZ_HID,
                 A_M1T = A_F + SZ_ROWB, SZ_M1T = (size_t)S5G * 256 * 1024 * 2, A_K3T = A_M1T + SZ_M1T, SZ_K3T = (size_t)S5G * 1024 * S5K * 2,
                 A_TBG = A_K3T + SZ_K3T, SZ_TBG = (size_t)S5G * 2 * 64 * 256 * 4, A_L0_END = A_TBG + SZ_TBG;
constexpr size_t WS_END_L0 = WS_ARENA + A_L0_END;
constexpr int MOE_ROWS = 2 * SEQ + NEXP * 256;
constexpr int MOE_MAIN_TILES = 128, MOE_SPLIT_TILES = MOE_ROWS / 256 - 128;
static_assert((size_t)4 * MOE_SPLIT_TILES * 256 * D * 4 <= (size_t)MOE_ROWS * D * 2, "split-K partials fit in the (dead) VG region");
constexpr size_t SZ_T512 = (size_t)T * 512 * 2, SZ_T1024 = (size_t)T * 1024 * 2, SZ_T256 = (size_t)T * 256 * 2, SZ_SEQB = (size_t)SEQ * D * 2;
constexpr size_t B_GQ = A_U + SZ_ROWB, B_GK = B_GQ + SZ_T512, B_GV = B_GK + SZ_T512, B_R = B_GV + SZ_T1024, B_AQ = B_R + SZ_T1024, B_AK = B_AQ + SZ_T1024, B_AV = B_AK + SZ_T256,
                 B_ALR = B_AV + SZ_T256, B_QE = B_ALR + al256((size_t)T * 16 * 4), B_KE = B_QE + 2 * SZ_T512, B_KDT = B_KE + 2 * SZ_T512, B_VT = B_KDT + 2 * SZ_T512,
                 B_DEC = B_VT + SZ_T1024, B_ST = B_DEC + al256((size_t)2 * NCH * 4 * 128 * 4), SZ_ST = (size_t)2 * NCH * 4 * 256 * 128 * 2, B_YMIX1 = B_ST + SZ_ST,
                 B_YO1 = B_YMIX1 + SZ_SEQB, B_REGA_END = B_YO1 + SZ_SEQB;
constexpr size_t B_HID2 = 0, SZ_HID2 = (size_t)MOE_ROWS * DFF * 2, B_FS = B_HID2 + SZ_HID2, SZ_FS = (size_t)MOE_ROWS * D * 2, B_OVL_END = B_FS + SZ_FS;
constexpr size_t B_REGB = al256(B_REGA_END > B_OVL_END ? B_REGA_END : B_OVL_END);
constexpr size_t B_V1 = B_REGB, B_VG = B_V1 + SZ_SEQB, B_RE = B_VG + SZ_FS, B_RG = B_RE + (size_t)SEQ * 8, B_SLOT = B_RG + (size_t)SEQ * 8, B_CNT = B_SLOT + (size_t)SEQ * 8,
                 B_TILE = B_CNT + 256 * 8 * 4, B_L1_END = B_TILE + 4096;
constexpr size_t WS_END_L1 = WS_ARENA + B_L1_END;
constexpr size_t WS_NEED = WS_END_L0 > WS_END_L1 ? WS_END_L0 : WS_END_L1;
static_assert(WS_NEED <= (size_t)1879048192, "workspace map exceeds the guaranteed size");

constexpr int CW_TMO = 0, CW_CODE = 1, CW_BAR = 4096;

#define GAS __attribute__((address_space(1)))
#define LAS __attribute__((address_space(3)))
typedef unsigned short bf16;
typedef unsigned v4u __attribute__((ext_vector_type(4)));
typedef unsigned v2u __attribute__((ext_vector_type(2)));
typedef float f32x4 __attribute__((ext_vector_type(4)));
typedef float f32x2 __attribute__((ext_vector_type(2)));
typedef short bf16x8 __attribute__((ext_vector_type(8)));
typedef GAS unsigned gu32;
#define RLX_AGENT __ATOMIC_RELAXED, __HIP_MEMORY_SCOPE_AGENT
#define LDS_WAIT() asm volatile("s_waitcnt lgkmcnt(0)" ::: "memory")
#define VM_WAIT() asm volatile("s_waitcnt vmcnt(0)" ::: "memory")
__device__ __forceinline__ unsigned f2bf(float f) { unsigned u = __builtin_bit_cast(unsigned, f); return (u + 0x7fffu + ((u >> 16) & 1u)) >> 16; }
typedef __bf16 bf16x2_t __attribute__((ext_vector_type(2)));
__device__ __forceinline__ unsigned pk2(float lo, float hi) { const f32x2 v = {lo, hi}; return __builtin_bit_cast(unsigned, __builtin_convertvector(v, bf16x2_t)); }
__device__ __forceinline__ float bflo(unsigned w) { return __builtin_bit_cast(float, w << 16); }
__device__ __forceinline__ float bfhi(unsigned w) { return __builtin_bit_cast(float, w & 0xffff0000u); }
__device__ __forceinline__ float bf2f(bf16 b) { return __builtin_bit_cast(float, (unsigned)b << 16); }
__device__ __forceinline__ float sigmoidf_(float x) { return __builtin_amdgcn_rcpf(1.f + __expf(-x)); }
__device__ __forceinline__ float siluf_(float x) { return x * __builtin_amdgcn_rcpf(1.f + __expf(-x)); }
__device__ __forceinline__ float swiglu_fast(float ag, float au, float negsg_log2e, float kk) { const float e = __builtin_amdgcn_exp2f(ag * negsg_log2e); return (ag * au) * (kk * __builtin_amdgcn_rcpf(1.f + e)); }
__device__ __forceinline__ float gelu_tanh(float y) { const float z = 0.7978845608028654f * (y + 0.044715f * y * y * y); const float e = __expf(2.f * z); const float th = 1.f - 2.f * __builtin_amdgcn_rcpf(e + 1.f); return 0.5f * y * (1.f + th); }

#define XB_TMO      128
#define XB_XCNT(j)  (256  + 64 * (j))
#define XB_XSUB(j)  (1280 + 64 * (j))
#define XB_XGEN(j)  (2304 + 64 * (j))
#define XB_TOP      3328
#define XB_TOPGEN   3392
#define XCD_BAR_WORDS 3456
#define XB_SPIN_CAP (1u << 22)
__device__ __forceinline__ unsigned xb_ld(unsigned* p)              { return __hip_atomic_load(p, __ATOMIC_RELAXED, __HIP_MEMORY_SCOPE_AGENT); }
__device__ __forceinline__ unsigned xb_add(unsigned* p, unsigned v) { return __hip_atomic_fetch_add(p, v, __ATOMIC_RELAXED, __HIP_MEMORY_SCOPE_AGENT); }
__device__ __forceinline__ unsigned xb_xcc_id() { return (unsigned)__builtin_amdgcn_s_getreg((3 << 11) | 20) & 0xFu; }
#define XB_SPIN(cond, bar) do { unsigned _sp = 0; while (cond) { __builtin_amdgcn_s_sleep(1); \
    if ((++_sp & 255u) == 0u) { if (xb_ld(&(bar)[XB_TMO])) break; if (_sp > XB_SPIN_CAP) { atomicAdd(&(bar)[XB_TMO], 1u); break; } } } } while (0)
struct XcdBarrier { unsigned* bar; unsigned x; volatile LAS unsigned* st; };
__device__ __forceinline__ XcdBarrier xcd_barrier_post(unsigned* bar, volatile LAS unsigned* st) {
    XcdBarrier b; b.bar = bar; b.x = xb_xcc_id(); b.st = st;
    if (threadIdx.x == 0) (void)xb_add(&bar[XB_XCNT(b.x)], 1u);
    return b;
}
__device__ __forceinline__ void xcd_barrier_complete(unsigned* bar, unsigned x, unsigned& nloc, unsigned& nx) {
    const unsigned G = gridDim.x * gridDim.y * gridDim.z;
    unsigned sum, cnt, mine, sp = 0u;
    for (;;) {
        sum = 0u; cnt = 0u; mine = 0u;
#pragma unroll
        for (unsigned j = 0; j < 16; ++j) { const unsigned c = xb_ld(&bar[XB_XCNT(j)]); sum += c; cnt += (c > 0u) ? 1u : 0u; mine = (j == x) ? c : mine; }
        if (sum == G) break;
        __builtin_amdgcn_s_sleep(1);
        if ((++sp & 255u) == 0u) { if (xb_ld(&bar[XB_TMO])) break; if (sp > XB_SPIN_CAP) { atomicAdd(&bar[XB_TMO], 1u); break; } }
    }
    nloc = mine > 0u ? mine : 1u; nx = cnt > 0u ? cnt : 1u;
}
__device__ __forceinline__ void xcd_barrier(const XcdBarrier& b) {
    asm volatile("s_waitcnt vmcnt(0)" ::: "memory");
    __syncthreads();
    if (threadIdx.x == 0) {
        unsigned* bar = b.bar;
        __builtin_amdgcn_s_waitcnt(0);
        unsigned nloc = b.st[0], nx = b.st[1];
        if (nloc == 0u) { xcd_barrier_complete(bar, b.x, nloc, nx); b.st[0] = nloc; b.st[1] = nx; }
        const unsigned old = xb_add(&bar[XB_XSUB(b.x)], 1u);
        const unsigned gen = old / nloc;
        if (old + 1u == (gen + 1u) * nloc) {
            __builtin_amdgcn_fence(__ATOMIC_RELEASE, "agent");
            asm volatile("s_waitcnt vmcnt(0)" ::: "memory");
            const unsigned og = xb_add(&bar[XB_TOP], 1u);
            const unsigned tg = og / nx;
            if (og + 1u == (tg + 1u) * nx) xb_add(&bar[XB_TOPGEN], 1u);
            else XB_SPIN(xb_ld(&bar[XB_TOPGEN]) == tg, bar);
            __builtin_amdgcn_fence(__ATOMIC_ACQUIRE, "agent");
            xb_add(&bar[XB_XGEN(b.x)], 1u);
            asm volatile("s_waitcnt vmcnt(0)" ::: "memory");
        } else {
            XB_SPIN(xb_ld(&bar[XB_XGEN(b.x)]) == gen, bar);
            __builtin_amdgcn_fence(__ATOMIC_ACQUIRE, "agent");
            asm volatile("s_waitcnt vmcnt(0)" ::: "memory");
        }
    }
    __syncthreads();
}

constexpr int RING_OFF = 0, RING_BYTES = 131072;
constexpr int LDSCTL_OFF = RING_BYTES, MISC_OFF = LDSCTL_OFF + 320;
constexpr int LDS_BYTES = 147456;

#define CAS __attribute__((address_space(4)))
__device__ __forceinline__ const float* inp(int k) { const CAS char* ka = (const CAS char*)__builtin_amdgcn_kernarg_segment_ptr(); return *(const float* const CAS*)(ka + 8 * k); }
__device__ __forceinline__ float* karg_out() { const CAS char* ka = (const CAS char*)__builtin_amdgcn_kernarg_segment_ptr(); return *(float* const CAS*)(ka + 8 * 35); }
__device__ __forceinline__ unsigned char* karg_ws() { const CAS char* ka = (const CAS char*)__builtin_amdgcn_kernarg_segment_ptr(); return *(unsigned char* const CAS*)(ka + 8 * 36); }
__device__ __forceinline__ int karg_i(int k) { const CAS char* ka = (const CAS char*)__builtin_amdgcn_kernarg_segment_ptr(); return *(const CAS int*)(ka + 8 * 37 + 4 * k); }
struct Frame {
    LAS unsigned char* lds;
    volatile LAS unsigned* MISC;
    gu32* ctl;
    int tid, lane, wave, vcu, G;
    unsigned char* ws;
};
__device__ __forceinline__ float wave_sum(float v) {
#pragma unroll
    for (int o = 1; o < 64; o <<= 1) v += __shfl_xor(v, o);
    return v;
}

struct RmIdent { int off; __device__ __forceinline__ int operator()(int n) const { return n + off; } };
struct RmGateUp { int which; __device__ __forceinline__ int operator()(int n) const { return (n >> 7) * 256 + which * 128 + (n & 127); } };
struct RmWinO { __device__ __forceinline__ int operator()(int n) const {
    if (n < 2048) return n; if (n < 2064) return 4608 + (n - 2048); return n - 16; } };
template <class RM> __device__ __forceinline__ void tr_item(const float* W, int K, int N, bf16* WT, int ldt, const RM rm, LAS float* scr, int item, int lane) {
    const int nblk = (N + 31) / 32, kb = item / nblk, nb = item - kb * nblk, k0 = 64 * kb, n0 = 32 * nb;
    const int c4 = (lane & 7) * 4, r8 = lane >> 3; const bool okc = (n0 + c4) < N;
    f32x4 v[8];
#pragma unroll
    for (int i = 0; i < 8; ++i) v[i] = okc ? *(const GAS f32x4*)(W + (size_t)(k0 + 8 * i + r8) * N + n0 + c4) : (f32x4){0.f, 0.f, 0.f, 0.f};
#pragma unroll
    for (int i = 0; i < 8; ++i) { LAS float* s = scr + (8 * i + r8) * 33 + c4; s[0] = v[i][0]; s[1] = v[i][1]; s[2] = v[i][2]; s[3] = v[i][3]; }
    LDS_WAIT(); asm volatile("" ::: "memory");
    const int c = lane & 7;
#pragma unroll
    for (int j = 0; j < 4; ++j) { const int n = (lane >> 3) + 8 * j; const LAS float* s = scr + (8 * c) * 33 + n;
        v4u o; o.x = pk2(s[0 * 33], s[1 * 33]); o.y = pk2(s[2 * 33], s[3 * 33]); o.z = pk2(s[4 * 33], s[5 * 33]); o.w = pk2(s[6 * 33], s[7 * 33]);
        if (n0 + n < N) *(GAS v4u*)(WT + (size_t)rm(n0 + n) * ldt + k0 + 8 * c) = o; }
    LDS_WAIT(); asm volatile("" ::: "memory");
}
__device__ __forceinline__ void zero_rows(bf16* p, size_t nbytes, int gt, int ngt) {
    for (size_t i = (size_t)gt; i < nbytes / 16; i += (size_t)ngt) ((GAS v4u*)p)[i] = (v4u){0u, 0u, 0u, 0u};
}
__device__ __forceinline__ unsigned pk4_fp8(float a, float b, float c, float d) { int w = 0; w = __builtin_amdgcn_cvt_pk_fp8_f32(a, b, w, false); w = __builtin_amdgcn_cvt_pk_fp8_f32(c, d, w, true); return (unsigned)w; }
template <class RM> __device__ __forceinline__ void tr_item8(const float* W, int K, int N, unsigned char* WT, int ldt, const RM rm, float sc, LAS float* scr, int item, int lane) {
    const int nblk = (N + 31) / 32, kb = item / nblk, nb = item - kb * nblk, k0 = 64 * kb, n0 = 32 * nb;
    const int c4 = (lane & 7) * 4, r8 = lane >> 3; const bool okc = (n0 + c4) < N;
    f32x4 v[8];
#pragma unroll
    for (int i = 0; i < 8; ++i) v[i] = okc ? *(const GAS f32x4*)(W + (size_t)(k0 + 8 * i + r8) * N + n0 + c4) : (f32x4){0.f, 0.f, 0.f, 0.f};
#pragma unroll
    for (int i = 0; i < 8; ++i) { LAS float* s = scr + (8 * i + r8) * 33 + c4; s[0] = v[i][0]; s[1] = v[i][1]; s[2] = v[i][2]; s[3] = v[i][3]; }
    LDS_WAIT(); asm volatile("" ::: "memory");
    const int c = lane & 7;
#pragma unroll
    for (int j = 0; j < 4; ++j) { const int n = (lane >> 3) + 8 * j; const LAS float* s = scr + (8 * c) * 33 + n;
        v2u o; o.x = pk4_fp8(s[0 * 33] * sc, s[1 * 33] * sc, s[2 * 33] * sc, s[3 * 33] * sc); o.y = pk4_fp8(s[4 * 33] * sc, s[5 * 33] * sc, s[6 * 33] * sc, s[7 * 33] * sc);
        if (n0 + n < N) *(GAS v2u*)(WT + (size_t)rm(n0 + n) * ldt + k0 + 8 * c) = o; }
    LDS_WAIT(); asm volatile("" ::: "memory");
}
constexpr int items_of(int K, int N) { return (K / 64) * ((N + 31) / 32); }

__device__ __forceinline__ void s5_small_tables(Frame& F, int g) {
    const float* lam_re = inp(I_LAMRE); const float* lam_im = inp(I_LAMIM); const float* log_dt = inp(I_LOGDT);
    const float* b_re = inp(I_BRE); const float* b_im = inp(I_BIM); const float* c_re = inp(I_CRE); const float* c_im = inp(I_CIM);
    LAS f32x2* APOW = (LAS f32x2*)(F.lds); LAS f32x2* BB = (LAS f32x2*)(F.lds + 2 * 64 * 65 * 8); LAS f32x2* CC = BB + 2 * 64 * 16;
    const int tid = F.tid;
    __syncthreads();
    if (tid < 128) {
        const int dir = tid >> 6, p = tid & 63; const int gi = (dir * S5G + g);
        const double dt = exp((double)log_dt[gi]); const double lr = (double)lam_re[gi * 64 + p], li = (double)lam_im[gi * 64 + p];
        const double mag = exp(lr * dt), ar = mag * cos(li * dt), ai = mag * sin(li * dt);
        double pr = 1.0, pi = 0.0;
        for (int k = 0; k <= 64; ++k) { APOW[(dir * 64 + p) * 65 + k] = (f32x2){(float)pr, (float)pi}; const double nr = pr * ar - pi * ai, ni = pr * ai + pi * ar; pr = nr; pi = ni; }
        const double den = lr * lr + li * li, nr = ar - 1.0, ni = ai;
        const double kr = (nr * lr + ni * li) / den, ki = (ni * lr - nr * li) / den;
        for (int n = 0; n < 16; ++n) { const double br = (double)b_re[(gi * 64 + p) * 16 + n], bi = (double)b_im[(gi * 64 + p) * 16 + n];
            BB[(dir * 64 + p) * 16 + n] = (f32x2){(float)(kr * br - ki * bi), (float)(kr * bi + ki * br)}; }
    }
    for (int i = tid; i < 2 * 16 * 64; i += NTHR) { const int dir = i >> 10, r = i & 1023; CC[i] = (f32x2){c_re[(size_t)(dir * S5G + g) * 1024 + r], c_im[(size_t)(dir * S5G + g) * 1024 + r]}; }
    __syncthreads();
}
__device__ __forceinline__ void s5_stage_a(Frame& F, int g, int part) {
    LAS f32x2* APOW = (LAS f32x2*)(F.lds); LAS f32x2* BB = (LAS f32x2*)(F.lds + 2 * 64 * 65 * 8); LAS f32x2* CC = BB + 2 * 64 * 16;
    float* TBG = (float*)(F.ws + WS_ARENA + A_TBG) + (size_t)g * (2 * 64 * 256);
    bf16* M1T = (bf16*)(F.ws + WS_ARENA + A_M1T) + (size_t)g * 256 * 1024;
    const int tid = F.tid;
    for (int i0 = tid; i0 < 2 * 8 * 256; i0 += NTHR) {
        const int dir = i0 >> 11, dl = 8 * part + ((i0 >> 8) & 7), np = (i0 >> 4) & 15, n = i0 & 15; float s = 0.f;
        for (int p = 0; p < 64; ++p) { const f32x2 c = CC[(dir * 16 + np) * 64 + p], a = APOW[(dir * 64 + p) * 65 + dl], b = BB[(dir * 64 + p) * 16 + n];
            const float zr = c.x * a.x - c.y * a.y, zi = c.x * a.y + c.y * a.x; s += zr * b.x - zi * b.y; }
        TBG[((dir * 64 + dl) * 16 + np) * 16 + n] = s;
    }
    for (int i = tid; i < 32 * 128; i += NTHR) {
        const int j = 32 * part + (i >> 7), c8 = (i & 127) * 8, sI = c8 >> 4, n0 = c8 & 15, dir = j >> 7, pt = (j >> 6) & 1, p = j & 63, e = dir ? sI : 63 - sI;
        const f32x2 a = APOW[(dir * 64 + p) * 65 + e]; float v[8];
#pragma unroll
        for (int q = 0; q < 8; ++q) { const f32x2 b = BB[(dir * 64 + p) * 16 + n0 + q]; v[q] = pt ? (a.x * b.y + a.y * b.x) : (a.x * b.x - a.y * b.y); }
        v4u o; o.x = pk2(v[0], v[1]); o.y = pk2(v[2], v[3]); o.z = pk2(v[4], v[5]); o.w = pk2(v[6], v[7]);
        *(GAS v4u*)(M1T + (size_t)j * 1024 + c8) = o;
    }
}
__device__ __forceinline__ void s5_stage_b(Frame& F, int g, int part) {
    LAS f32x2* APOW = (LAS f32x2*)(F.lds); LAS f32x2* CC = (LAS f32x2*)(F.lds + 2 * 64 * 65 * 8) + 2 * 64 * 16;
    const float* TBG = (const float*)(F.ws + WS_ARENA + A_TBG) + (size_t)g * (2 * 64 * 256);
    bf16* K3T = (bf16*)(F.ws + WS_ARENA + A_K3T) + (size_t)g * 1024 * S5K;
#pragma unroll 4
    for (int i = F.tid; i < 128 * (S5K / 8); i += NTHR) {
        const int row = 128 * part + i / (S5K / 8), c8 = (i % (S5K / 8)) * 8, tau = row >> 4, np = row & 15; float v[8];
        if (c8 < 1024) { const int sI = c8 >> 4, n0 = c8 & 15;
            f32x4 f0 = {0.f, 0.f, 0.f, 0.f}, f1 = f0, b0 = f0, b1 = f0;
            if (sI <= tau) { const GAS f32x4* tb = (const GAS f32x4*)(TBG + ((0 * 64 + (tau - sI)) * 16 + np) * 16 + n0); f0 = tb[0]; f1 = tb[1]; }
            if (sI >= tau) { const GAS f32x4* tb = (const GAS f32x4*)(TBG + ((1 * 64 + (sI - tau)) * 16 + np) * 16 + n0); b0 = tb[0]; b1 = tb[1]; }
            f0 += b0; f1 += b1; v[0] = f0[0]; v[1] = f0[1]; v[2] = f0[2]; v[3] = f0[3]; v[4] = f1[0]; v[5] = f1[1]; v[6] = f1[2]; v[7] = f1[3];
        } else { const int j0 = c8 - 1024, dir = j0 >> 7, pt = (j0 >> 6) & 1, e = dir ? 64 - tau : tau + 1;
#pragma unroll
            for (int q = 0; q < 8; ++q) { const int p = (j0 & 63) + q; const f32x2 c = CC[(dir * 16 + np) * 64 + p], a = APOW[(dir * 64 + p) * 65 + e];
                v[q] = pt ? -(c.x * a.y + c.y * a.x) : (c.x * a.x - c.y * a.y); } }
        v4u o; o.x = pk2(v[0], v[1]); o.y = pk2(v[2], v[3]); o.z = pk2(v[4], v[5]); o.w = pk2(v[6], v[7]);
        *(GAS v4u*)(K3T + (size_t)row * S5K + c8) = o;
    }
}

__device__ __forceinline__ void mod_item(Frame& F, int item) {
    const int l = item >> 7, slab = item & 127, col0 = 96 * slab;
    const float* wm = inp(I_WMOD) + (size_t)l * 2048 * 12288; const float* bm = inp(I_BMOD) + (size_t)l * 12288;
    LAS float* sv = (LAS float*)F.lds;
    LAS float* part = sv + 4096;
    __syncthreads();
    for (int i = F.tid; i < 4096; i += NTHR) { const float x = (i < 2048) ? inp(I_C)[i] : inp(I_CCTX)[i - 2048]; sv[i] = siluf_(x); }
    __syncthreads();
    const int sub = F.lane / 24, cl = F.lane % 24;
    f32x4 a0 = {0.f, 0.f, 0.f, 0.f}, a1 = {0.f, 0.f, 0.f, 0.f};
    if (sub < 2) {
        const float* wp = wm + (size_t)(256 * F.wave + sub) * 12288 + col0 + 4 * cl;
#pragma unroll 8
        for (int kk = 0; kk < 256; kk += 2) { const f32x4 w = *(const GAS f32x4*)(wp + (size_t)kk * 12288); const int k = 256 * F.wave + kk + sub;
            const float s0 = sv[k], s1 = sv[2048 + k]; a0 += w * s0; a1 += w * s1; }
        LAS float* pp = part + ((F.wave * 2 + sub) * 24 + cl) * 8;
        pp[0] = a0[0]; pp[1] = a0[1]; pp[2] = a0[2]; pp[3] = a0[3]; pp[4] = a1[0]; pp[5] = a1[1]; pp[6] = a1[2]; pp[7] = a1[3];
    }
    __syncthreads();
    if (F.tid < 192) { const int w = F.tid / 96, c = F.tid % 96; float s = 0.f;
        for (int q = 0; q < 16; ++q) s += part[(q * 24 + (c >> 2)) * 8 + w * 4 + (c & 3)];
        float* MODF = (float*)(F.ws + WS_MODF); MODF[(size_t)(l * 2 + w) * 12288 + col0 + c] = s + bm[col0 + c]; }
    __syncthreads();
}

constexpr int units_of(int K, int N) { return (K / 128) * ((N + 255) / 256); }
constexpr int CU_SQ = units_of(2048, 2048), CU_PW = units_of(384, 384), CU_GL = units_of(512, 512), CU_UP = units_of(2048, 7168), CU_DN = units_of(7168, 2048), CU_WO = units_of(2048, 4624);
constexpr int CQ_E0 = 0, CQ_E1 = CQ_E0 + CU_SQ  , CQ_E2 = CQ_E1 + 4 * CU_PW  , CQ_E3 = CQ_E2 + CU_GL  , CQ_E4 = CQ_E3 + CU_SQ  ,
              CQ_F1 = CQ_E4 + CU_UP  , CQ_F2 = CQ_F1 + CU_UP  , CQ_F3 = CQ_F2 + CU_DN  , CQ_O1 = CQ_F3 + CU_WO  , CQ_O2 = CQ_O1 + CU_SQ  ,
              CQ_M1 = CQ_O2 + 8 * CU_UP  , CQ_M2 = CQ_M1 + 8 * CU_UP  , CQ_M3 = CQ_M2 + 8 * CU_DN  , CQ_END = CQ_M3;
constexpr int CW_QUEUE = 2048;
struct ConvDesc { const float* W; unsigned char* WT; int N, ldt, kind, fp8, k0, n0, pitch, kbyte; float sc; };
__device__ __forceinline__ void conv_decode(Frame& F, int it, ConvDesc& d) {
    int r = it; d.kind = 0; d.fp8 = 0; d.sc = 1.f;
    if (r < CQ_E1) { d.W = inp(I_EWIN); d.WT = F.ws + WS_WINE; d.N = 2048; d.ldt = 2048; }
    else if (r < CQ_E2) { r -= CQ_E1; const int g4 = r / CU_PW; d.W = inp(I_EPOOLW) + (size_t)g4 * 384 * 384; d.WT = F.ws + WS_WPOOL + (size_t)g4 * 512 * 384 * 2; d.N = 384; d.ldt = 384; r -= g4 * CU_PW; }
    else if (r < CQ_E3) { d.W = inp(I_WGLU); d.WT = F.ws + WS_WGLU; d.N = 512; d.ldt = 512; r -= CQ_E2; }
    else if (r < CQ_E4) { d.W = inp(I_EWOUT); d.WT = F.ws + WS_WOUTE; d.N = 2048; d.ldt = 2048; r -= CQ_E3; }
    else if (r < CQ_F2) { const int up = r >= CQ_F1; d.W = inp(up ? I_FFU : I_FFG); d.WT = F.ws + WS_WGU; d.N = 7168; d.ldt = 2048; d.kind = 1 + up; r -= (up ? CQ_F1 : CQ_E4);
        if (FFN_FP8 == 1) { d.fp8 = 1; d.sc = MOE_WSC_GU; } }
    else if (r < CQ_F3) { d.W = inp(I_FFD); d.WT = F.ws + WS_WDN; d.N = 2048; d.ldt = 7168; r -= CQ_F2; if (FFN_FP8 != 0) { d.fp8 = 1; d.sc = MOE_WSC_DN; } }
    else if (r < CQ_O1) { d.W = inp(I_OWIN); d.WT = F.ws + WS_WINO; d.N = 4624; d.ldt = 2048; d.kind = 3; r -= CQ_F3; }
    else if (r < CQ_O2) { d.W = inp(I_OWOUT); d.WT = F.ws + WS_WOUTO; d.N = 2048; d.ldt = 2048; r -= CQ_O1; }
    else if (r < CQ_M2) { d.fp8 = 1; const int up = r >= CQ_M1; r -= up ? CQ_M1 : CQ_O2; const int e = r / CU_UP; d.W = inp(up ? I_MOEU : I_MOEG) + (size_t)e * 2048 * 7168; d.WT = F.ws + WS_WMGU + (size_t)e * 14336 * 2048;
        d.N = 7168; d.ldt = 2048; d.kind = 1 + up; d.sc = MOE_WSC_GU; r -= e * CU_UP; }
    else { d.fp8 = 1; r -= CQ_M2; const int e = r / CU_DN; d.W = inp(I_MOED) + (size_t)e * 7168 * 2048; d.WT = F.ws + WS_WMDN + (size_t)e * 2048 * 7168; d.N = 2048; d.ldt = 7168; d.sc = MOE_WSC_DN; r -= e * CU_DN; }
    const int nblk = (d.N + 255) / 256, kb = r / nblk; d.k0 = 128 * kb; d.n0 = 256 * (r - kb * nblk);
    d.pitch = d.fp8 ? d.ldt : 2 * d.ldt; d.kbyte = d.fp8 ? d.k0 : 2 * d.k0;
    if (FFN_FP8 == 2 && FFNU_K1 < 2048 && it >= CQ_E4 && it < CQ_F2) {
        d.pitch = 2 * FFNU_K1 + (2048 - FFNU_K1);
        if (d.k0 >= FFNU_K1) { d.fp8 = 1; d.sc = MOE_WSC_GU; d.kbyte = 2 * FFNU_K1 + (d.k0 - FFNU_K1); } }
}
__device__ __forceinline__ int conv_row(int kind, int n) {
    if (kind == 0) return n; if (kind == 3) return RmWinO{}(n); return (n >> 7) * 256 + (kind - 1) * 128 + (n & 127); }
__device__ __forceinline__ void conv_load(const ConvDesc& d, int wave, int lane, f32x4 (&v)[16]) {
    const bool okc = (d.n0 + 4 * lane) < d.N; const float* p = d.W + (size_t)(d.k0 + 16 * wave) * d.N + d.n0 + 4 * lane;
#pragma unroll
    for (int i = 0; i < 16; ++i) v[i] = okc ? __builtin_nontemporal_load((const GAS f32x4*)(p + (size_t)i * d.N)) : (f32x4){0.f, 0.f, 0.f, 0.f};
}
__device__ __forceinline__ void conv_to_lds(const f32x4 (&v)[16], LAS float* tile, int wave, int lane) {
#pragma unroll
    for (int i = 0; i < 16; ++i) *(LAS f32x4*)(tile + (16 * wave + i) * 256 + ((lane ^ ((2 * wave + (i >> 3)) & 7)) << 2)) = v[i];
}
__device__ __forceinline__ void conv_store(const ConvDesc& d, const LAS float* tile, int tid) {
    const int c = tid & 7;
    if (d.fp8) {
#pragma unroll
        for (int q = 0; q < 4; ++q) { const int nn = (tid >> 3) + 64 * q; float x[16];
#pragma unroll
            for (int j = 0; j < 16; ++j) { const int k = 16 * c + j; x[j] = tile[k * 256 + ((((nn >> 2) ^ ((k >> 3) & 7)) & 63) << 2) + (nn & 3)]; }
            if (d.n0 + nn < d.N) { const size_t row = (size_t)conv_row(d.kind, d.n0 + nn); v4u o;
                o.x = pk4_fp8(x[0] * d.sc, x[1] * d.sc, x[2] * d.sc, x[3] * d.sc); o.y = pk4_fp8(x[4] * d.sc, x[5] * d.sc, x[6] * d.sc, x[7] * d.sc);
                o.z = pk4_fp8(x[8] * d.sc, x[9] * d.sc, x[10] * d.sc, x[11] * d.sc); o.w = pk4_fp8(x[12] * d.sc, x[13] * d.sc, x[14] * d.sc, x[15] * d.sc);
                __builtin_nontemporal_store(o, (GAS v4u*)(d.WT + row * d.pitch + d.kbyte + 16 * c)); } }
    } else {
#pragma unroll
        for (int q = 0; q < 8; ++q) { const int kh = q & 1, nn = (tid >> 3) + 64 * (q >> 1); const LAS float* s = tile + (64 * kh + 8 * c) * 256 + (((nn >> 2) ^ c) << 2) + (nn & 3);
            float x[8];
#pragma unroll
            for (int j = 0; j < 8; ++j) x[j] = s[j * 256];
            if (d.n0 + nn < d.N) { const size_t row = (size_t)conv_row(d.kind, d.n0 + nn);
                v4u o; o.x = pk2(x[0], x[1]); o.y = pk2(x[2], x[3]); o.z = pk2(x[4], x[5]); o.w = pk2(x[6], x[7]);
                __builtin_nontemporal_store(o, (GAS v4u*)(d.WT + row * d.pitch + d.kbyte + (64 * kh + 8 * c) * 2)); } }
    }
}
constexpr int CQ_NONE = 0x7fffffff;
__device__ __forceinline__ int conv_pull(Frame& F) { return (int)__hip_atomic_fetch_add((unsigned*)(F.ctl + CW_QUEUE), 1u, RLX_AGENT); }
__device__ __forceinline__ void conv_work(Frame& F, int dlimit, int quota) {
    LAS float* tile = (LAS float*)(F.lds + RING_OFF);
    volatile LAS int* QW = (volatile LAS int*)(F.lds + LDSCTL_OFF);
    __syncthreads();
    if (F.tid == 0) { int c0 = CQ_NONE, c1 = CQ_NONE; const int head = (int)__hip_atomic_load((unsigned*)(F.ctl + CW_QUEUE), RLX_AGENT);
        if (head < CQ_END && (quota > 0 || head < dlimit)) { c0 = conv_pull(F); if (c0 < CQ_END && (quota > 1 || c0 < dlimit)) c1 = conv_pull(F); }
        QW[0] = c0; QW[1] = c1; }
    __syncthreads();
    int cur = __builtin_amdgcn_readfirstlane(QW[0]), nxt = __builtin_amdgcn_readfirstlane(QW[1]);
    int npull = (cur != CQ_NONE) + (nxt != CQ_NONE);
    __syncthreads();
    if (cur >= CQ_END) return;
    ConvDesc d; f32x4 v[16]; conv_decode(F, cur, d); conv_load(d, F.wave, F.lane, v);
    for (;;) {
        conv_to_lds(v, tile, F.wave, F.lane); LDS_WAIT(); __syncthreads();
        const bool more = nxt < CQ_END; ConvDesc dn = d;
        if (more) { conv_decode(F, nxt, dn); conv_load(dn, F.wave, F.lane, v); }
        const bool pull = more && (npull < quota || nxt < dlimit);
        conv_store(d, tile, F.tid);
        if (pull && F.tid == 0) QW[0] = conv_pull(F);
        LDS_WAIT(); __syncthreads();
        if (!more) break;
        cur = nxt; nxt = pull ? __builtin_amdgcn_readfirstlane(QW[0]) : CQ_NONE; npull += pull ? 1 : 0; d = dn;
    }
}
__device__ __forceinline__ int fill_quota(int nunits, int G, int c, int Q) { const int mine = nunits > c ? (nunits - 1 - c) / G + 1 : 0, most = (nunits + G - 1) / G; return mine < most ? Q : 0; }
__device__ __forceinline__ void p0_prologue(Frame& F) {
    const int gw = F.vcu * NWAVES + F.wave, NGW = F.G * NWAVES, gt = gw * 64 + F.lane, ngt = NGW * 64;
    for (int it = blockIdx.x; it < 256; it += F.G) mod_item(F, it);
    for (int it = blockIdx.x; it < S5G * 8; it += F.G) { s5_small_tables(F, it >> 3); s5_stage_a(F, it >> 3, it & 7); }
    { float* rp = (float*)(F.ws + WS_ROPE); for (int i = gt; i < 256 * 32; i += ngt) { const int pos = i >> 5, fi = i & 31; const float fr = powf(10000.f, -(float)fi / 32.f), ang = (float)pos * fr;
        rp[2 * i] = cosf(ang); rp[2 * i + 1] = sinf(ang); } }
    for (int g4 = 0; g4 < 4; ++g4) zero_rows((bf16*)(F.ws + WS_WPOOL) + ((size_t)g4 * 512 + 384) * 384, (size_t)128 * 384 * 2, gt, ngt);
    zero_rows((bf16*)(F.ws + WS_WINO) + (size_t)4624 * 2048, (size_t)(WINO_N - 4624) * 2048 * 2, gt, ngt);
    __syncthreads();
    conv_work(F, CQ_E4, 0);
    __syncthreads();
}

#define PV(k) ((LAS float*)(F.lds + (k) * 8192))
__device__ __forceinline__ void ld_row_f32(const float* p, int lane, f32x4 (&v)[8]) {
#pragma unroll
    for (int j = 0; j < 8; ++j) v[j] = *(const GAS f32x4*)(p + 4 * lane + 256 * j);
}
__device__ __forceinline__ void st_row_f32(float* p, int lane, const f32x4 (&v)[8]) {
#pragma unroll
    for (int j = 0; j < 8; ++j) *(GAS f32x4*)(p + 4 * lane + 256 * j) = v[j];
}
__device__ __forceinline__ void ld_row_bf16(const bf16* p, int lane, f32x4 (&v)[8]) {
#pragma unroll
    for (int j = 0; j < 8; ++j) { const v2u w = *(const GAS v2u*)(p + 4 * lane + 256 * j); v[j] = (f32x4){bflo(w.x), bfhi(w.x), bflo(w.y), bfhi(w.y)}; }
}
__device__ __forceinline__ void st_row_bf16(bf16* p, int lane, const f32x4 (&v)[8]) {
#pragma unroll
    for (int j = 0; j < 8; ++j) { v2u w; w.x = pk2(v[j][0], v[j][1]); w.y = pk2(v[j][2], v[j][3]); *(GAS v2u*)(p + 4 * lane + 256 * j) = w; }
}
__device__ __forceinline__ float row_sumsq(const f32x4 (&v)[8]) {
    float s = 0.f;
#pragma unroll
    for (int j = 0; j < 8; ++j) s += (v[j][0] * v[j][0] + v[j][1] * v[j][1]) + (v[j][2] * v[j][2] + v[j][3] * v[j][3]);
    return wave_sum(s);
}
__device__ __forceinline__ f32x4 ldp(const LAS float* p, int lane, int j) { return *(const LAS f32x4*)(p + 4 * lane + 256 * j); }
__device__ __forceinline__ const float* modp(Frame& F, int layer, int w, int k) { return (const float*)(F.ws + WS_MODF) + (size_t)(layer * 2 + w) * 12288 + k * 2048; }
__device__ __forceinline__ const float* h0_row(Frame& F, int m) { return m < CTX ? inp(I_CTX) + (size_t)m * D : inp(I_X) + (size_t)(m - CTX) * D; }

__device__ __forceinline__ void ph_norm0(Frame& F) {
    __syncthreads();
    for (int i = F.tid; i < 2 * 2048; i += NTHR) { const int w = i >> 11, c = i & 2047;
        PV(2 * w)[c] = inp(I_NORMS)[0 * 2048 + c] * (1.f + modp(F, 0, w, 1)[c]); PV(2 * w + 1)[c] = modp(F, 0, w, 0)[c]; }
    __syncthreads();
    bf16* U = (bf16*)(F.ws + WS_ARENA + A_U);
    const int gw = F.vcu * NWAVES + F.wave, NGW = F.G * NWAVES;
    for (int m = gw; m < T; m += NGW) { const int w = m < CTX ? 1 : 0; f32x4 v[8]; ld_row_f32(h0_row(F, m), F.lane, v);
        const float rstd = 1.f / sqrtf(row_sumsq(v) * (1.f / D) + EPS);
#pragma unroll
        for (int j = 0; j < 8; ++j) v[j] = v[j] * rstd * ldp(PV(2 * w), F.lane, j) + ldp(PV(2 * w + 1), F.lane, j);
        st_row_bf16(U + (size_t)m * D, F.lane, v); }
}
__device__ __forceinline__ void ph_norm1(Frame& F) {
    __syncthreads();
    for (int i = F.tid; i < 2 * 2048; i += NTHR) { const int w = i >> 11, c = i & 2047;
        PV(3 * w)[c] = modp(F, 0, w, 2)[c] * inp(I_NORMS)[1 * 2048 + c]; PV(3 * w + 1)[c] = inp(I_NORMS)[2 * 2048 + c] * (1.f + modp(F, 0, w, 4)[c]); PV(3 * w + 2)[c] = modp(F, 0, w, 3)[c]; }
    __syncthreads();
    const bf16* YO = (const bf16*)(F.ws + WS_ARENA + A_YO); bf16* V = (bf16*)(F.ws + WS_ARENA + A_V); bf16* HR = (bf16*)(F.ws + WS_HRES);
    const int gw = F.vcu * NWAVES + F.wave, NGW = F.G * NWAVES;
    for (int m = gw; m < T; m += NGW) { const int w = m < CTX ? 1 : 0; f32x4 y[8], h[8]; ld_row_bf16(YO + (size_t)m * D, F.lane, y); ld_row_f32(h0_row(F, m), F.lane, h);
        const float ry = 1.f / sqrtf(row_sumsq(y) * (1.f / D) + EPS);
#pragma unroll
        for (int j = 0; j < 8; ++j) h[j] = h[j] + y[j] * ry * ldp(PV(3 * w), F.lane, j);
        st_row_bf16(HR + (size_t)m * D, F.lane, h);
        const float rh = 1.f / sqrtf(row_sumsq(h) * (1.f / D) + EPS);
#pragma unroll
        for (int j = 0; j < 8; ++j) y[j] = h[j] * rh * ldp(PV(3 * w + 1), F.lane, j) + ldp(PV(3 * w + 2), F.lane, j);
#if FFN_FP8 == 1
        { unsigned char* V8 = (unsigned char*)V + (size_t)m * D;
#pragma unroll
          for (int j = 0; j < 8; ++j) *(GAS unsigned*)(V8 + 4 * F.lane + 256 * j) = pk4_fp8(y[j][0], y[j][1], y[j][2], y[j][3]); }
#elif FFN_FP8 == 2 && FFNU_K1 < 2048
        { unsigned char* Vr = (unsigned char*)V + (size_t)m * (2 * FFNU_K1 + (2048 - FFNU_K1));
#pragma unroll
          for (int j = 0; j < 8; ++j) { const int col = 4 * F.lane + 256 * j;
              if (256 * j < FFNU_K1) { v2u w; w.x = pk2(y[j][0], y[j][1]); w.y = pk2(y[j][2], y[j][3]); *(GAS v2u*)(Vr + 2 * col) = w; }
              else *(GAS unsigned*)(Vr + 2 * FFNU_K1 + (col - FFNU_K1)) = pk4_fp8(y[j][0], y[j][1], y[j][2], y[j][3]); } }
#else
        st_row_bf16(V + (size_t)m * D, F.lane, y);
#endif
    }
}
__device__ __forceinline__ void ph_norm2(Frame& F) {
    __syncthreads();
    for (int i = F.tid; i < 2 * 2048; i += NTHR) { const int w = i >> 11, c = i & 2047;
        PV(3 * w)[c] = modp(F, 0, w, 5)[c] * inp(I_NORMS)[3 * 2048 + c]; PV(3 * w + 1)[c] = inp(I_NORMS)[(4 + 0) * 2048 + c] * (1.f + modp(F, 1, w, 1)[c]); PV(3 * w + 2)[c] = modp(F, 1, w, 0)[c]; }
    __syncthreads();
    const bf16* FB = (const bf16*)(F.ws + WS_ARENA + A_F); bf16* U = (bf16*)(F.ws + WS_ARENA + A_U); bf16* HR = (bf16*)(F.ws + WS_HRES);
    const int gw = F.vcu * NWAVES + F.wave, NGW = F.G * NWAVES;
    for (int m = gw; m < T; m += NGW) { const int w = m < CTX ? 1 : 0; f32x4 y[8], h[8]; ld_row_bf16(FB + (size_t)m * D, F.lane, y); ld_row_bf16(HR + (size_t)m * D, F.lane, h);
        const float ry = 1.f / sqrtf(row_sumsq(y) * (1.f / D) + EPS);
#pragma unroll
        for (int j = 0; j < 8; ++j) h[j] = h[j] + y[j] * ry * ldp(PV(3 * w), F.lane, j);
        st_row_bf16(HR + (size_t)m * D, F.lane, h);
        const float rh = 1.f / sqrtf(row_sumsq(h) * (1.f / D) + EPS);
#pragma unroll
        for (int j = 0; j < 8; ++j) y[j] = h[j] * rh * ldp(PV(3 * w + 1), F.lane, j) + ldp(PV(3 * w + 2), F.lane, j);
        st_row_bf16(U + (size_t)m * D, F.lane, y); }
}
__device__ __forceinline__ void ph_emit(Frame& F, float* out) {
    const bf16* HR = (const bf16*)(F.ws + WS_HRES) + (size_t)CTX * D;
    for (size_t i = (size_t)blockIdx.x * NTHR + F.tid; i < (size_t)SEQ * D / 4; i += (size_t)F.G * NTHR) { const v2u w = ((const GAS v2u*)HR)[i]; ((GAS f32x4*)out)[i] = (f32x4){bflo(w.x), bfhi(w.x), bflo(w.y), bfhi(w.y)}; }
}

__device__ __forceinline__ void ph_pooldiff(Frame& F) {
    const bf16* ZP = (const bf16*)(F.ws + WS_ARENA + A_ZP); bf16* DP = (bf16*)(F.ws + WS_ARENA + A_DP);
    const size_t nitem = (size_t)T * (WPOOL / 8);
    for (size_t it = (size_t)F.vcu * NTHR + F.tid; it < nitem; it += (size_t)F.G * NTHR) {
        const int t = (int)(it / (WPOOL / 8)), c8 = (int)(it % (WPOOL / 8)) * 8, gi = c8 / PG, w = 2 << gi;
        const int s0 = t < CTX ? 0 : CTX, L = t < CTX ? CTX : SEQ, tp = t - s0;
        int lo = tp - w / 2; lo = lo < 0 ? 0 : lo; int hi = tp + (w - w / 2); hi = hi > L ? L : hi;
        float s[8];
#pragma unroll
        for (int q = 0; q < 8; ++q) s[q] = 0.f;
        for (int r = lo; r < hi; ++r) { const v4u x = *(const GAS v4u*)(ZP + (size_t)(s0 + r) * WPOOL + c8);
            s[0] += bflo(x.x); s[1] += bfhi(x.x); s[2] += bflo(x.y); s[3] += bfhi(x.y); s[4] += bflo(x.z); s[5] += bfhi(x.z); s[6] += bflo(x.w); s[7] += bfhi(x.w); }
        const float inv = 1.f / (float)(hi - lo); const v4u z = *(const GAS v4u*)(ZP + (size_t)t * WPOOL + c8);
        v4u o; o.x = pk2(s[0] * inv - bflo(z.x), s[1] * inv - bfhi(z.x)); o.y = pk2(s[2] * inv - bflo(z.y), s[3] * inv - bfhi(z.y));
        o.z = pk2(s[4] * inv - bflo(z.z), s[5] * inv - bfhi(z.z)); o.w = pk2(s[6] * inv - bflo(z.w), s[7] * inv - bfhi(z.w));
        *(GAS v4u*)(DP + (size_t)t * WPOOL + c8) = o;
    }
}

__device__ __forceinline__ void ph_s5scan(Frame& F) {
    const int gth = blockIdx.x * NTHR + F.tid; if (gth >= S5G * 2 * 64) return;
    const int g = gth >> 7, dir = (gth >> 6) & 1, p = gth & 63, gi = dir * S5G + g;
    const double dt = exp((double)inp(I_LOGDT)[gi]), lr = (double)inp(I_LAMRE)[gi * 64 + p], li = (double)inp(I_LAMIM)[gi * 64 + p];
    const float aLr = (float)(exp(lr * dt * LC) * cos(li * dt * LC)), aLi = (float)(exp(lr * dt * LC) * sin(li * dt * LC));
    const float* SL = (const float*)(F.ws + WS_ARENA + A_SLOC) + (size_t)g * S5ROWS * 256 + dir * 128 + p;
    bf16* CA = (bf16*)(F.ws + WS_ARENA + A_AS5) + (size_t)g * S5ROWS * S5K + 1024 + dir * 128 + p;
    float er = 0.f, ei = 0.f;
    for (int i0 = 0; i0 < NCH; i0 += 4) {
        int cc[4]; float sr[4], si[4];
#pragma unroll
        for (int q = 0; q < 4; ++q) { const int i = i0 + q; cc[q] = dir == 0 ? i : (i < NCH_CTX ? NCH_CTX - 1 - i : NCH - 1 - (i - NCH_CTX));
            sr[q] = SL[(size_t)cc[q] * 256]; si[q] = SL[(size_t)cc[q] * 256 + 64]; }
#pragma unroll
        for (int q = 0; q < 4; ++q) { CA[(size_t)cc[q] * S5K] = (bf16)f2bf(er); CA[(size_t)cc[q] * S5K + 64] = (bf16)f2bf(ei);
            const float nr = aLr * er - aLi * ei + sr[q], ni = aLr * ei + aLi * er + si[q]; er = nr; ei = ni; }
    }
}

typedef unsigned u32x4 __attribute__((ext_vector_type(4)));
using pg8::Unit; using pg8::pack8;
typedef const pg8::f32x4 (&AccRef)[2][2][4][2];
#define EPI_ROWS(u) const int row0 = (u).pm * 256 + wr * 64 + fr
struct EpiPlain { static constexpr bool PERM = true; bf16* O; int ldc;
    __device__ __forceinline__ void operator()(AccRef acc, const Unit& u, int wr, int wc, int fr, int fq) const { EPI_ROWS(u); const int col0 = u.pn * 256 + wc * 32 + 8 * fq;
#pragma unroll
        for (int ai = 0; ai < 2; ++ai)
#pragma unroll
            for (int m = 0; m < 4; ++m) { bf16* rp = O + (size_t)(row0 + ai * 128 + m * 16) * ldc + col0;
#pragma unroll
                for (int bj = 0; bj < 2; ++bj) *(GAS u32x4*)(rp + bj * 128) = pack8(acc[ai][bj][m][0], acc[ai][bj][m][1]); } } };
struct EpiWinE { static constexpr bool PERM = true; bf16* ZP; bf16* AS5;
    __device__ __forceinline__ void operator()(AccRef acc, const Unit& u, int wr, int wc, int fr, int fq) const { EPI_ROWS(u); const int col0 = u.pn * 256 + wc * 32 + 8 * fq;
#pragma unroll
        for (int ai = 0; ai < 2; ++ai)
#pragma unroll
            for (int m = 0; m < 4; ++m) { const int row = row0 + ai * 128 + m * 16;
#pragma unroll
                for (int bj = 0; bj < 2; ++bj) { const int col = col0 + bj * 128; const u32x4 w = pack8(acc[ai][bj][m][0], acc[ai][bj][m][1]);
                    if (u.pn < 6) *(GAS u32x4*)(ZP + (size_t)row * WPOOL + col) = w;
                    else { const int cc = col - WPOOL, g = cc >> 4, n0 = cc & 15, c = row >> 6, s = row & 63; *(GAS u32x4*)(AS5 + ((size_t)(g * S5ROWS + c) * S5K + s * 16 + n0)) = w; } } } } };
struct EpiPool { static constexpr bool PERM = true; bf16* YMIX; const float* scale;
    __device__ __forceinline__ void operator()(AccRef acc, const Unit& u, int wr, int wc, int fr, int fq) const { EPI_ROWS(u); const int lc0 = u.pn * 256 + wc * 32 + 8 * fq;
#pragma unroll
        for (int bj = 0; bj < 2; ++bj) { const int lc = lc0 + bj * 128; if (lc >= PG) continue; const int gc = u.bz * PG + lc;
            const f32x4 s0 = *(const GAS f32x4*)(scale + gc), s1 = *(const GAS f32x4*)(scale + gc + 4);
#pragma unroll
            for (int ai = 0; ai < 2; ++ai)
#pragma unroll
                for (int m = 0; m < 4; ++m) { const int row = row0 + ai * 128 + m * 16; *(GAS u32x4*)(YMIX + (size_t)row * D + gc) = pack8(acc[ai][bj][m][0] * s0, acc[ai][bj][m][1] * s1); } } } };
struct EpiSloc { static constexpr bool PERM = false; float* SL;
    __device__ __forceinline__ void operator()(AccRef acc, const Unit& u, int wr, int wc, int fr, int fq) const { EPI_ROWS(u); const int col0 = u.pn * 256 + wc * 32 + 4 * fq;
#pragma unroll
        for (int ai = 0; ai < 2; ++ai)
#pragma unroll
            for (int m = 0; m < 4; ++m) { float* rp = SL + ((size_t)u.bz * S5ROWS + row0 + ai * 128 + m * 16) * 256 + col0;
#pragma unroll
                for (int bj = 0; bj < 2; ++bj)
#pragma unroll
                    for (int n = 0; n < 2; ++n) *(GAS f32x4*)(rp + bj * 128 + n * 16) = acc[ai][bj][m][n]; } } };
struct EpiS5Y { static constexpr bool PERM = true; const bf16* AS5; const float* dsk; bf16* YG;
    __device__ __forceinline__ void operator()(AccRef acc, const Unit& u, int wr, int wc, int fr, int fq) const { EPI_ROWS(u); const int col0 = u.pn * 256 + wc * 32 + 8 * fq;
#pragma unroll
        for (int bj = 0; bj < 2; ++bj) { const int col = col0 + bj * 128, tau = col >> 4, n0 = col & 15;
            const f32x4 d0 = *(const GAS f32x4*)(dsk + u.bz * 16 + n0), d1 = *(const GAS f32x4*)(dsk + u.bz * 16 + n0 + 4);
#pragma unroll
            for (int ai = 0; ai < 2; ++ai)
#pragma unroll
                for (int m = 0; m < 4; ++m) { const int c = row0 + ai * 128 + m * 16; if (c >= NCH) continue;
                    const v4u x = *(const GAS v4u*)(AS5 + ((size_t)(u.bz * S5ROWS + c) * S5K + col));
                    f32x4 a = acc[ai][bj][m][0], b = acc[ai][bj][m][1];
                    a[0] = gelu_tanh(a[0] + bflo(x.x) * d0[0]); a[1] = gelu_tanh(a[1] + bfhi(x.x) * d0[1]); a[2] = gelu_tanh(a[2] + bflo(x.y) * d0[2]); a[3] = gelu_tanh(a[3] + bfhi(x.y) * d0[3]);
                    b[0] = gelu_tanh(b[0] + bflo(x.z) * d1[0]); b[1] = gelu_tanh(b[1] + bfhi(x.z) * d1[1]); b[2] = gelu_tanh(b[2] + bflo(x.w) * d1[2]); b[3] = gelu_tanh(b[3] + bfhi(x.w) * d1[3]);
                    *(GAS u32x4*)(YG + ((size_t)(c * 64 + tau) * WS5 + u.bz * 16 + n0)) = pack8(a, b); } } } };
struct EpiGlu { static constexpr bool PERM = true; const bf16* YG; bf16* YMIX;
    __device__ __forceinline__ void operator()(AccRef acc, const Unit& u, int wr, int wc, int fr, int fq) const { EPI_ROWS(u); const int col0 = u.pn * 256 + wc * 32 + 8 * fq;
#pragma unroll
        for (int ai = 0; ai < 2; ++ai)
#pragma unroll
            for (int m = 0; m < 4; ++m) { const int row = row0 + ai * 128 + m * 16;
#pragma unroll
                for (int bj = 0; bj < 2; ++bj) { const int col = col0 + bj * 128; const v4u x = *(const GAS v4u*)(YG + (size_t)row * WS5 + col);
                    f32x4 a = acc[ai][bj][m][0], b = acc[ai][bj][m][1];
                    a[0] = bflo(x.x) * sigmoidf_(a[0]); a[1] = bfhi(x.x) * sigmoidf_(a[1]); a[2] = bflo(x.y) * sigmoidf_(a[2]); a[3] = bfhi(x.y) * sigmoidf_(a[3]);
                    b[0] = bflo(x.z) * sigmoidf_(b[0]); b[1] = bfhi(x.z) * sigmoidf_(b[1]); b[2] = bflo(x.w) * sigmoidf_(b[2]); b[3] = bfhi(x.w) * sigmoidf_(b[3]);
                    *(GAS u32x4*)(YMIX + (size_t)row * D + WPOOL + col) = pack8(a, b); } } } };
struct EpiGateUp { static constexpr bool PERM = true; bf16* HID; int ldc;
    __device__ __forceinline__ void operator()(AccRef acc, const Unit& u, int wr, int wc, int fr, int fq) const { EPI_ROWS(u); const int col0 = u.pn * 128 + wc * 32 + 8 * fq;
#pragma unroll
        for (int ai = 0; ai < 2; ++ai)
#pragma unroll
            for (int m = 0; m < 4; ++m) { const int row = row0 + ai * 128 + m * 16; f32x4 a, b;
#pragma unroll
                for (int q = 0; q < 4; ++q) { a[q] = swiglu_fast(acc[ai][0][m][0][q], acc[ai][1][m][0][q], -1.4426950408889634f, 1.f); b[q] = swiglu_fast(acc[ai][0][m][1][q], acc[ai][1][m][1][q], -1.4426950408889634f, 1.f); }
                *(GAS u32x4*)(HID + (size_t)row * ldc + col0) = pack8(a, b); } } };

struct EpiWinO { static constexpr bool PERM = true; unsigned char* ar;
    __device__ __forceinline__ void operator()(AccRef acc, const Unit& u, int wr, int wc, int fr, int fq) const { EPI_ROWS(u); const int pn = u.pn;
        if (pn == 18) { if (wc == 0 && fq < 2) { float* ALR = (float*)(ar + B_ALR);
#pragma unroll
                for (int ai = 0; ai < 2; ++ai)
#pragma unroll
                    for (int m = 0; m < 4; ++m) { float* rp = ALR + (size_t)(row0 + ai * 128 + m * 16) * 16 + 8 * fq; *(GAS f32x4*)rp = acc[ai][0][m][0]; *(GAS f32x4*)(rp + 4) = acc[ai][0][m][1]; } }
            return; }
        bf16* base; int ld, c0;
        if (pn < 2) { base = (bf16*)(ar + B_GQ); ld = 512; c0 = pn * 256; } else if (pn < 4) { base = (bf16*)(ar + B_GK); ld = 512; c0 = (pn - 2) * 256; }
        else if (pn < 8) { base = (bf16*)(ar + B_GV); ld = 1024; c0 = (pn - 4) * 256; } else if (pn < 12) { base = (bf16*)(ar + B_R); ld = 1024; c0 = (pn - 8) * 256; }
        else if (pn < 16) { base = (bf16*)(ar + B_AQ); ld = 1024; c0 = (pn - 12) * 256; } else if (pn == 16) { base = (bf16*)(ar + B_AK); ld = 256; c0 = 0; } else { base = (bf16*)(ar + B_AV); ld = 256; c0 = 0; }
        const int col0 = c0 + wc * 32 + 8 * fq;
#pragma unroll
        for (int ai = 0; ai < 2; ++ai)
#pragma unroll
            for (int m = 0; m < 4; ++m) { bf16* rp = base + (size_t)(row0 + ai * 128 + m * 16) * ld + col0;
#pragma unroll
                for (int bj = 0; bj < 2; ++bj) *(GAS u32x4*)(rp + bj * 128) = pack8(acc[ai][bj][m][0], acc[ai][bj][m][1]); } } };

__device__ __forceinline__ void ph_qknorm(Frame& F) {
    unsigned char* ar = F.ws + WS_ARENA; bf16* AQ = (bf16*)(ar + B_AQ); bf16* AK = (bf16*)(ar + B_AK);
    const float* qn = inp(I_QNORM); const float* kn = inp(I_KNORM); const f32x2* rope = (const f32x2*)(F.ws + WS_ROPE);
    const size_t NQ = (size_t)SEQ * 8 * 8, NK = (size_t)T * 2 * 8;
    for (size_t it = (size_t)F.vcu * NTHR + F.tid; it < NQ + NK; it += (size_t)F.G * NTHR) {
        const bool isq = it < NQ; const size_t r = isq ? it : it - NQ; const int j = (int)(r & 7), hf = j >> 2, sub = j & 3;
        int row, head; bf16* p; const float* nw;
        if (isq) { head = (int)((r >> 3) & 7); row = CTX + (int)(r >> 6); p = AQ + (size_t)row * 1024 + head * 128; nw = qn; }
        else { head = (int)((r >> 3) & 1); row = (int)(r >> 4); p = AK + (size_t)row * 256 + head * 128; nw = kn; }
        const int d1 = 64 * hf + 8 * sub, d2 = d1 + 32;
        const v4u a = *(const GAS v4u*)(p + d1), b = *(const GAS v4u*)(p + d2);
        float x1[8] = {bflo(a.x), bfhi(a.x), bflo(a.y), bfhi(a.y), bflo(a.z), bfhi(a.z), bflo(a.w), bfhi(a.w)};
        float x2[8] = {bflo(b.x), bfhi(b.x), bflo(b.y), bfhi(b.y), bflo(b.z), bfhi(b.z), bflo(b.w), bfhi(b.w)};
        float ss = 0.f;
#pragma unroll
        for (int e = 0; e < 8; ++e) ss += x1[e] * x1[e] + x2[e] * x2[e];
        ss += __shfl_xor(ss, 1); ss += __shfl_xor(ss, 2); ss += __shfl_xor(ss, 4);
        const float rstd = 1.f / sqrtf(ss * (1.f / 128.f) + EPS);
        const bool rot = row >= CTX; const int tl = row - CTX, pos = hf ? (tl & 63) : (tl >> 6);
        float o1[8], o2[8];
#pragma unroll
        for (int e = 0; e < 8; ++e) { const float y1 = x1[e] * rstd * nw[d1 + e], y2 = x2[e] * rstd * nw[d2 + e];
            f32x2 cs = {1.f, 0.f}; if (rot) cs = rope[pos * 32 + 8 * sub + e];
            o1[e] = y1 * cs.x - y2 * cs.y; o2[e] = y1 * cs.y + y2 * cs.x; }
        v4u w1, w2; w1.x = pk2(o1[0], o1[1]); w1.y = pk2(o1[2], o1[3]); w1.z = pk2(o1[4], o1[5]); w1.w = pk2(o1[6], o1[7]);
        w2.x = pk2(o2[0], o2[1]); w2.y = pk2(o2[2], o2[3]); w2.z = pk2(o2[4], o2[5]); w2.w = pk2(o2[6], o2[7]);
        *(GAS v4u*)(p + d1) = w1; *(GAS v4u*)(p + d2) = w2;
        if (!isq) {
            unsigned char* k8 = ar + B_KDT + (size_t)row * 256 + head * 128 + 64 * (sub & 1) + 8 * (4 * hf + (sub >> 1));
            v2u a8, b8; a8.x = pk4_fp8(o1[0], o1[1], o1[2], o1[3]); a8.y = pk4_fp8(o1[4], o1[5], o1[6], o1[7]); b8.x = pk4_fp8(o2[0], o2[1], o2[2], o2[3]); b8.y = pk4_fp8(o2[4], o2[5], o2[6], o2[7]);
            *(GAS v2u*)k8 = a8; *(GAS v2u*)(k8 + 16) = b8; }
    }
}

constexpr size_t VT8_OFF = 8 * MiB;
__device__ __forceinline__ void ph_vt8(Frame& F) {
    unsigned char* ar = F.ws + WS_ARENA; const bf16* AV = (const bf16*)(ar + B_AV); unsigned char* VT8 = ar + B_KDT + VT8_OFF;
    const int ntask = 2 * NCH * 128 * 4;
    for (int it = F.vcu * NTHR + F.tid; it < ntask; it += F.G * NTHR) {
        const int g = it & 3, d = (it >> 2) & 127, tl = (it >> 9) % NCH, kvh = (it >> 9) / NCH, hi = g >> 1, blk = g & 1;
        float x[16];
#pragma unroll
        for (int r = 0; r < 16; ++r) { const int key = 32 * blk + (r & 3) + 8 * (r >> 2) + 4 * hi; x[r] = bf2f(AV[(size_t)(tl * 64 + key) * 256 + kvh * 128 + d]); }
        v4u o; o.x = pk4_fp8(x[0], x[1], x[2], x[3]); o.y = pk4_fp8(x[4], x[5], x[6], x[7]); o.z = pk4_fp8(x[8], x[9], x[10], x[11]); o.w = pk4_fp8(x[12], x[13], x[14], x[15]);
        *(GAS v4u*)(VT8 + ((size_t)(kvh * NCH + tl) * 128 + d) * 64 + g * 16) = o;
    }
}

namespace tri {
using s16x4 = __attribute__((ext_vector_type(4))) short;
__device__ __forceinline__ int st(int k, int c) { const int kk = (k & ~0xC) | ((k & 4) << 1) | ((k & 8) >> 1); return ((kk >> 3) * 4 + (c >> 5)) * 512 + ((kk & 7) * 32 + (c & 31)) * 2; }
__device__ __forceinline__ int rd_base(int lane) { return ((lane & 3) << 3) | (((lane >> 2) & 3) << 6) | (((lane >> 4) & 1) << 5) | (((lane >> 5) & 1) << 8); }
constexpr int rd_off(int d0, int ks, int half) { return d0 * 512 + ks * 4096 + half * 2048; }
template <int OFF> __device__ __forceinline__ s16x4 tr_read(int vb) { s16x4 r; asm volatile("ds_read_b64_tr_b16 %0, %1 offset:%2" : "=&v"(r) : "v"(vb), "i"(OFF) : "memory"); return r; }
struct Frag2 { s16x4 lo, hi; };
template <int D0, int KS> __device__ __forceinline__ Frag2 ld(int vb) { Frag2 f; f.lo = tr_read<rd_off(D0, KS, 0)>(vb); f.hi = tr_read<rd_off(D0, KS, 1)>(vb); return f; }
__device__ __forceinline__ bf16x8 pk(const Frag2& f) { return (bf16x8){f.lo[0], f.lo[1], f.lo[2], f.lo[3], f.hi[0], f.hi[1], f.hi[2], f.hi[3]}; }
#define TRI_WAIT() do { asm volatile("s_waitcnt lgkmcnt(0)" ::: "memory"); __builtin_amdgcn_sched_barrier(0); } while (0)
}
typedef float f32x16 __attribute__((ext_vector_type(16)));
__device__ __forceinline__ int crow(int r, int hi) { return (r & 3) + 8 * (r >> 2) + 4 * hi; }

__device__ __forceinline__ float logsigmoidf_(float z) { return fminf(z, 0.f) - __logf(1.f + __expf(-fabsf(z))); }
__device__ __forceinline__ void gla_prepkv_unit(Frame& F, int c, int h) {
    unsigned char* ar = F.ws + WS_ARENA;
    const bf16* GQ = (const bf16*)(ar + B_GQ); const bf16* GK = (const bf16*)(ar + B_GK); const bf16* GV = (const bf16*)(ar + B_GV); const float* ALR = (const float*)(ar + B_ALR);
    LAS float* ALR_S = (LAS float*)(F.lds);
    LAS float* WA_S = (LAS float*)(F.lds + 4096);
    LAS float* BA_S = (LAS float*)(F.lds + 12288);
    LAS float* SEG_S = (LAS float*)(F.lds + 12800);
    LAS float* GB = (LAS float*)(F.lds + 14848);
    LAS unsigned char* QS = F.lds + 47616;
    LAS unsigned char* KS = F.lds + 64000;
    LAS unsigned char* VIMG = F.lds + 80384;
    LAS unsigned char* KIMG = F.lds + 113152;
    const int tid = F.tid, lane = F.lane, t0 = c * 64;
    __syncthreads();
    for (int i = tid; i < 1024; i += NTHR) ALR_S[i] = ALR[(size_t)t0 * 16 + i];
    for (int i = tid; i < 1024; i += NTHR) { const int r = i >> 4, k8 = (i & 15) * 8;
        *(LAS v4u*)(QS + (r * 128 + k8) * 2) = *(const GAS v4u*)(GQ + (size_t)(t0 + r) * 512 + h * 128 + k8); *(LAS v4u*)(KS + (r * 128 + k8) * 2) = *(const GAS v4u*)(GK + (size_t)(t0 + r) * 512 + h * 128 + k8); }
    for (int i = tid; i < 2048; i += NTHR) { const int r = i >> 5, v8 = (i & 31) * 8;
        *(LAS v4u*)(VIMG + (v8 >> 7) * 16384 + tri::st(r, v8 & 127)) = *(const GAS v4u*)(GV + (size_t)(t0 + r) * 1024 + h * 256 + v8); }
    for (int d = 0; d < 2; ++d) {
        const float* wa = inp(I_GLAWA) + (size_t)d * 16 * 512 + h * 128; const float* ba = inp(I_GLABA) + d * 512 + h * 128;
        __syncthreads();
        for (int i = tid; i < 2048; i += NTHR) WA_S[i] = wa[(size_t)(i >> 7) * 512 + (i & 127)];
        if (tid < 128) BA_S[tid] = ba[tid];
        __syncthreads();
        const int k = tid & 127, seg = tid >> 7;
        float gl[16];
        { float w[16];
#pragma unroll
          for (int r = 0; r < 16; ++r) w[r] = WA_S[r * 128 + k];
          const float b0 = BA_S[k];
#pragma unroll
          for (int ii = 0; ii < 16; ++ii) { const int i = seg * 16 + ii; float z = b0;
#pragma unroll
              for (int r = 0; r < 16; ++r) z += ALR_S[i * 16 + r] * w[r];
              gl[ii] = logsigmoidf_(z) * (1.f / 16.f); } }
        if (d == 0) {
#pragma unroll
            for (int ii = 1; ii < 16; ++ii) gl[ii] += gl[ii - 1];
            SEG_S[seg * 128 + k] = gl[15]; }
        else {
#pragma unroll
            for (int ii = 14; ii >= 0; --ii) gl[ii] += gl[ii + 1];
            SEG_S[seg * 128 + k] = gl[0]; }
        __syncthreads();
        const float s0 = SEG_S[k], s1 = SEG_S[128 + k], s2 = SEG_S[256 + k], s3 = SEG_S[384 + k], tot = (s0 + s1) + (s2 + s3);
        float off;
        if (d == 0) off = seg == 0 ? 0.f : (seg == 1 ? s0 : (seg == 2 ? s0 + s1 : s0 + s1 + s2));
        else off = seg == 3 ? 0.f : (seg == 2 ? s3 : (seg == 1 ? s3 + s2 : s3 + s2 + s1));
#pragma unroll
        for (int ii = 0; ii < 16; ++ii) GB[(seg * 16 + ii) * 128 + k] = gl[ii] + off;
        if (seg == 0) ((float*)(ar + B_DEC))[((size_t)(d * NCH + c) * 4 + h) * 128 + k] = __expf(tot);
        __syncthreads();
        { bf16* QE = (bf16*)(ar + B_QE) + (size_t)d * T * 512; bf16* KE = (bf16*)(ar + B_KE) + (size_t)d * T * 512;
          for (int i2 = tid; i2 < 1024; i2 += NTHR) { const int i = i2 >> 4, k8 = (i2 & 15) * 8; const v4u qw = *(const LAS v4u*)(QS + (i * 128 + k8) * 2), kw = *(const LAS v4u*)(KS + (i * 128 + k8) * 2);
              const f32x4 ba0 = *(const LAS f32x4*)(GB + i * 128 + k8), ba1 = *(const LAS f32x4*)(GB + i * 128 + k8 + 4);
              const f32x4 t0v = *(const LAS f32x4*)(SEG_S + k8), t1v = *(const LAS f32x4*)(SEG_S + 128 + k8), t2v = *(const LAS f32x4*)(SEG_S + 256 + k8), t3v = *(const LAS f32x4*)(SEG_S + 384 + k8);
              const f32x4 u0v = *(const LAS f32x4*)(SEG_S + k8 + 4), u1v = *(const LAS f32x4*)(SEG_S + 128 + k8 + 4), u2v = *(const LAS f32x4*)(SEG_S + 256 + k8 + 4), u3v = *(const LAS f32x4*)(SEG_S + 384 + k8 + 4);
              const f32x4 tt0 = (t0v + t1v) + (t2v + t3v), tt1 = (u0v + u1v) + (u2v + u3v);
              const float b[8] = {ba0[0], ba0[1], ba0[2], ba0[3], ba1[0], ba1[1], ba1[2], ba1[3]}; const float tt[8] = {tt0[0], tt0[1], tt0[2], tt0[3], tt1[0], tt1[1], tt1[2], tt1[3]};
              const unsigned qv[4] = {qw.x, qw.y, qw.z, qw.w}, kv[4] = {kw.x, kw.y, kw.z, kw.w}; float qe[8], ke[8], kd[8];
#pragma unroll
              for (int e = 0; e < 4; ++e) { const float q0 = bflo(qv[e]), q1 = bfhi(qv[e]), k0 = bflo(kv[e]), k1 = bfhi(kv[e]); const float e0 = __expf(b[2 * e]), e1 = __expf(b[2 * e + 1]);
                  const float r0 = __builtin_amdgcn_rcpf(e0), r1 = __builtin_amdgcn_rcpf(e1);
                  qe[2 * e] = q0 * 0.08838834764831845f * e0; qe[2 * e + 1] = q1 * 0.08838834764831845f * e1; ke[2 * e] = k0 * r0; ke[2 * e + 1] = k1 * r1;
                  kd[2 * e] = k0 * __expf(tt[2 * e] - b[2 * e]); kd[2 * e + 1] = k1 * __expf(tt[2 * e + 1] - b[2 * e + 1]); }
              v4u wq, wk, wd; wq.x = pk2(qe[0], qe[1]); wq.y = pk2(qe[2], qe[3]); wq.z = pk2(qe[4], qe[5]); wq.w = pk2(qe[6], qe[7]);
              wk.x = pk2(ke[0], ke[1]); wk.y = pk2(ke[2], ke[3]); wk.z = pk2(ke[4], ke[5]); wk.w = pk2(ke[6], ke[7]);
              wd.x = pk2(kd[0], kd[1]); wd.y = pk2(kd[2], kd[3]); wd.z = pk2(kd[4], kd[5]); wd.w = pk2(kd[6], kd[7]);
              *(GAS v4u*)(QE + (size_t)(t0 + i) * 512 + h * 128 + k8) = wq; *(GAS v4u*)(KE + (size_t)(t0 + i) * 512 + h * 128 + k8) = wk;
              *(LAS v4u*)(KIMG + tri::st(i, k8)) = wd; } }
        __syncthreads();
        {
            const int w = F.wave, r = lane & 31, hi = lane >> 5;
            const int kb_base = (int)(uintptr_t)KIMG + tri::rd_base(lane), vb_base = (int)(uintptr_t)VIMG + (w >> 2) * 16384 + (w & 3) * 512 + tri::rd_base(lane);
            const tri::Frag2 b0 = tri::ld<0, 0>(vb_base), b1 = tri::ld<0, 1>(vb_base), b2 = tri::ld<0, 2>(vb_base), b3 = tri::ld<0, 3>(vb_base);
            const tri::Frag2 a00 = tri::ld<0, 0>(kb_base), a01 = tri::ld<0, 1>(kb_base), a02 = tri::ld<0, 2>(kb_base), a03 = tri::ld<0, 3>(kb_base);
            const tri::Frag2 a10 = tri::ld<1, 0>(kb_base), a11 = tri::ld<1, 1>(kb_base), a12 = tri::ld<1, 2>(kb_base), a13 = tri::ld<1, 3>(kb_base);
            const tri::Frag2 a20 = tri::ld<2, 0>(kb_base), a21 = tri::ld<2, 1>(kb_base), a22 = tri::ld<2, 2>(kb_base), a23 = tri::ld<2, 3>(kb_base);
            const tri::Frag2 a30 = tri::ld<3, 0>(kb_base), a31 = tri::ld<3, 1>(kb_base), a32 = tri::ld<3, 2>(kb_base), a33 = tri::ld<3, 3>(kb_base);
            TRI_WAIT();
            const bf16x8 B0 = tri::pk(b0), B1 = tri::pk(b1), B2 = tri::pk(b2), B3 = tri::pk(b3);
            f32x16 acc[4] = {};
            acc[0] = __builtin_amdgcn_mfma_f32_32x32x16_bf16(tri::pk(a00), B0, acc[0], 0, 0, 0); acc[0] = __builtin_amdgcn_mfma_f32_32x32x16_bf16(tri::pk(a01), B1, acc[0], 0, 0, 0);
            acc[0] = __builtin_amdgcn_mfma_f32_32x32x16_bf16(tri::pk(a02), B2, acc[0], 0, 0, 0); acc[0] = __builtin_amdgcn_mfma_f32_32x32x16_bf16(tri::pk(a03), B3, acc[0], 0, 0, 0);
            acc[1] = __builtin_amdgcn_mfma_f32_32x32x16_bf16(tri::pk(a10), B0, acc[1], 0, 0, 0); acc[1] = __builtin_amdgcn_mfma_f32_32x32x16_bf16(tri::pk(a11), B1, acc[1], 0, 0, 0);
            acc[1] = __builtin_amdgcn_mfma_f32_32x32x16_bf16(tri::pk(a12), B2, acc[1], 0, 0, 0); acc[1] = __builtin_amdgcn_mfma_f32_32x32x16_bf16(tri::pk(a13), B3, acc[1], 0, 0, 0);
            acc[2] = __builtin_amdgcn_mfma_f32_32x32x16_bf16(tri::pk(a20), B0, acc[2], 0, 0, 0); acc[2] = __builtin_amdgcn_mfma_f32_32x32x16_bf16(tri::pk(a21), B1, acc[2], 0, 0, 0);
            acc[2] = __builtin_amdgcn_mfma_f32_32x32x16_bf16(tri::pk(a22), B2, acc[2], 0, 0, 0); acc[2] = __builtin_amdgcn_mfma_f32_32x32x16_bf16(tri::pk(a23), B3, acc[2], 0, 0, 0);
            acc[3] = __builtin_amdgcn_mfma_f32_32x32x16_bf16(tri::pk(a30), B0, acc[3], 0, 0, 0); acc[3] = __builtin_amdgcn_mfma_f32_32x32x16_bf16(tri::pk(a31), B1, acc[3], 0, 0, 0);
            acc[3] = __builtin_amdgcn_mfma_f32_32x32x16_bf16(tri::pk(a32), B2, acc[3], 0, 0, 0); acc[3] = __builtin_amdgcn_mfma_f32_32x32x16_bf16(tri::pk(a33), B3, acc[3], 0, 0, 0);
            bf16* ST = (bf16*)(ar + B_ST) + ((size_t)(d * NCH + c) * 4 + h) * 256 * 128;
#pragma unroll
            for (int kb = 0; kb < 4; ++kb)
#pragma unroll
                for (int q4 = 0; q4 < 4; ++q4) { v2u o; o.x = pk2(acc[kb][4 * q4], acc[kb][4 * q4 + 1]); o.y = pk2(acc[kb][4 * q4 + 2], acc[kb][4 * q4 + 3]);
                    *(GAS v2u*)(ST + (size_t)(32 * w + r) * 128 + 32 * kb + 8 * q4 + 4 * hi) = o; }
        }
    }
}

__device__ __forceinline__ void ph_gla_scan(Frame& F) {
    unsigned char* ar = F.ws + WS_ARENA; const float* DEC = (const float*)(ar + B_DEC);
    for (int gth = blockIdx.x * NTHR + F.tid; gth < 2 * 4 * 256 * 64; gth += F.G * NTHR) {
        const int kp = gth & 63, v = (gth >> 6) & 255, h = (gth >> 14) & 3, d = gth >> 16;
        unsigned* ST = (unsigned*)(ar + B_ST) + ((((size_t)d * NCH) * 4 + h) * 256 + v) * 64 + kp;
        const f32x2* DC = (const f32x2*)DEC + (((size_t)d * NCH) * 4 + h) * 64 + kp;
        float s0 = 0.f, s1 = 0.f;
        for (int i0 = 0; i0 < NCH; i0 += 4) { int cc[4]; unsigned kv[4]; f32x2 dc[4];
#pragma unroll
            for (int q = 0; q < 4; ++q) { const int i = i0 + q; cc[q] = d == 0 ? i : (i < NCH_CTX ? NCH_CTX - 1 - i : NCH - 1 - (i - NCH_CTX));
                kv[q] = ST[(size_t)cc[q] * (4 * 256 * 64)]; dc[q] = DC[(size_t)cc[q] * (4 * 64)]; }
#pragma unroll
            for (int q = 0; q < 4; ++q) { ST[(size_t)cc[q] * (4 * 256 * 64)] = pk2(s0, s1); s0 = dc[q].x * s0 + bflo(kv[q]); s1 = dc[q].y * s1 + bfhi(kv[q]); } }
    }
}

__device__ __forceinline__ void gla_out_unit(Frame& F, int cl, int h) {
    unsigned char* ar = F.ws + WS_ARENA; const int c = cl + NCH_CTX, t0 = c * 64;
    LAS unsigned char* ATT = F.lds;
    LAS float* OS = (LAS float*)(F.lds + 18432);
    LAS unsigned char* VIMG = F.lds + 86016;
    const int lane = F.lane, r = lane & 31, hi = lane >> 5, w = F.wave;
    __syncthreads();
    { const bf16* GV = (const bf16*)(ar + B_GV);
      for (int i = F.tid; i < 2048; i += NTHR) { const int rr = i >> 5, v8 = (i & 31) * 8;
          *(LAS v4u*)(VIMG + (v8 >> 7) * 16384 + tri::st(rr, v8 & 127)) = *(const GAS v4u*)(GV + (size_t)(t0 + rr) * 1024 + h * 256 + v8); } }
    {
        const int d = w >> 2, ib = (w >> 1) & 1, jb = w & 1;
        const bf16* QE = (const bf16*)(ar + B_QE) + (size_t)d * T * 512 + (size_t)(t0 + ib * 32 + r) * 512 + h * 128 + 8 * hi;
        const bf16* KE = (const bf16*)(ar + B_KE) + (size_t)d * T * 512 + (size_t)(t0 + jb * 32 + r) * 512 + h * 128 + 8 * hi;
        bf16x8 a[8], b[8];
#pragma unroll
        for (int s = 0; s < 8; ++s) { a[s] = *(const GAS bf16x8*)(KE + 16 * s); b[s] = *(const GAS bf16x8*)(QE + 16 * s); }
        f32x16 acc = {};
#pragma unroll
        for (int s = 0; s < 8; ++s) acc = __builtin_amdgcn_mfma_f32_32x32x16_bf16(a[s], b[s], acc, 0, 0, 0);
        const int i = ib * 32 + r;
#pragma unroll
        for (int q4 = 0; q4 < 4; ++q4) { float x[4];
#pragma unroll
            for (int e = 0; e < 4; ++e) { const int j = jb * 32 + 8 * q4 + 4 * hi + e; const bool keep = d == 0 ? (j <= i) : (j >= i); x[e] = keep ? acc[4 * q4 + e] : 0.f; }
            v2u o; o.x = pk2(x[0], x[1]); o.y = pk2(x[2], x[3]);
            *(LAS v2u*)(ATT + ((size_t)(d * 64 + i) * 72 + jb * 32 + 8 * q4 + 4 * hi) * 2) = o; }
    }
    __syncthreads();
    {
        const int ib = w >> 2, vq = w & 3; f32x16 o0 = {}, o1 = {};
        const int vb_base = (int)(uintptr_t)VIMG + (vq >> 1) * 16384 + (2 * (vq & 1)) * 512 + tri::rd_base(lane);
        const tri::Frag2 p0 = tri::ld<0, 0>(vb_base), p1 = tri::ld<0, 1>(vb_base), p2 = tri::ld<0, 2>(vb_base), p3 = tri::ld<0, 3>(vb_base);
        const tri::Frag2 q0 = tri::ld<1, 0>(vb_base), q1 = tri::ld<1, 1>(vb_base), q2 = tri::ld<1, 2>(vb_base), q3 = tri::ld<1, 3>(vb_base);
        TRI_WAIT();
        const bf16x8 vb0[4] = {tri::pk(p0), tri::pk(p1), tri::pk(p2), tri::pk(p3)}, vb1[4] = {tri::pk(q0), tri::pk(q1), tri::pk(q2), tri::pk(q3)};
#pragma unroll
        for (int d = 0; d < 2; ++d) {
            bf16x8 a[4];
#pragma unroll
            for (int s = 0; s < 4; ++s) a[s] = *(const LAS bf16x8*)(ATT + ((size_t)(d * 64 + ib * 32 + r) * 72 + 16 * s + 8 * hi) * 2);
#pragma unroll
            for (int s = 0; s < 4; ++s) { o0 = __builtin_amdgcn_mfma_f32_32x32x16_bf16(a[s], vb0[s], o0, 0, 0, 0); o1 = __builtin_amdgcn_mfma_f32_32x32x16_bf16(a[s], vb1[s], o1, 0, 0, 0); }
            const bf16* QE = (const bf16*)(ar + B_QE) + (size_t)d * T * 512 + (size_t)(t0 + ib * 32 + r) * 512 + h * 128 + 8 * hi;
            const bf16* ST = (const bf16*)(ar + B_ST) + ((size_t)(d * NCH + c) * 4 + h) * 256 * 128 + (size_t)(64 * vq + r) * 128 + 8 * hi;
            bf16x8 qa[8], s0[8], s1[8];
#pragma unroll
            for (int s = 0; s < 8; ++s) { qa[s] = *(const GAS bf16x8*)(QE + 16 * s); s0[s] = *(const GAS bf16x8*)(ST + 16 * s); s1[s] = *(const GAS bf16x8*)(ST + 32 * 128 + 16 * s); }
#pragma unroll
            for (int s = 0; s < 8; ++s) { o0 = __builtin_amdgcn_mfma_f32_32x32x16_bf16(qa[s], s0[s], o0, 0, 0, 0); o1 = __builtin_amdgcn_mfma_f32_32x32x16_bf16(qa[s], s1[s], o1, 0, 0, 0); }
        }
#pragma unroll
        for (int q = 0; q < 16; ++q) { const int i = ib * 32 + crow(q, hi); OS[i * 260 + 64 * vq + r] = o0[q]; OS[i * 260 + 64 * vq + 32 + r] = o1[q]; }
    }
    __syncthreads();
    {
        const int i = F.tid >> 3, seg = F.tid & 7; const LAS float* op = OS + i * 260 + 32 * seg; f32x4 x[8]; float ss = 0.f;
#pragma unroll
        for (int e = 0; e < 8; ++e) { x[e] = *(const LAS f32x4*)(op + 4 * e); ss += (x[e][0] * x[e][0] + x[e][1] * x[e][1]) + (x[e][2] * x[e][2] + x[e][3] * x[e][3]); }
        ss += __shfl_xor(ss, 1); ss += __shfl_xor(ss, 2); ss += __shfl_xor(ss, 4);
        const float rstd = 1.f / sqrtf(ss * (1.f / 256.f) + EPS);
        const float* gn = inp(I_GLANORM) + h * 256 + 32 * seg; const bf16* R = (const bf16*)(ar + B_R) + (size_t)(t0 + i) * 1024 + h * 256 + 32 * seg;
        bf16* YM = (bf16*)(ar + B_YMIX1) + (size_t)(t0 - CTX + i) * D + h * 256 + 32 * seg;
#pragma unroll
        for (int e2 = 0; e2 < 4; ++e2) { const v4u rr = *(const GAS v4u*)(R + 8 * e2); const f32x4 g0 = *(const GAS f32x4*)(gn + 8 * e2), g1 = *(const GAS f32x4*)(gn + 8 * e2 + 4);
            const f32x4 a = x[2 * e2] * rstd * g0, b = x[2 * e2 + 1] * rstd * g1; v4u o;
            o.x = pk2(a[0] * siluf_(bflo(rr.x)), a[1] * siluf_(bfhi(rr.x))); o.y = pk2(a[2] * siluf_(bflo(rr.y)), a[3] * siluf_(bfhi(rr.y)));
            o.z = pk2(b[0] * siluf_(bflo(rr.z)), b[1] * siluf_(bfhi(rr.z))); o.w = pk2(b[2] * siluf_(bflo(rr.w)), b[3] * siluf_(bfhi(rr.w)));
            *(GAS v4u*)(YM + 8 * e2) = o; }
    }
}

namespace att {
constexpr int HD = 128, NW = 8, QBLK = 32, KVBLK = 64;
constexpr float SCALE = 0.088388347648318440f;
constexpr float THR = 8.f;
constexpr int LDQ = 1024, LDK = 256, LDO = 2048;
constexpr size_t SHM_V = KVBLK * HD * 2, SHM_K = KVBLK * HD * 2, SHM_ATTN = 2 * SHM_V + 2 * SHM_K + NW * 64 * 4;
using s16x4 = __attribute__((ext_vector_type(4))) short;
#define KSWZ(row, colB) ((row) * 256 + ((colB) ^ (((row) & 7) << 4)))
#define SBAR() __builtin_amdgcn_sched_barrier(0)
__device__ __forceinline__ unsigned cvtpk(float lo, float hi) { unsigned r; asm volatile("v_cvt_pk_bf16_f32 %0, %1, %2" : "=v"(r) : "v"(lo), "v"(hi)); return r; }
__device__ __forceinline__ void partialSM(f32x16& p0, f32x16& p1, float& m_reg, float& mn, float& alpha) {
  constexpr float C = SCALE * 1.4426950408889634f;
  float pmax = p0[0];
#pragma unroll
  for (int r = 1; r < 16; ++r) pmax = fmaxf(pmax, p0[r]);
#pragma unroll
  for (int r = 0; r < 16; ++r) pmax = fmaxf(pmax, p1[r]);
  { auto rr = __builtin_amdgcn_permlane32_swap(__float_as_uint(pmax), __float_as_uint(pmax), false, false);
    pmax = fmaxf(__uint_as_float(rr[0]), __uint_as_float(rr[1])); }
  if (__builtin_expect(__all(pmax - m_reg <= THR / SCALE), 1)) { mn = m_reg; alpha = 1.f; }
  else { mn = fmaxf(m_reg, pmax); alpha = __builtin_amdgcn_exp2f((m_reg - mn) * C); m_reg = mn; }
  float mnC = -mn * C;
#pragma unroll
  for (int r = 0; r < 16; ++r) p0[r] = fmaf(p0[r], C, mnC);
#pragma unroll
  for (int r = 0; r < 16; ++r) p1[r] = fmaf(p1[r], C, mnC);
#pragma unroll
  for (int r = 0; r < 16; ++r) p0[r] = __builtin_amdgcn_exp2f(p0[r]);
}
__device__ __forceinline__ void finishSM(f32x16& p0, f32x16& p1, float alpha, float& l_reg, bf16x8& pa0, bf16x8& pa1, bf16x8& pa2, bf16x8& pa3) {
#pragma unroll
  for (int r = 0; r < 16; ++r) p1[r] = __builtin_amdgcn_exp2f(p1[r]);
  float ps = 0;
#pragma unroll
  for (int r = 0; r < 16; ++r) ps += p0[r];
#pragma unroll
  for (int r = 0; r < 16; ++r) ps += p1[r];
  { auto rr = __builtin_amdgcn_permlane32_swap(__float_as_uint(ps), __float_as_uint(ps), false, false);
    ps = __uint_as_float(rr[0]) + __uint_as_float(rr[1]); }
  l_reg = l_reg * alpha + ps;
#define PK4(P, BASE, OUT) do { unsigned a0 = cvtpk(P[BASE + 0], P[BASE + 1]), a1 = cvtpk(P[BASE + 2], P[BASE + 3]);   \
    unsigned b0 = cvtpk(P[BASE + 4], P[BASE + 5]), b1 = cvtpk(P[BASE + 6], P[BASE + 7]);                              \
    auto r0 = __builtin_amdgcn_permlane32_swap(a0, b0, false, false); auto r1 = __builtin_amdgcn_permlane32_swap(a1, b1, false, false); \
    u32x4 w = {r0[0], r1[0], r0[1], r1[1]}; OUT = *reinterpret_cast<bf16x8*>(&w); } while (0)
  PK4(p0, 0, pa0); PK4(p0, 8, pa1); PK4(p1, 0, pa2); PK4(p1, 8, pa3);
#undef PK4
}
__device__ __forceinline__ void qkt(f32x16& p0, f32x16& p1, const bf16* Ks, const bf16x8* qr, int r32, int hi) {
  p0 = f32x16{}; p1 = f32x16{};
#pragma unroll
  for (int d0 = 0; d0 < 8; ++d0) { int cb = (d0 * 16 + hi * 8) * 2;
    bf16x8 b0 = *reinterpret_cast<const bf16x8*>((const char*)Ks + KSWZ(r32, cb));
    bf16x8 b1 = *reinterpret_cast<const bf16x8*>((const char*)Ks + KSWZ(32 + r32, cb));
    p0 = __builtin_amdgcn_mfma_f32_32x32x16_bf16(b0, qr[d0], p0, 0, 0, 0);
    p1 = __builtin_amdgcn_mfma_f32_32x32x16_bf16(b1, qr[d0], p1, 0, 0, 0); }
}
__device__ __forceinline__ int v_st(int k, int c) { const int kk = (k & ~0xC) | ((k & 4) << 1) | ((k & 8) >> 1); return ((kk >> 3) * 4 + (c >> 5)) * 512 + ((kk & 7) * 32 + (c & 31)) * 2; }
__device__ __forceinline__ int v_rd_base(int lane) { return ((lane & 3) << 3) | (((lane >> 2) & 3) << 6) | (((lane >> 4) & 1) << 5) | (((lane >> 5) & 1) << 8); }
constexpr int v_rd_off(int d0, int ks, int half) { return d0 * 512 + ks * 4096 + half * 2048; }
template <int OFF> __device__ __forceinline__ s16x4 tr_read(int vb) {
  s16x4 r; asm volatile("ds_read_b64_tr_b16 %0, %1 offset:%2" : "=&v"(r) : "v"(vb), "i"(OFF) : "memory"); return r;
}
template <int D0> __device__ __forceinline__ void pv_one(f32x16& od, int vb, bf16x8 pa0, bf16x8 pa1, bf16x8 pa2, bf16x8 pa3) {
  const s16x4 l0 = tr_read<v_rd_off(D0, 0, 0)>(vb), h0 = tr_read<v_rd_off(D0, 0, 1)>(vb), l1 = tr_read<v_rd_off(D0, 1, 0)>(vb), h1 = tr_read<v_rd_off(D0, 1, 1)>(vb);
  const s16x4 l2 = tr_read<v_rd_off(D0, 2, 0)>(vb), h2 = tr_read<v_rd_off(D0, 2, 1)>(vb), l3 = tr_read<v_rd_off(D0, 3, 0)>(vb), h3 = tr_read<v_rd_off(D0, 3, 1)>(vb);
  asm volatile("s_waitcnt lgkmcnt(0)" ::: "memory"); SBAR();
#define PK(L, H) (bf16x8){L[0], L[1], L[2], L[3], H[0], H[1], H[2], H[3]}
  od = __builtin_amdgcn_mfma_f32_32x32x16_bf16(pa0, PK(l0, h0), od, 0, 0, 0);
  od = __builtin_amdgcn_mfma_f32_32x32x16_bf16(pa1, PK(l1, h1), od, 0, 0, 0);
  od = __builtin_amdgcn_mfma_f32_32x32x16_bf16(pa2, PK(l2, h2), od, 0, 0, 0);
  od = __builtin_amdgcn_mfma_f32_32x32x16_bf16(pa3, PK(l3, h3), od, 0, 0, 0);
#undef PK
}
__device__ __forceinline__ void pv_d0(f32x16* o, int vb, bf16x8 pa0, bf16x8 pa1, bf16x8 pa2, bf16x8 pa3) {
  pv_one<0>(o[0], vb, pa0, pa1, pa2, pa3); pv_one<1>(o[1], vb, pa0, pa1, pa2, pa3); pv_one<2>(o[2], vb, pa0, pa1, pa2, pa3); pv_one<3>(o[3], vb, pa0, pa1, pa2, pa3);
}
typedef int v8i __attribute__((ext_vector_type(8)));
typedef int v4i __attribute__((ext_vector_type(4)));
constexpr size_t SHM_K8 = KVBLK * 128;
#define K8ADDR(row, g) ((row) * 128 + ((((g) ^ ((row) >> 1)) & 7) << 4))
__device__ __forceinline__ void qkt8(f32x16& p0, f32x16& p1, const char* Ks, const v8i& q0, const v8i& q1, int r32, int hi, int sc1) {
  p0 = f32x16{}; p1 = f32x16{};
  const int g0 = 4 * hi;
  { const v4i a00 = *reinterpret_cast<const v4i*>(Ks + K8ADDR(r32, g0)), a01 = *reinterpret_cast<const v4i*>(Ks + K8ADDR(r32, g0 + 1));
    const v4i b00 = *reinterpret_cast<const v4i*>(Ks + K8ADDR(32 + r32, g0)), b01 = *reinterpret_cast<const v4i*>(Ks + K8ADDR(32 + r32, g0 + 1));
    const v8i ka0 = __builtin_shufflevector(a00, a01, 0, 1, 2, 3, 4, 5, 6, 7), kb0 = __builtin_shufflevector(b00, b01, 0, 1, 2, 3, 4, 5, 6, 7);
    asm volatile("s_nop 1\n\tv_mfma_scale_f32_32x32x64_f8f6f4 %0, %1, %2, %0, %3, %3 op_sel_hi:[0,0,0]" : "+v"(p0) : "v"(ka0), "v"(q0), "v"(sc1));
    asm volatile("s_nop 1\n\tv_mfma_scale_f32_32x32x64_f8f6f4 %0, %1, %2, %0, %3, %3 op_sel_hi:[0,0,0]" : "+v"(p1) : "v"(kb0), "v"(q0), "v"(sc1) : "memory"); }
  { const v4i a10 = *reinterpret_cast<const v4i*>(Ks + K8ADDR(r32, g0 + 2)), a11 = *reinterpret_cast<const v4i*>(Ks + K8ADDR(r32, g0 + 3));
    const v4i b10 = *reinterpret_cast<const v4i*>(Ks + K8ADDR(32 + r32, g0 + 2)), b11 = *reinterpret_cast<const v4i*>(Ks + K8ADDR(32 + r32, g0 + 3));
    const v8i ka1 = __builtin_shufflevector(a10, a11, 0, 1, 2, 3, 4, 5, 6, 7), kb1 = __builtin_shufflevector(b10, b11, 0, 1, 2, 3, 4, 5, 6, 7);
    asm volatile("s_nop 1\n\tv_mfma_scale_f32_32x32x64_f8f6f4 %0, %1, %2, %0, %3, %3 op_sel_hi:[0,0,0]" : "+v"(p0) : "v"(ka1), "v"(q1), "v"(sc1));
    asm volatile("s_nop 1\n\tv_mfma_scale_f32_32x32x64_f8f6f4 %0, %1, %2, %0, %3, %3 op_sel_hi:[0,0,0]" : "+v"(p1) : "v"(kb1), "v"(q1), "v"(sc1)); }
  asm volatile("s_nop 15\n\ts_nop 7" : "+v"(p0), "+v"(p1));
}
__device__ __forceinline__ void attn_dense_body(const bf16* __restrict__ Qb, const unsigned char* __restrict__ Kh8, const bf16* __restrict__ Vh, bf16* __restrict__ Ob, int seq, char* lds) {
  constexpr int SDEPTH = 2;
  const int tid = threadIdx.x, wid = tid >> 6, lane = tid & 63, r32 = lane & 31, hi = lane >> 5;
  bf16* V_lds = (bf16*)lds; char* K_lds = lds + 2 * SHM_V;
  float* ws = (float*)(lds + 2 * SHM_V + 2 * SHM_K8) + wid * 64; float* li_l = ws; float* al_l = ws + 32;
  float m_reg = -1e30f, l_reg = 0; f32x16 o[4] = {}; bf16x8 qr[8];
  const bf16* Qw = Qb + (long)(wid * QBLK + r32) * LDQ + hi * 8;
#pragma unroll
  for (int d0 = 0; d0 < 8; ++d0) qr[d0] = *reinterpret_cast<const bf16x8*>(Qw + d0 * 16);
  v8i q8a, q8b; const int sc1 = 0x7f7f7f7f;
  { int w[16];
#pragma unroll
    for (int d0 = 0; d0 < 8; ++d0) { const u32x4 x = *reinterpret_cast<const u32x4*>(&qr[d0]);
      w[2 * d0] = (int)pk4_fp8(bflo(x.x), bfhi(x.x), bflo(x.y), bfhi(x.y)); w[2 * d0 + 1] = (int)pk4_fp8(bflo(x.z), bfhi(x.z), bflo(x.w), bfhi(x.w)); }
    q8a = (v8i){w[0], w[1], w[2], w[3], w[4], w[5], w[6], w[7]}; q8b = (v8i){w[8], w[9], w[10], w[11], w[12], w[13], w[14], w[15]}; }
  const int krow = tid >> 3, kg = tid & 7, kst = K8ADDR(krow, kg);
  const int sr = tid >> 4, sc = (tid & 15) * 8, vst0 = v_st(sr, sc), vst1 = v_st(32 + sr, sc);
  const int vb0 = (int)(uintptr_t)V_lds + v_rd_base(lane);
  struct { bf16x8 vs0, vs1; v4i ks; } sr_[SDEPTH];
#define SLOAD(i, k0) do { sr_[i].vs0 = *reinterpret_cast<const bf16x8*>(&Vh[(long)((k0) + sr) * LDK + sc]); sr_[i].vs1 = *reinterpret_cast<const bf16x8*>(&Vh[(long)((k0) + 32 + sr) * LDK + sc]); \
    sr_[i].ks = *reinterpret_cast<const v4i*>(&Kh8[(long)((k0) + krow) * 256 + kg * 16]); } while (0)
#define SWRITE(b, i) do { *(bf16x8*)((char*)V_lds + (b) * SHM_V + vst0) = sr_[i].vs0;          \
    *(bf16x8*)((char*)V_lds + (b) * SHM_V + vst1) = sr_[i].vs1;                                \
    *(v4i*)(K_lds + (b) * SHM_K8 + kst) = sr_[i].ks; } while (0)
#define SWAIT() do { asm volatile("s_waitcnt vmcnt(3)" ::: "memory"); } while (0)
#define RESC(a) do { if (__any((a) < 1.f)) { if (hi == 0) al_l[r32] = (a); asm volatile("s_waitcnt lgkmcnt(0)" ::: "memory"); \
    _Pragma("unroll") for (int d = 0; d < 4; ++d) _Pragma("unroll") for (int r = 0; r < 16; ++r) o[d][r] *= al_l[crow(r, hi)]; } } while (0)
  f32x16 pA0, pA1, pB0, pB1; float mnA, mnB, alA, alB; bf16x8 pa0, pa1, pa2, pa3; const int NT = seq / KVBLK;
  constexpr int SE = 0, SO = SDEPTH - 1;
  SLOAD(SE, 0); asm volatile("s_waitcnt vmcnt(0)" ::: "memory"); SWRITE(0, SE); __syncthreads();
  qkt8(pA0, pA1, K_lds, q8a, q8b, r32, hi, sc1); partialSM(pA0, pA1, m_reg, mnA, alA);
  SLOAD(SO, KVBLK); if (2 < NT) SLOAD(SE, 2 * KVBLK);
  SWAIT(); SWRITE(1, SO); __syncthreads();
  for (int j = 1; j + 1 < NT; j += 2) {
    SBAR(); qkt8(pB0, pB1, K_lds + SHM_K8, q8a, q8b, r32, hi, sc1);
    finishSM(pA0, pA1, alA, l_reg, pa0, pa1, pa2, pa3); SBAR();
    SLOAD(SO, (j + SDEPTH) * KVBLK); SBAR();
    pv_d0(o, vb0, pa0, pa1, pa2, pa3); partialSM(pB0, pB1, m_reg, mnB, alB);
    __syncthreads(); SWAIT(); SWRITE(0, SE);
    RESC(alB); __syncthreads();
    SBAR(); qkt8(pA0, pA1, K_lds, q8a, q8b, r32, hi, sc1);
    finishSM(pB0, pB1, alB, l_reg, pa0, pa1, pa2, pa3); SBAR();
    if (j + 3 < NT) SLOAD(SE, (j + 1 + SDEPTH) * KVBLK); SBAR();
    pv_d0(o, vb0 + (int)SHM_V, pa0, pa1, pa2, pa3); partialSM(pA0, pA1, m_reg, mnA, alA);
    __syncthreads(); SWAIT(); SWRITE(1, SO);
    RESC(alA); __syncthreads();
  }
  SBAR(); qkt8(pB0, pB1, K_lds + SHM_K8, q8a, q8b, r32, hi, sc1);
  finishSM(pA0, pA1, alA, l_reg, pa0, pa1, pa2, pa3); SBAR();
  pv_d0(o, vb0, pa0, pa1, pa2, pa3); partialSM(pB0, pB1, m_reg, mnB, alB);
  __syncthreads(); RESC(alB);
  finishSM(pB0, pB1, alB, l_reg, pa0, pa1, pa2, pa3); SBAR();
  pv_d0(o, vb0 + (int)SHM_V, pa0, pa1, pa2, pa3);
  if (hi == 0) li_l[r32] = l_reg; asm volatile("s_waitcnt lgkmcnt(0)" ::: "memory");
  float rli[16];
#pragma unroll
  for (int r = 0; r < 16; ++r) rli[r] = __builtin_amdgcn_rcpf(li_l[crow(r, hi)]);
  bf16* Ow = Ob + (long)(wid * QBLK) * LDO;
#pragma unroll
  for (int r = 0; r < 16; ++r) { int orow = crow(r, hi);
#pragma unroll
    for (int d0 = 0; d0 < 4; ++d0) Ow[(long)orow * LDO + d0 * 32 + r32] = (bf16)f2bf(o[d0][r] * rli[r]); }
  __syncthreads();
#undef SLOAD
#undef SWRITE
#undef SWAIT
#undef RESC
}
constexpr float THR8 = 6.f;
#define V8ADDR(d, g) ((d) * 64 + ((((g) ^ ((d) >> 2)) & 3) << 4))
__device__ __forceinline__ void partialSM8(f32x16& p0, f32x16& p1, float& m_reg, float& mn, float& alpha) {
  constexpr float C = SCALE * 1.4426950408889634f;
  float pmax = p0[0];
#pragma unroll
  for (int r = 1; r < 16; ++r) pmax = fmaxf(pmax, p0[r]);
#pragma unroll
  for (int r = 0; r < 16; ++r) pmax = fmaxf(pmax, p1[r]);
  { auto rr = __builtin_amdgcn_permlane32_swap(__float_as_uint(pmax), __float_as_uint(pmax), false, false);
    pmax = fmaxf(__uint_as_float(rr[0]), __uint_as_float(rr[1])); }
  if (__builtin_expect(__all(pmax - m_reg <= THR8 / SCALE), 1)) { mn = m_reg; alpha = 1.f; }
  else { mn = fmaxf(m_reg, pmax); alpha = __builtin_amdgcn_exp2f((m_reg - mn) * C); m_reg = mn; }
  float mnC = -mn * C;
#pragma unroll
  for (int r = 0; r < 16; ++r) p0[r] = fmaf(p0[r], C, mnC);
#pragma unroll
  for (int r = 0; r < 16; ++r) p1[r] = fmaf(p1[r], C, mnC);
#pragma unroll
  for (int r = 0; r < 16; ++r) p0[r] = __builtin_amdgcn_exp2f(p0[r]);
}
__device__ __forceinline__ void finishSM8(f32x16& p0, f32x16& p1, float alpha, float& l_reg, v8i& pa) {
#pragma unroll
  for (int r = 0; r < 16; ++r) p1[r] = __builtin_amdgcn_exp2f(p1[r]);
  float ps = 0;
#pragma unroll
  for (int r = 0; r < 16; ++r) ps += p0[r];
#pragma unroll
  for (int r = 0; r < 16; ++r) ps += p1[r];
  { auto rr = __builtin_amdgcn_permlane32_swap(__float_as_uint(ps), __float_as_uint(ps), false, false);
    ps = __uint_as_float(rr[0]) + __uint_as_float(rr[1]); }
  l_reg = l_reg * alpha + ps;
  pa = (v8i){(int)pk4_fp8(p0[0], p0[1], p0[2], p0[3]), (int)pk4_fp8(p0[4], p0[5], p0[6], p0[7]), (int)pk4_fp8(p0[8], p0[9], p0[10], p0[11]), (int)pk4_fp8(p0[12], p0[13], p0[14], p0[15]),
             (int)pk4_fp8(p1[0], p1[1], p1[2], p1[3]), (int)pk4_fp8(p1[4], p1[5], p1[6], p1[7]), (int)pk4_fp8(p1[8], p1[9], p1[10], p1[11]), (int)pk4_fp8(p1[12], p1[13], p1[14], p1[15])};
}
__device__ __forceinline__ void pv8(f32x16* o, const char* Vs, const v8i& pa, int r32, int hi, int sc1) {
#pragma unroll
  for (int d0 = 0; d0 < 4; ++d0) { const int d = 32 * d0 + r32;
    const v4i x0 = *reinterpret_cast<const v4i*>(Vs + V8ADDR(d, 2 * hi)), x1 = *reinterpret_cast<const v4i*>(Vs + V8ADDR(d, 2 * hi + 1));
    const v8i vb = __builtin_shufflevector(x0, x1, 0, 1, 2, 3, 4, 5, 6, 7);
    asm volatile("s_nop 1\n\tv_mfma_scale_f32_32x32x64_f8f6f4 %0, %1, %2, %0, %3, %3 op_sel_hi:[0,0,0]" : "+v"(o[d0]) : "v"(pa), "v"(vb), "v"(sc1)); }
  asm volatile("s_nop 15\n\ts_nop 7" : "+v"(o[0]), "+v"(o[1]), "+v"(o[2]), "+v"(o[3]));
}
__device__ __forceinline__ void attn_dense_body_pv8(const bf16* __restrict__ Qb, const unsigned char* __restrict__ Kh8, const unsigned char* __restrict__ Vt8, bf16* __restrict__ Ob, int seq, char* lds) {
  constexpr int SDEPTH = 2; constexpr size_t SHM_V8 = 8192;
  const int tid = threadIdx.x, wid = tid >> 6, lane = tid & 63, r32 = lane & 31, hi = lane >> 5;
  char* V_lds = lds; char* K_lds = lds + 2 * SHM_V8;
  float* ws = (float*)(lds + 2 * SHM_V8 + 2 * SHM_K8) + wid * 64; float* li_l = ws; float* al_l = ws + 32;
  float m_reg = -1e30f, l_reg = 0; f32x16 o[4] = {}; bf16x8 qr[8];
  const bf16* Qw = Qb + (long)(wid * QBLK + r32) * LDQ + hi * 8;
#pragma unroll
  for (int d0 = 0; d0 < 8; ++d0) qr[d0] = *reinterpret_cast<const bf16x8*>(Qw + d0 * 16);
  v8i q8a, q8b; const int sc1 = 0x7f7f7f7f;
  { int w[16];
#pragma unroll
    for (int d0 = 0; d0 < 8; ++d0) { const u32x4 x = *reinterpret_cast<const u32x4*>(&qr[d0]);
      w[2 * d0] = (int)pk4_fp8(bflo(x.x), bfhi(x.x), bflo(x.y), bfhi(x.y)); w[2 * d0 + 1] = (int)pk4_fp8(bflo(x.z), bfhi(x.z), bflo(x.w), bfhi(x.w)); }
    q8a = (v8i){w[0], w[1], w[2], w[3], w[4], w[5], w[6], w[7]}; q8b = (v8i){w[8], w[9], w[10], w[11], w[12], w[13], w[14], w[15]}; }
  const int krow = tid >> 3, kg = tid & 7, kst = K8ADDR(krow, kg);
  const int vrow = tid >> 2, vg = tid & 3, vst = V8ADDR(vrow, vg);
  struct { v4i vs, ks; } sr_[SDEPTH];
#define SLOAD(i, k0) do { sr_[i].vs = *reinterpret_cast<const v4i*>(&Vt8[(long)((k0) / KVBLK) * 8192 + tid * 16]); sr_[i].ks = *reinterpret_cast<const v4i*>(&Kh8[(long)((k0) + krow) * 256 + kg * 16]); } while (0)
#define SWRITE(b, i) do { *(v4i*)(V_lds + (b) * SHM_V8 + vst) = sr_[i].vs; *(v4i*)(K_lds + (b) * SHM_K8 + kst) = sr_[i].ks; } while (0)
#define SWAIT() do { asm volatile("s_waitcnt vmcnt(2)" ::: "memory"); } while (0)
#define RESC(a) do { if (__any((a) < 1.f)) { if (hi == 0) al_l[r32] = (a); asm volatile("s_waitcnt lgkmcnt(0)" ::: "memory"); \
    _Pragma("unroll") for (int d = 0; d < 4; ++d) _Pragma("unroll") for (int r = 0; r < 16; ++r) o[d][r] *= al_l[crow(r, hi)]; } } while (0)
  f32x16 pA0, pA1, pB0, pB1; float mnA, mnB, alA, alB; v8i pa; const int NT = seq / KVBLK;
  constexpr int SE = 0, SO = SDEPTH - 1;
  SLOAD(SE, 0); asm volatile("s_waitcnt vmcnt(0)" ::: "memory"); SWRITE(0, SE); __syncthreads();
  qkt8(pA0, pA1, K_lds, q8a, q8b, r32, hi, sc1); partialSM8(pA0, pA1, m_reg, mnA, alA);
  SLOAD(SO, KVBLK); if (2 < NT) SLOAD(SE, 2 * KVBLK);
  SWAIT(); SWRITE(1, SO); __syncthreads();
  for (int j = 1; j + 1 < NT; j += 2) {
    SBAR(); qkt8(pB0, pB1, K_lds + SHM_K8, q8a, q8b, r32, hi, sc1);
    finishSM8(pA0, pA1, alA, l_reg, pa); SBAR();
    SLOAD(SO, (j + SDEPTH) * KVBLK); SBAR();
    pv8(o, V_lds, pa, r32, hi, sc1); partialSM8(pB0, pB1, m_reg, mnB, alB);
    __syncthreads(); SWAIT(); SWRITE(0, SE);
    RESC(alB); __syncthreads();
    SBAR(); qkt8(pA0, pA1, K_lds, q8a, q8b, r32, hi, sc1);
    finishSM8(pB0, pB1, alB, l_reg, pa); SBAR();
    if (j + 3 < NT) SLOAD(SE, (j + 1 + SDEPTH) * KVBLK); SBAR();
    pv8(o, V_lds + SHM_V8, pa, r32, hi, sc1); partialSM8(pA0, pA1, m_reg, mnA, alA);
    __syncthreads(); SWAIT(); SWRITE(1, SO);
    RESC(alA); __syncthreads();
  }
  SBAR(); qkt8(pB0, pB1, K_lds + SHM_K8, q8a, q8b, r32, hi, sc1);
  finishSM8(pA0, pA1, alA, l_reg, pa); SBAR();
  pv8(o, V_lds, pa, r32, hi, sc1); partialSM8(pB0, pB1, m_reg, mnB, alB);
  __syncthreads(); RESC(alB);
  finishSM8(pB0, pB1, alB, l_reg, pa); SBAR();
  pv8(o, V_lds + SHM_V8, pa, r32, hi, sc1);
  if (hi == 0) li_l[r32] = l_reg; asm volatile("s_waitcnt lgkmcnt(0)" ::: "memory");
  float rli[16];
#pragma unroll
  for (int r = 0; r < 16; ++r) rli[r] = __builtin_amdgcn_rcpf(li_l[crow(r, hi)]);
  bf16* Ow = Ob + (long)(wid * QBLK) * LDO;
#pragma unroll
  for (int r = 0; r < 16; ++r) { int orow = crow(r, hi);
#pragma unroll
    for (int d0 = 0; d0 < 4; ++d0) Ow[(long)orow * LDO + d0 * 32 + r32] = (bf16)f2bf(o[d0][r] * rli[r]); }
  __syncthreads();
#undef SLOAD
#undef SWRITE
#undef SWAIT
#undef RESC
}
constexpr float QS8 = SCALE * 1.4426950408889634f * 8.f;
constexpr float THR2 = 8.6f;
__device__ __forceinline__ int cvt4_fp8(float a, float b, float c, float d) { int r; asm("v_cvt_pk_fp8_f32 %0, %1, %2" : "=v"(r) : "v"(a), "v"(b)); asm("v_cvt_pk_fp8_f32 %0, %1, %2 op_sel:[0,0,1]" : "+v"(r) : "v"(c), "v"(d)); return r; }
__device__ __forceinline__ void qkt8m(f32x16& p0, f32x16& p1, const f32x16& mi, const char* Ks, const v8i& q0, const v8i& q1, int r32, int hi, int sc1, int scq) {
  const int g0 = 4 * hi;
  { const v4i a00 = *reinterpret_cast<const v4i*>(Ks + K8ADDR(r32, g0)), a01 = *reinterpret_cast<const v4i*>(Ks + K8ADDR(r32, g0 + 1));
    const v4i b00 = *reinterpret_cast<const v4i*>(Ks + K8ADDR(32 + r32, g0)), b01 = *reinterpret_cast<const v4i*>(Ks + K8ADDR(32 + r32, g0 + 1));
    const v8i ka0 = __builtin_shufflevector(a00, a01, 0, 1, 2, 3, 4, 5, 6, 7), kb0 = __builtin_shufflevector(b00, b01, 0, 1, 2, 3, 4, 5, 6, 7);
    asm volatile("s_nop 1\n\tv_mfma_scale_f32_32x32x64_f8f6f4 %0, %1, %2, %3, %4, %5 op_sel_hi:[0,0,0]" : "=&v"(p0) : "v"(ka0), "v"(q0), "v"(mi), "v"(sc1), "v"(scq));
    asm volatile("s_nop 1\n\tv_mfma_scale_f32_32x32x64_f8f6f4 %0, %1, %2, %3, %4, %5 op_sel_hi:[0,0,0]" : "=&v"(p1) : "v"(kb0), "v"(q0), "v"(mi), "v"(sc1), "v"(scq) : "memory"); }
  { const v4i a10 = *reinterpret_cast<const v4i*>(Ks + K8ADDR(r32, g0 + 2)), a11 = *reinterpret_cast<const v4i*>(Ks + K8ADDR(r32, g0 + 3));
    const v4i b10 = *reinterpret_cast<const v4i*>(Ks + K8ADDR(32 + r32, g0 + 2)), b11 = *reinterpret_cast<const v4i*>(Ks + K8ADDR(32 + r32, g0 + 3));
    const v8i ka1 = __builtin_shufflevector(a10, a11, 0, 1, 2, 3, 4, 5, 6, 7), kb1 = __builtin_shufflevector(b10, b11, 0, 1, 2, 3, 4, 5, 6, 7);
    asm volatile("s_nop 1\n\tv_mfma_scale_f32_32x32x64_f8f6f4 %0, %1, %2, %0, %3, %4 op_sel_hi:[0,0,0]" : "+v"(p0) : "v"(ka1), "v"(q1), "v"(sc1), "v"(scq));
    asm volatile("s_nop 1\n\tv_mfma_scale_f32_32x32x64_f8f6f4 %0, %1, %2, %0, %3, %4 op_sel_hi:[0,0,0]" : "+v"(p1) : "v"(kb1), "v"(q1), "v"(sc1), "v"(scq)); }
}
__device__ __forceinline__ void xdl_pad2(f32x16& a, f32x16& b) { asm volatile("s_nop 15\n\ts_nop 7" : "+v"(a), "+v"(b)); }
template <bool FIRST> __device__ __forceinline__ void partialSM8m(f32x16& p0, f32x16& p1, float& M, f32x16& mi, float& alpha) {
  float pmax = p0[0];
#pragma unroll
  for (int r = 1; r < 16; ++r) pmax = fmaxf(pmax, p0[r]);
#pragma unroll
  for (int r = 0; r < 16; ++r) pmax = fmaxf(pmax, p1[r]);
  { auto rr = __builtin_amdgcn_permlane32_swap(__float_as_uint(pmax), __float_as_uint(pmax), false, false);
    pmax = fmaxf(__uint_as_float(rr[0]), __uint_as_float(rr[1])); }
  if (!FIRST && __builtin_expect(__all(pmax <= THR2), 1)) { alpha = 1.f; }
  else { const float d = FIRST ? pmax : fmaxf(pmax, 0.f); alpha = FIRST ? 1.f : __builtin_amdgcn_exp2f(-d); M += d;
#pragma unroll
    for (int r = 0; r < 16; ++r) { p0[r] -= d; p1[r] -= d; }
    const float nm = -M;
#pragma unroll
    for (int r = 0; r < 16; ++r) mi[r] = nm;
    asm volatile("" : "+v"(mi)); }
#pragma unroll
  for (int r = 0; r < 16; ++r) p0[r] = __builtin_amdgcn_exp2f(p0[r]);
}
__device__ __forceinline__ void finishSM8m(f32x16& p0, f32x16& p1, float alpha, float& l_reg, v8i& pa) {
#pragma unroll
  for (int r = 0; r < 16; ++r) p1[r] = __builtin_amdgcn_exp2f(p1[r]);
  float sa = p0[0], sb = p1[0];
#pragma unroll
  for (int r = 1; r < 16; ++r) { sa += p0[r]; sb += p1[r]; }
  float ps = sa + sb;
  { auto rr = __builtin_amdgcn_permlane32_swap(__float_as_uint(ps), __float_as_uint(ps), false, false);
    ps = __uint_as_float(rr[0]) + __uint_as_float(rr[1]); }
  l_reg = l_reg * alpha + ps;
  pa = (v8i){cvt4_fp8(p0[0], p0[1], p0[2], p0[3]), cvt4_fp8(p0[4], p0[5], p0[6], p0[7]), cvt4_fp8(p0[8], p0[9], p0[10], p0[11]), cvt4_fp8(p0[12], p0[13], p0[14], p0[15]),
             cvt4_fp8(p1[0], p1[1], p1[2], p1[3]), cvt4_fp8(p1[4], p1[5], p1[6], p1[7]), cvt4_fp8(p1[8], p1[9], p1[10], p1[11]), cvt4_fp8(p1[12], p1[13], p1[14], p1[15])};
}
__device__ __forceinline__ void pv8m(f32x16* o, const char* Vs, const v8i& pa, int r32, int hi, int sc1) {
#pragma unroll
  for (int d0 = 0; d0 < 4; ++d0) { const int d = 32 * d0 + r32;
    const v4i x0 = *reinterpret_cast<const v4i*>(Vs + V8ADDR(d, 2 * hi)), x1 = *reinterpret_cast<const v4i*>(Vs + V8ADDR(d, 2 * hi + 1));
    const v8i vb = __builtin_shufflevector(x0, x1, 0, 1, 2, 3, 4, 5, 6, 7);
    asm volatile("s_nop 1\n\tv_mfma_scale_f32_32x32x64_f8f6f4 %0, %1, %2, %0, %3, %3 op_sel_hi:[0,0,0]" : "+v"(o[d0]) : "v"(pa), "v"(vb), "v"(sc1)); }
}
__device__ __forceinline__ void attn_dense_body_m(const bf16* __restrict__ Qb, const unsigned char* __restrict__ Kh8, const unsigned char* __restrict__ Vt8, bf16* __restrict__ Ob, int seq, char* lds) {
  constexpr int SDEPTH = 2; constexpr size_t SHM_V8 = 8192;
  const int tid = threadIdx.x, wid = tid >> 6, lane = tid & 63, r32 = lane & 31, hi = lane >> 5;
  char* V_lds = lds; char* K_lds = lds + 2 * SHM_V8;
  float* ws = (float*)(lds + 2 * SHM_V8 + 2 * SHM_K8) + wid * 64; float* li_l = ws; float* al_l = ws + 32;
  float M = 0.f, l_reg = 0; f32x16 o[4] = {}; f32x16 mi = {}; asm volatile("" : "+v"(mi));
  v8i q8a, q8b; const int sc1 = 0x7f7f7f7f, scq = 0x7c7c7c7c;
  { bf16x8 qr[8]; const bf16* Qw = Qb + (long)(wid * QBLK + r32) * LDQ + hi * 8;
#pragma unroll
    for (int d0 = 0; d0 < 8; ++d0) qr[d0] = *reinterpret_cast<const bf16x8*>(Qw + d0 * 16);
    int w[16];
#pragma unroll
    for (int d0 = 0; d0 < 8; ++d0) { const u32x4 x = *reinterpret_cast<const u32x4*>(&qr[d0]);
      w[2 * d0] = (int)pk4_fp8(bflo(x.x) * QS8, bfhi(x.x) * QS8, bflo(x.y) * QS8, bfhi(x.y) * QS8); w[2 * d0 + 1] = (int)pk4_fp8(bflo(x.z) * QS8, bfhi(x.z) * QS8, bflo(x.w) * QS8, bfhi(x.w) * QS8); }
    q8a = (v8i){w[0], w[1], w[2], w[3], w[4], w[5], w[6], w[7]}; q8b = (v8i){w[8], w[9], w[10], w[11], w[12], w[13], w[14], w[15]}; }
  const int krow = tid >> 3, kg = tid & 7, kst = K8ADDR(krow, kg);
  const int vrow = tid >> 2, vg = tid & 3, vst = V8ADDR(vrow, vg);
  struct { v4i vs, ks; } sr_[SDEPTH];
#define SLOAD(i, k0) do { sr_[i].vs = *reinterpret_cast<const v4i*>(&Vt8[(long)((k0) / KVBLK) * 8192 + tid * 16]); sr_[i].ks = *reinterpret_cast<const v4i*>(&Kh8[(long)((k0) + krow) * 256 + kg * 16]); } while (0)
#define SWRITE(b, i) do { *(v4i*)(V_lds + (b) * SHM_V8 + vst) = sr_[i].vs; *(v4i*)(K_lds + (b) * SHM_K8 + kst) = sr_[i].ks; } while (0)
#define SWAIT() do { asm volatile("s_waitcnt vmcnt(2)" ::: "memory"); } while (0)
#define RESC(a) do { if (__any((a) < 1.f)) { if (hi == 0) al_l[r32] = (a); xdl_pad2(o[0], o[1]); xdl_pad2(o[2], o[3]); asm volatile("s_waitcnt lgkmcnt(0)" ::: "memory"); \
    _Pragma("unroll") for (int d = 0; d < 4; ++d) _Pragma("unroll") for (int r = 0; r < 16; ++r) o[d][r] *= al_l[crow(r, hi)]; } } while (0)
  f32x16 pA0, pA1, pB0, pB1; float alA, alB; v8i pa; const int NT = seq / KVBLK;
  constexpr int SE = 0, SO = SDEPTH - 1;
  SLOAD(SE, 0); asm volatile("s_waitcnt vmcnt(0)" ::: "memory"); SWRITE(0, SE); __syncthreads();
  qkt8m(pA0, pA1, mi, K_lds, q8a, q8b, r32, hi, sc1, scq); xdl_pad2(pA0, pA1); partialSM8m<true>(pA0, pA1, M, mi, alA);
  SLOAD(SO, KVBLK); if (2 < NT) SLOAD(SE, 2 * KVBLK);
  SWAIT(); SWRITE(1, SO); __syncthreads();
  for (int j = 1; j + 1 < NT; j += 2) {
    SBAR(); qkt8m(pB0, pB1, mi, K_lds + SHM_K8, q8a, q8b, r32, hi, sc1, scq);
    finishSM8m(pA0, pA1, alA, l_reg, pa); SBAR();
    SLOAD(SO, (j + SDEPTH) * KVBLK); SBAR();
    pv8m(o, V_lds, pa, r32, hi, sc1); partialSM8m<false>(pB0, pB1, M, mi, alB);
    __syncthreads(); SWAIT(); SWRITE(0, SE);
    RESC(alB); __syncthreads();
    SBAR(); qkt8m(pA0, pA1, mi, K_lds, q8a, q8b, r32, hi, sc1, scq);
    finishSM8m(pB0, pB1, alB, l_reg, pa); SBAR();
    if (j + 3 < NT) SLOAD(SE, (j + 1 + SDEPTH) * KVBLK); SBAR();
    pv8m(o, V_lds + SHM_V8, pa, r32, hi, sc1); partialSM8m<false>(pA0, pA1, M, mi, alA);
    __syncthreads(); SWAIT(); SWRITE(1, SO);
    RESC(alA); __syncthreads();
  }
  SBAR(); qkt8m(pB0, pB1, mi, K_lds + SHM_K8, q8a, q8b, r32, hi, sc1, scq);
  finishSM8m(pA0, pA1, alA, l_reg, pa); SBAR();
  pv8m(o, V_lds, pa, r32, hi, sc1); partialSM8m<false>(pB0, pB1, M, mi, alB);
  __syncthreads(); RESC(alB);
  finishSM8m(pB0, pB1, alB, l_reg, pa); SBAR();
  pv8m(o, V_lds + SHM_V8, pa, r32, hi, sc1);
  if (hi == 0) li_l[r32] = l_reg; asm volatile("s_waitcnt lgkmcnt(0)" ::: "memory");
  xdl_pad2(o[0], o[1]); xdl_pad2(o[2], o[3]);
  float rli[16];
#pragma unroll
  for (int r = 0; r < 16; ++r) rli[r] = __builtin_amdgcn_rcpf(li_l[crow(r, hi)]);
  bf16* Ow = Ob + (long)(wid * QBLK) * LDO;
#pragma unroll
  for (int r = 0; r < 16; ++r) { int orow = crow(r, hi);
#pragma unroll
    for (int d0 = 0; d0 < 4; ++d0) Ow[(long)orow * LDO + d0 * 32 + r32] = (bf16)f2bf(o[d0][r] * rli[r]); }
  __syncthreads();
#undef SLOAD
#undef SWRITE
#undef SWAIT
#undef RESC
}
}

__device__ __forceinline__ void ph_norm3(Frame& F) {
    unsigned char* ar = F.ws + WS_ARENA;
    LAS float* RT = (LAS float*)(F.lds + 3 * 8192);
    LAS int* HIST = (LAS int*)(F.lds + 11 * 8192);
    __syncthreads();
    for (int i = F.tid; i < 2048; i += NTHR) { PV(0)[i] = modp(F, 1, 0, 2)[i] * inp(I_NORMS)[(4 + 1) * 2048 + i]; PV(1)[i] = inp(I_NORMS)[(4 + 2) * 2048 + i] * (1.f + modp(F, 1, 0, 4)[i]); PV(2)[i] = modp(F, 1, 0, 3)[i]; }
    for (int i = F.tid; i < 2048 * 8; i += NTHR) RT[(i & 7) * 2048 + (i >> 3)] = inp(I_ROUTER)[i];
    __syncthreads();
    const bf16* YO = (const bf16*)(ar + B_YO1); bf16* V1 = (bf16*)(ar + B_V1); bf16* HR = (bf16*)(F.ws + WS_HRES) + (size_t)CTX * D;
    int* RE = (int*)(ar + B_RE); float* RG = (float*)(ar + B_RG); int* CNT = (int*)(ar + B_CNT);
    for (int blk = blockIdx.x; blk < SEQ / 64; blk += F.G) {
        if (F.tid < 8) HIST[F.tid] = 0;
        __syncthreads();
        for (int rr = 0; rr < 8; ++rr) { const int t = blk * 64 + F.wave * 8 + rr; f32x4 y[8], h[8];
            ld_row_bf16(YO + (size_t)t * D, F.lane, y); ld_row_bf16(HR + (size_t)t * D, F.lane, h);
            const float ry = 1.f / sqrtf(row_sumsq(y) * (1.f / D) + EPS);
#pragma unroll
            for (int j = 0; j < 8; ++j) h[j] = h[j] + y[j] * ry * ldp(PV(0), F.lane, j);
            st_row_bf16(HR + (size_t)t * D, F.lane, h);
            const float rh = 1.f / sqrtf(row_sumsq(h) * (1.f / D) + EPS);
#pragma unroll
            for (int j = 0; j < 8; ++j) y[j] = h[j] * rh * ldp(PV(1), F.lane, j) + ldp(PV(2), F.lane, j);
            { unsigned char* V8 = (unsigned char*)V1 + (size_t)t * D;
#pragma unroll
              for (int j = 0; j < 8; ++j) *(GAS unsigned*)(V8 + 4 * F.lane + 256 * j) = pk4_fp8(y[j][0], y[j][1], y[j][2], y[j][3]); }
            float lg[8];
#pragma unroll
            for (int e = 0; e < 8; ++e) { float s = 0.f;
#pragma unroll
                for (int j = 0; j < 8; ++j) { const f32x4 w = ldp(RT + e * 2048, F.lane, j); s += (y[j][0] * w[0] + y[j][1] * w[1]) + (y[j][2] * w[2] + y[j][3] * w[3]); }
                lg[e] = wave_sum(s) + inp(I_ROUTERB)[e]; }
            if (F.lane == 0) { int e0 = 0; float v0 = lg[0];
#pragma unroll
                for (int e = 1; e < 8; ++e) if (lg[e] > v0) { v0 = lg[e]; e0 = e; }
                int e1 = -1; float v1 = -3.0e38f;
#pragma unroll
                for (int e = 0; e < 8; ++e) if (e != e0 && lg[e] > v1) { v1 = lg[e]; e1 = e; }
                const float g0 = 1.f / (1.f + __expf(v1 - v0));
                RE[2 * t] = e0; RE[2 * t + 1] = e1; RG[2 * t] = g0; RG[2 * t + 1] = 1.f - g0;
                __hip_atomic_fetch_add((int*)(HIST + e0), 1, __ATOMIC_RELAXED, __HIP_MEMORY_SCOPE_WORKGROUP); __hip_atomic_fetch_add((int*)(HIST + e1), 1, __ATOMIC_RELAXED, __HIP_MEMORY_SCOPE_WORKGROUP); }
        }
        __syncthreads();
        if (F.tid < 8) CNT[blk * 8 + F.tid] = HIST[F.tid];
        __syncthreads();
    }
}
__device__ __forceinline__ void ph_route(Frame& F) {
    unsigned char* ar = F.ws + WS_ARENA;
    LAS int* TOT = (LAS int*)(F.lds); LAS int* PRE = TOT + 8; LAS int* BASE = TOT + 16; LAS int* POS = TOT + 32;
    const int* CNT = (const int*)(ar + B_CNT); const int* RE = (const int*)(ar + B_RE); int* SLOT = (int*)(ar + B_SLOT); int* TILE = (int*)(ar + B_TILE);
    const bf16* V1 = (const bf16*)(ar + B_V1); unsigned char* VG = ar + B_VG;
    for (int blk = blockIdx.x; blk < SEQ / 64; blk += F.G) {
        __syncthreads();
        { const int e = F.wave; int tot = 0, pre = 0;
          for (int q = 0; q < 4; ++q) { const int b = 4 * F.lane + q; const int cv = CNT[b * 8 + e]; tot += cv; pre += (b < blk) ? cv : 0; }
#pragma unroll
          for (int o = 1; o < 64; o <<= 1) { tot += __shfl_xor(tot, o); pre += __shfl_xor(pre, o); }
          if (F.lane == 0) { TOT[e] = tot; PRE[e] = pre; } }
        __syncthreads();
        if (F.tid == 0) { int b = 0; for (int e = 0; e < 8; ++e) { BASE[e] = b; b += (TOT[e] + 255) / 256 * 256; } BASE[8] = b; }
        __syncthreads();
        if (F.wave == 0) { const int t = blk * 64 + F.lane; const int e0 = RE[2 * t], e1 = RE[2 * t + 1]; int p0 = 0, p1 = 0;
            const unsigned long long lt = (1ull << F.lane) - 1ull;
#pragma unroll
            for (int e = 0; e < 8; ++e) { const unsigned long long m0 = __ballot(e0 == e), m1 = __ballot(e1 == e); const int rk = __popcll(m0 & lt) + __popcll(m1 & lt);
                if (e0 == e) p0 = BASE[e] + PRE[e] + rk; if (e1 == e) p1 = BASE[e] + PRE[e] + rk; }
            SLOT[2 * t] = p0; SLOT[2 * t + 1] = p1; POS[2 * F.lane] = p0; POS[2 * F.lane + 1] = p1; }
        __syncthreads();
        for (int idx = F.tid; idx < 128 * 128; idx += NTHR) { const int ri = idx >> 7, seg = idx & 127;
            *(GAS v4u*)(VG + (size_t)POS[ri] * D + seg * 16) = *(const GAS v4u*)((const unsigned char*)V1 + (size_t)(blk * 64 + (ri >> 1)) * D + seg * 16); }
        if (blk < 8) { const int e = blk, r0 = BASE[e] + TOT[e], r1 = BASE[e + 1];
            for (int idx = F.tid; idx < (r1 - r0) * 128; idx += NTHR) *(GAS v4u*)(VG + (size_t)(r0 + (idx >> 7)) * D + (idx & 127) * 16) = (v4u){0u, 0u, 0u, 0u}; }
        if (blk == 0 && F.tid == 0) { int nt = 0; for (int e = 0; e < 8; ++e) { const int n = (BASE[e + 1] - BASE[e]) / 256; for (int q = 0; q < n; ++q) TILE[1 + nt++] = e; } TILE[0] = nt; }
    }
}
__device__ __forceinline__ void ph_norm4(Frame& F, float* out) {
    unsigned char* ar = F.ws + WS_ARENA;
    __syncthreads();
    for (int i = F.tid; i < 2048; i += NTHR) PV(0)[i] = modp(F, 1, 0, 5)[i] * inp(I_NORMS)[(4 + 3) * 2048 + i];
    __syncthreads();
    const bf16* FS = (const bf16*)(ar + B_FS); const bf16* HR = (const bf16*)(F.ws + WS_HRES) + (size_t)CTX * D; const int* SLOT = (const int*)(ar + B_SLOT); const float* RG = (const float*)(ar + B_RG);
    const int gw = F.vcu * NWAVES + F.wave, NGW = F.G * NWAVES;
    for (int t = gw; t < SEQ; t += NGW) { f32x4 a[8], b[8], h[8]; const int p0 = SLOT[2 * t], p1 = SLOT[2 * t + 1]; const float g0 = RG[2 * t], g1 = RG[2 * t + 1];
        const float* PART = (const float*)(ar + B_VG); constexpr size_t PSTR = (size_t)MOE_SPLIT_TILES * 256 * D;
        if (p0 < MOE_MAIN_TILES * 256) ld_row_bf16(FS + (size_t)p0 * D, F.lane, a);
        else { const float* pp = PART + (size_t)(p0 - MOE_MAIN_TILES * 256) * D; f32x4 q1[8], q2[8], q3[8]; ld_row_f32(pp, F.lane, a); ld_row_f32(pp + PSTR, F.lane, q1); ld_row_f32(pp + 2 * PSTR, F.lane, q2); ld_row_f32(pp + 3 * PSTR, F.lane, q3);
#pragma unroll
            for (int j = 0; j < 8; ++j) a[j] = (a[j] + q1[j]) + (q2[j] + q3[j]); }
        if (p1 < MOE_MAIN_TILES * 256) ld_row_bf16(FS + (size_t)p1 * D, F.lane, b);
        else { const float* pp = PART + (size_t)(p1 - MOE_MAIN_TILES * 256) * D; f32x4 q1[8], q2[8], q3[8]; ld_row_f32(pp, F.lane, b); ld_row_f32(pp + PSTR, F.lane, q1); ld_row_f32(pp + 2 * PSTR, F.lane, q2); ld_row_f32(pp + 3 * PSTR, F.lane, q3);
#pragma unroll
            for (int j = 0; j < 8; ++j) b[j] = (b[j] + q1[j]) + (q2[j] + q3[j]); }
        ld_row_bf16(HR + (size_t)t * D, F.lane, h);
#pragma unroll
        for (int j = 0; j < 8; ++j) a[j] = a[j] * g0 + b[j] * g1;
        const float rf = 1.f / sqrtf(row_sumsq(a) * (1.f / D) + EPS);
#pragma unroll
        for (int j = 0; j < 8; ++j) h[j] = h[j] + a[j] * rf * ldp(PV(0), F.lane, j);
        st_row_f32(out + (size_t)t * D, F.lane, h); }
}

struct EpiGateUp8 { static constexpr bool PERM = true; unsigned char* HID; int ldc; float is;
    __device__ __forceinline__ void operator()(AccRef acc, const Unit& u, int wr, int wc, int fr, int fq) const { EPI_ROWS(u); const int col0 = u.pn * 128 + wc * 32 + 8 * fq; const float c1 = -1.4426950408889634f * is, kk = is * is * MOE_HSC;
#pragma unroll
        for (int ai = 0; ai < 2; ++ai)
#pragma unroll
            for (int m = 0; m < 4; ++m) { const int row = row0 + ai * 128 + m * 16; float a[4], b[4];
#pragma unroll
                for (int q = 0; q < 4; ++q) { a[q] = __builtin_amdgcn_fmed3f(swiglu_fast(acc[ai][0][m][0][q], acc[ai][1][m][0][q], c1, kk), -448.f, 448.f);
                                              b[q] = __builtin_amdgcn_fmed3f(swiglu_fast(acc[ai][0][m][1][q], acc[ai][1][m][1][q], c1, kk), -448.f, 448.f); }
                v2u o; o.x = pk4_fp8(a[0], a[1], a[2], a[3]); o.y = pk4_fp8(b[0], b[1], b[2], b[3]);
                *(GAS v2u*)(HID + (size_t)row * ldc + col0) = o; } } };
struct EpiPlainSc { static constexpr bool PERM = true; bf16* O; int ldc; float sc;
    __device__ __forceinline__ void operator()(AccRef acc, const Unit& u, int wr, int wc, int fr, int fq) const { EPI_ROWS(u); const int col0 = u.pn * 256 + wc * 32 + 8 * fq;
#pragma unroll
        for (int ai = 0; ai < 2; ++ai)
#pragma unroll
            for (int m = 0; m < 4; ++m) { bf16* rp = O + (size_t)(row0 + ai * 128 + m * 16) * ldc + col0;
#pragma unroll
                for (int bj = 0; bj < 2; ++bj) *(GAS u32x4*)(rp + bj * 128) = pack8(acc[ai][bj][m][0] * sc, acc[ai][bj][m][1] * sc); } } };

struct EpiPart { static constexpr bool PERM = false; float* P; int pm0; float sc;
    __device__ __forceinline__ void operator()(AccRef acc, const Unit& u, int wr, int wc, int fr, int fq) const { const int row0 = (u.pm - pm0) * 256 + wr * 64 + fr, col0 = u.pn * 256 + wc * 32 + 4 * fq;
        float* base = P + (size_t)u.bz * ((size_t)MOE_SPLIT_TILES * 256 * D);
#pragma unroll
        for (int ai = 0; ai < 2; ++ai)
#pragma unroll
            for (int m = 0; m < 4; ++m) { float* rp = base + (size_t)(row0 + ai * 128 + m * 16) * D + col0;
#pragma unroll
                for (int bj = 0; bj < 2; ++bj)
#pragma unroll
                    for (int n = 0; n < 2; ++n) *(GAS f32x4*)(rp + bj * 128 + n * 16) = acc[ai][bj][m][n] * sc; } } };

enum { PH_PRO = 0, PH_N0, PH_WINE, PH_POOLD, PH_SCAN, PH_S5Y, PH_GLU, PH_WOUTE, PH_N1, PH_FFNU, PH_FFND, PH_N2,
       PH_WINO, PH_PREP, PH_GLA1, PH_GLA2, PH_GLA3, PH_ATT, PH_WOUTO, PH_N3, PH_ROUTE, PH_MOEU, PH_MOED, PH_N4, NPH };
constexpr int PH_EMIT = 100;
struct Args { const float* in[N_IN]; float* out; unsigned char* ws; int ph_lo, ph_hi, li, pad; };

__global__ void __launch_bounds__(NTHR, 2) mk_fwd(Args args) {
    extern __shared__ __attribute__((aligned(16))) unsigned char lds[];
    Frame F;
    F.lds = (LAS unsigned char*)lds; F.MISC = (volatile LAS unsigned*)(F.lds + MISC_OFF);
    F.tid = threadIdx.x; F.lane = F.tid & 63; F.wave = __builtin_amdgcn_readfirstlane(F.tid >> 6);
    F.G = gridDim.x; { const int bx = blockIdx.x; F.vcu = (F.G % 8 == 0) ? (bx % 8) * (F.G / 8) + bx / 8 : bx; }
    F.ws = karg_ws(); F.ctl = (gu32*)(F.ws + WS_CTL);
    for (int u = F.tid; u < (LDS_BYTES - LDSCTL_OFF) / 4; u += NTHR) ((LAS unsigned*)(F.lds + LDSCTL_OFF))[u] = 0u;
    __syncthreads();
    XcdBarrier bar = xcd_barrier_post((unsigned*)(F.ctl + CW_BAR) + (karg_i(2) & 7) * XCD_BAR_WORDS, F.MISC + 8);
    const int lo = karg_i(0), hi = karg_i(1);
#define IN(k) (lo <= (k) && (k) < hi)
#define SEAM(k) do { if (IN(k) && IN((k) + 1)) xcd_barrier(bar); } while (0)
    PG8_LAS unsigned char* ring = (PG8_LAS unsigned char*)(F.lds + RING_OFF);
    unsigned char* ar = F.ws + WS_ARENA;
    const int bid = (int)blockIdx.x;

    if (lo == PH_EMIT) { ph_emit(F, karg_out()); return; }

    if (IN(PH_PRO)) { p0_prologue(F); } SEAM(PH_PRO);
    if (IN(PH_N0)) { for (int it = bid; it < S5G * 8; it += F.G) { s5_small_tables(F, it >> 3); s5_stage_b(F, it >> 3, it & 7); } ph_norm0(F); } SEAM(PH_N0);
    if (IN(PH_WINE)) {
        pg8::Gemm g{(const bf16*)(ar + A_U), (const bf16*)(F.ws + WS_WINE), D, D, D};
        pg8::PlainSched S; S.o.init(T / 256, D / 256, 1, F.G, bid); S.astr = (size_t)256 * D * 2; S.bstr = (size_t)256 * D * 2; S.zA = 0; S.zB = 0;
        EpiWinE E{(bf16*)(ar + A_ZP), (bf16*)(ar + A_AS5)};
        pg8::gemm_phase(ring, g, S, E);
        conv_work(F, 0, fill_quota(S.o.nwg, F.G, bid, 6));
    } SEAM(PH_WINE);
    if (IN(PH_POOLD)) {
        ph_pooldiff(F);
        __syncthreads();
        pg8::Gemm g{(const bf16*)(ar + A_AS5), (const bf16*)(ar + A_M1T), S5K, 1024, 1024};
        pg8::PlainSched S; S.o.init(S5ROWS / 256, 1, S5G, F.G, bid); S.astr = (size_t)256 * S5K * 2; S.bstr = 0; S.zA = (size_t)S5ROWS * S5K * 2; S.zB = (size_t)256 * 1024 * 2;
        EpiSloc E{(float*)(ar + A_SLOC)};
        pg8::gemm_phase(ring, g, S, E);
        conv_work(F, 0, fill_quota(S.o.nwg, F.G, bid, 3));
    } SEAM(PH_POOLD);
    if (IN(PH_SCAN)) {
        ph_s5scan(F);
        __syncthreads();
        pg8::Gemm g{(const bf16*)(ar + A_DP), (const bf16*)(F.ws + WS_WPOOL), WPOOL, PG, PG};
        pg8::PlainSched S; S.o.init(T / 256, 2, 4, F.G, bid); S.astr = (size_t)256 * WPOOL * 2; S.bstr = (size_t)256 * PG * 2; S.zA = (size_t)PG * 2; S.zB = (size_t)512 * PG * 2;
        EpiPool E{(bf16*)(ar + A_YMIX), inp(I_EPOOLS)};
        pg8::gemm_phase(ring, g, S, E);
        conv_work(F, 0, fill_quota(S.o.nwg, F.G, bid, 1));
    } SEAM(PH_SCAN);
    if (IN(PH_S5Y)) {
        pg8::Gemm g{(const bf16*)(ar + A_AS5), (const bf16*)(ar + A_K3T), S5K, S5K, S5K};
        pg8::PlainSched S; S.o.init(S5ROWS / 256, 4, S5G, F.G, bid); S.astr = (size_t)256 * S5K * 2; S.bstr = (size_t)256 * S5K * 2; S.zA = (size_t)S5ROWS * S5K * 2; S.zB = (size_t)1024 * S5K * 2;
        EpiS5Y E{(const bf16*)(ar + A_AS5), inp(I_S5D), (bf16*)(ar + A_YG)};
        pg8::gemm_phase(ring, g, S, E);
    } SEAM(PH_S5Y);
    if (IN(PH_GLU)) {
        pg8::Gemm g{(const bf16*)(ar + A_YG), (const bf16*)(F.ws + WS_WGLU), WS5, WS5, WS5};
        pg8::PlainSched S; S.o.init(T / 256, 2, 1, F.G, bid); S.astr = (size_t)256 * WS5 * 2; S.bstr = (size_t)256 * WS5 * 2; S.zA = 0; S.zB = 0;
        EpiGlu E{(const bf16*)(ar + A_YG), (bf16*)(ar + A_YMIX)};
        pg8::gemm_phase(ring, g, S, E);
        conv_work(F, 0, fill_quota(S.o.nwg, F.G, bid, 2));
    } SEAM(PH_GLU);
    if (IN(PH_WOUTE)) {
        pg8::Gemm g{(const bf16*)(ar + A_YMIX), (const bf16*)(F.ws + WS_WOUTE), D, D, D};
        pg8::PlainSched S; S.o.init(T / 256, D / 256, 1, F.G, bid); S.astr = (size_t)256 * D * 2; S.bstr = (size_t)256 * D * 2; S.zA = 0; S.zB = 0;
        EpiPlain E{(bf16*)(ar + A_YO), D};
        pg8::gemm_phase(ring, g, S, E);
        conv_work(F, 0, fill_quota(S.o.nwg, F.G, bid, 6));
    } SEAM(PH_WOUTE);
    if (IN(PH_N1)) { ph_norm1(F); conv_work(F, CQ_F2, 0); } SEAM(PH_N1);
    if (IN(PH_FFNU)) {
#if FFN_FP8 == 1
        pg8::Gemm g{(const bf16*)(ar + A_V), (const bf16*)(F.ws + WS_WGU), D / 2, D / 2, D / 2};
        pg8::PlainSched S; S.o.init(T / 256, 14336 / 256, 1, F.G, bid); S.astr = (size_t)256 * D; S.bstr = (size_t)256 * D; S.zA = 0; S.zB = 0;
        EpiGateUp8 E{ar + A_HID, DFF, 1.f / MOE_WSC_GU};
        pg8::gemm_phase<EpiGateUp8, pg8::PlainSched, true>(ring, g, S, E);
#elif FFN_FP8 == 2 && FFNU_K1 < 2048
        constexpr int KEQ = FFNU_K1 + (2048 - FFNU_K1) / 2;
        static_assert(FFNU_K1 % 128 == 0 && (2048 - FFNU_K1) % 256 == 0 && KEQ % 128 == 0 && FFNU_K1 % 256 == 0, "mixed-precision split");
        pg8::Gemm g{(const bf16*)(ar + A_V), (const bf16*)(F.ws + WS_WGU), KEQ, KEQ, KEQ};
        pg8::PlainSched S; S.o.init(T / 256, 14336 / 256, 1, F.G, bid); S.astr = (size_t)256 * KEQ * 2; S.bstr = (size_t)256 * KEQ * 2; S.zA = 0; S.zB = 0;
        EpiGateUp8 E{ar + A_HID, DFF, 1.f};
        pg8::gemm_phase<EpiGateUp8, pg8::PlainSched, false, FFNU_K1 / 64>(ring, g, S, E);
#elif FFN_FP8 == 2
        pg8::Gemm g{(const bf16*)(ar + A_V), (const bf16*)(F.ws + WS_WGU), D, D, D};
        pg8::PlainSched S; S.o.init(T / 256, 14336 / 256, 1, F.G, bid); S.astr = (size_t)256 * D * 2; S.bstr = (size_t)256 * D * 2; S.zA = 0; S.zB = 0;
        EpiGateUp8 E{ar + A_HID, DFF, 1.f};
        pg8::gemm_phase(ring, g, S, E);
#else
        pg8::Gemm g{(const bf16*)(ar + A_V), (const bf16*)(F.ws + WS_WGU), D, D, D};
        pg8::PlainSched S; S.o.init(T / 256, 14336 / 256, 1, F.G, bid); S.astr = (size_t)256 * D * 2; S.bstr = (size_t)256 * D * 2; S.zA = 0; S.zB = 0;
        EpiGateUp E{(bf16*)(ar + A_HID), DFF};
        pg8::gemm_phase(ring, g, S, E);
#endif
        conv_work(F, CQ_F3, fill_quota((T / 256) * (14336 / 256), F.G, bid, 6));
    } SEAM(PH_FFNU);
    if (IN(PH_FFND)) {
#if FFN_FP8
        pg8::Gemm g{(const bf16*)(ar + A_HID), (const bf16*)(F.ws + WS_WDN), DFF / 2, DFF / 2, DFF / 2};
        pg8::PlainSched S; S.o.init(T / 256, D / 256, 1, F.G, bid); S.astr = (size_t)256 * DFF; S.bstr = (size_t)256 * DFF; S.zA = 0; S.zB = 0;
        EpiPlainSc E{(bf16*)(ar + A_F), D, 1.f / (MOE_WSC_DN * MOE_HSC)};
        pg8::gemm_phase<EpiPlainSc, pg8::PlainSched, true>(ring, g, S, E);
#else
        pg8::Gemm g{(const bf16*)(ar + A_HID), (const bf16*)(F.ws + WS_WDN), DFF, DFF, DFF};
        pg8::PlainSched S; S.o.init(T / 256, D / 256, 1, F.G, bid); S.astr = (size_t)256 * DFF * 2; S.bstr = (size_t)256 * DFF * 2; S.zA = 0; S.zB = 0;
        EpiPlain E{(bf16*)(ar + A_F), D};
        pg8::gemm_phase(ring, g, S, E);
#endif
        conv_work(F, CQ_O1, fill_quota((T / 256) * (D / 256), F.G, bid, 11));
    } SEAM(PH_FFND);
    if (IN(PH_N2)) { ph_norm2(F); conv_work(F, CQ_O1, 0); } SEAM(PH_N2);
    if (IN(PH_WINO)) {
        pg8::Gemm g{(const bf16*)(ar + A_U), (const bf16*)(F.ws + WS_WINO), D, D, D};
        pg8::PlainSched S; S.o.init(T / 256, WINO_N / 256, 1, F.G, bid); S.astr = (size_t)256 * D * 2; S.bstr = (size_t)256 * D * 2; S.zA = 0; S.zB = 0;
        EpiWinO E{ar};
        pg8::gemm_phase(ring, g, S, E);
        conv_work(F, CQ_O2, fill_quota(S.o.nwg, F.G, bid, 5));
    } SEAM(PH_WINO);
    if (IN(PH_PREP)) { ph_qknorm(F); ph_vt8(F); for (int u = bid; u < NCH * 4; u += F.G) gla_prepkv_unit(F, u >> 2, u & 3); conv_work(F, 0, fill_quota(NCH * 4, F.G, bid, 4)); } SEAM(PH_PREP);
    if (IN(PH_GLA2)) { ph_gla_scan(F); } SEAM(PH_GLA2);
    if (IN(PH_GLA3)) { for (int u = bid; u < (SEQ / 64) * 4; u += F.G) gla_out_unit(F, u >> 2, u & 3); __syncthreads(); }
    if (IN(PH_ATT)) {
        for (int L = bid; L < 8 * (SEQ / 256); L += F.G) { const int h = L >> 6, qb = L & 63;
            const bf16* Q = (const bf16*)(ar + B_AQ) + (size_t)(CTX + qb * 256) * 1024 + h * 128;
            const unsigned char* Kp = ar + B_KDT + (h >> 2) * 128; const bf16* Vp = (const bf16*)(ar + B_AV) + (h >> 2) * 128;
            bf16* O = (bf16*)(ar + B_YMIX1) + (size_t)(qb * 256) * D + 1024 + h * 128;
            att::attn_dense_body_m(Q, Kp, ar + B_KDT + VT8_OFF + (size_t)(h >> 2) * NCH * 8192, O, T, (char*)lds); }
    } SEAM(PH_ATT);
    if (IN(PH_WOUTO)) {
        pg8::Gemm g{(const bf16*)(ar + B_YMIX1), (const bf16*)(F.ws + WS_WOUTO), D, D, D};
        pg8::PlainSched S; S.o.init(SEQ / 256, D / 256, 1, F.G, bid); S.astr = (size_t)256 * D * 2; S.bstr = (size_t)256 * D * 2; S.zA = 0; S.zB = 0;
        EpiPlain E{(bf16*)(ar + B_YO1), D};
        pg8::gemm_phase(ring, g, S, E);
    } SEAM(PH_WOUTO);
    if (IN(PH_N3)) { ph_norm3(F); } SEAM(PH_N3);
    if (IN(PH_ROUTE)) { ph_route(F); conv_work(F, CQ_M2, 0); } SEAM(PH_ROUTE);
    if (IN(PH_MOEU)) {
        const int* TILE = (const int*)(ar + B_TILE); const int nt = __builtin_amdgcn_readfirstlane(TILE[0]);
        pg8::Gemm g{(const bf16*)(ar + B_VG), (const bf16*)(F.ws + WS_WMGU), D / 2, D / 2, D / 2};
        pg8::MoeSched S; S.o.init(nt, 14336 / 256, 1, F.G, bid); S.astr = (size_t)256 * D; S.bstr = (size_t)256 * D; S.zB = (size_t)14336 * D; S.tile_e = TILE + 1;
        EpiGateUp8 E{ar + B_HID2, DFF, 1.f / MOE_WSC_GU};
        pg8::gemm_phase<EpiGateUp8, pg8::MoeSched, true>(ring, g, S, E);
        conv_work(F, CQ_M3, fill_quota(S.o.nwg, F.G, bid, 5));
    } SEAM(PH_MOEU);
    if (IN(PH_MOED)) {
        const int* TILE = (const int*)(ar + B_TILE); const int nt = __builtin_amdgcn_readfirstlane(TILE[0]);
        pg8::Gemm g{(const bf16*)(ar + B_HID2), (const bf16*)(F.ws + WS_WMDN), DFF / 2, DFF / 2, DFF / 2};
        const int nmain = nt < MOE_MAIN_TILES ? nt : MOE_MAIN_TILES;
        pg8::MoeSched S; S.o.init(nmain, D / 256, 1, F.G, bid); S.astr = (size_t)256 * DFF; S.bstr = (size_t)256 * DFF; S.zB = (size_t)D * DFF; S.tile_e = TILE + 1;
        EpiPlainSc E{(bf16*)(ar + B_FS), D, 1.f / (MOE_WSC_DN * MOE_HSC)};
        pg8::gemm_phase<EpiPlainSc, pg8::MoeSched, true>(ring, g, S, E);
        if (nt > MOE_MAIN_TILES) {
            pg8::Gemm g2{(const bf16*)(ar + B_HID2), (const bf16*)(F.ws + WS_WMDN), DFF / 2, DFF / 2, DFF / 8};
            pg8::MoeSplitSched S2; S2.pm0 = MOE_MAIN_TILES; S2.nun = (nt - MOE_MAIN_TILES) * 32; S2.G = F.G; S2.c = bid; S2.astr = (size_t)256 * DFF; S2.bstr = (size_t)256 * DFF; S2.zB = (size_t)D * DFF; S2.kslice = DFF / 4; S2.tile_e = TILE + 1;
            EpiPart E2{(float*)(ar + B_VG), MOE_MAIN_TILES, 1.f / (MOE_WSC_DN * MOE_HSC)};
            pg8::gemm_phase<EpiPart, pg8::MoeSplitSched, true>(ring, g2, S2, E2);
        }
    } SEAM(PH_MOED);
    if (IN(PH_N4)) { ph_norm4(F, karg_out()); }
#undef IN
#undef SEAM
}

extern "C" void kernel_launch(void* const* d_in, const int* in_sizes, int n_in, void* d_out, int out_size, void* d_ws, size_t ws_size, hipStream_t stream) {
    static int grid = 0;
    if (grid == 0) {
        if (n_in != N_IN || out_size != SEQ * D || ws_size < WS_NEED) { fprintf(stderr, "kernel_launch: shape/workspace mismatch (n_in %d out %d ws %zu need %zu)\n", n_in, out_size, ws_size, (size_t)WS_NEED); grid = -1; return; }
        int dev = 0, cus = 0, per_cu = 0;
        if (hipGetDevice(&dev) != hipSuccess || hipDeviceGetAttribute(&cus, hipDeviceAttributeMultiprocessorCount, dev) != hipSuccess) { grid = -1; return; }
        if (hipFuncSetAttribute((const void*)mk_fwd, hipFuncAttributeMaxDynamicSharedMemorySize, LDS_BYTES) != hipSuccess) { fprintf(stderr, "kernel_launch: hipFuncSetAttribute failed\n"); grid = -1; return; }
        if (hipOccupancyMaxActiveBlocksPerMultiprocessor(&per_cu, (const void*)mk_fwd, NTHR, LDS_BYTES) != hipSuccess || per_cu < 1) { fprintf(stderr, "kernel_launch: occupancy query says %d\n", per_cu); }
        (void)hipGetLastError();
        grid = cus;
    }
    if (grid < 0) return;
    (void)hipMemsetAsync((char*)d_ws + WS_CTL, 0, CTL_ZERO_BYTES, stream);
    Args a{};
    for (int i = 0; i < N_IN; ++i) a.in[i] = (const float*)d_in[i];
    a.out = (float*)d_out; a.ws = (unsigned char*)d_ws; a.pad = 0;
    const int last = (MK_STOP < NPH - 1) ? MK_STOP : NPH - 1;
#if MK_SPLIT
    for (int p = 0; p <= last; ++p) { a.ph_lo = p; a.ph_hi = p + 1; a.li = p; hipLaunchKernelGGL(mk_fwd, dim3(grid), dim3(NTHR), LDS_BYTES, stream, a); }
#else
    a.ph_lo = 0; a.ph_hi = last + 1; a.li = 0; hipLaunchKernelGGL(mk_fwd, dim3(grid), dim3(NTHR), LDS_BYTES, stream, a);
#endif
    if (last < NPH - 1) { a.ph_lo = PH_EMIT; a.ph_hi = PH_EMIT + 1; a.li = 7; hipLaunchKernelGGL(mk_fwd, dim3(grid), dim3(NTHR), LDS_BYTES, stream, a); }
    const hipError_t le = hipPeekAtLastError();
    if (le != hipSuccess) fprintf(stderr, "kernel_launch: launch failed: %s\n", hipGetErrorName(le));
}
```

```cpp
#include <hip/hip_runtime.h>
#include <cstdio>
#include <cstdint>

#ifndef MK_STOP
#define MK_STOP 99
#endif
#ifndef FFN_FP8
#define FFN_FP8 2
#endif
#ifndef FFNU_K1
#define FFNU_K1 1536
#endif
#ifndef MK_SPLIT
#define MK_SPLIT 0
#endif

namespace pg8 {
#define PG8_LAS __attribute__((address_space(3)))
typedef unsigned short bf16_t;
typedef short bf16x8 __attribute__((ext_vector_type(8)));
typedef float f32x4 __attribute__((ext_vector_type(4)));
typedef unsigned u32x4 __attribute__((ext_vector_type(4)));
typedef int v4i __attribute__((ext_vector_type(4)));
typedef int v8i __attribute__((ext_vector_type(8)));
constexpr int BM = 256, BK = 64, HALF = 128, HTB = HALF * BK * 2, STAGE_BYTES = 8 * HTB, NXCD = 8, WGM = 8;

__host__ __device__ __forceinline__ int lds_byte(int r, int c) { const int st = (r >> 4) * 2 + (c >> 5), rr = r & 15, cc = c & 31, ob = rr * 64 + cc * 2; return st * 1024 + (ob ^ (((ob >> 9) & 1) << 5)); }
__host__ __device__ __forceinline__ void stage_rc(int b, int& R, int& C) { const int st = b / 1024, sb = b % 1024, swz = sb ^ (((sb >> 9) & 1) << 5); R = (st >> 1) * 16 + swz / 64; C = (st & 1) * 32 + (swz % 64) / 2; }
__host__ __device__ __forceinline__ int perm32(int rho) { const int n = rho >> 4, i = rho & 15; return 8 * (i >> 2) + 4 * n + (i & 3); }

struct Unit { int pm, pn, bz; unsigned aoff, boff; };
struct Gemm { const bf16_t* A; const bf16_t* Bt; int lda, ldb, K; };

struct TileOrder {
    int nM, nN, nB, nwg, G, c;
    __device__ void init(int nM_, int nN_, int nB_, int G_, int c_) { nM = nM_; nN = nN_; nB = nB_; nwg = nM * nN * nB; G = G_; c = c_; }
    __device__ bool decode(int i, int& bz, int& pm, int& pn) const {
        const long L = (long)i * G + c; if (L >= nwg) return false;
        int wgid = (int)L; { const int q = nwg / NXCD, r = nwg % NXCD, xcd = wgid % NXCD, off = wgid / NXCD; wgid = (xcd < r ? xcd * (q + 1) : r * (q + 1) + (xcd - r) * q) + off; }
        const int per = nM * nN; bz = wgid / per; const int w = wgid - bz * per;
        const int nig = WGM * nN, gid = w / nig, fm = gid * WGM, gsz = (nM - fm) < WGM ? (nM - fm) : WGM;
        pm = fm + ((w % nig) % gsz); pn = (w % nig) / gsz; return true;
    }
};
struct PlainSched {
    TileOrder o; size_t astr, bstr, zA, zB;
    __device__ bool next(int i, Unit& u) const { if (!o.decode(i, u.bz, u.pm, u.pn)) return false; u.aoff = (unsigned)((size_t)u.bz * zA + (size_t)u.pm * astr); u.boff = (unsigned)((size_t)u.bz * zB + (size_t)u.pn * bstr); return true; }
};
struct MoeSched {
    TileOrder o; size_t astr, bstr, zB; const int* tile_e;
    __device__ bool next(int i, Unit& u) const { int bz; if (!o.decode(i, bz, u.pm, u.pn)) return false; u.bz = __builtin_amdgcn_readfirstlane(tile_e[u.pm]); u.aoff = (unsigned)((size_t)u.pm * astr); u.boff = (unsigned)((size_t)u.bz * zB + (size_t)u.pn * bstr); return true; }
};

struct MoeSplitSched {
    int pm0, nun, G, c; size_t astr, bstr, zB; unsigned kslice; const int* tile_e;
    __device__ bool next(int i, Unit& u) const { const long L = (long)i * G + c; if (L >= nun) return false; const int l = (int)L, ks = l & 3, pn = (l >> 2) & 7, pm = pm0 + (l >> 5);
        u.pm = pm; u.pn = pn; u.bz = ks; const int e = __builtin_amdgcn_readfirstlane(tile_e[pm]);
        u.aoff = (unsigned)((size_t)pm * astr + (size_t)ks * kslice); u.boff = (unsigned)((size_t)e * zB + (size_t)pn * bstr + (size_t)ks * kslice); return true; }
};
__device__ __forceinline__ unsigned cvt_pk_bf16(float lo, float hi) { unsigned r; asm volatile("v_cvt_pk_bf16_f32 %0, %1, %2" : "=v"(r) : "v"(lo), "v"(hi)); return r; }
__device__ __forceinline__ u32x4 pack8(const f32x4& a, const f32x4& b) { u32x4 w; w.x = cvt_pk_bf16(a[0], a[1]); w.y = cvt_pk_bf16(a[2], a[3]); w.z = cvt_pk_bf16(b[0], b[1]); w.w = cvt_pk_bf16(b[2], b[3]); return w; }

template <class Epi, class Sched, bool FP8 = false, int MIXT = -1>
__device__ __forceinline__ void gemm_phase(PG8_LAS unsigned char* lds, const Gemm g, const Sched& S, const Epi& E) {
    const int tid = threadIdx.x, wid = __builtin_amdgcn_readfirstlane(tid >> 6), lane = tid & 63, wr = wid >> 2, wc = wid & 3, fr = lane & 15, fq = lane >> 4;
    const int K = g.K, nt = K / BK;
    unsigned voffA[2], voffB[2];
#pragma unroll
    for (int i = 0; i < 2; ++i) { int R, C; stage_rc(tid * 16 + i * 8192, R, C); const int Rb = Epi::PERM ? ((R & ~31) + perm32(R & 31)) : R;
        voffA[i] = (unsigned)(R * g.lda + C) * 2u; voffB[i] = (unsigned)(Rb * g.ldb + C) * 2u; }
    const unsigned kstep = (unsigned)(BK * 2);
    const unsigned hstepA = (unsigned)HALF * (unsigned)g.lda * 2u, hstepB = (unsigned)HALF * (unsigned)g.ldb * 2u;
    const unsigned ldsw = (unsigned)wid * 1024u;
    const int aoff = lds_byte(wr * 64 + fr, fq * 8), boff = lds_byte(wc * 32 + fr, fq * 8);
    const char* const gA = (const char*)g.A; const char* const gB = (const char*)g.Bt;
#define PG8_SA(b, h) (((b) * 2 + (h)) * HTB)
#define PG8_SB(b, h) ((4 + (b) * 2 + (h)) * HTB)
#define PG8_STAGE(bufoff, gbase, soff, voff) do { _Pragma("unroll") for (int _i = 0; _i < 2; ++_i) \
        __builtin_amdgcn_global_load_lds((const unsigned*)((gbase) + (size_t)((soff) + (voff)[_i])), (PG8_LAS unsigned*)(lds + (bufoff) + ldsw + _i * 8192), 16, 0, 0); } while (0)
#define PG8_LDA(dst, b, h) do { _Pragma("unroll") for (int m = 0; m < 4; ++m) _Pragma("unroll") for (int k = 0; k < 2; ++k) dst[m][k] = *(const PG8_LAS bf16x8*)(lds + PG8_SA(b, h) + aoff + m * 2048 + k * 1024); } while (0)
#define PG8_LDB(dst, b, h) do { _Pragma("unroll") for (int n = 0; n < 2; ++n) _Pragma("unroll") for (int k = 0; k < 2; ++k) dst[n][k] = *(const PG8_LAS bf16x8*)(lds + PG8_SB(b, h) + boff + n * 2048 + k * 1024); } while (0)
#define PG8_CAT(x) __builtin_shufflevector(__builtin_bit_cast(v4i, (x)[0]), __builtin_bit_cast(v4i, (x)[1]), 0, 1, 2, 3, 4, 5, 6, 7)
#define PG8_MMA(ai, bj, At, Bt, IS8) do { __builtin_amdgcn_s_setprio(1); \
        if constexpr (MIXT >= 0) { if (IS8) { \
            _Pragma("unroll") for (int m = 0; m < 4; ++m) { const v8i a8 = PG8_CAT(At[m]); _Pragma("unroll") for (int n = 0; n < 2; ++n) { const v8i b8 = PG8_CAT(Bt[n]); \
                asm volatile("s_nop 1\n\tv_mfma_scale_f32_16x16x128_f8f6f4 %0, %1, %2, %0, %3, %4 op_sel_hi:[0,0,0]" : "+v"(acc[ai][bj][m][n]) : "v"(b8), "v"(a8), "v"(scw), "v"(sc1)); } } \
          } else { _Pragma("unroll") for (int m = 0; m < 4; ++m) _Pragma("unroll") for (int n = 0; n < 2; ++n) _Pragma("unroll") for (int k = 0; k < 2; ++k) \
            acc[ai][bj][m][n] = __builtin_amdgcn_mfma_f32_16x16x32_bf16(Bt[n][k], At[m][k], acc[ai][bj][m][n], 0, 0, 0); } \
        } else if constexpr (FP8) {   \
            _Pragma("unroll") for (int m = 0; m < 4; ++m) { const v8i a8 = PG8_CAT(At[m]); _Pragma("unroll") for (int n = 0; n < 2; ++n) { const v8i b8 = PG8_CAT(Bt[n]); \
                  \
                asm volatile("s_nop 1\n\tv_mfma_scale_f32_16x16x128_f8f6f4 %0, %1, %2, %0, %3, %3 op_sel_hi:[0,0,0]" : "+v"(acc[ai][bj][m][n]) : "v"(b8), "v"(a8), "v"(sc1)); } } \
        } else { _Pragma("unroll") for (int m = 0; m < 4; ++m) _Pragma("unroll") for (int n = 0; n < 2; ++n) _Pragma("unroll") for (int k = 0; k < 2; ++k) \
            acc[ai][bj][m][n] = __builtin_amdgcn_mfma_f32_16x16x32_bf16(Bt[n][k], At[m][k], acc[ai][bj][m][n], 0, 0, 0); } \
        __builtin_amdgcn_s_setprio(0); } while (0)
#define PG8_WAIT_V(n) asm volatile("s_waitcnt vmcnt(" #n ")" ::: "memory")
#define PG8_WAIT_L(n) asm volatile("s_waitcnt lgkmcnt(" #n ")" ::: "memory")
#define PG8_BAR __builtin_amdgcn_s_barrier()
#define PG8_SCHED __builtin_amdgcn_sched_barrier(0)
    Unit cur, nxt; int ui = 0;
    if (!S.next(0, cur)) return;
    const int sc1 = 0x7f7f7f7f, scw = 0x79797979;
    f32x4 acc[2][2][4][2];
#pragma unroll
    for (int a = 0; a < 2; ++a)
#pragma unroll
        for (int b = 0; b < 2; ++b)
#pragma unroll
            for (int m = 0; m < 4; ++m)
#pragma unroll
                for (int n = 0; n < 2; ++n) acc[a][b][m][n] = (f32x4){0.f, 0.f, 0.f, 0.f};
    bf16x8 At[4][2], B0[2][2], B1[2][2];
    unsigned cA = cur.aoff, cB = cur.boff;
    PG8_STAGE(PG8_SB(0, 0), gB, cB, voffB); PG8_STAGE(PG8_SB(0, 1), gB, cB + hstepB, voffB); PG8_STAGE(PG8_SA(0, 0), gA, cA, voffA); PG8_STAGE(PG8_SA(0, 1), gA, cA + hstepA, voffA);
    if (wr == 1) PG8_BAR;
    PG8_WAIT_V(2); PG8_BAR;
    PG8_STAGE(PG8_SB(1, 0), gB, cB + kstep, voffB); PG8_STAGE(PG8_SA(1, 0), gA, cA + kstep, voffA); PG8_STAGE(PG8_SB(1, 1), gB, cB + hstepB + kstep, voffB);
    PG8_WAIT_V(6); PG8_BAR;
    for (;;) {
        const bool has_next = S.next(ui + 1, nxt);
        const unsigned nA = has_next ? nxt.aoff : cA, nB = has_next ? nxt.boff : cB;
#define PG8_KBODY(IS8) do { \
            const bool last = (t == nt - 2); \
            const unsigned a1 = cA + (unsigned)(t + 1) * kstep; \
            const unsigned a2 = last ? nA : cA + (unsigned)(t + 2) * kstep, b2 = last ? nB : cB + (unsigned)(t + 2) * kstep; \
            const unsigned a3 = a2 + kstep, b3 = b2 + kstep; \
            PG8_LDB(B0, 0, 0); PG8_LDB(B1, 0, 1); PG8_SCHED; PG8_LDA(At, 0, 0); PG8_STAGE(PG8_SA(1, 1), gA, a1 + hstepA, voffA); \
            PG8_WAIT_V(8); PG8_WAIT_L(0); PG8_BAR; PG8_MMA(0, 0, At, B0, IS8); PG8_MMA(0, 1, At, B1, IS8); PG8_BAR; PG8_SCHED; \
            PG8_LDA(At, 0, 1); PG8_STAGE(PG8_SB(0, 0), gB, b2, voffB); PG8_STAGE(PG8_SB(0, 1), gB, b2 + hstepB, voffB); PG8_STAGE(PG8_SA(0, 0), gA, a2, voffA); \
            PG8_WAIT_V(8); PG8_WAIT_L(0); PG8_BAR; PG8_MMA(1, 0, At, B0, IS8); PG8_MMA(1, 1, At, B1, IS8); PG8_BAR; PG8_SCHED; \
            PG8_LDB(B0, 1, 0); PG8_LDB(B1, 1, 1); PG8_SCHED; PG8_LDA(At, 1, 0); PG8_STAGE(PG8_SA(0, 1), gA, a2 + hstepA, voffA); \
            PG8_WAIT_V(8); PG8_WAIT_L(0); PG8_BAR; PG8_MMA(0, 0, At, B0, IS8); PG8_MMA(0, 1, At, B1, IS8); PG8_BAR; PG8_SCHED; \
            PG8_LDA(At, 1, 1); PG8_STAGE(PG8_SB(1, 0), gB, b3, voffB); PG8_STAGE(PG8_SB(1, 1), gB, b3 + hstepB, voffB); PG8_STAGE(PG8_SA(1, 0), gA, a3, voffA); \
            PG8_WAIT_V(8); PG8_WAIT_L(0); PG8_BAR; PG8_MMA(1, 0, At, B0, IS8); PG8_MMA(1, 1, At, B1, IS8); PG8_BAR; PG8_SCHED; \
        } while (0)
        if constexpr (MIXT >= 0) {
#pragma unroll 1
            for (int t = 0; t < MIXT; t += 2) PG8_KBODY(false);
#pragma unroll 1
            for (int t = MIXT; t < nt; t += 2) PG8_KBODY(true);
        } else {
#pragma unroll 1
            for (int t = 0; t < nt; t += 2) PG8_KBODY(false);
        }
#undef PG8_KBODY
        if constexpr (FP8 || MIXT >= 0) {
            asm volatile("s_nop 15" : "+v"(acc[0][0][0][0]), "+v"(acc[0][0][0][1]), "+v"(acc[0][0][1][0]), "+v"(acc[0][0][1][1]), "+v"(acc[0][0][2][0]), "+v"(acc[0][0][2][1]), "+v"(acc[0][0][3][0]), "+v"(acc[0][0][3][1]),
                                      "+v"(acc[0][1][0][0]), "+v"(acc[0][1][0][1]), "+v"(acc[0][1][1][0]), "+v"(acc[0][1][1][1]), "+v"(acc[0][1][2][0]), "+v"(acc[0][1][2][1]), "+v"(acc[0][1][3][0]), "+v"(acc[0][1][3][1]));
            asm volatile("" : "+v"(acc[1][0][0][0]), "+v"(acc[1][0][0][1]), "+v"(acc[1][0][1][0]), "+v"(acc[1][0][1][1]), "+v"(acc[1][0][2][0]), "+v"(acc[1][0][2][1]), "+v"(acc[1][0][3][0]), "+v"(acc[1][0][3][1]),
                              "+v"(acc[1][1][0][0]), "+v"(acc[1][1][0][1]), "+v"(acc[1][1][1][0]), "+v"(acc[1][1][1][1]), "+v"(acc[1][1][2][0]), "+v"(acc[1][1][2][1]), "+v"(acc[1][1][3][0]), "+v"(acc[1][1][3][1]));
        }
        if (wr == 0) PG8_BAR;
        E(acc, cur, wr, wc, fr, fq);
        if (!has_next) break;
#pragma unroll
        for (int a = 0; a < 2; ++a)
#pragma unroll
            for (int b = 0; b < 2; ++b)
#pragma unroll
                for (int m = 0; m < 4; ++m)
#pragma unroll
                    for (int n = 0; n < 2; ++n) acc[a][b][m][n] = (f32x4){0.f, 0.f, 0.f, 0.f};
        cur = nxt; cA = nA; cB = nB; ++ui;
        if (wr == 1) PG8_BAR;
    }
    PG8_WAIT_V(0);
    PG8_BAR;
#undef PG8_SA
#undef PG8_SB
#undef PG8_STAGE
#undef PG8_LDA
#undef PG8_LDB
#undef PG8_MMA
#undef PG8_CAT
#undef PG8_WAIT_V
#undef PG8_WAIT_L
#undef PG8_BAR
#undef PG8_SCHED
}
}

constexpr int D = 2048, SEQ = 16384, CTX = 256, T = SEQ + CTX, DFF = 7168, NEXP = 8;
constexpr int NWAVES = 8, NTHR = 512;
constexpr int WPOOL = 1536, WS5 = 512, PG = 384, S5G = 32, S5P = 64, S5N = 16, LC = 64, NCH = T / LC  , NCH_CTX = CTX / LC  ;
constexpr int S5ROWS = 512, S5K = 1280;
constexpr int WINO_N = 4864;
constexpr float EPS = 1e-6f;
constexpr float MOE_WSC_GU = 64.f, MOE_WSC_DN = 128.f, MOE_HSC = 4.f;

enum { I_X = 0, I_C, I_CTX, I_CCTX, I_WMOD, I_BMOD, I_NORMS, I_EWIN, I_EPOOLW, I_EPOOLS, I_LAMRE, I_LAMIM, I_LOGDT, I_BRE, I_BIM, I_CRE, I_CIM, I_S5D, I_WGLU, I_EWOUT,
       I_FFG, I_FFU, I_FFD, I_OWIN, I_GLAWA, I_GLABA, I_GLANORM, I_QNORM, I_KNORM, I_OWOUT, I_ROUTER, I_ROUTERB, I_MOEG, I_MOEU, I_MOED, N_IN };

constexpr size_t MiB = 1u << 20;
constexpr size_t al256(size_t x) { return (x + 255) / 256 * 256; }
constexpr size_t WS_CTL = 0, CTL_ZERO_BYTES = 128 * 1024;
constexpr size_t WS_MODF = 1 * MiB;
constexpr size_t WS_ROPE = WS_MODF + al256(2 * 2 * 6 * 2048 * 4);
constexpr size_t WS_W0 = 2 * MiB;
constexpr size_t SZ_WINE = (size_t)2048 * 2048 * 2, SZ_WPOOL = (size_t)4 * 512 * 384 * 2, SZ_WGLU = (size_t)512 * 512 * 2, SZ_WGU = (size_t)14336 * 2048 * 2,
                 SZ_WDN = (size_t)2048 * 7168 * 2, SZ_WINO = (size_t)WINO_N * 2048 * 2;
constexpr size_t WS_WINE = WS_W0, WS_WPOOL = WS_WINE + SZ_WINE, WS_WGLU = WS_WPOOL + SZ_WPOOL, WS_WOUTE = WS_WGLU + SZ_WGLU, WS_WGU = WS_WOUTE + SZ_WINE,
                 WS_WDN = WS_WGU + SZ_WGU, WS_WINO = WS_WDN + SZ_WDN, WS_WOUTO = WS_WINO + SZ_WINO, WS_WMGU = WS_WOUTO + SZ_WINE, WS_WMDN = WS_WMGU + 8 * SZ_WGU,
                 WS_HRES = WS_WMDN + 8 * SZ_WDN;
constexpr size_t SZ_HRES = (size_t)T * D * 4;
constexpr size_t WS_ARENA = WS_HRES + SZ_HRES;
constexpr size_t SZ_ROWB = (size_t)T * D * 2;
constexpr size_t A_U = 0, A_ZP = A_U + SZ_ROWB, SZ_ZP = (size_t)T * WPOOL * 2, A_DP = A_ZP + SZ_ZP, A_AS5 = A_DP + SZ_ZP, SZ_AS5 = (size_t)S5G * S5ROWS * S5K * 2,
                 A_SLOC = A_AS5 + SZ_AS5, SZ_SLOC = (size_t)S5G * S5ROWS * 256 * 4, A_YG = A_SLOC + SZ_SLOC, SZ_YG = (size_t)T * WS5 * 2, A_YMIX = A_YG + SZ_YG,
                 A_YO = A_YMIX + SZ_ROWB, A_V = A_YO + SZ_ROWB, A_HID = A_V + SZ_ROWB, SZ_HID = (size_t)T * DFF * 2, A_F = A_HID + SZ_HID,
                 A_M1T = A_F + SZ_ROWB, SZ_M1T = (size_t)S5G * 256 * 1024 * 2, A_K3T = A_M1T + SZ_M1T, SZ_K3T = (size_t)S5G * 1024 * S5K * 2,
                 A_TBG = A_K3T + SZ_K3T, SZ_TBG = (size_t)S5G * 2 * 64 * 256 * 4, A_L0_END = A_TBG + SZ_TBG;
constexpr size_t WS_END_L0 = WS_ARENA + A_L0_END;
constexpr int MOE_ROWS = 2 * SEQ + NEXP * 256;
constexpr int MOE_MAIN_TILES = 128, MOE_SPLIT_TILES = MOE_ROWS / 256 - 128;
static_assert((size_t)4 * MOE_SPLIT_TILES * 256 * D * 4 <= (size_t)MOE_ROWS * D * 2, "split-K partials fit in the (dead) VG region");
constexpr size_t SZ_T512 = (size_t)T * 512 * 2, SZ_T1024 = (size_t)T * 1024 * 2, SZ_T256 = (size_t)T * 256 * 2, SZ_SEQB = (size_t)SEQ * D * 2;
constexpr size_t B_GQ = A_U + SZ_ROWB, B_GK = B_GQ + SZ_T512, B_GV = B_GK + SZ_T512, B_R = B_GV + SZ_T1024, B_AQ = B_R + SZ_T1024, B_AK = B_AQ + SZ_T1024, B_AV = B_AK + SZ_T256,
                 B_ALR = B_AV + SZ_T256, B_QE = B_ALR + al256((size_t)T * 16 * 4), B_KE = B_QE + 2 * SZ_T512, B_KDT = B_KE + 2 * SZ_T512, B_VT = B_KDT + 2 * SZ_T512,
                 B_DEC = B_VT + SZ_T1024, B_ST = B_DEC + al256((size_t)2 * NCH * 4 * 128 * 4), SZ_ST = (size_t)2 * NCH * 4 * 256 * 128 * 2, B_YMIX1 = B_ST + SZ_ST,
                 B_YO1 = B_YMIX1 + SZ_SEQB, B_REGA_END = B_YO1 + SZ_SEQB;
constexpr size_t B_HID2 = 0, SZ_HID2 = (size_t)MOE_ROWS * DFF * 2, B_FS = B_HID2 + SZ_HID2, SZ_FS = (size_t)MOE_ROWS * D * 2, B_OVL_END = B_FS + SZ_FS;
constexpr size_t B_REGB = al256(B_REGA_END > B_OVL_END ? B_REGA_END : B_OVL_END);
constexpr size_t B_V1 = B_REGB, B_VG = B_V1 + SZ_SEQB, B_RE = B_VG + SZ_FS, B_RG = B_RE + (size_t)SEQ * 8, B_SLOT = B_RG + (size_t)SEQ * 8, B_CNT = B_SLOT + (size_t)SEQ * 8,
                 B_TILE = B_CNT + 256 * 8 * 4, B_L1_END = B_TILE + 4096;
constexpr size_t WS_END_L1 = WS_ARENA + B_L1_END;
constexpr size_t WS_NEED = WS_END_L0 > WS_END_L1 ? WS_END_L0 : WS_END_L1;
static_assert(WS_NEED <= (size_t)1879048192, "workspace map exceeds the guaranteed size");

constexpr int CW_TMO = 0, CW_CODE = 1, CW_BAR = 4096;

#define GAS __attribute__((address_space(1)))
#define LAS __attribute__((address_space(3)))
typedef unsigned short bf16;
typedef unsigned v4u __attribute__((ext_vector_type(4)));
typedef unsigned v2u __attribute__((ext_vector_type(2)));
typedef float f32x4 __attribute__((ext_vector_type(4)));
typedef float f32x2 __attribute__((ext_vector_type(2)));
typedef short bf16x8 __attribute__((ext_vector_type(8)));
typedef GAS unsigned gu32;
#define RLX_AGENT __ATOMIC_RELAXED, __HIP_MEMORY_SCOPE_AGENT
#define LDS_WAIT() asm volatile("s_waitcnt lgkmcnt(0)" ::: "memory")
#define VM_WAIT() asm volatile("s_waitcnt vmcnt(0)" ::: "memory")
__device__ __forceinline__ unsigned f2bf(float f) { unsigned u = __builtin_bit_cast(unsigned, f); return (u + 0x7fffu + ((u >> 16) & 1u)) >> 16; }
typedef __bf16 bf16x2_t __attribute__((ext_vector_type(2)));
__device__ __forceinline__ unsigned pk2(float lo, float hi) { const f32x2 v = {lo, hi}; return __builtin_bit_cast(unsigned, __builtin_convertvector(v, bf16x2_t)); }
__device__ __forceinline__ float bflo(unsigned w) { return __builtin_bit_cast(float, w << 16); }
__device__ __forceinline__ float bfhi(unsigned w) { return __builtin_bit_cast(float, w & 0xffff0000u); }
__device__ __forceinline__ float bf2f(bf16 b) { return __builtin_bit_cast(float, (unsigned)b << 16); }
__device__ __forceinline__ float sigmoidf_(float x) { return __builtin_amdgcn_rcpf(1.f + __expf(-x)); }
__device__ __forceinline__ float siluf_(float x) { return x * __builtin_amdgcn_rcpf(1.f + __expf(-x)); }
__device__ __forceinline__ float swiglu_fast(float ag, float au, float negsg_log2e, float kk) { const float e = __builtin_amdgcn_exp2f(ag * negsg_log2e); return (ag * au) * (kk * __builtin_amdgcn_rcpf(1.f + e)); }
__device__ __forceinline__ float gelu_tanh(float y) { const float z = 0.7978845608028654f * (y + 0.044715f * y * y * y); const float e = __expf(2.f * z); const float th = 1.f - 2.f * __builtin_amdgcn_rcpf(e + 1.f); return 0.5f * y * (1.f + th); }

#define XB_TMO      128
#define XB_XCNT(j)  (256  + 64 * (j))
#define XB_XSUB(j)  (1280 + 64 * (j))
#define XB_XGEN(j)  (2304 + 64 * (j))
#define XB_TOP      3328
#define XB_TOPGEN   3392
#define XCD_BAR_WORDS 3456
#define XB_SPIN_CAP (1u << 22)
__device__ __forceinline__ unsigned xb_ld(unsigned* p)              { return __hip_atomic_load(p, __ATOMIC_RELAXED, __HIP_MEMORY_SCOPE_AGENT); }
__device__ __forceinline__ unsigned xb_add(unsigned* p, unsigned v) { return __hip_atomic_fetch_add(p, v, __ATOMIC_RELAXED, __HIP_MEMORY_SCOPE_AGENT); }
__device__ __forceinline__ unsigned xb_xcc_id() { return (unsigned)__builtin_amdgcn_s_getreg((3 << 11) | 20) & 0xFu; }
#define XB_SPIN(cond, bar) do { unsigned _sp = 0; while (cond) { __builtin_amdgcn_s_sleep(1); \
    if ((++_sp & 255u) == 0u) { if (xb_ld(&(bar)[XB_TMO])) break; if (_sp > XB_SPIN_CAP) { atomicAdd(&(bar)[XB_TMO], 1u); break; } } } } while (0)
struct XcdBarrier { unsigned* bar; unsigned x; volatile LAS unsigned* st; };
__device__ __forceinline__ XcdBarrier xcd_barrier_post(unsigned* bar, volatile LAS unsigned* st) {
    XcdBarrier b; b.bar = bar; b.x = xb_xcc_id(); b.st = st;
    if (threadIdx.x == 0) (void)xb_add(&bar[XB_XCNT(b.x)], 1u);
    return b;
}
__device__ __forceinline__ void xcd_barrier_complete(unsigned* bar, unsigned x, unsigned& nloc, unsigned& nx) {
    const unsigned G = gridDim.x * gridDim.y * gridDim.z;
    unsigned sum, cnt, mine, sp = 0u;
    for (;;) {
        sum = 0u; cnt = 0u; mine = 0u;
#pragma unroll
        for (unsigned j = 0; j < 16; ++j) { const unsigned c = xb_ld(&bar[XB_XCNT(j)]); sum += c; cnt += (c > 0u) ? 1u : 0u; mine = (j == x) ? c : mine; }
        if (sum == G) break;
        __builtin_amdgcn_s_sleep(1);
        if ((++sp & 255u) == 0u) { if (xb_ld(&bar[XB_TMO])) break; if (sp > XB_SPIN_CAP) { atomicAdd(&bar[XB_TMO], 1u); break; } }
    }
    nloc = mine > 0u ? mine : 1u; nx = cnt > 0u ? cnt : 1u;
}
__device__ __forceinline__ void xcd_barrier(const XcdBarrier& b) {
    asm volatile("s_waitcnt vmcnt(0)" ::: "memory");
    __syncthreads();
    if (threadIdx.x == 0) {
        unsigned* bar = b.bar;
        __builtin_amdgcn_s_waitcnt(0);
        unsigned nloc = b.st[0], nx = b.st[1];
        if (nloc == 0u) { xcd_barrier_complete(bar, b.x, nloc, nx); b.st[0] = nloc; b.st[1] = nx; }
        const unsigned old = xb_add(&bar[XB_XSUB(b.x)], 1u);
        const unsigned gen = old / nloc;
        if (old + 1u == (gen + 1u) * nloc) {
            __builtin_amdgcn_fence(__ATOMIC_RELEASE, "agent");
            asm volatile("s_waitcnt vmcnt(0)" ::: "memory");
            const unsigned og = xb_add(&bar[XB_TOP], 1u);
            const unsigned tg = og / nx;
            if (og + 1u == (tg + 1u) * nx) xb_add(&bar[XB_TOPGEN], 1u);
            else XB_SPIN(xb_ld(&bar[XB_TOPGEN]) == tg, bar);
            __builtin_amdgcn_fence(__ATOMIC_ACQUIRE, "agent");
            xb_add(&bar[XB_XGEN(b.x)], 1u);
            asm volatile("s_waitcnt vmcnt(0)" ::: "memory");
        } else {
            XB_SPIN(xb_ld(&bar[XB_XGEN(b.x)]) == gen, bar);
            __builtin_amdgcn_fence(__ATOMIC_ACQUIRE, "agent");
            asm volatile("s_waitcnt vmcnt(0)" ::: "memory");
        }
    }
    __syncthreads();
}

constexpr int RING_OFF = 0, RING_BYTES = 131072;
constexpr int LDSCTL_OFF = RING_BYTES, MISC_OFF = LDSCTL_OFF + 320;
constexpr int LDS_BYTES = 147456;

#define CAS __attribute__((address_space(4)))
__device__ __forceinline__ const float* inp(int k) { const CAS char* ka = (const CAS char*)__builtin_amdgcn_kernarg_segment_ptr(); return *(const float* const CAS*)(ka + 8 * k); }
__device__ __forceinline__ float* karg_out() { const CAS char* ka = (const CAS char*)__builtin_amdgcn_kernarg_segment_ptr(); return *(float* const CAS*)(ka + 8 * 35); }
__device__ __forceinline__ unsigned char* karg_ws() { const CAS char* ka = (const CAS char*)__builtin_amdgcn_kernarg_segment_ptr(); return *(unsigned char* const CAS*)(ka + 8 * 36); }
__device__ __forceinline__ int karg_i(int k) { const CAS char* ka = (const CAS char*)__builtin_amdgcn_kernarg_segment_ptr(); return *(const CAS int*)(ka + 8 * 37 + 4 * k); }
struct Frame {
    LAS unsigned char* lds;
    volatile LAS unsigned* MISC;
    gu32* ctl;
    int tid, lane, wave, vcu, G;
    unsigned char* ws;
};
__device__ __forceinline__ float wave_sum(float v) {
#pragma unroll
    for (int o = 1; o < 64; o <<= 1) v += __shfl_xor(v, o);
    return v;
}

struct RmIdent { int off; __device__ __forceinline__ int operator()(int n) const { return n + off; } };
struct RmGateUp { int which; __device__ __forceinline__ int operator()(int n) const { return (n >> 7) * 256 + which * 128 + (n & 127); } };
struct RmWinO { __device__ __forceinline__ int operator()(int n) const {
    if (n < 2048) return n; if (n < 2064) return 4608 + (n - 2048); return n - 16; } };
template <class RM> __device__ __forceinline__ void tr_item(const float* W, int K, int N, bf16* WT, int ldt, const RM rm, LAS float* scr, int item, int lane) {
    const int nblk = (N + 31) / 32, kb = item / nblk, nb = item - kb * nblk, k0 = 64 * kb, n0 = 32 * nb;
    const int c4 = (lane & 7) * 4, r8 = lane >> 3; const bool okc = (n0 + c4) < N;
    f32x4 v[8];
#pragma unroll
    for (int i = 0; i < 8; ++i) v[i] = okc ? *(const GAS f32x4*)(W + (size_t)(k0 + 8 * i + r8) * N + n0 + c4) : (f32x4){0.f, 0.f, 0.f, 0.f};
#pragma unroll
    for (int i = 0; i < 8; ++i) { LAS float* s = scr + (8 * i + r8) * 33 + c4; s[0] = v[i][0]; s[1] = v[i][1]; s[2] = v[i][2]; s[3] = v[i][3]; }
    LDS_WAIT(); asm volatile("" ::: "memory");
    const int c = lane & 7;
#pragma unroll
    for (int j = 0; j < 4; ++j) { const int n = (lane >> 3) + 8 * j; const LAS float* s = scr + (8 * c) * 33 + n;
        v4u o; o.x = pk2(s[0 * 33], s[1 * 33]); o.y = pk2(s[2 * 33], s[3 * 33]); o.z = pk2(s[4 * 33], s[5 * 33]); o.w = pk2(s[6 * 33], s[7 * 33]);
        if (n0 + n < N) *(GAS v4u*)(WT + (size_t)rm(n0 + n) * ldt + k0 + 8 * c) = o; }
    LDS_WAIT(); asm volatile("" ::: "memory");
}
__device__ __forceinline__ void zero_rows(bf16* p, size_t nbytes, int gt, int ngt) {
    for (size_t i = (size_t)gt; i < nbytes / 16; i += (size_t)ngt) ((GAS v4u*)p)[i] = (v4u){0u, 0u, 0u, 0u};
}
__device__ __forceinline__ unsigned pk4_fp8(float a, float b, float c, float d) { int w = 0; w = __builtin_amdgcn_cvt_pk_fp8_f32(a, b, w, false); w = __builtin_amdgcn_cvt_pk_fp8_f32(c, d, w, true); return (unsigned)w; }
template <class RM> __device__ __forceinline__ void tr_item8(const float* W, int K, int N, unsigned char* WT, int ldt, const RM rm, float sc, LAS float* scr, int item, int lane) {
    const int nblk = (N + 31) / 32, kb = item / nblk, nb = item - kb * nblk, k0 = 64 * kb, n0 = 32 * nb;
    const int c4 = (lane & 7) * 4, r8 = lane >> 3; const bool okc = (n0 + c4) < N;
    f32x4 v[8];
#pragma unroll
    for (int i = 0; i < 8; ++i) v[i] = okc ? *(const GAS f32x4*)(W + (size_t)(k0 + 8 * i + r8) * N + n0 + c4) : (f32x4){0.f, 0.f, 0.f, 0.f};
#pragma unroll
    for (int i = 0; i < 8; ++i) { LAS float* s = scr + (8 * i + r8) * 33 + c4; s[0] = v[i][0]; s[1] = v[i][1]; s[2] = v[i][2]; s[3] = v[i][3]; }
    LDS_WAIT(); asm volatile("" ::: "memory");
    const int c = lane & 7;
#pragma unroll
    for (int j = 0; j < 4; ++j) { const int n = (lane >> 3) + 8 * j; const LAS float* s = scr + (8 * c) * 33 + n;
        v2u o; o.x = pk4_fp8(s[0 * 33] * sc, s[1 * 33] * sc, s[2 * 33] * sc, s[3 * 33] * sc); o.y = pk4_fp8(s[4 * 33] * sc, s[5 * 33] * sc, s[6 * 33] * sc, s[7 * 33] * sc);
        if (n0 + n < N) *(GAS v2u*)(WT + (size_t)rm(n0 + n) * ldt + k0 + 8 * c) = o; }
    LDS_WAIT(); asm volatile("" ::: "memory");
}
constexpr int items_of(int K, int N) { return (K / 64) * ((N + 31) / 32); }

__device__ __forceinline__ void s5_small_tables(Frame& F, int g) {
    const float* lam_re = inp(I_LAMRE); const float* lam_im = inp(I_LAMIM); const float* log_dt = inp(I_LOGDT);
    const float* b_re = inp(I_BRE); const float* b_im = inp(I_BIM); const float* c_re = inp(I_CRE); const float* c_im = inp(I_CIM);
    LAS f32x2* APOW = (LAS f32x2*)(F.lds); LAS f32x2* BB = (LAS f32x2*)(F.lds + 2 * 64 * 65 * 8); LAS f32x2* CC = BB + 2 * 64 * 16;
    const int tid = F.tid;
    __syncthreads();
    if (tid < 128) {
        const int dir = tid >> 6, p = tid & 63; const int gi = (dir * S5G + g);
        const double dt = exp((double)log_dt[gi]); const double lr = (double)lam_re[gi * 64 + p], li = (double)lam_im[gi * 64 + p];
        const double mag = exp(lr * dt), ar = mag * cos(li * dt), ai = mag * sin(li * dt);
        double pr = 1.0, pi = 0.0;
        for (int k = 0; k <= 64; ++k) { APOW[(dir * 64 + p) * 65 + k] = (f32x2){(float)pr, (float)pi}; const double nr = pr * ar - pi * ai, ni = pr * ai + pi * ar; pr = nr; pi = ni; }
        const double den = lr * lr + li * li, nr = ar - 1.0, ni = ai;
        const double kr = (nr * lr + ni * li) / den, ki = (ni * lr - nr * li) / den;
        for (int n = 0; n < 16; ++n) { const double br = (double)b_re[(gi * 64 + p) * 16 + n], bi = (double)b_im[(gi * 64 + p) * 16 + n];
            BB[(dir * 64 + p) * 16 + n] = (f32x2){(float)(kr * br - ki * bi), (float)(kr * bi + ki * br)}; }
    }
    for (int i = tid; i < 2 * 16 * 64; i += NTHR) { const int dir = i >> 10, r = i & 1023; CC[i] = (f32x2){c_re[(size_t)(dir * S5G + g) * 1024 + r], c_im[(size_t)(dir * S5G + g) * 1024 + r]}; }
    __syncthreads();
}
__device__ __forceinline__ void s5_stage_a(Frame& F, int g, int part) {
    LAS f32x2* APOW = (LAS f32x2*)(F.lds); LAS f32x2* BB = (LAS f32x2*)(F.lds + 2 * 64 * 65 * 8); LAS f32x2* CC = BB + 2 * 64 * 16;
    float* TBG = (float*)(F.ws + WS_ARENA + A_TBG) + (size_t)g * (2 * 64 * 256);
    bf16* M1T = (bf16*)(F.ws + WS_ARENA + A_M1T) + (size_t)g * 256 * 1024;
    const int tid = F.tid;
    for (int i0 = tid; i0 < 2 * 8 * 256; i0 += NTHR) {
        const int dir = i0 >> 11, dl = 8 * part + ((i0 >> 8) & 7), np = (i0 >> 4) & 15, n = i0 & 15; float s = 0.f;
        for (int p = 0; p < 64; ++p) { const f32x2 c = CC[(dir * 16 + np) * 64 + p], a = APOW[(dir * 64 + p) * 65 + dl], b = BB[(dir * 64 + p) * 16 + n];
            const float zr = c.x * a.x - c.y * a.y, zi = c.x * a.y + c.y * a.x; s += zr * b.x - zi * b.y; }
        TBG[((dir * 64 + dl) * 16 + np) * 16 + n] = s;
    }
    for (int i = tid; i < 32 * 128; i += NTHR) {
        const int j = 32 * part + (i >> 7), c8 = (i & 127) * 8, sI = c8 >> 4, n0 = c8 & 15, dir = j >> 7, pt = (j >> 6) & 1, p = j & 63, e = dir ? sI : 63 - sI;
        const f32x2 a = APOW[(dir * 64 + p) * 65 + e]; float v[8];
#pragma unroll
        for (int q = 0; q < 8; ++q) { const f32x2 b = BB[(dir * 64 + p) * 16 + n0 + q]; v[q] = pt ? (a.x * b.y + a.y * b.x) : (a.x * b.x - a.y * b.y); }
        v4u o; o.x = pk2(v[0], v[1]); o.y = pk2(v[2], v[3]); o.z = pk2(v[4], v[5]); o.w = pk2(v[6], v[7]);
        *(GAS v4u*)(M1T + (size_t)j * 1024 + c8) = o;
    }
}
__device__ __forceinline__ void s5_stage_b(Frame& F, int g, int part) {
    LAS f32x2* APOW = (LAS f32x2*)(F.lds); LAS f32x2* CC = (LAS f32x2*)(F.lds + 2 * 64 * 65 * 8) + 2 * 64 * 16;
    const float* TBG = (const float*)(F.ws + WS_ARENA + A_TBG) + (size_t)g * (2 * 64 * 256);
    bf16* K3T = (bf16*)(F.ws + WS_ARENA + A_K3T) + (size_t)g * 1024 * S5K;
#pragma unroll 4
    for (int i = F.tid; i < 128 * (S5K / 8); i += NTHR) {
        const int row = 128 * part + i / (S5K / 8), c8 = (i % (S5K / 8)) * 8, tau = row >> 4, np = row & 15; float v[8];
        if (c8 < 1024) { const int sI = c8 >> 4, n0 = c8 & 15;
            f32x4 f0 = {0.f, 0.f, 0.f, 0.f}, f1 = f0, b0 = f0, b1 = f0;
            if (sI <= tau) { const GAS f32x4* tb = (const GAS f32x4*)(TBG + ((0 * 64 + (tau - sI)) * 16 + np) * 16 + n0); f0 = tb[0]; f1 = tb[1]; }
            if (sI >= tau) { const GAS f32x4* tb = (const GAS f32x4*)(TBG + ((1 * 64 + (sI - tau)) * 16 + np) * 16 + n0); b0 = tb[0]; b1 = tb[1]; }
            f0 += b0; f1 += b1; v[0] = f0[0]; v[1] = f0[1]; v[2] = f0[2]; v[3] = f0[3]; v[4] = f1[0]; v[5] = f1[1]; v[6] = f1[2]; v[7] = f1[3];
        } else { const int j0 = c8 - 1024, dir = j0 >> 7, pt = (j0 >> 6) & 1, e = dir ? 64 - tau : tau + 1;
#pragma unroll
            for (int q = 0; q < 8; ++q) { const int p = (j0 & 63) + q; const f32x2 c = CC[(dir * 16 + np) * 64 + p], a = APOW[(dir * 64 + p) * 65 + e];
                v[q] = pt ? -(c.x * a.y + c.y * a.x) : (c.x * a.x - c.y * a.y); } }
        v4u o; o.x = pk2(v[0], v[1]); o.y = pk2(v[2], v[3]); o.z = pk2(v[4], v[5]); o.w = pk2(v[6], v[7]);
        *(GAS v4u*)(K3T + (size_t)row * S5K + c8) = o;
    }
}

__device__ __forceinline__ void mod_item(Frame& F, int item) {
    const int l = item >> 7, slab = item & 127, col0 = 96 * slab;
    const float* wm = inp(I_WMOD) + (size_t)l * 2048 * 12288; const float* bm = inp(I_BMOD) + (size_t)l * 12288;
    LAS float* sv = (LAS float*)F.lds;
    LAS float* part = sv + 4096;
    __syncthreads();
    for (int i = F.tid; i < 4096; i += NTHR) { const float x = (i < 2048) ? inp(I_C)[i] : inp(I_CCTX)[i - 2048]; sv[i] = siluf_(x); }
    __syncthreads();
    const int sub = F.lane / 24, cl = F.lane % 24;
    f32x4 a0 = {0.f, 0.f, 0.f, 0.f}, a1 = {0.f, 0.f, 0.f, 0.f};
    if (sub < 2) {
        const float* wp = wm + (size_t)(256 * F.wave + sub) * 12288 + col0 + 4 * cl;
#pragma unroll 8
        for (int kk = 0; kk < 256; kk += 2) { const f32x4 w = *(const GAS f32x4*)(wp + (size_t)kk * 12288); const int k = 256 * F.wave + kk + sub;
            const float s0 = sv[k], s1 = sv[2048 + k]; a0 += w * s0; a1 += w * s1; }
        LAS float* pp = part + ((F.wave * 2 + sub) * 24 + cl) * 8;
        pp[0] = a0[0]; pp[1] = a0[1]; pp[2] = a0[2]; pp[3] = a0[3]; pp[4] = a1[0]; pp[5] = a1[1]; pp[6] = a1[2]; pp[7] = a1[3];
    }
    __syncthreads();
    if (F.tid < 192) { const int w = F.tid / 96, c = F.tid % 96; float s = 0.f;
        for (int q = 0; q < 16; ++q) s += part[(q * 24 + (c >> 2)) * 8 + w * 4 + (c & 3)];
        float* MODF = (float*)(F.ws + WS_MODF); MODF[(size_t)(l * 2 + w) * 12288 + col0 + c] = s + bm[col0 + c]; }
    __syncthreads();
}

constexpr int units_of(int K, int N) { return (K / 128) * ((N + 255) / 256); }
constexpr int CU_SQ = units_of(2048, 2048), CU_PW = units_of(384, 384), CU_GL = units_of(512, 512), CU_UP = units_of(2048, 7168), CU_DN = units_of(7168, 2048), CU_WO = units_of(2048, 4624);
constexpr int CQ_E0 = 0, CQ_E1 = CQ_E0 + CU_SQ  , CQ_E2 = CQ_E1 + 4 * CU_PW  , CQ_E3 = CQ_E2 + CU_GL  , CQ_E4 = CQ_E3 + CU_SQ  ,
              CQ_F1 = CQ_E4 + CU_UP  , CQ_F2 = CQ_F1 + CU_UP  , CQ_F3 = CQ_F2 + CU_DN  , CQ_O1 = CQ_F3 + CU_WO  , CQ_O2 = CQ_O1 + CU_SQ  ,
              CQ_M1 = CQ_O2 + 8 * CU_UP  , CQ_M2 = CQ_M1 + 8 * CU_UP  , CQ_M3 = CQ_M2 + 8 * CU_DN  , CQ_END = CQ_M3;
constexpr int CW_QUEUE = 2048;
struct ConvDesc { const float* W; unsigned char* WT; int N, ldt, kind, fp8, k0, n0, pitch, kbyte; float sc; };
__device__ __forceinline__ void conv_decode(Frame& F, int it, ConvDesc& d) {
    int r = it; d.kind = 0; d.fp8 = 0; d.sc = 1.f;
    if (r < CQ_E1) { d.W = inp(I_EWIN); d.WT = F.ws + WS_WINE; d.N = 2048; d.ldt = 2048; }
    else if (r < CQ_E2) { r -= CQ_E1; const int g4 = r / CU_PW; d.W = inp(I_EPOOLW) + (size_t)g4 * 384 * 384; d.WT = F.ws + WS_WPOOL + (size_t)g4 * 512 * 384 * 2; d.N = 384; d.ldt = 384; r -= g4 * CU_PW; }
    else if (r < CQ_E3) { d.W = inp(I_WGLU); d.WT = F.ws + WS_WGLU; d.N = 512; d.ldt = 512; r -= CQ_E2; }
    else if (r < CQ_E4) { d.W = inp(I_EWOUT); d.WT = F.ws + WS_WOUTE; d.N = 2048; d.ldt = 2048; r -= CQ_E3; }
    else if (r < CQ_F2) { const int up = r >= CQ_F1; d.W = inp(up ? I_FFU : I_FFG); d.WT = F.ws + WS_WGU; d.N = 7168; d.ldt = 2048; d.kind = 1 + up; r -= (up ? CQ_F1 : CQ_E4);
        if (FFN_FP8 == 1) { d.fp8 = 1; d.sc = MOE_WSC_GU; } }
    else if (r < CQ_F3) { d.W = inp(I_FFD); d.WT = F.ws + WS_WDN; d.N = 2048; d.ldt = 7168; r -= CQ_F2; if (FFN_FP8 != 0) { d.fp8 = 1; d.sc = MOE_WSC_DN; } }
    else if (r < CQ_O1) { d.W = inp(I_OWIN); d.WT = F.ws + WS_WINO; d.N = 4624; d.ldt = 2048; d.kind = 3; r -= CQ_F3; }
    else if (r < CQ_O2) { d.W = inp(I_OWOUT); d.WT = F.ws + WS_WOUTO; d.N = 2048; d.ldt = 2048; r -= CQ_O1; }
    else if (r < CQ_M2) { d.fp8 = 1; const int up = r >= CQ_M1; r -= up ? CQ_M1 : CQ_O2; const int e = r / CU_UP; d.W = inp(up ? I_MOEU : I_MOEG) + (size_t)e * 2048 * 7168; d.WT = F.ws + WS_WMGU + (size_t)e * 14336 * 2048;
        d.N = 7168; d.ldt = 2048; d.kind = 1 + up; d.sc = MOE_WSC_GU; r -= e * CU_UP; }
    else { d.fp8 = 1; r -= CQ_M2; const int e = r / CU_DN; d.W = inp(I_MOED) + (size_t)e * 7168 * 2048; d.WT = F.ws + WS_WMDN + (size_t)e * 2048 * 7168; d.N = 2048; d.ldt = 7168; d.sc = MOE_WSC_DN; r -= e * CU_DN; }
    const int nblk = (d.N + 255) / 256, kb = r / nblk; d.k0 = 128 * kb; d.n0 = 256 * (r - kb * nblk);
    d.pitch = d.fp8 ? d.ldt : 2 * d.ldt; d.kbyte = d.fp8 ? d.k0 : 2 * d.k0;
    if (FFN_FP8 == 2 && FFNU_K1 < 2048 && it >= CQ_E4 && it < CQ_F2) {
        d.pitch = 2 * FFNU_K1 + (2048 - FFNU_K1);
        if (d.k0 >= FFNU_K1) { d.fp8 = 1; d.sc = MOE_WSC_GU; d.kbyte = 2 * FFNU_K1 + (d.k0 - FFNU_K1); } }
}
__device__ __forceinline__ int conv_row(int kind, int n) {
    if (kind == 0) return n; if (kind == 3) return RmWinO{}(n); return (n >> 7) * 256 + (kind - 1) * 128 + (n & 127); }
__device__ __forceinline__ void conv_load(const ConvDesc& d, int wave, int lane, f32x4 (&v)[16]) {
    const bool okc = (d.n0 + 4 * lane) < d.N; const float* p = d.W + (size_t)(d.k0 + 16 * wave) * d.N + d.n0 + 4 * lane;
#pragma unroll
    for (int i = 0; i < 16; ++i) v[i] = okc ? __builtin_nontemporal_load((const GAS f32x4*)(p + (size_t)i * d.N)) : (f32x4){0.f, 0.f, 0.f, 0.f};
}
__device__ __forceinline__ void conv_to_lds(const f32x4 (&v)[16], LAS float* tile, int wave, int lane) {
#pragma unroll
    for (int i = 0; i < 16; ++i) *(LAS f32x4*)(tile + (16 * wave + i) * 256 + ((lane ^ ((2 * wave + (i >> 3)) & 7)) << 2)) = v[i];
}
__device__ __forceinline__ void conv_store(const ConvDesc& d, const LAS float* tile, int tid) {
    const int c = tid & 7;
    if (d.fp8) {
#pragma unroll
        for (int q = 0; q < 4; ++q) { const int nn = (tid >> 3) + 64 * q; float x[16];
#pragma unroll
            for (int j = 0; j < 16; ++j) { const int k = 16 * c + j; x[j] = tile[k * 256 + ((((nn >> 2) ^ ((k >> 3) & 7)) & 63) << 2) + (nn & 3)]; }
            if (d.n0 + nn < d.N) { const size_t row = (size_t)conv_row(d.kind, d.n0 + nn); v4u o;
                o.x = pk4_fp8(x[0] * d.sc, x[1] * d.sc, x[2] * d.sc, x[3] * d.sc); o.y = pk4_fp8(x[4] * d.sc, x[5] * d.sc, x[6] * d.sc, x[7] * d.sc);
                o.z = pk4_fp8(x[8] * d.sc, x[9] * d.sc, x[10] * d.sc, x[11] * d.sc); o.w = pk4_fp8(x[12] * d.sc, x[13] * d.sc, x[14] * d.sc, x[15] * d.sc);
                __builtin_nontemporal_store(o, (GAS v4u*)(d.WT + row * d.pitch + d.kbyte + 16 * c)); } }
    } else {
#pragma unroll
        for (int q = 0; q < 8; ++q) { const int kh = q & 1, nn = (tid >> 3) + 64 * (q >> 1); const LAS float* s = tile + (64 * kh + 8 * c) * 256 + (((nn >> 2) ^ c) << 2) + (nn & 3);
            float x[8];
#pragma unroll
            for (int j = 0; j < 8; ++j) x[j] = s[j * 256];
            if (d.n0 + nn < d.N) { const size_t row = (size_t)conv_row(d.kind, d.n0 + nn);
                v4u o; o.x = pk2(x[0], x[1]); o.y = pk2(x[2], x[3]); o.z = pk2(x[4], x[5]); o.w = pk2(x[6], x[7]);
                __builtin_nontemporal_store(o, (GAS v4u*)(d.WT + row * d.pitch + d.kbyte + (64 * kh + 8 * c) * 2)); } }
    }
}
constexpr int CQ_NONE = 0x7fffffff;
__device__ __forceinline__ int conv_pull(Frame& F) { return (int)__hip_atomic_fetch_add((unsigned*)(F.ctl + CW_QUEUE), 1u, RLX_AGENT); }
__device__ __forceinline__ void conv_work(Frame& F, int dlimit, int quota) {
    LAS float* tile = (LAS float*)(F.lds + RING_OFF);
    volatile LAS int* QW = (volatile LAS int*)(F.lds + LDSCTL_OFF);
    __syncthreads();
    if (F.tid == 0) { int c0 = CQ_NONE, c1 = CQ_NONE; const int head = (int)__hip_atomic_load((unsigned*)(F.ctl + CW_QUEUE), RLX_AGENT);
        if (head < CQ_END && (quota > 0 || head < dlimit)) { c0 = conv_pull(F); if (c0 < CQ_END && (quota > 1 || c0 < dlimit)) c1 = conv_pull(F); }
        QW[0] = c0; QW[1] = c1; }
    __syncthreads();
    int cur = __builtin_amdgcn_readfirstlane(QW[0]), nxt = __builtin_amdgcn_readfirstlane(QW[1]);
    int npull = (cur != CQ_NONE) + (nxt != CQ_NONE);
    __syncthreads();
    if (cur >= CQ_END) return;
    ConvDesc d; f32x4 v[16]; conv_decode(F, cur, d); conv_load(d, F.wave, F.lane, v);
    for (;;) {
        conv_to_lds(v, tile, F.wave, F.lane); LDS_WAIT(); __syncthreads();
        const bool more = nxt < CQ_END; ConvDesc dn = d;
        if (more) { conv_decode(F, nxt, dn); conv_load(dn, F.wave, F.lane, v); }
        const bool pull = more && (npull < quota || nxt < dlimit);
        conv_store(d, tile, F.tid);
        if (pull && F.tid == 0) QW[0] = conv_pull(F);
        LDS_WAIT(); __syncthreads();
        if (!more) break;
        cur = nxt; nxt = pull ? __builtin_amdgcn_readfirstlane(QW[0]) : CQ_NONE; npull += pull ? 1 : 0; d = dn;
    }
}
__device__ __forceinline__ int fill_quota(int nunits, int G, int c, int Q) { const int mine = nunits > c ? (nunits - 1 - c) / G + 1 : 0, most = (nunits + G - 1) / G; return mine < most ? Q : 0; }
__device__ __forceinline__ void p0_prologue(Frame& F) {
    const int gw = F.vcu * NWAVES + F.wave, NGW = F.G * NWAVES, gt = gw * 64 + F.lane, ngt = NGW * 64;
    for (int it = blockIdx.x; it < 256; it += F.G) mod_item(F, it);
    for (int it = blockIdx.x; it < S5G * 8; it += F.G) { s5_small_tables(F, it >> 3); s5_stage_a(F, it >> 3, it & 7); }
    { float* rp = (float*)(F.ws + WS_ROPE); for (int i = gt; i < 256 * 32; i += ngt) { const int pos = i >> 5, fi = i & 31; const float fr = powf(10000.f, -(float)fi / 32.f), ang = (float)pos * fr;
        rp[2 * i] = cosf(ang); rp[2 * i + 1] = sinf(ang); } }
    for (int g4 = 0; g4 < 4; ++g4) zero_rows((bf16*)(F.ws + WS_WPOOL) + ((size_t)g4 * 512 + 384) * 384, (size_t)128 * 384 * 2, gt, ngt);
    zero_rows((bf16*)(F.ws + WS_WINO) + (size_t)4624 * 2048, (size_t)(WINO_N - 4624) * 2048 * 2, gt, ngt);
    __syncthreads();
    conv_work(F, CQ_E4, 0);
    __syncthreads();
}

#define PV(k) ((LAS float*)(F.lds + (k) * 8192))
__device__ __forceinline__ void ld_row_f32(const float* p, int lane, f32x4 (&v)[8]) {
#pragma unroll
    for (int j = 0; j < 8; ++j) v[j] = *(const GAS f32x4*)(p + 4 * lane + 256 * j);
}
__device__ __forceinline__ void st_row_f32(float* p, int lane, const f32x4 (&v)[8]) {
#pragma unroll
    for (int j = 0; j < 8; ++j) *(GAS f32x4*)(p + 4 * lane + 256 * j) = v[j];
}
__device__ __forceinline__ void ld_row_bf16(const bf16* p, int lane, f32x4 (&v)[8]) {
#pragma unroll
    for (int j = 0; j < 8; ++j) { const v2u w = *(const GAS v2u*)(p + 4 * lane + 256 * j); v[j] = (f32x4){bflo(w.x), bfhi(w.x), bflo(w.y), bfhi(w.y)}; }
}
__device__ __forceinline__ void st_row_bf16(bf16* p, int lane, const f32x4 (&v)[8]) {
#pragma unroll
    for (int j = 0; j < 8; ++j) { v2u w; w.x = pk2(v[j][0], v[j][1]); w.y = pk2(v[j][2], v[j][3]); *(GAS v2u*)(p + 4 * lane + 256 * j) = w; }
}
__device__ __forceinline__ float row_sumsq(const f32x4 (&v)[8]) {
    float s = 0.f;
#pragma unroll
    for (int j = 0; j < 8; ++j) s += (v[j][0] * v[j][0] + v[j][1] * v[j][1]) + (v[j][2] * v[j][2] + v[j][3] * v[j][3]);
    return wave_sum(s);
}
__device__ __forceinline__ f32x4 ldp(const LAS float* p, int lane, int j) { return *(const LAS f32x4*)(p + 4 * lane + 256 * j); }
__device__ __forceinline__ const float* modp(Frame& F, int layer, int w, int k) { return (const float*)(F.ws + WS_MODF) + (size_t)(layer * 2 + w) * 12288 + k * 2048; }
__device__ __forceinline__ const float* h0_row(Frame& F, int m) { return m < CTX ? inp(I_CTX) + (size_t)m * D : inp(I_X) + (size_t)(m - CTX) * D; }

__device__ __forceinline__ void ph_norm0(Frame& F) {
    __syncthreads();
    for (int i = F.tid; i < 2 * 2048; i += NTHR) { const int w = i >> 11, c = i & 2047;
        PV(2 * w)[c] = inp(I_NORMS)[0 * 2048 + c] * (1.f + modp(F, 0, w, 1)[c]); PV(2 * w + 1)[c] = modp(F, 0, w, 0)[c]; }
    __syncthreads();
    bf16* U = (bf16*)(F.ws + WS_ARENA + A_U);
    const int gw = F.vcu * NWAVES + F.wave, NGW = F.G * NWAVES;
    for (int m = gw; m < T; m += NGW) { const int w = m < CTX ? 1 : 0; f32x4 v[8]; ld_row_f32(h0_row(F, m), F.lane, v);
        const float rstd = 1.f / sqrtf(row_sumsq(v) * (1.f / D) + EPS);
#pragma unroll
        for (int j = 0; j < 8; ++j) v[j] = v[j] * rstd * ldp(PV(2 * w), F.lane, j) + ldp(PV(2 * w + 1), F.lane, j);
        st_row_bf16(U + (size_t)m * D, F.lane, v); }
}
__device__ __forceinline__ void ph_norm1(Frame& F) {
    __syncthreads();
    for (int i = F.tid; i < 2 * 2048; i += NTHR) { const int w = i >> 11, c = i & 2047;
        PV(3 * w)[c] = modp(F, 0, w, 2)[c] * inp(I_NORMS)[1 * 2048 + c]; PV(3 * w + 1)[c] = inp(I_NORMS)[2 * 2048 + c] * (1.f + modp(F, 0, w, 4)[c]); PV(3 * w + 2)[c] = modp(F, 0, w, 3)[c]; }
    __syncthreads();
    const bf16* YO = (const bf16*)(F.ws + WS_ARENA + A_YO); bf16* V = (bf16*)(F.ws + WS_ARENA + A_V); bf16* HR = (bf16*)(F.ws + WS_HRES);
    const int gw = F.vcu * NWAVES + F.wave, NGW = F.G * NWAVES;
    for (int m = gw; m < T; m += NGW) { const int w = m < CTX ? 1 : 0; f32x4 y[8], h[8]; ld_row_bf16(YO + (size_t)m * D, F.lane, y); ld_row_f32(h0_row(F, m), F.lane, h);
        const float ry = 1.f / sqrtf(row_sumsq(y) * (1.f / D) + EPS);
#pragma unroll
        for (int j = 0; j < 8; ++j) h[j] = h[j] + y[j] * ry * ldp(PV(3 * w), F.lane, j);
        st_row_bf16(HR + (size_t)m * D, F.lane, h);
        const float rh = 1.f / sqrtf(row_sumsq(h) * (1.f / D) + EPS);
#pragma unroll
        for (int j = 0; j < 8; ++j) y[j] = h[j] * rh * ldp(PV(3 * w + 1), F.lane, j) + ldp(PV(3 * w + 2), F.lane, j);
#if FFN_FP8 == 1
        { unsigned char* V8 = (unsigned char*)V + (size_t)m * D;
#pragma unroll
          for (int j = 0; j < 8; ++j) *(GAS unsigned*)(V8 + 4 * F.lane + 256 * j) = pk4_fp8(y[j][0], y[j][1], y[j][2], y[j][3]); }
#elif FFN_FP8 == 2 && FFNU_K1 < 2048
        { unsigned char* Vr = (unsigned char*)V + (size_t)m * (2 * FFNU_K1 + (2048 - FFNU_K1));
#pragma unroll
          for (int j = 0; j < 8; ++j) { const int col = 4 * F.lane + 256 * j;
              if (256 * j < FFNU_K1) { v2u w; w.x = pk2(y[j][0], y[j][1]); w.y = pk2(y[j][2], y[j][3]); *(GAS v2u*)(Vr + 2 * col) = w; }
              else *(GAS unsigned*)(Vr + 2 * FFNU_K1 + (col - FFNU_K1)) = pk4_fp8(y[j][0], y[j][1], y[j][2], y[j][3]); } }
#else
        st_row_bf16(V + (size_t)m * D, F.lane, y);
#endif
    }
}
__device__ __forceinline__ void ph_norm2(Frame& F) {
    __syncthreads();
    for (int i = F.tid; i < 2 * 2048; i += NTHR) { const int w = i >> 11, c = i & 2047;
        PV(3 * w)[c] = modp(F, 0, w, 5)[c] * inp(I_NORMS)[3 * 2048 + c]; PV(3 * w + 1)[c] = inp(I_NORMS)[(4 + 0) * 2048 + c] * (1.f + modp(F, 1, w, 1)[c]); PV(3 * w + 2)[c] = modp(F, 1, w, 0)[c]; }
    __syncthreads();
    const bf16* FB = (const bf16*)(F.ws + WS_ARENA + A_F); bf16* U = (bf16*)(F.ws + WS_ARENA + A_U); bf16* HR = (bf16*)(F.ws + WS_HRES);
    const int gw = F.vcu * NWAVES + F.wave, NGW = F.G * NWAVES;
    for (int m = gw; m < T; m += NGW) { const int w = m < CTX ? 1 : 0; f32x4 y[8], h[8]; ld_row_bf16(FB + (size_t)m * D, F.lane, y); ld_row_bf16(HR + (size_t)m * D, F.lane, h);
        const float ry = 1.f / sqrtf(row_sumsq(y) * (1.f / D) + EPS);
#pragma unroll
        for (int j = 0; j < 8; ++j) h[j] = h[j] + y[j] * ry * ldp(PV(3 * w), F.lane, j);
        st_row_bf16(HR + (size_t)m * D, F.lane, h);
        const float rh = 1.f / sqrtf(row_sumsq(h) * (1.f / D) + EPS);
#pragma unroll
        for (int j = 0; j < 8; ++j) y[j] = h[j] * rh * ldp(PV(3 * w + 1), F.lane, j) + ldp(PV(3 * w + 2), F.lane, j);
        st_row_bf16(U + (size_t)m * D, F.lane, y); }
}
__device__ __forceinline__ void ph_emit(Frame& F, float* out) {
    const bf16* HR = (const bf16*)(F.ws + WS_HRES) + (size_t)CTX * D;
    for (size_t i = (size_t)blockIdx.x * NTHR + F.tid; i < (size_t)SEQ * D / 4; i += (size_t)F.G * NTHR) { const v2u w = ((const GAS v2u*)HR)[i]; ((GAS f32x4*)out)[i] = (f32x4){bflo(w.x), bfhi(w.x), bflo(w.y), bfhi(w.y)}; }
}

__device__ __forceinline__ void ph_pooldiff(Frame& F) {
    const bf16* ZP = (const bf16*)(F.ws + WS_ARENA + A_ZP); bf16* DP = (bf16*)(F.ws + WS_ARENA + A_DP);
    const size_t nitem = (size_t)T * (WPOOL / 8);
    for (size_t it = (size_t)F.vcu * NTHR + F.tid; it < nitem; it += (size_t)F.G * NTHR) {
        const int t = (int)(it / (WPOOL / 8)), c8 = (int)(it % (WPOOL / 8)) * 8, gi = c8 / PG, w = 2 << gi;
        const int s0 = t < CTX ? 0 : CTX, L = t < CTX ? CTX : SEQ, tp = t - s0;
        int lo = tp - w / 2; lo = lo < 0 ? 0 : lo; int hi = tp + (w - w / 2); hi = hi > L ? L : hi;
        float s[8];
#pragma unroll
        for (int q = 0; q < 8; ++q) s[q] = 0.f;
        for (int r = lo; r < hi; ++r) { const v4u x = *(const GAS v4u*)(ZP + (size_t)(s0 + r) * WPOOL + c8);
            s[0] += bflo(x.x); s[1] += bfhi(x.x); s[2] += bflo(x.y); s[3] += bfhi(x.y); s[4] += bflo(x.z); s[5] += bfhi(x.z); s[6] += bflo(x.w); s[7] += bfhi(x.w); }
        const float inv = 1.f / (float)(hi - lo); const v4u z = *(const GAS v4u*)(ZP + (size_t)t * WPOOL + c8);
        v4u o; o.x = pk2(s[0] * inv - bflo(z.x), s[1] * inv - bfhi(z.x)); o.y = pk2(s[2] * inv - bflo(z.y), s[3] * inv - bfhi(z.y));
        o.z = pk2(s[4] * inv - bflo(z.z), s[5] * inv - bfhi(z.z)); o.w = pk2(s[6] * inv - bflo(z.w), s[7] * inv - bfhi(z.w));
        *(GAS v4u*)(DP + (size_t)t * WPOOL + c8) = o;
    }
}

__device__ __forceinline__ void ph_s5scan(Frame& F) {
    const int gth = blockIdx.x * NTHR + F.tid; if (gth >= S5G * 2 * 64) return;
    const int g = gth >> 7, dir = (gth >> 6) & 1, p = gth & 63, gi = dir * S5G + g;
    const double dt = exp((double)inp(I_LOGDT)[gi]), lr = (double)inp(I_LAMRE)[gi * 64 + p], li = (double)inp(I_LAMIM)[gi * 64 + p];
    const float aLr = (float)(exp(lr * dt * LC) * cos(li * dt * LC)), aLi = (float)(exp(lr * dt * LC) * sin(li * dt * LC));
    const float* SL = (const float*)(F.ws + WS_ARENA + A_SLOC) + (size_t)g * S5ROWS * 256 + dir * 128 + p;
    bf16* CA = (bf16*)(F.ws + WS_ARENA + A_AS5) + (size_t)g * S5ROWS * S5K + 1024 + dir * 128 + p;
    float er = 0.f, ei = 0.f;
    for (int i0 = 0; i0 < NCH; i0 += 4) {
        int cc[4]; float sr[4], si[4];
#pragma unroll
        for (int q = 0; q < 4; ++q) { const int i = i0 + q; cc[q] = dir == 0 ? i : (i < NCH_CTX ? NCH_CTX - 1 - i : NCH - 1 - (i - NCH_CTX));
            sr[q] = SL[(size_t)cc[q] * 256]; si[q] = SL[(size_t)cc[q] * 256 + 64]; }
#pragma unroll
        for (int q = 0; q < 4; ++q) { CA[(size_t)cc[q] * S5K] = (bf16)f2bf(er); CA[(size_t)cc[q] * S5K + 64] = (bf16)f2bf(ei);
            const float nr = aLr * er - aLi * ei + sr[q], ni = aLr * ei + aLi * er + si[q]; er = nr; ei = ni; }
    }
}

typedef unsigned u32x4 __attribute__((ext_vector_type(4)));
using pg8::Unit; using pg8::pack8;
typedef const pg8::f32x4 (&AccRef)[2][2][4][2];
#define EPI_ROWS(u) const int row0 = (u).pm * 256 + wr * 64 + fr
struct EpiPlain { static constexpr bool PERM = true; bf16* O; int ldc;
    __device__ __forceinline__ void operator()(AccRef acc, const Unit& u, int wr, int wc, int fr, int fq) const { EPI_ROWS(u); const int col0 = u.pn * 256 + wc * 32 + 8 * fq;
#pragma unroll
        for (int ai = 0; ai < 2; ++ai)
#pragma unroll
            for (int m = 0; m < 4; ++m) { bf16* rp = O + (size_t)(row0 + ai * 128 + m * 16) * ldc + col0;
#pragma unroll
                for (int bj = 0; bj < 2; ++bj) *(GAS u32x4*)(rp + bj * 128) = pack8(acc[ai][bj][m][0], acc[ai][bj][m][1]); } } };
struct EpiWinE { static constexpr bool PERM = true; bf16* ZP; bf16* AS5;
    __device__ __forceinline__ void operator()(AccRef acc, const Unit& u, int wr, int wc, int fr, int fq) const { EPI_ROWS(u); const int col0 = u.pn * 256 + wc * 32 + 8 * fq;
#pragma unroll
        for (int ai = 0; ai < 2; ++ai)
#pragma unroll
            for (int m = 0; m < 4; ++m) { const int row = row0 + ai * 128 + m * 16;
#pragma unroll
                for (int bj = 0; bj < 2; ++bj) { const int col = col0 + bj * 128; const u32x4 w = pack8(acc[ai][bj][m][0], acc[ai][bj][m][1]);
                    if (u.pn < 6) *(GAS u32x4*)(ZP + (size_t)row * WPOOL + col) = w;
                    else { const int cc = col - WPOOL, g = cc >> 4, n0 = cc & 15, c = row >> 6, s = row & 63; *(GAS u32x4*)(AS5 + ((size_t)(g * S5ROWS + c) * S5K + s * 16 + n0)) = w; } } } } };
struct EpiPool { static constexpr bool PERM = true; bf16* YMIX; const float* scale;
    __device__ __forceinline__ void operator()(AccRef acc, const Unit& u, int wr, int wc, int fr, int fq) const { EPI_ROWS(u); const int lc0 = u.pn * 256 + wc * 32 + 8 * fq;
#pragma unroll
        for (int bj = 0; bj < 2; ++bj) { const int lc = lc0 + bj * 128; if (lc >= PG) continue; const int gc = u.bz * PG + lc;
            const f32x4 s0 = *(const GAS f32x4*)(scale + gc), s1 = *(const GAS f32x4*)(scale + gc + 4);
#pragma unroll
            for (int ai = 0; ai < 2; ++ai)
#pragma unroll
                for (int m = 0; m < 4; ++m) { const int row = row0 + ai * 128 + m * 16; *(GAS u32x4*)(YMIX + (size_t)row * D + gc) = pack8(acc[ai][bj][m][0] * s0, acc[ai][bj][m][1] * s1); } } } };
struct EpiSloc { static constexpr bool PERM = false; float* SL;
    __device__ __forceinline__ void operator()(AccRef acc, const Unit& u, int wr, int wc, int fr, int fq) const { EPI_ROWS(u); const int col0 = u.pn * 256 + wc * 32 + 4 * fq;
#pragma unroll
        for (int ai = 0; ai < 2; ++ai)
#pragma unroll
            for (int m = 0; m < 4; ++m) { float* rp = SL + ((size_t)u.bz * S5ROWS + row0 + ai * 128 + m * 16) * 256 + col0;
#pragma unroll
                for (int bj = 0; bj < 2; ++bj)
#pragma unroll
                    for (int n = 0; n < 2; ++n) *(GAS f32x4*)(rp + bj * 128 + n * 16) = acc[ai][bj][m][n]; } } };
struct EpiS5Y { static constexpr bool PERM = true; const bf16* AS5; const float* dsk; bf16* YG;
    __device__ __forceinline__ void operator()(AccRef acc, const Unit& u, int wr, int wc, int fr, int fq) const { EPI_ROWS(u); const int col0 = u.pn * 256 + wc * 32 + 8 * fq;
#pragma unroll
        for (int bj = 0; bj < 2; ++bj) { const int col = col0 + bj * 128, tau = col >> 4, n0 = col & 15;
            const f32x4 d0 = *(const GAS f32x4*)(dsk + u.bz * 16 + n0), d1 = *(const GAS f32x4*)(dsk + u.bz * 16 + n0 + 4);
#pragma unroll
            for (int ai = 0; ai < 2; ++ai)
#pragma unroll
                for (int m = 0; m < 4; ++m) { const int c = row0 + ai * 128 + m * 16; if (c >= NCH) continue;
                    const v4u x = *(const GAS v4u*)(AS5 + ((size_t)(u.bz * S5ROWS + c) * S5K + col));
                    f32x4 a = acc[ai][bj][m][0], b = acc[ai][bj][m][1];
                    a[0] = gelu_tanh(a[0] + bflo(x.x) * d0[0]); a[1] = gelu_tanh(a[1] + bfhi(x.x) * d0[1]); a[2] = gelu_tanh(a[2] + bflo(x.y) * d0[2]); a[3] = gelu_tanh(a[3] + bfhi(x.y) * d0[3]);
                    b[0] = gelu_tanh(b[0] + bflo(x.z) * d1[0]); b[1] = gelu_tanh(b[1] + bfhi(x.z) * d1[1]); b[2] = gelu_tanh(b[2] + bflo(x.w) * d1[2]); b[3] = gelu_tanh(b[3] + bfhi(x.w) * d1[3]);
                    *(GAS u32x4*)(YG + ((size_t)(c * 64 + tau) * WS5 + u.bz * 16 + n0)) = pack8(a, b); } } } };
struct EpiGlu { static constexpr bool PERM = true; const bf16* YG; bf16* YMIX;
    __device__ __forceinline__ void operator()(AccRef acc, const Unit& u, int wr, int wc, int fr, int fq) const { EPI_ROWS(u); const int col0 = u.pn * 256 + wc * 32 + 8 * fq;
#pragma unroll
        for (int ai = 0; ai < 2; ++ai)
#pragma unroll
            for (int m = 0; m < 4; ++m) { const int row = row0 + ai * 128 + m * 16;
#pragma unroll
                for (int bj = 0; bj < 2; ++bj) { const int col = col0 + bj * 128; const v4u x = *(const GAS v4u*)(YG + (size_t)row * WS5 + col);
                    f32x4 a = acc[ai][bj][m][0], b = acc[ai][bj][m][1];
                    a[0] = bflo(x.x) * sigmoidf_(a[0]); a[1] = bfhi(x.x) * sigmoidf_(a[1]); a[2] = bflo(x.y) * sigmoidf_(a[2]); a[3] = bfhi(x.y) * sigmoidf_(a[3]);
                    b[0] = bflo(x.z) * sigmoidf_(b[0]); b[1] = bfhi(x.z) * sigmoidf_(b[1]); b[2] = bflo(x.w) * sigmoidf_(b[2]); b[3] = bfhi(x.w) * sigmoidf_(b[3]);
                    *(GAS u32x4*)(YMIX + (size_t)row * D + WPOOL + col) = pack8(a, b); } } } };
struct EpiGateUp { static constexpr bool PERM = true; bf16* HID; int ldc;
    __device__ __forceinline__ void operator()(AccRef acc, const Unit& u, int wr, int wc, int fr, int fq) const { EPI_ROWS(u); const int col0 = u.pn * 128 + wc * 32 + 8 * fq;
#pragma unroll
        for (int ai = 0; ai < 2; ++ai)
#pragma unroll
            for (int m = 0; m < 4; ++m) { const int row = row0 + ai * 128 + m * 16; f32x4 a, b;
#pragma unroll
                for (int q = 0; q < 4; ++q) { a[q] = swiglu_fast(acc[ai][0][m][0][q], acc[ai][1][m][0][q], -1.4426950408889634f, 1.f); b[q] = swiglu_fast(acc[ai][0][m][1][q], acc[ai][1][m][1][q], -1.4426950408889634f, 1.f); }
                *(GAS u32x4*)(HID + (size_t)row * ldc + col0) = pack8(a, b); } } };

struct EpiWinO { static constexpr bool PERM = true; unsigned char* ar;
    __device__ __forceinline__ void operator()(AccRef acc, const Unit& u, int wr, int wc, int fr, int fq) const { EPI_ROWS(u); const int pn = u.pn;
        if (pn == 18) { if (wc == 0 && fq < 2) { float* ALR = (float*)(ar + B_ALR);
#pragma unroll
                for (int ai = 0; ai < 2; ++ai)
#pragma unroll
                    for (int m = 0; m < 4; ++m) { float* rp = ALR + (size_t)(row0 + ai * 128 + m * 16) * 16 + 8 * fq; *(GAS f32x4*)rp = acc[ai][0][m][0]; *(GAS f32x4*)(rp + 4) = acc[ai][0][m][1]; } }
            return; }
        bf16* base; int ld, c0;
        if (pn < 2) { base = (bf16*)(ar + B_GQ); ld = 512; c0 = pn * 256; } else if (pn < 4) { base = (bf16*)(ar + B_GK); ld = 512; c0 = (pn - 2) * 256; }
        else if (pn < 8) { base = (bf16*)(ar + B_GV); ld = 1024; c0 = (pn - 4) * 256; } else if (pn < 12) { base = (bf16*)(ar + B_R); ld = 1024; c0 = (pn - 8) * 256; }
        else if (pn < 16) { base = (bf16*)(ar + B_AQ); ld = 1024; c0 = (pn - 12) * 256; } else if (pn == 16) { base = (bf16*)(ar + B_AK); ld = 256; c0 = 0; } else { base = (bf16*)(ar + B_AV); ld = 256; c0 = 0; }
        const int col0 = c0 + wc * 32 + 8 * fq;
#pragma unroll
        for (int ai = 0; ai < 2; ++ai)
#pragma unroll
            for (int m = 0; m < 4; ++m) { bf16* rp = base + (size_t)(row0 + ai * 128 + m * 16) * ld + col0;
#pragma unroll
                for (int bj = 0; bj < 2; ++bj) *(GAS u32x4*)(rp + bj * 128) = pack8(acc[ai][bj][m][0], acc[ai][bj][m][1]); } } };

__device__ __forceinline__ void ph_qknorm(Frame& F) {
    unsigned char* ar = F.ws + WS_ARENA; bf16* AQ = (bf16*)(ar + B_AQ); bf16* AK = (bf16*)(ar + B_AK);
    const float* qn = inp(I_QNORM); const float* kn = inp(I_KNORM); const f32x2* rope = (const f32x2*)(F.ws + WS_ROPE);
    const size_t NQ = (size_t)SEQ * 8 * 8, NK = (size_t)T * 2 * 8;
    for (size_t it = (size_t)F.vcu * NTHR + F.tid; it < NQ + NK; it += (size_t)F.G * NTHR) {
        const bool isq = it < NQ; const size_t r = isq ? it : it - NQ; const int j = (int)(r & 7), hf = j >> 2, sub = j & 3;
        int row, head; bf16* p; const float* nw;
        if (isq) { head = (int)((r >> 3) & 7); row = CTX + (int)(r >> 6); p = AQ + (size_t)row * 1024 + head * 128; nw = qn; }
        else { head = (int)((r >> 3) & 1); row = (int)(r >> 4); p = AK + (size_t)row * 256 + head * 128; nw = kn; }
        const int d1 = 64 * hf + 8 * sub, d2 = d1 + 32;
        const v4u a = *(const GAS v4u*)(p + d1), b = *(const GAS v4u*)(p + d2);
        float x1[8] = {bflo(a.x), bfhi(a.x), bflo(a.y), bfhi(a.y), bflo(a.z), bfhi(a.z), bflo(a.w), bfhi(a.w)};
        float x2[8] = {bflo(b.x), bfhi(b.x), bflo(b.y), bfhi(b.y), bflo(b.z), bfhi(b.z), bflo(b.w), bfhi(b.w)};
        float ss = 0.f;
#pragma unroll
        for (int e = 0; e < 8; ++e) ss += x1[e] * x1[e] + x2[e] * x2[e];
        ss += __shfl_xor(ss, 1); ss += __shfl_xor(ss, 2); ss += __shfl_xor(ss, 4);
        const float rstd = 1.f / sqrtf(ss * (1.f / 128.f) + EPS);
        const bool rot = row >= CTX; const int tl = row - CTX, pos = hf ? (tl & 63) : (tl >> 6);
        float o1[8], o2[8];
#pragma unroll
        for (int e = 0; e < 8; ++e) { const float y1 = x1[e] * rstd * nw[d1 + e], y2 = x2[e] * rstd * nw[d2 + e];
            f32x2 cs = {1.f, 0.f}; if (rot) cs = rope[pos * 32 + 8 * sub + e];
            o1[e] = y1 * cs.x - y2 * cs.y; o2[e] = y1 * cs.y + y2 * cs.x; }
        v4u w1, w2; w1.x = pk2(o1[0], o1[1]); w1.y = pk2(o1[2], o1[3]); w1.z = pk2(o1[4], o1[5]); w1.w = pk2(o1[6], o1[7]);
        w2.x = pk2(o2[0], o2[1]); w2.y = pk2(o2[2], o2[3]); w2.z = pk2(o2[4], o2[5]); w2.w = pk2(o2[6], o2[7]);
        *(GAS v4u*)(p + d1) = w1; *(GAS v4u*)(p + d2) = w2;
        if (!isq) {
            unsigned char* k8 = ar + B_KDT + (size_t)row * 256 + head * 128 + 64 * (sub & 1) + 8 * (4 * hf + (sub >> 1));
            v2u a8, b8; a8.x = pk4_fp8(o1[0], o1[1], o1[2], o1[3]); a8.y = pk4_fp8(o1[4], o1[5], o1[6], o1[7]); b8.x = pk4_fp8(o2[0], o2[1], o2[2], o2[3]); b8.y = pk4_fp8(o2[4], o2[5], o2[6], o2[7]);
            *(GAS v2u*)k8 = a8; *(GAS v2u*)(k8 + 16) = b8; }
    }
}

constexpr size_t VT8_OFF = 8 * MiB;
__device__ __forceinline__ void ph_vt8(Frame& F) {
    unsigned char* ar = F.ws + WS_ARENA; const bf16* AV = (const bf16*)(ar + B_AV); unsigned char* VT8 = ar + B_KDT + VT8_OFF;
    const int ntask = 2 * NCH * 128 * 4;
    for (int it = F.vcu * NTHR + F.tid; it < ntask; it += F.G * NTHR) {
        const int g = it & 3, d = (it >> 2) & 127, tl = (it >> 9) % NCH, kvh = (it >> 9) / NCH, hi = g >> 1, blk = g & 1;
        float x[16];
#pragma unroll
        for (int r = 0; r < 16; ++r) { const int key = 32 * blk + (r & 3) + 8 * (r >> 2) + 4 * hi; x[r] = bf2f(AV[(size_t)(tl * 64 + key) * 256 + kvh * 128 + d]); }
        v4u o; o.x = pk4_fp8(x[0], x[1], x[2], x[3]); o.y = pk4_fp8(x[4], x[5], x[6], x[7]); o.z = pk4_fp8(x[8], x[9], x[10], x[11]); o.w = pk4_fp8(x[12], x[13], x[14], x[15]);
        *(GAS v4u*)(VT8 + ((size_t)(kvh * NCH + tl) * 128 + d) * 64 + g * 16) = o;
    }
}

namespace tri {
using s16x4 = __attribute__((ext_vector_type(4))) short;
__device__ __forceinline__ int st(int k, int c) { const int kk = (k & ~0xC) | ((k & 4) << 1) | ((k & 8) >> 1); return ((kk >> 3) * 4 + (c >> 5)) * 512 + ((kk & 7) * 32 + (c & 31)) * 2; }
__device__ __forceinline__ int rd_base(int lane) { return ((lane & 3) << 3) | (((lane >> 2) & 3) << 6) | (((lane >> 4) & 1) << 5) | (((lane >> 5) & 1) << 8); }
constexpr int rd_off(int d0, int ks, int half) { return d0 * 512 + ks * 4096 + half * 2048; }
template <int OFF> __device__ __forceinline__ s16x4 tr_read(int vb) { s16x4 r; asm volatile("ds_read_b64_tr_b16 %0, %1 offset:%2" : "=&v"(r) : "v"(vb), "i"(OFF) : "memory"); return r; }
struct Frag2 { s16x4 lo, hi; };
template <int D0, int KS> __device__ __forceinline__ Frag2 ld(int vb) { Frag2 f; f.lo = tr_read<rd_off(D0, KS, 0)>(vb); f.hi = tr_read<rd_off(D0, KS, 1)>(vb); return f; }
__device__ __forceinline__ bf16x8 pk(const Frag2& f) { return (bf16x8){f.lo[0], f.lo[1], f.lo[2], f.lo[3], f.hi[0], f.hi[1], f.hi[2], f.hi[3]}; }
#define TRI_WAIT() do { asm volatile("s_waitcnt lgkmcnt(0)" ::: "memory"); __builtin_amdgcn_sched_barrier(0); } while (0)
}
typedef float f32x16 __attribute__((ext_vector_type(16)));
__device__ __forceinline__ int crow(int r, int hi) { return (r & 3) + 8 * (r >> 2) + 4 * hi; }

__device__ __forceinline__ float logsigmoidf_(float z) { return fminf(z, 0.f) - __logf(1.f + __expf(-fabsf(z))); }
__device__ __forceinline__ void gla_prepkv_unit(Frame& F, int c, int h) {
    unsigned char* ar = F.ws + WS_ARENA;
    const bf16* GQ = (const bf16*)(ar + B_GQ); const bf16* GK = (const bf16*)(ar + B_GK); const bf16* GV = (const bf16*)(ar + B_GV); const float* ALR = (const float*)(ar + B_ALR);
    LAS float* ALR_S = (LAS float*)(F.lds);
    LAS float* WA_S = (LAS float*)(F.lds + 4096);
    LAS float* BA_S = (LAS float*)(F.lds + 12288);
    LAS float* SEG_S = (LAS float*)(F.lds + 12800);
    LAS float* GB = (LAS float*)(F.lds + 14848);
    LAS unsigned char* QS = F.lds + 47616;
    LAS unsigned char* KS = F.lds + 64000;
    LAS unsigned char* VIMG = F.lds + 80384;
    LAS unsigned char* KIMG = F.lds + 113152;
    const int tid = F.tid, lane = F.lane, t0 = c * 64;
    __syncthreads();
    for (int i = tid; i < 1024; i += NTHR) ALR_S[i] = ALR[(size_t)t0 * 16 + i];
    for (int i = tid; i < 1024; i += NTHR) { const int r = i >> 4, k8 = (i & 15) * 8;
        *(LAS v4u*)(QS + (r * 128 + k8) * 2) = *(const GAS v4u*)(GQ + (size_t)(t0 + r) * 512 + h * 128 + k8); *(LAS v4u*)(KS + (r * 128 + k8) * 2) = *(const GAS v4u*)(GK + (size_t)(t0 + r) * 512 + h * 128 + k8); }
    for (int i = tid; i < 2048; i += NTHR) { const int r = i >> 5, v8 = (i & 31) * 8;
        *(LAS v4u*)(VIMG + (v8 >> 7) * 16384 + tri::st(r, v8 & 127)) = *(const GAS v4u*)(GV + (size_t)(t0 + r) * 1024 + h * 256 + v8); }
    for (int d = 0; d < 2; ++d) {
        const float* wa = inp(I_GLAWA) + (size_t)d * 16 * 512 + h * 128; const float* ba = inp(I_GLABA) + d * 512 + h * 128;
        __syncthreads();
        for (int i = tid; i < 2048; i += NTHR) WA_S[i] = wa[(size_t)(i >> 7) * 512 + (i & 127)];
        if (tid < 128) BA_S[tid] = ba[tid];
        __syncthreads();
        const int k = tid & 127, seg = tid >> 7;
        float gl[16];
        { float w[16];
#pragma unroll
          for (int r = 0; r < 16; ++r) w[r] = WA_S[r * 128 + k];
          const float b0 = BA_S[k];
#pragma unroll
          for (int ii = 0; ii < 16; ++ii) { const int i = seg * 16 + ii; float z = b0;
#pragma unroll
              for (int r = 0; r < 16; ++r) z += ALR_S[i * 16 + r] * w[r];
              gl[ii] = logsigmoidf_(z) * (1.f / 16.f); } }
        if (d == 0) {
#pragma unroll
            for (int ii = 1; ii < 16; ++ii) gl[ii] += gl[ii - 1];
            SEG_S[seg * 128 + k] = gl[15]; }
        else {
#pragma unroll
            for (int ii = 14; ii >= 0; --ii) gl[ii] += gl[ii + 1];
            SEG_S[seg * 128 + k] = gl[0]; }
        __syncthreads();
        const float s0 = SEG_S[k], s1 = SEG_S[128 + k], s2 = SEG_S[256 + k], s3 = SEG_S[384 + k], tot = (s0 + s1) + (s2 + s3);
        float off;
        if (d == 0) off = seg == 0 ? 0.f : (seg == 1 ? s0 : (seg == 2 ? s0 + s1 : s0 + s1 + s2));
        else off = seg == 3 ? 0.f : (seg == 2 ? s3 : (seg == 1 ? s3 + s2 : s3 + s2 + s1));
#pragma unroll
        for (int ii = 0; ii < 16; ++ii) GB[(seg * 16 + ii) * 128 + k] = gl[ii] + off;
        if (seg == 0) ((float*)(ar + B_DEC))[((size_t)(d * NCH + c) * 4 + h) * 128 + k] = __expf(tot);
        __syncthreads();
        { bf16* QE = (bf16*)(ar + B_QE) + (size_t)d * T * 512; bf16* KE = (bf16*)(ar + B_KE) + (size_t)d * T * 512;
          for (int i2 = tid; i2 < 1024; i2 += NTHR) { const int i = i2 >> 4, k8 = (i2 & 15) * 8; const v4u qw = *(const LAS v4u*)(QS + (i * 128 + k8) * 2), kw = *(const LAS v4u*)(KS + (i * 128 + k8) * 2);
              const f32x4 ba0 = *(const LAS f32x4*)(GB + i * 128 + k8), ba1 = *(const LAS f32x4*)(GB + i * 128 + k8 + 4);
              const f32x4 t0v = *(const LAS f32x4*)(SEG_S + k8), t1v = *(const LAS f32x4*)(SEG_S + 128 + k8), t2v = *(const LAS f32x4*)(SEG_S + 256 + k8), t3v = *(const LAS f32x4*)(SEG_S + 384 + k8);
              const f32x4 u0v = *(const LAS f32x4*)(SEG_S + k8 + 4), u1v = *(const LAS f32x4*)(SEG_S + 128 + k8 + 4), u2v = *(const LAS f32x4*)(SEG_S + 256 + k8 + 4), u3v = *(const LAS f32x4*)(SEG_S + 384 + k8 + 4);
              const f32x4 tt0 = (t0v + t1v) + (t2v + t3v), tt1 = (u0v + u1v) + (u2v + u3v);
              const float b[8] = {ba0[0], ba0[1], ba0[2], ba0[3], ba1[0], ba1[1], ba1[2], ba1[3]}; const float tt[8] = {tt0[0], tt0[1], tt0[2], tt0[3], tt1[0], tt1[1], tt1[2], tt1[3]};
              const unsigned qv[4] = {qw.x, qw.y, qw.z, qw.w}, kv[4] = {kw.x, kw.y, kw.z, kw.w}; float qe[8], ke[8], kd[8];
#pragma unroll
              for (int e = 0; e < 4; ++e) { const float q0 = bflo(qv[e]), q1 = bfhi(qv[e]), k0 = bflo(kv[e]), k1 = bfhi(kv[e]); const float e0 = __expf(b[2 * e]), e1 = __expf(b[2 * e + 1]);
                  const float r0 = __builtin_amdgcn_rcpf(e0), r1 = __builtin_amdgcn_rcpf(e1);
                  qe[2 * e] = q0 * 0.08838834764831845f * e0; qe[2 * e + 1] = q1 * 0.08838834764831845f * e1; ke[2 * e] = k0 * r0; ke[2 * e + 1] = k1 * r1;
                  kd[2 * e] = k0 * __expf(tt[2 * e] - b[2 * e]); kd[2 * e + 1] = k1 * __expf(tt[2 * e + 1] - b[2 * e + 1]); }
              v4u wq, wk, wd; wq.x = pk2(qe[0], qe[1]); wq.y = pk2(qe[2], qe[3]); wq.z = pk2(qe[4], qe[5]); wq.w = pk2(qe[6], qe[7]);
              wk.x = pk2(ke[0], ke[1]); wk.y = pk2(ke[2], ke[3]); wk.z = pk2(ke[4], ke[5]); wk.w = pk2(ke[6], ke[7]);
              wd.x = pk2(kd[0], kd[1]); wd.y = pk2(kd[2], kd[3]); wd.z = pk2(kd[4], kd[5]); wd.w = pk2(kd[6], kd[7]);
              *(GAS v4u*)(QE + (size_t)(t0 + i) * 512 + h * 128 + k8) = wq; *(GAS v4u*)(KE + (size_t)(t0 + i) * 512 + h * 128 + k8) = wk;
              *(LAS v4u*)(KIMG + tri::st(i, k8)) = wd; } }
        __syncthreads();
        {
            const int w = F.wave, r = lane & 31, hi = lane >> 5;
            const int kb_base = (int)(uintptr_t)KIMG + tri::rd_base(lane), vb_base = (int)(uintptr_t)VIMG + (w >> 2) * 16384 + (w & 3) * 512 + tri::rd_base(lane);
            const tri::Frag2 b0 = tri::ld<0, 0>(vb_base), b1 = tri::ld<0, 1>(vb_base), b2 = tri::ld<0, 2>(vb_base), b3 = tri::ld<0, 3>(vb_base);
            const tri::Frag2 a00 = tri::ld<0, 0>(kb_base), a01 = tri::ld<0, 1>(kb_base), a02 = tri::ld<0, 2>(kb_base), a03 = tri::ld<0, 3>(kb_base);
            const tri::Frag2 a10 = tri::ld<1, 0>(kb_base), a11 = tri::ld<1, 1>(kb_base), a12 = tri::ld<1, 2>(kb_base), a13 = tri::ld<1, 3>(kb_base);
            const tri::Frag2 a20 = tri::ld<2, 0>(kb_base), a21 = tri::ld<2, 1>(kb_base), a22 = tri::ld<2, 2>(kb_base), a23 = tri::ld<2, 3>(kb_base);
            const tri::Frag2 a30 = tri::ld<3, 0>(kb_base), a31 = tri::ld<3, 1>(kb_base), a32 = tri::ld<3, 2>(kb_base), a33 = tri::ld<3, 3>(kb_base);
            TRI_WAIT();
            const bf16x8 B0 = tri::pk(b0), B1 = tri::pk(b1), B2 = tri::pk(b2), B3 = tri::pk(b3);
            f32x16 acc[4] = {};
            acc[0] = __builtin_amdgcn_mfma_f32_32x32x16_bf16(tri::pk(a00), B0, acc[0], 0, 0, 0); acc[0] = __builtin_amdgcn_mfma_f32_32x32x16_bf16(tri::pk(a01), B1, acc[0], 0, 0, 0);
            acc[0] = __builtin_amdgcn_mfma_f32_32x32x16_bf16(tri::pk(a02), B2, acc[0], 0, 0, 0); acc[0] = __builtin_amdgcn_mfma_f32_32x32x16_bf16(tri::pk(a03), B3, acc[0], 0, 0, 0);
            acc[1] = __builtin_amdgcn_mfma_f32_32x32x16_bf16(tri::pk(a10), B0, acc[1], 0, 0, 0); acc[1] = __builtin_amdgcn_mfma_f32_32x32x16_bf16(tri::pk(a11), B1, acc[1], 0, 0, 0);
            acc[1] = __builtin_amdgcn_mfma_f32_32x32x16_bf16(tri::pk(a12), B2, acc[1], 0, 0, 0); acc[1] = __builtin_amdgcn_mfma_f32_32x32x16_bf16(tri::pk(a13), B3, acc[1], 0, 0, 0);
            acc[2] = __builtin_amdgcn_mfma_f32_32x32x16_bf16(tri::pk(a20), B0, acc[2], 0, 0, 0); acc[2] = __builtin_amdgcn_mfma_f32_32x32x16_bf16(tri::pk(a21), B1, acc[2], 0, 0, 0);
            acc[2] = __builtin_amdgcn_mfma_f32_32x32x16_bf16(tri::pk(a22), B2, acc[2], 0, 0, 0); acc[2] = __builtin_amdgcn_mfma_f32_32x32x16_bf16(tri::pk(a23), B3, acc[2], 0, 0, 0);
            acc[3] = __builtin_amdgcn_mfma_f32_32x32x16_bf16(tri::pk(a30), B0, acc[3], 0, 0, 0); acc[3] = __builtin_amdgcn_mfma_f32_32x32x16_bf16(tri::pk(a31), B1, acc[3], 0, 0, 0);
            acc[3] = __builtin_amdgcn_mfma_f32_32x32x16_bf16(tri::pk(a32), B2, acc[3], 0, 0, 0); acc[3] = __builtin_amdgcn_mfma_f32_32x32x16_bf16(tri::pk(a33), B3, acc[3], 0, 0, 0);
            bf16* ST = (bf16*)(ar + B_ST) + ((size_t)(d * NCH + c) * 4 + h) * 256 * 128;
#pragma unroll
            for (int kb = 0; kb < 4; ++kb)
#pragma unroll
                for (int q4 = 0; q4 < 4; ++q4) { v2u o; o.x = pk2(acc[kb][4 * q4], acc[kb][4 * q4 + 1]); o.y = pk2(acc[kb][4 * q4 + 2], acc[kb][4 * q4 + 3]);
                    *(GAS v2u*)(ST + (size_t)(32 * w + r) * 128 + 32 * kb + 8 * q4 + 4 * hi) = o; }
        }
    }
}

__device__ __forceinline__ void ph_gla_scan(Frame& F) {
    unsigned char* ar = F.ws + WS_ARENA; const float* DEC = (const float*)(ar + B_DEC);
    for (int gth = blockIdx.x * NTHR + F.tid; gth < 2 * 4 * 256 * 64; gth += F.G * NTHR) {
        const int kp = gth & 63, v = (gth >> 6) & 255, h = (gth >> 14) & 3, d = gth >> 16;
        unsigned* ST = (unsigned*)(ar + B_ST) + ((((size_t)d * NCH) * 4 + h) * 256 + v) * 64 + kp;
        const f32x2* DC = (const f32x2*)DEC + (((size_t)d * NCH) * 4 + h) * 64 + kp;
        float s0 = 0.f, s1 = 0.f;
        for (int i0 = 0; i0 < NCH; i0 += 4) { int cc[4]; unsigned kv[4]; f32x2 dc[4];
#pragma unroll
            for (int q = 0; q < 4; ++q) { const int i = i0 + q; cc[q] = d == 0 ? i : (i < NCH_CTX ? NCH_CTX - 1 - i : NCH - 1 - (i - NCH_CTX));
                kv[q] = ST[(size_t)cc[q] * (4 * 256 * 64)]; dc[q] = DC[(size_t)cc[q] * (4 * 64)]; }
#pragma unroll
            for (int q = 0; q < 4; ++q) { ST[(size_t)cc[q] * (4 * 256 * 64)] = pk2(s0, s1); s0 = dc[q].x * s0 + bflo(kv[q]); s1 = dc[q].y * s1 + bfhi(kv[q]); } }
    }
}

__device__ __forceinline__ void gla_out_unit(Frame& F, int cl, int h) {
    unsigned char* ar = F.ws + WS_ARENA; const int c = cl + NCH_CTX, t0 = c * 64;
    LAS unsigned char* ATT = F.lds;
    LAS float* OS = (LAS float*)(F.lds + 18432);
    LAS unsigned char* VIMG = F.lds + 86016;
    const int lane = F.lane, r = lane & 31, hi = lane >> 5, w = F.wave;
    __syncthreads();
    { const bf16* GV = (const bf16*)(ar + B_GV);
      for (int i = F.tid; i < 2048; i += NTHR) { const int rr = i >> 5, v8 = (i & 31) * 8;
          *(LAS v4u*)(VIMG + (v8 >> 7) * 16384 + tri::st(rr, v8 & 127)) = *(const GAS v4u*)(GV + (size_t)(t0 + rr) * 1024 + h * 256 + v8); } }
    {
        const int d = w >> 2, ib = (w >> 1) & 1, jb = w & 1;
        const bf16* QE = (const bf16*)(ar + B_QE) + (size_t)d * T * 512 + (size_t)(t0 + ib * 32 + r) * 512 + h * 128 + 8 * hi;
        const bf16* KE = (const bf16*)(ar + B_KE) + (size_t)d * T * 512 + (size_t)(t0 + jb * 32 + r) * 512 + h * 128 + 8 * hi;
        bf16x8 a[8], b[8];
#pragma unroll
        for (int s = 0; s < 8; ++s) { a[s] = *(const GAS bf16x8*)(KE + 16 * s); b[s] = *(const GAS bf16x8*)(QE + 16 * s); }
        f32x16 acc = {};
#pragma unroll
        for (int s = 0; s < 8; ++s) acc = __builtin_amdgcn_mfma_f32_32x32x16_bf16(a[s], b[s], acc, 0, 0, 0);
        const int i = ib * 32 + r;
#pragma unroll
        for (int q4 = 0; q4 < 4; ++q4) { float x[4];
#pragma unroll
            for (int e = 0; e < 4; ++e) { const int j = jb * 32 + 8 * q4 + 4 * hi + e; const bool keep = d == 0 ? (j <= i) : (j >= i); x[e] = keep ? acc[4 * q4 + e] : 0.f; }
            v2u o; o.x = pk2(x[0], x[1]); o.y = pk2(x[2], x[3]);
            *(LAS v2u*)(ATT + ((size_t)(d * 64 + i) * 72 + jb * 32 + 8 * q4 + 4 * hi) * 2) = o; }
    }
    __syncthreads();
    {
        const int ib = w >> 2, vq = w & 3; f32x16 o0 = {}, o1 = {};
        const int vb_base = (int)(uintptr_t)VIMG + (vq >> 1) * 16384 + (2 * (vq & 1)) * 512 + tri::rd_base(lane);
        const tri::Frag2 p0 = tri::ld<0, 0>(vb_base), p1 = tri::ld<0, 1>(vb_base), p2 = tri::ld<0, 2>(vb_base), p3 = tri::ld<0, 3>(vb_base);
        const tri::Frag2 q0 = tri::ld<1, 0>(vb_base), q1 = tri::ld<1, 1>(vb_base), q2 = tri::ld<1, 2>(vb_base), q3 = tri::ld<1, 3>(vb_base);
        TRI_WAIT();
        const bf16x8 vb0[4] = {tri::pk(p0), tri::pk(p1), tri::pk(p2), tri::pk(p3)}, vb1[4] = {tri::pk(q0), tri::pk(q1), tri::pk(q2), tri::pk(q3)};
#pragma unroll
        for (int d = 0; d < 2; ++d) {
            bf16x8 a[4];
#pragma unroll
            for (int s = 0; s < 4; ++s) a[s] = *(const LAS bf16x8*)(ATT + ((size_t)(d * 64 + ib * 32 + r) * 72 + 16 * s + 8 * hi) * 2);
#pragma unroll
            for (int s = 0; s < 4; ++s) { o0 = __builtin_amdgcn_mfma_f32_32x32x16_bf16(a[s], vb0[s], o0, 0, 0, 0); o1 = __builtin_amdgcn_mfma_f32_32x32x16_bf16(a[s], vb1[s], o1, 0, 0, 0); }
            const bf16* QE = (const bf16*)(ar + B_QE) + (size_t)d * T * 512 + (size_t)(t0 + ib * 32 + r) * 512 + h * 128 + 8 * hi;
            const bf16* ST = (const bf16*)(ar + B_ST) + ((size_t)(d * NCH + c) * 4 + h) * 256 * 128 + (size_t)(64 * vq + r) * 128 + 8 * hi;
            bf16x8 qa[8], s0[8], s1[8];
#pragma unroll
            for (int s = 0; s < 8; ++s) { qa[s] = *(const GAS bf16x8*)(QE + 16 * s); s0[s] = *(const GAS bf16x8*)(ST + 16 * s); s1[s] = *(const GAS bf16x8*)(ST + 32 * 128 + 16 * s); }
#pragma unroll
            for (int s = 0; s < 8; ++s) { o0 = __builtin_amdgcn_mfma_f32_32x32x16_bf16(qa[s], s0[s], o0, 0, 0, 0); o1 = __builtin_amdgcn_mfma_f32_32x32x16_bf16(qa[s], s1[s], o1, 0, 0, 0); }
        }
#pragma unroll
        for (int q = 0; q < 16; ++q) { const int i = ib * 32 + crow(q, hi); OS[i * 260 + 64 * vq + r] = o0[q]; OS[i * 260 + 64 * vq + 32 + r] = o1[q]; }
    }
    __syncthreads();
    {
        const int i = F.tid >> 3, seg = F.tid & 7; const LAS float* op = OS + i * 260 + 32 * seg; f32x4 x[8]; float ss = 0.f;
#pragma unroll
        for (int e = 0; e < 8; ++e) { x[e] = *(const LAS f32x4*)(op + 4 * e); ss += (x[e][0] * x[e][0] + x[e][1] * x[e][1]) + (x[e][2] * x[e][2] + x[e][3] * x[e][3]); }
        ss += __shfl_xor(ss, 1); ss += __shfl_xor(ss, 2); ss += __shfl_xor(ss, 4);
        const float rstd = 1.f / sqrtf(ss * (1.f / 256.f) + EPS);
        const float* gn = inp(I_GLANORM) + h * 256 + 32 * seg; const bf16* R = (const bf16*)(ar + B_R) + (size_t)(t0 + i) * 1024 + h * 256 + 32 * seg;
        bf16* YM = (bf16*)(ar + B_YMIX1) + (size_t)(t0 - CTX + i) * D + h * 256 + 32 * seg;
#pragma unroll
        for (int e2 = 0; e2 < 4; ++e2) { const v4u rr = *(const GAS v4u*)(R + 8 * e2); const f32x4 g0 = *(const GAS f32x4*)(gn + 8 * e2), g1 = *(const GAS f32x4*)(gn + 8 * e2 + 4);
            const f32x4 a = x[2 * e2] * rstd * g0, b = x[2 * e2 + 1] * rstd * g1; v4u o;
            o.x = pk2(a[0] * siluf_(bflo(rr.x)), a[1] * siluf_(bfhi(rr.x))); o.y = pk2(a[2] * siluf_(bflo(rr.y)), a[3] * siluf_(bfhi(rr.y)));
            o.z = pk2(b[0] * siluf_(bflo(rr.z)), b[1] * siluf_(bfhi(rr.z))); o.w = pk2(b[2] * siluf_(bflo(rr.w)), b[3] * siluf_(bfhi(rr.w)));
            *(GAS v4u*)(YM + 8 * e2) = o; }
    }
}

namespace att {
constexpr int HD = 128, NW = 8, QBLK = 32, KVBLK = 64;
constexpr float SCALE = 0.088388347648318440f;
constexpr float THR = 8.f;
constexpr int LDQ = 1024, LDK = 256, LDO = 2048;
constexpr size_t SHM_V = KVBLK * HD * 2, SHM_K = KVBLK * HD * 2, SHM_ATTN = 2 * SHM_V + 2 * SHM_K + NW * 64 * 4;
using s16x4 = __attribute__((ext_vector_type(4))) short;
#define KSWZ(row, colB) ((row) * 256 + ((colB) ^ (((row) & 7) << 4)))
#define SBAR() __builtin_amdgcn_sched_barrier(0)
__device__ __forceinline__ unsigned cvtpk(float lo, float hi) { unsigned r; asm volatile("v_cvt_pk_bf16_f32 %0, %1, %2" : "=v"(r) : "v"(lo), "v"(hi)); return r; }
__device__ __forceinline__ void partialSM(f32x16& p0, f32x16& p1, float& m_reg, float& mn, float& alpha) {
  constexpr float C = SCALE * 1.4426950408889634f;
  float pmax = p0[0];
#pragma unroll
  for (int r = 1; r < 16; ++r) pmax = fmaxf(pmax, p0[r]);
#pragma unroll
  for (int r = 0; r < 16; ++r) pmax = fmaxf(pmax, p1[r]);
  { auto rr = __builtin_amdgcn_permlane32_swap(__float_as_uint(pmax), __float_as_uint(pmax), false, false);
    pmax = fmaxf(__uint_as_float(rr[0]), __uint_as_float(rr[1])); }
  if (__builtin_expect(__all(pmax - m_reg <= THR / SCALE), 1)) { mn = m_reg; alpha = 1.f; }
  else { mn = fmaxf(m_reg, pmax); alpha = __builtin_amdgcn_exp2f((m_reg - mn) * C); m_reg = mn; }
  float mnC = -mn * C;
#pragma unroll
  for (int r = 0; r < 16; ++r) p0[r] = fmaf(p0[r], C, mnC);
#pragma unroll
  for (int r = 0; r < 16; ++r) p1[r] = fmaf(p1[r], C, mnC);
#pragma unroll
  for (int r = 0; r < 16; ++r) p0[r] = __builtin_amdgcn_exp2f(p0[r]);
}
__device__ __forceinline__ void finishSM(f32x16& p0, f32x16& p1, float alpha, float& l_reg, bf16x8& pa0, bf16x8& pa1, bf16x8& pa2, bf16x8& pa3) {
#pragma unroll
  for (int r = 0; r < 16; ++r) p1[r] = __builtin_amdgcn_exp2f(p1[r]);
  float ps = 0;
#pragma unroll
  for (int r = 0; r < 16; ++r) ps += p0[r];
#pragma unroll
  for (int r = 0; r < 16; ++r) ps += p1[r];
  { auto rr = __builtin_amdgcn_permlane32_swap(__float_as_uint(ps), __float_as_uint(ps), false, false);
    ps = __uint_as_float(rr[0]) + __uint_as_float(rr[1]); }
  l_reg = l_reg * alpha + ps;
#define PK4(P, BASE, OUT) do { unsigned a0 = cvtpk(P[BASE + 0], P[BASE + 1]), a1 = cvtpk(P[BASE + 2], P[BASE + 3]);   \
    unsigned b0 = cvtpk(P[BASE + 4], P[BASE + 5]), b1 = cvtpk(P[BASE + 6], P[BASE + 7]);                              \
    auto r0 = __builtin_amdgcn_permlane32_swap(a0, b0, false, false); auto r1 = __builtin_amdgcn_permlane32_swap(a1, b1, false, false); \
    u32x4 w = {r0[0], r1[0], r0[1], r1[1]}; OUT = *reinterpret_cast<bf16x8*>(&w); } while (0)
  PK4(p0, 0, pa0); PK4(p0, 8, pa1); PK4(p1, 0, pa2); PK4(p1, 8, pa3);
#undef PK4
}
__device__ __forceinline__ void qkt(f32x16& p0, f32x16& p1, const bf16* Ks, const bf16x8* qr, int r32, int hi) {
  p0 = f32x16{}; p1 = f32x16{};
#pragma unroll
  for (int d0 = 0; d0 < 8; ++d0) { int cb = (d0 * 16 + hi * 8) * 2;
    bf16x8 b0 = *reinterpret_cast<const bf16x8*>((const char*)Ks + KSWZ(r32, cb));
    bf16x8 b1 = *reinterpret_cast<const bf16x8*>((const char*)Ks + KSWZ(32 + r32, cb));
    p0 = __builtin_amdgcn_mfma_f32_32x32x16_bf16(b0, qr[d0], p0, 0, 0, 0);
    p1 = __builtin_amdgcn_mfma_f32_32x32x16_bf16(b1, qr[d0], p1, 0, 0, 0); }
}
__device__ __forceinline__ int v_st(int k, int c) { const int kk = (k & ~0xC) | ((k & 4) << 1) | ((k & 8) >> 1); return ((kk >> 3) * 4 + (c >> 5)) * 512 + ((kk & 7) * 32 + (c & 31)) * 2; }
__device__ __forceinline__ int v_rd_base(int lane) { return ((lane & 3) << 3) | (((lane >> 2) & 3) << 6) | (((lane >> 4) & 1) << 5) | (((lane >> 5) & 1) << 8); }
constexpr int v_rd_off(int d0, int ks, int half) { return d0 * 512 + ks * 4096 + half * 2048; }
template <int OFF> __device__ __forceinline__ s16x4 tr_read(int vb) {
  s16x4 r; asm volatile("ds_read_b64_tr_b16 %0, %1 offset:%2" : "=&v"(r) : "v"(vb), "i"(OFF) : "memory"); return r;
}
template <int D0> __device__ __forceinline__ void pv_one(f32x16& od, int vb, bf16x8 pa0, bf16x8 pa1, bf16x8 pa2, bf16x8 pa3) {
  const s16x4 l0 = tr_read<v_rd_off(D0, 0, 0)>(vb), h0 = tr_read<v_rd_off(D0, 0, 1)>(vb), l1 = tr_read<v_rd_off(D0, 1, 0)>(vb), h1 = tr_read<v_rd_off(D0, 1, 1)>(vb);
  const s16x4 l2 = tr_read<v_rd_off(D0, 2, 0)>(vb), h2 = tr_read<v_rd_off(D0, 2, 1)>(vb), l3 = tr_read<v_rd_off(D0, 3, 0)>(vb), h3 = tr_read<v_rd_off(D0, 3, 1)>(vb);
  asm volatile("s_waitcnt lgkmcnt(0)" ::: "memory"); SBAR();
#define PK(L, H) (bf16x8){L[0], L[1], L[2], L[3], H[0], H[1], H[2], H[3]}
  od = __builtin_amdgcn_mfma_f32_32x32x16_bf16(pa0, PK(l0, h0), od, 0, 0, 0);
  od = __builtin_amdgcn_mfma_f32_32x32x16_bf16(pa1, PK(l1, h1), od, 0, 0, 0);
  od = __builtin_amdgcn_mfma_f32_32x32x16_bf16(pa2, PK(l2, h2), od, 0, 0, 0);
  od = __builtin_amdgcn_mfma_f32_32x32x16_bf16(pa3, PK(l3, h3), od, 0, 0, 0);
#undef PK
}
__device__ __forceinline__ void pv_d0(f32x16* o, int vb, bf16x8 pa0, bf16x8 pa1, bf16x8 pa2, bf16x8 pa3) {
  pv_one<0>(o[0], vb, pa0, pa1, pa2, pa3); pv_one<1>(o[1], vb, pa0, pa1, pa2, pa3); pv_one<2>(o[2], vb, pa0, pa1, pa2, pa3); pv_one<3>(o[3], vb, pa0, pa1, pa2, pa3);
}
typedef int v8i __attribute__((ext_vector_type(8)));
typedef int v4i __attribute__((ext_vector_type(4)));
constexpr size_t SHM_K8 = KVBLK * 128;
#define K8ADDR(row, g) ((row) * 128 + ((((g) ^ ((row) >> 1)) & 7) << 4))
__device__ __forceinline__ void qkt8(f32x16& p0, f32x16& p1, const char* Ks, const v8i& q0, const v8i& q1, int r32, int hi, int sc1) {
  p0 = f32x16{}; p1 = f32x16{};
  const int g0 = 4 * hi;
  { const v4i a00 = *reinterpret_cast<const v4i*>(Ks + K8ADDR(r32, g0)), a01 = *reinterpret_cast<const v4i*>(Ks + K8ADDR(r32, g0 + 1));
    const v4i b00 = *reinterpret_cast<const v4i*>(Ks + K8ADDR(32 + r32, g0)), b01 = *reinterpret_cast<const v4i*>(Ks + K8ADDR(32 + r32, g0 + 1));
    const v8i ka0 = __builtin_shufflevector(a00, a01, 0, 1, 2, 3, 4, 5, 6, 7), kb0 = __builtin_shufflevector(b00, b01, 0, 1, 2, 3, 4, 5, 6, 7);
    asm volatile("s_nop 1\n\tv_mfma_scale_f32_32x32x64_f8f6f4 %0, %1, %2, %0, %3, %3 op_sel_hi:[0,0,0]" : "+v"(p0) : "v"(ka0), "v"(q0), "v"(sc1));
    asm volatile("s_nop 1\n\tv_mfma_scale_f32_32x32x64_f8f6f4 %0, %1, %2, %0, %3, %3 op_sel_hi:[0,0,0]" : "+v"(p1) : "v"(kb0), "v"(q0), "v"(sc1) : "memory"); }
  { const v4i a10 = *reinterpret_cast<const v4i*>(Ks + K8ADDR(r32, g0 + 2)), a11 = *reinterpret_cast<const v4i*>(Ks + K8ADDR(r32, g0 + 3));
    const v4i b10 = *reinterpret_cast<const v4i*>(Ks + K8ADDR(32 + r32, g0 + 2)), b11 = *reinterpret_cast<const v4i*>(Ks + K8ADDR(32 + r32, g0 + 3));
    const v8i ka1 = __builtin_shufflevector(a10, a11, 0, 1, 2, 3, 4, 5, 6, 7), kb1 = __builtin_shufflevector(b10, b11, 0, 1, 2, 3, 4, 5, 6, 7);
    asm volatile("s_nop 1\n\tv_mfma_scale_f32_32x32x64_f8f6f4 %0, %1, %2, %0, %3, %3 op_sel_hi:[0,0,0]" : "+v"(p0) : "v"(ka1), "v"(q1), "v"(sc1));
    asm volatile("s_nop 1\n\tv_mfma_scale_f32_32x32x64_f8f6f4 %0, %1, %2, %0, %3, %3 op_sel_hi:[0,0,0]" : "+v"(p1) : "v"(kb1), "v"(q1), "v"(sc1)); }
  asm volatile("s_nop 15\n\ts_nop 7" : "+v"(p0), "+v"(p1));
}
__device__ __forceinline__ void attn_dense_body(const bf16* __restrict__ Qb, const unsigned char* __restrict__ Kh8, const bf16* __restrict__ Vh, bf16* __restrict__ Ob, int seq, char* lds) {
  constexpr int SDEPTH = 2;
  const int tid = threadIdx.x, wid = tid >> 6, lane = tid & 63, r32 = lane & 31, hi = lane >> 5;
  bf16* V_lds = (bf16*)lds; char* K_lds = lds + 2 * SHM_V;
  float* ws = (float*)(lds + 2 * SHM_V + 2 * SHM_K8) + wid * 64; float* li_l = ws; float* al_l = ws + 32;
  float m_reg = -1e30f, l_reg = 0; f32x16 o[4] = {}; bf16x8 qr[8];
  const bf16* Qw = Qb + (long)(wid * QBLK + r32) * LDQ + hi * 8;
#pragma unroll
  for (int d0 = 0; d0 < 8; ++d0) qr[d0] = *reinterpret_cast<const bf16x8*>(Qw + d0 * 16);
  v8i q8a, q8b; const int sc1 = 0x7f7f7f7f;
  { int w[16];
#pragma unroll
    for (int d0 = 0; d0 < 8; ++d0) { const u32x4 x = *reinterpret_cast<const u32x4*>(&qr[d0]);
      w[2 * d0] = (int)pk4_fp8(bflo(x.x), bfhi(x.x), bflo(x.y), bfhi(x.y)); w[2 * d0 + 1] = (int)pk4_fp8(bflo(x.z), bfhi(x.z), bflo(x.w), bfhi(x.w)); }
    q8a = (v8i){w[0], w[1], w[2], w[3], w[4], w[5], w[6], w[7]}; q8b = (v8i){w[8], w[9], w[10], w[11], w[12], w[13], w[14], w[15]}; }
  const int krow = tid >> 3, kg = tid & 7, kst = K8ADDR(krow, kg);
  const int sr = tid >> 4, sc = (tid & 15) * 8, vst0 = v_st(sr, sc), vst1 = v_st(32 + sr, sc);
  const int vb0 = (int)(uintptr_t)V_lds + v_rd_base(lane);
  struct { bf16x8 vs0, vs1; v4i ks; } sr_[SDEPTH];
#define SLOAD(i, k0) do { sr_[i].vs0 = *reinterpret_cast<const bf16x8*>(&Vh[(long)((k0) + sr) * LDK + sc]); sr_[i].vs1 = *reinterpret_cast<const bf16x8*>(&Vh[(long)((k0) + 32 + sr) * LDK + sc]); \
    sr_[i].ks = *reinterpret_cast<const v4i*>(&Kh8[(long)((k0) + krow) * 256 + kg * 16]); } while (0)
#define SWRITE(b, i) do { *(bf16x8*)((char*)V_lds + (b) * SHM_V + vst0) = sr_[i].vs0;          \
    *(bf16x8*)((char*)V_lds + (b) * SHM_V + vst1) = sr_[i].vs1;                                \
    *(v4i*)(K_lds + (b) * SHM_K8 + kst) = sr_[i].ks; } while (0)
#define SWAIT() do { asm volatile("s_waitcnt vmcnt(3)" ::: "memory"); } while (0)
#define RESC(a) do { if (__any((a) < 1.f)) { if (hi == 0) al_l[r32] = (a); asm volatile("s_waitcnt lgkmcnt(0)" ::: "memory"); \
    _Pragma("unroll") for (int d = 0; d < 4; ++d) _Pragma("unroll") for (int r = 0; r < 16; ++r) o[d][r] *= al_l[crow(r, hi)]; } } while (0)
  f32x16 pA0, pA1, pB0, pB1; float mnA, mnB, alA, alB; bf16x8 pa0, pa1, pa2, pa3; const int NT = seq / KVBLK;
  constexpr int SE = 0, SO = SDEPTH - 1;
  SLOAD(SE, 0); asm volatile("s_waitcnt vmcnt(0)" ::: "memory"); SWRITE(0, SE); __syncthreads();
  qkt8(pA0, pA1, K_lds, q8a, q8b, r32, hi, sc1); partialSM(pA0, pA1, m_reg, mnA, alA);
  SLOAD(SO, KVBLK); if (2 < NT) SLOAD(SE, 2 * KVBLK);
  SWAIT(); SWRITE(1, SO); __syncthreads();
  for (int j = 1; j + 1 < NT; j += 2) {
    SBAR(); qkt8(pB0, pB1, K_lds + SHM_K8, q8a, q8b, r32, hi, sc1);
    finishSM(pA0, pA1, alA, l_reg, pa0, pa1, pa2, pa3); SBAR();
    SLOAD(SO, (j + SDEPTH) * KVBLK); SBAR();
    pv_d0(o, vb0, pa0, pa1, pa2, pa3); partialSM(pB0, pB1, m_reg, mnB, alB);
    __syncthreads(); SWAIT(); SWRITE(0, SE);
    RESC(alB); __syncthreads();
    SBAR(); qkt8(pA0, pA1, K_lds, q8a, q8b, r32, hi, sc1);
    finishSM(pB0, pB1, alB, l_reg, pa0, pa1, pa2, pa3); SBAR();
    if (j + 3 < NT) SLOAD(SE, (j + 1 + SDEPTH) * KVBLK); SBAR();
    pv_d0(o, vb0 + (int)SHM_V, pa0, pa1, pa2, pa3); partialSM(pA0, pA1, m_reg, mnA, alA);
    __syncthreads(); SWAIT(); SWRITE(1, SO);
    RESC(alA); __syncthreads();
  }
  SBAR(); qkt8(pB0, pB1, K_lds + SHM_K8, q8a, q8b, r32, hi, sc1);
  finishSM(pA0, pA1, alA, l_reg, pa0, pa1, pa2, pa3); SBAR();
  pv_d0(o, vb0, pa0, pa1, pa2, pa3); partialSM(pB0, pB1, m_reg, mnB, alB);
  __syncthreads(); RESC(alB);
  finishSM(pB0, pB1, alB, l_reg, pa0, pa1, pa2, pa3); SBAR();
  pv_d0(o, vb0 + (int)SHM_V, pa0, pa1, pa2, pa3);
  if (hi == 0) li_l[r32] = l_reg; asm volatile("s_waitcnt lgkmcnt(0)" ::: "memory");
  float rli[16];
#pragma unroll
  for (int r = 0; r < 16; ++r) rli[r] = __builtin_amdgcn_rcpf(li_l[crow(r, hi)]);
  bf16* Ow = Ob + (long)(wid * QBLK) * LDO;
#pragma unroll
  for (int r = 0; r < 16; ++r) { int orow = crow(r, hi);
#pragma unroll
    for (int d0 = 0; d0 < 4; ++d0) Ow[(long)orow * LDO + d0 * 32 + r32] = (bf16)f2bf(o[d0][r] * rli[r]); }
  __syncthreads();
#undef SLOAD
#undef SWRITE
#undef SWAIT
#undef RESC
}
constexpr float THR8 = 6.f;
#define V8ADDR(d, g) ((d) * 64 + ((((g) ^ ((d) >> 2)) & 3) << 4))
__device__ __forceinline__ void partialSM8(f32x16& p0, f32x16& p1, float& m_reg, float& mn, float& alpha) {
  constexpr float C = SCALE * 1.4426950408889634f;
  float pmax = p0[0];
#pragma unroll
  for (int r = 1; r < 16; ++r) pmax = fmaxf(pmax, p0[r]);
#pragma unroll
  for (int r = 0; r < 16; ++r) pmax = fmaxf(pmax, p1[r]);
  { auto rr = __builtin_amdgcn_permlane32_swap(__float_as_uint(pmax), __float_as_uint(pmax), false, false);
    pmax = fmaxf(__uint_as_float(rr[0]), __uint_as_float(rr[1])); }
  if (__builtin_expect(__all(pmax - m_reg <= THR8 / SCALE), 1)) { mn = m_reg; alpha = 1.f; }
  else { mn = fmaxf(m_reg, pmax); alpha = __builtin_amdgcn_exp2f((m_reg - mn) * C); m_reg = mn; }
  float mnC = -mn * C;
#pragma unroll
  for (int r = 0; r < 16; ++r) p0[r] = fmaf(p0[r], C, mnC);
#pragma unroll
  for (int r = 0; r < 16; ++r) p1[r] = fmaf(p1[r], C, mnC);
#pragma unroll
  for (int r = 0; r < 16; ++r) p0[r] = __builtin_amdgcn_exp2f(p0[r]);
}
__device__ __forceinline__ void finishSM8(f32x16& p0, f32x16& p1, float alpha, float& l_reg, v8i& pa) {
#pragma unroll
  for (int r = 0; r < 16; ++r) p1[r] = __builtin_amdgcn_exp2f(p1[r]);
  float ps = 0;
#pragma unroll
  for (int r = 0; r < 16; ++r) ps += p0[r];
#pragma unroll
  for (int r = 0; r < 16; ++r) ps += p1[r];
  { auto rr = __builtin_amdgcn_permlane32_swap(__float_as_uint(ps), __float_as_uint(ps), false, false);
    ps = __uint_as_float(rr[0]) + __uint_as_float(rr[1]); }
  l_reg = l_reg * alpha + ps;
  pa = (v8i){(int)pk4_fp8(p0[0], p0[1], p0[2], p0[3]), (int)pk4_fp8(p0[4], p0[5], p0[6], p0[7]), (int)pk4_fp8(p0[8], p0[9], p0[10], p0[11]), (int)pk4_fp8(p0[12], p0[13], p0[14], p0[15]),
             (int)pk4_fp8(p1[0], p1[1], p1[2], p1[3]), (int)pk4_fp8(p1[4], p1[5], p1[6], p1[7]), (int)pk4_fp8(p1[8], p1[9], p1[10], p1[11]), (int)pk4_fp8(p1[12], p1[13], p1[14], p1[15])};
}
__device__ __forceinline__ void pv8(f32x16* o, const char* Vs, const v8i& pa, int r32, int hi, int sc1) {
#pragma unroll
  for (int d0 = 0; d0 < 4; ++d0) { const int d = 32 * d0 + r32;
    const v4i x0 = *reinterpret_cast<const v4i*>(Vs + V8ADDR(d, 2 * hi)), x1 = *reinterpret_cast<const v4i*>(Vs + V8ADDR(d, 2 * hi + 1));
    const v8i vb = __builtin_shufflevector(x0, x1, 0, 1, 2, 3, 4, 5, 6, 7);
    asm volatile("s_nop 1\n\tv_mfma_scale_f32_32x32x64_f8f6f4 %0, %1, %2, %0, %3, %3 op_sel_hi:[0,0,0]" : "+v"(o[d0]) : "v"(pa), "v"(vb), "v"(sc1)); }
  asm volatile("s_nop 15\n\ts_nop 7" : "+v"(o[0]), "+v"(o[1]), "+v"(o[2]), "+v"(o[3]));
}
__device__ __forceinline__ void attn_dense_body_pv8(const bf16* __restrict__ Qb, const unsigned char* __restrict__ Kh8, const unsigned char* __restrict__ Vt8, bf16* __restrict__ Ob, int seq, char* lds) {
  constexpr int SDEPTH = 2; constexpr size_t SHM_V8 = 8192;
  const int tid = threadIdx.x, wid = tid >> 6, lane = tid & 63, r32 = lane & 31, hi = lane >> 5;
  char* V_lds = lds; char* K_lds = lds + 2 * SHM_V8;
  float* ws = (float*)(lds + 2 * SHM_V8 + 2 * SHM_K8) + wid * 64; float* li_l = ws; float* al_l = ws + 32;
  float m_reg = -1e30f, l_reg = 0; f32x16 o[4] = {}; bf16x8 qr[8];
  const bf16* Qw = Qb + (long)(wid * QBLK + r32) * LDQ + hi * 8;
#pragma unroll
  for (int d0 = 0; d0 < 8; ++d0) qr[d0] = *reinterpret_cast<const bf16x8*>(Qw + d0 * 16);
  v8i q8a, q8b; const int sc1 = 0x7f7f7f7f;
  { int w[16];
#pragma unroll
    for (int d0 = 0; d0 < 8; ++d0) { const u32x4 x = *reinterpret_cast<const u32x4*>(&qr[d0]);
      w[2 * d0] = (int)pk4_fp8(bflo(x.x), bfhi(x.x), bflo(x.y), bfhi(x.y)); w[2 * d0 + 1] = (int)pk4_fp8(bflo(x.z), bfhi(x.z), bflo(x.w), bfhi(x.w)); }
    q8a = (v8i){w[0], w[1], w[2], w[3], w[4], w[5], w[6], w[7]}; q8b = (v8i){w[8], w[9], w[10], w[11], w[12], w[13], w[14], w[15]}; }
  const int krow = tid >> 3, kg = tid & 7, kst = K8ADDR(krow, kg);
  const int vrow = tid >> 2, vg = tid & 3, vst = V8ADDR(vrow, vg);
  struct { v4i vs, ks; } sr_[SDEPTH];
#define SLOAD(i, k0) do { sr_[i].vs = *reinterpret_cast<const v4i*>(&Vt8[(long)((k0) / KVBLK) * 8192 + tid * 16]); sr_[i].ks = *reinterpret_cast<const v4i*>(&Kh8[(long)((k0) + krow) * 256 + kg * 16]); } while (0)
#define SWRITE(b, i) do { *(v4i*)(V_lds + (b) * SHM_V8 + vst) = sr_[i].vs; *(v4i*)(K_lds + (b) * SHM_K8 + kst) = sr_[i].ks; } while (0)
#define SWAIT() do { asm volatile("s_waitcnt vmcnt(2)" ::: "memory"); } while (0)
#define RESC(a) do { if (__any((a) < 1.f)) { if (hi == 0) al_l[r32] = (a); asm volatile("s_waitcnt lgkmcnt(0)" ::: "memory"); \
    _Pragma("unroll") for (int d = 0; d < 4; ++d) _Pragma("unroll") for (int r = 0; r < 16; ++r) o[d][r] *= al_l[crow(r, hi)]; } } while (0)
  f32x16 pA0, pA1, pB0, pB1; float mnA, mnB, alA, alB; v8i pa; const int NT = seq / KVBLK;
  constexpr int SE = 0, SO = SDEPTH - 1;
  SLOAD(SE, 0); asm volatile("s_waitcnt vmcnt(0)" ::: "memory"); SWRITE(0, SE); __syncthreads();
  qkt8(pA0, pA1, K_lds, q8a, q8b, r32, hi, sc1); partialSM8(pA0, pA1, m_reg, mnA, alA);
  SLOAD(SO, KVBLK); if (2 < NT) SLOAD(SE, 2 * KVBLK);
  SWAIT(); SWRITE(1, SO); __syncthreads();
  for (int j = 1; j + 1 < NT; j += 2) {
    SBAR(); qkt8(pB0, pB1, K_lds + SHM_K8, q8a, q8b, r32, hi, sc1);
    finishSM8(pA0, pA1, alA, l_reg, pa); SBAR();
    SLOAD(SO, (j + SDEPTH) * KVBLK); SBAR();
    pv8(o, V_lds, pa, r32, hi, sc1); partialSM8(pB0, pB1, m_reg, mnB, alB);
    __syncthreads(); SWAIT(); SWRITE(0, SE);
    RESC(alB); __syncthreads();
    SBAR(); qkt8(pA0, pA1, K_lds, q8a, q8b, r32, hi, sc1);
    finishSM8(pB0, pB1, alB, l_reg, pa); SBAR();
    if (j + 3 < NT) SLOAD(SE, (j + 1 + SDEPTH) * KVBLK); SBAR();
    pv8(o, V_lds + SHM_V8, pa, r32, hi, sc1); partialSM8(pA0, pA1, m_reg, mnA, alA);
    __syncthreads(); SWAIT(); SWRITE(1, SO);
    RESC(alA); __syncthreads();
  }
  SBAR(); qkt8(pB0, pB1, K_lds + SHM_K8, q8a, q8b, r32, hi, sc1);
  finishSM8(pA0, pA1, alA, l_reg, pa); SBAR();
  pv8(o, V_lds, pa, r32, hi, sc1); partialSM8(pB0, pB1, m_reg, mnB, alB);
  __syncthreads(); RESC(alB);
  finishSM8(pB0, pB1, alB, l_reg, pa); SBAR();
  pv8(o, V_lds + SHM_V8, pa, r32, hi, sc1);
  if (hi == 0) li_l[r32] = l_reg; asm volatile("s_waitcnt lgkmcnt(0)" ::: "memory");
  float rli[16];
#pragma unroll
  for (int r = 0; r < 16; ++r) rli[r] = __builtin_amdgcn_rcpf(li_l[crow(r, hi)]);
  bf16* Ow = Ob + (long)(wid * QBLK) * LDO;
#pragma unroll
  for (int r = 0; r < 16; ++r) { int orow = crow(r, hi);
#pragma unroll
    for (int d0 = 0; d0 < 4; ++d0) Ow[(long)orow * LDO + d0 * 32 + r32] = (bf16)f2bf(o[d0][r] * rli[r]); }
  __syncthreads();
#undef SLOAD
#undef SWRITE
#undef SWAIT
#undef RESC
}
constexpr float QS8 = SCALE * 1.4426950408889634f * 8.f;
constexpr float THR2 = 8.6f;
__device__ __forceinline__ int cvt4_fp8(float a, float b, float c, float d) { int r; asm("v_cvt_pk_fp8_f32 %0, %1, %2" : "=v"(r) : "v"(a), "v"(b)); asm("v_cvt_pk_fp8_f32 %0, %1, %2 op_sel:[0,0,1]" : "+v"(r) : "v"(c), "v"(d)); return r; }
__device__ __forceinline__ void qkt8m(f32x16& p0, f32x16& p1, const f32x16& mi, const char* Ks, const v8i& q0, const v8i& q1, int r32, int hi, int sc1, int scq) {
  const int g0 = 4 * hi;
  { const v4i a00 = *reinterpret_cast<const v4i*>(Ks + K8ADDR(r32, g0)), a01 = *reinterpret_cast<const v4i*>(Ks + K8ADDR(r32, g0 + 1));
    const v4i b00 = *reinterpret_cast<const v4i*>(Ks + K8ADDR(32 + r32, g0)), b01 = *reinterpret_cast<const v4i*>(Ks + K8ADDR(32 + r32, g0 + 1));
    const v8i ka0 = __builtin_shufflevector(a00, a01, 0, 1, 2, 3, 4, 5, 6, 7), kb0 = __builtin_shufflevector(b00, b01, 0, 1, 2, 3, 4, 5, 6, 7);
    asm volatile("s_nop 1\n\tv_mfma_scale_f32_32x32x64_f8f6f4 %0, %1, %2, %3, %4, %5 op_sel_hi:[0,0,0]" : "=&v"(p0) : "v"(ka0), "v"(q0), "v"(mi), "v"(sc1), "v"(scq));
    asm volatile("s_nop 1\n\tv_mfma_scale_f32_32x32x64_f8f6f4 %0, %1, %2, %3, %4, %5 op_sel_hi:[0,0,0]" : "=&v"(p1) : "v"(kb0), "v"(q0), "v"(mi), "v"(sc1), "v"(scq) : "memory"); }
  { const v4i a10 = *reinterpret_cast<const v4i*>(Ks + K8ADDR(r32, g0 + 2)), a11 = *reinterpret_cast<const v4i*>(Ks + K8ADDR(r32, g0 + 3));
    const v4i b10 = *reinterpret_cast<const v4i*>(Ks + K8ADDR(32 + r32, g0 + 2)), b11 = *reinterpret_cast<const v4i*>(Ks + K8ADDR(32 + r32, g0 + 3));
    const v8i ka1 = __builtin_shufflevector(a10, a11, 0, 1, 2, 3, 4, 5, 6, 7), kb1 = __builtin_shufflevector(b10, b11, 0, 1, 2, 3, 4, 5, 6, 7);
    asm volatile("s_nop 1\n\tv_mfma_scale_f32_32x32x64_f8f6f4 %0, %1, %2, %0, %3, %4 op_sel_hi:[0,0,0]" : "+v"(p0) : "v"(ka1), "v"(q1), "v"(sc1), "v"(scq));
    asm volatile("s_nop 1\n\tv_mfma_scale_f32_32x32x64_f8f6f4 %0, %1, %2, %0, %3, %4 op_sel_hi:[0,0,0]" : "+v"(p1) : "v"(kb1), "v"(q1), "v"(sc1), "v"(scq)); }
}
__device__ __forceinline__ void xdl_pad2(f32x16& a, f32x16& b) { asm volatile("s_nop 15\n\ts_nop 7" : "+v"(a), "+v"(b)); }
template <bool FIRST> __device__ __forceinline__ void partialSM8m(f32x16& p0, f32x16& p1, float& M, f32x16& mi, float& alpha) {
  float pmax = p0[0];
#pragma unroll
  for (int r = 1; r < 16; ++r) pmax = fmaxf(pmax, p0[r]);
#pragma unroll
  for (int r = 0; r < 16; ++r) pmax = fmaxf(pmax, p1[r]);
  { auto rr = __builtin_amdgcn_permlane32_swap(__float_as_uint(pmax), __float_as_uint(pmax), false, false);
    pmax = fmaxf(__uint_as_float(rr[0]), __uint_as_float(rr[1])); }
  if (!FIRST && __builtin_expect(__all(pmax <= THR2), 1)) { alpha = 1.f; }
  else { const float d = FIRST ? pmax : fmaxf(pmax, 0.f); alpha = FIRST ? 1.f : __builtin_amdgcn_exp2f(-d); M += d;
#pragma unroll
    for (int r = 0; r < 16; ++r) { p0[r] -= d; p1[r] -= d; }
    const float nm = -M;
#pragma unroll
    for (int r = 0; r < 16; ++r) mi[r] = nm;
    asm volatile("" : "+v"(mi)); }
#pragma unroll
  for (int r = 0; r < 16; ++r) p0[r] = __builtin_amdgcn_exp2f(p0[r]);
}
__device__ __forceinline__ void finishSM8m(f32x16& p0, f32x16& p1, float alpha, float& l_reg, v8i& pa) {
#pragma unroll
  for (int r = 0; r < 16; ++r) p1[r] = __builtin_amdgcn_exp2f(p1[r]);
  float sa = p0[0], sb = p1[0];
#pragma unroll
  for (int r = 1; r < 16; ++r) { sa += p0[r]; sb += p1[r]; }
  float ps = sa + sb;
  { auto rr = __builtin_amdgcn_permlane32_swap(__float_as_uint(ps), __float_as_uint(ps), false, false);
    ps = __uint_as_float(rr[0]) + __uint_as_float(rr[1]); }
  l_reg = l_reg * alpha + ps;
  pa = (v8i){cvt4_fp8(p0[0], p0[1], p0[2], p0[3]), cvt4_fp8(p0[4], p0[5], p0[6], p0[7]), cvt4_fp8(p0[8], p0[9], p0[10], p0[11]), cvt4_fp8(p0[12], p0[13], p0[14], p0[15]),
             cvt4_fp8(p1[0], p1[1], p1[2], p1[3]), cvt4_fp8(p1[4], p1[5], p1[6], p1[7]), cvt4_fp8(p1[8], p1[9], p1[10], p1[11]), cvt4_fp8(p1[12], p1[13], p1[14], p1[15])};
}
__device__ __forceinline__ void pv8m(f32x16* o, const char* Vs, const v8i& pa, int r32, int hi, int sc1) {
#pragma unroll
  for (int d0 = 0; d0 < 4; ++d0) { const int d = 32 * d0 + r32;
    const v4i x0 = *reinterpret_cast<const v4i*>(Vs + V8ADDR(d, 2 * hi)), x1 = *reinterpret_cast<const v4i*>(Vs + V8ADDR(d, 2 * hi + 1));
    const v8i vb = __builtin_shufflevector(x0, x1, 0, 1, 2, 3, 4, 5, 6, 7);
    asm volatile("s_nop 1\n\tv_mfma_scale_f32_32x32x64_f8f6f4 %0, %1, %2, %0, %3, %3 op_sel_hi:[0,0,0]" : "+v"(o[d0]) : "v"(pa), "v"(vb), "v"(sc1)); }
}
__device__ __forceinline__ void attn_dense_body_m(const bf16* __restrict__ Qb, const unsigned char* __restrict__ Kh8, const unsigned char* __restrict__ Vt8, bf16* __restrict__ Ob, int seq, char* lds) {
  constexpr int SDEPTH = 2; constexpr size_t SHM_V8 = 8192;
  const int tid = threadIdx.x, wid = tid >> 6, lane = tid & 63, r32 = lane & 31, hi = lane >> 5;
  char* V_lds = lds; char* K_lds = lds + 2 * SHM_V8;
  float* ws = (float*)(lds + 2 * SHM_V8 + 2 * SHM_K8) + wid * 64; float* li_l = ws; float* al_l = ws + 32;
  float M = 0.f, l_reg = 0; f32x16 o[4] = {}; f32x16 mi = {}; asm volatile("" : "+v"(mi));
  v8i q8a, q8b; const int sc1 = 0x7f7f7f7f, scq = 0x7c7c7c7c;
  { bf16x8 qr[8]; const bf16* Qw = Qb + (long)(wid * QBLK + r32) * LDQ + hi * 8;
#pragma unroll
    for (int d0 = 0; d0 < 8; ++d0) qr[d0] = *reinterpret_cast<const bf16x8*>(Qw + d0 * 16);
    int w[16];
#pragma unroll
    for (int d0 = 0; d0 < 8; ++d0) { const u32x4 x = *reinterpret_cast<const u32x4*>(&qr[d0]);
      w[2 * d0] = (int)pk4_fp8(bflo(x.x) * QS8, bfhi(x.x) * QS8, bflo(x.y) * QS8, bfhi(x.y) * QS8); w[2 * d0 + 1] = (int)pk4_fp8(bflo(x.z) * QS8, bfhi(x.z) * QS8, bflo(x.w) * QS8, bfhi(x.w) * QS8); }
    q8a = (v8i){w[0], w[1], w[2], w[3], w[4], w[5], w[6], w[7]}; q8b = (v8i){w[8], w[9], w[10], w[11], w[12], w[13], w[14], w[15]}; }
  const int krow = tid >> 3, kg = tid & 7, kst = K8ADDR(krow, kg);
  const int vrow = tid >> 2, vg = tid & 3, vst = V8ADDR(vrow, vg);
  struct { v4i vs, ks; } sr_[SDEPTH];
#define SLOAD(i, k0) do { sr_[i].vs = *reinterpret_cast<const v4i*>(&Vt8[(long)((k0) / KVBLK) * 8192 + tid * 16]); sr_[i].ks = *reinterpret_cast<const v4i*>(&Kh8[(long)((k0) + krow) * 256 + kg * 16]); } while (0)
#define SWRITE(b, i) do { *(v4i*)(V_lds + (b) * SHM_V8 + vst) = sr_[i].vs; *(v4i*)(K_lds + (b) * SHM_K8 + kst) = sr_[i].ks; } while (0)
#define SWAIT() do { asm volatile("s_waitcnt vmcnt(2)" ::: "memory"); } while (0)
#define RESC(a) do { if (__any((a) < 1.f)) { if (hi == 0) al_l[r32] = (a); xdl_pad2(o[0], o[1]); xdl_pad2(o[2], o[3]); asm volatile("s_waitcnt lgkmcnt(0)" ::: "memory"); \
    _Pragma("unroll") for (int d = 0; d < 4; ++d) _Pragma("unroll") for (int r = 0; r < 16; ++r) o[d][r] *= al_l[crow(r, hi)]; } } while (0)
  f32x16 pA0, pA1, pB0, pB1; float alA, alB; v8i pa; const int NT = seq / KVBLK;
  constexpr int SE = 0, SO = SDEPTH - 1;
  SLOAD(SE, 0); asm volatile("s_waitcnt vmcnt(0)" ::: "memory"); SWRITE(0, SE); __syncthreads();
  qkt8m(pA0, pA1, mi, K_lds, q8a, q8b, r32, hi, sc1, scq); xdl_pad2(pA0, pA1); partialSM8m<true>(pA0, pA1, M, mi, alA);
  SLOAD(SO, KVBLK); if (2 < NT) SLOAD(SE, 2 * KVBLK);
  SWAIT(); SWRITE(1, SO); __syncthreads();
  for (int j = 1; j + 1 < NT; j += 2) {
    SBAR(); qkt8m(pB0, pB1, mi, K_lds + SHM_K8, q8a, q8b, r32, hi, sc1, scq);
    finishSM8m(pA0, pA1, alA, l_reg, pa); SBAR();
    SLOAD(SO, (j + SDEPTH) * KVBLK); SBAR();
    pv8m(o, V_lds, pa, r32, hi, sc1); partialSM8m<false>(pB0, pB1, M, mi, alB);
    __syncthreads(); SWAIT(); SWRITE(0, SE);
    RESC(alB); __syncthreads();
    SBAR(); qkt8m(pA0, pA1, mi, K_lds, q8a, q8b, r32, hi, sc1, scq);
    finishSM8m(pB0, pB1, alB, l_reg, pa); SBAR();
    if (j + 3 < NT) SLOAD(SE, (j + 1 + SDEPTH) * KVBLK); SBAR();
    pv8m(o, V_lds + SHM_V8, pa, r32, hi, sc1); partialSM8m<false>(pA0, pA1, M, mi, alA);
    __syncthreads(); SWAIT(); SWRITE(1, SO);
    RESC(alA); __syncthreads();
  }
  SBAR(); qkt8m(pB0, pB1, mi, K_lds + SHM_K8, q8a, q8b, r32, hi, sc1, scq);
  finishSM8m(pA0, pA1, alA, l_reg, pa); SBAR();
  pv8m(o, V_lds, pa, r32, hi, sc1); partialSM8m<false>(pB0, pB1, M, mi, alB);
  __syncthreads(); RESC(alB);
  finishSM8m(pB0, pB1, alB, l_reg, pa); SBAR();
  pv8m(o, V_lds + SHM_V8, pa, r32, hi, sc1);
  if (hi == 0) li_l[r32] = l_reg; asm volatile("s_waitcnt lgkmcnt(0)" ::: "memory");
  xdl_pad2(o[0], o[1]); xdl_pad2(o[2], o[3]);
  float rli[16];
#pragma unroll
  for (int r = 0; r < 16; ++r) rli[r] = __builtin_amdgcn_rcpf(li_l[crow(r, hi)]);
  bf16* Ow = Ob + (long)(wid * QBLK) * LDO;
#pragma unroll
  for (int r = 0; r < 16; ++r) { int orow = crow(r, hi);
#pragma unroll
    for (int d0 = 0; d0 < 4; ++d0) Ow[(long)orow * LDO + d0 * 32 + r32] = (bf16)f2bf(o[d0][r] * rli[r]); }
  __syncthreads();
#undef SLOAD
#undef SWRITE
#undef SWAIT
#undef RESC
}
__device__ __forceinline__ void mfma8_init(f32x16& p, const v8i& a, const v8i& b, const f32x16& c, int sa, int sb) {
  asm volatile("s_nop 1\n\tv_mfma_scale_f32_32x32x64_f8f6f4 %0, %1, %2, %3, %4, %5 op_sel_hi:[0,0,0]" : "=&v"(p) : "v"(a), "v"(b), "v"(c), "v"(sa), "v"(sb)); }
__device__ __forceinline__ void mfma8_acc(f32x16& p, const v8i& a, const v8i& b, int sa, int sb) {
  asm volatile("s_nop 1\n\tv_mfma_scale_f32_32x32x64_f8f6f4 %0, %1, %2, %0, %3, %4 op_sel_hi:[0,0,0]" : "+v"(p) : "v"(a), "v"(b), "v"(sa), "v"(sb)); }
__device__ __forceinline__ void attn_dense_body_i(const bf16* __restrict__ Qb, const unsigned char* __restrict__ Kh8, const unsigned char* __restrict__ Vt8, bf16* __restrict__ Ob, int seq, char* lds) {
  constexpr int SDEPTH = 2; constexpr size_t SHM_V8 = 8192;
  const int tid = threadIdx.x, wid = tid >> 6, lane = tid & 63, r32 = lane & 31, hi = lane >> 5;
  char* V_lds = lds; char* K_lds = lds + 2 * SHM_V8;
  float* ws = (float*)(lds + 2 * SHM_V8 + 2 * SHM_K8) + wid * 64; float* li_l = ws; float* al_l = ws + 32;
  float M = 0.f, l_reg = 0; f32x16 o[4] = {}; f32x16 mi = {}; asm volatile("" : "+v"(mi));
  v8i q8a, q8b; const int sc1 = 0x7f7f7f7f, scq = 0x7c7c7c7c;
  { bf16x8 qr[8]; const bf16* Qw = Qb + (long)(wid * QBLK + r32) * LDQ + hi * 8;
#pragma unroll
    for (int d0 = 0; d0 < 8; ++d0) qr[d0] = *reinterpret_cast<const bf16x8*>(Qw + d0 * 16);
    int w[16];
#pragma unroll
    for (int d0 = 0; d0 < 8; ++d0) { const u32x4 x = *reinterpret_cast<const u32x4*>(&qr[d0]);
      w[2 * d0] = (int)pk4_fp8(bflo(x.x) * QS8, bfhi(x.x) * QS8, bflo(x.y) * QS8, bfhi(x.y) * QS8); w[2 * d0 + 1] = (int)pk4_fp8(bflo(x.z) * QS8, bfhi(x.z) * QS8, bflo(x.w) * QS8, bfhi(x.w) * QS8); }
    q8a = (v8i){w[0], w[1], w[2], w[3], w[4], w[5], w[6], w[7]}; q8b = (v8i){w[8], w[9], w[10], w[11], w[12], w[13], w[14], w[15]}; }
  const int krow = tid >> 3, kg = tid & 7, kst = K8ADDR(krow, kg);
  const int vrow = tid >> 2, vg = tid & 3, vst = V8ADDR(vrow, vg);
  const int g0 = 4 * hi;
  struct { v4i vs, ks; } sr_[SDEPTH];
#define SLOAD(i, k0) do { sr_[i].vs = *reinterpret_cast<const v4i*>(&Vt8[(long)((k0) / KVBLK) * 8192 + tid * 16]); sr_[i].ks = *reinterpret_cast<const v4i*>(&Kh8[(long)((k0) + krow) * 256 + kg * 16]); } while (0)
#define SWRITE(b, i) do { *(v4i*)(V_lds + (b) * SHM_V8 + vst) = sr_[i].vs; *(v4i*)(K_lds + (b) * SHM_K8 + kst) = sr_[i].ks; } while (0)
#define SWAIT() do { asm volatile("s_waitcnt vmcnt(2)" ::: "memory"); } while (0)
#define RESC(a) do { if (__any((a) < 1.f)) { if (hi == 0) al_l[r32] = (a); xdl_pad2(o[0], o[1]); xdl_pad2(o[2], o[3]); asm volatile("s_waitcnt lgkmcnt(0)" ::: "memory"); \
    _Pragma("unroll") for (int d = 0; d < 4; ++d) _Pragma("unroll") for (int r = 0; r < 16; ++r) o[d][r] *= al_l[crow(r, hi)]; } } while (0)
#define KFRAG(D0, D1, KB, G) do { const v4i a0_ = *reinterpret_cast<const v4i*>((KB) + K8ADDR(r32, (G))), a1_ = *reinterpret_cast<const v4i*>((KB) + K8ADDR(r32, (G) + 1));             \
    const v4i b0_ = *reinterpret_cast<const v4i*>((KB) + K8ADDR(32 + r32, (G))), b1_ = *reinterpret_cast<const v4i*>((KB) + K8ADDR(32 + r32, (G) + 1));                                \
    D0 = __builtin_shufflevector(a0_, a1_, 0, 1, 2, 3, 4, 5, 6, 7); D1 = __builtin_shufflevector(b0_, b1_, 0, 1, 2, 3, 4, 5, 6, 7); } while (0)
#define VFRAG(Dv, VB, D0) do { const int d_ = 32 * (D0) + r32; const v4i x0_ = *reinterpret_cast<const v4i*>((VB) + V8ADDR(d_, 2 * hi)), x1_ = *reinterpret_cast<const v4i*>((VB) + V8ADDR(d_, 2 * hi + 1)); \
    Dv = __builtin_shufflevector(x0_, x1_, 0, 1, 2, 3, 4, 5, 6, 7); } while (0)
#define EXPR(P, LO, HI) do { _Pragma("unroll") for (int r = (LO); r < (HI); ++r) P[r] = __builtin_amdgcn_exp2f(P[r]); } while (0)
#define ATT_HALF(PB0, PB1, ALB, PA0, PA1, ALA, KB, VA, LOADSTMT) do {                                                                              \
    v8i ka_, kb_, vf_;                                                                                                                             \
    KFRAG(ka_, kb_, KB, g0); EXPR(PA1, 0, 8);                                                                                                      \
    SBAR(); mfma8_init(PB0, ka_, q8a, mi, sc1, scq); SBAR();                                                                                       \
    EXPR(PA1, 8, 16);                                                                                                                              \
    SBAR(); mfma8_init(PB1, kb_, q8a, mi, sc1, scq); SBAR();                                                                                       \
    KFRAG(ka_, kb_, KB, g0 + 2);                                                                                                                   \
    float sa_ = PA0[0], sb_ = PA0[8];                                                                                                              \
    _Pragma("unroll") for (int r = 1; r < 8; ++r) { sa_ += PA0[r]; sb_ += PA0[8 + r]; }                                                            \
    SBAR(); mfma8_acc(PB0, ka_, q8b, sc1, scq); SBAR();                                                                                            \
    VFRAG(vf_, VA, 0);                                                                                                                             \
    { float sc_ = PA1[0], sd_ = PA1[8];                                                                                                            \
      _Pragma("unroll") for (int r = 1; r < 8; ++r) { sc_ += PA1[r]; sd_ += PA1[8 + r]; }                                                          \
      float ps_ = (sa_ + sb_) + (sc_ + sd_);                                                                                                       \
      auto rr_ = __builtin_amdgcn_permlane32_swap(__float_as_uint(ps_), __float_as_uint(ps_), false, false);                                       \
      l_reg = l_reg * (ALA) + (__uint_as_float(rr_[0]) + __uint_as_float(rr_[1])); }                                                               \
    SBAR(); mfma8_acc(PB1, kb_, q8b, sc1, scq); SBAR();                                                                                            \
    pa = (v8i){cvt4_fp8(PA0[0], PA0[1], PA0[2], PA0[3]), cvt4_fp8(PA0[4], PA0[5], PA0[6], PA0[7]), cvt4_fp8(PA0[8], PA0[9], PA0[10], PA0[11]), cvt4_fp8(PA0[12], PA0[13], PA0[14], PA0[15]), \
               cvt4_fp8(PA1[0], PA1[1], PA1[2], PA1[3]), cvt4_fp8(PA1[4], PA1[5], PA1[6], PA1[7]), cvt4_fp8(PA1[8], PA1[9], PA1[10], PA1[11]), cvt4_fp8(PA1[12], PA1[13], PA1[14], PA1[15])}; \
    SBAR(); mfma8_acc(o[0], pa, vf_, sc1, sc1); SBAR();                                                                                            \
    VFRAG(vf_, VA, 1); LOADSTMT;                                                                                                                   \
    float mx_ = PB0[0];                                                                                                                            \
    _Pragma("unroll") for (int r = 1; r < 16; ++r) mx_ = fmaxf(mx_, PB0[r]);                                                                       \
    SBAR(); mfma8_acc(o[1], pa, vf_, sc1, sc1); SBAR();                                                                                            \
    VFRAG(vf_, VA, 2);                                                                                                                             \
    _Pragma("unroll") for (int r = 0; r < 16; ++r) mx_ = fmaxf(mx_, PB1[r]);                                                                       \
    { auto rr_ = __builtin_amdgcn_permlane32_swap(__float_as_uint(mx_), __float_as_uint(mx_), false, false);                                       \
      mx_ = fmaxf(__uint_as_float(rr_[0]), __uint_as_float(rr_[1])); }                                                                             \
    if (__builtin_expect(__all(mx_ <= THR2), 1)) { ALB = 1.f; }                                                                                    \
    else { const float d_ = fmaxf(mx_, 0.f); ALB = __builtin_amdgcn_exp2f(-d_); M += d_;                                                           \
      _Pragma("unroll") for (int r = 0; r < 16; ++r) { PB0[r] -= d_; PB1[r] -= d_; }                                                               \
      const float nm_ = -M;                                                                                                                        \
      _Pragma("unroll") for (int r = 0; r < 16; ++r) mi[r] = nm_;                                                                                  \
      asm volatile("" : "+v"(mi)); }                                                                                                               \
    SBAR(); mfma8_acc(o[2], pa, vf_, sc1, sc1); SBAR();                                                                                            \
    VFRAG(vf_, VA, 3); EXPR(PB0, 0, 8);                                                                                                            \
    SBAR(); mfma8_acc(o[3], pa, vf_, sc1, sc1); SBAR();                                                                                            \
    EXPR(PB0, 8, 16);                                                                                                                              \
  } while (0)
  f32x16 pA0, pA1, pB0, pB1; float alA, alB; v8i pa; const int NT = seq / KVBLK;
  constexpr int SE = 0, SO = SDEPTH - 1;
  SLOAD(SE, 0); asm volatile("s_waitcnt vmcnt(0)" ::: "memory"); SWRITE(0, SE); __syncthreads();
  qkt8m(pA0, pA1, mi, K_lds, q8a, q8b, r32, hi, sc1, scq); xdl_pad2(pA0, pA1); partialSM8m<true>(pA0, pA1, M, mi, alA);
  SLOAD(SO, KVBLK); if (2 < NT) SLOAD(SE, 2 * KVBLK);
  SWAIT(); SWRITE(1, SO); __syncthreads();
  for (int j = 1; j + 1 < NT; j += 2) {
    ATT_HALF(pB0, pB1, alB, pA0, pA1, alA, K_lds + SHM_K8, V_lds, SLOAD(SO, (j + SDEPTH) * KVBLK));
    __syncthreads(); SWAIT(); SWRITE(0, SE);
    RESC(alB); __syncthreads();
    ATT_HALF(pA0, pA1, alA, pB0, pB1, alB, K_lds, V_lds + SHM_V8, if (j + 3 < NT) SLOAD(SE, (j + 1 + SDEPTH) * KVBLK));
    __syncthreads(); SWAIT(); SWRITE(1, SO);
    RESC(alA); __syncthreads();
  }
  ATT_HALF(pB0, pB1, alB, pA0, pA1, alA, K_lds + SHM_K8, V_lds, (void)0);
  __syncthreads(); RESC(alB);
  finishSM8m(pB0, pB1, alB, l_reg, pa); SBAR();
  pv8m(o, V_lds + SHM_V8, pa, r32, hi, sc1);
  if (hi == 0) li_l[r32] = l_reg; asm volatile("s_waitcnt lgkmcnt(0)" ::: "memory");
  xdl_pad2(o[0], o[1]); xdl_pad2(o[2], o[3]);
  float rli[16];
#pragma unroll
  for (int r = 0; r < 16; ++r) rli[r] = __builtin_amdgcn_rcpf(li_l[crow(r, hi)]);
  bf16* Ow = Ob + (long)(wid * QBLK) * LDO;
#pragma unroll
  for (int r = 0; r < 16; ++r) { int orow = crow(r, hi);
#pragma unroll
    for (int d0 = 0; d0 < 4; ++d0) Ow[(long)orow * LDO + d0 * 32 + r32] = (bf16)f2bf(o[d0][r] * rli[r]); }
  __syncthreads();
#undef SLOAD
#undef SWRITE
#undef SWAIT
#undef RESC
#undef KFRAG
#undef VFRAG
#undef EXPR
#undef ATT_HALF
}
__device__ __forceinline__ void attn_dense_body_d(const bf16* __restrict__ Qb, const unsigned char* __restrict__ Kh8, const unsigned char* __restrict__ Vt8, bf16* __restrict__ Ob, int seq, LAS char* lds) {
  const int tid = threadIdx.x, wid = tid >> 6, lane = tid & 63, r32 = lane & 31, hi = lane >> 5;
  LAS char* K_lds = lds; LAS char* V_lds = lds + 4 * 8192;
  LAS float* ws = (LAS float*)(lds + 8 * 8192) + wid * 64; LAS float* li_l = ws; LAS float* al_l = ws + 32;
  float M = 0.f, l_reg = 0; f32x16 o[4] = {}; f32x16 mi = {}; asm volatile("" : "+v"(mi));
  v8i q8a, q8b; const int sc1 = 0x7f7f7f7f, scq = 0x7c7c7c7c;
  { bf16x8 qr[8]; const bf16* Qw = Qb + (long)(wid * QBLK + r32) * LDQ + hi * 8;
#pragma unroll
    for (int d0 = 0; d0 < 8; ++d0) qr[d0] = *reinterpret_cast<const bf16x8*>(Qw + d0 * 16);
    int w[16];
#pragma unroll
    for (int d0 = 0; d0 < 8; ++d0) { const u32x4 x = *reinterpret_cast<const u32x4*>(&qr[d0]);
      w[2 * d0] = (int)pk4_fp8(bflo(x.x) * QS8, bfhi(x.x) * QS8, bflo(x.y) * QS8, bfhi(x.y) * QS8); w[2 * d0 + 1] = (int)pk4_fp8(bflo(x.z) * QS8, bfhi(x.z) * QS8, bflo(x.w) * QS8, bfhi(x.w) * QS8); }
    q8a = (v8i){w[0], w[1], w[2], w[3], w[4], w[5], w[6], w[7]}; q8b = (v8i){w[8], w[9], w[10], w[11], w[12], w[13], w[14], w[15]}; }
  const int g0 = 4 * hi;
  const int kr = wid * 8 + (lane >> 3), vd = wid * 16 + (lane >> 2);
  const unsigned kgo = (unsigned)kr * 256u + (unsigned)((((lane & 7) ^ (kr >> 1)) & 7) << 4), vgo = (unsigned)vd * 64u + (unsigned)((((lane & 3) ^ (vd >> 2)) & 3) << 4);
#define DMA(blk) do { const int b_ = (blk) & 3; unsigned ko_ = (unsigned)(blk) * 16384u, vo_ = (unsigned)(blk) * 8192u; asm volatile("" : "+s"(ko_), "+s"(vo_));     \
    __builtin_amdgcn_global_load_lds((const unsigned*)(Kh8 + (size_t)(ko_ + kgo)), (LAS unsigned*)(K_lds + b_ * 8192 + wid * 1024), 16, 0, 0);                      \
    __builtin_amdgcn_global_load_lds((const unsigned*)(Vt8 + (size_t)(vo_ + vgo)), (LAS unsigned*)(V_lds + b_ * 8192 + wid * 1024), 16, 0, 0); } while (0)
#define VMW(n) asm volatile("s_waitcnt vmcnt(" #n ")" ::: "memory")
#define BAR() __builtin_amdgcn_s_barrier()
#define RESC(a) do { if (__any((a) < 1.f)) { if (hi == 0) al_l[r32] = (a); xdl_pad2(o[0], o[1]); xdl_pad2(o[2], o[3]); asm volatile("s_waitcnt lgkmcnt(0)" ::: "memory"); \
    _Pragma("unroll") for (int d = 0; d < 4; ++d) _Pragma("unroll") for (int r = 0; r < 16; ++r) o[d][r] *= al_l[crow(r, hi)]; } } while (0)
#define KFRAG(D0, D1, KB, G) do { const v4i a0_ = *reinterpret_cast<const LAS v4i*>((KB) + K8ADDR(r32, (G))), a1_ = *reinterpret_cast<const LAS v4i*>((KB) + K8ADDR(r32, (G) + 1));             \
    const v4i b0_ = *reinterpret_cast<const LAS v4i*>((KB) + K8ADDR(r32, (G)) + 4096), b1_ = *reinterpret_cast<const LAS v4i*>((KB) + K8ADDR(r32, (G) + 1) + 4096);     \
    D0 = __builtin_shufflevector(a0_, a1_, 0, 1, 2, 3, 4, 5, 6, 7); D1 = __builtin_shufflevector(b0_, b1_, 0, 1, 2, 3, 4, 5, 6, 7); } while (0)
#define VFRAG(Dv, VB, D0) do { const v4i x0_ = *reinterpret_cast<const LAS v4i*>((VB) + V8ADDR(r32, 2 * hi) + 2048 * (D0)), x1_ = *reinterpret_cast<const LAS v4i*>((VB) + V8ADDR(r32, 2 * hi + 1) + 2048 * (D0));     \
    Dv = __builtin_shufflevector(x0_, x1_, 0, 1, 2, 3, 4, 5, 6, 7); } while (0)
#define EXPR(P, LO, HI) do { _Pragma("unroll") for (int r = (LO); r < (HI); ++r) P[r] = __builtin_amdgcn_exp2f(P[r]); } while (0)
#define ATT_HALF(PB0, PB1, ALB, PA0, PA1, ALA, KB, VA, LOADSTMT) do {                                                                              \
    v8i ka_, kb_, vf_;                                                                                                                             \
    KFRAG(ka_, kb_, KB, g0); EXPR(PA1, 0, 8);                                                                                                      \
    SBAR(); mfma8_init(PB0, ka_, q8a, mi, sc1, scq); SBAR();                                                                                       \
    EXPR(PA1, 8, 16);                                                                                                                              \
    SBAR(); mfma8_init(PB1, kb_, q8a, mi, sc1, scq); SBAR();                                                                                       \
    KFRAG(ka_, kb_, KB, g0 + 2);                                                                                                                   \
    float sa_ = PA0[0], sb_ = PA0[8];                                                                                                              \
    _Pragma("unroll") for (int r = 1; r < 8; ++r) { sa_ += PA0[r]; sb_ += PA0[8 + r]; }                                                            \
    asm volatile("" : "+v"(sa_), "+v"(sb_));                                                                                                       \
    SBAR(); mfma8_acc(PB0, ka_, q8b, sc1, scq); SBAR();                                                                                            \
    VFRAG(vf_, VA, 0);                                                                                                                             \
    { float sc_ = PA1[0], sd_ = PA1[8];                                                                                                            \
      _Pragma("unroll") for (int r = 1; r < 8; ++r) { sc_ += PA1[r]; sd_ += PA1[8 + r]; }                                                          \
      float ps_ = (sa_ + sb_) + (sc_ + sd_);                                                                                                       \
      auto rr_ = __builtin_amdgcn_permlane32_swap(__float_as_uint(ps_), __float_as_uint(ps_), false, false);                                       \
      l_reg = l_reg * (ALA) + (__uint_as_float(rr_[0]) + __uint_as_float(rr_[1])); }                                                               \
    SBAR(); mfma8_acc(PB1, kb_, q8b, sc1, scq); SBAR();                                                                                            \
    pa = (v8i){cvt4_fp8(PA0[0], PA0[1], PA0[2], PA0[3]), cvt4_fp8(PA0[4], PA0[5], PA0[6], PA0[7]), cvt4_fp8(PA0[8], PA0[9], PA0[10], PA0[11]), cvt4_fp8(PA0[12], PA0[13], PA0[14], PA0[15]), \
               cvt4_fp8(PA1[0], PA1[1], PA1[2], PA1[3]), cvt4_fp8(PA1[4], PA1[5], PA1[6], PA1[7]), cvt4_fp8(PA1[8], PA1[9], PA1[10], PA1[11]), cvt4_fp8(PA1[12], PA1[13], PA1[14], PA1[15])}; \
    SBAR(); mfma8_acc(o[0], pa, vf_, sc1, sc1); SBAR();                                                                                            \
    VFRAG(vf_, VA, 1); LOADSTMT;                                                                                                                   \
    float mx_ = PB0[0];                                                                                                                            \
    _Pragma("unroll") for (int r = 1; r < 16; ++r) mx_ = fmaxf(mx_, PB0[r]);                                                                       \
    SBAR(); mfma8_acc(o[1], pa, vf_, sc1, sc1); SBAR();                                                                                            \
    VFRAG(vf_, VA, 2);                                                                                                                             \
    _Pragma("unroll") for (int r = 0; r < 16; ++r) mx_ = fmaxf(mx_, PB1[r]);                                                                       \
    { auto rr_ = __builtin_amdgcn_permlane32_swap(__float_as_uint(mx_), __float_as_uint(mx_), false, false);                                       \
      mx_ = fmaxf(__uint_as_float(rr_[0]), __uint_as_float(rr_[1])); }                                                                             \
    if (__builtin_expect(__all(mx_ <= THR2), 1)) { ALB = 1.f; }                                                                                    \
    else { const float d_ = fmaxf(mx_, 0.f); ALB = __builtin_amdgcn_exp2f(-d_); M += d_;                                                           \
      _Pragma("unroll") for (int r = 0; r < 16; ++r) { PB0[r] -= d_; PB1[r] -= d_; }                                                               \
      const float nm_ = -M;                                                                                                                        \
      _Pragma("unroll") for (int r = 0; r < 16; ++r) mi[r] = nm_;                                                                                  \
      asm volatile("" : "+v"(mi)); }                                                                                                               \
    SBAR(); mfma8_acc(o[2], pa, vf_, sc1, sc1); SBAR();                                                                                            \
    VFRAG(vf_, VA, 3); EXPR(PB0, 0, 8); asm volatile("" : "+v"(PB0));       \
    SBAR(); mfma8_acc(o[3], pa, vf_, sc1, sc1); SBAR();                                                                                            \
    EXPR(PB0, 8, 16); asm volatile("" : "+v"(PB0));                                                                                                \
  } while (0)
  f32x16 pA0, pA1, pB0, pB1; float alA, alB; v8i pa; const int NT = seq / KVBLK;
  DMA(0); DMA(1); VMW(2); BAR();
  { v8i ka_, kb_; KFRAG(ka_, kb_, K_lds, g0); mfma8_init(pA0, ka_, q8a, mi, sc1, scq); mfma8_init(pA1, kb_, q8a, mi, sc1, scq);
    KFRAG(ka_, kb_, K_lds, g0 + 2); mfma8_acc(pA0, ka_, q8b, sc1, scq); mfma8_acc(pA1, kb_, q8b, sc1, scq); }
  xdl_pad2(pA0, pA1); partialSM8m<true>(pA0, pA1, M, mi, alA);
  DMA(2); VMW(2); BAR();
  for (int j = 1; j + 1 < NT; j += 2) {
    DMA(j + 2);
    ATT_HALF(pB0, pB1, alB, pA0, pA1, alA, K_lds + (j & 3) * 8192, V_lds + ((j - 1) & 3) * 8192, (void)0);
    VMW(2); BAR(); RESC(alB);
    const bool more = j + 3 < NT;
    if (more) DMA(j + 3);
    ATT_HALF(pA0, pA1, alA, pB0, pB1, alB, K_lds + ((j + 1) & 3) * 8192, V_lds + (j & 3) * 8192, (void)0);
    if (more) VMW(2); else VMW(0);
    BAR(); RESC(alA);
  }
  ATT_HALF(pB0, pB1, alB, pA0, pA1, alA, K_lds + ((NT - 1) & 3) * 8192, V_lds + ((NT - 2) & 3) * 8192, (void)0);
  RESC(alB);
  { LAS char* Vb = V_lds + ((NT - 1) & 3) * 8192; v8i vf_;
    EXPR(pB1, 0, 16);
    float sa_ = pB0[0], sb_ = pB1[0];
#pragma unroll
    for (int r = 1; r < 16; ++r) { sa_ += pB0[r]; sb_ += pB1[r]; }
    float ps_ = sa_ + sb_;
    auto rr_ = __builtin_amdgcn_permlane32_swap(__float_as_uint(ps_), __float_as_uint(ps_), false, false);
    l_reg = l_reg * alB + (__uint_as_float(rr_[0]) + __uint_as_float(rr_[1]));
    pa = (v8i){cvt4_fp8(pB0[0], pB0[1], pB0[2], pB0[3]), cvt4_fp8(pB0[4], pB0[5], pB0[6], pB0[7]), cvt4_fp8(pB0[8], pB0[9], pB0[10], pB0[11]), cvt4_fp8(pB0[12], pB0[13], pB0[14], pB0[15]),
               cvt4_fp8(pB1[0], pB1[1], pB1[2], pB1[3]), cvt4_fp8(pB1[4], pB1[5], pB1[6], pB1[7]), cvt4_fp8(pB1[8], pB1[9], pB1[10], pB1[11]), cvt4_fp8(pB1[12], pB1[13], pB1[14], pB1[15])};
#pragma unroll
    for (int d0 = 0; d0 < 4; ++d0) { VFRAG(vf_, Vb, d0); mfma8_acc(o[d0], pa, vf_, sc1, sc1); } }
  if (hi == 0) li_l[r32] = l_reg; asm volatile("s_waitcnt lgkmcnt(0)" ::: "memory");
  xdl_pad2(o[0], o[1]); xdl_pad2(o[2], o[3]);
  float rli[16];
#pragma unroll
  for (int r = 0; r < 16; ++r) rli[r] = __builtin_amdgcn_rcpf(li_l[crow(r, hi)]);
  bf16* Ow = Ob + (long)(wid * QBLK) * LDO;
#pragma unroll
  for (int r = 0; r < 16; ++r) { int orow = crow(r, hi);
#pragma unroll
    for (int d0 = 0; d0 < 4; ++d0) Ow[(long)orow * LDO + d0 * 32 + r32] = (bf16)f2bf(o[d0][r] * rli[r]); }
  BAR();
#undef DMA
#undef VMW
#undef BAR
#undef RESC
#undef KFRAG
#undef VFRAG
#undef EXPR
#undef ATT_HALF
}
}

__device__ __forceinline__ void ph_norm3(Frame& F) {
    unsigned char* ar = F.ws + WS_ARENA;
    LAS float* RT = (LAS float*)(F.lds + 3 * 8192);
    LAS int* HIST = (LAS int*)(F.lds + 11 * 8192);
    __syncthreads();
    for (int i = F.tid; i < 2048; i += NTHR) { PV(0)[i] = modp(F, 1, 0, 2)[i] * inp(I_NORMS)[(4 + 1) * 2048 + i]; PV(1)[i] = inp(I_NORMS)[(4 + 2) * 2048 + i] * (1.f + modp(F, 1, 0, 4)[i]); PV(2)[i] = modp(F, 1, 0, 3)[i]; }
    for (int i = F.tid; i < 2048 * 8; i += NTHR) RT[(i & 7) * 2048 + (i >> 3)] = inp(I_ROUTER)[i];
    __syncthreads();
    const bf16* YO = (const bf16*)(ar + B_YO1); bf16* V1 = (bf16*)(ar + B_V1); bf16* HR = (bf16*)(F.ws + WS_HRES) + (size_t)CTX * D;
    int* RE = (int*)(ar + B_RE); float* RG = (float*)(ar + B_RG); int* CNT = (int*)(ar + B_CNT);
    for (int blk = blockIdx.x; blk < SEQ / 64; blk += F.G) {
        if (F.tid < 8) HIST[F.tid] = 0;
        __syncthreads();
        for (int rr = 0; rr < 8; ++rr) { const int t = blk * 64 + F.wave * 8 + rr; f32x4 y[8], h[8];
            ld_row_bf16(YO + (size_t)t * D, F.lane, y); ld_row_bf16(HR + (size_t)t * D, F.lane, h);
            const float ry = 1.f / sqrtf(row_sumsq(y) * (1.f / D) + EPS);
#pragma unroll
            for (int j = 0; j < 8; ++j) h[j] = h[j] + y[j] * ry * ldp(PV(0), F.lane, j);
            st_row_bf16(HR + (size_t)t * D, F.lane, h);
            const float rh = 1.f / sqrtf(row_sumsq(h) * (1.f / D) + EPS);
#pragma unroll
            for (int j = 0; j < 8; ++j) y[j] = h[j] * rh * ldp(PV(1), F.lane, j) + ldp(PV(2), F.lane, j);
            { unsigned char* V8 = (unsigned char*)V1 + (size_t)t * D;
#pragma unroll
              for (int j = 0; j < 8; ++j) *(GAS unsigned*)(V8 + 4 * F.lane + 256 * j) = pk4_fp8(y[j][0], y[j][1], y[j][2], y[j][3]); }
            float lg[8];
#pragma unroll
            for (int e = 0; e < 8; ++e) { float s = 0.f;
#pragma unroll
                for (int j = 0; j < 8; ++j) { const f32x4 w = ldp(RT + e * 2048, F.lane, j); s += (y[j][0] * w[0] + y[j][1] * w[1]) + (y[j][2] * w[2] + y[j][3] * w[3]); }
                lg[e] = wave_sum(s) + inp(I_ROUTERB)[e]; }
            if (F.lane == 0) { int e0 = 0; float v0 = lg[0];
#pragma unroll
                for (int e = 1; e < 8; ++e) if (lg[e] > v0) { v0 = lg[e]; e0 = e; }
                int e1 = -1; float v1 = -3.0e38f;
#pragma unroll
                for (int e = 0; e < 8; ++e) if (e != e0 && lg[e] > v1) { v1 = lg[e]; e1 = e; }
                const float g0 = 1.f / (1.f + __expf(v1 - v0));
                RE[2 * t] = e0; RE[2 * t + 1] = e1; RG[2 * t] = g0; RG[2 * t + 1] = 1.f - g0;
                __hip_atomic_fetch_add((int*)(HIST + e0), 1, __ATOMIC_RELAXED, __HIP_MEMORY_SCOPE_WORKGROUP); __hip_atomic_fetch_add((int*)(HIST + e1), 1, __ATOMIC_RELAXED, __HIP_MEMORY_SCOPE_WORKGROUP); }
        }
        __syncthreads();
        if (F.tid < 8) CNT[blk * 8 + F.tid] = HIST[F.tid];
        __syncthreads();
    }
}
__device__ __forceinline__ void ph_route(Frame& F) {
    unsigned char* ar = F.ws + WS_ARENA;
    LAS int* TOT = (LAS int*)(F.lds); LAS int* PRE = TOT + 8; LAS int* BASE = TOT + 16; LAS int* POS = TOT + 32;
    const int* CNT = (const int*)(ar + B_CNT); const int* RE = (const int*)(ar + B_RE); int* SLOT = (int*)(ar + B_SLOT); int* TILE = (int*)(ar + B_TILE);
    const bf16* V1 = (const bf16*)(ar + B_V1); unsigned char* VG = ar + B_VG;
    for (int blk = blockIdx.x; blk < SEQ / 64; blk += F.G) {
        __syncthreads();
        { const int e = F.wave; int tot = 0, pre = 0;
          for (int q = 0; q < 4; ++q) { const int b = 4 * F.lane + q; const int cv = CNT[b * 8 + e]; tot += cv; pre += (b < blk) ? cv : 0; }
#pragma unroll
          for (int o = 1; o < 64; o <<= 1) { tot += __shfl_xor(tot, o); pre += __shfl_xor(pre, o); }
          if (F.lane == 0) { TOT[e] = tot; PRE[e] = pre; } }
        __syncthreads();
        if (F.tid == 0) { int b = 0; for (int e = 0; e < 8; ++e) { BASE[e] = b; b += (TOT[e] + 255) / 256 * 256; } BASE[8] = b; }
        __syncthreads();
        if (F.wave == 0) { const int t = blk * 64 + F.lane; const int e0 = RE[2 * t], e1 = RE[2 * t + 1]; int p0 = 0, p1 = 0;
            const unsigned long long lt = (1ull << F.lane) - 1ull;
#pragma unroll
            for (int e = 0; e < 8; ++e) { const unsigned long long m0 = __ballot(e0 == e), m1 = __ballot(e1 == e); const int rk = __popcll(m0 & lt) + __popcll(m1 & lt);
                if (e0 == e) p0 = BASE[e] + PRE[e] + rk; if (e1 == e) p1 = BASE[e] + PRE[e] + rk; }
            SLOT[2 * t] = p0; SLOT[2 * t + 1] = p1; POS[2 * F.lane] = p0; POS[2 * F.lane + 1] = p1; }
        __syncthreads();
        for (int idx = F.tid; idx < 128 * 128; idx += NTHR) { const int ri = idx >> 7, seg = idx & 127;
            *(GAS v4u*)(VG + (size_t)POS[ri] * D + seg * 16) = *(const GAS v4u*)((const unsigned char*)V1 + (size_t)(blk * 64 + (ri >> 1)) * D + seg * 16); }
        if (blk < 8) { const int e = blk, r0 = BASE[e] + TOT[e], r1 = BASE[e + 1];
            for (int idx = F.tid; idx < (r1 - r0) * 128; idx += NTHR) *(GAS v4u*)(VG + (size_t)(r0 + (idx >> 7)) * D + (idx & 127) * 16) = (v4u){0u, 0u, 0u, 0u}; }
        if (blk == 0 && F.tid == 0) { int nt = 0; for (int e = 0; e < 8; ++e) { const int n = (BASE[e + 1] - BASE[e]) / 256; for (int q = 0; q < n; ++q) TILE[1 + nt++] = e; } TILE[0] = nt; }
    }
}
__device__ __forceinline__ void ph_norm4(Frame& F, float* out) {
    unsigned char* ar = F.ws + WS_ARENA;
    __syncthreads();
    for (int i = F.tid; i < 2048; i += NTHR) PV(0)[i] = modp(F, 1, 0, 5)[i] * inp(I_NORMS)[(4 + 3) * 2048 + i];
    __syncthreads();
    const bf16* FS = (const bf16*)(ar + B_FS); const bf16* HR = (const bf16*)(F.ws + WS_HRES) + (size_t)CTX * D; const int* SLOT = (const int*)(ar + B_SLOT); const float* RG = (const float*)(ar + B_RG);
    const int gw = F.vcu * NWAVES + F.wave, NGW = F.G * NWAVES;
    for (int t = gw; t < SEQ; t += NGW) { f32x4 a[8], b[8], h[8]; const int p0 = SLOT[2 * t], p1 = SLOT[2 * t + 1]; const float g0 = RG[2 * t], g1 = RG[2 * t + 1];
        const float* PART = (const float*)(ar + B_VG); constexpr size_t PSTR = (size_t)MOE_SPLIT_TILES * 256 * D;
        if (p0 < MOE_MAIN_TILES * 256) ld_row_bf16(FS + (size_t)p0 * D, F.lane, a);
        else { const float* pp = PART + (size_t)(p0 - MOE_MAIN_TILES * 256) * D; f32x4 q1[8], q2[8], q3[8]; ld_row_f32(pp, F.lane, a); ld_row_f32(pp + PSTR, F.lane, q1); ld_row_f32(pp + 2 * PSTR, F.lane, q2); ld_row_f32(pp + 3 * PSTR, F.lane, q3);
#pragma unroll
            for (int j = 0; j < 8; ++j) a[j] = (a[j] + q1[j]) + (q2[j] + q3[j]); }
        if (p1 < MOE_MAIN_TILES * 256) ld_row_bf16(FS + (size_t)p1 * D, F.lane, b);
        else { const float* pp = PART + (size_t)(p1 - MOE_MAIN_TILES * 256) * D; f32x4 q1[8], q2[8], q3[8]; ld_row_f32(pp, F.lane, b); ld_row_f32(pp + PSTR, F.lane, q1); ld_row_f32(pp + 2 * PSTR, F.lane, q2); ld_row_f32(pp + 3 * PSTR, F.lane, q3);
#pragma unroll
            for (int j = 0; j < 8; ++j) b[j] = (b[j] + q1[j]) + (q2[j] + q3[j]); }
        ld_row_bf16(HR + (size_t)t * D, F.lane, h);
#pragma unroll
        for (int j = 0; j < 8; ++j) a[j] = a[j] * g0 + b[j] * g1;
        const float rf = 1.f / sqrtf(row_sumsq(a) * (1.f / D) + EPS);
#pragma unroll
        for (int j = 0; j < 8; ++j) h[j] = h[j] + a[j] * rf * ldp(PV(0), F.lane, j);
        st_row_f32(out + (size_t)t * D, F.lane, h); }
}

struct EpiGateUp8 { static constexpr bool PERM = true; unsigned char* HID; int ldc; float is;
    __device__ __forceinline__ void operator()(AccRef acc, const Unit& u, int wr, int wc, int fr, int fq) const { EPI_ROWS(u); const int col0 = u.pn * 128 + wc * 32 + 8 * fq; const float c1 = -1.4426950408889634f * is, kk = is * is * MOE_HSC;
#pragma unroll
        for (int ai = 0; ai < 2; ++ai)
#pragma unroll
            for (int m = 0; m < 4; ++m) { const int row = row0 + ai * 128 + m * 16; float a[4], b[4];
#pragma unroll
                for (int q = 0; q < 4; ++q) { a[q] = __builtin_amdgcn_fmed3f(swiglu_fast(acc[ai][0][m][0][q], acc[ai][1][m][0][q], c1, kk), -448.f, 448.f);
                                              b[q] = __builtin_amdgcn_fmed3f(swiglu_fast(acc[ai][0][m][1][q], acc[ai][1][m][1][q], c1, kk), -448.f, 448.f); }
                v2u o; o.x = pk4_fp8(a[0], a[1], a[2], a[3]); o.y = pk4_fp8(b[0], b[1], b[2], b[3]);
                *(GAS v2u*)(HID + (size_t)row * ldc + col0) = o; } } };
struct EpiPlainSc { static constexpr bool PERM = true; bf16* O; int ldc; float sc;
    __device__ __forceinline__ void operator()(AccRef acc, const Unit& u, int wr, int wc, int fr, int fq) const { EPI_ROWS(u); const int col0 = u.pn * 256 + wc * 32 + 8 * fq;
#pragma unroll
        for (int ai = 0; ai < 2; ++ai)
#pragma unroll
            for (int m = 0; m < 4; ++m) { bf16* rp = O + (size_t)(row0 + ai * 128 + m * 16) * ldc + col0;
#pragma unroll
                for (int bj = 0; bj < 2; ++bj) *(GAS u32x4*)(rp + bj * 128) = pack8(acc[ai][bj][m][0] * sc, acc[ai][bj][m][1] * sc); } } };

struct EpiPart { static constexpr bool PERM = false; float* P; int pm0; float sc;
    __device__ __forceinline__ void operator()(AccRef acc, const Unit& u, int wr, int wc, int fr, int fq) const { const int row0 = (u.pm - pm0) * 256 + wr * 64 + fr, col0 = u.pn * 256 + wc * 32 + 4 * fq;
        float* base = P + (size_t)u.bz * ((size_t)MOE_SPLIT_TILES * 256 * D);
#pragma unroll
        for (int ai = 0; ai < 2; ++ai)
#pragma unroll
            for (int m = 0; m < 4; ++m) { float* rp = base + (size_t)(row0 + ai * 128 + m * 16) * D + col0;
#pragma unroll
                for (int bj = 0; bj < 2; ++bj)
#pragma unroll
                    for (int n = 0; n < 2; ++n) *(GAS f32x4*)(rp + bj * 128 + n * 16) = acc[ai][bj][m][n] * sc; } } };

enum { PH_PRO = 0, PH_N0, PH_WINE, PH_POOLD, PH_SCAN, PH_S5Y, PH_GLU, PH_WOUTE, PH_N1, PH_FFNU, PH_FFND, PH_N2,
       PH_WINO, PH_PREP, PH_GLA1, PH_GLA2, PH_GLA3, PH_ATT, PH_WOUTO, PH_N3, PH_ROUTE, PH_MOEU, PH_MOED, PH_N4, NPH };
constexpr int PH_EMIT = 100;
struct Args { const float* in[N_IN]; float* out; unsigned char* ws; int ph_lo, ph_hi, li, pad; };

__global__ void __launch_bounds__(NTHR, 2) mk_fwd(Args args) {
    extern __shared__ __attribute__((aligned(16))) unsigned char lds[];
    Frame F;
    F.lds = (LAS unsigned char*)lds; F.MISC = (volatile LAS unsigned*)(F.lds + MISC_OFF);
    F.tid = threadIdx.x; F.lane = F.tid & 63; F.wave = __builtin_amdgcn_readfirstlane(F.tid >> 6);
    F.G = gridDim.x; { const int bx = blockIdx.x; F.vcu = (F.G % 8 == 0) ? (bx % 8) * (F.G / 8) + bx / 8 : bx; }
    F.ws = karg_ws(); F.ctl = (gu32*)(F.ws + WS_CTL);
    for (int u = F.tid; u < (LDS_BYTES - LDSCTL_OFF) / 4; u += NTHR) ((LAS unsigned*)(F.lds + LDSCTL_OFF))[u] = 0u;
    __syncthreads();
    XcdBarrier bar = xcd_barrier_post((unsigned*)(F.ctl + CW_BAR) + (karg_i(2) & 7) * XCD_BAR_WORDS, F.MISC + 8);
    const int lo = karg_i(0), hi = karg_i(1);
#define IN(k) (lo <= (k) && (k) < hi)
#define SEAM(k) do { if (IN(k) && IN((k) + 1)) xcd_barrier(bar); } while (0)
    PG8_LAS unsigned char* ring = (PG8_LAS unsigned char*)(F.lds + RING_OFF);
    unsigned char* ar = F.ws + WS_ARENA;
    const int bid = (int)blockIdx.x;

    if (lo == PH_EMIT) { ph_emit(F, karg_out()); return; }

    if (IN(PH_PRO)) { p0_prologue(F); } SEAM(PH_PRO);
    if (IN(PH_N0)) { for (int it = bid; it < S5G * 8; it += F.G) { s5_small_tables(F, it >> 3); s5_stage_b(F, it >> 3, it & 7); } ph_norm0(F); } SEAM(PH_N0);
    if (IN(PH_WINE)) {
        pg8::Gemm g{(const bf16*)(ar + A_U), (const bf16*)(F.ws + WS_WINE), D, D, D};
        pg8::PlainSched S; S.o.init(T / 256, D / 256, 1, F.G, bid); S.astr = (size_t)256 * D * 2; S.bstr = (size_t)256 * D * 2; S.zA = 0; S.zB = 0;
        EpiWinE E{(bf16*)(ar + A_ZP), (bf16*)(ar + A_AS5)};
        pg8::gemm_phase(ring, g, S, E);
        conv_work(F, 0, fill_quota(S.o.nwg, F.G, bid, 6));
    } SEAM(PH_WINE);
    if (IN(PH_POOLD)) {
        ph_pooldiff(F);
        __syncthreads();
        pg8::Gemm g{(const bf16*)(ar + A_AS5), (const bf16*)(ar + A_M1T), S5K, 1024, 1024};
        pg8::PlainSched S; S.o.init(S5ROWS / 256, 1, S5G, F.G, bid); S.astr = (size_t)256 * S5K * 2; S.bstr = 0; S.zA = (size_t)S5ROWS * S5K * 2; S.zB = (size_t)256 * 1024 * 2;
        EpiSloc E{(float*)(ar + A_SLOC)};
        pg8::gemm_phase(ring, g, S, E);
        conv_work(F, 0, fill_quota(S.o.nwg, F.G, bid, 3));
    } SEAM(PH_POOLD);
    if (IN(PH_SCAN)) {
        ph_s5scan(F);
        __syncthreads();
        pg8::Gemm g{(const bf16*)(ar + A_DP), (const bf16*)(F.ws + WS_WPOOL), WPOOL, PG, PG};
        pg8::PlainSched S; S.o.init(T / 256, 2, 4, F.G, bid); S.astr = (size_t)256 * WPOOL * 2; S.bstr = (size_t)256 * PG * 2; S.zA = (size_t)PG * 2; S.zB = (size_t)512 * PG * 2;
        EpiPool E{(bf16*)(ar + A_YMIX), inp(I_EPOOLS)};
        pg8::gemm_phase(ring, g, S, E);
        conv_work(F, 0, fill_quota(S.o.nwg, F.G, bid, 1));
    } SEAM(PH_SCAN);
    if (IN(PH_S5Y)) {
        pg8::Gemm g{(const bf16*)(ar + A_AS5), (const bf16*)(ar + A_K3T), S5K, S5K, S5K};
        pg8::PlainSched S; S.o.init(S5ROWS / 256, 4, S5G, F.G, bid); S.astr = (size_t)256 * S5K * 2; S.bstr = (size_t)256 * S5K * 2; S.zA = (size_t)S5ROWS * S5K * 2; S.zB = (size_t)1024 * S5K * 2;
        EpiS5Y E{(const bf16*)(ar + A_AS5), inp(I_S5D), (bf16*)(ar + A_YG)};
        pg8::gemm_phase(ring, g, S, E);
    } SEAM(PH_S5Y);
    if (IN(PH_GLU)) {
        pg8::Gemm g{(const bf16*)(ar + A_YG), (const bf16*)(F.ws + WS_WGLU), WS5, WS5, WS5};
        pg8::PlainSched S; S.o.init(T / 256, 2, 1, F.G, bid); S.astr = (size_t)256 * WS5 * 2; S.bstr = (size_t)256 * WS5 * 2; S.zA = 0; S.zB = 0;
        EpiGlu E{(const bf16*)(ar + A_YG), (bf16*)(ar + A_YMIX)};
        pg8::gemm_phase(ring, g, S, E);
        conv_work(F, 0, fill_quota(S.o.nwg, F.G, bid, 2));
    } SEAM(PH_GLU);
    if (IN(PH_WOUTE)) {
        pg8::Gemm g{(const bf16*)(ar + A_YMIX), (const bf16*)(F.ws + WS_WOUTE), D, D, D};
        pg8::PlainSched S; S.o.init(T / 256, D / 256, 1, F.G, bid); S.astr = (size_t)256 * D * 2; S.bstr = (size_t)256 * D * 2; S.zA = 0; S.zB = 0;
        EpiPlain E{(bf16*)(ar + A_YO), D};
        pg8::gemm_phase(ring, g, S, E);
        conv_work(F, 0, fill_quota(S.o.nwg, F.G, bid, 6));
    } SEAM(PH_WOUTE);
    if (IN(PH_N1)) { ph_norm1(F); conv_work(F, CQ_F2, 0); } SEAM(PH_N1);
    if (IN(PH_FFNU)) {
#if FFN_FP8 == 1
        pg8::Gemm g{(const bf16*)(ar + A_V), (const bf16*)(F.ws + WS_WGU), D / 2, D / 2, D / 2};
        pg8::PlainSched S; S.o.init(T / 256, 14336 / 256, 1, F.G, bid); S.astr = (size_t)256 * D; S.bstr = (size_t)256 * D; S.zA = 0; S.zB = 0;
        EpiGateUp8 E{ar + A_HID, DFF, 1.f / MOE_WSC_GU};
        pg8::gemm_phase<EpiGateUp8, pg8::PlainSched, true>(ring, g, S, E);
#elif FFN_FP8 == 2 && FFNU_K1 < 2048
        constexpr int KEQ = FFNU_K1 + (2048 - FFNU_K1) / 2;
        static_assert(FFNU_K1 % 128 == 0 && (2048 - FFNU_K1) % 256 == 0 && KEQ % 128 == 0 && FFNU_K1 % 256 == 0, "mixed-precision split");
        pg8::Gemm g{(const bf16*)(ar + A_V), (const bf16*)(F.ws + WS_WGU), KEQ, KEQ, KEQ};
        pg8::PlainSched S; S.o.init(T / 256, 14336 / 256, 1, F.G, bid); S.astr = (size_t)256 * KEQ * 2; S.bstr = (size_t)256 * KEQ * 2; S.zA = 0; S.zB = 0;
        EpiGateUp8 E{ar + A_HID, DFF, 1.f};
        pg8::gemm_phase<EpiGateUp8, pg8::PlainSched, false, FFNU_K1 / 64>(ring, g, S, E);
#elif FFN_FP8 == 2
        pg8::Gemm g{(const bf16*)(ar + A_V), (const bf16*)(F.ws + WS_WGU), D, D, D};
        pg8::PlainSched S; S.o.init(T / 256, 14336 / 256, 1, F.G, bid); S.astr = (size_t)256 * D * 2; S.bstr = (size_t)256 * D * 2; S.zA = 0; S.zB = 0;
        EpiGateUp8 E{ar + A_HID, DFF, 1.f};
        pg8::gemm_phase(ring, g, S, E);
#else
        pg8::Gemm g{(const bf16*)(ar + A_V), (const bf16*)(F.ws + WS_WGU), D, D, D};
        pg8::PlainSched S; S.o.init(T / 256, 14336 / 256, 1, F.G, bid); S.astr = (size_t)256 * D * 2; S.bstr = (size_t)256 * D * 2; S.zA = 0; S.zB = 0;
        EpiGateUp E{(bf16*)(ar + A_HID), DFF};
        pg8::gemm_phase(ring, g, S, E);
#endif
        conv_work(F, CQ_F3, fill_quota((T / 256) * (14336 / 256), F.G, bid, 6));
    } SEAM(PH_FFNU);
    if (IN(PH_FFND)) {
#if FFN_FP8
        pg8::Gemm g{(const bf16*)(ar + A_HID), (const bf16*)(F.ws + WS_WDN), DFF / 2, DFF / 2, DFF / 2};
        pg8::PlainSched S; S.o.init(T / 256, D / 256, 1, F.G, bid); S.astr = (size_t)256 * DFF; S.bstr = (size_t)256 * DFF; S.zA = 0; S.zB = 0;
        EpiPlainSc E{(bf16*)(ar + A_F), D, 1.f / (MOE_WSC_DN * MOE_HSC)};
        pg8::gemm_phase<EpiPlainSc, pg8::PlainSched, true>(ring, g, S, E);
#else
        pg8::Gemm g{(const bf16*)(ar + A_HID), (const bf16*)(F.ws + WS_WDN), DFF, DFF, DFF};
        pg8::PlainSched S; S.o.init(T / 256, D / 256, 1, F.G, bid); S.astr = (size_t)256 * DFF * 2; S.bstr = (size_t)256 * DFF * 2; S.zA = 0; S.zB = 0;
        EpiPlain E{(bf16*)(ar + A_F), D};
        pg8::gemm_phase(ring, g, S, E);
#endif
        conv_work(F, CQ_O1, fill_quota((T / 256) * (D / 256), F.G, bid, 11));
    } SEAM(PH_FFND);
    if (IN(PH_N2)) { ph_norm2(F); conv_work(F, CQ_O1, 0); } SEAM(PH_N2);
    if (IN(PH_WINO)) {
        pg8::Gemm g{(const bf16*)(ar + A_U), (const bf16*)(F.ws + WS_WINO), D, D, D};
        pg8::PlainSched S; S.o.init(T / 256, WINO_N / 256, 1, F.G, bid); S.astr = (size_t)256 * D * 2; S.bstr = (size_t)256 * D * 2; S.zA = 0; S.zB = 0;
        EpiWinO E{ar};
        pg8::gemm_phase(ring, g, S, E);
        conv_work(F, CQ_O2, fill_quota(S.o.nwg, F.G, bid, 5));
    } SEAM(PH_WINO);
    if (IN(PH_PREP)) { ph_qknorm(F); ph_vt8(F); for (int u = bid; u < NCH * 4; u += F.G) gla_prepkv_unit(F, u >> 2, u & 3); conv_work(F, 0, fill_quota(NCH * 4, F.G, bid, 4)); } SEAM(PH_PREP);
    if (IN(PH_GLA2)) { ph_gla_scan(F); } SEAM(PH_GLA2);
    if (IN(PH_GLA3)) { for (int u = bid; u < (SEQ / 64) * 4; u += F.G) gla_out_unit(F, u >> 2, u & 3); __syncthreads(); }
    if (IN(PH_ATT)) {
        for (int L = bid; L < 8 * (SEQ / 256); L += F.G) { const int h = L >> 6, qb = L & 63;
            const bf16* Q = (const bf16*)(ar + B_AQ) + (size_t)(CTX + qb * 256) * 1024 + h * 128;
            const unsigned char* Kp = ar + B_KDT + (h >> 2) * 128; const bf16* Vp = (const bf16*)(ar + B_AV) + (h >> 2) * 128;
            bf16* O = (bf16*)(ar + B_YMIX1) + (size_t)(qb * 256) * D + 1024 + h * 128;
            att::attn_dense_body_d(Q, Kp, ar + B_KDT + VT8_OFF + (size_t)(h >> 2) * NCH * 8192, O, T, (LAS char*)F.lds); }
    } SEAM(PH_ATT);
    if (IN(PH_WOUTO)) {
        pg8::Gemm g{(const bf16*)(ar + B_YMIX1), (const bf16*)(F.ws + WS_WOUTO), D, D, D};
        pg8::PlainSched S; S.o.init(SEQ / 256, D / 256, 1, F.G, bid); S.astr = (size_t)256 * D * 2; S.bstr = (size_t)256 * D * 2; S.zA = 0; S.zB = 0;
        EpiPlain E{(bf16*)(ar + B_YO1), D};
        pg8::gemm_phase(ring, g, S, E);
    } SEAM(PH_WOUTO);
    if (IN(PH_N3)) { ph_norm3(F); } SEAM(PH_N3);
    if (IN(PH_ROUTE)) { ph_route(F); conv_work(F, CQ_M2, 0); } SEAM(PH_ROUTE);
    if (IN(PH_MOEU)) {
        const int* TILE = (const int*)(ar + B_TILE); const int nt = __builtin_amdgcn_readfirstlane(TILE[0]);
        pg8::Gemm g{(const bf16*)(ar + B_VG), (const bf16*)(F.ws + WS_WMGU), D / 2, D / 2, D / 2};
        pg8::MoeSched S; S.o.init(nt, 14336 / 256, 1, F.G, bid); S.astr = (size_t)256 * D; S.bstr = (size_t)256 * D; S.zB = (size_t)14336 * D; S.tile_e = TILE + 1;
        EpiGateUp8 E{ar + B_HID2, DFF, 1.f / MOE_WSC_GU};
        pg8::gemm_phase<EpiGateUp8, pg8::MoeSched, true>(ring, g, S, E);
        conv_work(F, CQ_M3, fill_quota(S.o.nwg, F.G, bid, 5));
    } SEAM(PH_MOEU);
    if (IN(PH_MOED)) {
        const int* TILE = (const int*)(ar + B_TILE); const int nt = __builtin_amdgcn_readfirstlane(TILE[0]);
        pg8::Gemm g{(const bf16*)(ar + B_HID2), (const bf16*)(F.ws + WS_WMDN), DFF / 2, DFF / 2, DFF / 2};
        const int nmain = nt < MOE_MAIN_TILES ? nt : MOE_MAIN_TILES;
        pg8::MoeSched S; S.o.init(nmain, D / 256, 1, F.G, bid); S.astr = (size_t)256 * DFF; S.bstr = (size_t)256 * DFF; S.zB = (size_t)D * DFF; S.tile_e = TILE + 1;
        EpiPlainSc E{(bf16*)(ar + B_FS), D, 1.f / (MOE_WSC_DN * MOE_HSC)};
        pg8::gemm_phase<EpiPlainSc, pg8::MoeSched, true>(ring, g, S, E);
        if (nt > MOE_MAIN_TILES) {
            pg8::Gemm g2{(const bf16*)(ar + B_HID2), (const bf16*)(F.ws + WS_WMDN), DFF / 2, DFF / 2, DFF / 8};
            pg8::MoeSplitSched S2; S2.pm0 = MOE_MAIN_TILES; S2.nun = (nt - MOE_MAIN_TILES) * 32; S2.G = F.G; S2.c = bid; S2.astr = (size_t)256 * DFF; S2.bstr = (size_t)256 * DFF; S2.zB = (size_t)D * DFF; S2.kslice = DFF / 4; S2.tile_e = TILE + 1;
            EpiPart E2{(float*)(ar + B_VG), MOE_MAIN_TILES, 1.f / (MOE_WSC_DN * MOE_HSC)};
            pg8::gemm_phase<EpiPart, pg8::MoeSplitSched, true>(ring, g2, S2, E2);
        }
    } SEAM(PH_MOED);
    if (IN(PH_N4)) { ph_norm4(F, karg_out()); }
#undef IN
#undef SEAM
}

extern "C" void kernel_launch(void* const* d_in, const int* in_sizes, int n_in, void* d_out, int out_size, void* d_ws, size_t ws_size, hipStream_t stream) {
    static int grid = 0;
    if (grid == 0) {
        if (n_in != N_IN || out_size != SEQ * D || ws_size < WS_NEED) { fprintf(stderr, "kernel_launch: shape/workspace mismatch (n_in %d out %d ws %zu need %zu)\n", n_in, out_size, ws_size, (size_t)WS_NEED); grid = -1; return; }
        int dev = 0, cus = 0, per_cu = 0;
        if (hipGetDevice(&dev) != hipSuccess || hipDeviceGetAttribute(&cus, hipDeviceAttributeMultiprocessorCount, dev) != hipSuccess) { grid = -1; return; }
        if (hipFuncSetAttribute((const void*)mk_fwd, hipFuncAttributeMaxDynamicSharedMemorySize, LDS_BYTES) != hipSuccess) { fprintf(stderr, "kernel_launch: hipFuncSetAttribute failed\n"); grid = -1; return; }
        if (hipOccupancyMaxActiveBlocksPerMultiprocessor(&per_cu, (const void*)mk_fwd, NTHR, LDS_BYTES) != hipSuccess || per_cu < 1) { fprintf(stderr, "kernel_launch: occupancy query says %d\n", per_cu); }
        (void)hipGetLastError();
        grid = cus;
    }
    if (grid < 0) return;
    (void)hipMemsetAsync((char*)d_ws + WS_CTL, 0, CTL_ZERO_BYTES, stream);
    Args a{};
    for (int i = 0; i < N_IN; ++i) a.in[i] = (const float*)d_in[i];
    a.out = (float*)d_out; a.ws = (unsigned char*)d_ws; a.pad = 0;
    const int last = (MK_STOP < NPH - 1) ? MK_STOP : NPH - 1;
#if MK_SPLIT
    for (int p = 0; p <= last; ++p) { a.ph_lo = p; a.ph_hi = p + 1; a.li = p; hipLaunchKernelGGL(mk_fwd, dim3(grid), dim3(NTHR), LDS_BYTES, stream, a); }
#else
    a.ph_lo = 0; a.ph_hi = last + 1; a.li = 0; hipLaunchKernelGGL(mk_fwd, dim3(grid), dim3(NTHR), LDS_BYTES, stream, a);
#endif
    if (last < NPH - 1) { a.ph_lo = PH_EMIT; a.ph_hi = PH_EMIT + 1; a.li = 7; hipLaunchKernelGGL(mk_fwd, dim3(grid), dim3(NTHR), LDS_BYTES, stream, a); }
    const hipError_t le = hipPeekAtLastError();
    if (le != hipSuccess) fprintf(stderr, "kernel_launch: launch failed: %s\n", hipGetErrorName(le));
}
```

```cpp
#include <hip/hip_runtime.h>
#include <cstdio>
#include <cstdint>

#ifndef MK_STOP
#define MK_STOP 99
#endif
#ifndef FFN_FP8
#define FFN_FP8 2
#endif
#ifndef FFNU_K1
#define FFNU_K1 1024
#endif
#ifndef MK_SPLIT
#define MK_SPLIT 0
#endif

namespace pg8 {
#define PG8_LAS __attribute__((address_space(3)))
typedef unsigned short bf16_t;
typedef short bf16x8 __attribute__((ext_vector_type(8)));
typedef float f32x4 __attribute__((ext_vector_type(4)));
typedef unsigned u32x4 __attribute__((ext_vector_type(4)));
typedef int v4i __attribute__((ext_vector_type(4)));
typedef int v8i __attribute__((ext_vector_type(8)));
constexpr int BM = 256, BK = 64, HALF = 128, HTB = HALF * BK * 2, STAGE_BYTES = 8 * HTB, NXCD = 8, WGM = 8;

__host__ __device__ __forceinline__ int lds_byte(int r, int c) { const int st = (r >> 4) * 2 + (c >> 5), rr = r & 15, cc = c & 31, ob = rr * 64 + cc * 2; return st * 1024 + (ob ^ (((ob >> 9) & 1) << 5)); }
__host__ __device__ __forceinline__ void stage_rc(int b, int& R, int& C) { const int st = b / 1024, sb = b % 1024, swz = sb ^ (((sb >> 9) & 1) << 5); R = (st >> 1) * 16 + swz / 64; C = (st & 1) * 32 + (swz % 64) / 2; }
__host__ __device__ __forceinline__ int perm32(int rho) { const int n = rho >> 4, i = rho & 15; return 8 * (i >> 2) + 4 * n + (i & 3); }

struct Unit { int pm, pn, bz; unsigned aoff, boff; };
struct Gemm { const bf16_t* A; const bf16_t* Bt; int lda, ldb, K; };

struct TileOrder {
    int nM, nN, nB, nwg, G, c;
    __device__ void init(int nM_, int nN_, int nB_, int G_, int c_) { nM = nM_; nN = nN_; nB = nB_; nwg = nM * nN * nB; G = G_; c = c_; }
    __device__ bool decode(int i, int& bz, int& pm, int& pn) const {
        const long L = (long)i * G + c; if (L >= nwg) return false;
        int wgid = (int)L; { const int q = nwg / NXCD, r = nwg % NXCD, xcd = wgid % NXCD, off = wgid / NXCD; wgid = (xcd < r ? xcd * (q + 1) : r * (q + 1) + (xcd - r) * q) + off; }
        const int per = nM * nN; bz = wgid / per; const int w = wgid - bz * per;
        const int nig = WGM * nN, gid = w / nig, fm = gid * WGM, gsz = (nM - fm) < WGM ? (nM - fm) : WGM;
        pm = fm + ((w % nig) % gsz); pn = (w % nig) / gsz; return true;
    }
};
struct PlainSched {
    TileOrder o; size_t astr, bstr, zA, zB;
    __device__ bool next(int i, Unit& u) const { if (!o.decode(i, u.bz, u.pm, u.pn)) return false; u.aoff = (unsigned)((size_t)u.bz * zA + (size_t)u.pm * astr); u.boff = (unsigned)((size_t)u.bz * zB + (size_t)u.pn * bstr); return true; }
};
struct MoeSched {
    TileOrder o; size_t astr, bstr, zB; const int* tile_e;
    __device__ bool next(int i, Unit& u) const { int bz; if (!o.decode(i, bz, u.pm, u.pn)) return false; u.bz = __builtin_amdgcn_readfirstlane(tile_e[u.pm]); u.aoff = (unsigned)((size_t)u.pm * astr); u.boff = (unsigned)((size_t)u.bz * zB + (size_t)u.pn * bstr); return true; }
};

struct MoeSplitSched {
    int pm0, nun, G, c; size_t astr, bstr, zB; unsigned kslice; const int* tile_e;
    __device__ bool next(int i, Unit& u) const { const long L = (long)i * G + c; if (L >= nun) return false; const int l = (int)L, ks = l & 3, pn = (l >> 2) & 7, pm = pm0 + (l >> 5);
        u.pm = pm; u.pn = pn; u.bz = ks; const int e = __builtin_amdgcn_readfirstlane(tile_e[pm]);
        u.aoff = (unsigned)((size_t)pm * astr + (size_t)ks * kslice); u.boff = (unsigned)((size_t)e * zB + (size_t)pn * bstr + (size_t)ks * kslice); return true; }
};
__device__ __forceinline__ unsigned cvt_pk_bf16(float lo, float hi) { unsigned r; asm volatile("v_cvt_pk_bf16_f32 %0, %1, %2" : "=v"(r) : "v"(lo), "v"(hi)); return r; }
__device__ __forceinline__ u32x4 pack8(const f32x4& a, const f32x4& b) { u32x4 w; w.x = cvt_pk_bf16(a[0], a[1]); w.y = cvt_pk_bf16(a[2], a[3]); w.z = cvt_pk_bf16(b[0], b[1]); w.w = cvt_pk_bf16(b[2], b[3]); return w; }

template <class Epi, class Sched, bool FP8 = false, int MIXT = -1>
__device__ __forceinline__ void gemm_phase(PG8_LAS unsigned char* lds, const Gemm g, const Sched& S, const Epi& E) {
    const int tid = threadIdx.x, wid = __builtin_amdgcn_readfirstlane(tid >> 6), lane = tid & 63, wr = wid >> 2, wc = wid & 3, fr = lane & 15, fq = lane >> 4;
    const int K = g.K, nt = K / BK;
    unsigned voffA[2], voffB[2];
#pragma unroll
    for (int i = 0; i < 2; ++i) { int R, C; stage_rc(tid * 16 + i * 8192, R, C); const int Rb = Epi::PERM ? ((R & ~31) + perm32(R & 31)) : R;
        voffA[i] = (unsigned)(R * g.lda + C) * 2u; voffB[i] = (unsigned)(Rb * g.ldb + C) * 2u; }
    const unsigned kstep = (unsigned)(BK * 2);
    const unsigned hstepA = (unsigned)HALF * (unsigned)g.lda * 2u, hstepB = (unsigned)HALF * (unsigned)g.ldb * 2u;
    const unsigned ldsw = (unsigned)wid * 1024u;
    const int aoff = lds_byte(wr * 64 + fr, fq * 8), boff = lds_byte(wc * 32 + fr, fq * 8);
    const char* const gA = (const char*)g.A; const char* const gB = (const char*)g.Bt;
#define PG8_SA(b, h) (((b) * 2 + (h)) * HTB)
#define PG8_SB(b, h) ((4 + (b) * 2 + (h)) * HTB)
#define PG8_STAGE(bufoff, gbase, soff, voff) do { _Pragma("unroll") for (int _i = 0; _i < 2; ++_i) \
        __builtin_amdgcn_global_load_lds((const unsigned*)((gbase) + (size_t)((soff) + (voff)[_i])), (PG8_LAS unsigned*)(lds + (bufoff) + ldsw + _i * 8192), 16, 0, 0); } while (0)
#define PG8_LDA(dst, b, h) do { _Pragma("unroll") for (int m = 0; m < 4; ++m) _Pragma("unroll") for (int k = 0; k < 2; ++k) dst[m][k] = *(const PG8_LAS bf16x8*)(lds + PG8_SA(b, h) + aoff + m * 2048 + k * 1024); } while (0)
#define PG8_LDB(dst, b, h) do { _Pragma("unroll") for (int n = 0; n < 2; ++n) _Pragma("unroll") for (int k = 0; k < 2; ++k) dst[n][k] = *(const PG8_LAS bf16x8*)(lds + PG8_SB(b, h) + boff + n * 2048 + k * 1024); } while (0)
#define PG8_CAT(x) __builtin_shufflevector(__builtin_bit_cast(v4i, (x)[0]), __builtin_bit_cast(v4i, (x)[1]), 0, 1, 2, 3, 4, 5, 6, 7)
#define PG8_MMA(ai, bj, At, Bt, IS8) do { __builtin_amdgcn_s_setprio(1); \
        if constexpr (MIXT >= 0) { if (IS8) { \
            _Pragma("unroll") for (int m = 0; m < 4; ++m) { const v8i a8 = PG8_CAT(At[m]); _Pragma("unroll") for (int n = 0; n < 2; ++n) { const v8i b8 = PG8_CAT(Bt[n]); \
                asm volatile("s_nop 1\n\tv_mfma_scale_f32_16x16x128_f8f6f4 %0, %1, %2, %0, %3, %4 op_sel_hi:[0,0,0]" : "+v"(acc[ai][bj][m][n]) : "v"(b8), "v"(a8), "v"(scw), "v"(sc1)); } } \
          } else { _Pragma("unroll") for (int m = 0; m < 4; ++m) _Pragma("unroll") for (int n = 0; n < 2; ++n) _Pragma("unroll") for (int k = 0; k < 2; ++k) \
            acc[ai][bj][m][n] = __builtin_amdgcn_mfma_f32_16x16x32_bf16(Bt[n][k], At[m][k], acc[ai][bj][m][n], 0, 0, 0); } \
        } else if constexpr (FP8) {   \
            _Pragma("unroll") for (int m = 0; m < 4; ++m) { const v8i a8 = PG8_CAT(At[m]); _Pragma("unroll") for (int n = 0; n < 2; ++n) { const v8i b8 = PG8_CAT(Bt[n]); \
                  \
                asm volatile("s_nop 1\n\tv_mfma_scale_f32_16x16x128_f8f6f4 %0, %1, %2, %0, %3, %3 op_sel_hi:[0,0,0]" : "+v"(acc[ai][bj][m][n]) : "v"(b8), "v"(a8), "v"(sc1)); } } \
        } else { _Pragma("unroll") for (int m = 0; m < 4; ++m) _Pragma("unroll") for (int n = 0; n < 2; ++n) _Pragma("unroll") for (int k = 0; k < 2; ++k) \
            acc[ai][bj][m][n] = __builtin_amdgcn_mfma_f32_16x16x32_bf16(Bt[n][k], At[m][k], acc[ai][bj][m][n], 0, 0, 0); } \
        __builtin_amdgcn_s_setprio(0); } while (0)
#define PG8_WAIT_V(n) asm volatile("s_waitcnt vmcnt(" #n ")" ::: "memory")
#define PG8_WAIT_L(n) asm volatile("s_waitcnt lgkmcnt(" #n ")" ::: "memory")
#define PG8_BAR __builtin_amdgcn_s_barrier()
#define PG8_SCHED __builtin_amdgcn_sched_barrier(0)
    Unit cur, nxt; int ui = 0;
    if (!S.next(0, cur)) return;
    const int sc1 = 0x7f7f7f7f, scw = 0x79797979;
    f32x4 acc[2][2][4][2];
#pragma unroll
    for (int a = 0; a < 2; ++a)
#pragma unroll
        for (int b = 0; b < 2; ++b)
#pragma unroll
            for (int m = 0; m < 4; ++m)
#pragma unroll
                for (int n = 0; n < 2; ++n) acc[a][b][m][n] = (f32x4){0.f, 0.f, 0.f, 0.f};
    bf16x8 At[4][2], B0[2][2], B1[2][2];
    unsigned cA = cur.aoff, cB = cur.boff;
    PG8_STAGE(PG8_SB(0, 0), gB, cB, voffB); PG8_STAGE(PG8_SB(0, 1), gB, cB + hstepB, voffB); PG8_STAGE(PG8_SA(0, 0), gA, cA, voffA); PG8_STAGE(PG8_SA(0, 1), gA, cA + hstepA, voffA);
    if (wr == 1) PG8_BAR;
    PG8_WAIT_V(2); PG8_BAR;
    PG8_STAGE(PG8_SB(1, 0), gB, cB + kstep, voffB); PG8_STAGE(PG8_SA(1, 0), gA, cA + kstep, voffA); PG8_STAGE(PG8_SB(1, 1), gB, cB + hstepB + kstep, voffB);
    PG8_WAIT_V(6); PG8_BAR;
    for (;;) {
        const bool has_next = S.next(ui + 1, nxt);
        const unsigned nA = has_next ? nxt.aoff : cA, nB = has_next ? nxt.boff : cB;
#define PG8_KBODY(IS8) do { \
            const bool last = (t == nt - 2); \
            const unsigned a1 = cA + (unsigned)(t + 1) * kstep; \
            const unsigned a2 = last ? nA : cA + (unsigned)(t + 2) * kstep, b2 = last ? nB : cB + (unsigned)(t + 2) * kstep; \
            const unsigned a3 = a2 + kstep, b3 = b2 + kstep; \
            PG8_LDB(B0, 0, 0); PG8_LDB(B1, 0, 1); PG8_SCHED; PG8_LDA(At, 0, 0); PG8_STAGE(PG8_SA(1, 1), gA, a1 + hstepA, voffA); \
            PG8_WAIT_V(8); PG8_WAIT_L(0); PG8_BAR; PG8_MMA(0, 0, At, B0, IS8); PG8_MMA(0, 1, At, B1, IS8); PG8_BAR; PG8_SCHED; \
            PG8_LDA(At, 0, 1); PG8_STAGE(PG8_SB(0, 0), gB, b2, voffB); PG8_STAGE(PG8_SB(0, 1), gB, b2 + hstepB, voffB); PG8_STAGE(PG8_SA(0, 0), gA, a2, voffA); \
            PG8_WAIT_V(8); PG8_WAIT_L(0); PG8_BAR; PG8_MMA(1, 0, At, B0, IS8); PG8_MMA(1, 1, At, B1, IS8); PG8_BAR; PG8_SCHED; \
            PG8_LDB(B0, 1, 0); PG8_LDB(B1, 1, 1); PG8_SCHED; PG8_LDA(At, 1, 0); PG8_STAGE(PG8_SA(0, 1), gA, a2 + hstepA, voffA); \
            PG8_WAIT_V(8); PG8_WAIT_L(0); PG8_BAR; PG8_MMA(0, 0, At, B0, IS8); PG8_MMA(0, 1, At, B1, IS8); PG8_BAR; PG8_SCHED; \
            PG8_LDA(At, 1, 1); PG8_STAGE(PG8_SB(1, 0), gB, b3, voffB); PG8_STAGE(PG8_SB(1, 1), gB, b3 + hstepB, voffB); PG8_STAGE(PG8_SA(1, 0), gA, a3, voffA); \
            PG8_WAIT_V(8); PG8_WAIT_L(0); PG8_BAR; PG8_MMA(1, 0, At, B0, IS8); PG8_MMA(1, 1, At, B1, IS8); PG8_BAR; PG8_SCHED; \
        } while (0)
        if constexpr (MIXT >= 0) {
#pragma unroll 1
            for (int t = 0; t < MIXT; t += 2) PG8_KBODY(false);
#pragma unroll 1
            for (int t = MIXT; t < nt; t += 2) PG8_KBODY(true);
        } else {
#pragma unroll 1
            for (int t = 0; t < nt; t += 2) PG8_KBODY(false);
        }
#undef PG8_KBODY
        if constexpr (FP8 || MIXT >= 0) {
            asm volatile("s_nop 15" : "+v"(acc[0][0][0][0]), "+v"(acc[0][0][0][1]), "+v"(acc[0][0][1][0]), "+v"(acc[0][0][1][1]), "+v"(acc[0][0][2][0]), "+v"(acc[0][0][2][1]), "+v"(acc[0][0][3][0]), "+v"(acc[0][0][3][1]),
                                      "+v"(acc[0][1][0][0]), "+v"(acc[0][1][0][1]), "+v"(acc[0][1][1][0]), "+v"(acc[0][1][1][1]), "+v"(acc[0][1][2][0]), "+v"(acc[0][1][2][1]), "+v"(acc[0][1][3][0]), "+v"(acc[0][1][3][1]));
            asm volatile("" : "+v"(acc[1][0][0][0]), "+v"(acc[1][0][0][1]), "+v"(acc[1][0][1][0]), "+v"(acc[1][0][1][1]), "+v"(acc[1][0][2][0]), "+v"(acc[1][0][2][1]), "+v"(acc[1][0][3][0]), "+v"(acc[1][0][3][1]),
                              "+v"(acc[1][1][0][0]), "+v"(acc[1][1][0][1]), "+v"(acc[1][1][1][0]), "+v"(acc[1][1][1][1]), "+v"(acc[1][1][2][0]), "+v"(acc[1][1][2][1]), "+v"(acc[1][1][3][0]), "+v"(acc[1][1][3][1]));
        }
        if (wr == 0) PG8_BAR;
        E(acc, cur, wr, wc, fr, fq);
        if (!has_next) break;
#pragma unroll
        for (int a = 0; a < 2; ++a)
#pragma unroll
            for (int b = 0; b < 2; ++b)
#pragma unroll
                for (int m = 0; m < 4; ++m)
#pragma unroll
                    for (int n = 0; n < 2; ++n) acc[a][b][m][n] = (f32x4){0.f, 0.f, 0.f, 0.f};
        cur = nxt; cA = nA; cB = nB; ++ui;
        if (wr == 1) PG8_BAR;
    }
    PG8_WAIT_V(0);
    PG8_BAR;
#undef PG8_SA
#undef PG8_SB
#undef PG8_STAGE
#undef PG8_LDA
#undef PG8_LDB
#undef PG8_MMA
#undef PG8_CAT
#undef PG8_WAIT_V
#undef PG8_WAIT_L
#undef PG8_BAR
#undef PG8_SCHED
}
}

constexpr int D = 2048, SEQ = 16384, CTX = 256, T = SEQ + CTX, DFF = 7168, NEXP = 8;
constexpr int NWAVES = 8, NTHR = 512;
constexpr int WPOOL = 1536, WS5 = 512, PG = 384, S5G = 32, S5P = 64, S5N = 16, LC = 64, NCH = T / LC  , NCH_CTX = CTX / LC  ;
constexpr int S5ROWS = 512, S5K = 1280;
constexpr int WINO_N = 4864;
constexpr float EPS = 1e-6f;
constexpr float MOE_WSC_GU = 64.f, MOE_WSC_DN = 128.f, MOE_HSC = 4.f;

enum { I_X = 0, I_C, I_CTX, I_CCTX, I_WMOD, I_BMOD, I_NORMS, I_EWIN, I_EPOOLW, I_EPOOLS, I_LAMRE, I_LAMIM, I_LOGDT, I_BRE, I_BIM, I_CRE, I_CIM, I_S5D, I_WGLU, I_EWOUT,
       I_FFG, I_FFU, I_FFD, I_OWIN, I_GLAWA, I_GLABA, I_GLANORM, I_QNORM, I_KNORM, I_OWOUT, I_ROUTER, I_ROUTERB, I_MOEG, I_MOEU, I_MOED, N_IN };

constexpr size_t MiB = 1u << 20;
constexpr size_t al256(size_t x) { return (x + 255) / 256 * 256; }
constexpr size_t WS_CTL = 0, CTL_ZERO_BYTES = 128 * 1024;
constexpr size_t WS_MODF = 1 * MiB;
constexpr size_t WS_ROPE = WS_MODF + al256(2 * 2 * 6 * 2048 * 4);
constexpr size_t WS_W0 = 2 * MiB;
constexpr size_t SZ_WINE = (size_t)2048 * 2048 * 2, SZ_WPOOL = (size_t)4 * 512 * 384 * 2, SZ_WGLU = (size_t)512 * 512 * 2, SZ_WGU = (size_t)14336 * 2048 * 2,
                 SZ_WDN = (size_t)2048 * 7168 * 2, SZ_WINO = (size_t)WINO_N * 2048 * 2;
constexpr size_t WS_WINE = WS_W0, WS_WPOOL = WS_WINE + SZ_WINE, WS_WGLU = WS_WPOOL + SZ_WPOOL, WS_WOUTE = WS_WGLU + SZ_WGLU, WS_WGU = WS_WOUTE + SZ_WINE,
                 WS_WDN = WS_WGU + SZ_WGU, WS_WINO = WS_WDN + SZ_WDN, WS_WOUTO = WS_WINO + SZ_WINO, WS_WMGU = WS_WOUTO + SZ_WINE, WS_WMDN = WS_WMGU + 8 * SZ_WGU,
                 WS_HRES = WS_WMDN + 8 * SZ_WDN;
constexpr size_t SZ_HRES = (size_t)T * D * 4;
constexpr size_t WS_ARENA = WS_HRES + SZ_HRES;
constexpr size_t SZ_ROWB = (size_t)T * D * 2;
constexpr size_t A_U = 0, A_ZP = A_U + SZ_ROWB, SZ_ZP = (size_t)T * WPOOL * 2, A_DP = A_ZP + SZ_ZP, A_AS5 = A_DP + SZ_ZP, SZ_AS5 = (size_t)S5G * S5ROWS * S5K * 2,
                 A_SLOC = A_AS5 + SZ_AS5, SZ_SLOC = (size_t)S5G * S5ROWS * 256 * 4, A_YG = A_SLOC + SZ_SLOC, SZ_YG = (size_t)T * WS5 * 2, A_YMIX = A_YG + SZ_YG,
                 A_YO = A_YMIX + SZ_ROWB, A_V = A_YO + SZ_ROWB, A_HID = A_V + SZ_ROWB, SZ_HID = (size_t)T * DFF * 2, A_F = A_HID + SZ_HID,
                 A_M1T = A_F + SZ_ROWB, SZ_M1T = (size_t)S5G * 256 * 1024 * 2, A_K3T = A_M1T + SZ_M1T, SZ_K3T = (size_t)S5G * 1024 * S5K * 2,
                 A_TBG = A_K3T + SZ_K3T, SZ_TBG = (size_t)S5G * 2 * 64 * 256 * 4, A_L0_END = A_TBG + SZ_TBG;
constexpr size_t WS_END_L0 = WS_ARENA + A_L0_END;
constexpr int MOE_ROWS = 2 * SEQ + NEXP * 256;
constexpr int MOE_MAIN_TILES = 128, MOE_SPLIT_TILES = MOE_ROWS / 256 - 128;
static_assert((size_t)4 * MOE_SPLIT_TILES * 256 * D * 4 <= (size_t)MOE_ROWS * D * 2, "split-K partials fit in the (dead) VG region");
constexpr size_t SZ_T512 = (size_t)T * 512 * 2, SZ_T1024 = (size_t)T * 1024 * 2, SZ_T256 = (size_t)T * 256 * 2, SZ_SEQB = (size_t)SEQ * D * 2;
constexpr size_t B_GQ = A_U + SZ_ROWB, B_GK = B_GQ + SZ_T512, B_GV = B_GK + SZ_T512, B_R = B_GV + SZ_T1024, B_AQ = B_R + SZ_T1024, B_AK = B_AQ + SZ_T1024, B_AV = B_AK + SZ_T256,
                 B_ALR = B_AV + SZ_T256, B_QE = B_ALR + al256((size_t)T * 16 * 4), B_KE = B_QE + 2 * SZ_T512, B_KDT = B_KE + 2 * SZ_T512, B_VT = B_KDT + 2 * SZ_T512,
                 B_DEC = B_VT + SZ_T1024, B_ST = B_DEC + al256((size_t)2 * NCH * 4 * 128 * 4), SZ_ST = (size_t)2 * NCH * 4 * 256 * 128 * 2, B_YMIX1 = B_ST + SZ_ST,
                 B_YO1 = B_YMIX1 + SZ_SEQB, B_REGA_END = B_YO1 + SZ_SEQB;
constexpr size_t B_HID2 = 0, SZ_HID2 = (size_t)MOE_ROWS * DFF * 2, B_FS = B_HID2 + SZ_HID2, SZ_FS = (size_t)MOE_ROWS * D * 2, B_OVL_END = B_FS + SZ_FS;
constexpr size_t B_REGB = al256(B_REGA_END > B_OVL_END ? B_REGA_END : B_OVL_END);
constexpr size_t B_V1 = B_REGB, B_VG = B_V1 + SZ_SEQB, B_RE = B_VG + SZ_FS, B_RG = B_RE + (size_t)SEQ * 8, B_SLOT = B_RG + (size_t)SEQ * 8, B_CNT = B_SLOT + (size_t)SEQ * 8,
                 B_TILE = B_CNT + 256 * 8 * 4, B_L1_END = B_TILE + 4096;
constexpr size_t WS_END_L1 = WS_ARENA + B_L1_END;
constexpr size_t WS_NEED = WS_END_L0 > WS_END_L1 ? WS_END_L0 : WS_END_L1;
static_assert(WS_NEED <= (size_t)1879048192, "workspace map exceeds the guaranteed size");

constexpr int CW_TMO = 0, CW_CODE = 1, CW_BAR = 4096;

#define GAS __attribute__((address_space(1)))
#define LAS __attribute__((address_space(3)))
typedef unsigned short bf16;
typedef unsigned v4u __attribute__((ext_vector_type(4)));
typedef unsigned v2u __attribute__((ext_vector_type(2)));
typedef float f32x4 __attribute__((ext_vector_type(4)));
typedef float f32x2 __attribute__((ext_vector_type(2)));
typedef short bf16x8 __attribute__((ext_vector_type(8)));
typedef GAS unsigned gu32;
#define RLX_AGENT __ATOMIC_RELAXED, __HIP_MEMORY_SCOPE_AGENT
#define LDS_WAIT() asm volatile("s_waitcnt lgkmcnt(0)" ::: "memory")
#define VM_WAIT() asm volatile("s_waitcnt vmcnt(0)" ::: "memory")
__device__ __forceinline__ unsigned f2bf(float f) { unsigned u = __builtin_bit_cast(unsigned, f); return (u + 0x7fffu + ((u >> 16) & 1u)) >> 16; }
typedef __bf16 bf16x2_t __attribute__((ext_vector_type(2)));
__device__ __forceinline__ unsigned pk2(float lo, float hi) { const f32x2 v = {lo, hi}; return __builtin_bit_cast(unsigned, __builtin_convertvector(v, bf16x2_t)); }
__device__ __forceinline__ float bflo(unsigned w) { return __builtin_bit_cast(float, w << 16); }
__device__ __forceinline__ float bfhi(unsigned w) { return __builtin_bit_cast(float, w & 0xffff0000u); }
__device__ __forceinline__ float bf2f(bf16 b) { return __builtin_bit_cast(float, (unsigned)b << 16); }
__device__ __forceinline__ float sigmoidf_(float x) { return __builtin_amdgcn_rcpf(1.f + __expf(-x)); }
__device__ __forceinline__ float siluf_(float x) { return x * __builtin_amdgcn_rcpf(1.f + __expf(-x)); }
__device__ __forceinline__ float swiglu_fast(float ag, float au, float negsg_log2e, float kk) { const float e = __builtin_amdgcn_exp2f(ag * negsg_log2e); return (ag * au) * (kk * __builtin_amdgcn_rcpf(1.f + e)); }
__device__ __forceinline__ float gelu_tanh(float y) { const float z = 0.7978845608028654f * (y + 0.044715f * y * y * y); const float e = __expf(2.f * z); const float th = 1.f - 2.f * __builtin_amdgcn_rcpf(e + 1.f); return 0.5f * y * (1.f + th); }

#define XB_TMO      128
#define XB_XCNT(j)  (256  + 64 * (j))
#define XB_XSUB(j)  (1280 + 64 * (j))
#define XB_XGEN(j)  (2304 + 64 * (j))
#define XB_TOP      3328
#define XB_TOPGEN   3392
#define XCD_BAR_WORDS 3456
#define XB_SPIN_CAP (1u << 22)
__device__ __forceinline__ unsigned xb_ld(unsigned* p)              { return __hip_atomic_load(p, __ATOMIC_RELAXED, __HIP_MEMORY_SCOPE_AGENT); }
__device__ __forceinline__ unsigned xb_add(unsigned* p, unsigned v) { return __hip_atomic_fetch_add(p, v, __ATOMIC_RELAXED, __HIP_MEMORY_SCOPE_AGENT); }
__device__ __forceinline__ unsigned xb_xcc_id() { return (unsigned)__builtin_amdgcn_s_getreg((3 << 11) | 20) & 0xFu; }
#define XB_SPIN(cond, bar) do { unsigned _sp = 0; while (cond) { __builtin_amdgcn_s_sleep(1); \
    if ((++_sp & 255u) == 0u) { if (xb_ld(&(bar)[XB_TMO])) break; if (_sp > XB_SPIN_CAP) { atomicAdd(&(bar)[XB_TMO], 1u); break; } } } } while (0)
struct XcdBarrier { unsigned* bar; unsigned x; volatile LAS unsigned* st; };
__device__ __forceinline__ XcdBarrier xcd_barrier_post(unsigned* bar, volatile LAS unsigned* st) {
    XcdBarrier b; b.bar = bar; b.x = xb_xcc_id(); b.st = st;
    if (threadIdx.x == 0) (void)xb_add(&bar[XB_XCNT(b.x)], 1u);
    return b;
}
__device__ __forceinline__ void xcd_barrier_complete(unsigned* bar, unsigned x, unsigned& nloc, unsigned& nx) {
    const unsigned G = gridDim.x * gridDim.y * gridDim.z;
    unsigned sum, cnt, mine, sp = 0u;
    for (;;) {
        sum = 0u; cnt = 0u; mine = 0u;
#pragma unroll
        for (unsigned j = 0; j < 16; ++j) { const unsigned c = xb_ld(&bar[XB_XCNT(j)]); sum += c; cnt += (c > 0u) ? 1u : 0u; mine = (j == x) ? c : mine; }
        if (sum == G) break;
        __builtin_amdgcn_s_sleep(1);
        if ((++sp & 255u) == 0u) { if (xb_ld(&bar[XB_TMO])) break; if (sp > XB_SPIN_CAP) { atomicAdd(&bar[XB_TMO], 1u); break; } }
    }
    nloc = mine > 0u ? mine : 1u; nx = cnt > 0u ? cnt : 1u;
}
__device__ __forceinline__ void xcd_barrier(const XcdBarrier& b) {
    asm volatile("s_waitcnt vmcnt(0)" ::: "memory");
    __syncthreads();
    if (threadIdx.x == 0) {
        unsigned* bar = b.bar;
        __builtin_amdgcn_s_waitcnt(0);
        unsigned nloc = b.st[0], nx = b.st[1];
        if (nloc == 0u) { xcd_barrier_complete(bar, b.x, nloc, nx); b.st[0] = nloc; b.st[1] = nx; }
        const unsigned old = xb_add(&bar[XB_XSUB(b.x)], 1u);
        const unsigned gen = old / nloc;
        if (old + 1u == (gen + 1u) * nloc) {
            __builtin_amdgcn_fence(__ATOMIC_RELEASE, "agent");
            asm volatile("s_waitcnt vmcnt(0)" ::: "memory");
            const unsigned og = xb_add(&bar[XB_TOP], 1u);
            const unsigned tg = og / nx;
            if (og + 1u == (tg + 1u) * nx) xb_add(&bar[XB_TOPGEN], 1u);
            else XB_SPIN(xb_ld(&bar[XB_TOPGEN]) == tg, bar);
            __builtin_amdgcn_fence(__ATOMIC_ACQUIRE, "agent");
            xb_add(&bar[XB_XGEN(b.x)], 1u);
            asm volatile("s_waitcnt vmcnt(0)" ::: "memory");
        } else {
            XB_SPIN(xb_ld(&bar[XB_XGEN(b.x)]) == gen, bar);
            __builtin_amdgcn_fence(__ATOMIC_ACQUIRE, "agent");
            asm volatile("s_waitcnt vmcnt(0)" ::: "memory");
        }
    }
    __syncthreads();
}

constexpr int RING_OFF = 0, RING_BYTES = 131072;
constexpr int LDSCTL_OFF = RING_BYTES, MISC_OFF = LDSCTL_OFF + 320;
constexpr int LDS_BYTES = 147456;

#define CAS __attribute__((address_space(4)))
__device__ __forceinline__ const float* inp(int k) { const CAS char* ka = (const CAS char*)__builtin_amdgcn_kernarg_segment_ptr(); return *(const float* const CAS*)(ka + 8 * k); }
__device__ __forceinline__ float* karg_out() { const CAS char* ka = (const CAS char*)__builtin_amdgcn_kernarg_segment_ptr(); return *(float* const CAS*)(ka + 8 * 35); }
__device__ __forceinline__ unsigned char* karg_ws() { const CAS char* ka = (const CAS char*)__builtin_amdgcn_kernarg_segment_ptr(); return *(unsigned char* const CAS*)(ka + 8 * 36); }
__device__ __forceinline__ int karg_i(int k) { const CAS char* ka = (const CAS char*)__builtin_amdgcn_kernarg_segment_ptr(); return *(const CAS int*)(ka + 8 * 37 + 4 * k); }
struct Frame {
    LAS unsigned char* lds;
    volatile LAS unsigned* MISC;
    gu32* ctl;
    int tid, lane, wave, vcu, G;
    unsigned char* ws;
};
__device__ __forceinline__ float wave_sum(float v) {
#pragma unroll
    for (int o = 1; o < 64; o <<= 1) v += __shfl_xor(v, o);
    return v;
}

struct RmIdent { int off; __device__ __forceinline__ int operator()(int n) const { return n + off; } };
struct RmGateUp { int which; __device__ __forceinline__ int operator()(int n) const { return (n >> 7) * 256 + which * 128 + (n & 127); } };
struct RmWinO { __device__ __forceinline__ int operator()(int n) const {
    if (n < 2048) return n; if (n < 2064) return 4608 + (n - 2048); return n - 16; } };
template <class RM> __device__ __forceinline__ void tr_item(const float* W, int K, int N, bf16* WT, int ldt, const RM rm, LAS float* scr, int item, int lane) {
    const int nblk = (N + 31) / 32, kb = item / nblk, nb = item - kb * nblk, k0 = 64 * kb, n0 = 32 * nb;
    const int c4 = (lane & 7) * 4, r8 = lane >> 3; const bool okc = (n0 + c4) < N;
    f32x4 v[8];
#pragma unroll
    for (int i = 0; i < 8; ++i) v[i] = okc ? *(const GAS f32x4*)(W + (size_t)(k0 + 8 * i + r8) * N + n0 + c4) : (f32x4){0.f, 0.f, 0.f, 0.f};
#pragma unroll
    for (int i = 0; i < 8; ++i) { LAS float* s = scr + (8 * i + r8) * 33 + c4; s[0] = v[i][0]; s[1] = v[i][1]; s[2] = v[i][2]; s[3] = v[i][3]; }
    LDS_WAIT(); asm volatile("" ::: "memory");
    const int c = lane & 7;
#pragma unroll
    for (int j = 0; j < 4; ++j) { const int n = (lane >> 3) + 8 * j; const LAS float* s = scr + (8 * c) * 33 + n;
        v4u o; o.x = pk2(s[0 * 33], s[1 * 33]); o.y = pk2(s[2 * 33], s[3 * 33]); o.z = pk2(s[4 * 33], s[5 * 33]); o.w = pk2(s[6 * 33], s[7 * 33]);
        if (n0 + n < N) *(GAS v4u*)(WT + (size_t)rm(n0 + n) * ldt + k0 + 8 * c) = o; }
    LDS_WAIT(); asm volatile("" ::: "memory");
}
__device__ __forceinline__ void zero_rows(bf16* p, size_t nbytes, int gt, int ngt) {
    for (size_t i = (size_t)gt; i < nbytes / 16; i += (size_t)ngt) ((GAS v4u*)p)[i] = (v4u){0u, 0u, 0u, 0u};
}
__device__ __forceinline__ unsigned pk4_fp8(float a, float b, float c, float d) { int w = 0; w = __builtin_amdgcn_cvt_pk_fp8_f32(a, b, w, false); w = __builtin_amdgcn_cvt_pk_fp8_f32(c, d, w, true); return (unsigned)w; }
template <class RM> __device__ __forceinline__ void tr_item8(const float* W, int K, int N, unsigned char* WT, int ldt, const RM rm, float sc, LAS float* scr, int item, int lane) {
    const int nblk = (N + 31) / 32, kb = item / nblk, nb = item - kb * nblk, k0 = 64 * kb, n0 = 32 * nb;
    const int c4 = (lane & 7) * 4, r8 = lane >> 3; const bool okc = (n0 + c4) < N;
    f32x4 v[8];
#pragma unroll
    for (int i = 0; i < 8; ++i) v[i] = okc ? *(const GAS f32x4*)(W + (size_t)(k0 + 8 * i + r8) * N + n0 + c4) : (f32x4){0.f, 0.f, 0.f, 0.f};
#pragma unroll
    for (int i = 0; i < 8; ++i) { LAS float* s = scr + (8 * i + r8) * 33 + c4; s[0] = v[i][0]; s[1] = v[i][1]; s[2] = v[i][2]; s[3] = v[i][3]; }
    LDS_WAIT(); asm volatile("" ::: "memory");
    const int c = lane & 7;
#pragma unroll
    for (int j = 0; j < 4; ++j) { const int n = (lane >> 3) + 8 * j; const LAS float* s = scr + (8 * c) * 33 + n;
        v2u o; o.x = pk4_fp8(s[0 * 33] * sc, s[1 * 33] * sc, s[2 * 33] * sc, s[3 * 33] * sc); o.y = pk4_fp8(s[4 * 33] * sc, s[5 * 33] * sc, s[6 * 33] * sc, s[7 * 33] * sc);
        if (n0 + n < N) *(GAS v2u*)(WT + (size_t)rm(n0 + n) * ldt + k0 + 8 * c) = o; }
    LDS_WAIT(); asm volatile("" ::: "memory");
}
constexpr int items_of(int K, int N) { return (K / 64) * ((N + 31) / 32); }

__device__ __forceinline__ void s5_small_tables(Frame& F, int g) {
    const float* lam_re = inp(I_LAMRE); const float* lam_im = inp(I_LAMIM); const float* log_dt = inp(I_LOGDT);
    const float* b_re = inp(I_BRE); const float* b_im = inp(I_BIM); const float* c_re = inp(I_CRE); const float* c_im = inp(I_CIM);
    LAS f32x2* APOW = (LAS f32x2*)(F.lds); LAS f32x2* BB = (LAS f32x2*)(F.lds + 2 * 64 * 65 * 8); LAS f32x2* CC = BB + 2 * 64 * 16;
    const int tid = F.tid;
    __syncthreads();
    if (tid < 128) {
        const int dir = tid >> 6, p = tid & 63; const int gi = (dir * S5G + g);
        const double dt = exp((double)log_dt[gi]); const double lr = (double)lam_re[gi * 64 + p], li = (double)lam_im[gi * 64 + p];
        const double mag = exp(lr * dt), ar = mag * cos(li * dt), ai = mag * sin(li * dt);
        double pr = 1.0, pi = 0.0;
        for (int k = 0; k <= 64; ++k) { APOW[(dir * 64 + p) * 65 + k] = (f32x2){(float)pr, (float)pi}; const double nr = pr * ar - pi * ai, ni = pr * ai + pi * ar; pr = nr; pi = ni; }
        const double den = lr * lr + li * li, nr = ar - 1.0, ni = ai;
        const double kr = (nr * lr + ni * li) / den, ki = (ni * lr - nr * li) / den;
        for (int n = 0; n < 16; ++n) { const double br = (double)b_re[(gi * 64 + p) * 16 + n], bi = (double)b_im[(gi * 64 + p) * 16 + n];
            BB[(dir * 64 + p) * 16 + n] = (f32x2){(float)(kr * br - ki * bi), (float)(kr * bi + ki * br)}; }
    }
    for (int i = tid; i < 2 * 16 * 64; i += NTHR) { const int dir = i >> 10, r = i & 1023; CC[i] = (f32x2){c_re[(size_t)(dir * S5G + g) * 1024 + r], c_im[(size_t)(dir * S5G + g) * 1024 + r]}; }
    __syncthreads();
}
__device__ __forceinline__ void s5_stage_a(Frame& F, int g, int part) {
    LAS f32x2* APOW = (LAS f32x2*)(F.lds); LAS f32x2* BB = (LAS f32x2*)(F.lds + 2 * 64 * 65 * 8); LAS f32x2* CC = BB + 2 * 64 * 16;
    float* TBG = (float*)(F.ws + WS_ARENA + A_TBG) + (size_t)g * (2 * 64 * 256);
    bf16* M1T = (bf16*)(F.ws + WS_ARENA + A_M1T) + (size_t)g * 256 * 1024;
    const int tid = F.tid;
    for (int i0 = tid; i0 < 2 * 8 * 256; i0 += NTHR) {
        const int dir = i0 >> 11, dl = 8 * part + ((i0 >> 8) & 7), np = (i0 >> 4) & 15, n = i0 & 15; float s = 0.f;
        for (int p = 0; p < 64; ++p) { const f32x2 c = CC[(dir * 16 + np) * 64 + p], a = APOW[(dir * 64 + p) * 65 + dl], b = BB[(dir * 64 + p) * 16 + n];
            const float zr = c.x * a.x - c.y * a.y, zi = c.x * a.y + c.y * a.x; s += zr * b.x - zi * b.y; }
        TBG[((dir * 64 + dl) * 16 + np) * 16 + n] = s;
    }
    for (int i = tid; i < 32 * 128; i += NTHR) {
        const int j = 32 * part + (i >> 7), c8 = (i & 127) * 8, sI = c8 >> 4, n0 = c8 & 15, dir = j >> 7, pt = (j >> 6) & 1, p = j & 63, e = dir ? sI : 63 - sI;
        const f32x2 a = APOW[(dir * 64 + p) * 65 + e]; float v[8];
#pragma unroll
        for (int q = 0; q < 8; ++q) { const f32x2 b = BB[(dir * 64 + p) * 16 + n0 + q]; v[q] = pt ? (a.x * b.y + a.y * b.x) : (a.x * b.x - a.y * b.y); }
        v4u o; o.x = pk2(v[0], v[1]); o.y = pk2(v[2], v[3]); o.z = pk2(v[4], v[5]); o.w = pk2(v[6], v[7]);
        *(GAS v4u*)(M1T + (size_t)j * 1024 + c8) = o;
    }
}
__device__ __forceinline__ void s5_stage_b(Frame& F, int g, int part) {
    LAS f32x2* APOW = (LAS f32x2*)(F.lds); LAS f32x2* CC = (LAS f32x2*)(F.lds + 2 * 64 * 65 * 8) + 2 * 64 * 16;
    const float* TBG = (const float*)(F.ws + WS_ARENA + A_TBG) + (size_t)g * (2 * 64 * 256);
    bf16* K3T = (bf16*)(F.ws + WS_ARENA + A_K3T) + (size_t)g * 1024 * S5K;
#pragma unroll 4
    for (int i = F.tid; i < 128 * (S5K / 8); i += NTHR) {
        const int row = 128 * part + i / (S5K / 8), c8 = (i % (S5K / 8)) * 8, tau = row >> 4, np = row & 15; float v[8];
        if (c8 < 1024) { const int sI = c8 >> 4, n0 = c8 & 15;
            f32x4 f0 = {0.f, 0.f, 0.f, 0.f}, f1 = f0, b0 = f0, b1 = f0;
            if (sI <= tau) { const GAS f32x4* tb = (const GAS f32x4*)(TBG + ((0 * 64 + (tau - sI)) * 16 + np) * 16 + n0); f0 = tb[0]; f1 = tb[1]; }
            if (sI >= tau) { const GAS f32x4* tb = (const GAS f32x4*)(TBG + ((1 * 64 + (sI - tau)) * 16 + np) * 16 + n0); b0 = tb[0]; b1 = tb[1]; }
            f0 += b0; f1 += b1; v[0] = f0[0]; v[1] = f0[1]; v[2] = f0[2]; v[3] = f0[3]; v[4] = f1[0]; v[5] = f1[1]; v[6] = f1[2]; v[7] = f1[3];
        } else { const int j0 = c8 - 1024, dir = j0 >> 7, pt = (j0 >> 6) & 1, e = dir ? 64 - tau : tau + 1;
#pragma unroll
            for (int q = 0; q < 8; ++q) { const int p = (j0 & 63) + q; const f32x2 c = CC[(dir * 16 + np) * 64 + p], a = APOW[(dir * 64 + p) * 65 + e];
                v[q] = pt ? -(c.x * a.y + c.y * a.x) : (c.x * a.x - c.y * a.y); } }
        v4u o; o.x = pk2(v[0], v[1]); o.y = pk2(v[2], v[3]); o.z = pk2(v[4], v[5]); o.w = pk2(v[6], v[7]);
        *(GAS v4u*)(K3T + (size_t)row * S5K + c8) = o;
    }
}

__device__ __forceinline__ void mod_item(Frame& F, int item) {
    const int l = item >> 7, slab = item & 127, col0 = 96 * slab;
    const float* wm = inp(I_WMOD) + (size_t)l * 2048 * 12288; const float* bm = inp(I_BMOD) + (size_t)l * 12288;
    LAS float* sv = (LAS float*)F.lds;
    LAS float* part = sv + 4096;
    __syncthreads();
    for (int i = F.tid; i < 4096; i += NTHR) { const float x = (i < 2048) ? inp(I_C)[i] : inp(I_CCTX)[i - 2048]; sv[i] = siluf_(x); }
    __syncthreads();
    const int sub = F.lane / 24, cl = F.lane % 24;
    f32x4 a0 = {0.f, 0.f, 0.f, 0.f}, a1 = {0.f, 0.f, 0.f, 0.f};
    if (sub < 2) {
        const float* wp = wm + (size_t)(256 * F.wave + sub) * 12288 + col0 + 4 * cl;
#pragma unroll 8
        for (int kk = 0; kk < 256; kk += 2) { const f32x4 w = *(const GAS f32x4*)(wp + (size_t)kk * 12288); const int k = 256 * F.wave + kk + sub;
            const float s0 = sv[k], s1 = sv[2048 + k]; a0 += w * s0; a1 += w * s1; }
        LAS float* pp = part + ((F.wave * 2 + sub) * 24 + cl) * 8;
        pp[0] = a0[0]; pp[1] = a0[1]; pp[2] = a0[2]; pp[3] = a0[3]; pp[4] = a1[0]; pp[5] = a1[1]; pp[6] = a1[2]; pp[7] = a1[3];
    }
    __syncthreads();
    if (F.tid < 192) { const int w = F.tid / 96, c = F.tid % 96; float s = 0.f;
        for (int q = 0; q < 16; ++q) s += part[(q * 24 + (c >> 2)) * 8 + w * 4 + (c & 3)];
        float* MODF = (float*)(F.ws + WS_MODF); MODF[(size_t)(l * 2 + w) * 12288 + col0 + c] = s + bm[col0 + c]; }
    __syncthreads();
}

constexpr int units_of(int K, int N) { return (K / 128) * ((N + 255) / 256); }
constexpr int CU_SQ = units_of(2048, 2048), CU_PW = units_of(384, 384), CU_GL = units_of(512, 512), CU_UP = units_of(2048, 7168), CU_DN = units_of(7168, 2048), CU_WO = units_of(2048, 4624);
constexpr int CQ_E0 = 0, CQ_E1 = CQ_E0 + CU_SQ  , CQ_E2 = CQ_E1 + 4 * CU_PW  , CQ_E3 = CQ_E2 + CU_GL  , CQ_E4 = CQ_E3 + CU_SQ  ,
              CQ_F1 = CQ_E4 + CU_UP  , CQ_F2 = CQ_F1 + CU_UP  , CQ_F3 = CQ_F2 + CU_DN  , CQ_O1 = CQ_F3 + CU_WO  , CQ_O2 = CQ_O1 + CU_SQ  ,
              CQ_M1 = CQ_O2 + 8 * CU_UP  , CQ_M2 = CQ_M1 + 8 * CU_UP  , CQ_M3 = CQ_M2 + 8 * CU_DN  , CQ_END = CQ_M3;
constexpr int CW_QUEUE = 2048;
struct ConvDesc { const float* W; unsigned char* WT; int N, ldt, kind, fp8, k0, n0, pitch, kbyte; float sc; };
__device__ __forceinline__ void conv_decode(Frame& F, int it, ConvDesc& d) {
    int r = it; d.kind = 0; d.fp8 = 0; d.sc = 1.f;
    if (r < CQ_E1) { d.W = inp(I_EWIN); d.WT = F.ws + WS_WINE; d.N = 2048; d.ldt = 2048; }
    else if (r < CQ_E2) { r -= CQ_E1; const int g4 = r / CU_PW; d.W = inp(I_EPOOLW) + (size_t)g4 * 384 * 384; d.WT = F.ws + WS_WPOOL + (size_t)g4 * 512 * 384 * 2; d.N = 384; d.ldt = 384; r -= g4 * CU_PW; }
    else if (r < CQ_E3) { d.W = inp(I_WGLU); d.WT = F.ws + WS_WGLU; d.N = 512; d.ldt = 512; r -= CQ_E2; }
    else if (r < CQ_E4) { d.W = inp(I_EWOUT); d.WT = F.ws + WS_WOUTE; d.N = 2048; d.ldt = 2048; r -= CQ_E3; }
    else if (r < CQ_F2) { const int up = r >= CQ_F1; d.W = inp(up ? I_FFU : I_FFG); d.WT = F.ws + WS_WGU; d.N = 7168; d.ldt = 2048; d.kind = 1 + up; r -= (up ? CQ_F1 : CQ_E4);
        if (FFN_FP8 == 1) { d.fp8 = 1; d.sc = MOE_WSC_GU; } }
    else if (r < CQ_F3) { d.W = inp(I_FFD); d.WT = F.ws + WS_WDN; d.N = 2048; d.ldt = 7168; r -= CQ_F2; if (FFN_FP8 != 0) { d.fp8 = 1; d.sc = MOE_WSC_DN; } }
    else if (r < CQ_O1) { d.W = inp(I_OWIN); d.WT = F.ws + WS_WINO; d.N = 4624; d.ldt = 2048; d.kind = 3; r -= CQ_F3; }
    else if (r < CQ_O2) { d.W = inp(I_OWOUT); d.WT = F.ws + WS_WOUTO; d.N = 2048; d.ldt = 2048; r -= CQ_O1; }
    else if (r < CQ_M2) { d.fp8 = 1; const int up = r >= CQ_M1; r -= up ? CQ_M1 : CQ_O2; const int e = r / CU_UP; d.W = inp(up ? I_MOEU : I_MOEG) + (size_t)e * 2048 * 7168; d.WT = F.ws + WS_WMGU + (size_t)e * 14336 * 2048;
        d.N = 7168; d.ldt = 2048; d.kind = 1 + up; d.sc = MOE_WSC_GU; r -= e * CU_UP; }
    else { d.fp8 = 1; r -= CQ_M2; const int e = r / CU_DN; d.W = inp(I_MOED) + (size_t)e * 7168 * 2048; d.WT = F.ws + WS_WMDN + (size_t)e * 2048 * 7168; d.N = 2048; d.ldt = 7168; d.sc = MOE_WSC_DN; r -= e * CU_DN; }
    const int nblk = (d.N + 255) / 256, kb = r / nblk; d.k0 = 128 * kb; d.n0 = 256 * (r - kb * nblk);
    d.pitch = d.fp8 ? d.ldt : 2 * d.ldt; d.kbyte = d.fp8 ? d.k0 : 2 * d.k0;
    if (FFN_FP8 == 2 && FFNU_K1 < 2048 && it >= CQ_E4 && it < CQ_F2) {
        d.pitch = 2 * FFNU_K1 + (2048 - FFNU_K1);
        if (d.k0 >= FFNU_K1) { d.fp8 = 1; d.sc = MOE_WSC_GU; d.kbyte = 2 * FFNU_K1 + (d.k0 - FFNU_K1); } }
}
__device__ __forceinline__ int conv_row(int kind, int n) {
    if (kind == 0) return n; if (kind == 3) return RmWinO{}(n); return (n >> 7) * 256 + (kind - 1) * 128 + (n & 127); }
__device__ __forceinline__ void conv_load(const ConvDesc& d, int wave, int lane, f32x4 (&v)[16]) {
    const bool okc = (d.n0 + 4 * lane) < d.N; const float* p = d.W + (size_t)(d.k0 + 16 * wave) * d.N + d.n0 + 4 * lane;
#pragma unroll
    for (int i = 0; i < 16; ++i) v[i] = okc ? __builtin_nontemporal_load((const GAS f32x4*)(p + (size_t)i * d.N)) : (f32x4){0.f, 0.f, 0.f, 0.f};
}
__device__ __forceinline__ void conv_to_lds(const f32x4 (&v)[16], LAS float* tile, int wave, int lane) {
#pragma unroll
    for (int i = 0; i < 16; ++i) *(LAS f32x4*)(tile + (16 * wave + i) * 256 + ((lane ^ ((2 * wave + (i >> 3)) & 7)) << 2)) = v[i];
}
__device__ __forceinline__ void conv_store(const ConvDesc& d, const LAS float* tile, int tid) {
    const int c = tid & 7;
    if (d.fp8) {
#pragma unroll
        for (int q = 0; q < 4; ++q) { const int nn = (tid >> 3) + 64 * q; float x[16];
#pragma unroll
            for (int j = 0; j < 16; ++j) { const int k = 16 * c + j; x[j] = tile[k * 256 + ((((nn >> 2) ^ ((k >> 3) & 7)) & 63) << 2) + (nn & 3)]; }
            if (d.n0 + nn < d.N) { const size_t row = (size_t)conv_row(d.kind, d.n0 + nn); v4u o;
                o.x = pk4_fp8(x[0] * d.sc, x[1] * d.sc, x[2] * d.sc, x[3] * d.sc); o.y = pk4_fp8(x[4] * d.sc, x[5] * d.sc, x[6] * d.sc, x[7] * d.sc);
                o.z = pk4_fp8(x[8] * d.sc, x[9] * d.sc, x[10] * d.sc, x[11] * d.sc); o.w = pk4_fp8(x[12] * d.sc, x[13] * d.sc, x[14] * d.sc, x[15] * d.sc);
                __builtin_nontemporal_store(o, (GAS v4u*)(d.WT + row * d.pitch + d.kbyte + 16 * c)); } }
    } else {
#pragma unroll
        for (int q = 0; q < 8; ++q) { const int kh = q & 1, nn = (tid >> 3) + 64 * (q >> 1); const LAS float* s = tile + (64 * kh + 8 * c) * 256 + (((nn >> 2) ^ c) << 2) + (nn & 3);
            float x[8];
#pragma unroll
            for (int j = 0; j < 8; ++j) x[j] = s[j * 256];
            if (d.n0 + nn < d.N) { const size_t row = (size_t)conv_row(d.kind, d.n0 + nn);
                v4u o; o.x = pk2(x[0], x[1]); o.y = pk2(x[2], x[3]); o.z = pk2(x[4], x[5]); o.w = pk2(x[6], x[7]);
                __builtin_nontemporal_store(o, (GAS v4u*)(d.WT + row * d.pitch + d.kbyte + (64 * kh + 8 * c) * 2)); } }
    }
}
constexpr int CQ_NONE = 0x7fffffff;
__device__ __forceinline__ int conv_pull(Frame& F) { return (int)__hip_atomic_fetch_add((unsigned*)(F.ctl + CW_QUEUE), 1u, RLX_AGENT); }
__device__ __forceinline__ void conv_work(Frame& F, int dlimit, int quota) {
    LAS float* tile = (LAS float*)(F.lds + RING_OFF);
    volatile LAS int* QW = (volatile LAS int*)(F.lds + LDSCTL_OFF);
    __syncthreads();
    if (F.tid == 0) { int c0 = CQ_NONE, c1 = CQ_NONE; const int head = (int)__hip_atomic_load((unsigned*)(F.ctl + CW_QUEUE), RLX_AGENT);
        if (head < CQ_END && (quota > 0 || head < dlimit)) { c0 = conv_pull(F); if (c0 < CQ_END && (quota > 1 || c0 < dlimit)) c1 = conv_pull(F); }
        QW[0] = c0; QW[1] = c1; }
    __syncthreads();
    int cur = __builtin_amdgcn_readfirstlane(QW[0]), nxt = __builtin_amdgcn_readfirstlane(QW[1]);
    int npull = (cur != CQ_NONE) + (nxt != CQ_NONE);
    __syncthreads();
    if (cur >= CQ_END) return;
    ConvDesc d; f32x4 v[16]; conv_decode(F, cur, d); conv_load(d, F.wave, F.lane, v);
    for (;;) {
        conv_to_lds(v, tile, F.wave, F.lane); LDS_WAIT(); __syncthreads();
        const bool more = nxt < CQ_END; ConvDesc dn = d;
        if (more) { conv_decode(F, nxt, dn); conv_load(dn, F.wave, F.lane, v); }
        const bool pull = more && (npull < quota || nxt < dlimit);
        conv_store(d, tile, F.tid);
        if (pull && F.tid == 0) QW[0] = conv_pull(F);
        LDS_WAIT(); __syncthreads();
        if (!more) break;
        cur = nxt; nxt = pull ? __builtin_amdgcn_readfirstlane(QW[0]) : CQ_NONE; npull += pull ? 1 : 0; d = dn;
    }
}
__device__ __forceinline__ int fill_quota(int nunits, int G, int c, int Q) { const int mine = nunits > c ? (nunits - 1 - c) / G + 1 : 0, most = (nunits + G - 1) / G; return mine < most ? Q : 0; }
__device__ __forceinline__ void p0_prologue(Frame& F) {
    const int gw = F.vcu * NWAVES + F.wave, NGW = F.G * NWAVES, gt = gw * 64 + F.lane, ngt = NGW * 64;
    for (int it = blockIdx.x; it < 256; it += F.G) mod_item(F, it);
    for (int it = blockIdx.x; it < S5G * 8; it += F.G) { s5_small_tables(F, it >> 3); s5_stage_a(F, it >> 3, it & 7); }
    { float* rp = (float*)(F.ws + WS_ROPE); for (int i = gt; i < 256 * 32; i += ngt) { const int pos = i >> 5, fi = i & 31; const float fr = powf(10000.f, -(float)fi / 32.f), ang = (float)pos * fr;
        rp[2 * i] = cosf(ang); rp[2 * i + 1] = sinf(ang); } }
    for (int g4 = 0; g4 < 4; ++g4) zero_rows((bf16*)(F.ws + WS_WPOOL) + ((size_t)g4 * 512 + 384) * 384, (size_t)128 * 384 * 2, gt, ngt);
    zero_rows((bf16*)(F.ws + WS_WINO) + (size_t)4624 * 2048, (size_t)(WINO_N - 4624) * 2048 * 2, gt, ngt);
    __syncthreads();
    conv_work(F, CQ_E4, 0);
    __syncthreads();
}

#define PV(k) ((LAS float*)(F.lds + (k) * 8192))
__device__ __forceinline__ void ld_row_f32(const float* p, int lane, f32x4 (&v)[8]) {
#pragma unroll
    for (int j = 0; j < 8; ++j) v[j] = *(const GAS f32x4*)(p + 4 * lane + 256 * j);
}
__device__ __forceinline__ void st_row_f32(float* p, int lane, const f32x4 (&v)[8]) {
#pragma unroll
    for (int j = 0; j < 8; ++j) *(GAS f32x4*)(p + 4 * lane + 256 * j) = v[j];
}
__device__ __forceinline__ void ld_row_bf16(const bf16* p, int lane, f32x4 (&v)[8]) {
#pragma unroll
    for (int j = 0; j < 8; ++j) { const v2u w = *(const GAS v2u*)(p + 4 * lane + 256 * j); v[j] = (f32x4){bflo(w.x), bfhi(w.x), bflo(w.y), bfhi(w.y)}; }
}
__device__ __forceinline__ void st_row_bf16(bf16* p, int lane, const f32x4 (&v)[8]) {
#pragma unroll
    for (int j = 0; j < 8; ++j) { v2u w; w.x = pk2(v[j][0], v[j][1]); w.y = pk2(v[j][2], v[j][3]); *(GAS v2u*)(p + 4 * lane + 256 * j) = w; }
}
__device__ __forceinline__ float row_sumsq(const f32x4 (&v)[8]) {
    float s = 0.f;
#pragma unroll
    for (int j = 0; j < 8; ++j) s += (v[j][0] * v[j][0] + v[j][1] * v[j][1]) + (v[j][2] * v[j][2] + v[j][3] * v[j][3]);
    return wave_sum(s);
}
__device__ __forceinline__ f32x4 ldp(const LAS float* p, int lane, int j) { return *(const LAS f32x4*)(p + 4 * lane + 256 * j); }
__device__ __forceinline__ const float* modp(Frame& F, int layer, int w, int k) { return (const float*)(F.ws + WS_MODF) + (size_t)(layer * 2 + w) * 12288 + k * 2048; }
__device__ __forceinline__ const float* h0_row(Frame& F, int m) { return m < CTX ? inp(I_CTX) + (size_t)m * D : inp(I_X) + (size_t)(m - CTX) * D; }

__device__ __forceinline__ void ph_norm0(Frame& F) {
    __syncthreads();
    for (int i = F.tid; i < 2 * 2048; i += NTHR) { const int w = i >> 11, c = i & 2047;
        PV(2 * w)[c] = inp(I_NORMS)[0 * 2048 + c] * (1.f + modp(F, 0, w, 1)[c]); PV(2 * w + 1)[c] = modp(F, 0, w, 0)[c]; }
    __syncthreads();
    bf16* U = (bf16*)(F.ws + WS_ARENA + A_U);
    const int gw = F.vcu * NWAVES + F.wave, NGW = F.G * NWAVES;
    for (int m = gw; m < T; m += NGW) { const int w = m < CTX ? 1 : 0; f32x4 v[8]; ld_row_f32(h0_row(F, m), F.lane, v);
        const float rstd = 1.f / sqrtf(row_sumsq(v) * (1.f / D) + EPS);
#pragma unroll
        for (int j = 0; j < 8; ++j) v[j] = v[j] * rstd * ldp(PV(2 * w), F.lane, j) + ldp(PV(2 * w + 1), F.lane, j);
        st_row_bf16(U + (size_t)m * D, F.lane, v); }
}
__device__ __forceinline__ void ph_norm1(Frame& F) {
    __syncthreads();
    for (int i = F.tid; i < 2 * 2048; i += NTHR) { const int w = i >> 11, c = i & 2047;
        PV(3 * w)[c] = modp(F, 0, w, 2)[c] * inp(I_NORMS)[1 * 2048 + c]; PV(3 * w + 1)[c] = inp(I_NORMS)[2 * 2048 + c] * (1.f + modp(F, 0, w, 4)[c]); PV(3 * w + 2)[c] = modp(F, 0, w, 3)[c]; }
    __syncthreads();
    const bf16* YO = (const bf16*)(F.ws + WS_ARENA + A_YO); bf16* V = (bf16*)(F.ws + WS_ARENA + A_V); bf16* HR = (bf16*)(F.ws + WS_HRES);
    const int gw = F.vcu * NWAVES + F.wave, NGW = F.G * NWAVES;
    for (int m = gw; m < T; m += NGW) { const int w = m < CTX ? 1 : 0; f32x4 y[8], h[8]; ld_row_bf16(YO + (size_t)m * D, F.lane, y); ld_row_f32(h0_row(F, m), F.lane, h);
        const float ry = 1.f / sqrtf(row_sumsq(y) * (1.f / D) + EPS);
#pragma unroll
        for (int j = 0; j < 8; ++j) h[j] = h[j] + y[j] * ry * ldp(PV(3 * w), F.lane, j);
        st_row_bf16(HR + (size_t)m * D, F.lane, h);
        const float rh = 1.f / sqrtf(row_sumsq(h) * (1.f / D) + EPS);
#pragma unroll
        for (int j = 0; j < 8; ++j) y[j] = h[j] * rh * ldp(PV(3 * w + 1), F.lane, j) + ldp(PV(3 * w + 2), F.lane, j);
#if FFN_FP8 == 1
        { unsigned char* V8 = (unsigned char*)V + (size_t)m * D;
#pragma unroll
          for (int j = 0; j < 8; ++j) *(GAS unsigned*)(V8 + 4 * F.lane + 256 * j) = pk4_fp8(y[j][0], y[j][1], y[j][2], y[j][3]); }
#elif FFN_FP8 == 2 && FFNU_K1 < 2048
        { unsigned char* Vr = (unsigned char*)V + (size_t)m * (2 * FFNU_K1 + (2048 - FFNU_K1));
#pragma unroll
          for (int j = 0; j < 8; ++j) { const int col = 4 * F.lane + 256 * j;
              if (256 * j < FFNU_K1) { v2u w; w.x = pk2(y[j][0], y[j][1]); w.y = pk2(y[j][2], y[j][3]); *(GAS v2u*)(Vr + 2 * col) = w; }
              else *(GAS unsigned*)(Vr + 2 * FFNU_K1 + (col - FFNU_K1)) = pk4_fp8(y[j][0], y[j][1], y[j][2], y[j][3]); } }
#else
        st_row_bf16(V + (size_t)m * D, F.lane, y);
#endif
    }
}
__device__ __forceinline__ void ph_norm2(Frame& F) {
    __syncthreads();
    for (int i = F.tid; i < 2 * 2048; i += NTHR) { const int w = i >> 11, c = i & 2047;
        PV(3 * w)[c] = modp(F, 0, w, 5)[c] * inp(I_NORMS)[3 * 2048 + c]; PV(3 * w + 1)[c] = inp(I_NORMS)[(4 + 0) * 2048 + c] * (1.f + modp(F, 1, w, 1)[c]); PV(3 * w + 2)[c] = modp(F, 1, w, 0)[c]; }
    __syncthreads();
    const bf16* FB = (const bf16*)(F.ws + WS_ARENA + A_F); bf16* U = (bf16*)(F.ws + WS_ARENA + A_U); bf16* HR = (bf16*)(F.ws + WS_HRES);
    const int gw = F.vcu * NWAVES + F.wave, NGW = F.G * NWAVES;
    for (int m = gw; m < T; m += NGW) { const int w = m < CTX ? 1 : 0; f32x4 y[8], h[8]; ld_row_bf16(FB + (size_t)m * D, F.lane, y); ld_row_bf16(HR + (size_t)m * D, F.lane, h);
        const float ry = 1.f / sqrtf(row_sumsq(y) * (1.f / D) + EPS);
#pragma unroll
        for (int j = 0; j < 8; ++j) h[j] = h[j] + y[j] * ry * ldp(PV(3 * w), F.lane, j);
        st_row_bf16(HR + (size_t)m * D, F.lane, h);
        const float rh = 1.f / sqrtf(row_sumsq(h) * (1.f / D) + EPS);
#pragma unroll
        for (int j = 0; j < 8; ++j) y[j] = h[j] * rh * ldp(PV(3 * w + 1), F.lane, j) + ldp(PV(3 * w + 2), F.lane, j);
        st_row_bf16(U + (size_t)m * D, F.lane, y); }
}
__device__ __forceinline__ void ph_emit(Frame& F, float* out) {
    const bf16* HR = (const bf16*)(F.ws + WS_HRES) + (size_t)CTX * D;
    for (size_t i = (size_t)blockIdx.x * NTHR + F.tid; i < (size_t)SEQ * D / 4; i += (size_t)F.G * NTHR) { const v2u w = ((const GAS v2u*)HR)[i]; ((GAS f32x4*)out)[i] = (f32x4){bflo(w.x), bfhi(w.x), bflo(w.y), bfhi(w.y)}; }
}

__device__ __forceinline__ void ph_pooldiff(Frame& F) {
    const bf16* ZP = (const bf16*)(F.ws + WS_ARENA + A_ZP); bf16* DP = (bf16*)(F.ws + WS_ARENA + A_DP);
    const size_t nitem = (size_t)T * (WPOOL / 8);
    for (size_t it = (size_t)F.vcu * NTHR + F.tid; it < nitem; it += (size_t)F.G * NTHR) {
        const int t = (int)(it / (WPOOL / 8)), c8 = (int)(it % (WPOOL / 8)) * 8, gi = c8 / PG, w = 2 << gi;
        const int s0 = t < CTX ? 0 : CTX, L = t < CTX ? CTX : SEQ, tp = t - s0;
        int lo = tp - w / 2; lo = lo < 0 ? 0 : lo; int hi = tp + (w - w / 2); hi = hi > L ? L : hi;
        float s[8];
#pragma unroll
        for (int q = 0; q < 8; ++q) s[q] = 0.f;
        for (int r = lo; r < hi; ++r) { const v4u x = *(const GAS v4u*)(ZP + (size_t)(s0 + r) * WPOOL + c8);
            s[0] += bflo(x.x); s[1] += bfhi(x.x); s[2] += bflo(x.y); s[3] += bfhi(x.y); s[4] += bflo(x.z); s[5] += bfhi(x.z); s[6] += bflo(x.w); s[7] += bfhi(x.w); }
        const float inv = 1.f / (float)(hi - lo); const v4u z = *(const GAS v4u*)(ZP + (size_t)t * WPOOL + c8);
        v4u o; o.x = pk2(s[0] * inv - bflo(z.x), s[1] * inv - bfhi(z.x)); o.y = pk2(s[2] * inv - bflo(z.y), s[3] * inv - bfhi(z.y));
        o.z = pk2(s[4] * inv - bflo(z.z), s[5] * inv - bfhi(z.z)); o.w = pk2(s[6] * inv - bflo(z.w), s[7] * inv - bfhi(z.w));
        *(GAS v4u*)(DP + (size_t)t * WPOOL + c8) = o;
    }
}

__device__ __forceinline__ void ph_s5scan(Frame& F) {
    const int gth = blockIdx.x * NTHR + F.tid; if (gth >= S5G * 2 * 64) return;
    const int g = gth >> 7, dir = (gth >> 6) & 1, p = gth & 63, gi = dir * S5G + g;
    const double dt = exp((double)inp(I_LOGDT)[gi]), lr = (double)inp(I_LAMRE)[gi * 64 + p], li = (double)inp(I_LAMIM)[gi * 64 + p];
    const float aLr = (float)(exp(lr * dt * LC) * cos(li * dt * LC)), aLi = (float)(exp(lr * dt * LC) * sin(li * dt * LC));
    const float* SL = (const float*)(F.ws + WS_ARENA + A_SLOC) + (size_t)g * S5ROWS * 256 + dir * 128 + p;
    bf16* CA = (bf16*)(F.ws + WS_ARENA + A_AS5) + (size_t)g * S5ROWS * S5K + 1024 + dir * 128 + p;
    float er = 0.f, ei = 0.f;
    for (int i0 = 0; i0 < NCH; i0 += 4) {
        int cc[4]; float sr[4], si[4];
#pragma unroll
        for (int q = 0; q < 4; ++q) { const int i = i0 + q; cc[q] = dir == 0 ? i : (i < NCH_CTX ? NCH_CTX - 1 - i : NCH - 1 - (i - NCH_CTX));
            sr[q] = SL[(size_t)cc[q] * 256]; si[q] = SL[(size_t)cc[q] * 256 + 64]; }
#pragma unroll
        for (int q = 0; q < 4; ++q) { CA[(size_t)cc[q] * S5K] = (bf16)f2bf(er); CA[(size_t)cc[q] * S5K + 64] = (bf16)f2bf(ei);
            const float nr = aLr * er - aLi * ei + sr[q], ni = aLr * ei + aLi * er + si[q]; er = nr; ei = ni; }
    }
}

typedef unsigned u32x4 __attribute__((ext_vector_type(4)));
using pg8::Unit; using pg8::pack8;
typedef const pg8::f32x4 (&AccRef)[2][2][4][2];
#define EPI_ROWS(u) const int row0 = (u).pm * 256 + wr * 64 + fr
struct EpiPlain { static constexpr bool PERM = true; bf16* O; int ldc;
    __device__ __forceinline__ void operator()(AccRef acc, const Unit& u, int wr, int wc, int fr, int fq) const { EPI_ROWS(u); const int col0 = u.pn * 256 + wc * 32 + 8 * fq;
#pragma unroll
        for (int ai = 0; ai < 2; ++ai)
#pragma unroll
            for (int m = 0; m < 4; ++m) { bf16* rp = O + (size_t)(row0 + ai * 128 + m * 16) * ldc + col0;
#pragma unroll
                for (int bj = 0; bj < 2; ++bj) *(GAS u32x4*)(rp + bj * 128) = pack8(acc[ai][bj][m][0], acc[ai][bj][m][1]); } } };
struct EpiWinE { static constexpr bool PERM = true; bf16* ZP; bf16* AS5;
    __device__ __forceinline__ void operator()(AccRef acc, const Unit& u, int wr, int wc, int fr, int fq) const { EPI_ROWS(u); const int col0 = u.pn * 256 + wc * 32 + 8 * fq;
#pragma unroll
        for (int ai = 0; ai < 2; ++ai)
#pragma unroll
            for (int m = 0; m < 4; ++m) { const int row = row0 + ai * 128 + m * 16;
#pragma unroll
                for (int bj = 0; bj < 2; ++bj) { const int col = col0 + bj * 128; const u32x4 w = pack8(acc[ai][bj][m][0], acc[ai][bj][m][1]);
                    if (u.pn < 6) *(GAS u32x4*)(ZP + (size_t)row * WPOOL + col) = w;
                    else { const int cc = col - WPOOL, g = cc >> 4, n0 = cc & 15, c = row >> 6, s = row & 63; *(GAS u32x4*)(AS5 + ((size_t)(g * S5ROWS + c) * S5K + s * 16 + n0)) = w; } } } } };
struct EpiPool { static constexpr bool PERM = true; bf16* YMIX; const float* scale;
    __device__ __forceinline__ void operator()(AccRef acc, const Unit& u, int wr, int wc, int fr, int fq) const { EPI_ROWS(u); const int lc0 = u.pn * 256 + wc * 32 + 8 * fq;
#pragma unroll
        for (int bj = 0; bj < 2; ++bj) { const int lc = lc0 + bj * 128; if (lc >= PG) continue; const int gc = u.bz * PG + lc;
            const f32x4 s0 = *(const GAS f32x4*)(scale + gc), s1 = *(const GAS f32x4*)(scale + gc + 4);
#pragma unroll
            for (int ai = 0; ai < 2; ++ai)
#pragma unroll
                for (int m = 0; m < 4; ++m) { const int row = row0 + ai * 128 + m * 16; *(GAS u32x4*)(YMIX + (size_t)row * D + gc) = pack8(acc[ai][bj][m][0] * s0, acc[ai][bj][m][1] * s1); } } } };
struct EpiSloc { static constexpr bool PERM = false; float* SL;
    __device__ __forceinline__ void operator()(AccRef acc, const Unit& u, int wr, int wc, int fr, int fq) const { EPI_ROWS(u); const int col0 = u.pn * 256 + wc * 32 + 4 * fq;
#pragma unroll
        for (int ai = 0; ai < 2; ++ai)
#pragma unroll
            for (int m = 0; m < 4; ++m) { float* rp = SL + ((size_t)u.bz * S5ROWS + row0 + ai * 128 + m * 16) * 256 + col0;
#pragma unroll
                for (int bj = 0; bj < 2; ++bj)
#pragma unroll
                    for (int n = 0; n < 2; ++n) *(GAS f32x4*)(rp + bj * 128 + n * 16) = acc[ai][bj][m][n]; } } };
struct EpiS5Y { static constexpr bool PERM = true; const bf16* AS5; const float* dsk; bf16* YG;
    __device__ __forceinline__ void operator()(AccRef acc, const Unit& u, int wr, int wc, int fr, int fq) const { EPI_ROWS(u); const int col0 = u.pn * 256 + wc * 32 + 8 * fq;
#pragma unroll
        for (int bj = 0; bj < 2; ++bj) { const int col = col0 + bj * 128, tau = col >> 4, n0 = col & 15;
            const f32x4 d0 = *(const GAS f32x4*)(dsk + u.bz * 16 + n0), d1 = *(const GAS f32x4*)(dsk + u.bz * 16 + n0 + 4);
#pragma unroll
            for (int ai = 0; ai < 2; ++ai)
#pragma unroll
                for (int m = 0; m < 4; ++m) { const int c = row0 + ai * 128 + m * 16; if (c >= NCH) continue;
                    const v4u x = *(const GAS v4u*)(AS5 + ((size_t)(u.bz * S5ROWS + c) * S5K + col));
                    f32x4 a = acc[ai][bj][m][0], b = acc[ai][bj][m][1];
                    a[0] = gelu_tanh(a[0] + bflo(x.x) * d0[0]); a[1] = gelu_tanh(a[1] + bfhi(x.x) * d0[1]); a[2] = gelu_tanh(a[2] + bflo(x.y) * d0[2]); a[3] = gelu_tanh(a[3] + bfhi(x.y) * d0[3]);
                    b[0] = gelu_tanh(b[0] + bflo(x.z) * d1[0]); b[1] = gelu_tanh(b[1] + bfhi(x.z) * d1[1]); b[2] = gelu_tanh(b[2] + bflo(x.w) * d1[2]); b[3] = gelu_tanh(b[3] + bfhi(x.w) * d1[3]);
                    *(GAS u32x4*)(YG + ((size_t)(c * 64 + tau) * WS5 + u.bz * 16 + n0)) = pack8(a, b); } } } };
struct EpiGlu { static constexpr bool PERM = true; const bf16* YG; bf16* YMIX;
    __device__ __forceinline__ void operator()(AccRef acc, const Unit& u, int wr, int wc, int fr, int fq) const { EPI_ROWS(u); const int col0 = u.pn * 256 + wc * 32 + 8 * fq;
#pragma unroll
        for (int ai = 0; ai < 2; ++ai)
#pragma unroll
            for (int m = 0; m < 4; ++m) { const int row = row0 + ai * 128 + m * 16;
#pragma unroll
                for (int bj = 0; bj < 2; ++bj) { const int col = col0 + bj * 128; const v4u x = *(const GAS v4u*)(YG + (size_t)row * WS5 + col);
                    f32x4 a = acc[ai][bj][m][0], b = acc[ai][bj][m][1];
                    a[0] = bflo(x.x) * sigmoidf_(a[0]); a[1] = bfhi(x.x) * sigmoidf_(a[1]); a[2] = bflo(x.y) * sigmoidf_(a[2]); a[3] = bfhi(x.y) * sigmoidf_(a[3]);
                    b[0] = bflo(x.z) * sigmoidf_(b[0]); b[1] = bfhi(x.z) * sigmoidf_(b[1]); b[2] = bflo(x.w) * sigmoidf_(b[2]); b[3] = bfhi(x.w) * sigmoidf_(b[3]);
                    *(GAS u32x4*)(YMIX + (size_t)row * D + WPOOL + col) = pack8(a, b); } } } };
struct EpiGateUp { static constexpr bool PERM = true; bf16* HID; int ldc;
    __device__ __forceinline__ void operator()(AccRef acc, const Unit& u, int wr, int wc, int fr, int fq) const { EPI_ROWS(u); const int col0 = u.pn * 128 + wc * 32 + 8 * fq;
#pragma unroll
        for (int ai = 0; ai < 2; ++ai)
#pragma unroll
            for (int m = 0; m < 4; ++m) { const int row = row0 + ai * 128 + m * 16; f32x4 a, b;
#pragma unroll
                for (int q = 0; q < 4; ++q) { a[q] = swiglu_fast(acc[ai][0][m][0][q], acc[ai][1][m][0][q], -1.4426950408889634f, 1.f); b[q] = swiglu_fast(acc[ai][0][m][1][q], acc[ai][1][m][1][q], -1.4426950408889634f, 1.f); }
                *(GAS u32x4*)(HID + (size_t)row * ldc + col0) = pack8(a, b); } } };

struct EpiWinO { static constexpr bool PERM = true; unsigned char* ar;
    __device__ __forceinline__ void operator()(AccRef acc, const Unit& u, int wr, int wc, int fr, int fq) const { EPI_ROWS(u); const int pn = u.pn;
        if (pn == 18) { if (wc == 0 && fq < 2) { float* ALR = (float*)(ar + B_ALR);
#pragma unroll
                for (int ai = 0; ai < 2; ++ai)
#pragma unroll
                    for (int m = 0; m < 4; ++m) { float* rp = ALR + (size_t)(row0 + ai * 128 + m * 16) * 16 + 8 * fq; *(GAS f32x4*)rp = acc[ai][0][m][0]; *(GAS f32x4*)(rp + 4) = acc[ai][0][m][1]; } }
            return; }
        bf16* base; int ld, c0;
        if (pn < 2) { base = (bf16*)(ar + B_GQ); ld = 512; c0 = pn * 256; } else if (pn < 4) { base = (bf16*)(ar + B_GK); ld = 512; c0 = (pn - 2) * 256; }
        else if (pn < 8) { base = (bf16*)(ar + B_GV); ld = 1024; c0 = (pn - 4) * 256; } else if (pn < 12) { base = (bf16*)(ar + B_R); ld = 1024; c0 = (pn - 8) * 256; }
        else if (pn < 16) { base = (bf16*)(ar + B_AQ); ld = 1024; c0 = (pn - 12) * 256; } else if (pn == 16) { base = (bf16*)(ar + B_AK); ld = 256; c0 = 0; } else { base = (bf16*)(ar + B_AV); ld = 256; c0 = 0; }
        const int col0 = c0 + wc * 32 + 8 * fq;
#pragma unroll
        for (int ai = 0; ai < 2; ++ai)
#pragma unroll
            for (int m = 0; m < 4; ++m) { bf16* rp = base + (size_t)(row0 + ai * 128 + m * 16) * ld + col0;
#pragma unroll
                for (int bj = 0; bj < 2; ++bj) *(GAS u32x4*)(rp + bj * 128) = pack8(acc[ai][bj][m][0], acc[ai][bj][m][1]); } } };

__device__ __forceinline__ void ph_qknorm(Frame& F) {
    unsigned char* ar = F.ws + WS_ARENA; bf16* AQ = (bf16*)(ar + B_AQ); bf16* AK = (bf16*)(ar + B_AK);
    const float* qn = inp(I_QNORM); const float* kn = inp(I_KNORM); const f32x2* rope = (const f32x2*)(F.ws + WS_ROPE);
    const size_t NQ = (size_t)SEQ * 8 * 8, NK = (size_t)T * 2 * 8;
    for (size_t it = (size_t)F.vcu * NTHR + F.tid; it < NQ + NK; it += (size_t)F.G * NTHR) {
        const bool isq = it < NQ; const size_t r = isq ? it : it - NQ; const int j = (int)(r & 7), hf = j >> 2, sub = j & 3;
        int row, head; bf16* p; const float* nw;
        if (isq) { head = (int)((r >> 3) & 7); row = CTX + (int)(r >> 6); p = AQ + (size_t)row * 1024 + head * 128; nw = qn; }
        else { head = (int)((r >> 3) & 1); row = (int)(r >> 4); p = AK + (size_t)row * 256 + head * 128; nw = kn; }
        const int d1 = 64 * hf + 8 * sub, d2 = d1 + 32;
        const v4u a = *(const GAS v4u*)(p + d1), b = *(const GAS v4u*)(p + d2);
        float x1[8] = {bflo(a.x), bfhi(a.x), bflo(a.y), bfhi(a.y), bflo(a.z), bfhi(a.z), bflo(a.w), bfhi(a.w)};
        float x2[8] = {bflo(b.x), bfhi(b.x), bflo(b.y), bfhi(b.y), bflo(b.z), bfhi(b.z), bflo(b.w), bfhi(b.w)};
        float ss = 0.f;
#pragma unroll
        for (int e = 0; e < 8; ++e) ss += x1[e] * x1[e] + x2[e] * x2[e];
        ss += __shfl_xor(ss, 1); ss += __shfl_xor(ss, 2); ss += __shfl_xor(ss, 4);
        const float rstd = 1.f / sqrtf(ss * (1.f / 128.f) + EPS);
        const bool rot = row >= CTX; const int tl = row - CTX, pos = hf ? (tl & 63) : (tl >> 6);
        float o1[8], o2[8];
#pragma unroll
        for (int e = 0; e < 8; ++e) { const float y1 = x1[e] * rstd * nw[d1 + e], y2 = x2[e] * rstd * nw[d2 + e];
            f32x2 cs = {1.f, 0.f}; if (rot) cs = rope[pos * 32 + 8 * sub + e];
            o1[e] = y1 * cs.x - y2 * cs.y; o2[e] = y1 * cs.y + y2 * cs.x; }
        v4u w1, w2; w1.x = pk2(o1[0], o1[1]); w1.y = pk2(o1[2], o1[3]); w1.z = pk2(o1[4], o1[5]); w1.w = pk2(o1[6], o1[7]);
        w2.x = pk2(o2[0], o2[1]); w2.y = pk2(o2[2], o2[3]); w2.z = pk2(o2[4], o2[5]); w2.w = pk2(o2[6], o2[7]);
        *(GAS v4u*)(p + d1) = w1; *(GAS v4u*)(p + d2) = w2;
        if (!isq) {
            unsigned char* k8 = ar + B_KDT + (size_t)row * 256 + head * 128 + 64 * (sub & 1) + 8 * (4 * hf + (sub >> 1));
            v2u a8, b8; a8.x = pk4_fp8(o1[0], o1[1], o1[2], o1[3]); a8.y = pk4_fp8(o1[4], o1[5], o1[6], o1[7]); b8.x = pk4_fp8(o2[0], o2[1], o2[2], o2[3]); b8.y = pk4_fp8(o2[4], o2[5], o2[6], o2[7]);
            *(GAS v2u*)k8 = a8; *(GAS v2u*)(k8 + 16) = b8; }
    }
}

constexpr size_t VT8_OFF = 8 * MiB;
__device__ __forceinline__ void ph_vt8(Frame& F) {
    unsigned char* ar = F.ws + WS_ARENA; const bf16* AV = (const bf16*)(ar + B_AV); unsigned char* VT8 = ar + B_KDT + VT8_OFF;
    const int ntask = 2 * NCH * 128 * 4;
    for (int it = F.vcu * NTHR + F.tid; it < ntask; it += F.G * NTHR) {
        const int g = it & 3, d = (it >> 2) & 127, tl = (it >> 9) % NCH, kvh = (it >> 9) / NCH, hi = g >> 1, blk = g & 1;
        float x[16];
#pragma unroll
        for (int r = 0; r < 16; ++r) { const int key = 32 * blk + (r & 3) + 8 * (r >> 2) + 4 * hi; x[r] = bf2f(AV[(size_t)(tl * 64 + key) * 256 + kvh * 128 + d]); }
        v4u o; o.x = pk4_fp8(x[0], x[1], x[2], x[3]); o.y = pk4_fp8(x[4], x[5], x[6], x[7]); o.z = pk4_fp8(x[8], x[9], x[10], x[11]); o.w = pk4_fp8(x[12], x[13], x[14], x[15]);
        *(GAS v4u*)(VT8 + ((size_t)(kvh * NCH + tl) * 128 + d) * 64 + g * 16) = o;
    }
}

namespace tri {
using s16x4 = __attribute__((ext_vector_type(4))) short;
__device__ __forceinline__ int st(int k, int c) { const int kk = (k & ~0xC) | ((k & 4) << 1) | ((k & 8) >> 1); return ((kk >> 3) * 4 + (c >> 5)) * 512 + ((kk & 7) * 32 + (c & 31)) * 2; }
__device__ __forceinline__ int rd_base(int lane) { return ((lane & 3) << 3) | (((lane >> 2) & 3) << 6) | (((lane >> 4) & 1) << 5) | (((lane >> 5) & 1) << 8); }
constexpr int rd_off(int d0, int ks, int half) { return d0 * 512 + ks * 4096 + half * 2048; }
template <int OFF> __device__ __forceinline__ s16x4 tr_read(int vb) { s16x4 r; asm volatile("ds_read_b64_tr_b16 %0, %1 offset:%2" : "=&v"(r) : "v"(vb), "i"(OFF) : "memory"); return r; }
struct Frag2 { s16x4 lo, hi; };
template <int D0, int KS> __device__ __forceinline__ Frag2 ld(int vb) { Frag2 f; f.lo = tr_read<rd_off(D0, KS, 0)>(vb); f.hi = tr_read<rd_off(D0, KS, 1)>(vb); return f; }
__device__ __forceinline__ bf16x8 pk(const Frag2& f) { return (bf16x8){f.lo[0], f.lo[1], f.lo[2], f.lo[3], f.hi[0], f.hi[1], f.hi[2], f.hi[3]}; }
#define TRI_WAIT() do { asm volatile("s_waitcnt lgkmcnt(0)" ::: "memory"); __builtin_amdgcn_sched_barrier(0); } while (0)
}
typedef float f32x16 __attribute__((ext_vector_type(16)));
__device__ __forceinline__ int crow(int r, int hi) { return (r & 3) + 8 * (r >> 2) + 4 * hi; }

__device__ __forceinline__ float logsigmoidf_(float z) { return fminf(z, 0.f) - __logf(1.f + __expf(-fabsf(z))); }
__device__ __forceinline__ void gla_prepkv_unit(Frame& F, int c, int h) {
    unsigned char* ar = F.ws + WS_ARENA;
    const bf16* GQ = (const bf16*)(ar + B_GQ); const bf16* GK = (const bf16*)(ar + B_GK); const bf16* GV = (const bf16*)(ar + B_GV); const float* ALR = (const float*)(ar + B_ALR);
    LAS float* ALR_S = (LAS float*)(F.lds);
    LAS float* WA_S = (LAS float*)(F.lds + 4096);
    LAS float* BA_S = (LAS float*)(F.lds + 12288);
    LAS float* SEG_S = (LAS float*)(F.lds + 12800);
    LAS float* GB = (LAS float*)(F.lds + 14848);
    LAS unsigned char* QS = F.lds + 47616;
    LAS unsigned char* KS = F.lds + 64000;
    LAS unsigned char* VIMG = F.lds + 80384;
    LAS unsigned char* KIMG = F.lds + 113152;
    const int tid = F.tid, lane = F.lane, t0 = c * 64;
    __syncthreads();
    for (int i = tid; i < 1024; i += NTHR) ALR_S[i] = ALR[(size_t)t0 * 16 + i];
    for (int i = tid; i < 1024; i += NTHR) { const int r = i >> 4, k8 = (i & 15) * 8;
        *(LAS v4u*)(QS + (r * 128 + k8) * 2) = *(const GAS v4u*)(GQ + (size_t)(t0 + r) * 512 + h * 128 + k8); *(LAS v4u*)(KS + (r * 128 + k8) * 2) = *(const GAS v4u*)(GK + (size_t)(t0 + r) * 512 + h * 128 + k8); }
    for (int i = tid; i < 2048; i += NTHR) { const int r = i >> 5, v8 = (i & 31) * 8;
        *(LAS v4u*)(VIMG + (v8 >> 7) * 16384 + tri::st(r, v8 & 127)) = *(const GAS v4u*)(GV + (size_t)(t0 + r) * 1024 + h * 256 + v8); }
    for (int d = 0; d < 2; ++d) {
        const float* wa = inp(I_GLAWA) + (size_t)d * 16 * 512 + h * 128; const float* ba = inp(I_GLABA) + d * 512 + h * 128;
        __syncthreads();
        for (int i = tid; i < 2048; i += NTHR) WA_S[i] = wa[(size_t)(i >> 7) * 512 + (i & 127)];
        if (tid < 128) BA_S[tid] = ba[tid];
        __syncthreads();
        const int k = tid & 127, seg = tid >> 7;
        float gl[16];
        { float w[16];
#pragma unroll
          for (int r = 0; r < 16; ++r) w[r] = WA_S[r * 128 + k];
          const float b0 = BA_S[k];
#pragma unroll
          for (int ii = 0; ii < 16; ++ii) { const int i = seg * 16 + ii; float z = b0;
#pragma unroll
              for (int r = 0; r < 16; ++r) z += ALR_S[i * 16 + r] * w[r];
              gl[ii] = logsigmoidf_(z) * (1.f / 16.f); } }
        if (d == 0) {
#pragma unroll
            for (int ii = 1; ii < 16; ++ii) gl[ii] += gl[ii - 1];
            SEG_S[seg * 128 + k] = gl[15]; }
        else {
#pragma unroll
            for (int ii = 14; ii >= 0; --ii) gl[ii] += gl[ii + 1];
            SEG_S[seg * 128 + k] = gl[0]; }
        __syncthreads();
        const float s0 = SEG_S[k], s1 = SEG_S[128 + k], s2 = SEG_S[256 + k], s3 = SEG_S[384 + k], tot = (s0 + s1) + (s2 + s3);
        float off;
        if (d == 0) off = seg == 0 ? 0.f : (seg == 1 ? s0 : (seg == 2 ? s0 + s1 : s0 + s1 + s2));
        else off = seg == 3 ? 0.f : (seg == 2 ? s3 : (seg == 1 ? s3 + s2 : s3 + s2 + s1));
#pragma unroll
        for (int ii = 0; ii < 16; ++ii) GB[(seg * 16 + ii) * 128 + k] = gl[ii] + off;
        if (seg == 0) ((float*)(ar + B_DEC))[((size_t)(d * NCH + c) * 4 + h) * 128 + k] = __expf(tot);
        __syncthreads();
        { bf16* QE = (bf16*)(ar + B_QE) + (size_t)d * T * 512; bf16* KE = (bf16*)(ar + B_KE) + (size_t)d * T * 512;
          for (int i2 = tid; i2 < 1024; i2 += NTHR) { const int i = i2 >> 4, k8 = (i2 & 15) * 8; const v4u qw = *(const LAS v4u*)(QS + (i * 128 + k8) * 2), kw = *(const LAS v4u*)(KS + (i * 128 + k8) * 2);
              const f32x4 ba0 = *(const LAS f32x4*)(GB + i * 128 + k8), ba1 = *(const LAS f32x4*)(GB + i * 128 + k8 + 4);
              const f32x4 t0v = *(const LAS f32x4*)(SEG_S + k8), t1v = *(const LAS f32x4*)(SEG_S + 128 + k8), t2v = *(const LAS f32x4*)(SEG_S + 256 + k8), t3v = *(const LAS f32x4*)(SEG_S + 384 + k8);
              const f32x4 u0v = *(const LAS f32x4*)(SEG_S + k8 + 4), u1v = *(const LAS f32x4*)(SEG_S + 128 + k8 + 4), u2v = *(const LAS f32x4*)(SEG_S + 256 + k8 + 4), u3v = *(const LAS f32x4*)(SEG_S + 384 + k8 + 4);
              const f32x4 tt0 = (t0v + t1v) + (t2v + t3v), tt1 = (u0v + u1v) + (u2v + u3v);
              const float b[8] = {ba0[0], ba0[1], ba0[2], ba0[3], ba1[0], ba1[1], ba1[2], ba1[3]}; const float tt[8] = {tt0[0], tt0[1], tt0[2], tt0[3], tt1[0], tt1[1], tt1[2], tt1[3]};
              const unsigned qv[4] = {qw.x, qw.y, qw.z, qw.w}, kv[4] = {kw.x, kw.y, kw.z, kw.w}; float qe[8], ke[8], kd[8];
#pragma unroll
              for (int e = 0; e < 4; ++e) { const float q0 = bflo(qv[e]), q1 = bfhi(qv[e]), k0 = bflo(kv[e]), k1 = bfhi(kv[e]); const float e0 = __expf(b[2 * e]), e1 = __expf(b[2 * e + 1]);
                  const float r0 = __builtin_amdgcn_rcpf(e0), r1 = __builtin_amdgcn_rcpf(e1);
                  qe[2 * e] = q0 * 0.08838834764831845f * e0; qe[2 * e + 1] = q1 * 0.08838834764831845f * e1; ke[2 * e] = k0 * r0; ke[2 * e + 1] = k1 * r1;
                  kd[2 * e] = k0 * __expf(tt[2 * e] - b[2 * e]); kd[2 * e + 1] = k1 * __expf(tt[2 * e + 1] - b[2 * e + 1]); }
              v4u wq, wk, wd; wq.x = pk2(qe[0], qe[1]); wq.y = pk2(qe[2], qe[3]); wq.z = pk2(qe[4], qe[5]); wq.w = pk2(qe[6], qe[7]);
              wk.x = pk2(ke[0], ke[1]); wk.y = pk2(ke[2], ke[3]); wk.z = pk2(ke[4], ke[5]); wk.w = pk2(ke[6], ke[7]);
              wd.x = pk2(kd[0], kd[1]); wd.y = pk2(kd[2], kd[3]); wd.z = pk2(kd[4], kd[5]); wd.w = pk2(kd[6], kd[7]);
              *(GAS v4u*)(QE + (size_t)(t0 + i) * 512 + h * 128 + k8) = wq; *(GAS v4u*)(KE + (size_t)(t0 + i) * 512 + h * 128 + k8) = wk;
              *(LAS v4u*)(KIMG + tri::st(i, k8)) = wd; } }
        __syncthreads();
        {
            const int w = F.wave, r = lane & 31, hi = lane >> 5;
            const int kb_base = (int)(uintptr_t)KIMG + tri::rd_base(lane), vb_base = (int)(uintptr_t)VIMG + (w >> 2) * 16384 + (w & 3) * 512 + tri::rd_base(lane);
            const tri::Frag2 b0 = tri::ld<0, 0>(vb_base), b1 = tri::ld<0, 1>(vb_base), b2 = tri::ld<0, 2>(vb_base), b3 = tri::ld<0, 3>(vb_base);
            const tri::Frag2 a00 = tri::ld<0, 0>(kb_base), a01 = tri::ld<0, 1>(kb_base), a02 = tri::ld<0, 2>(kb_base), a03 = tri::ld<0, 3>(kb_base);
            const tri::Frag2 a10 = tri::ld<1, 0>(kb_base), a11 = tri::ld<1, 1>(kb_base), a12 = tri::ld<1, 2>(kb_base), a13 = tri::ld<1, 3>(kb_base);
            const tri::Frag2 a20 = tri::ld<2, 0>(kb_base), a21 = tri::ld<2, 1>(kb_base), a22 = tri::ld<2, 2>(kb_base), a23 = tri::ld<2, 3>(kb_base);
            const tri::Frag2 a30 = tri::ld<3, 0>(kb_base), a31 = tri::ld<3, 1>(kb_base), a32 = tri::ld<3, 2>(kb_base), a33 = tri::ld<3, 3>(kb_base);
            TRI_WAIT();
            const bf16x8 B0 = tri::pk(b0), B1 = tri::pk(b1), B2 = tri::pk(b2), B3 = tri::pk(b3);
            f32x16 acc[4] = {};
            acc[0] = __builtin_amdgcn_mfma_f32_32x32x16_bf16(tri::pk(a00), B0, acc[0], 0, 0, 0); acc[0] = __builtin_amdgcn_mfma_f32_32x32x16_bf16(tri::pk(a01), B1, acc[0], 0, 0, 0);
            acc[0] = __builtin_amdgcn_mfma_f32_32x32x16_bf16(tri::pk(a02), B2, acc[0], 0, 0, 0); acc[0] = __builtin_amdgcn_mfma_f32_32x32x16_bf16(tri::pk(a03), B3, acc[0], 0, 0, 0);
            acc[1] = __builtin_amdgcn_mfma_f32_32x32x16_bf16(tri::pk(a10), B0, acc[1], 0, 0, 0); acc[1] = __builtin_amdgcn_mfma_f32_32x32x16_bf16(tri::pk(a11), B1, acc[1], 0, 0, 0);
            acc[1] = __builtin_amdgcn_mfma_f32_32x32x16_bf16(tri::pk(a12), B2, acc[1], 0, 0, 0); acc[1] = __builtin_amdgcn_mfma_f32_32x32x16_bf16(tri::pk(a13), B3, acc[1], 0, 0, 0);
            acc[2] = __builtin_amdgcn_mfma_f32_32x32x16_bf16(tri::pk(a20), B0, acc[2], 0, 0, 0); acc[2] = __builtin_amdgcn_mfma_f32_32x32x16_bf16(tri::pk(a21), B1, acc[2], 0, 0, 0);
            acc[2] = __builtin_amdgcn_mfma_f32_32x32x16_bf16(tri::pk(a22), B2, acc[2], 0, 0, 0); acc[2] = __builtin_amdgcn_mfma_f32_32x32x16_bf16(tri::pk(a23), B3, acc[2], 0, 0, 0);
            acc[3] = __builtin_amdgcn_mfma_f32_32x32x16_bf16(tri::pk(a30), B0, acc[3], 0, 0, 0); acc[3] = __builtin_amdgcn_mfma_f32_32x32x16_bf16(tri::pk(a31), B1, acc[3], 0, 0, 0);
            acc[3] = __builtin_amdgcn_mfma_f32_32x32x16_bf16(tri::pk(a32), B2, acc[3], 0, 0, 0); acc[3] = __builtin_amdgcn_mfma_f32_32x32x16_bf16(tri::pk(a33), B3, acc[3], 0, 0, 0);
            bf16* ST = (bf16*)(ar + B_ST) + ((size_t)(d * NCH + c) * 4 + h) * 256 * 128;
#pragma unroll
            for (int kb = 0; kb < 4; ++kb)
#pragma unroll
                for (int q4 = 0; q4 < 4; ++q4) { v2u o; o.x = pk2(acc[kb][4 * q4], acc[kb][4 * q4 + 1]); o.y = pk2(acc[kb][4 * q4 + 2], acc[kb][4 * q4 + 3]);
                    *(GAS v2u*)(ST + (size_t)(32 * w + r) * 128 + 32 * kb + 8 * q4 + 4 * hi) = o; }
        }
    }
}

__device__ __forceinline__ void ph_gla_scan(Frame& F) {
    unsigned char* ar = F.ws + WS_ARENA; const float* DEC = (const float*)(ar + B_DEC);
    for (int gth = blockIdx.x * NTHR + F.tid; gth < 2 * 4 * 256 * 64; gth += F.G * NTHR) {
        const int kp = gth & 63, v = (gth >> 6) & 255, h = (gth >> 14) & 3, d = gth >> 16;
        unsigned* ST = (unsigned*)(ar + B_ST) + ((((size_t)d * NCH) * 4 + h) * 256 + v) * 64 + kp;
        const f32x2* DC = (const f32x2*)DEC + (((size_t)d * NCH) * 4 + h) * 64 + kp;
        float s0 = 0.f, s1 = 0.f;
        for (int i0 = 0; i0 < NCH; i0 += 4) { int cc[4]; unsigned kv[4]; f32x2 dc[4];
#pragma unroll
            for (int q = 0; q < 4; ++q) { const int i = i0 + q; cc[q] = d == 0 ? i : (i < NCH_CTX ? NCH_CTX - 1 - i : NCH - 1 - (i - NCH_CTX));
                kv[q] = ST[(size_t)cc[q] * (4 * 256 * 64)]; dc[q] = DC[(size_t)cc[q] * (4 * 64)]; }
#pragma unroll
            for (int q = 0; q < 4; ++q) { ST[(size_t)cc[q] * (4 * 256 * 64)] = pk2(s0, s1); s0 = dc[q].x * s0 + bflo(kv[q]); s1 = dc[q].y * s1 + bfhi(kv[q]); } }
    }
}

__device__ __forceinline__ void gla_out_unit(Frame& F, int cl, int h) {
    unsigned char* ar = F.ws + WS_ARENA; const int c = cl + NCH_CTX, t0 = c * 64;
    LAS unsigned char* ATT = F.lds;
    LAS float* OS = (LAS float*)(F.lds + 18432);
    LAS unsigned char* VIMG = F.lds + 86016;
    const int lane = F.lane, r = lane & 31, hi = lane >> 5, w = F.wave;
    __syncthreads();
    { const bf16* GV = (const bf16*)(ar + B_GV);
      for (int i = F.tid; i < 2048; i += NTHR) { const int rr = i >> 5, v8 = (i & 31) * 8;
          *(LAS v4u*)(VIMG + (v8 >> 7) * 16384 + tri::st(rr, v8 & 127)) = *(const GAS v4u*)(GV + (size_t)(t0 + rr) * 1024 + h * 256 + v8); } }
    {
        const int d = w >> 2, ib = (w >> 1) & 1, jb = w & 1;
        const bf16* QE = (const bf16*)(ar + B_QE) + (size_t)d * T * 512 + (size_t)(t0 + ib * 32 + r) * 512 + h * 128 + 8 * hi;
        const bf16* KE = (const bf16*)(ar + B_KE) + (size_t)d * T * 512 + (size_t)(t0 + jb * 32 + r) * 512 + h * 128 + 8 * hi;
        bf16x8 a[8], b[8];
#pragma unroll
        for (int s = 0; s < 8; ++s) { a[s] = *(const GAS bf16x8*)(KE + 16 * s); b[s] = *(const GAS bf16x8*)(QE + 16 * s); }
        f32x16 acc = {};
#pragma unroll
        for (int s = 0; s < 8; ++s) acc = __builtin_amdgcn_mfma_f32_32x32x16_bf16(a[s], b[s], acc, 0, 0, 0);
        const int i = ib * 32 + r;
#pragma unroll
        for (int q4 = 0; q4 < 4; ++q4) { float x[4];
#pragma unroll
            for (int e = 0; e < 4; ++e) { const int j = jb * 32 + 8 * q4 + 4 * hi + e; const bool keep = d == 0 ? (j <= i) : (j >= i); x[e] = keep ? acc[4 * q4 + e] : 0.f; }
            v2u o; o.x = pk2(x[0], x[1]); o.y = pk2(x[2], x[3]);
            *(LAS v2u*)(ATT + ((size_t)(d * 64 + i) * 72 + jb * 32 + 8 * q4 + 4 * hi) * 2) = o; }
    }
    __syncthreads();
    {
        const int ib = w >> 2, vq = w & 3; f32x16 o0 = {}, o1 = {};
        const int vb_base = (int)(uintptr_t)VIMG + (vq >> 1) * 16384 + (2 * (vq & 1)) * 512 + tri::rd_base(lane);
        const tri::Frag2 p0 = tri::ld<0, 0>(vb_base), p1 = tri::ld<0, 1>(vb_base), p2 = tri::ld<0, 2>(vb_base), p3 = tri::ld<0, 3>(vb_base);
        const tri::Frag2 q0 = tri::ld<1, 0>(vb_base), q1 = tri::ld<1, 1>(vb_base), q2 = tri::ld<1, 2>(vb_base), q3 = tri::ld<1, 3>(vb_base);
        TRI_WAIT();
        const bf16x8 vb0[4] = {tri::pk(p0), tri::pk(p1), tri::pk(p2), tri::pk(p3)}, vb1[4] = {tri::pk(q0), tri::pk(q1), tri::pk(q2), tri::pk(q3)};
#pragma unroll
        for (int d = 0; d < 2; ++d) {
            bf16x8 a[4];
#pragma unroll
            for (int s = 0; s < 4; ++s) a[s] = *(const LAS bf16x8*)(ATT + ((size_t)(d * 64 + ib * 32 + r) * 72 + 16 * s + 8 * hi) * 2);
#pragma unroll
            for (int s = 0; s < 4; ++s) { o0 = __builtin_amdgcn_mfma_f32_32x32x16_bf16(a[s], vb0[s], o0, 0, 0, 0); o1 = __builtin_amdgcn_mfma_f32_32x32x16_bf16(a[s], vb1[s], o1, 0, 0, 0); }
            const bf16* QE = (const bf16*)(ar + B_QE) + (size_t)d * T * 512 + (size_t)(t0 + ib * 32 + r) * 512 + h * 128 + 8 * hi;
            const bf16* ST = (const bf16*)(ar + B_ST) + ((size_t)(d * NCH + c) * 4 + h) * 256 * 128 + (size_t)(64 * vq + r) * 128 + 8 * hi;
            bf16x8 qa[8], s0[8], s1[8];
#pragma unroll
            for (int s = 0; s < 8; ++s) { qa[s] = *(const GAS bf16x8*)(QE + 16 * s); s0[s] = *(const GAS bf16x8*)(ST + 16 * s); s1[s] = *(const GAS bf16x8*)(ST + 32 * 128 + 16 * s); }
#pragma unroll
            for (int s = 0; s < 8; ++s) { o0 = __builtin_amdgcn_mfma_f32_32x32x16_bf16(qa[s], s0[s], o0, 0, 0, 0); o1 = __builtin_amdgcn_mfma_f32_32x32x16_bf16(qa[s], s1[s], o1, 0, 0, 0); }
        }
#pragma unroll
        for (int q = 0; q < 16; ++q) { const int i = ib * 32 + crow(q, hi); OS[i * 260 + 64 * vq + r] = o0[q]; OS[i * 260 + 64 * vq + 32 + r] = o1[q]; }
    }
    __syncthreads();
    {
        const int i = F.tid >> 3, seg = F.tid & 7; const LAS float* op = OS + i * 260 + 32 * seg; f32x4 x[8]; float ss = 0.f;
#pragma unroll
        for (int e = 0; e < 8; ++e) { x[e] = *(const LAS f32x4*)(op + 4 * e); ss += (x[e][0] * x[e][0] + x[e][1] * x[e][1]) + (x[e][2] * x[e][2] + x[e][3] * x[e][3]); }
        ss += __shfl_xor(ss, 1); ss += __shfl_xor(ss, 2); ss += __shfl_xor(ss, 4);
        const float rstd = 1.f / sqrtf(ss * (1.f / 256.f) + EPS);
        const float* gn = inp(I_GLANORM) + h * 256 + 32 * seg; const bf16* R = (const bf16*)(ar + B_R) + (size_t)(t0 + i) * 1024 + h * 256 + 32 * seg;
        bf16* YM = (bf16*)(ar + B_YMIX1) + (size_t)(t0 - CTX + i) * D + h * 256 + 32 * seg;
#pragma unroll
        for (int e2 = 0; e2 < 4; ++e2) { const v4u rr = *(const GAS v4u*)(R + 8 * e2); const f32x4 g0 = *(const GAS f32x4*)(gn + 8 * e2), g1 = *(const GAS f32x4*)(gn + 8 * e2 + 4);
            const f32x4 a = x[2 * e2] * rstd * g0, b = x[2 * e2 + 1] * rstd * g1; v4u o;
            o.x = pk2(a[0] * siluf_(bflo(rr.x)), a[1] * siluf_(bfhi(rr.x))); o.y = pk2(a[2] * siluf_(bflo(rr.y)), a[3] * siluf_(bfhi(rr.y)));
            o.z = pk2(b[0] * siluf_(bflo(rr.z)), b[1] * siluf_(bfhi(rr.z))); o.w = pk2(b[2] * siluf_(bflo(rr.w)), b[3] * siluf_(bfhi(rr.w)));
            *(GAS v4u*)(YM + 8 * e2) = o; }
    }
}

namespace att {
constexpr int HD = 128, NW = 8, QBLK = 32, KVBLK = 64;
constexpr float SCALE = 0.088388347648318440f;
constexpr float THR = 8.f;
constexpr int LDQ = 1024, LDK = 256, LDO = 2048;
constexpr size_t SHM_V = KVBLK * HD * 2, SHM_K = KVBLK * HD * 2, SHM_ATTN = 2 * SHM_V + 2 * SHM_K + NW * 64 * 4;
using s16x4 = __attribute__((ext_vector_type(4))) short;
#define KSWZ(row, colB) ((row) * 256 + ((colB) ^ (((row) & 7) << 4)))
#define SBAR() __builtin_amdgcn_sched_barrier(0)
__device__ __forceinline__ unsigned cvtpk(float lo, float hi) { unsigned r; asm volatile("v_cvt_pk_bf16_f32 %0, %1, %2" : "=v"(r) : "v"(lo), "v"(hi)); return r; }
__device__ __forceinline__ void partialSM(f32x16& p0, f32x16& p1, float& m_reg, float& mn, float& alpha) {
  constexpr float C = SCALE * 1.4426950408889634f;
  float pmax = p0[0];
#pragma unroll
  for (int r = 1; r < 16; ++r) pmax = fmaxf(pmax, p0[r]);
#pragma unroll
  for (int r = 0; r < 16; ++r) pmax = fmaxf(pmax, p1[r]);
  { auto rr = __builtin_amdgcn_permlane32_swap(__float_as_uint(pmax), __float_as_uint(pmax), false, false);
    pmax = fmaxf(__uint_as_float(rr[0]), __uint_as_float(rr[1])); }
  if (__builtin_expect(__all(pmax - m_reg <= THR / SCALE), 1)) { mn = m_reg; alpha = 1.f; }
  else { mn = fmaxf(m_reg, pmax); alpha = __builtin_amdgcn_exp2f((m_reg - mn) * C); m_reg = mn; }
  float mnC = -mn * C;
#pragma unroll
  for (int r = 0; r < 16; ++r) p0[r] = fmaf(p0[r], C, mnC);
#pragma unroll
  for (int r = 0; r < 16; ++r) p1[r] = fmaf(p1[r], C, mnC);
#pragma unroll
  for (int r = 0; r < 16; ++r) p0[r] = __builtin_amdgcn_exp2f(p0[r]);
}
__device__ __forceinline__ void finishSM(f32x16& p0, f32x16& p1, float alpha, float& l_reg, bf16x8& pa0, bf16x8& pa1, bf16x8& pa2, bf16x8& pa3) {
#pragma unroll
  for (int r = 0; r < 16; ++r) p1[r] = __builtin_amdgcn_exp2f(p1[r]);
  float ps = 0;
#pragma unroll
  for (int r = 0; r < 16; ++r) ps += p0[r];
#pragma unroll
  for (int r = 0; r < 16; ++r) ps += p1[r];
  { auto rr = __builtin_amdgcn_permlane32_swap(__float_as_uint(ps), __float_as_uint(ps), false, false);
    ps = __uint_as_float(rr[0]) + __uint_as_float(rr[1]); }
  l_reg = l_reg * alpha + ps;
#define PK4(P, BASE, OUT) do { unsigned a0 = cvtpk(P[BASE + 0], P[BASE + 1]), a1 = cvtpk(P[BASE + 2], P[BASE + 3]);   \
    unsigned b0 = cvtpk(P[BASE + 4], P[BASE + 5]), b1 = cvtpk(P[BASE + 6], P[BASE + 7]);                              \
    auto r0 = __builtin_amdgcn_permlane32_swap(a0, b0, false, false); auto r1 = __builtin_amdgcn_permlane32_swap(a1, b1, false, false); \
    u32x4 w = {r0[0], r1[0], r0[1], r1[1]}; OUT = *reinterpret_cast<bf16x8*>(&w); } while (0)
  PK4(p0, 0, pa0); PK4(p0, 8, pa1); PK4(p1, 0, pa2); PK4(p1, 8, pa3);
#undef PK4
}
__device__ __forceinline__ void qkt(f32x16& p0, f32x16& p1, const bf16* Ks, const bf16x8* qr, int r32, int hi) {
  p0 = f32x16{}; p1 = f32x16{};
#pragma unroll
  for (int d0 = 0; d0 < 8; ++d0) { int cb = (d0 * 16 + hi * 8) * 2;
    bf16x8 b0 = *reinterpret_cast<const bf16x8*>((const char*)Ks + KSWZ(r32, cb));
    bf16x8 b1 = *reinterpret_cast<const bf16x8*>((const char*)Ks + KSWZ(32 + r32, cb));
    p0 = __builtin_amdgcn_mfma_f32_32x32x16_bf16(b0, qr[d0], p0, 0, 0, 0);
    p1 = __builtin_amdgcn_mfma_f32_32x32x16_bf16(b1, qr[d0], p1, 0, 0, 0); }
}
__device__ __forceinline__ int v_st(int k, int c) { const int kk = (k & ~0xC) | ((k & 4) << 1) | ((k & 8) >> 1); return ((kk >> 3) * 4 + (c >> 5)) * 512 + ((kk & 7) * 32 + (c & 31)) * 2; }
__device__ __forceinline__ int v_rd_base(int lane) { return ((lane & 3) << 3) | (((lane >> 2) & 3) << 6) | (((lane >> 4) & 1) << 5) | (((lane >> 5) & 1) << 8); }
constexpr int v_rd_off(int d0, int ks, int half) { return d0 * 512 + ks * 4096 + half * 2048; }
template <int OFF> __device__ __forceinline__ s16x4 tr_read(int vb) {
  s16x4 r; asm volatile("ds_read_b64_tr_b16 %0, %1 offset:%2" : "=&v"(r) : "v"(vb), "i"(OFF) : "memory"); return r;
}
template <int D0> __device__ __forceinline__ void pv_one(f32x16& od, int vb, bf16x8 pa0, bf16x8 pa1, bf16x8 pa2, bf16x8 pa3) {
  const s16x4 l0 = tr_read<v_rd_off(D0, 0, 0)>(vb), h0 = tr_read<v_rd_off(D0, 0, 1)>(vb), l1 = tr_read<v_rd_off(D0, 1, 0)>(vb), h1 = tr_read<v_rd_off(D0, 1, 1)>(vb);
  const s16x4 l2 = tr_read<v_rd_off(D0, 2, 0)>(vb), h2 = tr_read<v_rd_off(D0, 2, 1)>(vb), l3 = tr_read<v_rd_off(D0, 3, 0)>(vb), h3 = tr_read<v_rd_off(D0, 3, 1)>(vb);
  asm volatile("s_waitcnt lgkmcnt(0)" ::: "memory"); SBAR();
#define PK(L, H) (bf16x8){L[0], L[1], L[2], L[3], H[0], H[1], H[2], H[3]}
  od = __builtin_amdgcn_mfma_f32_32x32x16_bf16(pa0, PK(l0, h0), od, 0, 0, 0);
  od = __builtin_amdgcn_mfma_f32_32x32x16_bf16(pa1, PK(l1, h1), od, 0, 0, 0);
  od = __builtin_amdgcn_mfma_f32_32x32x16_bf16(pa2, PK(l2, h2), od, 0, 0, 0);
  od = __builtin_amdgcn_mfma_f32_32x32x16_bf16(pa3, PK(l3, h3), od, 0, 0, 0);
#undef PK
}
__device__ __forceinline__ void pv_d0(f32x16* o, int vb, bf16x8 pa0, bf16x8 pa1, bf16x8 pa2, bf16x8 pa3) {
  pv_one<0>(o[0], vb, pa0, pa1, pa2, pa3); pv_one<1>(o[1], vb, pa0, pa1, pa2, pa3); pv_one<2>(o[2], vb, pa0, pa1, pa2, pa3); pv_one<3>(o[3], vb, pa0, pa1, pa2, pa3);
}
typedef int v8i __attribute__((ext_vector_type(8)));
typedef int v4i __attribute__((ext_vector_type(4)));
constexpr size_t SHM_K8 = KVBLK * 128;
#define K8ADDR(row, g) ((row) * 128 + ((((g) ^ ((row) >> 1)) & 7) << 4))
__device__ __forceinline__ void qkt8(f32x16& p0, f32x16& p1, const char* Ks, const v8i& q0, const v8i& q1, int r32, int hi, int sc1) {
  p0 = f32x16{}; p1 = f32x16{};
  const int g0 = 4 * hi;
  { const v4i a00 = *reinterpret_cast<const v4i*>(Ks + K8ADDR(r32, g0)), a01 = *reinterpret_cast<const v4i*>(Ks + K8ADDR(r32, g0 + 1));
    const v4i b00 = *reinterpret_cast<const v4i*>(Ks + K8ADDR(32 + r32, g0)), b01 = *reinterpret_cast<const v4i*>(Ks + K8ADDR(32 + r32, g0 + 1));
    const v8i ka0 = __builtin_shufflevector(a00, a01, 0, 1, 2, 3, 4, 5, 6, 7), kb0 = __builtin_shufflevector(b00, b01, 0, 1, 2, 3, 4, 5, 6, 7);
    asm volatile("s_nop 1\n\tv_mfma_scale_f32_32x32x64_f8f6f4 %0, %1, %2, %0, %3, %3 op_sel_hi:[0,0,0]" : "+v"(p0) : "v"(ka0), "v"(q0), "v"(sc1));
    asm volatile("s_nop 1\n\tv_mfma_scale_f32_32x32x64_f8f6f4 %0, %1, %2, %0, %3, %3 op_sel_hi:[0,0,0]" : "+v"(p1) : "v"(kb0), "v"(q0), "v"(sc1) : "memory"); }
  { const v4i a10 = *reinterpret_cast<const v4i*>(Ks + K8ADDR(r32, g0 + 2)), a11 = *reinterpret_cast<const v4i*>(Ks + K8ADDR(r32, g0 + 3));
    const v4i b10 = *reinterpret_cast<const v4i*>(Ks + K8ADDR(32 + r32, g0 + 2)), b11 = *reinterpret_cast<const v4i*>(Ks + K8ADDR(32 + r32, g0 + 3));
    const v8i ka1 = __builtin_shufflevector(a10, a11, 0, 1, 2, 3, 4, 5, 6, 7), kb1 = __builtin_shufflevector(b10, b11, 0, 1, 2, 3, 4, 5, 6, 7);
    asm volatile("s_nop 1\n\tv_mfma_scale_f32_32x32x64_f8f6f4 %0, %1, %2, %0, %3, %3 op_sel_hi:[0,0,0]" : "+v"(p0) : "v"(ka1), "v"(q1), "v"(sc1));
    asm volatile("s_nop 1\n\tv_mfma_scale_f32_32x32x64_f8f6f4 %0, %1, %2, %0, %3, %3 op_sel_hi:[0,0,0]" : "+v"(p1) : "v"(kb1), "v"(q1), "v"(sc1)); }
  asm volatile("s_nop 15\n\ts_nop 7" : "+v"(p0), "+v"(p1));
}
__device__ __forceinline__ void attn_dense_body(const bf16* __restrict__ Qb, const unsigned char* __restrict__ Kh8, const bf16* __restrict__ Vh, bf16* __restrict__ Ob, int seq, char* lds) {
  constexpr int SDEPTH = 2;
  const int tid = threadIdx.x, wid = tid >> 6, lane = tid & 63, r32 = lane & 31, hi = lane >> 5;
  bf16* V_lds = (bf16*)lds; char* K_lds = lds + 2 * SHM_V;
  float* ws = (float*)(lds + 2 * SHM_V + 2 * SHM_K8) + wid * 64; float* li_l = ws; float* al_l = ws + 32;
  float m_reg = -1e30f, l_reg = 0; f32x16 o[4] = {}; bf16x8 qr[8];
  const bf16* Qw = Qb + (long)(wid * QBLK + r32) * LDQ + hi * 8;
#pragma unroll
  for (int d0 = 0; d0 < 8; ++d0) qr[d0] = *reinterpret_cast<const bf16x8*>(Qw + d0 * 16);
  v8i q8a, q8b; const int sc1 = 0x7f7f7f7f;
  { int w[16];
#pragma unroll
    for (int d0 = 0; d0 < 8; ++d0) { const u32x4 x = *reinterpret_cast<const u32x4*>(&qr[d0]);
      w[2 * d0] = (int)pk4_fp8(bflo(x.x), bfhi(x.x), bflo(x.y), bfhi(x.y)); w[2 * d0 + 1] = (int)pk4_fp8(bflo(x.z), bfhi(x.z), bflo(x.w), bfhi(x.w)); }
    q8a = (v8i){w[0], w[1], w[2], w[3], w[4], w[5], w[6], w[7]}; q8b = (v8i){w[8], w[9], w[10], w[11], w[12], w[13], w[14], w[15]}; }
  const int krow = tid >> 3, kg = tid & 7, kst = K8ADDR(krow, kg);
  const int sr = tid >> 4, sc = (tid & 15) * 8, vst0 = v_st(sr, sc), vst1 = v_st(32 + sr, sc);
  const int vb0 = (int)(uintptr_t)V_lds + v_rd_base(lane);
  struct { bf16x8 vs0, vs1; v4i ks; } sr_[SDEPTH];
#define SLOAD(i, k0) do { sr_[i].vs0 = *reinterpret_cast<const bf16x8*>(&Vh[(long)((k0) + sr) * LDK + sc]); sr_[i].vs1 = *reinterpret_cast<const bf16x8*>(&Vh[(long)((k0) + 32 + sr) * LDK + sc]); \
    sr_[i].ks = *reinterpret_cast<const v4i*>(&Kh8[(long)((k0) + krow) * 256 + kg * 16]); } while (0)
#define SWRITE(b, i) do { *(bf16x8*)((char*)V_lds + (b) * SHM_V + vst0) = sr_[i].vs0;          \
    *(bf16x8*)((char*)V_lds + (b) * SHM_V + vst1) = sr_[i].vs1;                                \
    *(v4i*)(K_lds + (b) * SHM_K8 + kst) = sr_[i].ks; } while (0)
#define SWAIT() do { asm volatile("s_waitcnt vmcnt(3)" ::: "memory"); } while (0)
#define RESC(a) do { if (__any((a) < 1.f)) { if (hi == 0) al_l[r32] = (a); asm volatile("s_waitcnt lgkmcnt(0)" ::: "memory"); \
    _Pragma("unroll") for (int d = 0; d < 4; ++d) _Pragma("unroll") for (int r = 0; r < 16; ++r) o[d][r] *= al_l[crow(r, hi)]; } } while (0)
  f32x16 pA0, pA1, pB0, pB1; float mnA, mnB, alA, alB; bf16x8 pa0, pa1, pa2, pa3; const int NT = seq / KVBLK;
  constexpr int SE = 0, SO = SDEPTH - 1;
  SLOAD(SE, 0); asm volatile("s_waitcnt vmcnt(0)" ::: "memory"); SWRITE(0, SE); __syncthreads();
  qkt8(pA0, pA1, K_lds, q8a, q8b, r32, hi, sc1); partialSM(pA0, pA1, m_reg, mnA, alA);
  SLOAD(SO, KVBLK); if (2 < NT) SLOAD(SE, 2 * KVBLK);
  SWAIT(); SWRITE(1, SO); __syncthreads();
  for (int j = 1; j + 1 < NT; j += 2) {
    SBAR(); qkt8(pB0, pB1, K_lds + SHM_K8, q8a, q8b, r32, hi, sc1);
    finishSM(pA0, pA1, alA, l_reg, pa0, pa1, pa2, pa3); SBAR();
    SLOAD(SO, (j + SDEPTH) * KVBLK); SBAR();
    pv_d0(o, vb0, pa0, pa1, pa2, pa3); partialSM(pB0, pB1, m_reg, mnB, alB);
    __syncthreads(); SWAIT(); SWRITE(0, SE);
    RESC(alB); __syncthreads();
    SBAR(); qkt8(pA0, pA1, K_lds, q8a, q8b, r32, hi, sc1);
    finishSM(pB0, pB1, alB, l_reg, pa0, pa1, pa2, pa3); SBAR();
    if (j + 3 < NT) SLOAD(SE, (j + 1 + SDEPTH) * KVBLK); SBAR();
    pv_d0(o, vb0 + (int)SHM_V, pa0, pa1, pa2, pa3); partialSM(pA0, pA1, m_reg, mnA, alA);
    __syncthreads(); SWAIT(); SWRITE(1, SO);
    RESC(alA); __syncthreads();
  }
  SBAR(); qkt8(pB0, pB1, K_lds + SHM_K8, q8a, q8b, r32, hi, sc1);
  finishSM(pA0, pA1, alA, l_reg, pa0, pa1, pa2, pa3); SBAR();
  pv_d0(o, vb0, pa0, pa1, pa2, pa3); partialSM(pB0, pB1, m_reg, mnB, alB);
  __syncthreads(); RESC(alB);
  finishSM(pB0, pB1, alB, l_reg, pa0, pa1, pa2, pa3); SBAR();
  pv_d0(o, vb0 + (int)SHM_V, pa0, pa1, pa2, pa3);
  if (hi == 0) li_l[r32] = l_reg; asm volatile("s_waitcnt lgkmcnt(0)" ::: "memory");
  float rli[16];
#pragma unroll
  for (int r = 0; r < 16; ++r) rli[r] = __builtin_amdgcn_rcpf(li_l[crow(r, hi)]);
  bf16* Ow = Ob + (long)(wid * QBLK) * LDO;
#pragma unroll
  for (int r = 0; r < 16; ++r) { int orow = crow(r, hi);
#pragma unroll
    for (int d0 = 0; d0 < 4; ++d0) Ow[(long)orow * LDO + d0 * 32 + r32] = (bf16)f2bf(o[d0][r] * rli[r]); }
  __syncthreads();
#undef SLOAD
#undef SWRITE
#undef SWAIT
#undef RESC
}
constexpr float THR8 = 6.f;
#define V8ADDR(d, g) ((d) * 64 + ((((g) ^ ((d) >> 2)) & 3) << 4))
__device__ __forceinline__ void partialSM8(f32x16& p0, f32x16& p1, float& m_reg, float& mn, float& alpha) {
  constexpr float C = SCALE * 1.4426950408889634f;
  float pmax = p0[0];
#pragma unroll
  for (int r = 1; r < 16; ++r) pmax = fmaxf(pmax, p0[r]);
#pragma unroll
  for (int r = 0; r < 16; ++r) pmax = fmaxf(pmax, p1[r]);
  { auto rr = __builtin_amdgcn_permlane32_swap(__float_as_uint(pmax), __float_as_uint(pmax), false, false);
    pmax = fmaxf(__uint_as_float(rr[0]), __uint_as_float(rr[1])); }
  if (__builtin_expect(__all(pmax - m_reg <= THR8 / SCALE), 1)) { mn = m_reg; alpha = 1.f; }
  else { mn = fmaxf(m_reg, pmax); alpha = __builtin_amdgcn_exp2f((m_reg - mn) * C); m_reg = mn; }
  float mnC = -mn * C;
#pragma unroll
  for (int r = 0; r < 16; ++r) p0[r] = fmaf(p0[r], C, mnC);
#pragma unroll
  for (int r = 0; r < 16; ++r) p1[r] = fmaf(p1[r], C, mnC);
#pragma unroll
  for (int r = 0; r < 16; ++r) p0[r] = __builtin_amdgcn_exp2f(p0[r]);
}
__device__ __forceinline__ void finishSM8(f32x16& p0, f32x16& p1, float alpha, float& l_reg, v8i& pa) {
#pragma unroll
  for (int r = 0; r < 16; ++r) p1[r] = __builtin_amdgcn_exp2f(p1[r]);
  float ps = 0;
#pragma unroll
  for (int r = 0; r < 16; ++r) ps += p0[r];
#pragma unroll
  for (int r = 0; r < 16; ++r) ps += p1[r];
  { auto rr = __builtin_amdgcn_permlane32_swap(__float_as_uint(ps), __float_as_uint(ps), false, false);
    ps = __uint_as_float(rr[0]) + __uint_as_float(rr[1]); }
  l_reg = l_reg * alpha + ps;
  pa = (v8i){(int)pk4_fp8(p0[0], p0[1], p0[2], p0[3]), (int)pk4_fp8(p0[4], p0[5], p0[6], p0[7]), (int)pk4_fp8(p0[8], p0[9], p0[10], p0[11]), (int)pk4_fp8(p0[12], p0[13], p0[14], p0[15]),
             (int)pk4_fp8(p1[0], p1[1], p1[2], p1[3]), (int)pk4_fp8(p1[4], p1[5], p1[6], p1[7]), (int)pk4_fp8(p1[8], p1[9], p1[10], p1[11]), (int)pk4_fp8(p1[12], p1[13], p1[14], p1[15])};
}
__device__ __forceinline__ void pv8(f32x16* o, const char* Vs, const v8i& pa, int r32, int hi, int sc1) {
#pragma unroll
  for (int d0 = 0; d0 < 4; ++d0) { const int d = 32 * d0 + r32;
    const v4i x0 = *reinterpret_cast<const v4i*>(Vs + V8ADDR(d, 2 * hi)), x1 = *reinterpret_cast<const v4i*>(Vs + V8ADDR(d, 2 * hi + 1));
    const v8i vb = __builtin_shufflevector(x0, x1, 0, 1, 2, 3, 4, 5, 6, 7);
    asm volatile("s_nop 1\n\tv_mfma_scale_f32_32x32x64_f8f6f4 %0, %1, %2, %0, %3, %3 op_sel_hi:[0,0,0]" : "+v"(o[d0]) : "v"(pa), "v"(vb), "v"(sc1)); }
  asm volatile("s_nop 15\n\ts_nop 7" : "+v"(o[0]), "+v"(o[1]), "+v"(o[2]), "+v"(o[3]));
}
__device__ __forceinline__ void attn_dense_body_pv8(const bf16* __restrict__ Qb, const unsigned char* __restrict__ Kh8, const unsigned char* __restrict__ Vt8, bf16* __restrict__ Ob, int seq, char* lds) {
  constexpr int SDEPTH = 2; constexpr size_t SHM_V8 = 8192;
  const int tid = threadIdx.x, wid = tid >> 6, lane = tid & 63, r32 = lane & 31, hi = lane >> 5;
  char* V_lds = lds; char* K_lds = lds + 2 * SHM_V8;
  float* ws = (float*)(lds + 2 * SHM_V8 + 2 * SHM_K8) + wid * 64; float* li_l = ws; float* al_l = ws + 32;
  float m_reg = -1e30f, l_reg = 0; f32x16 o[4] = {}; bf16x8 qr[8];
  const bf16* Qw = Qb + (long)(wid * QBLK + r32) * LDQ + hi * 8;
#pragma unroll
  for (int d0 = 0; d0 < 8; ++d0) qr[d0] = *reinterpret_cast<const bf16x8*>(Qw + d0 * 16);
  v8i q8a, q8b; const int sc1 = 0x7f7f7f7f;
  { int w[16];
#pragma unroll
    for (int d0 = 0; d0 < 8; ++d0) { const u32x4 x = *reinterpret_cast<const u32x4*>(&qr[d0]);
      w[2 * d0] = (int)pk4_fp8(bflo(x.x), bfhi(x.x), bflo(x.y), bfhi(x.y)); w[2 * d0 + 1] = (int)pk4_fp8(bflo(x.z), bfhi(x.z), bflo(x.w), bfhi(x.w)); }
    q8a = (v8i){w[0], w[1], w[2], w[3], w[4], w[5], w[6], w[7]}; q8b = (v8i){w[8], w[9], w[10], w[11], w[12], w[13], w[14], w[15]}; }
  const int krow = tid >> 3, kg = tid & 7, kst = K8ADDR(krow, kg);
  const int vrow = tid >> 2, vg = tid & 3, vst = V8ADDR(vrow, vg);
  struct { v4i vs, ks; } sr_[SDEPTH];
#define SLOAD(i, k0) do { sr_[i].vs = *reinterpret_cast<const v4i*>(&Vt8[(long)((k0) / KVBLK) * 8192 + tid * 16]); sr_[i].ks = *reinterpret_cast<const v4i*>(&Kh8[(long)((k0) + krow) * 256 + kg * 16]); } while (0)
#define SWRITE(b, i) do { *(v4i*)(V_lds + (b) * SHM_V8 + vst) = sr_[i].vs; *(v4i*)(K_lds + (b) * SHM_K8 + kst) = sr_[i].ks; } while (0)
#define SWAIT() do { asm volatile("s_waitcnt vmcnt(2)" ::: "memory"); } while (0)
#define RESC(a) do { if (__any((a) < 1.f)) { if (hi == 0) al_l[r32] = (a); asm volatile("s_waitcnt lgkmcnt(0)" ::: "memory"); \
    _Pragma("unroll") for (int d = 0; d < 4; ++d) _Pragma("unroll") for (int r = 0; r < 16; ++r) o[d][r] *= al_l[crow(r, hi)]; } } while (0)
  f32x16 pA0, pA1, pB0, pB1; float mnA, mnB, alA, alB; v8i pa; const int NT = seq / KVBLK;
  constexpr int SE = 0, SO = SDEPTH - 1;
  SLOAD(SE, 0); asm volatile("s_waitcnt vmcnt(0)" ::: "memory"); SWRITE(0, SE); __syncthreads();
  qkt8(pA0, pA1, K_lds, q8a, q8b, r32, hi, sc1); partialSM8(pA0, pA1, m_reg, mnA, alA);
  SLOAD(SO, KVBLK); if (2 < NT) SLOAD(SE, 2 * KVBLK);
  SWAIT(); SWRITE(1, SO); __syncthreads();
  for (int j = 1; j + 1 < NT; j += 2) {
    SBAR(); qkt8(pB0, pB1, K_lds + SHM_K8, q8a, q8b, r32, hi, sc1);
    finishSM8(pA0, pA1, alA, l_reg, pa); SBAR();
    SLOAD(SO, (j + SDEPTH) * KVBLK); SBAR();
    pv8(o, V_lds, pa, r32, hi, sc1); partialSM8(pB0, pB1, m_reg, mnB, alB);
    __syncthreads(); SWAIT(); SWRITE(0, SE);
    RESC(alB); __syncthreads();
    SBAR(); qkt8(pA0, pA1, K_lds, q8a, q8b, r32, hi, sc1);
    finishSM8(pB0, pB1, alB, l_reg, pa); SBAR();
    if (j + 3 < NT) SLOAD(SE, (j + 1 + SDEPTH) * KVBLK); SBAR();
    pv8(o, V_lds + SHM_V8, pa, r32, hi, sc1); partialSM8(pA0, pA1, m_reg, mnA, alA);
    __syncthreads(); SWAIT(); SWRITE(1, SO);
    RESC(alA); __syncthreads();
  }
  SBAR(); qkt8(pB0, pB1, K_lds + SHM_K8, q8a, q8b, r32, hi, sc1);
  finishSM8(pA0, pA1, alA, l_reg, pa); SBAR();
  pv8(o, V_lds, pa, r32, hi, sc1); partialSM8(pB0, pB1, m_reg, mnB, alB);
  __syncthreads(); RESC(alB);
  finishSM8(pB0, pB1, alB, l_reg, pa); SBAR();
  pv8(o, V_lds + SHM_V8, pa, r32, hi, sc1);
  if (hi == 0) li_l[r32] = l_reg; asm volatile("s_waitcnt lgkmcnt(0)" ::: "memory");
  float rli[16];
#pragma unroll
  for (int r = 0; r < 16; ++r) rli[r] = __builtin_amdgcn_rcpf(li_l[crow(r, hi)]);
  bf16* Ow = Ob + (long)(wid * QBLK) * LDO;
#pragma unroll
  for (int r = 0; r < 16; ++r) { int orow = crow(r, hi);
#pragma unroll
    for (int d0 = 0; d0 < 4; ++d0) Ow[(long)orow * LDO + d0 * 32 + r32] = (bf16)f2bf(o[d0][r] * rli[r]); }
  __syncthreads();
#undef SLOAD
#undef SWRITE
#undef SWAIT
#undef RESC
}
constexpr float QS8 = SCALE * 1.4426950408889634f * 8.f;
constexpr float THR2 = 8.6f;
__device__ __forceinline__ int cvt4_fp8(float a, float b, float c, float d) { int r; asm("v_cvt_pk_fp8_f32 %0, %1, %2" : "=v"(r) : "v"(a), "v"(b)); asm("v_cvt_pk_fp8_f32 %0, %1, %2 op_sel:[0,0,1]" : "+v"(r) : "v"(c), "v"(d)); return r; }
__device__ __forceinline__ void qkt8m(f32x16& p0, f32x16& p1, const f32x16& mi, const char* Ks, const v8i& q0, const v8i& q1, int r32, int hi, int sc1, int scq) {
  const int g0 = 4 * hi;
  { const v4i a00 = *reinterpret_cast<const v4i*>(Ks + K8ADDR(r32, g0)), a01 = *reinterpret_cast<const v4i*>(Ks + K8ADDR(r32, g0 + 1));
    const v4i b00 = *reinterpret_cast<const v4i*>(Ks + K8ADDR(32 + r32, g0)), b01 = *reinterpret_cast<const v4i*>(Ks + K8ADDR(32 + r32, g0 + 1));
    const v8i ka0 = __builtin_shufflevector(a00, a01, 0, 1, 2, 3, 4, 5, 6, 7), kb0 = __builtin_shufflevector(b00, b01, 0, 1, 2, 3, 4, 5, 6, 7);
    asm volatile("s_nop 1\n\tv_mfma_scale_f32_32x32x64_f8f6f4 %0, %1, %2, %3, %4, %5 op_sel_hi:[0,0,0]" : "=&v"(p0) : "v"(ka0), "v"(q0), "v"(mi), "v"(sc1), "v"(scq));
    asm volatile("s_nop 1\n\tv_mfma_scale_f32_32x32x64_f8f6f4 %0, %1, %2, %3, %4, %5 op_sel_hi:[0,0,0]" : "=&v"(p1) : "v"(kb0), "v"(q0), "v"(mi), "v"(sc1), "v"(scq) : "memory"); }
  { const v4i a10 = *reinterpret_cast<const v4i*>(Ks + K8ADDR(r32, g0 + 2)), a11 = *reinterpret_cast<const v4i*>(Ks + K8ADDR(r32, g0 + 3));
    const v4i b10 = *reinterpret_cast<const v4i*>(Ks + K8ADDR(32 + r32, g0 + 2)), b11 = *reinterpret_cast<const v4i*>(Ks + K8ADDR(32 + r32, g0 + 3));
    const v8i ka1 = __builtin_shufflevector(a10, a11, 0, 1, 2, 3, 4, 5, 6, 7), kb1 = __builtin_shufflevector(b10, b11, 0, 1, 2, 3, 4, 5, 6, 7);
    asm volatile("s_nop 1\n\tv_mfma_scale_f32_32x32x64_f8f6f4 %0, %1, %2, %0, %3, %4 op_sel_hi:[0,0,0]" : "+v"(p0) : "v"(ka1), "v"(q1), "v"(sc1), "v"(scq));
    asm volatile("s_nop 1\n\tv_mfma_scale_f32_32x32x64_f8f6f4 %0, %1, %2, %0, %3, %4 op_sel_hi:[0,0,0]" : "+v"(p1) : "v"(kb1), "v"(q1), "v"(sc1), "v"(scq)); }
}
__device__ __forceinline__ void xdl_pad2(f32x16& a, f32x16& b) { asm volatile("s_nop 15\n\ts_nop 7" : "+v"(a), "+v"(b)); }
template <bool FIRST> __device__ __forceinline__ void partialSM8m(f32x16& p0, f32x16& p1, float& M, f32x16& mi, float& alpha) {
  float pmax = p0[0];
#pragma unroll
  for (int r = 1; r < 16; ++r) pmax = fmaxf(pmax, p0[r]);
#pragma unroll
  for (int r = 0; r < 16; ++r) pmax = fmaxf(pmax, p1[r]);
  { auto rr = __builtin_amdgcn_permlane32_swap(__float_as_uint(pmax), __float_as_uint(pmax), false, false);
    pmax = fmaxf(__uint_as_float(rr[0]), __uint_as_float(rr[1])); }
  if (!FIRST && __builtin_expect(__all(pmax <= THR2), 1)) { alpha = 1.f; }
  else { const float d = FIRST ? pmax : fmaxf(pmax, 0.f); alpha = FIRST ? 1.f : __builtin_amdgcn_exp2f(-d); M += d;
#pragma unroll
    for (int r = 0; r < 16; ++r) { p0[r] -= d; p1[r] -= d; }
    const float nm = -M;
#pragma unroll
    for (int r = 0; r < 16; ++r) mi[r] = nm;
    asm volatile("" : "+v"(mi)); }
#pragma unroll
  for (int r = 0; r < 16; ++r) p0[r] = __builtin_amdgcn_exp2f(p0[r]);
}
__device__ __forceinline__ void finishSM8m(f32x16& p0, f32x16& p1, float alpha, float& l_reg, v8i& pa) {
#pragma unroll
  for (int r = 0; r < 16; ++r) p1[r] = __builtin_amdgcn_exp2f(p1[r]);
  float sa = p0[0], sb = p1[0];
#pragma unroll
  for (int r = 1; r < 16; ++r) { sa += p0[r]; sb += p1[r]; }
  float ps = sa + sb;
  { auto rr = __builtin_amdgcn_permlane32_swap(__float_as_uint(ps), __float_as_uint(ps), false, false);
    ps = __uint_as_float(rr[0]) + __uint_as_float(rr[1]); }
  l_reg = l_reg * alpha + ps;
  pa = (v8i){cvt4_fp8(p0[0], p0[1], p0[2], p0[3]), cvt4_fp8(p0[4], p0[5], p0[6], p0[7]), cvt4_fp8(p0[8], p0[9], p0[10], p0[11]), cvt4_fp8(p0[12], p0[13], p0[14], p0[15]),
             cvt4_fp8(p1[0], p1[1], p1[2], p1[3]), cvt4_fp8(p1[4], p1[5], p1[6], p1[7]), cvt4_fp8(p1[8], p1[9], p1[10], p1[11]), cvt4_fp8(p1[12], p1[13], p1[14], p1[15])};
}
__device__ __forceinline__ void pv8m(f32x16* o, const char* Vs, const v8i& pa, int r32, int hi, int sc1) {
#pragma unroll
  for (int d0 = 0; d0 < 4; ++d0) { const int d = 32 * d0 + r32;
    const v4i x0 = *reinterpret_cast<const v4i*>(Vs + V8ADDR(d, 2 * hi)), x1 = *reinterpret_cast<const v4i*>(Vs + V8ADDR(d, 2 * hi + 1));
    const v8i vb = __builtin_shufflevector(x0, x1, 0, 1, 2, 3, 4, 5, 6, 7);
    asm volatile("s_nop 1\n\tv_mfma_scale_f32_32x32x64_f8f6f4 %0, %1, %2, %0, %3, %3 op_sel_hi:[0,0,0]" : "+v"(o[d0]) : "v"(pa), "v"(vb), "v"(sc1)); }
}
__device__ __forceinline__ void attn_dense_body_m(const bf16* __restrict__ Qb, const unsigned char* __restrict__ Kh8, const unsigned char* __restrict__ Vt8, bf16* __restrict__ Ob, int seq, char* lds) {
  constexpr int SDEPTH = 2; constexpr size_t SHM_V8 = 8192;
  const int tid = threadIdx.x, wid = tid >> 6, lane = tid & 63, r32 = lane & 31, hi = lane >> 5;
  char* V_lds = lds; char* K_lds = lds + 2 * SHM_V8;
  float* ws = (float*)(lds + 2 * SHM_V8 + 2 * SHM_K8) + wid * 64; float* li_l = ws; float* al_l = ws + 32;
  float M = 0.f, l_reg = 0; f32x16 o[4] = {}; f32x16 mi = {}; asm volatile("" : "+v"(mi));
  v8i q8a, q8b; const int sc1 = 0x7f7f7f7f, scq = 0x7c7c7c7c;
  { bf16x8 qr[8]; const bf16* Qw = Qb + (long)(wid * QBLK + r32) * LDQ + hi * 8;
#pragma unroll
    for (int d0 = 0; d0 < 8; ++d0) qr[d0] = *reinterpret_cast<const bf16x8*>(Qw + d0 * 16);
    int w[16];
#pragma unroll
    for (int d0 = 0; d0 < 8; ++d0) { const u32x4 x = *reinterpret_cast<const u32x4*>(&qr[d0]);
      w[2 * d0] = (int)pk4_fp8(bflo(x.x) * QS8, bfhi(x.x) * QS8, bflo(x.y) * QS8, bfhi(x.y) * QS8); w[2 * d0 + 1] = (int)pk4_fp8(bflo(x.z) * QS8, bfhi(x.z) * QS8, bflo(x.w) * QS8, bfhi(x.w) * QS8); }
    q8a = (v8i){w[0], w[1], w[2], w[3], w[4], w[5], w[6], w[7]}; q8b = (v8i){w[8], w[9], w[10], w[11], w[12], w[13], w[14], w[15]}; }
  const int krow = tid >> 3, kg = tid & 7, kst = K8ADDR(krow, kg);
  const int vrow = tid >> 2, vg = tid & 3, vst = V8ADDR(vrow, vg);
  struct { v4i vs, ks; } sr_[SDEPTH];
#define SLOAD(i, k0) do { sr_[i].vs = *reinterpret_cast<const v4i*>(&Vt8[(long)((k0) / KVBLK) * 8192 + tid * 16]); sr_[i].ks = *reinterpret_cast<const v4i*>(&Kh8[(long)((k0) + krow) * 256 + kg * 16]); } while (0)
#define SWRITE(b, i) do { *(v4i*)(V_lds + (b) * SHM_V8 + vst) = sr_[i].vs; *(v4i*)(K_lds + (b) * SHM_K8 + kst) = sr_[i].ks; } while (0)
#define SWAIT() do { asm volatile("s_waitcnt vmcnt(2)" ::: "memory"); } while (0)
#define RESC(a) do { if (__any((a) < 1.f)) { if (hi == 0) al_l[r32] = (a); xdl_pad2(o[0], o[1]); xdl_pad2(o[2], o[3]); asm volatile("s_waitcnt lgkmcnt(0)" ::: "memory"); \
    _Pragma("unroll") for (int d = 0; d < 4; ++d) _Pragma("unroll") for (int r = 0; r < 16; ++r) o[d][r] *= al_l[crow(r, hi)]; } } while (0)
  f32x16 pA0, pA1, pB0, pB1; float alA, alB; v8i pa; const int NT = seq / KVBLK;
  constexpr int SE = 0, SO = SDEPTH - 1;
  SLOAD(SE, 0); asm volatile("s_waitcnt vmcnt(0)" ::: "memory"); SWRITE(0, SE); __syncthreads();
  qkt8m(pA0, pA1, mi, K_lds, q8a, q8b, r32, hi, sc1, scq); xdl_pad2(pA0, pA1); partialSM8m<true>(pA0, pA1, M, mi, alA);
  SLOAD(SO, KVBLK); if (2 < NT) SLOAD(SE, 2 * KVBLK);
  SWAIT(); SWRITE(1, SO); __syncthreads();
  for (int j = 1; j + 1 < NT; j += 2) {
    SBAR(); qkt8m(pB0, pB1, mi, K_lds + SHM_K8, q8a, q8b, r32, hi, sc1, scq);
    finishSM8m(pA0, pA1, alA, l_reg, pa); SBAR();
    SLOAD(SO, (j + SDEPTH) * KVBLK); SBAR();
    pv8m(o, V_lds, pa, r32, hi, sc1); partialSM8m<false>(pB0, pB1, M, mi, alB);
    __syncthreads(); SWAIT(); SWRITE(0, SE);
    RESC(alB); __syncthreads();
    SBAR(); qkt8m(pA0, pA1, mi, K_lds, q8a, q8b, r32, hi, sc1, scq);
    finishSM8m(pB0, pB1, alB, l_reg, pa); SBAR();
    if (j + 3 < NT) SLOAD(SE, (j + 1 + SDEPTH) * KVBLK); SBAR();
    pv8m(o, V_lds + SHM_V8, pa, r32, hi, sc1); partialSM8m<false>(pA0, pA1, M, mi, alA);
    __syncthreads(); SWAIT(); SWRITE(1, SO);
    RESC(alA); __syncthreads();
  }
  SBAR(); qkt8m(pB0, pB1, mi, K_lds + SHM_K8, q8a, q8b, r32, hi, sc1, scq);
  finishSM8m(pA0, pA1, alA, l_reg, pa); SBAR();
  pv8m(o, V_lds, pa, r32, hi, sc1); partialSM8m<false>(pB0, pB1, M, mi, alB);
  __syncthreads(); RESC(alB);
  finishSM8m(pB0, pB1, alB, l_reg, pa); SBAR();
  pv8m(o, V_lds + SHM_V8, pa, r32, hi, sc1);
  if (hi == 0) li_l[r32] = l_reg; asm volatile("s_waitcnt lgkmcnt(0)" ::: "memory");
  xdl_pad2(o[0], o[1]); xdl_pad2(o[2], o[3]);
  float rli[16];
#pragma unroll
  for (int r = 0; r < 16; ++r) rli[r] = __builtin_amdgcn_rcpf(li_l[crow(r, hi)]);
  bf16* Ow = Ob + (long)(wid * QBLK) * LDO;
#pragma unroll
  for (int r = 0; r < 16; ++r) { int orow = crow(r, hi);
#pragma unroll
    for (int d0 = 0; d0 < 4; ++d0) Ow[(long)orow * LDO + d0 * 32 + r32] = (bf16)f2bf(o[d0][r] * rli[r]); }
  __syncthreads();
#undef SLOAD
#undef SWRITE
#undef SWAIT
#undef RESC
}
__device__ __forceinline__ void mfma8_init(f32x16& p, const v8i& a, const v8i& b, const f32x16& c, int sa, int sb) {
  asm volatile("s_nop 1\n\tv_mfma_scale_f32_32x32x64_f8f6f4 %0, %1, %2, %3, %4, %5 op_sel_hi:[0,0,0]" : "=&v"(p) : "v"(a), "v"(b), "v"(c), "v"(sa), "v"(sb)); }
__device__ __forceinline__ void mfma8_acc(f32x16& p, const v8i& a, const v8i& b, int sa, int sb) {
  asm volatile("s_nop 1\n\tv_mfma_scale_f32_32x32x64_f8f6f4 %0, %1, %2, %0, %3, %4 op_sel_hi:[0,0,0]" : "+v"(p) : "v"(a), "v"(b), "v"(sa), "v"(sb)); }
__device__ __forceinline__ void attn_dense_body_i(const bf16* __restrict__ Qb, const unsigned char* __restrict__ Kh8, const unsigned char* __restrict__ Vt8, bf16* __restrict__ Ob, int seq, char* lds) {
  constexpr int SDEPTH = 2; constexpr size_t SHM_V8 = 8192;
  const int tid = threadIdx.x, wid = tid >> 6, lane = tid & 63, r32 = lane & 31, hi = lane >> 5;
  char* V_lds = lds; char* K_lds = lds + 2 * SHM_V8;
  float* ws = (float*)(lds + 2 * SHM_V8 + 2 * SHM_K8) + wid * 64; float* li_l = ws; float* al_l = ws + 32;
  float M = 0.f, l_reg = 0; f32x16 o[4] = {}; f32x16 mi = {}; asm volatile("" : "+v"(mi));
  v8i q8a, q8b; const int sc1 = 0x7f7f7f7f, scq = 0x7c7c7c7c;
  { bf16x8 qr[8]; const bf16* Qw = Qb + (long)(wid * QBLK + r32) * LDQ + hi * 8;
#pragma unroll
    for (int d0 = 0; d0 < 8; ++d0) qr[d0] = *reinterpret_cast<const bf16x8*>(Qw + d0 * 16);
    int w[16];
#pragma unroll
    for (int d0 = 0; d0 < 8; ++d0) { const u32x4 x = *reinterpret_cast<const u32x4*>(&qr[d0]);
      w[2 * d0] = (int)pk4_fp8(bflo(x.x) * QS8, bfhi(x.x) * QS8, bflo(x.y) * QS8, bfhi(x.y) * QS8); w[2 * d0 + 1] = (int)pk4_fp8(bflo(x.z) * QS8, bfhi(x.z) * QS8, bflo(x.w) * QS8, bfhi(x.w) * QS8); }
    q8a = (v8i){w[0], w[1], w[2], w[3], w[4], w[5], w[6], w[7]}; q8b = (v8i){w[8], w[9], w[10], w[11], w[12], w[13], w[14], w[15]}; }
  const int krow = tid >> 3, kg = tid & 7, kst = K8ADDR(krow, kg);
  const int vrow = tid >> 2, vg = tid & 3, vst = V8ADDR(vrow, vg);
  const int g0 = 4 * hi;
  struct { v4i vs, ks; } sr_[SDEPTH];
#define SLOAD(i, k0) do { sr_[i].vs = *reinterpret_cast<const v4i*>(&Vt8[(long)((k0) / KVBLK) * 8192 + tid * 16]); sr_[i].ks = *reinterpret_cast<const v4i*>(&Kh8[(long)((k0) + krow) * 256 + kg * 16]); } while (0)
#define SWRITE(b, i) do { *(v4i*)(V_lds + (b) * SHM_V8 + vst) = sr_[i].vs; *(v4i*)(K_lds + (b) * SHM_K8 + kst) = sr_[i].ks; } while (0)
#define SWAIT() do { asm volatile("s_waitcnt vmcnt(2)" ::: "memory"); } while (0)
#define RESC(a) do { if (__any((a) < 1.f)) { if (hi == 0) al_l[r32] = (a); xdl_pad2(o[0], o[1]); xdl_pad2(o[2], o[3]); asm volatile("s_waitcnt lgkmcnt(0)" ::: "memory"); \
    _Pragma("unroll") for (int d = 0; d < 4; ++d) _Pragma("unroll") for (int r = 0; r < 16; ++r) o[d][r] *= al_l[crow(r, hi)]; } } while (0)
#define KFRAG(D0, D1, KB, G) do { const v4i a0_ = *reinterpret_cast<const v4i*>((KB) + K8ADDR(r32, (G))), a1_ = *reinterpret_cast<const v4i*>((KB) + K8ADDR(r32, (G) + 1));             \
    const v4i b0_ = *reinterpret_cast<const v4i*>((KB) + K8ADDR(32 + r32, (G))), b1_ = *reinterpret_cast<const v4i*>((KB) + K8ADDR(32 + r32, (G) + 1));                                \
    D0 = __builtin_shufflevector(a0_, a1_, 0, 1, 2, 3, 4, 5, 6, 7); D1 = __builtin_shufflevector(b0_, b1_, 0, 1, 2, 3, 4, 5, 6, 7); } while (0)
#define VFRAG(Dv, VB, D0) do { const int d_ = 32 * (D0) + r32; const v4i x0_ = *reinterpret_cast<const v4i*>((VB) + V8ADDR(d_, 2 * hi)), x1_ = *reinterpret_cast<const v4i*>((VB) + V8ADDR(d_, 2 * hi + 1)); \
    Dv = __builtin_shufflevector(x0_, x1_, 0, 1, 2, 3, 4, 5, 6, 7); } while (0)
#define EXPR(P, LO, HI) do { _Pragma("unroll") for (int r = (LO); r < (HI); ++r) P[r] = __builtin_amdgcn_exp2f(P[r]); } while (0)
#define ATT_HALF(PB0, PB1, ALB, PA0, PA1, ALA, KB, VA, LOADSTMT) do {                                                                              \
    v8i ka_, kb_, vf_;                                                                                                                             \
    KFRAG(ka_, kb_, KB, g0); EXPR(PA1, 0, 8);                                                                                                      \
    SBAR(); mfma8_init(PB0, ka_, q8a, mi, sc1, scq); SBAR();                                                                                       \
    EXPR(PA1, 8, 16);                                                                                                                              \
    SBAR(); mfma8_init(PB1, kb_, q8a, mi, sc1, scq); SBAR();                                                                                       \
    KFRAG(ka_, kb_, KB, g0 + 2);                                                                                                                   \
    float sa_ = PA0[0], sb_ = PA0[8];                                                                                                              \
    _Pragma("unroll") for (int r = 1; r < 8; ++r) { sa_ += PA0[r]; sb_ += PA0[8 + r]; }                                                            \
    SBAR(); mfma8_acc(PB0, ka_, q8b, sc1, scq); SBAR();                                                                                            \
    VFRAG(vf_, VA, 0);                                                                                                                             \
    { float sc_ = PA1[0], sd_ = PA1[8];                                                                                                            \
      _Pragma("unroll") for (int r = 1; r < 8; ++r) { sc_ += PA1[r]; sd_ += PA1[8 + r]; }                                                          \
      float ps_ = (sa_ + sb_) + (sc_ + sd_);                                                                                                       \
      auto rr_ = __builtin_amdgcn_permlane32_swap(__float_as_uint(ps_), __float_as_uint(ps_), false, false);                                       \
      l_reg = l_reg * (ALA) + (__uint_as_float(rr_[0]) + __uint_as_float(rr_[1])); }                                                               \
    SBAR(); mfma8_acc(PB1, kb_, q8b, sc1, scq); SBAR();                                                                                            \
    pa = (v8i){cvt4_fp8(PA0[0], PA0[1], PA0[2], PA0[3]), cvt4_fp8(PA0[4], PA0[5], PA0[6], PA0[7]), cvt4_fp8(PA0[8], PA0[9], PA0[10], PA0[11]), cvt4_fp8(PA0[12], PA0[13], PA0[14], PA0[15]), \
               cvt4_fp8(PA1[0], PA1[1], PA1[2], PA1[3]), cvt4_fp8(PA1[4], PA1[5], PA1[6], PA1[7]), cvt4_fp8(PA1[8], PA1[9], PA1[10], PA1[11]), cvt4_fp8(PA1[12], PA1[13], PA1[14], PA1[15])}; \
    SBAR(); mfma8_acc(o[0], pa, vf_, sc1, sc1); SBAR();                                                                                            \
    VFRAG(vf_, VA, 1); LOADSTMT;                                                                                                                   \
    float mx_ = PB0[0];                                                                                                                            \
    _Pragma("unroll") for (int r = 1; r < 16; ++r) mx_ = fmaxf(mx_, PB0[r]);                                                                       \
    SBAR(); mfma8_acc(o[1], pa, vf_, sc1, sc1); SBAR();                                                                                            \
    VFRAG(vf_, VA, 2);                                                                                                                             \
    _Pragma("unroll") for (int r = 0; r < 16; ++r) mx_ = fmaxf(mx_, PB1[r]);                                                                       \
    { auto rr_ = __builtin_amdgcn_permlane32_swap(__float_as_uint(mx_), __float_as_uint(mx_), false, false);                                       \
      mx_ = fmaxf(__uint_as_float(rr_[0]), __uint_as_float(rr_[1])); }                                                                             \
    if (__builtin_expect(__all(mx_ <= THR2), 1)) { ALB = 1.f; }                                                                                    \
    else { const float d_ = fmaxf(mx_, 0.f); ALB = __builtin_amdgcn_exp2f(-d_); M += d_;                                                           \
      _Pragma("unroll") for (int r = 0; r < 16; ++r) { PB0[r] -= d_; PB1[r] -= d_; }                                                               \
      const float nm_ = -M;                                                                                                                        \
      _Pragma("unroll") for (int r = 0; r < 16; ++r) mi[r] = nm_;                                                                                  \
      asm volatile("" : "+v"(mi)); }                                                                                                               \
    SBAR(); mfma8_acc(o[2], pa, vf_, sc1, sc1); SBAR();                                                                                            \
    VFRAG(vf_, VA, 3); EXPR(PB0, 0, 8);                                                                                                            \
    SBAR(); mfma8_acc(o[3], pa, vf_, sc1, sc1); SBAR();                                                                                            \
    EXPR(PB0, 8, 16);                                                                                                                              \
  } while (0)
  f32x16 pA0, pA1, pB0, pB1; float alA, alB; v8i pa; const int NT = seq / KVBLK;
  constexpr int SE = 0, SO = SDEPTH - 1;
  SLOAD(SE, 0); asm volatile("s_waitcnt vmcnt(0)" ::: "memory"); SWRITE(0, SE); __syncthreads();
  qkt8m(pA0, pA1, mi, K_lds, q8a, q8b, r32, hi, sc1, scq); xdl_pad2(pA0, pA1); partialSM8m<true>(pA0, pA1, M, mi, alA);
  SLOAD(SO, KVBLK); if (2 < NT) SLOAD(SE, 2 * KVBLK);
  SWAIT(); SWRITE(1, SO); __syncthreads();
  for (int j = 1; j + 1 < NT; j += 2) {
    ATT_HALF(pB0, pB1, alB, pA0, pA1, alA, K_lds + SHM_K8, V_lds, SLOAD(SO, (j + SDEPTH) * KVBLK));
    __syncthreads(); SWAIT(); SWRITE(0, SE);
    RESC(alB); __syncthreads();
    ATT_HALF(pA0, pA1, alA, pB0, pB1, alB, K_lds, V_lds + SHM_V8, if (j + 3 < NT) SLOAD(SE, (j + 1 + SDEPTH) * KVBLK));
    __syncthreads(); SWAIT(); SWRITE(1, SO);
    RESC(alA); __syncthreads();
  }
  ATT_HALF(pB0, pB1, alB, pA0, pA1, alA, K_lds + SHM_K8, V_lds, (void)0);
  __syncthreads(); RESC(alB);
  finishSM8m(pB0, pB1, alB, l_reg, pa); SBAR();
  pv8m(o, V_lds + SHM_V8, pa, r32, hi, sc1);
  if (hi == 0) li_l[r32] = l_reg; asm volatile("s_waitcnt lgkmcnt(0)" ::: "memory");
  xdl_pad2(o[0], o[1]); xdl_pad2(o[2], o[3]);
  float rli[16];
#pragma unroll
  for (int r = 0; r < 16; ++r) rli[r] = __builtin_amdgcn_rcpf(li_l[crow(r, hi)]);
  bf16* Ow = Ob + (long)(wid * QBLK) * LDO;
#pragma unroll
  for (int r = 0; r < 16; ++r) { int orow = crow(r, hi);
#pragma unroll
    for (int d0 = 0; d0 < 4; ++d0) Ow[(long)orow * LDO + d0 * 32 + r32] = (bf16)f2bf(o[d0][r] * rli[r]); }
  __syncthreads();
#undef SLOAD
#undef SWRITE
#undef SWAIT
#undef RESC
#undef KFRAG
#undef VFRAG
#undef EXPR
#undef ATT_HALF
}
__device__ __forceinline__ void attn_dense_body_d(const bf16* __restrict__ Qb, const unsigned char* __restrict__ Kh8, const unsigned char* __restrict__ Vt8, bf16* __restrict__ Ob, int seq, LAS char* lds) {
  const int tid = threadIdx.x, wid = tid >> 6, lane = tid & 63, r32 = lane & 31, hi = lane >> 5;
  LAS char* K_lds = lds; LAS char* V_lds = lds + 4 * 8192;
  LAS float* ws = (LAS float*)(lds + 8 * 8192) + wid * 64; LAS float* li_l = ws; LAS float* al_l = ws + 32;
  float M = 0.f, l_reg = 0; f32x16 o[4] = {}; f32x16 mi = {}; asm volatile("" : "+v"(mi));
  v8i q8a, q8b; const int sc1 = 0x7f7f7f7f, scq = 0x7c7c7c7c;
  { bf16x8 qr[8]; const bf16* Qw = Qb + (long)(wid * QBLK + r32) * LDQ + hi * 8;
#pragma unroll
    for (int d0 = 0; d0 < 8; ++d0) qr[d0] = *reinterpret_cast<const bf16x8*>(Qw + d0 * 16);
    int w[16];
#pragma unroll
    for (int d0 = 0; d0 < 8; ++d0) { const u32x4 x = *reinterpret_cast<const u32x4*>(&qr[d0]);
      w[2 * d0] = (int)pk4_fp8(bflo(x.x) * QS8, bfhi(x.x) * QS8, bflo(x.y) * QS8, bfhi(x.y) * QS8); w[2 * d0 + 1] = (int)pk4_fp8(bflo(x.z) * QS8, bfhi(x.z) * QS8, bflo(x.w) * QS8, bfhi(x.w) * QS8); }
    q8a = (v8i){w[0], w[1], w[2], w[3], w[4], w[5], w[6], w[7]}; q8b = (v8i){w[8], w[9], w[10], w[11], w[12], w[13], w[14], w[15]}; }
  const int g0 = 4 * hi;
  const int kr = wid * 8 + (lane >> 3), vd = wid * 16 + (lane >> 2);
  const unsigned kgo = (unsigned)kr * 256u + (unsigned)((((lane & 7) ^ (kr >> 1)) & 7) << 4), vgo = (unsigned)vd * 64u + (unsigned)((((lane & 3) ^ (vd >> 2)) & 3) << 4);
#define DMA(blk) do { const int b_ = (blk) & 3; unsigned ko_ = (unsigned)(blk) * 16384u, vo_ = (unsigned)(blk) * 8192u; asm volatile("" : "+s"(ko_), "+s"(vo_));     \
    __builtin_amdgcn_global_load_lds((const unsigned*)(Kh8 + (size_t)(ko_ + kgo)), (LAS unsigned*)(K_lds + b_ * 8192 + wid * 1024), 16, 0, 0);                      \
    __builtin_amdgcn_global_load_lds((const unsigned*)(Vt8 + (size_t)(vo_ + vgo)), (LAS unsigned*)(V_lds + b_ * 8192 + wid * 1024), 16, 0, 0); } while (0)
#define VMW(n) asm volatile("s_waitcnt vmcnt(" #n ")" ::: "memory")
#define BAR() __builtin_amdgcn_s_barrier()
#define RESC(a) do { if (__any((a) < 1.f)) { if (hi == 0) al_l[r32] = (a); xdl_pad2(o[0], o[1]); xdl_pad2(o[2], o[3]); asm volatile("s_waitcnt lgkmcnt(0)" ::: "memory"); \
    _Pragma("unroll") for (int d = 0; d < 4; ++d) _Pragma("unroll") for (int r = 0; r < 16; ++r) o[d][r] *= al_l[crow(r, hi)]; } } while (0)
#define KFRAG(D0, D1, KB, G) do { const v4i a0_ = *reinterpret_cast<const LAS v4i*>((KB) + K8ADDR(r32, (G))), a1_ = *reinterpret_cast<const LAS v4i*>((KB) + K8ADDR(r32, (G) + 1));             \
    const v4i b0_ = *reinterpret_cast<const LAS v4i*>((KB) + K8ADDR(r32, (G)) + 4096), b1_ = *reinterpret_cast<const LAS v4i*>((KB) + K8ADDR(r32, (G) + 1) + 4096);     \
    D0 = __builtin_shufflevector(a0_, a1_, 0, 1, 2, 3, 4, 5, 6, 7); D1 = __builtin_shufflevector(b0_, b1_, 0, 1, 2, 3, 4, 5, 6, 7); } while (0)
#define VFRAG(Dv, VB, D0) do { const v4i x0_ = *reinterpret_cast<const LAS v4i*>((VB) + V8ADDR(r32, 2 * hi) + 2048 * (D0)), x1_ = *reinterpret_cast<const LAS v4i*>((VB) + V8ADDR(r32, 2 * hi + 1) + 2048 * (D0));     \
    Dv = __builtin_shufflevector(x0_, x1_, 0, 1, 2, 3, 4, 5, 6, 7); } while (0)
#define EXPR(P, LO, HI) do { _Pragma("unroll") for (int r = (LO); r < (HI); ++r) P[r] = __builtin_amdgcn_exp2f(P[r]); } while (0)
#define ATT_HALF(PB0, PB1, ALB, PA0, PA1, ALA, KB, VA, LOADSTMT) do {                                                                              \
    v8i ka_, kb_, vf_;                                                                                                                             \
    KFRAG(ka_, kb_, KB, g0); EXPR(PA1, 0, 8);                                                                                                      \
    SBAR(); mfma8_init(PB0, ka_, q8a, mi, sc1, scq); SBAR();                                                                                       \
    EXPR(PA1, 8, 16);                                                                                                                              \
    SBAR(); mfma8_init(PB1, kb_, q8a, mi, sc1, scq); SBAR();                                                                                       \
    KFRAG(ka_, kb_, KB, g0 + 2);                                                                                                                   \
    float sa_ = PA0[0], sb_ = PA0[8];                                                                                                              \
    _Pragma("unroll") for (int r = 1; r < 8; ++r) { sa_ += PA0[r]; sb_ += PA0[8 + r]; }                                                            \
    asm volatile("" : "+v"(sa_), "+v"(sb_));                                                                                                       \
    SBAR(); mfma8_acc(PB0, ka_, q8b, sc1, scq); SBAR();                                                                                            \
    VFRAG(vf_, VA, 0);                                                                                                                             \
    { float sc_ = PA1[0], sd_ = PA1[8];                                                                                                            \
      _Pragma("unroll") for (int r = 1; r < 8; ++r) { sc_ += PA1[r]; sd_ += PA1[8 + r]; }                                                          \
      float ps_ = (sa_ + sb_) + (sc_ + sd_);                                                                                                       \
      auto rr_ = __builtin_amdgcn_permlane32_swap(__float_as_uint(ps_), __float_as_uint(ps_), false, false);                                       \
      l_reg = l_reg * (ALA) + (__uint_as_float(rr_[0]) + __uint_as_float(rr_[1])); }                                                               \
    SBAR(); mfma8_acc(PB1, kb_, q8b, sc1, scq); SBAR();                                                                                            \
    pa = (v8i){cvt4_fp8(PA0[0], PA0[1], PA0[2], PA0[3]), cvt4_fp8(PA0[4], PA0[5], PA0[6], PA0[7]), cvt4_fp8(PA0[8], PA0[9], PA0[10], PA0[11]), cvt4_fp8(PA0[12], PA0[13], PA0[14], PA0[15]), \
               cvt4_fp8(PA1[0], PA1[1], PA1[2], PA1[3]), cvt4_fp8(PA1[4], PA1[5], PA1[6], PA1[7]), cvt4_fp8(PA1[8], PA1[9], PA1[10], PA1[11]), cvt4_fp8(PA1[12], PA1[13], PA1[14], PA1[15])}; \
    SBAR(); mfma8_acc(o[0], pa, vf_, sc1, sc1); SBAR();                                                                                            \
    VFRAG(vf_, VA, 1); LOADSTMT;                                                                                                                   \
    float mx_ = PB0[0];                                                                                                                            \
    _Pragma("unroll") for (int r = 1; r < 16; ++r) mx_ = fmaxf(mx_, PB0[r]);                                                                       \
    SBAR(); mfma8_acc(o[1], pa, vf_, sc1, sc1); SBAR();                                                                                            \
    VFRAG(vf_, VA, 2);                                                                                                                             \
    _Pragma("unroll") for (int r = 0; r < 16; ++r) mx_ = fmaxf(mx_, PB1[r]);                                                                       \
    { auto rr_ = __builtin_amdgcn_permlane32_swap(__float_as_uint(mx_), __float_as_uint(mx_), false, false);                                       \
      mx_ = fmaxf(__uint_as_float(rr_[0]), __uint_as_float(rr_[1])); }                                                                             \
    if (__builtin_expect(__all(mx_ <= THR2), 1)) { ALB = 1.f; }                                                                                    \
    else { const float d_ = fmaxf(mx_, 0.f); ALB = __builtin_amdgcn_exp2f(-d_); M += d_;                                                           \
      _Pragma("unroll") for (int r = 0; r < 16; ++r) { PB0[r] -= d_; PB1[r] -= d_; }                                                               \
      const float nm_ = -M;                                                                                                                        \
      _Pragma("unroll") for (int r = 0; r < 16; ++r) mi[r] = nm_;                                                                                  \
      asm volatile("" : "+v"(mi)); }                                                                                                               \
    SBAR(); mfma8_acc(o[2], pa, vf_, sc1, sc1); SBAR();                                                                                            \
    VFRAG(vf_, VA, 3); EXPR(PB0, 0, 8); asm volatile("" : "+v"(PB0));       \
    SBAR(); mfma8_acc(o[3], pa, vf_, sc1, sc1); SBAR();                                                                                            \
    EXPR(PB0, 8, 16); asm volatile("" : "+v"(PB0));                                                                                                \
  } while (0)
  f32x16 pA0, pA1, pB0, pB1; float alA, alB; v8i pa; const int NT = seq / KVBLK;
  DMA(0); DMA(1); VMW(2); BAR();
  { v8i ka_, kb_; KFRAG(ka_, kb_, K_lds, g0); mfma8_init(pA0, ka_, q8a, mi, sc1, scq); mfma8_init(pA1, kb_, q8a, mi, sc1, scq);
    KFRAG(ka_, kb_, K_lds, g0 + 2); mfma8_acc(pA0, ka_, q8b, sc1, scq); mfma8_acc(pA1, kb_, q8b, sc1, scq); }
  xdl_pad2(pA0, pA1); partialSM8m<true>(pA0, pA1, M, mi, alA);
  DMA(2); VMW(2); BAR();
  for (int j = 1; j + 1 < NT; j += 2) {
    DMA(j + 2);
    ATT_HALF(pB0, pB1, alB, pA0, pA1, alA, K_lds + (j & 3) * 8192, V_lds + ((j - 1) & 3) * 8192, (void)0);
    VMW(2); BAR(); RESC(alB);
    const bool more = j + 3 < NT;
    if (more) DMA(j + 3);
    ATT_HALF(pA0, pA1, alA, pB0, pB1, alB, K_lds + ((j + 1) & 3) * 8192, V_lds + (j & 3) * 8192, (void)0);
    if (more) VMW(2); else VMW(0);
    BAR(); RESC(alA);
  }
  ATT_HALF(pB0, pB1, alB, pA0, pA1, alA, K_lds + ((NT - 1) & 3) * 8192, V_lds + ((NT - 2) & 3) * 8192, (void)0);
  RESC(alB);
  { LAS char* Vb = V_lds + ((NT - 1) & 3) * 8192; v8i vf_;
    EXPR(pB1, 0, 16);
    float sa_ = pB0[0], sb_ = pB1[0];
#pragma unroll
    for (int r = 1; r < 16; ++r) { sa_ += pB0[r]; sb_ += pB1[r]; }
    float ps_ = sa_ + sb_;
    auto rr_ = __builtin_amdgcn_permlane32_swap(__float_as_uint(ps_), __float_as_uint(ps_), false, false);
    l_reg = l_reg * alB + (__uint_as_float(rr_[0]) + __uint_as_float(rr_[1]));
    pa = (v8i){cvt4_fp8(pB0[0], pB0[1], pB0[2], pB0[3]), cvt4_fp8(pB0[4], pB0[5], pB0[6], pB0[7]), cvt4_fp8(pB0[8], pB0[9], pB0[10], pB0[11]), cvt4_fp8(pB0[12], pB0[13], pB0[14], pB0[15]),
               cvt4_fp8(pB1[0], pB1[1], pB1[2], pB1[3]), cvt4_fp8(pB1[4], pB1[5], pB1[6], pB1[7]), cvt4_fp8(pB1[8], pB1[9], pB1[10], pB1[11]), cvt4_fp8(pB1[12], pB1[13], pB1[14], pB1[15])};
#pragma unroll
    for (int d0 = 0; d0 < 4; ++d0) { VFRAG(vf_, Vb, d0); mfma8_acc(o[d0], pa, vf_, sc1, sc1); } }
  if (hi == 0) li_l[r32] = l_reg; asm volatile("s_waitcnt lgkmcnt(0)" ::: "memory");
  xdl_pad2(o[0], o[1]); xdl_pad2(o[2], o[3]);
  float rli[16];
#pragma unroll
  for (int r = 0; r < 16; ++r) rli[r] = __builtin_amdgcn_rcpf(li_l[crow(r, hi)]);
  bf16* Ow = Ob + (long)(wid * QBLK) * LDO;
#pragma unroll
  for (int r = 0; r < 16; ++r) { int orow = crow(r, hi);
#pragma unroll
    for (int d0 = 0; d0 < 4; ++d0) Ow[(long)orow * LDO + d0 * 32 + r32] = (bf16)f2bf(o[d0][r] * rli[r]); }
  BAR();
#undef DMA
#undef VMW
#undef BAR
#undef RESC
#undef KFRAG
#undef VFRAG
#undef EXPR
#undef ATT_HALF
}
}

__device__ __forceinline__ void ph_norm3(Frame& F) {
    unsigned char* ar = F.ws + WS_ARENA;
    LAS float* RT = (LAS float*)(F.lds + 3 * 8192);
    LAS int* HIST = (LAS int*)(F.lds + 11 * 8192);
    __syncthreads();
    for (int i = F.tid; i < 2048; i += NTHR) { PV(0)[i] = modp(F, 1, 0, 2)[i] * inp(I_NORMS)[(4 + 1) * 2048 + i]; PV(1)[i] = inp(I_NORMS)[(4 + 2) * 2048 + i] * (1.f + modp(F, 1, 0, 4)[i]); PV(2)[i] = modp(F, 1, 0, 3)[i]; }
    for (int i = F.tid; i < 2048 * 8; i += NTHR) RT[(i & 7) * 2048 + (i >> 3)] = inp(I_ROUTER)[i];
    __syncthreads();
    const bf16* YO = (const bf16*)(ar + B_YO1); bf16* V1 = (bf16*)(ar + B_V1); bf16* HR = (bf16*)(F.ws + WS_HRES) + (size_t)CTX * D;
    int* RE = (int*)(ar + B_RE); float* RG = (float*)(ar + B_RG); int* CNT = (int*)(ar + B_CNT);
    for (int blk = blockIdx.x; blk < SEQ / 64; blk += F.G) {
        if (F.tid < 8) HIST[F.tid] = 0;
        __syncthreads();
        for (int rr = 0; rr < 8; ++rr) { const int t = blk * 64 + F.wave * 8 + rr; f32x4 y[8], h[8];
            ld_row_bf16(YO + (size_t)t * D, F.lane, y); ld_row_bf16(HR + (size_t)t * D, F.lane, h);
            const float ry = 1.f / sqrtf(row_sumsq(y) * (1.f / D) + EPS);
#pragma unroll
            for (int j = 0; j < 8; ++j) h[j] = h[j] + y[j] * ry * ldp(PV(0), F.lane, j);
            st_row_bf16(HR + (size_t)t * D, F.lane, h);
            const float rh = 1.f / sqrtf(row_sumsq(h) * (1.f / D) + EPS);
#pragma unroll
            for (int j = 0; j < 8; ++j) y[j] = h[j] * rh * ldp(PV(1), F.lane, j) + ldp(PV(2), F.lane, j);
            { unsigned char* V8 = (unsigned char*)V1 + (size_t)t * D;
#pragma unroll
              for (int j = 0; j < 8; ++j) *(GAS unsigned*)(V8 + 4 * F.lane + 256 * j) = pk4_fp8(y[j][0], y[j][1], y[j][2], y[j][3]); }
            float lg[8];
#pragma unroll
            for (int e = 0; e < 8; ++e) { float s = 0.f;
#pragma unroll
                for (int j = 0; j < 8; ++j) { const f32x4 w = ldp(RT + e * 2048, F.lane, j); s += (y[j][0] * w[0] + y[j][1] * w[1]) + (y[j][2] * w[2] + y[j][3] * w[3]); }
                lg[e] = wave_sum(s) + inp(I_ROUTERB)[e]; }
            if (F.lane == 0) { int e0 = 0; float v0 = lg[0];
#pragma unroll
                for (int e = 1; e < 8; ++e) if (lg[e] > v0) { v0 = lg[e]; e0 = e; }
                int e1 = -1; float v1 = -3.0e38f;
#pragma unroll
                for (int e = 0; e < 8; ++e) if (e != e0 && lg[e] > v1) { v1 = lg[e]; e1 = e; }
                const float g0 = 1.f / (1.f + __expf(v1 - v0));
                RE[2 * t] = e0; RE[2 * t + 1] = e1; RG[2 * t] = g0; RG[2 * t + 1] = 1.f - g0;
                __hip_atomic_fetch_add((int*)(HIST + e0), 1, __ATOMIC_RELAXED, __HIP_MEMORY_SCOPE_WORKGROUP); __hip_atomic_fetch_add((int*)(HIST + e1), 1, __ATOMIC_RELAXED, __HIP_MEMORY_SCOPE_WORKGROUP); }
        }
        __syncthreads();
        if (F.tid < 8) CNT[blk * 8 + F.tid] = HIST[F.tid];
        __syncthreads();
    }
}
__device__ __forceinline__ void ph_route(Frame& F) {
    unsigned char* ar = F.ws + WS_ARENA;
    LAS int* TOT = (LAS int*)(F.lds); LAS int* PRE = TOT + 8; LAS int* BASE = TOT + 16; LAS int* POS = TOT + 32;
    const int* CNT = (const int*)(ar + B_CNT); const int* RE = (const int*)(ar + B_RE); int* SLOT = (int*)(ar + B_SLOT); int* TILE = (int*)(ar + B_TILE);
    const bf16* V1 = (const bf16*)(ar + B_V1); unsigned char* VG = ar + B_VG;
    for (int blk = blockIdx.x; blk < SEQ / 64; blk += F.G) {
        __syncthreads();
        { const int e = F.wave; int tot = 0, pre = 0;
          for (int q = 0; q < 4; ++q) { const int b = 4 * F.lane + q; const int cv = CNT[b * 8 + e]; tot += cv; pre += (b < blk) ? cv : 0; }
#pragma unroll
          for (int o = 1; o < 64; o <<= 1) { tot += __shfl_xor(tot, o); pre += __shfl_xor(pre, o); }
          if (F.lane == 0) { TOT[e] = tot; PRE[e] = pre; } }
        __syncthreads();
        if (F.tid == 0) { int b = 0; for (int e = 0; e < 8; ++e) { BASE[e] = b; b += (TOT[e] + 255) / 256 * 256; } BASE[8] = b; }
        __syncthreads();
        if (F.wave == 0) { const int t = blk * 64 + F.lane; const int e0 = RE[2 * t], e1 = RE[2 * t + 1]; int p0 = 0, p1 = 0;
            const unsigned long long lt = (1ull << F.lane) - 1ull;
#pragma unroll
            for (int e = 0; e < 8; ++e) { const unsigned long long m0 = __ballot(e0 == e), m1 = __ballot(e1 == e); const int rk = __popcll(m0 & lt) + __popcll(m1 & lt);
                if (e0 == e) p0 = BASE[e] + PRE[e] + rk; if (e1 == e) p1 = BASE[e] + PRE[e] + rk; }
            SLOT[2 * t] = p0; SLOT[2 * t + 1] = p1; POS[2 * F.lane] = p0; POS[2 * F.lane + 1] = p1; }
        __syncthreads();
        for (int idx = F.tid; idx < 128 * 128; idx += NTHR) { const int ri = idx >> 7, seg = idx & 127;
            *(GAS v4u*)(VG + (size_t)POS[ri] * D + seg * 16) = *(const GAS v4u*)((const unsigned char*)V1 + (size_t)(blk * 64 + (ri >> 1)) * D + seg * 16); }
        if (blk < 8) { const int e = blk, r0 = BASE[e] + TOT[e], r1 = BASE[e + 1];
            for (int idx = F.tid; idx < (r1 - r0) * 128; idx += NTHR) *(GAS v4u*)(VG + (size_t)(r0 + (idx >> 7)) * D + (idx & 127) * 16) = (v4u){0u, 0u, 0u, 0u}; }
        if (blk == 0 && F.tid == 0) { int nt = 0; for (int e = 0; e < 8; ++e) { const int n = (BASE[e + 1] - BASE[e]) / 256; for (int q = 0; q < n; ++q) TILE[1 + nt++] = e; } TILE[0] = nt; }
    }
}
__device__ __forceinline__ void ph_norm4(Frame& F, float* out) {
    unsigned char* ar = F.ws + WS_ARENA;
    __syncthreads();
    for (int i = F.tid; i < 2048; i += NTHR) PV(0)[i] = modp(F, 1, 0, 5)[i] * inp(I_NORMS)[(4 + 3) * 2048 + i];
    __syncthreads();
    const bf16* FS = (const bf16*)(ar + B_FS); const bf16* HR = (const bf16*)(F.ws + WS_HRES) + (size_t)CTX * D; const int* SLOT = (const int*)(ar + B_SLOT); const float* RG = (const float*)(ar + B_RG);
    const int gw = F.vcu * NWAVES + F.wave, NGW = F.G * NWAVES;
    for (int t = gw; t < SEQ; t += NGW) { f32x4 a[8], b[8], h[8]; const int p0 = SLOT[2 * t], p1 = SLOT[2 * t + 1]; const float g0 = RG[2 * t], g1 = RG[2 * t + 1];
        const float* PART = (const float*)(ar + B_VG); constexpr size_t PSTR = (size_t)MOE_SPLIT_TILES * 256 * D;
        if (p0 < MOE_MAIN_TILES * 256) ld_row_bf16(FS + (size_t)p0 * D, F.lane, a);
        else { const float* pp = PART + (size_t)(p0 - MOE_MAIN_TILES * 256) * D; f32x4 q1[8], q2[8], q3[8]; ld_row_f32(pp, F.lane, a); ld_row_f32(pp + PSTR, F.lane, q1); ld_row_f32(pp + 2 * PSTR, F.lane, q2); ld_row_f32(pp + 3 * PSTR, F.lane, q3);
#pragma unroll
            for (int j = 0; j < 8; ++j) a[j] = (a[j] + q1[j]) + (q2[j] + q3[j]); }
        if (p1 < MOE_MAIN_TILES * 256) ld_row_bf16(FS + (size_t)p1 * D, F.lane, b);
        else { const float* pp = PART + (size_t)(p1 - MOE_MAIN_TILES * 256) * D; f32x4 q1[8], q2[8], q3[8]; ld_row_f32(pp, F.lane, b); ld_row_f32(pp + PSTR, F.lane, q1); ld_row_f32(pp + 2 * PSTR, F.lane, q2); ld_row_f32(pp + 3 * PSTR, F.lane, q3);
#pragma unroll
            for (int j = 0; j < 8; ++j) b[j] = (b[j] + q1[j]) + (q2[j] + q3[j]); }
        ld_row_bf16(HR + (size_t)t * D, F.lane, h);
#pragma unroll
        for (int j = 0; j < 8; ++j) a[j] = a[j] * g0 + b[j] * g1;
        const float rf = 1.f / sqrtf(row_sumsq(a) * (1.f / D) + EPS);
#pragma unroll
        for (int j = 0; j < 8; ++j) h[j] = h[j] + a[j] * rf * ldp(PV(0), F.lane, j);
        st_row_f32(out + (size_t)t * D, F.lane, h); }
}

struct EpiGateUp8 { static constexpr bool PERM = true; unsigned char* HID; int ldc; float is;
    __device__ __forceinline__ void operator()(AccRef acc, const Unit& u, int wr, int wc, int fr, int fq) const { EPI_ROWS(u); const int col0 = u.pn * 128 + wc * 32 + 8 * fq; const float c1 = -1.4426950408889634f * is, kk = is * is * MOE_HSC;
#pragma unroll
        for (int ai = 0; ai < 2; ++ai)
#pragma unroll
            for (int m = 0; m < 4; ++m) { const int row = row0 + ai * 128 + m * 16; float a[4], b[4];
#pragma unroll
                for (int q = 0; q < 4; ++q) { a[q] = __builtin_amdgcn_fmed3f(swiglu_fast(acc[ai][0][m][0][q], acc[ai][1][m][0][q], c1, kk), -448.f, 448.f);
                                              b[q] = __builtin_amdgcn_fmed3f(swiglu_fast(acc[ai][0][m][1][q], acc[ai][1][m][1][q], c1, kk), -448.f, 448.f); }
                v2u o; o.x = pk4_fp8(a[0], a[1], a[2], a[3]); o.y = pk4_fp8(b[0], b[1], b[2], b[3]);
                *(GAS v2u*)(HID + (size_t)row * ldc + col0) = o; } } };
struct EpiPlainSc { static constexpr bool PERM = true; bf16* O; int ldc; float sc;
    __device__ __forceinline__ void operator()(AccRef acc, const Unit& u, int wr, int wc, int fr, int fq) const { EPI_ROWS(u); const int col0 = u.pn * 256 + wc * 32 + 8 * fq;
#pragma unroll
        for (int ai = 0; ai < 2; ++ai)
#pragma unroll
            for (int m = 0; m < 4; ++m) { bf16* rp = O + (size_t)(row0 + ai * 128 + m * 16) * ldc + col0;
#pragma unroll
                for (int bj = 0; bj < 2; ++bj) *(GAS u32x4*)(rp + bj * 128) = pack8(acc[ai][bj][m][0] * sc, acc[ai][bj][m][1] * sc); } } };

struct EpiPart { static constexpr bool PERM = false; float* P; int pm0; float sc;
    __device__ __forceinline__ void operator()(AccRef acc, const Unit& u, int wr, int wc, int fr, int fq) const { const int row0 = (u.pm - pm0) * 256 + wr * 64 + fr, col0 = u.pn * 256 + wc * 32 + 4 * fq;
        float* base = P + (size_t)u.bz * ((size_t)MOE_SPLIT_TILES * 256 * D);
#pragma unroll
        for (int ai = 0; ai < 2; ++ai)
#pragma unroll
            for (int m = 0; m < 4; ++m) { float* rp = base + (size_t)(row0 + ai * 128 + m * 16) * D + col0;
#pragma unroll
                for (int bj = 0; bj < 2; ++bj)
#pragma unroll
                    for (int n = 0; n < 2; ++n) *(GAS f32x4*)(rp + bj * 128 + n * 16) = acc[ai][bj][m][n] * sc; } } };

enum { PH_PRO = 0, PH_N0, PH_WINE, PH_POOLD, PH_SCAN, PH_S5Y, PH_GLU, PH_WOUTE, PH_N1, PH_FFNU, PH_FFND, PH_N2,
       PH_WINO, PH_PREP, PH_GLA1, PH_GLA2, PH_GLA3, PH_ATT, PH_WOUTO, PH_N3, PH_ROUTE, PH_MOEU, PH_MOED, PH_N4, NPH };
constexpr int PH_EMIT = 100;
struct Args { const float* in[N_IN]; float* out; unsigned char* ws; int ph_lo, ph_hi, li, pad; };

__global__ void __launch_bounds__(NTHR, 2) mk_fwd(Args args) {
    extern __shared__ __attribute__((aligned(16))) unsigned char lds[];
    Frame F;
    F.lds = (LAS unsigned char*)lds; F.MISC = (volatile LAS unsigned*)(F.lds + MISC_OFF);
    F.tid = threadIdx.x; F.lane = F.tid & 63; F.wave = __builtin_amdgcn_readfirstlane(F.tid >> 6);
    F.G = gridDim.x; { const int bx = blockIdx.x; F.vcu = (F.G % 8 == 0) ? (bx % 8) * (F.G / 8) + bx / 8 : bx; }
    F.ws = karg_ws(); F.ctl = (gu32*)(F.ws + WS_CTL);
    for (int u = F.tid; u < (LDS_BYTES - LDSCTL_OFF) / 4; u += NTHR) ((LAS unsigned*)(F.lds + LDSCTL_OFF))[u] = 0u;
    __syncthreads();
    XcdBarrier bar = xcd_barrier_post((unsigned*)(F.ctl + CW_BAR) + (karg_i(2) & 7) * XCD_BAR_WORDS, F.MISC + 8);
    const int lo = karg_i(0), hi = karg_i(1);
#define IN(k) (lo <= (k) && (k) < hi)
#define SEAM(k) do { if (IN(k) && IN((k) + 1)) xcd_barrier(bar); } while (0)
    PG8_LAS unsigned char* ring = (PG8_LAS unsigned char*)(F.lds + RING_OFF);
    unsigned char* ar = F.ws + WS_ARENA;
    const int bid = (int)blockIdx.x;

    if (lo == PH_EMIT) { ph_emit(F, karg_out()); return; }

    if (IN(PH_PRO)) { p0_prologue(F); } SEAM(PH_PRO);
    if (IN(PH_N0)) { for (int it = bid; it < S5G * 8; it += F.G) { s5_small_tables(F, it >> 3); s5_stage_b(F, it >> 3, it & 7); } ph_norm0(F); } SEAM(PH_N0);
    if (IN(PH_WINE)) {
        pg8::Gemm g{(const bf16*)(ar + A_U), (const bf16*)(F.ws + WS_WINE), D, D, D};
        pg8::PlainSched S; S.o.init(T / 256, D / 256, 1, F.G, bid); S.astr = (size_t)256 * D * 2; S.bstr = (size_t)256 * D * 2; S.zA = 0; S.zB = 0;
        EpiWinE E{(bf16*)(ar + A_ZP), (bf16*)(ar + A_AS5)};
        pg8::gemm_phase(ring, g, S, E);
        conv_work(F, 0, fill_quota(S.o.nwg, F.G, bid, 6));
    } SEAM(PH_WINE);
    if (IN(PH_POOLD)) {
        ph_pooldiff(F);
        __syncthreads();
        pg8::Gemm g{(const bf16*)(ar + A_AS5), (const bf16*)(ar + A_M1T), S5K, 1024, 1024};
        pg8::PlainSched S; S.o.init(S5ROWS / 256, 1, S5G, F.G, bid); S.astr = (size_t)256 * S5K * 2; S.bstr = 0; S.zA = (size_t)S5ROWS * S5K * 2; S.zB = (size_t)256 * 1024 * 2;
        EpiSloc E{(float*)(ar + A_SLOC)};
        pg8::gemm_phase(ring, g, S, E);
        conv_work(F, 0, fill_quota(S.o.nwg, F.G, bid, 3));
    } SEAM(PH_POOLD);
    if (IN(PH_SCAN)) {
        ph_s5scan(F);
        __syncthreads();
        pg8::Gemm g{(const bf16*)(ar + A_DP), (const bf16*)(F.ws + WS_WPOOL), WPOOL, PG, PG};
        pg8::PlainSched S; S.o.init(T / 256, 2, 4, F.G, bid); S.astr = (size_t)256 * WPOOL * 2; S.bstr = (size_t)256 * PG * 2; S.zA = (size_t)PG * 2; S.zB = (size_t)512 * PG * 2;
        EpiPool E{(bf16*)(ar + A_YMIX), inp(I_EPOOLS)};
        pg8::gemm_phase(ring, g, S, E);
        conv_work(F, 0, fill_quota(S.o.nwg, F.G, bid, 1));
    } SEAM(PH_SCAN);
    if (IN(PH_S5Y)) {
        pg8::Gemm g{(const bf16*)(ar + A_AS5), (const bf16*)(ar + A_K3T), S5K, S5K, S5K};
        pg8::PlainSched S; S.o.init(S5ROWS / 256, 4, S5G, F.G, bid); S.astr = (size_t)256 * S5K * 2; S.bstr = (size_t)256 * S5K * 2; S.zA = (size_t)S5ROWS * S5K * 2; S.zB = (size_t)1024 * S5K * 2;
        EpiS5Y E{(const bf16*)(ar + A_AS5), inp(I_S5D), (bf16*)(ar + A_YG)};
        pg8::gemm_phase(ring, g, S, E);
    } SEAM(PH_S5Y);
    if (IN(PH_GLU)) {
        pg8::Gemm g{(const bf16*)(ar + A_YG), (const bf16*)(F.ws + WS_WGLU), WS5, WS5, WS5};
        pg8::PlainSched S; S.o.init(T / 256, 2, 1, F.G, bid); S.astr = (size_t)256 * WS5 * 2; S.bstr = (size_t)256 * WS5 * 2; S.zA = 0; S.zB = 0;
        EpiGlu E{(const bf16*)(ar + A_YG), (bf16*)(ar + A_YMIX)};
        pg8::gemm_phase(ring, g, S, E);
        conv_work(F, 0, fill_quota(S.o.nwg, F.G, bid, 2));
    } SEAM(PH_GLU);
    if (IN(PH_WOUTE)) {
        pg8::Gemm g{(const bf16*)(ar + A_YMIX), (const bf16*)(F.ws + WS_WOUTE), D, D, D};
        pg8::PlainSched S; S.o.init(T / 256, D / 256, 1, F.G, bid); S.astr = (size_t)256 * D * 2; S.bstr = (size_t)256 * D * 2; S.zA = 0; S.zB = 0;
        EpiPlain E{(bf16*)(ar + A_YO), D};
        pg8::gemm_phase(ring, g, S, E);
        conv_work(F, 0, fill_quota(S.o.nwg, F.G, bid, 6));
    } SEAM(PH_WOUTE);
    if (IN(PH_N1)) { ph_norm1(F); conv_work(F, CQ_F2, 0); } SEAM(PH_N1);
    if (IN(PH_FFNU)) {
#if FFN_FP8 == 1
        pg8::Gemm g{(const bf16*)(ar + A_V), (const bf16*)(F.ws + WS_WGU), D / 2, D / 2, D / 2};
        pg8::PlainSched S; S.o.init(T / 256, 14336 / 256, 1, F.G, bid); S.astr = (size_t)256 * D; S.bstr = (size_t)256 * D; S.zA = 0; S.zB = 0;
        EpiGateUp8 E{ar + A_HID, DFF, 1.f / MOE_WSC_GU};
        pg8::gemm_phase<EpiGateUp8, pg8::PlainSched, true>(ring, g, S, E);
#elif FFN_FP8 == 2 && FFNU_K1 < 2048
        constexpr int KEQ = FFNU_K1 + (2048 - FFNU_K1) / 2;
        static_assert(FFNU_K1 % 128 == 0 && (2048 - FFNU_K1) % 256 == 0 && KEQ % 128 == 0 && FFNU_K1 % 256 == 0, "mixed-precision split");
        pg8::Gemm g{(const bf16*)(ar + A_V), (const bf16*)(F.ws + WS_WGU), KEQ, KEQ, KEQ};
        pg8::PlainSched S; S.o.init(T / 256, 14336 / 256, 1, F.G, bid); S.astr = (size_t)256 * KEQ * 2; S.bstr = (size_t)256 * KEQ * 2; S.zA = 0; S.zB = 0;
        EpiGateUp8 E{ar + A_HID, DFF, 1.f};
        pg8::gemm_phase<EpiGateUp8, pg8::PlainSched, false, FFNU_K1 / 64>(ring, g, S, E);
#elif FFN_FP8 == 2
        pg8::Gemm g{(const bf16*)(ar + A_V), (const bf16*)(F.ws + WS_WGU), D, D, D};
        pg8::PlainSched S; S.o.init(T / 256, 14336 / 256, 1, F.G, bid); S.astr = (size_t)256 * D * 2; S.bstr = (size_t)256 * D * 2; S.zA = 0; S.zB = 0;
        EpiGateUp8 E{ar + A_HID, DFF, 1.f};
        pg8::gemm_phase(ring, g, S, E);
#else
        pg8::Gemm g{(const bf16*)(ar + A_V), (const bf16*)(F.ws + WS_WGU), D, D, D};
        pg8::PlainSched S; S.o.init(T / 256, 14336 / 256, 1, F.G, bid); S.astr = (size_t)256 * D * 2; S.bstr = (size_t)256 * D * 2; S.zA = 0; S.zB = 0;
        EpiGateUp E{(bf16*)(ar + A_HID), DFF};
        pg8::gemm_phase(ring, g, S, E);
#endif
        conv_work(F, CQ_F3, fill_quota((T / 256) * (14336 / 256), F.G, bid, 6));
    } SEAM(PH_FFNU);
    if (IN(PH_FFND)) {
#if FFN_FP8
        pg8::Gemm g{(const bf16*)(ar + A_HID), (const bf16*)(F.ws + WS_WDN), DFF / 2, DFF / 2, DFF / 2};
        pg8::PlainSched S; S.o.init(T / 256, D / 256, 1, F.G, bid); S.astr = (size_t)256 * DFF; S.bstr = (size_t)256 * DFF; S.zA = 0; S.zB = 0;
        EpiPlainSc E{(bf16*)(ar + A_F), D, 1.f / (MOE_WSC_DN * MOE_HSC)};
        pg8::gemm_phase<EpiPlainSc, pg8::PlainSched, true>(ring, g, S, E);
#else
        pg8::Gemm g{(const bf16*)(ar + A_HID), (const bf16*)(F.ws + WS_WDN), DFF, DFF, DFF};
        pg8::PlainSched S; S.o.init(T / 256, D / 256, 1, F.G, bid); S.astr = (size_t)256 * DFF * 2; S.bstr = (size_t)256 * DFF * 2; S.zA = 0; S.zB = 0;
        EpiPlain E{(bf16*)(ar + A_F), D};
        pg8::gemm_phase(ring, g, S, E);
#endif
        conv_work(F, CQ_O1, fill_quota((T / 256) * (D / 256), F.G, bid, 11));
    } SEAM(PH_FFND);
    if (IN(PH_N2)) { ph_norm2(F); conv_work(F, CQ_O1, 0); } SEAM(PH_N2);
    if (IN(PH_WINO)) {
        pg8::Gemm g{(const bf16*)(ar + A_U), (const bf16*)(F.ws + WS_WINO), D, D, D};
        pg8::PlainSched S; S.o.init(T / 256, WINO_N / 256, 1, F.G, bid); S.astr = (size_t)256 * D * 2; S.bstr = (size_t)256 * D * 2; S.zA = 0; S.zB = 0;
        EpiWinO E{ar};
        pg8::gemm_phase(ring, g, S, E);
        conv_work(F, CQ_O2, fill_quota(S.o.nwg, F.G, bid, 5));
    } SEAM(PH_WINO);
    if (IN(PH_PREP)) { ph_qknorm(F); ph_vt8(F); for (int u = bid; u < NCH * 4; u += F.G) gla_prepkv_unit(F, u >> 2, u & 3); conv_work(F, 0, fill_quota(NCH * 4, F.G, bid, 4)); } SEAM(PH_PREP);
    if (IN(PH_GLA2)) { ph_gla_scan(F); } SEAM(PH_GLA2);
    if (IN(PH_GLA3)) { for (int u = bid; u < (SEQ / 64) * 4; u += F.G) gla_out_unit(F, u >> 2, u & 3); __syncthreads(); }
    if (IN(PH_ATT)) {
        for (int L = bid; L < 8 * (SEQ / 256); L += F.G) { const int h = L >> 6, qb = L & 63;
            const bf16* Q = (const bf16*)(ar + B_AQ) + (size_t)(CTX + qb * 256) * 1024 + h * 128;
            const unsigned char* Kp = ar + B_KDT + (h >> 2) * 128; const bf16* Vp = (const bf16*)(ar + B_AV) + (h >> 2) * 128;
            bf16* O = (bf16*)(ar + B_YMIX1) + (size_t)(qb * 256) * D + 1024 + h * 128;
            att::attn_dense_body_d(Q, Kp, ar + B_KDT + VT8_OFF + (size_t)(h >> 2) * NCH * 8192, O, T, (LAS char*)F.lds); }
    } SEAM(PH_ATT);
    if (IN(PH_WOUTO)) {
        pg8::Gemm g{(const bf16*)(ar + B_YMIX1), (const bf16*)(F.ws + WS_WOUTO), D, D, D};
        pg8::PlainSched S; S.o.init(SEQ / 256, D / 256, 1, F.G, bid); S.astr = (size_t)256 * D * 2; S.bstr = (size_t)256 * D * 2; S.zA = 0; S.zB = 0;
        EpiPlain E{(bf16*)(ar + B_YO1), D};
        pg8::gemm_phase(ring, g, S, E);
    } SEAM(PH_WOUTO);
    if (IN(PH_N3)) { ph_norm3(F); } SEAM(PH_N3);
    if (IN(PH_ROUTE)) { ph_route(F); conv_work(F, CQ_M2, 0); } SEAM(PH_ROUTE);
    if (IN(PH_MOEU)) {
        const int* TILE = (const int*)(ar + B_TILE); const int nt = __builtin_amdgcn_readfirstlane(TILE[0]);
        pg8::Gemm g{(const bf16*)(ar + B_VG), (const bf16*)(F.ws + WS_WMGU), D / 2, D / 2, D / 2};
        pg8::MoeSched S; S.o.init(nt, 14336 / 256, 1, F.G, bid); S.astr = (size_t)256 * D; S.bstr = (size_t)256 * D; S.zB = (size_t)14336 * D; S.tile_e = TILE + 1;
        EpiGateUp8 E{ar + B_HID2, DFF, 1.f / MOE_WSC_GU};
        pg8::gemm_phase<EpiGateUp8, pg8::MoeSched, true>(ring, g, S, E);
        conv_work(F, CQ_M3, fill_quota(S.o.nwg, F.G, bid, 5));
    } SEAM(PH_MOEU);
    if (IN(PH_MOED)) {
        const int* TILE = (const int*)(ar + B_TILE); const int nt = __builtin_amdgcn_readfirstlane(TILE[0]);
        pg8::Gemm g{(const bf16*)(ar + B_HID2), (const bf16*)(F.ws + WS_WMDN), DFF / 2, DFF / 2, DFF / 2};
        const int nmain = nt < MOE_MAIN_TILES ? nt : MOE_MAIN_TILES;
        pg8::MoeSched S; S.o.init(nmain, D / 256, 1, F.G, bid); S.astr = (size_t)256 * DFF; S.bstr = (size_t)256 * DFF; S.zB = (size_t)D * DFF; S.tile_e = TILE + 1;
        EpiPlainSc E{(bf16*)(ar + B_FS), D, 1.f / (MOE_WSC_DN * MOE_HSC)};
        pg8::gemm_phase<EpiPlainSc, pg8::MoeSched, true>(ring, g, S, E);
        if (nt > MOE_MAIN_TILES) {
            pg8::Gemm g2{(const bf16*)(ar + B_HID2), (const bf16*)(F.ws + WS_WMDN), DFF / 2, DFF / 2, DFF / 8};
            pg8::MoeSplitSched S2; S2.pm0 = MOE_MAIN_TILES; S2.nun = (nt - MOE_MAIN_TILES) * 32; S2.G = F.G; S2.c = bid; S2.astr = (size_t)256 * DFF; S2.bstr = (size_t)256 * DFF; S2.zB = (size_t)D * DFF; S2.kslice = DFF / 4; S2.tile_e = TILE + 1;
            EpiPart E2{(float*)(ar + B_VG), MOE_MAIN_TILES, 1.f / (MOE_WSC_DN * MOE_HSC)};
            pg8::gemm_phase<EpiPart, pg8::MoeSplitSched, true>(ring, g2, S2, E2);
        }
    } SEAM(PH_MOED);
    if (IN(PH_N4)) { ph_norm4(F, karg_out()); }
#undef IN
#undef SEAM
}

extern "C" void kernel_launch(void* const* d_in, const int* in_sizes, int n_in, void* d_out, int out_size, void* d_ws, size_t ws_size, hipStream_t stream) {
    static int grid = 0;
    if (grid == 0) {
        if (n_in != N_IN || out_size != SEQ * D || ws_size < WS_NEED) { fprintf(stderr, "kernel_launch: shape/workspace mismatch (n_in %d out %d ws %zu need %zu)\n", n_in, out_size, ws_size, (size_t)WS_NEED); grid = -1; return; }
        int dev = 0, cus = 0, per_cu = 0;
        if (hipGetDevice(&dev) != hipSuccess || hipDeviceGetAttribute(&cus, hipDeviceAttributeMultiprocessorCount, dev) != hipSuccess) { grid = -1; return; }
        if (hipFuncSetAttribute((const void*)mk_fwd, hipFuncAttributeMaxDynamicSharedMemorySize, LDS_BYTES) != hipSuccess) { fprintf(stderr, "kernel_launch: hipFuncSetAttribute failed\n"); grid = -1; return; }
        if (hipOccupancyMaxActiveBlocksPerMultiprocessor(&per_cu, (const void*)mk_fwd, NTHR, LDS_BYTES) != hipSuccess || per_cu < 1) { fprintf(stderr, "kernel_launch: occupancy query says %d\n", per_cu); }
        (void)hipGetLastError();
        grid = cus;
    }
    if (grid < 0) return;
    (void)hipMemsetAsync((char*)d_ws + WS_CTL, 0, CTL_ZERO_BYTES, stream);
    Args a{};
    for (int i = 0; i < N_IN; ++i) a.in[i] = (const float*)d_in[i];
    a.out = (float*)d_out; a.ws = (unsigned char*)d_ws; a.pad = 0;
    const int last = (MK_STOP < NPH - 1) ? MK_STOP : NPH - 1;
#if MK_SPLIT
    for (int p = 0; p <= last; ++p) { a.ph_lo = p; a.ph_hi = p + 1; a.li = p; hipLaunchKernelGGL(mk_fwd, dim3(grid), dim3(NTHR), LDS_BYTES, stream, a); }
#else
    a.ph_lo = 0; a.ph_hi = last + 1; a.li = 0; hipLaunchKernelGGL(mk_fwd, dim3(grid), dim3(NTHR), LDS_BYTES, stream, a);
#endif
    if (last < NPH - 1) { a.ph_lo = PH_EMIT; a.ph_hi = PH_EMIT + 1; a.li = 7; hipLaunchKernelGGL(mk_fwd, dim3(grid), dim3(NTHR), LDS_BYTES, stream, a); }
    const hipError_t le = hipPeekAtLastError();
    if (le != hipSuccess) fprintf(stderr, "kernel_launch: launch failed: %s\n", hipGetErrorName(le));
}
```

```cpp
#include <hip/hip_runtime.h>
#include <cstdio>
#include <cstdint>

#ifndef PROBE_MASK
#define PROBE_MASK 0ull
#define PROBE_K 1
#endif
#ifndef MK_STOP
#define MK_STOP 99
#endif
#ifndef FFN_FP8
#define FFN_FP8 2
#endif
#ifndef FFNU_K1
#define FFNU_K1 1024
#endif
#ifndef MK_SPLIT
#define MK_SPLIT 0
#endif

namespace pg8 {
#define PG8_LAS __attribute__((address_space(3)))
typedef unsigned short bf16_t;
typedef short bf16x8 __attribute__((ext_vector_type(8)));
typedef float f32x4 __attribute__((ext_vector_type(4)));
typedef unsigned u32x4 __attribute__((ext_vector_type(4)));
typedef int v4i __attribute__((ext_vector_type(4)));
typedef int v8i __attribute__((ext_vector_type(8)));
constexpr int BM = 256, BK = 64, HALF = 128, HTB = HALF * BK * 2, STAGE_BYTES = 8 * HTB, NXCD = 8, WGM = 8;

__host__ __device__ __forceinline__ int lds_byte(int r, int c) { const int st = (r >> 4) * 2 + (c >> 5), rr = r & 15, cc = c & 31, ob = rr * 64 + cc * 2; return st * 1024 + (ob ^ (((ob >> 9) & 1) << 5)); }
__host__ __device__ __forceinline__ void stage_rc(int b, int& R, int& C) { const int st = b / 1024, sb = b % 1024, swz = sb ^ (((sb >> 9) & 1) << 5); R = (st >> 1) * 16 + swz / 64; C = (st & 1) * 32 + (swz % 64) / 2; }
__host__ __device__ __forceinline__ int perm32(int rho) { const int n = rho >> 4, i = rho & 15; return 8 * (i >> 2) + 4 * n + (i & 3); }

struct Unit { int pm, pn, bz; unsigned aoff, boff; };
struct Gemm { const bf16_t* A; const bf16_t* Bt; int lda, ldb, K; };

struct TileOrder {
    int nM, nN, nB, nwg, G, c;
    __device__ void init(int nM_, int nN_, int nB_, int G_, int c_) { nM = nM_; nN = nN_; nB = nB_; nwg = nM * nN * nB; G = G_; c = c_; }
    __device__ bool decode(int i, int& bz, int& pm, int& pn) const {
        const long L = (long)i * G + c; if (L >= nwg) return false;
        int wgid = (int)L; { const int q = nwg / NXCD, r = nwg % NXCD, xcd = wgid % NXCD, off = wgid / NXCD; wgid = (xcd < r ? xcd * (q + 1) : r * (q + 1) + (xcd - r) * q) + off; }
        const int per = nM * nN; bz = wgid / per; const int w = wgid - bz * per;
        const int nig = WGM * nN, gid = w / nig, fm = gid * WGM, gsz = (nM - fm) < WGM ? (nM - fm) : WGM;
        pm = fm + ((w % nig) % gsz); pn = (w % nig) / gsz; return true;
    }
};
struct PlainSched {
    TileOrder o; size_t astr, bstr, zA, zB;
    __device__ bool next(int i, Unit& u) const { if (!o.decode(i, u.bz, u.pm, u.pn)) return false; u.aoff = (unsigned)((size_t)u.bz * zA + (size_t)u.pm * astr); u.boff = (unsigned)((size_t)u.bz * zB + (size_t)u.pn * bstr); return true; }
};
struct MoeSched {
    TileOrder o; size_t astr, bstr, zB; const int* tile_e;
    __device__ bool next(int i, Unit& u) const { int bz; if (!o.decode(i, bz, u.pm, u.pn)) return false; u.bz = __builtin_amdgcn_readfirstlane(tile_e[u.pm]); u.aoff = (unsigned)((size_t)u.pm * astr); u.boff = (unsigned)((size_t)u.bz * zB + (size_t)u.pn * bstr); return true; }
};

struct MoeSplitSched {
    int pm0, nun, G, c; size_t astr, bstr, zB; unsigned kslice; const int* tile_e;
    __device__ bool next(int i, Unit& u) const { const long L = (long)i * G + c; if (L >= nun) return false; const int l = (int)L, ks = l & 3, pn = (l >> 2) & 7, pm = pm0 + (l >> 5);
        u.pm = pm; u.pn = pn; u.bz = ks; const int e = __builtin_amdgcn_readfirstlane(tile_e[pm]);
        u.aoff = (unsigned)((size_t)pm * astr + (size_t)ks * kslice); u.boff = (unsigned)((size_t)e * zB + (size_t)pn * bstr + (size_t)ks * kslice); return true; }
};
__device__ __forceinline__ unsigned cvt_pk_bf16(float lo, float hi) { unsigned r; asm volatile("v_cvt_pk_bf16_f32 %0, %1, %2" : "=v"(r) : "v"(lo), "v"(hi)); return r; }
__device__ __forceinline__ u32x4 pack8(const f32x4& a, const f32x4& b) { u32x4 w; w.x = cvt_pk_bf16(a[0], a[1]); w.y = cvt_pk_bf16(a[2], a[3]); w.z = cvt_pk_bf16(b[0], b[1]); w.w = cvt_pk_bf16(b[2], b[3]); return w; }

template <class Epi, class Sched, bool FP8 = false, int MIXT = -1>
__device__ __forceinline__ void gemm_phase(PG8_LAS unsigned char* lds, const Gemm g, const Sched& S, const Epi& E) {
    const int tid = threadIdx.x, wid = __builtin_amdgcn_readfirstlane(tid >> 6), lane = tid & 63, wr = wid >> 2, wc = wid & 3, fr = lane & 15, fq = lane >> 4;
    const int K = g.K, nt = K / BK;
    unsigned voffA[2], voffB[2];
#pragma unroll
    for (int i = 0; i < 2; ++i) { int R, C; stage_rc(tid * 16 + i * 8192, R, C); const int Rb = Epi::PERM ? ((R & ~31) + perm32(R & 31)) : R;
        voffA[i] = (unsigned)(R * g.lda + C) * 2u; voffB[i] = (unsigned)(Rb * g.ldb + C) * 2u; }
    const unsigned kstep = (unsigned)(BK * 2);
    const unsigned hstepA = (unsigned)HALF * (unsigned)g.lda * 2u, hstepB = (unsigned)HALF * (unsigned)g.ldb * 2u;
    const unsigned ldsw = (unsigned)wid * 1024u;
    const int aoff = lds_byte(wr * 64 + fr, fq * 8), boff = lds_byte(wc * 32 + fr, fq * 8);
    const char* const gA = (const char*)g.A; const char* const gB = (const char*)g.Bt;
#define PG8_SA(b, h) (((b) * 2 + (h)) * HTB)
#define PG8_SB(b, h) ((4 + (b) * 2 + (h)) * HTB)
#define PG8_STAGE(bufoff, gbase, soff, voff) do { _Pragma("unroll") for (int _i = 0; _i < 2; ++_i) \
        __builtin_amdgcn_global_load_lds((const unsigned*)((gbase) + (size_t)((soff) + (voff)[_i])), (PG8_LAS unsigned*)(lds + (bufoff) + ldsw + _i * 8192), 16, 0, 0); } while (0)
#define PG8_LDA(dst, b, h) do { _Pragma("unroll") for (int m = 0; m < 4; ++m) _Pragma("unroll") for (int k = 0; k < 2; ++k) dst[m][k] = *(const PG8_LAS bf16x8*)(lds + PG8_SA(b, h) + aoff + m * 2048 + k * 1024); } while (0)
#define PG8_LDB(dst, b, h) do { _Pragma("unroll") for (int n = 0; n < 2; ++n) _Pragma("unroll") for (int k = 0; k < 2; ++k) dst[n][k] = *(const PG8_LAS bf16x8*)(lds + PG8_SB(b, h) + boff + n * 2048 + k * 1024); } while (0)
#define PG8_CAT(x) __builtin_shufflevector(__builtin_bit_cast(v4i, (x)[0]), __builtin_bit_cast(v4i, (x)[1]), 0, 1, 2, 3, 4, 5, 6, 7)
#define PG8_MMA(ai, bj, At, Bt, IS8) do { __builtin_amdgcn_s_setprio(1); \
        if constexpr (MIXT >= 0) { if (IS8) { \
            _Pragma("unroll") for (int m = 0; m < 4; ++m) { const v8i a8 = PG8_CAT(At[m]); _Pragma("unroll") for (int n = 0; n < 2; ++n) { const v8i b8 = PG8_CAT(Bt[n]); \
                asm volatile("s_nop 1\n\tv_mfma_scale_f32_16x16x128_f8f6f4 %0, %1, %2, %0, %3, %4 op_sel_hi:[0,0,0]" : "+v"(acc[ai][bj][m][n]) : "v"(b8), "v"(a8), "v"(scw), "v"(sc1)); } } \
          } else { _Pragma("unroll") for (int m = 0; m < 4; ++m) _Pragma("unroll") for (int n = 0; n < 2; ++n) _Pragma("unroll") for (int k = 0; k < 2; ++k) \
            acc[ai][bj][m][n] = __builtin_amdgcn_mfma_f32_16x16x32_bf16(Bt[n][k], At[m][k], acc[ai][bj][m][n], 0, 0, 0); } \
        } else if constexpr (FP8) {   \
            _Pragma("unroll") for (int m = 0; m < 4; ++m) { const v8i a8 = PG8_CAT(At[m]); _Pragma("unroll") for (int n = 0; n < 2; ++n) { const v8i b8 = PG8_CAT(Bt[n]); \
                  \
                asm volatile("s_nop 1\n\tv_mfma_scale_f32_16x16x128_f8f6f4 %0, %1, %2, %0, %3, %3 op_sel_hi:[0,0,0]" : "+v"(acc[ai][bj][m][n]) : "v"(b8), "v"(a8), "v"(sc1)); } } \
        } else { _Pragma("unroll") for (int m = 0; m < 4; ++m) _Pragma("unroll") for (int n = 0; n < 2; ++n) _Pragma("unroll") for (int k = 0; k < 2; ++k) \
            acc[ai][bj][m][n] = __builtin_amdgcn_mfma_f32_16x16x32_bf16(Bt[n][k], At[m][k], acc[ai][bj][m][n], 0, 0, 0); } \
        __builtin_amdgcn_s_setprio(0); } while (0)
#define PG8_WAIT_V(n) asm volatile("s_waitcnt vmcnt(" #n ")" ::: "memory")
#define PG8_WAIT_L(n) asm volatile("s_waitcnt lgkmcnt(" #n ")" ::: "memory")
#define PG8_BAR __builtin_amdgcn_s_barrier()
#define PG8_SCHED __builtin_amdgcn_sched_barrier(0)
    Unit cur, nxt; int ui = 0;
    if (!S.next(0, cur)) return;
    const int sc1 = 0x7f7f7f7f, scw = 0x79797979;
    f32x4 acc[2][2][4][2];
#pragma unroll
    for (int a = 0; a < 2; ++a)
#pragma unroll
        for (int b = 0; b < 2; ++b)
#pragma unroll
            for (int m = 0; m < 4; ++m)
#pragma unroll
                for (int n = 0; n < 2; ++n) acc[a][b][m][n] = (f32x4){0.f, 0.f, 0.f, 0.f};
    bf16x8 At[4][2], B0[2][2], B1[2][2];
    unsigned cA = cur.aoff, cB = cur.boff;
    PG8_STAGE(PG8_SB(0, 0), gB, cB, voffB); PG8_STAGE(PG8_SB(0, 1), gB, cB + hstepB, voffB); PG8_STAGE(PG8_SA(0, 0), gA, cA, voffA); PG8_STAGE(PG8_SA(0, 1), gA, cA + hstepA, voffA);
    if (wr == 1) PG8_BAR;
    PG8_WAIT_V(2); PG8_BAR;
    PG8_STAGE(PG8_SB(1, 0), gB, cB + kstep, voffB); PG8_STAGE(PG8_SA(1, 0), gA, cA + kstep, voffA); PG8_STAGE(PG8_SB(1, 1), gB, cB + hstepB + kstep, voffB);
    PG8_WAIT_V(6); PG8_BAR;
    for (;;) {
        const bool has_next = S.next(ui + 1, nxt);
        const unsigned nA = has_next ? nxt.aoff : cA, nB = has_next ? nxt.boff : cB;
#define PG8_KBODY(IS8) do { \
            const bool last = (t == nt - 2); \
            const unsigned a1 = cA + (unsigned)(t + 1) * kstep; \
            const unsigned a2 = last ? nA : cA + (unsigned)(t + 2) * kstep, b2 = last ? nB : cB + (unsigned)(t + 2) * kstep; \
            const unsigned a3 = a2 + kstep, b3 = b2 + kstep; \
            PG8_LDB(B0, 0, 0); PG8_LDB(B1, 0, 1); PG8_SCHED; PG8_LDA(At, 0, 0); PG8_STAGE(PG8_SA(1, 1), gA, a1 + hstepA, voffA); \
            PG8_WAIT_V(8); PG8_WAIT_L(0); PG8_BAR; PG8_MMA(0, 0, At, B0, IS8); PG8_MMA(0, 1, At, B1, IS8); PG8_BAR; PG8_SCHED; \
            PG8_LDA(At, 0, 1); PG8_STAGE(PG8_SB(0, 0), gB, b2, voffB); PG8_STAGE(PG8_SB(0, 1), gB, b2 + hstepB, voffB); PG8_STAGE(PG8_SA(0, 0), gA, a2, voffA); \
            PG8_WAIT_V(8); PG8_WAIT_L(0); PG8_BAR; PG8_MMA(1, 0, At, B0, IS8); PG8_MMA(1, 1, At, B1, IS8); PG8_BAR; PG8_SCHED; \
            PG8_LDB(B0, 1, 0); PG8_LDB(B1, 1, 1); PG8_SCHED; PG8_LDA(At, 1, 0); PG8_STAGE(PG8_SA(0, 1), gA, a2 + hstepA, voffA); \
            PG8_WAIT_V(8); PG8_WAIT_L(0); PG8_BAR; PG8_MMA(0, 0, At, B0, IS8); PG8_MMA(0, 1, At, B1, IS8); PG8_BAR; PG8_SCHED; \
            PG8_LDA(At, 1, 1); PG8_STAGE(PG8_SB(1, 0), gB, b3, voffB); PG8_STAGE(PG8_SB(1, 1), gB, b3 + hstepB, voffB); PG8_STAGE(PG8_SA(1, 0), gA, a3, voffA); \
            PG8_WAIT_V(8); PG8_WAIT_L(0); PG8_BAR; PG8_MMA(1, 0, At, B0, IS8); PG8_MMA(1, 1, At, B1, IS8); PG8_BAR; PG8_SCHED; \
        } while (0)
        if constexpr (MIXT >= 0) {
#pragma unroll 1
            for (int t = 0; t < MIXT; t += 2) PG8_KBODY(false);
#pragma unroll 1
            for (int t = MIXT; t < nt; t += 2) PG8_KBODY(true);
        } else {
#pragma unroll 1
            for (int t = 0; t < nt; t += 2) PG8_KBODY(false);
        }
#undef PG8_KBODY
        if constexpr (FP8 || MIXT >= 0) {
            asm volatile("s_nop 15" : "+v"(acc[0][0][0][0]), "+v"(acc[0][0][0][1]), "+v"(acc[0][0][1][0]), "+v"(acc[0][0][1][1]), "+v"(acc[0][0][2][0]), "+v"(acc[0][0][2][1]), "+v"(acc[0][0][3][0]), "+v"(acc[0][0][3][1]),
                                      "+v"(acc[0][1][0][0]), "+v"(acc[0][1][0][1]), "+v"(acc[0][1][1][0]), "+v"(acc[0][1][1][1]), "+v"(acc[0][1][2][0]), "+v"(acc[0][1][2][1]), "+v"(acc[0][1][3][0]), "+v"(acc[0][1][3][1]));
            asm volatile("" : "+v"(acc[1][0][0][0]), "+v"(acc[1][0][0][1]), "+v"(acc[1][0][1][0]), "+v"(acc[1][0][1][1]), "+v"(acc[1][0][2][0]), "+v"(acc[1][0][2][1]), "+v"(acc[1][0][3][0]), "+v"(acc[1][0][3][1]),
                              "+v"(acc[1][1][0][0]), "+v"(acc[1][1][0][1]), "+v"(acc[1][1][1][0]), "+v"(acc[1][1][1][1]), "+v"(acc[1][1][2][0]), "+v"(acc[1][1][2][1]), "+v"(acc[1][1][3][0]), "+v"(acc[1][1][3][1]));
        }
        if (wr == 0) PG8_BAR;
        E(acc, cur, wr, wc, fr, fq);
        if (!has_next) break;
#pragma unroll
        for (int a = 0; a < 2; ++a)
#pragma unroll
            for (int b = 0; b < 2; ++b)
#pragma unroll
                for (int m = 0; m < 4; ++m)
#pragma unroll
                    for (int n = 0; n < 2; ++n) acc[a][b][m][n] = (f32x4){0.f, 0.f, 0.f, 0.f};
        cur = nxt; cA = nA; cB = nB; ++ui;
        if (wr == 1) PG8_BAR;
    }
    PG8_WAIT_V(0);
    PG8_BAR;
#undef PG8_SA
#undef PG8_SB
#undef PG8_STAGE
#undef PG8_LDA
#undef PG8_LDB
#undef PG8_MMA
#undef PG8_CAT
#undef PG8_WAIT_V
#undef PG8_WAIT_L
#undef PG8_BAR
#undef PG8_SCHED
}
}

constexpr int D = 2048, SEQ = 16384, CTX = 256, T = SEQ + CTX, DFF = 7168, NEXP = 8;
constexpr int NWAVES = 8, NTHR = 512;
constexpr int WPOOL = 1536, WS5 = 512, PG = 384, S5G = 32, S5P = 64, S5N = 16, LC = 64, NCH = T / LC  , NCH_CTX = CTX / LC  ;
constexpr int S5ROWS = 512, S5K = 1280;
constexpr int WINO_N = 4864;
constexpr float EPS = 1e-6f;
constexpr float MOE_WSC_GU = 64.f, MOE_WSC_DN = 128.f, MOE_HSC = 4.f;

enum { I_X = 0, I_C, I_CTX, I_CCTX, I_WMOD, I_BMOD, I_NORMS, I_EWIN, I_EPOOLW, I_EPOOLS, I_LAMRE, I_LAMIM, I_LOGDT, I_BRE, I_BIM, I_CRE, I_CIM, I_S5D, I_WGLU, I_EWOUT,
       I_FFG, I_FFU, I_FFD, I_OWIN, I_GLAWA, I_GLABA, I_GLANORM, I_QNORM, I_KNORM, I_OWOUT, I_ROUTER, I_ROUTERB, I_MOEG, I_MOEU, I_MOED, N_IN };

constexpr size_t MiB = 1u << 20;
constexpr size_t al256(size_t x) { return (x + 255) / 256 * 256; }
constexpr size_t WS_CTL = 0, CTL_ZERO_BYTES = 128 * 1024;
constexpr size_t WS_MODF = 1 * MiB;
constexpr size_t WS_ROPE = WS_MODF + al256(2 * 2 * 6 * 2048 * 4);
constexpr size_t WS_W0 = 2 * MiB;
constexpr size_t SZ_WINE = (size_t)2048 * 2048 * 2, SZ_WPOOL = (size_t)4 * 512 * 384 * 2, SZ_WGLU = (size_t)512 * 512 * 2, SZ_WGU = (size_t)14336 * 2048 * 2,
                 SZ_WDN = (size_t)2048 * 7168 * 2, SZ_WINO = (size_t)WINO_N * 2048 * 2;
constexpr size_t WS_WINE = WS_W0, WS_WPOOL = WS_WINE + SZ_WINE, WS_WGLU = WS_WPOOL + SZ_WPOOL, WS_WOUTE = WS_WGLU + SZ_WGLU, WS_WGU = WS_WOUTE + SZ_WINE,
                 WS_WDN = WS_WGU + SZ_WGU, WS_WINO = WS_WDN + SZ_WDN, WS_WOUTO = WS_WINO + SZ_WINO, WS_WMGU = WS_WOUTO + SZ_WINE, WS_WMDN = WS_WMGU + 8 * SZ_WGU,
                 WS_HRES = WS_WMDN + 8 * SZ_WDN;
constexpr size_t SZ_HRES = (size_t)T * D * 4;
constexpr size_t WS_ARENA = WS_HRES + SZ_HRES;
constexpr size_t SZ_ROWB = (size_t)T * D * 2;
constexpr size_t A_U = 0, A_ZP = A_U + SZ_ROWB, SZ_ZP = (size_t)T * WPOOL * 2, A_DP = A_ZP + SZ_ZP, A_AS5 = A_DP + SZ_ZP, SZ_AS5 = (size_t)S5G * S5ROWS * S5K * 2,
                 A_SLOC = A_AS5 + SZ_AS5, SZ_SLOC = (size_t)S5G * S5ROWS * 256 * 4, A_YG = A_SLOC + SZ_SLOC, SZ_YG = (size_t)T * WS5 * 2, A_YMIX = A_YG + SZ_YG,
                 A_YO = A_YMIX + SZ_ROWB, A_V = A_YO + SZ_ROWB, A_HID = A_V + SZ_ROWB, SZ_HID = (size_t)T * DFF * 2, A_F = A_HID + SZ_HID,
                 A_M1T = A_F + SZ_ROWB, SZ_M1T = (size_t)S5G * 256 * 1024 * 2, A_K3T = A_M1T + SZ_M1T, SZ_K3T = (size_t)S5G * 1024 * S5K * 2,
                 A_TBG = A_K3T + SZ_K3T, SZ_TBG = (size_t)S5G * 2 * 64 * 256 * 4, A_L0_END = A_TBG + SZ_TBG;
constexpr size_t WS_END_L0 = WS_ARENA + A_L0_END;
constexpr int MOE_ROWS = 2 * SEQ + NEXP * 256;
constexpr int MOE_MAIN_TILES = 128, MOE_SPLIT_TILES = MOE_ROWS / 256 - 128;
static_assert((size_t)4 * MOE_SPLIT_TILES * 256 * D * 4 <= (size_t)MOE_ROWS * D * 2, "split-K partials fit in the (dead) VG region");
constexpr size_t SZ_T512 = (size_t)T * 512 * 2, SZ_T1024 = (size_t)T * 1024 * 2, SZ_T256 = (size_t)T * 256 * 2, SZ_SEQB = (size_t)SEQ * D * 2;
constexpr size_t B_GQ = A_U + SZ_ROWB, B_GK = B_GQ + SZ_T512, B_GV = B_GK + SZ_T512, B_R = B_GV + SZ_T1024, B_AQ = B_R + SZ_T1024, B_AK = B_AQ + SZ_T1024, B_AV = B_AK + SZ_T256,
                 B_ALR = B_AV + SZ_T256, B_QE = B_ALR + al256((size_t)T * 16 * 4), B_KE = B_QE + 2 * SZ_T512, B_KDT = B_KE + 2 * SZ_T512, B_VT = B_KDT + 2 * SZ_T512,
                 B_DEC = B_VT + SZ_T1024, B_ST = B_DEC + al256((size_t)2 * NCH * 4 * 128 * 4), SZ_ST = (size_t)2 * NCH * 4 * 256 * 128 * 2, B_YMIX1 = B_ST + SZ_ST,
                 B_YO1 = B_YMIX1 + SZ_SEQB, B_REGA_END = B_YO1 + SZ_SEQB;
constexpr size_t B_HID2 = 0, SZ_HID2 = (size_t)MOE_ROWS * DFF * 2, B_FS = B_HID2 + SZ_HID2, SZ_FS = (size_t)MOE_ROWS * D * 2, B_OVL_END = B_FS + SZ_FS;
constexpr size_t B_REGB = al256(B_REGA_END > B_OVL_END ? B_REGA_END : B_OVL_END);
constexpr size_t B_V1 = B_REGB, B_VG = B_V1 + SZ_SEQB, B_RE = B_VG + SZ_FS, B_RG = B_RE + (size_t)SEQ * 8, B_SLOT = B_RG + (size_t)SEQ * 8, B_CNT = B_SLOT + (size_t)SEQ * 8,
                 B_TILE = B_CNT + 256 * 8 * 4, B_L1_END = B_TILE + 4096;
constexpr size_t WS_END_L1 = WS_ARENA + B_L1_END;
constexpr size_t WS_NEED = WS_END_L0 > WS_END_L1 ? WS_END_L0 : WS_END_L1;
static_assert(WS_NEED <= (size_t)1879048192, "workspace map exceeds the guaranteed size");

constexpr int CW_TMO = 0, CW_CODE = 1, CW_BAR = 4096;

#define GAS __attribute__((address_space(1)))
#define LAS __attribute__((address_space(3)))
typedef unsigned short bf16;
typedef unsigned v4u __attribute__((ext_vector_type(4)));
typedef unsigned v2u __attribute__((ext_vector_type(2)));
typedef float f32x4 __attribute__((ext_vector_type(4)));
typedef float f32x2 __attribute__((ext_vector_type(2)));
typedef short bf16x8 __attribute__((ext_vector_type(8)));
typedef GAS unsigned gu32;
#define RLX_AGENT __ATOMIC_RELAXED, __HIP_MEMORY_SCOPE_AGENT
#define LDS_WAIT() asm volatile("s_waitcnt lgkmcnt(0)" ::: "memory")
#define VM_WAIT() asm volatile("s_waitcnt vmcnt(0)" ::: "memory")
__device__ __forceinline__ unsigned f2bf(float f) { unsigned u = __builtin_bit_cast(unsigned, f); return (u + 0x7fffu + ((u >> 16) & 1u)) >> 16; }
typedef __bf16 bf16x2_t __attribute__((ext_vector_type(2)));
__device__ __forceinline__ unsigned pk2(float lo, float hi) { const f32x2 v = {lo, hi}; return __builtin_bit_cast(unsigned, __builtin_convertvector(v, bf16x2_t)); }
__device__ __forceinline__ float bflo(unsigned w) { return __builtin_bit_cast(float, w << 16); }
__device__ __forceinline__ float bfhi(unsigned w) { return __builtin_bit_cast(float, w & 0xffff0000u); }
__device__ __forceinline__ float bf2f(bf16 b) { return __builtin_bit_cast(float, (unsigned)b << 16); }
__device__ __forceinline__ float sigmoidf_(float x) { return __builtin_amdgcn_rcpf(1.f + __expf(-x)); }
__device__ __forceinline__ float siluf_(float x) { return x * __builtin_amdgcn_rcpf(1.f + __expf(-x)); }
__device__ __forceinline__ float swiglu_fast(float ag, float au, float negsg_log2e, float kk) { const float e = __builtin_amdgcn_exp2f(ag * negsg_log2e); return (ag * au) * (kk * __builtin_amdgcn_rcpf(1.f + e)); }
__device__ __forceinline__ float gelu_tanh(float y) { const float z = 0.7978845608028654f * (y + 0.044715f * y * y * y); const float e = __expf(2.f * z); const float th = 1.f - 2.f * __builtin_amdgcn_rcpf(e + 1.f); return 0.5f * y * (1.f + th); }

#define XB_TMO      128
#define XB_XCNT(j)  (256  + 64 * (j))
#define XB_XSUB(j)  (1280 + 64 * (j))
#define XB_XGEN(j)  (2304 + 64 * (j))
#define XB_TOP      3328
#define XB_TOPGEN   3392
#define XCD_BAR_WORDS 3456
#define XB_SPIN_CAP (1u << 22)
__device__ __forceinline__ unsigned xb_ld(unsigned* p)              { return __hip_atomic_load(p, __ATOMIC_RELAXED, __HIP_MEMORY_SCOPE_AGENT); }
__device__ __forceinline__ unsigned xb_add(unsigned* p, unsigned v) { return __hip_atomic_fetch_add(p, v, __ATOMIC_RELAXED, __HIP_MEMORY_SCOPE_AGENT); }
__device__ __forceinline__ unsigned xb_xcc_id() { return (unsigned)__builtin_amdgcn_s_getreg((3 << 11) | 20) & 0xFu; }
#define XB_SPIN(cond, bar) do { unsigned _sp = 0; while (cond) { __builtin_amdgcn_s_sleep(1); \
    if ((++_sp & 255u) == 0u) { if (xb_ld(&(bar)[XB_TMO])) break; if (_sp > XB_SPIN_CAP) { atomicAdd(&(bar)[XB_TMO], 1u); break; } } } } while (0)
struct XcdBarrier { unsigned* bar; unsigned x; volatile LAS unsigned* st; };
__device__ __forceinline__ XcdBarrier xcd_barrier_post(unsigned* bar, volatile LAS unsigned* st) {
    XcdBarrier b; b.bar = bar; b.x = xb_xcc_id(); b.st = st;
    if (threadIdx.x == 0) (void)xb_add(&bar[XB_XCNT(b.x)], 1u);
    return b;
}
__device__ __forceinline__ void xcd_barrier_complete(unsigned* bar, unsigned x, unsigned& nloc, unsigned& nx) {
    const unsigned G = gridDim.x * gridDim.y * gridDim.z;
    unsigned sum, cnt, mine, sp = 0u;
    for (;;) {
        sum = 0u; cnt = 0u; mine = 0u;
#pragma unroll
        for (unsigned j = 0; j < 16; ++j) { const unsigned c = xb_ld(&bar[XB_XCNT(j)]); sum += c; cnt += (c > 0u) ? 1u : 0u; mine = (j == x) ? c : mine; }
        if (sum == G) break;
        __builtin_amdgcn_s_sleep(1);
        if ((++sp & 255u) == 0u) { if (xb_ld(&bar[XB_TMO])) break; if (sp > XB_SPIN_CAP) { atomicAdd(&bar[XB_TMO], 1u); break; } }
    }
    nloc = mine > 0u ? mine : 1u; nx = cnt > 0u ? cnt : 1u;
}
__device__ __forceinline__ void xcd_barrier(const XcdBarrier& b) {
    asm volatile("s_waitcnt vmcnt(0)" ::: "memory");
    __syncthreads();
    if (threadIdx.x == 0) {
        unsigned* bar = b.bar;
        __builtin_amdgcn_s_waitcnt(0);
        unsigned nloc = b.st[0], nx = b.st[1];
        if (nloc == 0u) { xcd_barrier_complete(bar, b.x, nloc, nx); b.st[0] = nloc; b.st[1] = nx; }
        const unsigned old = xb_add(&bar[XB_XSUB(b.x)], 1u);
        const unsigned gen = old / nloc;
        if (old + 1u == (gen + 1u) * nloc) {
            __builtin_amdgcn_fence(__ATOMIC_RELEASE, "agent");
            asm volatile("s_waitcnt vmcnt(0)" ::: "memory");
            const unsigned og = xb_add(&bar[XB_TOP], 1u);
            const unsigned tg = og / nx;
            if (og + 1u == (tg + 1u) * nx) xb_add(&bar[XB_TOPGEN], 1u);
            else XB_SPIN(xb_ld(&bar[XB_TOPGEN]) == tg, bar);
            __builtin_amdgcn_fence(__ATOMIC_ACQUIRE, "agent");
            xb_add(&bar[XB_XGEN(b.x)], 1u);
            asm volatile("s_waitcnt vmcnt(0)" ::: "memory");
        } else {
            XB_SPIN(xb_ld(&bar[XB_XGEN(b.x)]) == gen, bar);
            __builtin_amdgcn_fence(__ATOMIC_ACQUIRE, "agent");
            asm volatile("s_waitcnt vmcnt(0)" ::: "memory");
        }
    }
    __syncthreads();
}

constexpr int RING_OFF = 0, RING_BYTES = 131072;
constexpr int LDSCTL_OFF = RING_BYTES, MISC_OFF = LDSCTL_OFF + 320;
constexpr int LDS_BYTES = 147456;

#define CAS __attribute__((address_space(4)))
__device__ __forceinline__ const float* inp(int k) { const CAS char* ka = (const CAS char*)__builtin_amdgcn_kernarg_segment_ptr(); return *(const float* const CAS*)(ka + 8 * k); }
__device__ __forceinline__ float* karg_out() { const CAS char* ka = (const CAS char*)__builtin_amdgcn_kernarg_segment_ptr(); return *(float* const CAS*)(ka + 8 * 35); }
__device__ __forceinline__ unsigned char* karg_ws() { const CAS char* ka = (const CAS char*)__builtin_amdgcn_kernarg_segment_ptr(); return *(unsigned char* const CAS*)(ka + 8 * 36); }
__device__ __forceinline__ int karg_i(int k) { const CAS char* ka = (const CAS char*)__builtin_amdgcn_kernarg_segment_ptr(); return *(const CAS int*)(ka + 8 * 37 + 4 * k); }
struct Frame {
    LAS unsigned char* lds;
    volatile LAS unsigned* MISC;
    gu32* ctl;
    int tid, lane, wave, vcu, G;
    unsigned char* ws;
};
__device__ __forceinline__ float wave_sum(float v) {
#pragma unroll
    for (int o = 1; o < 64; o <<= 1) v += __shfl_xor(v, o);
    return v;
}

struct RmIdent { int off; __device__ __forceinline__ int operator()(int n) const { return n + off; } };
struct RmGateUp { int which; __device__ __forceinline__ int operator()(int n) const { return (n >> 7) * 256 + which * 128 + (n & 127); } };
struct RmWinO { __device__ __forceinline__ int operator()(int n) const {
    if (n < 2048) return n; if (n < 2064) return 4608 + (n - 2048); return n - 16; } };
template <class RM> __device__ __forceinline__ void tr_item(const float* W, int K, int N, bf16* WT, int ldt, const RM rm, LAS float* scr, int item, int lane) {
    const int nblk = (N + 31) / 32, kb = item / nblk, nb = item - kb * nblk, k0 = 64 * kb, n0 = 32 * nb;
    const int c4 = (lane & 7) * 4, r8 = lane >> 3; const bool okc = (n0 + c4) < N;
    f32x4 v[8];
#pragma unroll
    for (int i = 0; i < 8; ++i) v[i] = okc ? *(const GAS f32x4*)(W + (size_t)(k0 + 8 * i + r8) * N + n0 + c4) : (f32x4){0.f, 0.f, 0.f, 0.f};
#pragma unroll
    for (int i = 0; i < 8; ++i) { LAS float* s = scr + (8 * i + r8) * 33 + c4; s[0] = v[i][0]; s[1] = v[i][1]; s[2] = v[i][2]; s[3] = v[i][3]; }
    LDS_WAIT(); asm volatile("" ::: "memory");
    const int c = lane & 7;
#pragma unroll
    for (int j = 0; j < 4; ++j) { const int n = (lane >> 3) + 8 * j; const LAS float* s = scr + (8 * c) * 33 + n;
        v4u o; o.x = pk2(s[0 * 33], s[1 * 33]); o.y = pk2(s[2 * 33], s[3 * 33]); o.z = pk2(s[4 * 33], s[5 * 33]); o.w = pk2(s[6 * 33], s[7 * 33]);
        if (n0 + n < N) *(GAS v4u*)(WT + (size_t)rm(n0 + n) * ldt + k0 + 8 * c) = o; }
    LDS_WAIT(); asm volatile("" ::: "memory");
}
__device__ __forceinline__ void zero_rows(bf16* p, size_t nbytes, int gt, int ngt) {
    for (size_t i = (size_t)gt; i < nbytes / 16; i += (size_t)ngt) ((GAS v4u*)p)[i] = (v4u){0u, 0u, 0u, 0u};
}
__device__ __forceinline__ unsigned pk4_fp8(float a, float b, float c, float d) { int w = 0; w = __builtin_amdgcn_cvt_pk_fp8_f32(a, b, w, false); w = __builtin_amdgcn_cvt_pk_fp8_f32(c, d, w, true); return (unsigned)w; }
template <class RM> __device__ __forceinline__ void tr_item8(const float* W, int K, int N, unsigned char* WT, int ldt, const RM rm, float sc, LAS float* scr, int item, int lane) {
    const int nblk = (N + 31) / 32, kb = item / nblk, nb = item - kb * nblk, k0 = 64 * kb, n0 = 32 * nb;
    const int c4 = (lane & 7) * 4, r8 = lane >> 3; const bool okc = (n0 + c4) < N;
    f32x4 v[8];
#pragma unroll
    for (int i = 0; i < 8; ++i) v[i] = okc ? *(const GAS f32x4*)(W + (size_t)(k0 + 8 * i + r8) * N + n0 + c4) : (f32x4){0.f, 0.f, 0.f, 0.f};
#pragma unroll
    for (int i = 0; i < 8; ++i) { LAS float* s = scr + (8 * i + r8) * 33 + c4; s[0] = v[i][0]; s[1] = v[i][1]; s[2] = v[i][2]; s[3] = v[i][3]; }
    LDS_WAIT(); asm volatile("" ::: "memory");
    const int c = lane & 7;
#pragma unroll
    for (int j = 0; j < 4; ++j) { const int n = (lane >> 3) + 8 * j; const LAS float* s = scr + (8 * c) * 33 + n;
        v2u o; o.x = pk4_fp8(s[0 * 33] * sc, s[1 * 33] * sc, s[2 * 33] * sc, s[3 * 33] * sc); o.y = pk4_fp8(s[4 * 33] * sc, s[5 * 33] * sc, s[6 * 33] * sc, s[7 * 33] * sc);
        if (n0 + n < N) *(GAS v2u*)(WT + (size_t)rm(n0 + n) * ldt + k0 + 8 * c) = o; }
    LDS_WAIT(); asm volatile("" ::: "memory");
}
constexpr int items_of(int K, int N) { return (K / 64) * ((N + 31) / 32); }

__device__ __forceinline__ void s5_small_tables(Frame& F, int g) {
    const float* lam_re = inp(I_LAMRE); const float* lam_im = inp(I_LAMIM); const float* log_dt = inp(I_LOGDT);
    const float* b_re = inp(I_BRE); const float* b_im = inp(I_BIM); const float* c_re = inp(I_CRE); const float* c_im = inp(I_CIM);
    LAS f32x2* APOW = (LAS f32x2*)(F.lds); LAS f32x2* BB = (LAS f32x2*)(F.lds + 2 * 64 * 65 * 8); LAS f32x2* CC = BB + 2 * 64 * 16;
    const int tid = F.tid;
    __syncthreads();
    if (tid < 128) {
        const int dir = tid >> 6, p = tid & 63; const int gi = (dir * S5G + g);
        const double dt = exp((double)log_dt[gi]); const double lr = (double)lam_re[gi * 64 + p], li = (double)lam_im[gi * 64 + p];
        const double mag = exp(lr * dt), ar = mag * cos(li * dt), ai = mag * sin(li * dt);
        double pr = 1.0, pi = 0.0;
        for (int k = 0; k <= 64; ++k) { APOW[(dir * 64 + p) * 65 + k] = (f32x2){(float)pr, (float)pi}; const double nr = pr * ar - pi * ai, ni = pr * ai + pi * ar; pr = nr; pi = ni; }
        const double den = lr * lr + li * li, nr = ar - 1.0, ni = ai;
        const double kr = (nr * lr + ni * li) / den, ki = (ni * lr - nr * li) / den;
        for (int n = 0; n < 16; ++n) { const double br = (double)b_re[(gi * 64 + p) * 16 + n], bi = (double)b_im[(gi * 64 + p) * 16 + n];
            BB[(dir * 64 + p) * 16 + n] = (f32x2){(float)(kr * br - ki * bi), (float)(kr * bi + ki * br)}; }
    }
    for (int i = tid; i < 2 * 16 * 64; i += NTHR) { const int dir = i >> 10, r = i & 1023; CC[i] = (f32x2){c_re[(size_t)(dir * S5G + g) * 1024 + r], c_im[(size_t)(dir * S5G + g) * 1024 + r]}; }
    __syncthreads();
}
__device__ __forceinline__ void s5_stage_a(Frame& F, int g, int part) {
    LAS f32x2* APOW = (LAS f32x2*)(F.lds); LAS f32x2* BB = (LAS f32x2*)(F.lds + 2 * 64 * 65 * 8); LAS f32x2* CC = BB + 2 * 64 * 16;
    float* TBG = (float*)(F.ws + WS_ARENA + A_TBG) + (size_t)g * (2 * 64 * 256);
    bf16* M1T = (bf16*)(F.ws + WS_ARENA + A_M1T) + (size_t)g * 256 * 1024;
    const int tid = F.tid;
    {
        const int n = tid & 15, np = (tid >> 4) & 15, dl0 = 8 * part + ((tid >> 8) & 1);
#pragma unroll
        for (int dir = 0; dir < 2; ++dir) { float s[4] = {0.f, 0.f, 0.f, 0.f};
            for (int p = 0; p < 64; ++p) { const f32x2 c = CC[(dir * 16 + np) * 64 + p], b = BB[(dir * 64 + p) * 16 + n];
                const float wr = c.x * b.x - c.y * b.y, wi = c.x * b.y + c.y * b.x;
#pragma unroll
                for (int j = 0; j < 4; ++j) { const f32x2 a = APOW[(dir * 64 + p) * 65 + dl0 + 2 * j]; s[j] += wr * a.x - wi * a.y; } }
#pragma unroll
            for (int j = 0; j < 4; ++j) TBG[((dir * 64 + dl0 + 2 * j) * 16 + np) * 16 + n] = s[j]; }
    }
    for (int i = tid; i < 32 * 128; i += NTHR) {
        const int j = 32 * part + (i >> 7), c8 = (i & 127) * 8, sI = c8 >> 4, n0 = c8 & 15, dir = j >> 7, pt = (j >> 6) & 1, p = j & 63, e = dir ? sI : 63 - sI;
        const f32x2 a = APOW[(dir * 64 + p) * 65 + e]; float v[8];
#pragma unroll
        for (int q = 0; q < 8; ++q) { const f32x2 b = BB[(dir * 64 + p) * 16 + n0 + q]; v[q] = pt ? (a.x * b.y + a.y * b.x) : (a.x * b.x - a.y * b.y); }
        v4u o; o.x = pk2(v[0], v[1]); o.y = pk2(v[2], v[3]); o.z = pk2(v[4], v[5]); o.w = pk2(v[6], v[7]);
        *(GAS v4u*)(M1T + (size_t)j * 1024 + c8) = o;
    }
}
__device__ __forceinline__ void s5_stage_b(Frame& F, int g, int part) {
    LAS f32x2* APOW = (LAS f32x2*)(F.lds); LAS f32x2* CC = (LAS f32x2*)(F.lds + 2 * 64 * 65 * 8) + 2 * 64 * 16;
    const float* TBG = (const float*)(F.ws + WS_ARENA + A_TBG) + (size_t)g * (2 * 64 * 256);
    bf16* K3T = (bf16*)(F.ws + WS_ARENA + A_K3T) + (size_t)g * 1024 * S5K;
#pragma unroll 4
    for (int i = F.tid; i < 128 * (S5K / 8); i += NTHR) {
        const int row = 128 * part + i / (S5K / 8), c8 = (i % (S5K / 8)) * 8, tau = row >> 4, np = row & 15; float v[8];
        if (c8 < 1024) { const int sI = c8 >> 4, n0 = c8 & 15;
            f32x4 f0 = {0.f, 0.f, 0.f, 0.f}, f1 = f0, b0 = f0, b1 = f0;
            if (sI <= tau) { const GAS f32x4* tb = (const GAS f32x4*)(TBG + ((0 * 64 + (tau - sI)) * 16 + np) * 16 + n0); f0 = tb[0]; f1 = tb[1]; }
            if (sI >= tau) { const GAS f32x4* tb = (const GAS f32x4*)(TBG + ((1 * 64 + (sI - tau)) * 16 + np) * 16 + n0); b0 = tb[0]; b1 = tb[1]; }
            f0 += b0; f1 += b1; v[0] = f0[0]; v[1] = f0[1]; v[2] = f0[2]; v[3] = f0[3]; v[4] = f1[0]; v[5] = f1[1]; v[6] = f1[2]; v[7] = f1[3];
        } else { const int j0 = c8 - 1024, dir = j0 >> 7, pt = (j0 >> 6) & 1, e = dir ? 64 - tau : tau + 1;
#pragma unroll
            for (int q = 0; q < 8; ++q) { const int p = (j0 & 63) + q; const f32x2 c = CC[(dir * 16 + np) * 64 + p], a = APOW[(dir * 64 + p) * 65 + e];
                v[q] = pt ? -(c.x * a.y + c.y * a.x) : (c.x * a.x - c.y * a.y); } }
        v4u o; o.x = pk2(v[0], v[1]); o.y = pk2(v[2], v[3]); o.z = pk2(v[4], v[5]); o.w = pk2(v[6], v[7]);
        *(GAS v4u*)(K3T + (size_t)row * S5K + c8) = o;
    }
}

__device__ __forceinline__ void mod_item(Frame& F, int item) {
    const int l = item >> 7, slab = item & 127, col0 = 96 * slab;
    const float* wm = inp(I_WMOD) + (size_t)l * 2048 * 12288; const float* bm = inp(I_BMOD) + (size_t)l * 12288;
    LAS float* sv = (LAS float*)F.lds;
    LAS float* part = sv + 4096;
    __syncthreads();
    { const float* pc = inp(I_C); const float* pcc = inp(I_CCTX); float xv[8];
#pragma unroll
      for (int q = 0; q < 4; ++q) { xv[q] = pc[F.tid + NTHR * q]; xv[4 + q] = pcc[F.tid + NTHR * q]; }
#pragma unroll
      for (int q = 0; q < 8; ++q) sv[F.tid + NTHR * q] = siluf_(xv[q]); }
    __syncthreads();
    const int sub = F.lane / 24, cl = F.lane % 24;
    f32x4 a0 = {0.f, 0.f, 0.f, 0.f}, a1 = {0.f, 0.f, 0.f, 0.f};
    if (sub < 2) {
        const float* wp = wm + (size_t)(256 * F.wave + sub) * 12288 + col0 + 4 * cl;
#pragma unroll 8
        for (int kk = 0; kk < 256; kk += 2) { const f32x4 w = *(const GAS f32x4*)(wp + (size_t)kk * 12288); const int k = 256 * F.wave + kk + sub;
            const float s0 = sv[k], s1 = sv[2048 + k]; a0 += w * s0; a1 += w * s1; }
        LAS float* pp = part + ((F.wave * 2 + sub) * 24 + cl) * 8;
        pp[0] = a0[0]; pp[1] = a0[1]; pp[2] = a0[2]; pp[3] = a0[3]; pp[4] = a1[0]; pp[5] = a1[1]; pp[6] = a1[2]; pp[7] = a1[3];
    }
    __syncthreads();
    if (F.tid < 192) { const int w = F.tid / 96, c = F.tid % 96; float s = 0.f;
        for (int q = 0; q < 16; ++q) s += part[(q * 24 + (c >> 2)) * 8 + w * 4 + (c & 3)];
        float* MODF = (float*)(F.ws + WS_MODF); MODF[(size_t)(l * 2 + w) * 12288 + col0 + c] = s + bm[col0 + c]; }
    __syncthreads();
}

constexpr int units_of(int K, int N) { return (K / 128) * ((N + 255) / 256); }
constexpr int CU_SQ = units_of(2048, 2048), CU_PW = units_of(384, 384), CU_GL = units_of(512, 512), CU_UP = units_of(2048, 7168), CU_DN = units_of(7168, 2048), CU_WO = units_of(2048, 4624);
constexpr int CQ_E0 = 0, CQ_E1 = CQ_E0 + CU_SQ  , CQ_E2 = CQ_E1 + 4 * CU_PW  , CQ_E3 = CQ_E2 + CU_GL  , CQ_E4 = CQ_E3 + CU_SQ  ,
              CQ_F1 = CQ_E4 + CU_UP  , CQ_F2 = CQ_F1 + CU_UP  , CQ_F3 = CQ_F2 + CU_DN  , CQ_O1 = CQ_F3 + CU_WO  , CQ_O2 = CQ_O1 + CU_SQ  ,
              CQ_M1 = CQ_O2 + 8 * CU_UP  , CQ_M2 = CQ_M1 + 8 * CU_UP  , CQ_M3 = CQ_M2 + 8 * CU_DN  , CQ_END = CQ_M3;
constexpr int CW_QUEUE = 2048;
struct ConvDesc { const float* W; unsigned char* WT; int N, ldt, kind, fp8, k0, n0, pitch, kbyte; float sc; };
__device__ __forceinline__ void conv_decode(Frame& F, int it, ConvDesc& d) {
    int r = it; d.kind = 0; d.fp8 = 0; d.sc = 1.f;
    if (r < CQ_E1) { d.W = inp(I_EWIN); d.WT = F.ws + WS_WINE; d.N = 2048; d.ldt = 2048; }
    else if (r < CQ_E2) { r -= CQ_E1; const int g4 = r / CU_PW; d.W = inp(I_EPOOLW) + (size_t)g4 * 384 * 384; d.WT = F.ws + WS_WPOOL + (size_t)g4 * 512 * 384 * 2; d.N = 384; d.ldt = 384; r -= g4 * CU_PW; }
    else if (r < CQ_E3) { d.W = inp(I_WGLU); d.WT = F.ws + WS_WGLU; d.N = 512; d.ldt = 512; r -= CQ_E2; }
    else if (r < CQ_E4) { d.W = inp(I_EWOUT); d.WT = F.ws + WS_WOUTE; d.N = 2048; d.ldt = 2048; r -= CQ_E3; }
    else if (r < CQ_F2) { const int up = r >= CQ_F1; d.W = inp(up ? I_FFU : I_FFG); d.WT = F.ws + WS_WGU; d.N = 7168; d.ldt = 2048; d.kind = 1 + up; r -= (up ? CQ_F1 : CQ_E4);
        if (FFN_FP8 == 1) { d.fp8 = 1; d.sc = MOE_WSC_GU; } }
    else if (r < CQ_F3) { d.W = inp(I_FFD); d.WT = F.ws + WS_WDN; d.N = 2048; d.ldt = 7168; r -= CQ_F2; if (FFN_FP8 != 0) { d.fp8 = 1; d.sc = MOE_WSC_DN; } }
    else if (r < CQ_O1) { d.W = inp(I_OWIN); d.WT = F.ws + WS_WINO; d.N = 4624; d.ldt = 2048; d.kind = 3; r -= CQ_F3; }
    else if (r < CQ_O2) { d.W = inp(I_OWOUT); d.WT = F.ws + WS_WOUTO; d.N = 2048; d.ldt = 2048; r -= CQ_O1; }
    else if (r < CQ_M2) { d.fp8 = 1; const int up = r >= CQ_M1; r -= up ? CQ_M1 : CQ_O2; const int e = r / CU_UP; d.W = inp(up ? I_MOEU : I_MOEG) + (size_t)e * 2048 * 7168; d.WT = F.ws + WS_WMGU + (size_t)e * 14336 * 2048;
        d.N = 7168; d.ldt = 2048; d.kind = 1 + up; d.sc = MOE_WSC_GU; r -= e * CU_UP; }
    else { d.fp8 = 1; r -= CQ_M2; const int e = r / CU_DN; d.W = inp(I_MOED) + (size_t)e * 7168 * 2048; d.WT = F.ws + WS_WMDN + (size_t)e * 2048 * 7168; d.N = 2048; d.ldt = 7168; d.sc = MOE_WSC_DN; r -= e * CU_DN; }
    const int nblk = (d.N + 255) / 256, kb = r / nblk; d.k0 = 128 * kb; d.n0 = 256 * (r - kb * nblk);
    d.pitch = d.fp8 ? d.ldt : 2 * d.ldt; d.kbyte = d.fp8 ? d.k0 : 2 * d.k0;
    if (FFN_FP8 == 2 && FFNU_K1 < 2048 && it >= CQ_E4 && it < CQ_F2) {
        d.pitch = 2 * FFNU_K1 + (2048 - FFNU_K1);
        if (d.k0 >= FFNU_K1) { d.fp8 = 1; d.sc = MOE_WSC_GU; d.kbyte = 2 * FFNU_K1 + (d.k0 - FFNU_K1); } }
}
__device__ __forceinline__ int conv_row(int kind, int n) {
    if (kind == 0) return n; if (kind == 3) return RmWinO{}(n); return (n >> 7) * 256 + (kind - 1) * 128 + (n & 127); }
__device__ __forceinline__ void conv_load(const ConvDesc& d, int wave, int lane, f32x4 (&v)[16]) {
    const bool okc = (d.n0 + 4 * lane) < d.N; const float* p = d.W + (size_t)(d.k0 + 16 * wave) * d.N + d.n0 + 4 * lane;
#pragma unroll
    for (int i = 0; i < 16; ++i) v[i] = okc ? __builtin_nontemporal_load((const GAS f32x4*)(p + (size_t)i * d.N)) : (f32x4){0.f, 0.f, 0.f, 0.f};
}
__device__ __forceinline__ void conv_to_lds(const f32x4 (&v)[16], LAS float* tile, int wave, int lane) {
#pragma unroll
    for (int i = 0; i < 16; ++i) *(LAS f32x4*)(tile + (16 * wave + i) * 256 + ((lane ^ ((2 * wave + (i >> 3)) & 7)) << 2)) = v[i];
}
__device__ __forceinline__ void conv_store(const ConvDesc& d, const LAS float* tile, int tid) {
    const int c = tid & 7;
    if (d.fp8) {
#pragma unroll
        for (int q = 0; q < 4; ++q) { const int nn = (tid >> 3) + 64 * q; float x[16];
#pragma unroll
            for (int j = 0; j < 16; ++j) { const int k = 16 * c + j; x[j] = tile[k * 256 + ((((nn >> 2) ^ ((k >> 3) & 7)) & 63) << 2) + (nn & 3)]; }
            if (d.n0 + nn < d.N) { const size_t row = (size_t)conv_row(d.kind, d.n0 + nn); v4u o;
                o.x = pk4_fp8(x[0] * d.sc, x[1] * d.sc, x[2] * d.sc, x[3] * d.sc); o.y = pk4_fp8(x[4] * d.sc, x[5] * d.sc, x[6] * d.sc, x[7] * d.sc);
                o.z = pk4_fp8(x[8] * d.sc, x[9] * d.sc, x[10] * d.sc, x[11] * d.sc); o.w = pk4_fp8(x[12] * d.sc, x[13] * d.sc, x[14] * d.sc, x[15] * d.sc);
                __builtin_nontemporal_store(o, (GAS v4u*)(d.WT + row * d.pitch + d.kbyte + 16 * c)); } }
    } else {
#pragma unroll
        for (int q = 0; q < 8; ++q) { const int kh = q & 1, nn = (tid >> 3) + 64 * (q >> 1); const LAS float* s = tile + (64 * kh + 8 * c) * 256 + (((nn >> 2) ^ c) << 2) + (nn & 3);
            float x[8];
#pragma unroll
            for (int j = 0; j < 8; ++j) x[j] = s[j * 256];
            if (d.n0 + nn < d.N) { const size_t row = (size_t)conv_row(d.kind, d.n0 + nn);
                v4u o; o.x = pk2(x[0], x[1]); o.y = pk2(x[2], x[3]); o.z = pk2(x[4], x[5]); o.w = pk2(x[6], x[7]);
                __builtin_nontemporal_store(o, (GAS v4u*)(d.WT + row * d.pitch + d.kbyte + (64 * kh + 8 * c) * 2)); } }
    }
}
constexpr int CQ_NONE = 0x7fffffff;
__device__ __forceinline__ int conv_pull(Frame& F) { return (int)__hip_atomic_fetch_add((unsigned*)(F.ctl + CW_QUEUE), 1u, RLX_AGENT); }
__device__ __forceinline__ void conv_work(Frame& F, int dlimit, int quota) {
    LAS float* tile = (LAS float*)(F.lds + RING_OFF);
    volatile LAS int* QW = (volatile LAS int*)(F.lds + LDSCTL_OFF);
    __syncthreads();
    if (F.tid == 0) { int c0 = CQ_NONE, c1 = CQ_NONE; const int head = (int)__hip_atomic_load((unsigned*)(F.ctl + CW_QUEUE), RLX_AGENT);
        if (head < CQ_END && (quota > 0 || head < dlimit)) { c0 = conv_pull(F); if (c0 < CQ_END && (quota > 1 || c0 < dlimit)) c1 = conv_pull(F); }
        QW[0] = c0; QW[1] = c1; }
    __syncthreads();
    int cur = __builtin_amdgcn_readfirstlane(QW[0]), nxt = __builtin_amdgcn_readfirstlane(QW[1]);
    int npull = (cur != CQ_NONE) + (nxt != CQ_NONE);
    __syncthreads();
    if (cur >= CQ_END) return;
    ConvDesc d; f32x4 v[16]; conv_decode(F, cur, d); conv_load(d, F.wave, F.lane, v);
    for (;;) {
        conv_to_lds(v, tile, F.wave, F.lane); LDS_WAIT(); __syncthreads();
        const bool more = nxt < CQ_END; ConvDesc dn = d;
        if (more) { conv_decode(F, nxt, dn); conv_load(dn, F.wave, F.lane, v); }
        const bool pull = more && (npull < quota || nxt < dlimit);
        conv_store(d, tile, F.tid);
        if (pull && F.tid == 0) QW[0] = conv_pull(F);
        LDS_WAIT(); __syncthreads();
        if (!more) break;
        cur = nxt; nxt = pull ? __builtin_amdgcn_readfirstlane(QW[0]) : CQ_NONE; npull += pull ? 1 : 0; d = dn;
    }
}
__device__ __forceinline__ int fill_quota(int nunits, int G, int c, int Q) { const int mine = nunits > c ? (nunits - 1 - c) / G + 1 : 0, most = (nunits + G - 1) / G; return mine < most ? Q : 0; }
__device__ __forceinline__ void p0_prologue(Frame& F) {
    const int gw = F.vcu * NWAVES + F.wave, NGW = F.G * NWAVES, gt = gw * 64 + F.lane, ngt = NGW * 64;
    for (int it = blockIdx.x; it < 256; it += F.G) mod_item(F, it);
    for (int it = blockIdx.x; it < S5G * 8; it += F.G) { s5_small_tables(F, it >> 3); s5_stage_a(F, it >> 3, it & 7); }
    { float* rp = (float*)(F.ws + WS_ROPE); for (int i = gt; i < 256 * 32; i += ngt) { const int pos = i >> 5, fi = i & 31; const float fr = powf(10000.f, -(float)fi / 32.f), ang = (float)pos * fr;
        rp[2 * i] = cosf(ang); rp[2 * i + 1] = sinf(ang); } }
    for (int g4 = 0; g4 < 4; ++g4) zero_rows((bf16*)(F.ws + WS_WPOOL) + ((size_t)g4 * 512 + 384) * 384, (size_t)128 * 384 * 2, gt, ngt);
    zero_rows((bf16*)(F.ws + WS_WINO) + (size_t)4624 * 2048, (size_t)(WINO_N - 4624) * 2048 * 2, gt, ngt);
    __syncthreads();
    conv_work(F, CQ_E4, 0);
    __syncthreads();
}

#define PV(k) ((LAS float*)(F.lds + (k) * 8192))
__device__ __forceinline__ void ld_row_f32(const float* p, int lane, f32x4 (&v)[8]) {
#pragma unroll
    for (int j = 0; j < 8; ++j) v[j] = *(const GAS f32x4*)(p + 4 * lane + 256 * j);
}
__device__ __forceinline__ void st_row_f32(float* p, int lane, const f32x4 (&v)[8]) {
#pragma unroll
    for (int j = 0; j < 8; ++j) *(GAS f32x4*)(p + 4 * lane + 256 * j) = v[j];
}
__device__ __forceinline__ void ld_row_bf16(const bf16* p, int lane, f32x4 (&v)[8]) {
#pragma unroll
    for (int j = 0; j < 8; ++j) { const v2u w = *(const GAS v2u*)(p + 4 * lane + 256 * j); v[j] = (f32x4){bflo(w.x), bfhi(w.x), bflo(w.y), bfhi(w.y)}; }
}
__device__ __forceinline__ void st_row_bf16(bf16* p, int lane, const f32x4 (&v)[8]) {
#pragma unroll
    for (int j = 0; j < 8; ++j) { v2u w; w.x = pk2(v[j][0], v[j][1]); w.y = pk2(v[j][2], v[j][3]); *(GAS v2u*)(p + 4 * lane + 256 * j) = w; }
}
__device__ __forceinline__ float row_sumsq(const f32x4 (&v)[8]) {
    float s = 0.f;
#pragma unroll
    for (int j = 0; j < 8; ++j) s += (v[j][0] * v[j][0] + v[j][1] * v[j][1]) + (v[j][2] * v[j][2] + v[j][3] * v[j][3]);
    return wave_sum(s);
}
__device__ __forceinline__ f32x4 ldp(const LAS float* p, int lane, int j) { return *(const LAS f32x4*)(p + 4 * lane + 256 * j); }
__device__ __forceinline__ const float* modp(Frame& F, int layer, int w, int k) { return (const float*)(F.ws + WS_MODF) + (size_t)(layer * 2 + w) * 12288 + k * 2048; }
__device__ __forceinline__ const float* h0_row(Frame& F, int m) { return m < CTX ? inp(I_CTX) + (size_t)m * D : inp(I_X) + (size_t)(m - CTX) * D; }

__device__ __forceinline__ void ph_norm0(Frame& F) {
    __syncthreads();
    for (int i = F.tid; i < 2 * 2048; i += NTHR) { const int w = i >> 11, c = i & 2047;
        PV(2 * w)[c] = inp(I_NORMS)[0 * 2048 + c] * (1.f + modp(F, 0, w, 1)[c]); PV(2 * w + 1)[c] = modp(F, 0, w, 0)[c]; }
    __syncthreads();
    bf16* U = (bf16*)(F.ws + WS_ARENA + A_U);
    const int gw = F.vcu * NWAVES + F.wave, NGW = F.G * NWAVES;
    for (int m = gw; m < T; m += NGW) { const int w = m < CTX ? 1 : 0; f32x4 v[8]; ld_row_f32(h0_row(F, m), F.lane, v);
        const float rstd = 1.f / sqrtf(row_sumsq(v) * (1.f / D) + EPS);
#pragma unroll
        for (int j = 0; j < 8; ++j) v[j] = v[j] * rstd * ldp(PV(2 * w), F.lane, j) + ldp(PV(2 * w + 1), F.lane, j);
        st_row_bf16(U + (size_t)m * D, F.lane, v); }
}
__device__ __forceinline__ void ph_norm1(Frame& F) {
    __syncthreads();
    for (int i = F.tid; i < 2 * 2048; i += NTHR) { const int w = i >> 11, c = i & 2047;
        PV(3 * w)[c] = modp(F, 0, w, 2)[c] * inp(I_NORMS)[1 * 2048 + c]; PV(3 * w + 1)[c] = inp(I_NORMS)[2 * 2048 + c] * (1.f + modp(F, 0, w, 4)[c]); PV(3 * w + 2)[c] = modp(F, 0, w, 3)[c]; }
    __syncthreads();
    const bf16* YO = (const bf16*)(F.ws + WS_ARENA + A_YO); bf16* V = (bf16*)(F.ws + WS_ARENA + A_V); bf16* HR = (bf16*)(F.ws + WS_HRES);
    const int gw = F.vcu * NWAVES + F.wave, NGW = F.G * NWAVES;
    for (int m = gw; m < T; m += NGW) { const int w = m < CTX ? 1 : 0; f32x4 y[8], h[8]; ld_row_bf16(YO + (size_t)m * D, F.lane, y); ld_row_f32(h0_row(F, m), F.lane, h);
        const float ry = 1.f / sqrtf(row_sumsq(y) * (1.f / D) + EPS);
#pragma unroll
        for (int j = 0; j < 8; ++j) h[j] = h[j] + y[j] * ry * ldp(PV(3 * w), F.lane, j);
        st_row_bf16(HR + (size_t)m * D, F.lane, h);
        const float rh = 1.f / sqrtf(row_sumsq(h) * (1.f / D) + EPS);
#pragma unroll
        for (int j = 0; j < 8; ++j) y[j] = h[j] * rh * ldp(PV(3 * w + 1), F.lane, j) + ldp(PV(3 * w + 2), F.lane, j);
#if FFN_FP8 == 1
        { unsigned char* V8 = (unsigned char*)V + (size_t)m * D;
#pragma unroll
          for (int j = 0; j < 8; ++j) *(GAS unsigned*)(V8 + 4 * F.lane + 256 * j) = pk4_fp8(y[j][0], y[j][1], y[j][2], y[j][3]); }
#elif FFN_FP8 == 2 && FFNU_K1 < 2048
        { unsigned char* Vr = (unsigned char*)V + (size_t)m * (2 * FFNU_K1 + (2048 - FFNU_K1));
#pragma unroll
          for (int j = 0; j < 8; ++j) { const int col = 4 * F.lane + 256 * j;
              if (256 * j < FFNU_K1) { v2u w; w.x = pk2(y[j][0], y[j][1]); w.y = pk2(y[j][2], y[j][3]); *(GAS v2u*)(Vr + 2 * col) = w; }
              else *(GAS unsigned*)(Vr + 2 * FFNU_K1 + (col - FFNU_K1)) = pk4_fp8(y[j][0], y[j][1], y[j][2], y[j][3]); } }
#else
        st_row_bf16(V + (size_t)m * D, F.lane, y);
#endif
    }
}
__device__ __forceinline__ void ph_norm2(Frame& F) {
    __syncthreads();
    for (int i = F.tid; i < 2 * 2048; i += NTHR) { const int w = i >> 11, c = i & 2047;
        PV(3 * w)[c] = modp(F, 0, w, 5)[c] * inp(I_NORMS)[3 * 2048 + c]; PV(3 * w + 1)[c] = inp(I_NORMS)[(4 + 0) * 2048 + c] * (1.f + modp(F, 1, w, 1)[c]); PV(3 * w + 2)[c] = modp(F, 1, w, 0)[c]; }
    __syncthreads();
    const bf16* FB = (const bf16*)(F.ws + WS_ARENA + A_F); bf16* U = (bf16*)(F.ws + WS_ARENA + A_U); bf16* HR = (bf16*)(F.ws + WS_HRES);
    const int gw = F.vcu * NWAVES + F.wave, NGW = F.G * NWAVES;
    for (int m = gw; m < T; m += NGW) { const int w = m < CTX ? 1 : 0; f32x4 y[8], h[8]; ld_row_bf16(FB + (size_t)m * D, F.lane, y); ld_row_bf16(HR + (size_t)m * D, F.lane, h);
        const float ry = 1.f / sqrtf(row_sumsq(y) * (1.f / D) + EPS);
#pragma unroll
        for (int j = 0; j < 8; ++j) h[j] = h[j] + y[j] * ry * ldp(PV(3 * w), F.lane, j);
        st_row_bf16(HR + (size_t)m * D, F.lane, h);
        const float rh = 1.f / sqrtf(row_sumsq(h) * (1.f / D) + EPS);
#pragma unroll
        for (int j = 0; j < 8; ++j) y[j] = h[j] * rh * ldp(PV(3 * w + 1), F.lane, j) + ldp(PV(3 * w + 2), F.lane, j);
        st_row_bf16(U + (size_t)m * D, F.lane, y); }
}
__device__ __forceinline__ void ph_emit(Frame& F, float* out) {
    const bf16* HR = (const bf16*)(F.ws + WS_HRES) + (size_t)CTX * D;
    for (size_t i = (size_t)blockIdx.x * NTHR + F.tid; i < (size_t)SEQ * D / 4; i += (size_t)F.G * NTHR) { const v2u w = ((const GAS v2u*)HR)[i]; ((GAS f32x4*)out)[i] = (f32x4){bflo(w.x), bfhi(w.x), bflo(w.y), bfhi(w.y)}; }
}

template <int W> __device__ __forceinline__ void pooldiff_group(Frame& F, int gi) {
    const bf16* ZP = (const bf16*)(F.ws + WS_ARENA + A_ZP); bf16* DP = (bf16*)(F.ws + WS_ARENA + A_DP);
    constexpr int OG = PG / 8;
    const int nitem = T * OG;
    for (int it = F.vcu * NTHR + F.tid; it < nitem; it += F.G * NTHR) {
        const int t = it / OG, c8 = gi * PG + (it - t * OG) * 8;
        const int s0 = t < CTX ? 0 : CTX, L = t < CTX ? CTX : SEQ, tp = t - s0;
        int lo = tp - W / 2; lo = lo < 0 ? 0 : lo; int hi = tp + (W - W / 2); hi = hi > L ? L : hi;
        v4u x[W];
#pragma unroll
        for (int i = 0; i < W; ++i) { int r = tp - W / 2 + i; r = (r >= 0 && r < L) ? r : tp; x[i] = *(const GAS v4u*)(ZP + (size_t)(s0 + r) * WPOOL + c8); }
        float s[8];
#pragma unroll
        for (int q = 0; q < 8; ++q) s[q] = 0.f;
#pragma unroll
        for (int i = 0; i < W; ++i) { const int r = tp - W / 2 + i; if (r >= 0 && r < L) {
            s[0] += bflo(x[i].x); s[1] += bfhi(x[i].x); s[2] += bflo(x[i].y); s[3] += bfhi(x[i].y); s[4] += bflo(x[i].z); s[5] += bfhi(x[i].z); s[6] += bflo(x[i].w); s[7] += bfhi(x[i].w); } }
        const float inv = 1.f / (float)(hi - lo); const v4u z = x[W / 2];
        v4u o; o.x = pk2(s[0] * inv - bflo(z.x), s[1] * inv - bfhi(z.x)); o.y = pk2(s[2] * inv - bflo(z.y), s[3] * inv - bfhi(z.y));
        o.z = pk2(s[4] * inv - bflo(z.z), s[5] * inv - bfhi(z.z)); o.w = pk2(s[6] * inv - bflo(z.w), s[7] * inv - bfhi(z.w));
        *(GAS v4u*)(DP + (size_t)t * WPOOL + c8) = o;
    }
}
__device__ __forceinline__ void ph_pooldiff(Frame& F) { pooldiff_group<16>(F, 3); pooldiff_group<8>(F, 2); pooldiff_group<4>(F, 1); pooldiff_group<2>(F, 0); }

__device__ __forceinline__ void ph_s5scan(Frame& F) {
    const int gth = blockIdx.x * NTHR + F.tid; if (gth >= S5G * 2 * 64) return;
    const int g = gth >> 7, dir = (gth >> 6) & 1, p = gth & 63, gi = dir * S5G + g;
    const double dt = exp((double)inp(I_LOGDT)[gi]), lr = (double)inp(I_LAMRE)[gi * 64 + p], li = (double)inp(I_LAMIM)[gi * 64 + p];
    const float aLr = (float)(exp(lr * dt * LC) * cos(li * dt * LC)), aLi = (float)(exp(lr * dt * LC) * sin(li * dt * LC));
    const float* SL = (const float*)(F.ws + WS_ARENA + A_SLOC) + (size_t)g * S5ROWS * 256 + dir * 128 + p;
    bf16* CA = (bf16*)(F.ws + WS_ARENA + A_AS5) + (size_t)g * S5ROWS * S5K + 1024 + dir * 128 + p;
    float er = 0.f, ei = 0.f;
    for (int i0 = 0; i0 < NCH; i0 += 4) {
        int cc[4]; float sr[4], si[4];
#pragma unroll
        for (int q = 0; q < 4; ++q) { const int i = i0 + q; cc[q] = dir == 0 ? i : (i < NCH_CTX ? NCH_CTX - 1 - i : NCH - 1 - (i - NCH_CTX));
            sr[q] = SL[(size_t)cc[q] * 256]; si[q] = SL[(size_t)cc[q] * 256 + 64]; }
#pragma unroll
        for (int q = 0; q < 4; ++q) { CA[(size_t)cc[q] * S5K] = (bf16)f2bf(er); CA[(size_t)cc[q] * S5K + 64] = (bf16)f2bf(ei);
            const float nr = aLr * er - aLi * ei + sr[q], ni = aLr * ei + aLi * er + si[q]; er = nr; ei = ni; }
    }
}

typedef unsigned u32x4 __attribute__((ext_vector_type(4)));
using pg8::Unit; using pg8::pack8;
typedef const pg8::f32x4 (&AccRef)[2][2][4][2];
#define EPI_ROWS(u) const int row0 = (u).pm * 256 + wr * 64 + fr
struct EpiPlain { static constexpr bool PERM = true; bf16* O; int ldc;
    __device__ __forceinline__ void operator()(AccRef acc, const Unit& u, int wr, int wc, int fr, int fq) const { EPI_ROWS(u); const int col0 = u.pn * 256 + wc * 32 + 8 * fq;
#pragma unroll
        for (int ai = 0; ai < 2; ++ai)
#pragma unroll
            for (int m = 0; m < 4; ++m) { bf16* rp = O + (size_t)(row0 + ai * 128 + m * 16) * ldc + col0;
#pragma unroll
                for (int bj = 0; bj < 2; ++bj) *(GAS u32x4*)(rp + bj * 128) = pack8(acc[ai][bj][m][0], acc[ai][bj][m][1]); } } };
struct EpiWinE { static constexpr bool PERM = true; bf16* ZP; bf16* AS5;
    __device__ __forceinline__ void operator()(AccRef acc, const Unit& u, int wr, int wc, int fr, int fq) const { EPI_ROWS(u); const int col0 = u.pn * 256 + wc * 32 + 8 * fq;
#pragma unroll
        for (int ai = 0; ai < 2; ++ai)
#pragma unroll
            for (int m = 0; m < 4; ++m) { const int row = row0 + ai * 128 + m * 16;
#pragma unroll
                for (int bj = 0; bj < 2; ++bj) { const int col = col0 + bj * 128; const u32x4 w = pack8(acc[ai][bj][m][0], acc[ai][bj][m][1]);
                    if (u.pn < 6) *(GAS u32x4*)(ZP + (size_t)row * WPOOL + col) = w;
                    else { const int cc = col - WPOOL, g = cc >> 4, n0 = cc & 15, c = row >> 6, s = row & 63; *(GAS u32x4*)(AS5 + ((size_t)(g * S5ROWS + c) * S5K + s * 16 + n0)) = w; } } } } };
struct EpiPool { static constexpr bool PERM = true; bf16* YMIX; const float* scale;
    __device__ __forceinline__ void operator()(AccRef acc, const Unit& u, int wr, int wc, int fr, int fq) const { EPI_ROWS(u); const int lc0 = u.pn * 256 + wc * 32 + 8 * fq;
#pragma unroll
        for (int bj = 0; bj < 2; ++bj) { const int lc = lc0 + bj * 128; if (lc >= PG) continue; const int gc = u.bz * PG + lc;
            const f32x4 s0 = *(const GAS f32x4*)(scale + gc), s1 = *(const GAS f32x4*)(scale + gc + 4);
#pragma unroll
            for (int ai = 0; ai < 2; ++ai)
#pragma unroll
                for (int m = 0; m < 4; ++m) { const int row = row0 + ai * 128 + m * 16; *(GAS u32x4*)(YMIX + (size_t)row * D + gc) = pack8(acc[ai][bj][m][0] * s0, acc[ai][bj][m][1] * s1); } } } };
struct EpiSloc { static constexpr bool PERM = false; float* SL;
    __device__ __forceinline__ void operator()(AccRef acc, const Unit& u, int wr, int wc, int fr, int fq) const { EPI_ROWS(u); const int col0 = u.pn * 256 + wc * 32 + 4 * fq;
#pragma unroll
        for (int ai = 0; ai < 2; ++ai)
#pragma unroll
            for (int m = 0; m < 4; ++m) { float* rp = SL + ((size_t)u.bz * S5ROWS + row0 + ai * 128 + m * 16) * 256 + col0;
#pragma unroll
                for (int bj = 0; bj < 2; ++bj)
#pragma unroll
                    for (int n = 0; n < 2; ++n) *(GAS f32x4*)(rp + bj * 128 + n * 16) = acc[ai][bj][m][n]; } } };
struct EpiS5Y { static constexpr bool PERM = true; const bf16* AS5; const float* dsk; bf16* YG;
    __device__ __forceinline__ void operator()(AccRef acc, const Unit& u, int wr, int wc, int fr, int fq) const { EPI_ROWS(u); const int col0 = u.pn * 256 + wc * 32 + 8 * fq;
#pragma unroll
        for (int bj = 0; bj < 2; ++bj) { const int col = col0 + bj * 128, tau = col >> 4, n0 = col & 15;
            const f32x4 d0 = *(const GAS f32x4*)(dsk + u.bz * 16 + n0), d1 = *(const GAS f32x4*)(dsk + u.bz * 16 + n0 + 4);
#pragma unroll
            for (int ai = 0; ai < 2; ++ai)
#pragma unroll
                for (int m = 0; m < 4; ++m) { const int c = row0 + ai * 128 + m * 16; if (c >= NCH) continue;
                    const v4u x = *(const GAS v4u*)(AS5 + ((size_t)(u.bz * S5ROWS + c) * S5K + col));
                    f32x4 a = acc[ai][bj][m][0], b = acc[ai][bj][m][1];
                    a[0] = gelu_tanh(a[0] + bflo(x.x) * d0[0]); a[1] = gelu_tanh(a[1] + bfhi(x.x) * d0[1]); a[2] = gelu_tanh(a[2] + bflo(x.y) * d0[2]); a[3] = gelu_tanh(a[3] + bfhi(x.y) * d0[3]);
                    b[0] = gelu_tanh(b[0] + bflo(x.z) * d1[0]); b[1] = gelu_tanh(b[1] + bfhi(x.z) * d1[1]); b[2] = gelu_tanh(b[2] + bflo(x.w) * d1[2]); b[3] = gelu_tanh(b[3] + bfhi(x.w) * d1[3]);
                    *(GAS u32x4*)(YG + ((size_t)(c * 64 + tau) * WS5 + u.bz * 16 + n0)) = pack8(a, b); } } } };
struct EpiGlu { static constexpr bool PERM = true; const bf16* YG; bf16* YMIX;
    __device__ __forceinline__ void operator()(AccRef acc, const Unit& u, int wr, int wc, int fr, int fq) const { EPI_ROWS(u); const int col0 = u.pn * 256 + wc * 32 + 8 * fq;
#pragma unroll
        for (int ai = 0; ai < 2; ++ai)
#pragma unroll
            for (int m = 0; m < 4; ++m) { const int row = row0 + ai * 128 + m * 16;
#pragma unroll
                for (int bj = 0; bj < 2; ++bj) { const int col = col0 + bj * 128; const v4u x = *(const GAS v4u*)(YG + (size_t)row * WS5 + col);
                    f32x4 a = acc[ai][bj][m][0], b = acc[ai][bj][m][1];
                    a[0] = bflo(x.x) * sigmoidf_(a[0]); a[1] = bfhi(x.x) * sigmoidf_(a[1]); a[2] = bflo(x.y) * sigmoidf_(a[2]); a[3] = bfhi(x.y) * sigmoidf_(a[3]);
                    b[0] = bflo(x.z) * sigmoidf_(b[0]); b[1] = bfhi(x.z) * sigmoidf_(b[1]); b[2] = bflo(x.w) * sigmoidf_(b[2]); b[3] = bfhi(x.w) * sigmoidf_(b[3]);
                    *(GAS u32x4*)(YMIX + (size_t)row * D + WPOOL + col) = pack8(a, b); } } } };
struct EpiGateUp { static constexpr bool PERM = true; bf16* HID; int ldc;
    __device__ __forceinline__ void operator()(AccRef acc, const Unit& u, int wr, int wc, int fr, int fq) const { EPI_ROWS(u); const int col0 = u.pn * 128 + wc * 32 + 8 * fq;
#pragma unroll
        for (int ai = 0; ai < 2; ++ai)
#pragma unroll
            for (int m = 0; m < 4; ++m) { const int row = row0 + ai * 128 + m * 16; f32x4 a, b;
#pragma unroll
                for (int q = 0; q < 4; ++q) { a[q] = swiglu_fast(acc[ai][0][m][0][q], acc[ai][1][m][0][q], -1.4426950408889634f, 1.f); b[q] = swiglu_fast(acc[ai][0][m][1][q], acc[ai][1][m][1][q], -1.4426950408889634f, 1.f); }
                *(GAS u32x4*)(HID + (size_t)row * ldc + col0) = pack8(a, b); } } };

struct EpiWinO { static constexpr bool PERM = true; unsigned char* ar;
    __device__ __forceinline__ void operator()(AccRef acc, const Unit& u, int wr, int wc, int fr, int fq) const { EPI_ROWS(u); const int pn = u.pn;
        if (pn == 18) { if (wc == 0 && fq < 2) { float* ALR = (float*)(ar + B_ALR);
#pragma unroll
                for (int ai = 0; ai < 2; ++ai)
#pragma unroll
                    for (int m = 0; m < 4; ++m) { float* rp = ALR + (size_t)(row0 + ai * 128 + m * 16) * 16 + 8 * fq; *(GAS f32x4*)rp = acc[ai][0][m][0]; *(GAS f32x4*)(rp + 4) = acc[ai][0][m][1]; } }
            return; }
        bf16* base; int ld, c0;
        if (pn < 2) { base = (bf16*)(ar + B_GQ); ld = 512; c0 = pn * 256; } else if (pn < 4) { base = (bf16*)(ar + B_GK); ld = 512; c0 = (pn - 2) * 256; }
        else if (pn < 8) { base = (bf16*)(ar + B_GV); ld = 1024; c0 = (pn - 4) * 256; } else if (pn < 12) { base = (bf16*)(ar + B_R); ld = 1024; c0 = (pn - 8) * 256; }
        else if (pn < 16) { base = (bf16*)(ar + B_AQ); ld = 1024; c0 = (pn - 12) * 256; } else if (pn == 16) { base = (bf16*)(ar + B_AK); ld = 256; c0 = 0; } else { base = (bf16*)(ar + B_AV); ld = 256; c0 = 0; }
        const int col0 = c0 + wc * 32 + 8 * fq;
#pragma unroll
        for (int ai = 0; ai < 2; ++ai)
#pragma unroll
            for (int m = 0; m < 4; ++m) { bf16* rp = base + (size_t)(row0 + ai * 128 + m * 16) * ld + col0;
#pragma unroll
                for (int bj = 0; bj < 2; ++bj) *(GAS u32x4*)(rp + bj * 128) = pack8(acc[ai][bj][m][0], acc[ai][bj][m][1]); } } };

__device__ __forceinline__ void ph_qknorm(Frame& F) {
    unsigned char* ar = F.ws + WS_ARENA; bf16* AQ = (bf16*)(ar + B_AQ); bf16* AK = (bf16*)(ar + B_AK);
    const float* qn = inp(I_QNORM); const float* kn = inp(I_KNORM); const f32x2* rope = (const f32x2*)(F.ws + WS_ROPE);
    const size_t NQ = (size_t)SEQ * 8 * 8, NK = (size_t)T * 2 * 8;
    for (size_t it = (size_t)F.vcu * NTHR + F.tid; it < NQ + NK; it += (size_t)F.G * NTHR) {
        const bool isq = it < NQ; const size_t r = isq ? it : it - NQ; const int j = (int)(r & 7), hf = j >> 2, sub = j & 3;
        int row, head; bf16* p; const float* nw;
        if (isq) { head = (int)((r >> 3) & 7); row = CTX + (int)(r >> 6); p = AQ + (size_t)row * 1024 + head * 128; nw = qn; }
        else { head = (int)((r >> 3) & 1); row = (int)(r >> 4); p = AK + (size_t)row * 256 + head * 128; nw = kn; }
        const int d1 = 64 * hf + 8 * sub, d2 = d1 + 32;
        const v4u a = *(const GAS v4u*)(p + d1), b = *(const GAS v4u*)(p + d2);
        float x1[8] = {bflo(a.x), bfhi(a.x), bflo(a.y), bfhi(a.y), bflo(a.z), bfhi(a.z), bflo(a.w), bfhi(a.w)};
        float x2[8] = {bflo(b.x), bfhi(b.x), bflo(b.y), bfhi(b.y), bflo(b.z), bfhi(b.z), bflo(b.w), bfhi(b.w)};
        float ss = 0.f;
#pragma unroll
        for (int e = 0; e < 8; ++e) ss += x1[e] * x1[e] + x2[e] * x2[e];
        ss += __shfl_xor(ss, 1); ss += __shfl_xor(ss, 2); ss += __shfl_xor(ss, 4);
        const float rstd = 1.f / sqrtf(ss * (1.f / 128.f) + EPS);
        const bool rot = row >= CTX; const int tl = row - CTX, pos = hf ? (tl & 63) : (tl >> 6);
        float o1[8], o2[8];
#pragma unroll
        for (int e = 0; e < 8; ++e) { const float y1 = x1[e] * rstd * nw[d1 + e], y2 = x2[e] * rstd * nw[d2 + e];
            f32x2 cs = {1.f, 0.f}; if (rot) cs = rope[pos * 32 + 8 * sub + e];
            o1[e] = y1 * cs.x - y2 * cs.y; o2[e] = y1 * cs.y + y2 * cs.x; }
        v4u w1, w2; w1.x = pk2(o1[0], o1[1]); w1.y = pk2(o1[2], o1[3]); w1.z = pk2(o1[4], o1[5]); w1.w = pk2(o1[6], o1[7]);
        w2.x = pk2(o2[0], o2[1]); w2.y = pk2(o2[2], o2[3]); w2.z = pk2(o2[4], o2[5]); w2.w = pk2(o2[6], o2[7]);
        *(GAS v4u*)(p + d1) = w1; *(GAS v4u*)(p + d2) = w2;
        if (!isq) {
            unsigned char* k8 = ar + B_KDT + (size_t)row * 256 + head * 128 + 64 * (sub & 1) + 8 * (4 * hf + (sub >> 1));
            v2u a8, b8; a8.x = pk4_fp8(o1[0], o1[1], o1[2], o1[3]); a8.y = pk4_fp8(o1[4], o1[5], o1[6], o1[7]); b8.x = pk4_fp8(o2[0], o2[1], o2[2], o2[3]); b8.y = pk4_fp8(o2[4], o2[5], o2[6], o2[7]);
            *(GAS v2u*)k8 = a8; *(GAS v2u*)(k8 + 16) = b8; }
    }
}

constexpr size_t VT8_OFF = 8 * MiB;
__device__ __forceinline__ void ph_vt8(Frame& F) {
    unsigned char* ar = F.ws + WS_ARENA; const bf16* AV = (const bf16*)(ar + B_AV); unsigned char* VT8 = ar + B_KDT + VT8_OFF;
    const int ntask = 2 * NCH * 128 * 4;
    for (int it = F.vcu * NTHR + F.tid; it < ntask; it += F.G * NTHR) {
        const int g = it & 3, d = (it >> 2) & 127, tl = (it >> 9) % NCH, kvh = (it >> 9) / NCH, hi = g >> 1, blk = g & 1;
        float x[16];
#pragma unroll
        for (int r = 0; r < 16; ++r) { const int key = 32 * blk + (r & 3) + 8 * (r >> 2) + 4 * hi; x[r] = bf2f(AV[(size_t)(tl * 64 + key) * 256 + kvh * 128 + d]); }
        v4u o; o.x = pk4_fp8(x[0], x[1], x[2], x[3]); o.y = pk4_fp8(x[4], x[5], x[6], x[7]); o.z = pk4_fp8(x[8], x[9], x[10], x[11]); o.w = pk4_fp8(x[12], x[13], x[14], x[15]);
        *(GAS v4u*)(VT8 + ((size_t)(kvh * NCH + tl) * 128 + d) * 64 + g * 16) = o;
    }
}

namespace tri {
using s16x4 = __attribute__((ext_vector_type(4))) short;
__device__ __forceinline__ int st(int k, int c) { const int kk = (k & ~0xC) | ((k & 4) << 1) | ((k & 8) >> 1); return ((kk >> 3) * 4 + (c >> 5)) * 512 + ((kk & 7) * 32 + (c & 31)) * 2; }
__device__ __forceinline__ int rd_base(int lane) { return ((lane & 3) << 3) | (((lane >> 2) & 3) << 6) | (((lane >> 4) & 1) << 5) | (((lane >> 5) & 1) << 8); }
constexpr int rd_off(int d0, int ks, int half) { return d0 * 512 + ks * 4096 + half * 2048; }
template <int OFF> __device__ __forceinline__ s16x4 tr_read(int vb) { s16x4 r; asm volatile("ds_read_b64_tr_b16 %0, %1 offset:%2" : "=&v"(r) : "v"(vb), "i"(OFF) : "memory"); return r; }
struct Frag2 { s16x4 lo, hi; };
template <int D0, int KS> __device__ __forceinline__ Frag2 ld(int vb) { Frag2 f; f.lo = tr_read<rd_off(D0, KS, 0)>(vb); f.hi = tr_read<rd_off(D0, KS, 1)>(vb); return f; }
__device__ __forceinline__ bf16x8 pk(const Frag2& f) { return (bf16x8){f.lo[0], f.lo[1], f.lo[2], f.lo[3], f.hi[0], f.hi[1], f.hi[2], f.hi[3]}; }
#define TRI_WAIT() do { asm volatile("s_waitcnt lgkmcnt(0)" ::: "memory"); __builtin_amdgcn_sched_barrier(0); } while (0)
}
typedef float f32x16 __attribute__((ext_vector_type(16)));
__device__ __forceinline__ int crow(int r, int hi) { return (r & 3) + 8 * (r >> 2) + 4 * hi; }

__device__ __forceinline__ float logsigmoidf_(float z) { return fminf(z, 0.f) - __logf(1.f + __expf(-fabsf(z))); }
__device__ __forceinline__ void gla_prepkv_unit(Frame& F, int c, int h) {
    unsigned char* ar = F.ws + WS_ARENA;
    const bf16* GQ = (const bf16*)(ar + B_GQ); const bf16* GK = (const bf16*)(ar + B_GK); const bf16* GV = (const bf16*)(ar + B_GV); const float* ALR = (const float*)(ar + B_ALR);
    LAS float* ALR_S = (LAS float*)(F.lds);
    LAS float* WA_S = (LAS float*)(F.lds + 4096);
    LAS float* BA_S = (LAS float*)(F.lds + 12288);
    LAS float* SEG_S = (LAS float*)(F.lds + 12800);
    LAS float* GB = (LAS float*)(F.lds + 14848);
    LAS unsigned char* QS = F.lds + 47616;
    LAS unsigned char* KS = F.lds + 64000;
    LAS unsigned char* VIMG = F.lds + 80384;
    LAS unsigned char* KIMG = F.lds + 113152;
    const int tid = F.tid, lane = F.lane, t0 = c * 64;
    __syncthreads();
    for (int i = tid; i < 1024; i += NTHR) ALR_S[i] = ALR[(size_t)t0 * 16 + i];
    for (int i = tid; i < 1024; i += NTHR) { const int r = i >> 4, k8 = (i & 15) * 8;
        *(LAS v4u*)(QS + (r * 128 + k8) * 2) = *(const GAS v4u*)(GQ + (size_t)(t0 + r) * 512 + h * 128 + k8); *(LAS v4u*)(KS + (r * 128 + k8) * 2) = *(const GAS v4u*)(GK + (size_t)(t0 + r) * 512 + h * 128 + k8); }
    for (int i = tid; i < 2048; i += NTHR) { const int r = i >> 5, v8 = (i & 31) * 8;
        *(LAS v4u*)(VIMG + (v8 >> 7) * 16384 + tri::st(r, v8 & 127)) = *(const GAS v4u*)(GV + (size_t)(t0 + r) * 1024 + h * 256 + v8); }
    for (int d = 0; d < 2; ++d) {
        const float* wa = inp(I_GLAWA) + (size_t)d * 16 * 512 + h * 128; const float* ba = inp(I_GLABA) + d * 512 + h * 128;
        __syncthreads();
        for (int i = tid; i < 2048; i += NTHR) WA_S[i] = wa[(size_t)(i >> 7) * 512 + (i & 127)];
        if (tid < 128) BA_S[tid] = ba[tid];
        __syncthreads();
        const int k = tid & 127, seg = tid >> 7;
        float gl[16];
        { float w[16];
#pragma unroll
          for (int r = 0; r < 16; ++r) w[r] = WA_S[r * 128 + k];
          const float b0 = BA_S[k];
#pragma unroll
          for (int ii = 0; ii < 16; ++ii) { const int i = seg * 16 + ii; float z = b0;
#pragma unroll
              for (int r = 0; r < 16; ++r) z += ALR_S[i * 16 + r] * w[r];
              gl[ii] = logsigmoidf_(z) * (1.f / 16.f); } }
        if (d == 0) {
#pragma unroll
            for (int ii = 1; ii < 16; ++ii) gl[ii] += gl[ii - 1];
            SEG_S[seg * 128 + k] = gl[15]; }
        else {
#pragma unroll
            for (int ii = 14; ii >= 0; --ii) gl[ii] += gl[ii + 1];
            SEG_S[seg * 128 + k] = gl[0]; }
        __syncthreads();
        const float s0 = SEG_S[k], s1 = SEG_S[128 + k], s2 = SEG_S[256 + k], s3 = SEG_S[384 + k], tot = (s0 + s1) + (s2 + s3);
        float off;
        if (d == 0) off = seg == 0 ? 0.f : (seg == 1 ? s0 : (seg == 2 ? s0 + s1 : s0 + s1 + s2));
        else off = seg == 3 ? 0.f : (seg == 2 ? s3 : (seg == 1 ? s3 + s2 : s3 + s2 + s1));
#pragma unroll
        for (int ii = 0; ii < 16; ++ii) GB[(seg * 16 + ii) * 128 + k] = gl[ii] + off;
        if (seg == 0) ((float*)(ar + B_DEC))[((size_t)(d * NCH + c) * 4 + h) * 128 + k] = __expf(tot);
        __syncthreads();
        { bf16* QE = (bf16*)(ar + B_QE) + (size_t)d * T * 512; bf16* KE = (bf16*)(ar + B_KE) + (size_t)d * T * 512;
          for (int i2 = tid; i2 < 1024; i2 += NTHR) { const int i = i2 >> 4, k8 = (i2 & 15) * 8; const v4u qw = *(const LAS v4u*)(QS + (i * 128 + k8) * 2), kw = *(const LAS v4u*)(KS + (i * 128 + k8) * 2);
              const f32x4 ba0 = *(const LAS f32x4*)(GB + i * 128 + k8), ba1 = *(const LAS f32x4*)(GB + i * 128 + k8 + 4);
              const f32x4 t0v = *(const LAS f32x4*)(SEG_S + k8), t1v = *(const LAS f32x4*)(SEG_S + 128 + k8), t2v = *(const LAS f32x4*)(SEG_S + 256 + k8), t3v = *(const LAS f32x4*)(SEG_S + 384 + k8);
              const f32x4 u0v = *(const LAS f32x4*)(SEG_S + k8 + 4), u1v = *(const LAS f32x4*)(SEG_S + 128 + k8 + 4), u2v = *(const LAS f32x4*)(SEG_S + 256 + k8 + 4), u3v = *(const LAS f32x4*)(SEG_S + 384 + k8 + 4);
              const f32x4 tt0 = (t0v + t1v) + (t2v + t3v), tt1 = (u0v + u1v) + (u2v + u3v);
              const float b[8] = {ba0[0], ba0[1], ba0[2], ba0[3], ba1[0], ba1[1], ba1[2], ba1[3]}; const float tt[8] = {tt0[0], tt0[1], tt0[2], tt0[3], tt1[0], tt1[1], tt1[2], tt1[3]};
              const unsigned qv[4] = {qw.x, qw.y, qw.z, qw.w}, kv[4] = {kw.x, kw.y, kw.z, kw.w}; float qe[8], ke[8], kd[8];
#pragma unroll
              for (int e = 0; e < 4; ++e) { const float q0 = bflo(qv[e]), q1 = bfhi(qv[e]), k0 = bflo(kv[e]), k1 = bfhi(kv[e]); const float e0 = __expf(b[2 * e]), e1 = __expf(b[2 * e + 1]);
                  const float r0 = __builtin_amdgcn_rcpf(e0), r1 = __builtin_amdgcn_rcpf(e1);
                  qe[2 * e] = q0 * 0.08838834764831845f * e0; qe[2 * e + 1] = q1 * 0.08838834764831845f * e1; ke[2 * e] = k0 * r0; ke[2 * e + 1] = k1 * r1;
                  kd[2 * e] = k0 * __expf(tt[2 * e] - b[2 * e]); kd[2 * e + 1] = k1 * __expf(tt[2 * e + 1] - b[2 * e + 1]); }
              v4u wq, wk, wd; wq.x = pk2(qe[0], qe[1]); wq.y = pk2(qe[2], qe[3]); wq.z = pk2(qe[4], qe[5]); wq.w = pk2(qe[6], qe[7]);
              wk.x = pk2(ke[0], ke[1]); wk.y = pk2(ke[2], ke[3]); wk.z = pk2(ke[4], ke[5]); wk.w = pk2(ke[6], ke[7]);
              wd.x = pk2(kd[0], kd[1]); wd.y = pk2(kd[2], kd[3]); wd.z = pk2(kd[4], kd[5]); wd.w = pk2(kd[6], kd[7]);
              *(GAS v4u*)(QE + (size_t)(t0 + i) * 512 + h * 128 + k8) = wq; *(GAS v4u*)(KE + (size_t)(t0 + i) * 512 + h * 128 + k8) = wk;
              *(LAS v4u*)(KIMG + tri::st(i, k8)) = wd; } }
        __syncthreads();
        {
            const int w = F.wave, r = lane & 31, hi = lane >> 5;
            const int kb_base = (int)(uintptr_t)KIMG + tri::rd_base(lane), vb_base = (int)(uintptr_t)VIMG + (w >> 2) * 16384 + (w & 3) * 512 + tri::rd_base(lane);
            const tri::Frag2 b0 = tri::ld<0, 0>(vb_base), b1 = tri::ld<0, 1>(vb_base), b2 = tri::ld<0, 2>(vb_base), b3 = tri::ld<0, 3>(vb_base);
            const tri::Frag2 a00 = tri::ld<0, 0>(kb_base), a01 = tri::ld<0, 1>(kb_base), a02 = tri::ld<0, 2>(kb_base), a03 = tri::ld<0, 3>(kb_base);
            const tri::Frag2 a10 = tri::ld<1, 0>(kb_base), a11 = tri::ld<1, 1>(kb_base), a12 = tri::ld<1, 2>(kb_base), a13 = tri::ld<1, 3>(kb_base);
            const tri::Frag2 a20 = tri::ld<2, 0>(kb_base), a21 = tri::ld<2, 1>(kb_base), a22 = tri::ld<2, 2>(kb_base), a23 = tri::ld<2, 3>(kb_base);
            const tri::Frag2 a30 = tri::ld<3, 0>(kb_base), a31 = tri::ld<3, 1>(kb_base), a32 = tri::ld<3, 2>(kb_base), a33 = tri::ld<3, 3>(kb_base);
            TRI_WAIT();
            const bf16x8 B0 = tri::pk(b0), B1 = tri::pk(b1), B2 = tri::pk(b2), B3 = tri::pk(b3);
            f32x16 acc[4] = {};
            acc[0] = __builtin_amdgcn_mfma_f32_32x32x16_bf16(tri::pk(a00), B0, acc[0], 0, 0, 0); acc[0] = __builtin_amdgcn_mfma_f32_32x32x16_bf16(tri::pk(a01), B1, acc[0], 0, 0, 0);
            acc[0] = __builtin_amdgcn_mfma_f32_32x32x16_bf16(tri::pk(a02), B2, acc[0], 0, 0, 0); acc[0] = __builtin_amdgcn_mfma_f32_32x32x16_bf16(tri::pk(a03), B3, acc[0], 0, 0, 0);
            acc[1] = __builtin_amdgcn_mfma_f32_32x32x16_bf16(tri::pk(a10), B0, acc[1], 0, 0, 0); acc[1] = __builtin_amdgcn_mfma_f32_32x32x16_bf16(tri::pk(a11), B1, acc[1], 0, 0, 0);
            acc[1] = __builtin_amdgcn_mfma_f32_32x32x16_bf16(tri::pk(a12), B2, acc[1], 0, 0, 0); acc[1] = __builtin_amdgcn_mfma_f32_32x32x16_bf16(tri::pk(a13), B3, acc[1], 0, 0, 0);
            acc[2] = __builtin_amdgcn_mfma_f32_32x32x16_bf16(tri::pk(a20), B0, acc[2], 0, 0, 0); acc[2] = __builtin_amdgcn_mfma_f32_32x32x16_bf16(tri::pk(a21), B1, acc[2], 0, 0, 0);
            acc[2] = __builtin_amdgcn_mfma_f32_32x32x16_bf16(tri::pk(a22), B2, acc[2], 0, 0, 0); acc[2] = __builtin_amdgcn_mfma_f32_32x32x16_bf16(tri::pk(a23), B3, acc[2], 0, 0, 0);
            acc[3] = __builtin_amdgcn_mfma_f32_32x32x16_bf16(tri::pk(a30), B0, acc[3], 0, 0, 0); acc[3] = __builtin_amdgcn_mfma_f32_32x32x16_bf16(tri::pk(a31), B1, acc[3], 0, 0, 0);
            acc[3] = __builtin_amdgcn_mfma_f32_32x32x16_bf16(tri::pk(a32), B2, acc[3], 0, 0, 0); acc[3] = __builtin_amdgcn_mfma_f32_32x32x16_bf16(tri::pk(a33), B3, acc[3], 0, 0, 0);
            bf16* ST = (bf16*)(ar + B_ST) + ((size_t)(d * NCH + c) * 4 + h) * 256 * 128;
#pragma unroll
            for (int kb = 0; kb < 4; ++kb)
#pragma unroll
                for (int q4 = 0; q4 < 4; ++q4) { v2u o; o.x = pk2(acc[kb][4 * q4], acc[kb][4 * q4 + 1]); o.y = pk2(acc[kb][4 * q4 + 2], acc[kb][4 * q4 + 3]);
                    *(GAS v2u*)(ST + (size_t)(32 * w + r) * 128 + 32 * kb + 8 * q4 + 4 * hi) = o; }
        }
    }
}

__device__ __forceinline__ void ph_gla_scan(Frame& F) {
    unsigned char* ar = F.ws + WS_ARENA; const float* DEC = (const float*)(ar + B_DEC);
    for (int gth = blockIdx.x * NTHR + F.tid; gth < 2 * 4 * 256 * 64; gth += F.G * NTHR) {
        const int kp = gth & 63, v = (gth >> 6) & 255, h = (gth >> 14) & 3, d = gth >> 16;
        unsigned* ST = (unsigned*)(ar + B_ST) + ((((size_t)d * NCH) * 4 + h) * 256 + v) * 64 + kp;
        const f32x2* DC = (const f32x2*)DEC + (((size_t)d * NCH) * 4 + h) * 64 + kp;
        float s0 = 0.f, s1 = 0.f;
        for (int i0 = 0; i0 < NCH; i0 += 4) { int cc[4]; unsigned kv[4]; f32x2 dc[4];
#pragma unroll
            for (int q = 0; q < 4; ++q) { const int i = i0 + q; cc[q] = d == 0 ? i : (i < NCH_CTX ? NCH_CTX - 1 - i : NCH - 1 - (i - NCH_CTX));
                kv[q] = ST[(size_t)cc[q] * (4 * 256 * 64)]; dc[q] = DC[(size_t)cc[q] * (4 * 64)]; }
#pragma unroll
            for (int q = 0; q < 4; ++q) { ST[(size_t)cc[q] * (4 * 256 * 64)] = pk2(s0, s1); s0 = dc[q].x * s0 + bflo(kv[q]); s1 = dc[q].y * s1 + bfhi(kv[q]); } }
    }
}

__device__ __forceinline__ void gla_out_unit(Frame& F, int cl, int h) {
    unsigned char* ar = F.ws + WS_ARENA; const int c = cl + NCH_CTX, t0 = c * 64;
    LAS unsigned char* ATT = F.lds;
    LAS float* OS = (LAS float*)(F.lds + 18432);
    LAS unsigned char* VIMG = F.lds + 86016;
    const int lane = F.lane, r = lane & 31, hi = lane >> 5, w = F.wave;
    __syncthreads();
    { const bf16* GV = (const bf16*)(ar + B_GV);
      for (int i = F.tid; i < 2048; i += NTHR) { const int rr = i >> 5, v8 = (i & 31) * 8;
          *(LAS v4u*)(VIMG + (v8 >> 7) * 16384 + tri::st(rr, v8 & 127)) = *(const GAS v4u*)(GV + (size_t)(t0 + rr) * 1024 + h * 256 + v8); } }
    {
        const int d = w >> 2, ib = (w >> 1) & 1, jb = w & 1;
        const bf16* QE = (const bf16*)(ar + B_QE) + (size_t)d * T * 512 + (size_t)(t0 + ib * 32 + r) * 512 + h * 128 + 8 * hi;
        const bf16* KE = (const bf16*)(ar + B_KE) + (size_t)d * T * 512 + (size_t)(t0 + jb * 32 + r) * 512 + h * 128 + 8 * hi;
        bf16x8 a[8], b[8];
#pragma unroll
        for (int s = 0; s < 8; ++s) { a[s] = *(const GAS bf16x8*)(KE + 16 * s); b[s] = *(const GAS bf16x8*)(QE + 16 * s); }
        f32x16 acc = {};
#pragma unroll
        for (int s = 0; s < 8; ++s) acc = __builtin_amdgcn_mfma_f32_32x32x16_bf16(a[s], b[s], acc, 0, 0, 0);
        const int i = ib * 32 + r;
#pragma unroll
        for (int q4 = 0; q4 < 4; ++q4) { float x[4];
#pragma unroll
            for (int e = 0; e < 4; ++e) { const int j = jb * 32 + 8 * q4 + 4 * hi + e; const bool keep = d == 0 ? (j <= i) : (j >= i); x[e] = keep ? acc[4 * q4 + e] : 0.f; }
            v2u o; o.x = pk2(x[0], x[1]); o.y = pk2(x[2], x[3]);
            *(LAS v2u*)(ATT + ((size_t)(d * 64 + i) * 72 + jb * 32 + 8 * q4 + 4 * hi) * 2) = o; }
    }
    __syncthreads();
    {
        const int ib = w >> 2, vq = w & 3; f32x16 o0 = {}, o1 = {};
        const int vb_base = (int)(uintptr_t)VIMG + (vq >> 1) * 16384 + (2 * (vq & 1)) * 512 + tri::rd_base(lane);
        const tri::Frag2 p0 = tri::ld<0, 0>(vb_base), p1 = tri::ld<0, 1>(vb_base), p2 = tri::ld<0, 2>(vb_base), p3 = tri::ld<0, 3>(vb_base);
        const tri::Frag2 q0 = tri::ld<1, 0>(vb_base), q1 = tri::ld<1, 1>(vb_base), q2 = tri::ld<1, 2>(vb_base), q3 = tri::ld<1, 3>(vb_base);
        TRI_WAIT();
        const bf16x8 vb0[4] = {tri::pk(p0), tri::pk(p1), tri::pk(p2), tri::pk(p3)}, vb1[4] = {tri::pk(q0), tri::pk(q1), tri::pk(q2), tri::pk(q3)};
#pragma unroll
        for (int d = 0; d < 2; ++d) {
            bf16x8 a[4];
#pragma unroll
            for (int s = 0; s < 4; ++s) a[s] = *(const LAS bf16x8*)(ATT + ((size_t)(d * 64 + ib * 32 + r) * 72 + 16 * s + 8 * hi) * 2);
#pragma unroll
            for (int s = 0; s < 4; ++s) { o0 = __builtin_amdgcn_mfma_f32_32x32x16_bf16(a[s], vb0[s], o0, 0, 0, 0); o1 = __builtin_amdgcn_mfma_f32_32x32x16_bf16(a[s], vb1[s], o1, 0, 0, 0); }
            const bf16* QE = (const bf16*)(ar + B_QE) + (size_t)d * T * 512 + (size_t)(t0 + ib * 32 + r) * 512 + h * 128 + 8 * hi;
            const bf16* ST = (const bf16*)(ar + B_ST) + ((size_t)(d * NCH + c) * 4 + h) * 256 * 128 + (size_t)(64 * vq + r) * 128 + 8 * hi;
            bf16x8 qa[8], s0[8], s1[8];
#pragma unroll
            for (int s = 0; s < 8; ++s) { qa[s] = *(const GAS bf16x8*)(QE + 16 * s); s0[s] = *(const GAS bf16x8*)(ST + 16 * s); s1[s] = *(const GAS bf16x8*)(ST + 32 * 128 + 16 * s); }
#pragma unroll
            for (int s = 0; s < 8; ++s) { o0 = __builtin_amdgcn_mfma_f32_32x32x16_bf16(qa[s], s0[s], o0, 0, 0, 0); o1 = __builtin_amdgcn_mfma_f32_32x32x16_bf16(qa[s], s1[s], o1, 0, 0, 0); }
        }
#pragma unroll
        for (int q = 0; q < 16; ++q) { const int i = ib * 32 + crow(q, hi); OS[i * 260 + 64 * vq + r] = o0[q]; OS[i * 260 + 64 * vq + 32 + r] = o1[q]; }
    }
    __syncthreads();
    {
        const int i = F.tid >> 3, seg = F.tid & 7; const LAS float* op = OS + i * 260 + 32 * seg; f32x4 x[8]; float ss = 0.f;
#pragma unroll
        for (int e = 0; e < 8; ++e) { x[e] = *(const LAS f32x4*)(op + 4 * e); ss += (x[e][0] * x[e][0] + x[e][1] * x[e][1]) + (x[e][2] * x[e][2] + x[e][3] * x[e][3]); }
        ss += __shfl_xor(ss, 1); ss += __shfl_xor(ss, 2); ss += __shfl_xor(ss, 4);
        const float rstd = 1.f / sqrtf(ss * (1.f / 256.f) + EPS);
        const float* gn = inp(I_GLANORM) + h * 256 + 32 * seg; const bf16* R = (const bf16*)(ar + B_R) + (size_t)(t0 + i) * 1024 + h * 256 + 32 * seg;
        bf16* YM = (bf16*)(ar + B_YMIX1) + (size_t)(t0 - CTX + i) * D + h * 256 + 32 * seg;
#pragma unroll
        for (int e2 = 0; e2 < 4; ++e2) { const v4u rr = *(const GAS v4u*)(R + 8 * e2); const f32x4 g0 = *(const GAS f32x4*)(gn + 8 * e2), g1 = *(const GAS f32x4*)(gn + 8 * e2 + 4);
            const f32x4 a = x[2 * e2] * rstd * g0, b = x[2 * e2 + 1] * rstd * g1; v4u o;
            o.x = pk2(a[0] * siluf_(bflo(rr.x)), a[1] * siluf_(bfhi(rr.x))); o.y = pk2(a[2] * siluf_(bflo(rr.y)), a[3] * siluf_(bfhi(rr.y)));
            o.z = pk2(b[0] * siluf_(bflo(rr.z)), b[1] * siluf_(bfhi(rr.z))); o.w = pk2(b[2] * siluf_(bflo(rr.w)), b[3] * siluf_(bfhi(rr.w)));
            *(GAS v4u*)(YM + 8 * e2) = o; }
    }
}

namespace att {
constexpr int HD = 128, NW = 8, QBLK = 32, KVBLK = 64;
constexpr float SCALE = 0.088388347648318440f;
constexpr float THR = 8.f;
constexpr int LDQ = 1024, LDK = 256, LDO = 2048;
constexpr size_t SHM_V = KVBLK * HD * 2, SHM_K = KVBLK * HD * 2, SHM_ATTN = 2 * SHM_V + 2 * SHM_K + NW * 64 * 4;
using s16x4 = __attribute__((ext_vector_type(4))) short;
#define KSWZ(row, colB) ((row) * 256 + ((colB) ^ (((row) & 7) << 4)))
#define SBAR() __builtin_amdgcn_sched_barrier(0)
__device__ __forceinline__ unsigned cvtpk(float lo, float hi) { unsigned r; asm volatile("v_cvt_pk_bf16_f32 %0, %1, %2" : "=v"(r) : "v"(lo), "v"(hi)); return r; }
__device__ __forceinline__ void partialSM(f32x16& p0, f32x16& p1, float& m_reg, float& mn, float& alpha) {
  constexpr float C = SCALE * 1.4426950408889634f;
  float pmax = p0[0];
#pragma unroll
  for (int r = 1; r < 16; ++r) pmax = fmaxf(pmax, p0[r]);
#pragma unroll
  for (int r = 0; r < 16; ++r) pmax = fmaxf(pmax, p1[r]);
  { auto rr = __builtin_amdgcn_permlane32_swap(__float_as_uint(pmax), __float_as_uint(pmax), false, false);
    pmax = fmaxf(__uint_as_float(rr[0]), __uint_as_float(rr[1])); }
  if (__builtin_expect(__all(pmax - m_reg <= THR / SCALE), 1)) { mn = m_reg; alpha = 1.f; }
  else { mn = fmaxf(m_reg, pmax); alpha = __builtin_amdgcn_exp2f((m_reg - mn) * C); m_reg = mn; }
  float mnC = -mn * C;
#pragma unroll
  for (int r = 0; r < 16; ++r) p0[r] = fmaf(p0[r], C, mnC);
#pragma unroll
  for (int r = 0; r < 16; ++r) p1[r] = fmaf(p1[r], C, mnC);
#pragma unroll
  for (int r = 0; r < 16; ++r) p0[r] = __builtin_amdgcn_exp2f(p0[r]);
}
__device__ __forceinline__ void finishSM(f32x16& p0, f32x16& p1, float alpha, float& l_reg, bf16x8& pa0, bf16x8& pa1, bf16x8& pa2, bf16x8& pa3) {
#pragma unroll
  for (int r = 0; r < 16; ++r) p1[r] = __builtin_amdgcn_exp2f(p1[r]);
  float ps = 0;
#pragma unroll
  for (int r = 0; r < 16; ++r) ps += p0[r];
#pragma unroll
  for (int r = 0; r < 16; ++r) ps += p1[r];
  { auto rr = __builtin_amdgcn_permlane32_swap(__float_as_uint(ps), __float_as_uint(ps), false, false);
    ps = __uint_as_float(rr[0]) + __uint_as_float(rr[1]); }
  l_reg = l_reg * alpha + ps;
#define PK4(P, BASE, OUT) do { unsigned a0 = cvtpk(P[BASE + 0], P[BASE + 1]), a1 = cvtpk(P[BASE + 2], P[BASE + 3]);   \
    unsigned b0 = cvtpk(P[BASE + 4], P[BASE + 5]), b1 = cvtpk(P[BASE + 6], P[BASE + 7]);                              \
    auto r0 = __builtin_amdgcn_permlane32_swap(a0, b0, false, false); auto r1 = __builtin_amdgcn_permlane32_swap(a1, b1, false, false); \
    u32x4 w = {r0[0], r1[0], r0[1], r1[1]}; OUT = *reinterpret_cast<bf16x8*>(&w); } while (0)
  PK4(p0, 0, pa0); PK4(p0, 8, pa1); PK4(p1, 0, pa2); PK4(p1, 8, pa3);
#undef PK4
}
__device__ __forceinline__ void qkt(f32x16& p0, f32x16& p1, const bf16* Ks, const bf16x8* qr, int r32, int hi) {
  p0 = f32x16{}; p1 = f32x16{};
#pragma unroll
  for (int d0 = 0; d0 < 8; ++d0) { int cb = (d0 * 16 + hi * 8) * 2;
    bf16x8 b0 = *reinterpret_cast<const bf16x8*>((const char*)Ks + KSWZ(r32, cb));
    bf16x8 b1 = *reinterpret_cast<const bf16x8*>((const char*)Ks + KSWZ(32 + r32, cb));
    p0 = __builtin_amdgcn_mfma_f32_32x32x16_bf16(b0, qr[d0], p0, 0, 0, 0);
    p1 = __builtin_amdgcn_mfma_f32_32x32x16_bf16(b1, qr[d0], p1, 0, 0, 0); }
}
__device__ __forceinline__ int v_st(int k, int c) { const int kk = (k & ~0xC) | ((k & 4) << 1) | ((k & 8) >> 1); return ((kk >> 3) * 4 + (c >> 5)) * 512 + ((kk & 7) * 32 + (c & 31)) * 2; }
__device__ __forceinline__ int v_rd_base(int lane) { return ((lane & 3) << 3) | (((lane >> 2) & 3) << 6) | (((lane >> 4) & 1) << 5) | (((lane >> 5) & 1) << 8); }
constexpr int v_rd_off(int d0, int ks, int half) { return d0 * 512 + ks * 4096 + half * 2048; }
template <int OFF> __device__ __forceinline__ s16x4 tr_read(int vb) {
  s16x4 r; asm volatile("ds_read_b64_tr_b16 %0, %1 offset:%2" : "=&v"(r) : "v"(vb), "i"(OFF) : "memory"); return r;
}
template <int D0> __device__ __forceinline__ void pv_one(f32x16& od, int vb, bf16x8 pa0, bf16x8 pa1, bf16x8 pa2, bf16x8 pa3) {
  const s16x4 l0 = tr_read<v_rd_off(D0, 0, 0)>(vb), h0 = tr_read<v_rd_off(D0, 0, 1)>(vb), l1 = tr_read<v_rd_off(D0, 1, 0)>(vb), h1 = tr_read<v_rd_off(D0, 1, 1)>(vb);
  const s16x4 l2 = tr_read<v_rd_off(D0, 2, 0)>(vb), h2 = tr_read<v_rd_off(D0, 2, 1)>(vb), l3 = tr_read<v_rd_off(D0, 3, 0)>(vb), h3 = tr_read<v_rd_off(D0, 3, 1)>(vb);
  asm volatile("s_waitcnt lgkmcnt(0)" ::: "memory"); SBAR();
#define PK(L, H) (bf16x8){L[0], L[1], L[2], L[3], H[0], H[1], H[2], H[3]}
  od = __builtin_amdgcn_mfma_f32_32x32x16_bf16(pa0, PK(l0, h0), od, 0, 0, 0);
  od = __builtin_amdgcn_mfma_f32_32x32x16_bf16(pa1, PK(l1, h1), od, 0, 0, 0);
  od = __builtin_amdgcn_mfma_f32_32x32x16_bf16(pa2, PK(l2, h2), od, 0, 0, 0);
  od = __builtin_amdgcn_mfma_f32_32x32x16_bf16(pa3, PK(l3, h3), od, 0, 0, 0);
#undef PK
}
__device__ __forceinline__ void pv_d0(f32x16* o, int vb, bf16x8 pa0, bf16x8 pa1, bf16x8 pa2, bf16x8 pa3) {
  pv_one<0>(o[0], vb, pa0, pa1, pa2, pa3); pv_one<1>(o[1], vb, pa0, pa1, pa2, pa3); pv_one<2>(o[2], vb, pa0, pa1, pa2, pa3); pv_one<3>(o[3], vb, pa0, pa1, pa2, pa3);
}
typedef int v8i __attribute__((ext_vector_type(8)));
typedef int v4i __attribute__((ext_vector_type(4)));
constexpr size_t SHM_K8 = KVBLK * 128;
#define K8ADDR(row, g) ((row) * 128 + ((((g) ^ ((row) >> 1)) & 7) << 4))
__device__ __forceinline__ void qkt8(f32x16& p0, f32x16& p1, const char* Ks, const v8i& q0, const v8i& q1, int r32, int hi, int sc1) {
  p0 = f32x16{}; p1 = f32x16{};
  const int g0 = 4 * hi;
  { const v4i a00 = *reinterpret_cast<const v4i*>(Ks + K8ADDR(r32, g0)), a01 = *reinterpret_cast<const v4i*>(Ks + K8ADDR(r32, g0 + 1));
    const v4i b00 = *reinterpret_cast<const v4i*>(Ks + K8ADDR(32 + r32, g0)), b01 = *reinterpret_cast<const v4i*>(Ks + K8ADDR(32 + r32, g0 + 1));
    const v8i ka0 = __builtin_shufflevector(a00, a01, 0, 1, 2, 3, 4, 5, 6, 7), kb0 = __builtin_shufflevector(b00, b01, 0, 1, 2, 3, 4, 5, 6, 7);
    asm volatile("s_nop 1\n\tv_mfma_scale_f32_32x32x64_f8f6f4 %0, %1, %2, %0, %3, %3 op_sel_hi:[0,0,0]" : "+v"(p0) : "v"(ka0), "v"(q0), "v"(sc1));
    asm volatile("s_nop 1\n\tv_mfma_scale_f32_32x32x64_f8f6f4 %0, %1, %2, %0, %3, %3 op_sel_hi:[0,0,0]" : "+v"(p1) : "v"(kb0), "v"(q0), "v"(sc1) : "memory"); }
  { const v4i a10 = *reinterpret_cast<const v4i*>(Ks + K8ADDR(r32, g0 + 2)), a11 = *reinterpret_cast<const v4i*>(Ks + K8ADDR(r32, g0 + 3));
    const v4i b10 = *reinterpret_cast<const v4i*>(Ks + K8ADDR(32 + r32, g0 + 2)), b11 = *reinterpret_cast<const v4i*>(Ks + K8ADDR(32 + r32, g0 + 3));
    const v8i ka1 = __builtin_shufflevector(a10, a11, 0, 1, 2, 3, 4, 5, 6, 7), kb1 = __builtin_shufflevector(b10, b11, 0, 1, 2, 3, 4, 5, 6, 7);
    asm volatile("s_nop 1\n\tv_mfma_scale_f32_32x32x64_f8f6f4 %0, %1, %2, %0, %3, %3 op_sel_hi:[0,0,0]" : "+v"(p0) : "v"(ka1), "v"(q1), "v"(sc1));
    asm volatile("s_nop 1\n\tv_mfma_scale_f32_32x32x64_f8f6f4 %0, %1, %2, %0, %3, %3 op_sel_hi:[0,0,0]" : "+v"(p1) : "v"(kb1), "v"(q1), "v"(sc1)); }
  asm volatile("s_nop 15\n\ts_nop 7" : "+v"(p0), "+v"(p1));
}
__device__ __forceinline__ void attn_dense_body(const bf16* __restrict__ Qb, const unsigned char* __restrict__ Kh8, const bf16* __restrict__ Vh, bf16* __restrict__ Ob, int seq, char* lds) {
  constexpr int SDEPTH = 2;
  const int tid = threadIdx.x, wid = tid >> 6, lane = tid & 63, r32 = lane & 31, hi = lane >> 5;
  bf16* V_lds = (bf16*)lds; char* K_lds = lds + 2 * SHM_V;
  float* ws = (float*)(lds + 2 * SHM_V + 2 * SHM_K8) + wid * 64; float* li_l = ws; float* al_l = ws + 32;
  float m_reg = -1e30f, l_reg = 0; f32x16 o[4] = {}; bf16x8 qr[8];
  const bf16* Qw = Qb + (long)(wid * QBLK + r32) * LDQ + hi * 8;
#pragma unroll
  for (int d0 = 0; d0 < 8; ++d0) qr[d0] = *reinterpret_cast<const bf16x8*>(Qw + d0 * 16);
  v8i q8a, q8b; const int sc1 = 0x7f7f7f7f;
  { int w[16];
#pragma unroll
    for (int d0 = 0; d0 < 8; ++d0) { const u32x4 x = *reinterpret_cast<const u32x4*>(&qr[d0]);
      w[2 * d0] = (int)pk4_fp8(bflo(x.x), bfhi(x.x), bflo(x.y), bfhi(x.y)); w[2 * d0 + 1] = (int)pk4_fp8(bflo(x.z), bfhi(x.z), bflo(x.w), bfhi(x.w)); }
    q8a = (v8i){w[0], w[1], w[2], w[3], w[4], w[5], w[6], w[7]}; q8b = (v8i){w[8], w[9], w[10], w[11], w[12], w[13], w[14], w[15]}; }
  const int krow = tid >> 3, kg = tid & 7, kst = K8ADDR(krow, kg);
  const int sr = tid >> 4, sc = (tid & 15) * 8, vst0 = v_st(sr, sc), vst1 = v_st(32 + sr, sc);
  const int vb0 = (int)(uintptr_t)V_lds + v_rd_base(lane);
  struct { bf16x8 vs0, vs1; v4i ks; } sr_[SDEPTH];
#define SLOAD(i, k0) do { sr_[i].vs0 = *reinterpret_cast<const bf16x8*>(&Vh[(long)((k0) + sr) * LDK + sc]); sr_[i].vs1 = *reinterpret_cast<const bf16x8*>(&Vh[(long)((k0) + 32 + sr) * LDK + sc]); \
    sr_[i].ks = *reinterpret_cast<const v4i*>(&Kh8[(long)((k0) + krow) * 256 + kg * 16]); } while (0)
#define SWRITE(b, i) do { *(bf16x8*)((char*)V_lds + (b) * SHM_V + vst0) = sr_[i].vs0;          \
    *(bf16x8*)((char*)V_lds + (b) * SHM_V + vst1) = sr_[i].vs1;                                \
    *(v4i*)(K_lds + (b) * SHM_K8 + kst) = sr_[i].ks; } while (0)
#define SWAIT() do { asm volatile("s_waitcnt vmcnt(3)" ::: "memory"); } while (0)
#define RESC(a) do { if (__any((a) < 1.f)) { if (hi == 0) al_l[r32] = (a); asm volatile("s_waitcnt lgkmcnt(0)" ::: "memory"); \
    _Pragma("unroll") for (int d = 0; d < 4; ++d) _Pragma("unroll") for (int r = 0; r < 16; ++r) o[d][r] *= al_l[crow(r, hi)]; } } while (0)
  f32x16 pA0, pA1, pB0, pB1; float mnA, mnB, alA, alB; bf16x8 pa0, pa1, pa2, pa3; const int NT = seq / KVBLK;
  constexpr int SE = 0, SO = SDEPTH - 1;
  SLOAD(SE, 0); asm volatile("s_waitcnt vmcnt(0)" ::: "memory"); SWRITE(0, SE); __syncthreads();
  qkt8(pA0, pA1, K_lds, q8a, q8b, r32, hi, sc1); partialSM(pA0, pA1, m_reg, mnA, alA);
  SLOAD(SO, KVBLK); if (2 < NT) SLOAD(SE, 2 * KVBLK);
  SWAIT(); SWRITE(1, SO); __syncthreads();
  for (int j = 1; j + 1 < NT; j += 2) {
    SBAR(); qkt8(pB0, pB1, K_lds + SHM_K8, q8a, q8b, r32, hi, sc1);
    finishSM(pA0, pA1, alA, l_reg, pa0, pa1, pa2, pa3); SBAR();
    SLOAD(SO, (j + SDEPTH) * KVBLK); SBAR();
    pv_d0(o, vb0, pa0, pa1, pa2, pa3); partialSM(pB0, pB1, m_reg, mnB, alB);
    __syncthreads(); SWAIT(); SWRITE(0, SE);
    RESC(alB); __syncthreads();
    SBAR(); qkt8(pA0, pA1, K_lds, q8a, q8b, r32, hi, sc1);
    finishSM(pB0, pB1, alB, l_reg, pa0, pa1, pa2, pa3); SBAR();
    if (j + 3 < NT) SLOAD(SE, (j + 1 + SDEPTH) * KVBLK); SBAR();
    pv_d0(o, vb0 + (int)SHM_V, pa0, pa1, pa2, pa3); partialSM(pA0, pA1, m_reg, mnA, alA);
    __syncthreads(); SWAIT(); SWRITE(1, SO);
    RESC(alA); __syncthreads();
  }
  SBAR(); qkt8(pB0, pB1, K_lds + SHM_K8, q8a, q8b, r32, hi, sc1);
  finishSM(pA0, pA1, alA, l_reg, pa0, pa1, pa2, pa3); SBAR();
  pv_d0(o, vb0, pa0, pa1, pa2, pa3); partialSM(pB0, pB1, m_reg, mnB, alB);
  __syncthreads(); RESC(alB);
  finishSM(pB0, pB1, alB, l_reg, pa0, pa1, pa2, pa3); SBAR();
  pv_d0(o, vb0 + (int)SHM_V, pa0, pa1, pa2, pa3);
  if (hi == 0) li_l[r32] = l_reg; asm volatile("s_waitcnt lgkmcnt(0)" ::: "memory");
  float rli[16];
#pragma unroll
  for (int r = 0; r < 16; ++r) rli[r] = __builtin_amdgcn_rcpf(li_l[crow(r, hi)]);
  bf16* Ow = Ob + (long)(wid * QBLK) * LDO;
#pragma unroll
  for (int r = 0; r < 16; ++r) { int orow = crow(r, hi);
#pragma unroll
    for (int d0 = 0; d0 < 4; ++d0) Ow[(long)orow * LDO + d0 * 32 + r32] = (bf16)f2bf(o[d0][r] * rli[r]); }
  __syncthreads();
#undef SLOAD
#undef SWRITE
#undef SWAIT
#undef RESC
}
constexpr float THR8 = 6.f;
#define V8ADDR(d, g) ((d) * 64 + ((((g) ^ ((d) >> 2)) & 3) << 4))
__device__ __forceinline__ void partialSM8(f32x16& p0, f32x16& p1, float& m_reg, float& mn, float& alpha) {
  constexpr float C = SCALE * 1.4426950408889634f;
  float pmax = p0[0];
#pragma unroll
  for (int r = 1; r < 16; ++r) pmax = fmaxf(pmax, p0[r]);
#pragma unroll
  for (int r = 0; r < 16; ++r) pmax = fmaxf(pmax, p1[r]);
  { auto rr = __builtin_amdgcn_permlane32_swap(__float_as_uint(pmax), __float_as_uint(pmax), false, false);
    pmax = fmaxf(__uint_as_float(rr[0]), __uint_as_float(rr[1])); }
  if (__builtin_expect(__all(pmax - m_reg <= THR8 / SCALE), 1)) { mn = m_reg; alpha = 1.f; }
  else { mn = fmaxf(m_reg, pmax); alpha = __builtin_amdgcn_exp2f((m_reg - mn) * C); m_reg = mn; }
  float mnC = -mn * C;
#pragma unroll
  for (int r = 0; r < 16; ++r) p0[r] = fmaf(p0[r], C, mnC);
#pragma unroll
  for (int r = 0; r < 16; ++r) p1[r] = fmaf(p1[r], C, mnC);
#pragma unroll
  for (int r = 0; r < 16; ++r) p0[r] = __builtin_amdgcn_exp2f(p0[r]);
}
__device__ __forceinline__ void finishSM8(f32x16& p0, f32x16& p1, float alpha, float& l_reg, v8i& pa) {
#pragma unroll
  for (int r = 0; r < 16; ++r) p1[r] = __builtin_amdgcn_exp2f(p1[r]);
  float ps = 0;
#pragma unroll
  for (int r = 0; r < 16; ++r) ps += p0[r];
#pragma unroll
  for (int r = 0; r < 16; ++r) ps += p1[r];
  { auto rr = __builtin_amdgcn_permlane32_swap(__float_as_uint(ps), __float_as_uint(ps), false, false);
    ps = __uint_as_float(rr[0]) + __uint_as_float(rr[1]); }
  l_reg = l_reg * alpha + ps;
  pa = (v8i){(int)pk4_fp8(p0[0], p0[1], p0[2], p0[3]), (int)pk4_fp8(p0[4], p0[5], p0[6], p0[7]), (int)pk4_fp8(p0[8], p0[9], p0[10], p0[11]), (int)pk4_fp8(p0[12], p0[13], p0[14], p0[15]),
             (int)pk4_fp8(p1[0], p1[1], p1[2], p1[3]), (int)pk4_fp8(p1[4], p1[5], p1[6], p1[7]), (int)pk4_fp8(p1[8], p1[9], p1[10], p1[11]), (int)pk4_fp8(p1[12], p1[13], p1[14], p1[15])};
}
__device__ __forceinline__ void pv8(f32x16* o, const char* Vs, const v8i& pa, int r32, int hi, int sc1) {
#pragma unroll
  for (int d0 = 0; d0 < 4; ++d0) { const int d = 32 * d0 + r32;
    const v4i x0 = *reinterpret_cast<const v4i*>(Vs + V8ADDR(d, 2 * hi)), x1 = *reinterpret_cast<const v4i*>(Vs + V8ADDR(d, 2 * hi + 1));
    const v8i vb = __builtin_shufflevector(x0, x1, 0, 1, 2, 3, 4, 5, 6, 7);
    asm volatile("s_nop 1\n\tv_mfma_scale_f32_32x32x64_f8f6f4 %0, %1, %2, %0, %3, %3 op_sel_hi:[0,0,0]" : "+v"(o[d0]) : "v"(pa), "v"(vb), "v"(sc1)); }
  asm volatile("s_nop 15\n\ts_nop 7" : "+v"(o[0]), "+v"(o[1]), "+v"(o[2]), "+v"(o[3]));
}
__device__ __forceinline__ void attn_dense_body_pv8(const bf16* __restrict__ Qb, const unsigned char* __restrict__ Kh8, const unsigned char* __restrict__ Vt8, bf16* __restrict__ Ob, int seq, char* lds) {
  constexpr int SDEPTH = 2; constexpr size_t SHM_V8 = 8192;
  const int tid = threadIdx.x, wid = tid >> 6, lane = tid & 63, r32 = lane & 31, hi = lane >> 5;
  char* V_lds = lds; char* K_lds = lds + 2 * SHM_V8;
  float* ws = (float*)(lds + 2 * SHM_V8 + 2 * SHM_K8) + wid * 64; float* li_l = ws; float* al_l = ws + 32;
  float m_reg = -1e30f, l_reg = 0; f32x16 o[4] = {}; bf16x8 qr[8];
  const bf16* Qw = Qb + (long)(wid * QBLK + r32) * LDQ + hi * 8;
#pragma unroll
  for (int d0 = 0; d0 < 8; ++d0) qr[d0] = *reinterpret_cast<const bf16x8*>(Qw + d0 * 16);
  v8i q8a, q8b; const int sc1 = 0x7f7f7f7f;
  { int w[16];
#pragma unroll
    for (int d0 = 0; d0 < 8; ++d0) { const u32x4 x = *reinterpret_cast<const u32x4*>(&qr[d0]);
      w[2 * d0] = (int)pk4_fp8(bflo(x.x), bfhi(x.x), bflo(x.y), bfhi(x.y)); w[2 * d0 + 1] = (int)pk4_fp8(bflo(x.z), bfhi(x.z), bflo(x.w), bfhi(x.w)); }
    q8a = (v8i){w[0], w[1], w[2], w[3], w[4], w[5], w[6], w[7]}; q8b = (v8i){w[8], w[9], w[10], w[11], w[12], w[13], w[14], w[15]}; }
  const int krow = tid >> 3, kg = tid & 7, kst = K8ADDR(krow, kg);
  const int vrow = tid >> 2, vg = tid & 3, vst = V8ADDR(vrow, vg);
  struct { v4i vs, ks; } sr_[SDEPTH];
#define SLOAD(i, k0) do { sr_[i].vs = *reinterpret_cast<const v4i*>(&Vt8[(long)((k0) / KVBLK) * 8192 + tid * 16]); sr_[i].ks = *reinterpret_cast<const v4i*>(&Kh8[(long)((k0) + krow) * 256 + kg * 16]); } while (0)
#define SWRITE(b, i) do { *(v4i*)(V_lds + (b) * SHM_V8 + vst) = sr_[i].vs; *(v4i*)(K_lds + (b) * SHM_K8 + kst) = sr_[i].ks; } while (0)
#define SWAIT() do { asm volatile("s_waitcnt vmcnt(2)" ::: "memory"); } while (0)
#define RESC(a) do { if (__any((a) < 1.f)) { if (hi == 0) al_l[r32] = (a); asm volatile("s_waitcnt lgkmcnt(0)" ::: "memory"); \
    _Pragma("unroll") for (int d = 0; d < 4; ++d) _Pragma("unroll") for (int r = 0; r < 16; ++r) o[d][r] *= al_l[crow(r, hi)]; } } while (0)
  f32x16 pA0, pA1, pB0, pB1; float mnA, mnB, alA, alB; v8i pa; const int NT = seq / KVBLK;
  constexpr int SE = 0, SO = SDEPTH - 1;
  SLOAD(SE, 0); asm volatile("s_waitcnt vmcnt(0)" ::: "memory"); SWRITE(0, SE); __syncthreads();
  qkt8(pA0, pA1, K_lds, q8a, q8b, r32, hi, sc1); partialSM8(pA0, pA1, m_reg, mnA, alA);
  SLOAD(SO, KVBLK); if (2 < NT) SLOAD(SE, 2 * KVBLK);
  SWAIT(); SWRITE(1, SO); __syncthreads();
  for (int j = 1; j + 1 < NT; j += 2) {
    SBAR(); qkt8(pB0, pB1, K_lds + SHM_K8, q8a, q8b, r32, hi, sc1);
    finishSM8(pA0, pA1, alA, l_reg, pa); SBAR();
    SLOAD(SO, (j + SDEPTH) * KVBLK); SBAR();
    pv8(o, V_lds, pa, r32, hi, sc1); partialSM8(pB0, pB1, m_reg, mnB, alB);
    __syncthreads(); SWAIT(); SWRITE(0, SE);
    RESC(alB); __syncthreads();
    SBAR(); qkt8(pA0, pA1, K_lds, q8a, q8b, r32, hi, sc1);
    finishSM8(pB0, pB1, alB, l_reg, pa); SBAR();
    if (j + 3 < NT) SLOAD(SE, (j + 1 + SDEPTH) * KVBLK); SBAR();
    pv8(o, V_lds + SHM_V8, pa, r32, hi, sc1); partialSM8(pA0, pA1, m_reg, mnA, alA);
    __syncthreads(); SWAIT(); SWRITE(1, SO);
    RESC(alA); __syncthreads();
  }
  SBAR(); qkt8(pB0, pB1, K_lds + SHM_K8, q8a, q8b, r32, hi, sc1);
  finishSM8(pA0, pA1, alA, l_reg, pa); SBAR();
  pv8(o, V_lds, pa, r32, hi, sc1); partialSM8(pB0, pB1, m_reg, mnB, alB);
  __syncthreads(); RESC(alB);
  finishSM8(pB0, pB1, alB, l_reg, pa); SBAR();
  pv8(o, V_lds + SHM_V8, pa, r32, hi, sc1);
  if (hi == 0) li_l[r32] = l_reg; asm volatile("s_waitcnt lgkmcnt(0)" ::: "memory");
  float rli[16];
#pragma unroll
  for (int r = 0; r < 16; ++r) rli[r] = __builtin_amdgcn_rcpf(li_l[crow(r, hi)]);
  bf16* Ow = Ob + (long)(wid * QBLK) * LDO;
#pragma unroll
  for (int r = 0; r < 16; ++r) { int orow = crow(r, hi);
#pragma unroll
    for (int d0 = 0; d0 < 4; ++d0) Ow[(long)orow * LDO + d0 * 32 + r32] = (bf16)f2bf(o[d0][r] * rli[r]); }
  __syncthreads();
#undef SLOAD
#undef SWRITE
#undef SWAIT
#undef RESC
}
constexpr float QS8 = SCALE * 1.4426950408889634f * 8.f;
constexpr float THR2 = 8.6f;
__device__ __forceinline__ int cvt4_fp8(float a, float b, float c, float d) { int r; asm("v_cvt_pk_fp8_f32 %0, %1, %2" : "=v"(r) : "v"(a), "v"(b)); asm("v_cvt_pk_fp8_f32 %0, %1, %2 op_sel:[0,0,1]" : "+v"(r) : "v"(c), "v"(d)); return r; }
__device__ __forceinline__ void qkt8m(f32x16& p0, f32x16& p1, const f32x16& mi, const char* Ks, const v8i& q0, const v8i& q1, int r32, int hi, int sc1, int scq) {
  const int g0 = 4 * hi;
  { const v4i a00 = *reinterpret_cast<const v4i*>(Ks + K8ADDR(r32, g0)), a01 = *reinterpret_cast<const v4i*>(Ks + K8ADDR(r32, g0 + 1));
    const v4i b00 = *reinterpret_cast<const v4i*>(Ks + K8ADDR(32 + r32, g0)), b01 = *reinterpret_cast<const v4i*>(Ks + K8ADDR(32 + r32, g0 + 1));
    const v8i ka0 = __builtin_shufflevector(a00, a01, 0, 1, 2, 3, 4, 5, 6, 7), kb0 = __builtin_shufflevector(b00, b01, 0, 1, 2, 3, 4, 5, 6, 7);
    asm volatile("s_nop 1\n\tv_mfma_scale_f32_32x32x64_f8f6f4 %0, %1, %2, %3, %4, %5 op_sel_hi:[0,0,0]" : "=&v"(p0) : "v"(ka0), "v"(q0), "v"(mi), "v"(sc1), "v"(scq));
    asm volatile("s_nop 1\n\tv_mfma_scale_f32_32x32x64_f8f6f4 %0, %1, %2, %3, %4, %5 op_sel_hi:[0,0,0]" : "=&v"(p1) : "v"(kb0), "v"(q0), "v"(mi), "v"(sc1), "v"(scq) : "memory"); }
  { const v4i a10 = *reinterpret_cast<const v4i*>(Ks + K8ADDR(r32, g0 + 2)), a11 = *reinterpret_cast<const v4i*>(Ks + K8ADDR(r32, g0 + 3));
    const v4i b10 = *reinterpret_cast<const v4i*>(Ks + K8ADDR(32 + r32, g0 + 2)), b11 = *reinterpret_cast<const v4i*>(Ks + K8ADDR(32 + r32, g0 + 3));
    const v8i ka1 = __builtin_shufflevector(a10, a11, 0, 1, 2, 3, 4, 5, 6, 7), kb1 = __builtin_shufflevector(b10, b11, 0, 1, 2, 3, 4, 5, 6, 7);
    asm volatile("s_nop 1\n\tv_mfma_scale_f32_32x32x64_f8f6f4 %0, %1, %2, %0, %3, %4 op_sel_hi:[0,0,0]" : "+v"(p0) : "v"(ka1), "v"(q1), "v"(sc1), "v"(scq));
    asm volatile("s_nop 1\n\tv_mfma_scale_f32_32x32x64_f8f6f4 %0, %1, %2, %0, %3, %4 op_sel_hi:[0,0,0]" : "+v"(p1) : "v"(kb1), "v"(q1), "v"(sc1), "v"(scq)); }
}
__device__ __forceinline__ void xdl_pad2(f32x16& a, f32x16& b) { asm volatile("s_nop 15\n\ts_nop 7" : "+v"(a), "+v"(b)); }
template <bool FIRST> __device__ __forceinline__ void partialSM8m(f32x16& p0, f32x16& p1, float& M, f32x16& mi, float& alpha) {
  float pmax = p0[0];
#pragma unroll
  for (int r = 1; r < 16; ++r) pmax = fmaxf(pmax, p0[r]);
#pragma unroll
  for (int r = 0; r < 16; ++r) pmax = fmaxf(pmax, p1[r]);
  { auto rr = __builtin_amdgcn_permlane32_swap(__float_as_uint(pmax), __float_as_uint(pmax), false, false);
    pmax = fmaxf(__uint_as_float(rr[0]), __uint_as_float(rr[1])); }
  if (!FIRST && __builtin_expect(__all(pmax <= THR2), 1)) { alpha = 1.f; }
  else { const float d = FIRST ? pmax : fmaxf(pmax, 0.f); alpha = FIRST ? 1.f : __builtin_amdgcn_exp2f(-d); M += d;
#pragma unroll
    for (int r = 0; r < 16; ++r) { p0[r] -= d; p1[r] -= d; }
    const float nm = -M;
#pragma unroll
    for (int r = 0; r < 16; ++r) mi[r] = nm;
    asm volatile("" : "+v"(mi)); }
#pragma unroll
  for (int r = 0; r < 16; ++r) p0[r] = __builtin_amdgcn_exp2f(p0[r]);
}
__device__ __forceinline__ void finishSM8m(f32x16& p0, f32x16& p1, float alpha, float& l_reg, v8i& pa) {
#pragma unroll
  for (int r = 0; r < 16; ++r) p1[r] = __builtin_amdgcn_exp2f(p1[r]);
  float sa = p0[0], sb = p1[0];
#pragma unroll
  for (int r = 1; r < 16; ++r) { sa += p0[r]; sb += p1[r]; }
  float ps = sa + sb;
  { auto rr = __builtin_amdgcn_permlane32_swap(__float_as_uint(ps), __float_as_uint(ps), false, false);
    ps = __uint_as_float(rr[0]) + __uint_as_float(rr[1]); }
  l_reg = l_reg * alpha + ps;
  pa = (v8i){cvt4_fp8(p0[0], p0[1], p0[2], p0[3]), cvt4_fp8(p0[4], p0[5], p0[6], p0[7]), cvt4_fp8(p0[8], p0[9], p0[10], p0[11]), cvt4_fp8(p0[12], p0[13], p0[14], p0[15]),
             cvt4_fp8(p1[0], p1[1], p1[2], p1[3]), cvt4_fp8(p1[4], p1[5], p1[6], p1[7]), cvt4_fp8(p1[8], p1[9], p1[10], p1[11]), cvt4_fp8(p1[12], p1[13], p1[14], p1[15])};
}
__device__ __forceinline__ void pv8m(f32x16* o, const char* Vs, const v8i& pa, int r32, int hi, int sc1) {
#pragma unroll
  for (int d0 = 0; d0 < 4; ++d0) { const int d = 32 * d0 + r32;
    const v4i x0 = *reinterpret_cast<const v4i*>(Vs + V8ADDR(d, 2 * hi)), x1 = *reinterpret_cast<const v4i*>(Vs + V8ADDR(d, 2 * hi + 1));
    const v8i vb = __builtin_shufflevector(x0, x1, 0, 1, 2, 3, 4, 5, 6, 7);
    asm volatile("s_nop 1\n\tv_mfma_scale_f32_32x32x64_f8f6f4 %0, %1, %2, %0, %3, %3 op_sel_hi:[0,0,0]" : "+v"(o[d0]) : "v"(pa), "v"(vb), "v"(sc1)); }
}
__device__ __forceinline__ void attn_dense_body_m(const bf16* __restrict__ Qb, const unsigned char* __restrict__ Kh8, const unsigned char* __restrict__ Vt8, bf16* __restrict__ Ob, int seq, char* lds) {
  constexpr int SDEPTH = 2; constexpr size_t SHM_V8 = 8192;
  const int tid = threadIdx.x, wid = tid >> 6, lane = tid & 63, r32 = lane & 31, hi = lane >> 5;
  char* V_lds = lds; char* K_lds = lds + 2 * SHM_V8;
  float* ws = (float*)(lds + 2 * SHM_V8 + 2 * SHM_K8) + wid * 64; float* li_l = ws; float* al_l = ws + 32;
  float M = 0.f, l_reg = 0; f32x16 o[4] = {}; f32x16 mi = {}; asm volatile("" : "+v"(mi));
  v8i q8a, q8b; const int sc1 = 0x7f7f7f7f, scq = 0x7c7c7c7c;
  { bf16x8 qr[8]; const bf16* Qw = Qb + (long)(wid * QBLK + r32) * LDQ + hi * 8;
#pragma unroll
    for (int d0 = 0; d0 < 8; ++d0) qr[d0] = *reinterpret_cast<const bf16x8*>(Qw + d0 * 16);
    int w[16];
#pragma unroll
    for (int d0 = 0; d0 < 8; ++d0) { const u32x4 x = *reinterpret_cast<const u32x4*>(&qr[d0]);
      w[2 * d0] = (int)pk4_fp8(bflo(x.x) * QS8, bfhi(x.x) * QS8, bflo(x.y) * QS8, bfhi(x.y) * QS8); w[2 * d0 + 1] = (int)pk4_fp8(bflo(x.z) * QS8, bfhi(x.z) * QS8, bflo(x.w) * QS8, bfhi(x.w) * QS8); }
    q8a = (v8i){w[0], w[1], w[2], w[3], w[4], w[5], w[6], w[7]}; q8b = (v8i){w[8], w[9], w[10], w[11], w[12], w[13], w[14], w[15]}; }
  const int krow = tid >> 3, kg = tid & 7, kst = K8ADDR(krow, kg);
  const int vrow = tid >> 2, vg = tid & 3, vst = V8ADDR(vrow, vg);
  struct { v4i vs, ks; } sr_[SDEPTH];
#define SLOAD(i, k0) do { sr_[i].vs = *reinterpret_cast<const v4i*>(&Vt8[(long)((k0) / KVBLK) * 8192 + tid * 16]); sr_[i].ks = *reinterpret_cast<const v4i*>(&Kh8[(long)((k0) + krow) * 256 + kg * 16]); } while (0)
#define SWRITE(b, i) do { *(v4i*)(V_lds + (b) * SHM_V8 + vst) = sr_[i].vs; *(v4i*)(K_lds + (b) * SHM_K8 + kst) = sr_[i].ks; } while (0)
#define SWAIT() do { asm volatile("s_waitcnt vmcnt(2)" ::: "memory"); } while (0)
#define RESC(a) do { if (__any((a) < 1.f)) { if (hi == 0) al_l[r32] = (a); xdl_pad2(o[0], o[1]); xdl_pad2(o[2], o[3]); asm volatile("s_waitcnt lgkmcnt(0)" ::: "memory"); \
    _Pragma("unroll") for (int d = 0; d < 4; ++d) _Pragma("unroll") for (int r = 0; r < 16; ++r) o[d][r] *= al_l[crow(r, hi)]; } } while (0)
  f32x16 pA0, pA1, pB0, pB1; float alA, alB; v8i pa; const int NT = seq / KVBLK;
  constexpr int SE = 0, SO = SDEPTH - 1;
  SLOAD(SE, 0); asm volatile("s_waitcnt vmcnt(0)" ::: "memory"); SWRITE(0, SE); __syncthreads();
  qkt8m(pA0, pA1, mi, K_lds, q8a, q8b, r32, hi, sc1, scq); xdl_pad2(pA0, pA1); partialSM8m<true>(pA0, pA1, M, mi, alA);
  SLOAD(SO, KVBLK); if (2 < NT) SLOAD(SE, 2 * KVBLK);
  SWAIT(); SWRITE(1, SO); __syncthreads();
  for (int j = 1; j + 1 < NT; j += 2) {
    SBAR(); qkt8m(pB0, pB1, mi, K_lds + SHM_K8, q8a, q8b, r32, hi, sc1, scq);
    finishSM8m(pA0, pA1, alA, l_reg, pa); SBAR();
    SLOAD(SO, (j + SDEPTH) * KVBLK); SBAR();
    pv8m(o, V_lds, pa, r32, hi, sc1); partialSM8m<false>(pB0, pB1, M, mi, alB);
    __syncthreads(); SWAIT(); SWRITE(0, SE);
    RESC(alB); __syncthreads();
    SBAR(); qkt8m(pA0, pA1, mi, K_lds, q8a, q8b, r32, hi, sc1, scq);
    finishSM8m(pB0, pB1, alB, l_reg, pa); SBAR();
    if (j + 3 < NT) SLOAD(SE, (j + 1 + SDEPTH) * KVBLK); SBAR();
    pv8m(o, V_lds + SHM_V8, pa, r32, hi, sc1); partialSM8m<false>(pA0, pA1, M, mi, alA);
    __syncthreads(); SWAIT(); SWRITE(1, SO);
    RESC(alA); __syncthreads();
  }
  SBAR(); qkt8m(pB0, pB1, mi, K_lds + SHM_K8, q8a, q8b, r32, hi, sc1, scq);
  finishSM8m(pA0, pA1, alA, l_reg, pa); SBAR();
  pv8m(o, V_lds, pa, r32, hi, sc1); partialSM8m<false>(pB0, pB1, M, mi, alB);
  __syncthreads(); RESC(alB);
  finishSM8m(pB0, pB1, alB, l_reg, pa); SBAR();
  pv8m(o, V_lds + SHM_V8, pa, r32, hi, sc1);
  if (hi == 0) li_l[r32] = l_reg; asm volatile("s_waitcnt lgkmcnt(0)" ::: "memory");
  xdl_pad2(o[0], o[1]); xdl_pad2(o[2], o[3]);
  float rli[16];
#pragma unroll
  for (int r = 0; r < 16; ++r) rli[r] = __builtin_amdgcn_rcpf(li_l[crow(r, hi)]);
  bf16* Ow = Ob + (long)(wid * QBLK) * LDO;
#pragma unroll
  for (int r = 0; r < 16; ++r) { int orow = crow(r, hi);
#pragma unroll
    for (int d0 = 0; d0 < 4; ++d0) Ow[(long)orow * LDO + d0 * 32 + r32] = (bf16)f2bf(o[d0][r] * rli[r]); }
  __syncthreads();
#undef SLOAD
#undef SWRITE
#undef SWAIT
#undef RESC
}
__device__ __forceinline__ void mfma8_init(f32x16& p, const v8i& a, const v8i& b, const f32x16& c, int sa, int sb) {
  asm volatile("s_nop 1\n\tv_mfma_scale_f32_32x32x64_f8f6f4 %0, %1, %2, %3, %4, %5 op_sel_hi:[0,0,0]" : "=&v"(p) : "v"(a), "v"(b), "v"(c), "v"(sa), "v"(sb)); }
__device__ __forceinline__ void mfma8_acc(f32x16& p, const v8i& a, const v8i& b, int sa, int sb) {
  asm volatile("s_nop 1\n\tv_mfma_scale_f32_32x32x64_f8f6f4 %0, %1, %2, %0, %3, %4 op_sel_hi:[0,0,0]" : "+v"(p) : "v"(a), "v"(b), "v"(sa), "v"(sb)); }
__device__ __forceinline__ void attn_dense_body_i(const bf16* __restrict__ Qb, const unsigned char* __restrict__ Kh8, const unsigned char* __restrict__ Vt8, bf16* __restrict__ Ob, int seq, char* lds) {
  constexpr int SDEPTH = 2; constexpr size_t SHM_V8 = 8192;
  const int tid = threadIdx.x, wid = tid >> 6, lane = tid & 63, r32 = lane & 31, hi = lane >> 5;
  char* V_lds = lds; char* K_lds = lds + 2 * SHM_V8;
  float* ws = (float*)(lds + 2 * SHM_V8 + 2 * SHM_K8) + wid * 64; float* li_l = ws; float* al_l = ws + 32;
  float M = 0.f, l_reg = 0; f32x16 o[4] = {}; f32x16 mi = {}; asm volatile("" : "+v"(mi));
  v8i q8a, q8b; const int sc1 = 0x7f7f7f7f, scq = 0x7c7c7c7c;
  { bf16x8 qr[8]; const bf16* Qw = Qb + (long)(wid * QBLK + r32) * LDQ + hi * 8;
#pragma unroll
    for (int d0 = 0; d0 < 8; ++d0) qr[d0] = *reinterpret_cast<const bf16x8*>(Qw + d0 * 16);
    int w[16];
#pragma unroll
    for (int d0 = 0; d0 < 8; ++d0) { const u32x4 x = *reinterpret_cast<const u32x4*>(&qr[d0]);
      w[2 * d0] = (int)pk4_fp8(bflo(x.x) * QS8, bfhi(x.x) * QS8, bflo(x.y) * QS8, bfhi(x.y) * QS8); w[2 * d0 + 1] = (int)pk4_fp8(bflo(x.z) * QS8, bfhi(x.z) * QS8, bflo(x.w) * QS8, bfhi(x.w) * QS8); }
    q8a = (v8i){w[0], w[1], w[2], w[3], w[4], w[5], w[6], w[7]}; q8b = (v8i){w[8], w[9], w[10], w[11], w[12], w[13], w[14], w[15]}; }
  const int krow = tid >> 3, kg = tid & 7, kst = K8ADDR(krow, kg);
  const int vrow = tid >> 2, vg = tid & 3, vst = V8ADDR(vrow, vg);
  const int g0 = 4 * hi;
  struct { v4i vs, ks; } sr_[SDEPTH];
#define SLOAD(i, k0) do { sr_[i].vs = *reinterpret_cast<const v4i*>(&Vt8[(long)((k0) / KVBLK) * 8192 + tid * 16]); sr_[i].ks = *reinterpret_cast<const v4i*>(&Kh8[(long)((k0) + krow) * 256 + kg * 16]); } while (0)
#define SWRITE(b, i) do { *(v4i*)(V_lds + (b) * SHM_V8 + vst) = sr_[i].vs; *(v4i*)(K_lds + (b) * SHM_K8 + kst) = sr_[i].ks; } while (0)
#define SWAIT() do { asm volatile("s_waitcnt vmcnt(2)" ::: "memory"); } while (0)
#define RESC(a) do { if (__any((a) < 1.f)) { if (hi == 0) al_l[r32] = (a); xdl_pad2(o[0], o[1]); xdl_pad2(o[2], o[3]); asm volatile("s_waitcnt lgkmcnt(0)" ::: "memory"); \
    _Pragma("unroll") for (int d = 0; d < 4; ++d) _Pragma("unroll") for (int r = 0; r < 16; ++r) o[d][r] *= al_l[crow(r, hi)]; } } while (0)
#define KFRAG(D0, D1, KB, G) do { const v4i a0_ = *reinterpret_cast<const v4i*>((KB) + K8ADDR(r32, (G))), a1_ = *reinterpret_cast<const v4i*>((KB) + K8ADDR(r32, (G) + 1));             \
    const v4i b0_ = *reinterpret_cast<const v4i*>((KB) + K8ADDR(32 + r32, (G))), b1_ = *reinterpret_cast<const v4i*>((KB) + K8ADDR(32 + r32, (G) + 1));                                \
    D0 = __builtin_shufflevector(a0_, a1_, 0, 1, 2, 3, 4, 5, 6, 7); D1 = __builtin_shufflevector(b0_, b1_, 0, 1, 2, 3, 4, 5, 6, 7); } while (0)
#define VFRAG(Dv, VB, D0) do { const int d_ = 32 * (D0) + r32; const v4i x0_ = *reinterpret_cast<const v4i*>((VB) + V8ADDR(d_, 2 * hi)), x1_ = *reinterpret_cast<const v4i*>((VB) + V8ADDR(d_, 2 * hi + 1)); \
    Dv = __builtin_shufflevector(x0_, x1_, 0, 1, 2, 3, 4, 5, 6, 7); } while (0)
#define EXPR(P, LO, HI) do { _Pragma("unroll") for (int r = (LO); r < (HI); ++r) P[r] = __builtin_amdgcn_exp2f(P[r]); } while (0)
#define ATT_HALF(PB0, PB1, ALB, PA0, PA1, ALA, KB, VA, LOADSTMT) do {                                                                              \
    v8i ka_, kb_, vf_;                                                                                                                             \
    KFRAG(ka_, kb_, KB, g0); EXPR(PA1, 0, 8);                                                                                                      \
    SBAR(); mfma8_init(PB0, ka_, q8a, mi, sc1, scq); SBAR();                                                                                       \
    EXPR(PA1, 8, 16);                                                                                                                              \
    SBAR(); mfma8_init(PB1, kb_, q8a, mi, sc1, scq); SBAR();                                                                                       \
    KFRAG(ka_, kb_, KB, g0 + 2);                                                                                                                   \
    float sa_ = PA0[0], sb_ = PA0[8];                                                                                                              \
    _Pragma("unroll") for (int r = 1; r < 8; ++r) { sa_ += PA0[r]; sb_ += PA0[8 + r]; }                                                            \
    SBAR(); mfma8_acc(PB0, ka_, q8b, sc1, scq); SBAR();                                                                                            \
    VFRAG(vf_, VA, 0);                                                                                                                             \
    { float sc_ = PA1[0], sd_ = PA1[8];                                                                                                            \
      _Pragma("unroll") for (int r = 1; r < 8; ++r) { sc_ += PA1[r]; sd_ += PA1[8 + r]; }                                                          \
      float ps_ = (sa_ + sb_) + (sc_ + sd_);                                                                                                       \
      auto rr_ = __builtin_amdgcn_permlane32_swap(__float_as_uint(ps_), __float_as_uint(ps_), false, false);                                       \
      l_reg = l_reg * (ALA) + (__uint_as_float(rr_[0]) + __uint_as_float(rr_[1])); }                                                               \
    SBAR(); mfma8_acc(PB1, kb_, q8b, sc1, scq); SBAR();                                                                                            \
    pa = (v8i){cvt4_fp8(PA0[0], PA0[1], PA0[2], PA0[3]), cvt4_fp8(PA0[4], PA0[5], PA0[6], PA0[7]), cvt4_fp8(PA0[8], PA0[9], PA0[10], PA0[11]), cvt4_fp8(PA0[12], PA0[13], PA0[14], PA0[15]), \
               cvt4_fp8(PA1[0], PA1[1], PA1[2], PA1[3]), cvt4_fp8(PA1[4], PA1[5], PA1[6], PA1[7]), cvt4_fp8(PA1[8], PA1[9], PA1[10], PA1[11]), cvt4_fp8(PA1[12], PA1[13], PA1[14], PA1[15])}; \
    SBAR(); mfma8_acc(o[0], pa, vf_, sc1, sc1); SBAR();                                                                                            \
    VFRAG(vf_, VA, 1); LOADSTMT;                                                                                                                   \
    float mx_ = PB0[0];                                                                                                                            \
    _Pragma("unroll") for (int r = 1; r < 16; ++r) mx_ = fmaxf(mx_, PB0[r]);                                                                       \
    SBAR(); mfma8_acc(o[1], pa, vf_, sc1, sc1); SBAR();                                                                                            \
    VFRAG(vf_, VA, 2);                                                                                                                             \
    _Pragma("unroll") for (int r = 0; r < 16; ++r) mx_ = fmaxf(mx_, PB1[r]);                                                                       \
    { auto rr_ = __builtin_amdgcn_permlane32_swap(__float_as_uint(mx_), __float_as_uint(mx_), false, false);                                       \
      mx_ = fmaxf(__uint_as_float(rr_[0]), __uint_as_float(rr_[1])); }                                                                             \
    if (__builtin_expect(__all(mx_ <= THR2), 1)) { ALB = 1.f; }                                                                                    \
    else { const float d_ = fmaxf(mx_, 0.f); ALB = __builtin_amdgcn_exp2f(-d_); M += d_;                                                           \
      _Pragma("unroll") for (int r = 0; r < 16; ++r) { PB0[r] -= d_; PB1[r] -= d_; }                                                               \
      const float nm_ = -M;                                                                                                                        \
      _Pragma("unroll") for (int r = 0; r < 16; ++r) mi[r] = nm_;                                                                                  \
      asm volatile("" : "+v"(mi)); }                                                                                                               \
    SBAR(); mfma8_acc(o[2], pa, vf_, sc1, sc1); SBAR();                                                                                            \
    VFRAG(vf_, VA, 3); EXPR(PB0, 0, 8);                                                                                                            \
    SBAR(); mfma8_acc(o[3], pa, vf_, sc1, sc1); SBAR();                                                                                            \
    EXPR(PB0, 8, 16);                                                                                                                              \
  } while (0)
  f32x16 pA0, pA1, pB0, pB1; float alA, alB; v8i pa; const int NT = seq / KVBLK;
  constexpr int SE = 0, SO = SDEPTH - 1;
  SLOAD(SE, 0); asm volatile("s_waitcnt vmcnt(0)" ::: "memory"); SWRITE(0, SE); __syncthreads();
  qkt8m(pA0, pA1, mi, K_lds, q8a, q8b, r32, hi, sc1, scq); xdl_pad2(pA0, pA1); partialSM8m<true>(pA0, pA1, M, mi, alA);
  SLOAD(SO, KVBLK); if (2 < NT) SLOAD(SE, 2 * KVBLK);
  SWAIT(); SWRITE(1, SO); __syncthreads();
  for (int j = 1; j + 1 < NT; j += 2) {
    ATT_HALF(pB0, pB1, alB, pA0, pA1, alA, K_lds + SHM_K8, V_lds, SLOAD(SO, (j + SDEPTH) * KVBLK));
    __syncthreads(); SWAIT(); SWRITE(0, SE);
    RESC(alB); __syncthreads();
    ATT_HALF(pA0, pA1, alA, pB0, pB1, alB, K_lds, V_lds + SHM_V8, if (j + 3 < NT) SLOAD(SE, (j + 1 + SDEPTH) * KVBLK));
    __syncthreads(); SWAIT(); SWRITE(1, SO);
    RESC(alA); __syncthreads();
  }
  ATT_HALF(pB0, pB1, alB, pA0, pA1, alA, K_lds + SHM_K8, V_lds, (void)0);
  __syncthreads(); RESC(alB);
  finishSM8m(pB0, pB1, alB, l_reg, pa); SBAR();
  pv8m(o, V_lds + SHM_V8, pa, r32, hi, sc1);
  if (hi == 0) li_l[r32] = l_reg; asm volatile("s_waitcnt lgkmcnt(0)" ::: "memory");
  xdl_pad2(o[0], o[1]); xdl_pad2(o[2], o[3]);
  float rli[16];
#pragma unroll
  for (int r = 0; r < 16; ++r) rli[r] = __builtin_amdgcn_rcpf(li_l[crow(r, hi)]);
  bf16* Ow = Ob + (long)(wid * QBLK) * LDO;
#pragma unroll
  for (int r = 0; r < 16; ++r) { int orow = crow(r, hi);
#pragma unroll
    for (int d0 = 0; d0 < 4; ++d0) Ow[(long)orow * LDO + d0 * 32 + r32] = (bf16)f2bf(o[d0][r] * rli[r]); }
  __syncthreads();
#undef SLOAD
#undef SWRITE
#undef SWAIT
#undef RESC
#undef KFRAG
#undef VFRAG
#undef EXPR
#undef ATT_HALF
}
__device__ __forceinline__ void attn_dense_body_d(const bf16* __restrict__ Qb, const unsigned char* __restrict__ Kh8, const unsigned char* __restrict__ Vt8, bf16* __restrict__ Ob, int seq, LAS char* lds) {
  const int tid = threadIdx.x, wid = tid >> 6, lane = tid & 63, r32 = lane & 31, hi = lane >> 5;
  LAS char* K_lds = lds; LAS char* V_lds = lds + 4 * 8192;
  LAS float* ws = (LAS float*)(lds + 8 * 8192) + wid * 64; LAS float* li_l = ws; LAS float* al_l = ws + 32;
  float M = 0.f, l_reg = 0; f32x16 o[4] = {}; f32x16 mi = {}; asm volatile("" : "+v"(mi));
  v8i q8a, q8b; const int sc1 = 0x7f7f7f7f, scq = 0x7c7c7c7c;
  { bf16x8 qr[8]; const bf16* Qw = Qb + (long)(wid * QBLK + r32) * LDQ + hi * 8;
#pragma unroll
    for (int d0 = 0; d0 < 8; ++d0) qr[d0] = *reinterpret_cast<const bf16x8*>(Qw + d0 * 16);
    int w[16];
#pragma unroll
    for (int d0 = 0; d0 < 8; ++d0) { const u32x4 x = *reinterpret_cast<const u32x4*>(&qr[d0]);
      w[2 * d0] = (int)pk4_fp8(bflo(x.x) * QS8, bfhi(x.x) * QS8, bflo(x.y) * QS8, bfhi(x.y) * QS8); w[2 * d0 + 1] = (int)pk4_fp8(bflo(x.z) * QS8, bfhi(x.z) * QS8, bflo(x.w) * QS8, bfhi(x.w) * QS8); }
    q8a = (v8i){w[0], w[1], w[2], w[3], w[4], w[5], w[6], w[7]}; q8b = (v8i){w[8], w[9], w[10], w[11], w[12], w[13], w[14], w[15]}; }
  const int g0 = 4 * hi;
  const int kr = wid * 8 + (lane >> 3), vd = wid * 16 + (lane >> 2);
  const unsigned kgo = (unsigned)kr * 256u + (unsigned)((((lane & 7) ^ (kr >> 1)) & 7) << 4), vgo = (unsigned)vd * 64u + (unsigned)((((lane & 3) ^ (vd >> 2)) & 3) << 4);
#define DMA(blk) do { const int b_ = (blk) & 3; unsigned ko_ = (unsigned)(blk) * 16384u, vo_ = (unsigned)(blk) * 8192u; asm volatile("" : "+s"(ko_), "+s"(vo_));     \
    __builtin_amdgcn_global_load_lds((const unsigned*)(Kh8 + (size_t)(ko_ + kgo)), (LAS unsigned*)(K_lds + b_ * 8192 + wid * 1024), 16, 0, 0);                      \
    __builtin_amdgcn_global_load_lds((const unsigned*)(Vt8 + (size_t)(vo_ + vgo)), (LAS unsigned*)(V_lds + b_ * 8192 + wid * 1024), 16, 0, 0); } while (0)
#define VMW(n) asm volatile("s_waitcnt vmcnt(" #n ")" ::: "memory")
#define BAR() __builtin_amdgcn_s_barrier()
#define RESC(a) do { if (__any((a) < 1.f)) { if (hi == 0) al_l[r32] = (a); xdl_pad2(o[0], o[1]); xdl_pad2(o[2], o[3]); asm volatile("s_waitcnt lgkmcnt(0)" ::: "memory"); \
    _Pragma("unroll") for (int d = 0; d < 4; ++d) _Pragma("unroll") for (int r = 0; r < 16; ++r) o[d][r] *= al_l[crow(r, hi)]; } } while (0)
#define KFRAG(D0, D1, KB, G) do { const v4i a0_ = *reinterpret_cast<const LAS v4i*>((KB) + K8ADDR(r32, (G))), a1_ = *reinterpret_cast<const LAS v4i*>((KB) + K8ADDR(r32, (G) + 1));             \
    const v4i b0_ = *reinterpret_cast<const LAS v4i*>((KB) + K8ADDR(r32, (G)) + 4096), b1_ = *reinterpret_cast<const LAS v4i*>((KB) + K8ADDR(r32, (G) + 1) + 4096);     \
    D0 = __builtin_shufflevector(a0_, a1_, 0, 1, 2, 3, 4, 5, 6, 7); D1 = __builtin_shufflevector(b0_, b1_, 0, 1, 2, 3, 4, 5, 6, 7); } while (0)
#define VFRAG(Dv, VB, D0) do { const v4i x0_ = *reinterpret_cast<const LAS v4i*>((VB) + V8ADDR(r32, 2 * hi) + 2048 * (D0)), x1_ = *reinterpret_cast<const LAS v4i*>((VB) + V8ADDR(r32, 2 * hi + 1) + 2048 * (D0));     \
    Dv = __builtin_shufflevector(x0_, x1_, 0, 1, 2, 3, 4, 5, 6, 7); } while (0)
#define EXPR(P, LO, HI) do { _Pragma("unroll") for (int r = (LO); r < (HI); ++r) P[r] = __builtin_amdgcn_exp2f(P[r]); } while (0)
#define ATT_HALF(PB0, PB1, ALB, PA0, PA1, ALA, KB, VA, LOADSTMT) do {                                                                              \
    v8i ka_, kb_, vf_;                                                                                                                             \
    KFRAG(ka_, kb_, KB, g0); EXPR(PA1, 0, 8);                                                                                                      \
    SBAR(); __builtin_amdgcn_s_setprio(1); mfma8_init(PB0, ka_, q8a, mi, sc1, scq); __builtin_amdgcn_s_setprio(0); SBAR();                                                                                       \
    EXPR(PA1, 8, 16);                                                                                                                              \
    SBAR(); __builtin_amdgcn_s_setprio(1); mfma8_init(PB1, kb_, q8a, mi, sc1, scq); __builtin_amdgcn_s_setprio(0); SBAR();                                                                                       \
    KFRAG(ka_, kb_, KB, g0 + 2);                                                                                                                   \
    float sa_ = PA0[0], sb_ = PA0[8];                                                                                                              \
    _Pragma("unroll") for (int r = 1; r < 8; ++r) { sa_ += PA0[r]; sb_ += PA0[8 + r]; }                                                            \
    asm volatile("" : "+v"(sa_), "+v"(sb_));                                                                                                       \
    SBAR(); __builtin_amdgcn_s_setprio(1); mfma8_acc(PB0, ka_, q8b, sc1, scq); __builtin_amdgcn_s_setprio(0); SBAR();                                                                                            \
    VFRAG(vf_, VA, 0);                                                                                                                             \
    { float sc_ = PA1[0], sd_ = PA1[8];                                                                                                            \
      _Pragma("unroll") for (int r = 1; r < 8; ++r) { sc_ += PA1[r]; sd_ += PA1[8 + r]; }                                                          \
      float ps_ = (sa_ + sb_) + (sc_ + sd_);                                                                                                       \
      auto rr_ = __builtin_amdgcn_permlane32_swap(__float_as_uint(ps_), __float_as_uint(ps_), false, false);                                       \
      l_reg = l_reg * (ALA) + (__uint_as_float(rr_[0]) + __uint_as_float(rr_[1])); }                                                               \
    SBAR(); __builtin_amdgcn_s_setprio(1); mfma8_acc(PB1, kb_, q8b, sc1, scq); __builtin_amdgcn_s_setprio(0); SBAR();                                                                                            \
    pa = (v8i){cvt4_fp8(PA0[0], PA0[1], PA0[2], PA0[3]), cvt4_fp8(PA0[4], PA0[5], PA0[6], PA0[7]), cvt4_fp8(PA0[8], PA0[9], PA0[10], PA0[11]), cvt4_fp8(PA0[12], PA0[13], PA0[14], PA0[15]), \
               cvt4_fp8(PA1[0], PA1[1], PA1[2], PA1[3]), cvt4_fp8(PA1[4], PA1[5], PA1[6], PA1[7]), cvt4_fp8(PA1[8], PA1[9], PA1[10], PA1[11]), cvt4_fp8(PA1[12], PA1[13], PA1[14], PA1[15])}; \
    SBAR(); __builtin_amdgcn_s_setprio(1); mfma8_acc(o[0], pa, vf_, sc1, sc1); __builtin_amdgcn_s_setprio(0); SBAR();                                                                                            \
    VFRAG(vf_, VA, 1); LOADSTMT;                                                                                                                   \
    float mx_ = PB0[0], my_ = PB0[8];                                                                                                              \
    _Pragma("unroll") for (int r = 1; r < 8; ++r) { mx_ = fmaxf(mx_, PB0[r]); my_ = fmaxf(my_, PB0[8 + r]); }                                      \
    SBAR(); __builtin_amdgcn_s_setprio(1); mfma8_acc(o[1], pa, vf_, sc1, sc1); __builtin_amdgcn_s_setprio(0); SBAR();                                                                                            \
    VFRAG(vf_, VA, 2);                                                                                                                             \
    _Pragma("unroll") for (int r = 0; r < 8; ++r) { mx_ = fmaxf(mx_, PB1[r]); my_ = fmaxf(my_, PB1[8 + r]); }                                      \
    mx_ = fmaxf(mx_, my_);                                                                                                                         \
    { auto rr_ = __builtin_amdgcn_permlane32_swap(__float_as_uint(mx_), __float_as_uint(mx_), false, false);                                       \
      mx_ = fmaxf(__uint_as_float(rr_[0]), __uint_as_float(rr_[1])); }                                                                             \
    if (__builtin_expect(__all(mx_ <= THR2), 1)) { ALB = 1.f; }                                                                                    \
    else { const float d_ = fmaxf(mx_, 0.f); ALB = __builtin_amdgcn_exp2f(-d_); M += d_;                                                           \
      _Pragma("unroll") for (int r = 0; r < 16; ++r) { PB0[r] -= d_; PB1[r] -= d_; }                                                               \
      const float nm_ = -M;                                                                                                                        \
      _Pragma("unroll") for (int r = 0; r < 16; ++r) mi[r] = nm_;                                                                                  \
      asm volatile("" : "+v"(mi)); }                                                                                                               \
    SBAR(); __builtin_amdgcn_s_setprio(1); mfma8_acc(o[2], pa, vf_, sc1, sc1); __builtin_amdgcn_s_setprio(0); SBAR();                                                                                            \
    VFRAG(vf_, VA, 3); EXPR(PB0, 0, 8); asm volatile("" : "+v"(PB0));       \
    SBAR(); __builtin_amdgcn_s_setprio(1); mfma8_acc(o[3], pa, vf_, sc1, sc1); __builtin_amdgcn_s_setprio(0); SBAR();                                                                                            \
    EXPR(PB0, 8, 16); asm volatile("" : "+v"(PB0));                                                                                                \
  } while (0)
  f32x16 pA0, pA1, pB0, pB1; float alA, alB; v8i pa; const int NT = seq / KVBLK;
  DMA(0); DMA(1); VMW(2); BAR();
  { v8i ka_, kb_; KFRAG(ka_, kb_, K_lds, g0); mfma8_init(pA0, ka_, q8a, mi, sc1, scq); mfma8_init(pA1, kb_, q8a, mi, sc1, scq);
    KFRAG(ka_, kb_, K_lds, g0 + 2); mfma8_acc(pA0, ka_, q8b, sc1, scq); mfma8_acc(pA1, kb_, q8b, sc1, scq); }
  xdl_pad2(pA0, pA1); partialSM8m<true>(pA0, pA1, M, mi, alA);
  DMA(2); VMW(2); BAR();
  for (int j = 1; j + 1 < NT; j += 2) {
    DMA(j + 2);
    ATT_HALF(pB0, pB1, alB, pA0, pA1, alA, K_lds + (j & 3) * 8192, V_lds + ((j - 1) & 3) * 8192, (void)0);
    VMW(2); BAR(); RESC(alB);
    const bool more = j + 3 < NT;
    if (more) DMA(j + 3);
    ATT_HALF(pA0, pA1, alA, pB0, pB1, alB, K_lds + ((j + 1) & 3) * 8192, V_lds + (j & 3) * 8192, (void)0);
    if (more) VMW(2); else VMW(0);
    BAR(); RESC(alA);
  }
  ATT_HALF(pB0, pB1, alB, pA0, pA1, alA, K_lds + ((NT - 1) & 3) * 8192, V_lds + ((NT - 2) & 3) * 8192, (void)0);
  RESC(alB);
  { LAS char* Vb = V_lds + ((NT - 1) & 3) * 8192; v8i vf_;
    EXPR(pB1, 0, 16);
    float sa_ = pB0[0], sb_ = pB1[0];
#pragma unroll
    for (int r = 1; r < 16; ++r) { sa_ += pB0[r]; sb_ += pB1[r]; }
    float ps_ = sa_ + sb_;
    auto rr_ = __builtin_amdgcn_permlane32_swap(__float_as_uint(ps_), __float_as_uint(ps_), false, false);
    l_reg = l_reg * alB + (__uint_as_float(rr_[0]) + __uint_as_float(rr_[1]));
    pa = (v8i){cvt4_fp8(pB0[0], pB0[1], pB0[2], pB0[3]), cvt4_fp8(pB0[4], pB0[5], pB0[6], pB0[7]), cvt4_fp8(pB0[8], pB0[9], pB0[10], pB0[11]), cvt4_fp8(pB0[12], pB0[13], pB0[14], pB0[15]),
               cvt4_fp8(pB1[0], pB1[1], pB1[2], pB1[3]), cvt4_fp8(pB1[4], pB1[5], pB1[6], pB1[7]), cvt4_fp8(pB1[8], pB1[9], pB1[10], pB1[11]), cvt4_fp8(pB1[12], pB1[13], pB1[14], pB1[15])};
#pragma unroll
    for (int d0 = 0; d0 < 4; ++d0) { VFRAG(vf_, Vb, d0); mfma8_acc(o[d0], pa, vf_, sc1, sc1); } }
  if (hi == 0) li_l[r32] = l_reg; asm volatile("s_waitcnt lgkmcnt(0)" ::: "memory");
  xdl_pad2(o[0], o[1]); xdl_pad2(o[2], o[3]);
  float rli[16];
#pragma unroll
  for (int r = 0; r < 16; ++r) rli[r] = __builtin_amdgcn_rcpf(li_l[crow(r, hi)]);
  bf16* Ow = Ob + (long)(wid * QBLK) * LDO;
#pragma unroll
  for (int r = 0; r < 16; ++r) { int orow = crow(r, hi);
#pragma unroll
    for (int d0 = 0; d0 < 4; ++d0) Ow[(long)orow * LDO + d0 * 32 + r32] = (bf16)f2bf(o[d0][r] * rli[r]); }
  BAR();
#undef DMA
#undef VMW
#undef BAR
#undef RESC
#undef KFRAG
#undef VFRAG
#undef EXPR
#undef ATT_HALF
}
}

__device__ __forceinline__ void ph_norm3(Frame& F) {
    unsigned char* ar = F.ws + WS_ARENA;
    LAS float* RT = (LAS float*)(F.lds + 3 * 8192);
    LAS int* HIST = (LAS int*)(F.lds + 11 * 8192);
    __syncthreads();
    for (int i = F.tid; i < 2048; i += NTHR) { PV(0)[i] = modp(F, 1, 0, 2)[i] * inp(I_NORMS)[(4 + 1) * 2048 + i]; PV(1)[i] = inp(I_NORMS)[(4 + 2) * 2048 + i] * (1.f + modp(F, 1, 0, 4)[i]); PV(2)[i] = modp(F, 1, 0, 3)[i]; }
    for (int i = F.tid; i < 2048 * 8; i += NTHR) RT[(i & 7) * 2048 + (i >> 3)] = inp(I_ROUTER)[i];
    __syncthreads();
    const bf16* YO = (const bf16*)(ar + B_YO1); bf16* V1 = (bf16*)(ar + B_V1); bf16* HR = (bf16*)(F.ws + WS_HRES) + (size_t)CTX * D;
    int* RE = (int*)(ar + B_RE); float* RG = (float*)(ar + B_RG); int* CNT = (int*)(ar + B_CNT);
    for (int blk = blockIdx.x; blk < SEQ / 64; blk += F.G) {
        if (F.tid < 8) HIST[F.tid] = 0;
        __syncthreads();
        for (int rr = 0; rr < 8; ++rr) { const int t = blk * 64 + F.wave * 8 + rr; f32x4 y[8], h[8];
            ld_row_bf16(YO + (size_t)t * D, F.lane, y); ld_row_bf16(HR + (size_t)t * D, F.lane, h);
            const float ry = 1.f / sqrtf(row_sumsq(y) * (1.f / D) + EPS);
#pragma unroll
            for (int j = 0; j < 8; ++j) h[j] = h[j] + y[j] * ry * ldp(PV(0), F.lane, j);
            st_row_bf16(HR + (size_t)t * D, F.lane, h);
            const float rh = 1.f / sqrtf(row_sumsq(h) * (1.f / D) + EPS);
#pragma unroll
            for (int j = 0; j < 8; ++j) y[j] = h[j] * rh * ldp(PV(1), F.lane, j) + ldp(PV(2), F.lane, j);
            { unsigned char* V8 = (unsigned char*)V1 + (size_t)t * D;
#pragma unroll
              for (int j = 0; j < 8; ++j) *(GAS unsigned*)(V8 + 4 * F.lane + 256 * j) = pk4_fp8(y[j][0], y[j][1], y[j][2], y[j][3]); }
            float lg[8];
#pragma unroll
            for (int e = 0; e < 8; ++e) { float s = 0.f;
#pragma unroll
                for (int j = 0; j < 8; ++j) { const f32x4 w = ldp(RT + e * 2048, F.lane, j); s += (y[j][0] * w[0] + y[j][1] * w[1]) + (y[j][2] * w[2] + y[j][3] * w[3]); }
                lg[e] = wave_sum(s) + inp(I_ROUTERB)[e]; }
            if (F.lane == 0) { int e0 = 0; float v0 = lg[0];
#pragma unroll
                for (int e = 1; e < 8; ++e) if (lg[e] > v0) { v0 = lg[e]; e0 = e; }
                int e1 = -1; float v1 = -3.0e38f;
#pragma unroll
                for (int e = 0; e < 8; ++e) if (e != e0 && lg[e] > v1) { v1 = lg[e]; e1 = e; }
                const float g0 = 1.f / (1.f + __expf(v1 - v0));
                RE[2 * t] = e0; RE[2 * t + 1] = e1; RG[2 * t] = g0; RG[2 * t + 1] = 1.f - g0;
                __hip_atomic_fetch_add((int*)(HIST + e0), 1, __ATOMIC_RELAXED, __HIP_MEMORY_SCOPE_WORKGROUP); __hip_atomic_fetch_add((int*)(HIST + e1), 1, __ATOMIC_RELAXED, __HIP_MEMORY_SCOPE_WORKGROUP); }
        }
        __syncthreads();
        if (F.tid < 8) CNT[blk * 8 + F.tid] = HIST[F.tid];
        __syncthreads();
    }
}
__device__ __forceinline__ void ph_route(Frame& F) {
    unsigned char* ar = F.ws + WS_ARENA;
    LAS int* TOT = (LAS int*)(F.lds); LAS int* PRE = TOT + 8; LAS int* BASE = TOT + 16; LAS int* POS = TOT + 32;
    const int* CNT = (const int*)(ar + B_CNT); const int* RE = (const int*)(ar + B_RE); int* SLOT = (int*)(ar + B_SLOT); int* TILE = (int*)(ar + B_TILE);
    const bf16* V1 = (const bf16*)(ar + B_V1); unsigned char* VG = ar + B_VG;
    for (int blk = blockIdx.x; blk < SEQ / 64; blk += F.G) {
        __syncthreads();
        { const int e = F.wave; int tot = 0, pre = 0;
          for (int q = 0; q < 4; ++q) { const int b = 4 * F.lane + q; const int cv = CNT[b * 8 + e]; tot += cv; pre += (b < blk) ? cv : 0; }
#pragma unroll
          for (int o = 1; o < 64; o <<= 1) { tot += __shfl_xor(tot, o); pre += __shfl_xor(pre, o); }
          if (F.lane == 0) { TOT[e] = tot; PRE[e] = pre; } }
        __syncthreads();
        if (F.tid == 0) { int b = 0; for (int e = 0; e < 8; ++e) { BASE[e] = b; b += (TOT[e] + 255) / 256 * 256; } BASE[8] = b; }
        __syncthreads();
        if (F.wave == 0) { const int t = blk * 64 + F.lane; const int e0 = RE[2 * t], e1 = RE[2 * t + 1]; int p0 = 0, p1 = 0;
            const unsigned long long lt = (1ull << F.lane) - 1ull;
#pragma unroll
            for (int e = 0; e < 8; ++e) { const unsigned long long m0 = __ballot(e0 == e), m1 = __ballot(e1 == e); const int rk = __popcll(m0 & lt) + __popcll(m1 & lt);
                if (e0 == e) p0 = BASE[e] + PRE[e] + rk; if (e1 == e) p1 = BASE[e] + PRE[e] + rk; }
            SLOT[2 * t] = p0; SLOT[2 * t + 1] = p1; POS[2 * F.lane] = p0; POS[2 * F.lane + 1] = p1; }
        __syncthreads();
        for (int idx = F.tid; idx < 128 * 128; idx += NTHR) { const int ri = idx >> 7, seg = idx & 127;
            *(GAS v4u*)(VG + (size_t)POS[ri] * D + seg * 16) = *(const GAS v4u*)((const unsigned char*)V1 + (size_t)(blk * 64 + (ri >> 1)) * D + seg * 16); }
        if (blk < 8) { const int e = blk, r0 = BASE[e] + TOT[e], r1 = BASE[e + 1];
            for (int idx = F.tid; idx < (r1 - r0) * 128; idx += NTHR) *(GAS v4u*)(VG + (size_t)(r0 + (idx >> 7)) * D + (idx & 127) * 16) = (v4u){0u, 0u, 0u, 0u}; }
        if (blk == 0 && F.tid == 0) { int nt = 0; for (int e = 0; e < 8; ++e) { const int n = (BASE[e + 1] - BASE[e]) / 256; for (int q = 0; q < n; ++q) TILE[1 + nt++] = e; } TILE[0] = nt; }
    }
}
__device__ __forceinline__ void ph_norm4(Frame& F, float* out) {
    unsigned char* ar = F.ws + WS_ARENA;
    __syncthreads();
    for (int i = F.tid; i < 2048; i += NTHR) PV(0)[i] = modp(F, 1, 0, 5)[i] * inp(I_NORMS)[(4 + 3) * 2048 + i];
    __syncthreads();
    const bf16* FS = (const bf16*)(ar + B_FS); const bf16* HR = (const bf16*)(F.ws + WS_HRES) + (size_t)CTX * D; const int* SLOT = (const int*)(ar + B_SLOT); const float* RG = (const float*)(ar + B_RG);
    const int gw = F.vcu * NWAVES + F.wave, NGW = F.G * NWAVES;
    for (int t = gw; t < SEQ; t += NGW) { f32x4 a[8], b[8], h[8]; const int p0 = SLOT[2 * t], p1 = SLOT[2 * t + 1]; const float g0 = RG[2 * t], g1 = RG[2 * t + 1];
        const float* PART = (const float*)(ar + B_VG); constexpr size_t PSTR = (size_t)MOE_SPLIT_TILES * 256 * D;
        if (p0 < MOE_MAIN_TILES * 256) ld_row_bf16(FS + (size_t)p0 * D, F.lane, a);
        else { const float* pp = PART + (size_t)(p0 - MOE_MAIN_TILES * 256) * D; f32x4 q1[8], q2[8], q3[8]; ld_row_f32(pp, F.lane, a); ld_row_f32(pp + PSTR, F.lane, q1); ld_row_f32(pp + 2 * PSTR, F.lane, q2); ld_row_f32(pp + 3 * PSTR, F.lane, q3);
#pragma unroll
            for (int j = 0; j < 8; ++j) a[j] = (a[j] + q1[j]) + (q2[j] + q3[j]); }
        if (p1 < MOE_MAIN_TILES * 256) ld_row_bf16(FS + (size_t)p1 * D, F.lane, b);
        else { const float* pp = PART + (size_t)(p1 - MOE_MAIN_TILES * 256) * D; f32x4 q1[8], q2[8], q3[8]; ld_row_f32(pp, F.lane, b); ld_row_f32(pp + PSTR, F.lane, q1); ld_row_f32(pp + 2 * PSTR, F.lane, q2); ld_row_f32(pp + 3 * PSTR, F.lane, q3);
#pragma unroll
            for (int j = 0; j < 8; ++j) b[j] = (b[j] + q1[j]) + (q2[j] + q3[j]); }
        ld_row_bf16(HR + (size_t)t * D, F.lane, h);
#pragma unroll
        for (int j = 0; j < 8; ++j) a[j] = a[j] * g0 + b[j] * g1;
        const float rf = 1.f / sqrtf(row_sumsq(a) * (1.f / D) + EPS);
#pragma unroll
        for (int j = 0; j < 8; ++j) h[j] = h[j] + a[j] * rf * ldp(PV(0), F.lane, j);
        st_row_f32(out + (size_t)t * D, F.lane, h); }
}

struct EpiGateUp8 { static constexpr bool PERM = true; unsigned char* HID; int ldc; float is;
    __device__ __forceinline__ void operator()(AccRef acc, const Unit& u, int wr, int wc, int fr, int fq) const { EPI_ROWS(u); const int col0 = u.pn * 128 + wc * 32 + 8 * fq; const float c1 = -1.4426950408889634f * is, kk = is * is * MOE_HSC;
#pragma unroll
        for (int ai = 0; ai < 2; ++ai)
#pragma unroll
            for (int m = 0; m < 4; ++m) { const int row = row0 + ai * 128 + m * 16; float a[4], b[4];
#pragma unroll
                for (int q = 0; q < 4; ++q) { a[q] = __builtin_amdgcn_fmed3f(swiglu_fast(acc[ai][0][m][0][q], acc[ai][1][m][0][q], c1, kk), -448.f, 448.f);
                                              b[q] = __builtin_amdgcn_fmed3f(swiglu_fast(acc[ai][0][m][1][q], acc[ai][1][m][1][q], c1, kk), -448.f, 448.f); }
                v2u o; o.x = pk4_fp8(a[0], a[1], a[2], a[3]); o.y = pk4_fp8(b[0], b[1], b[2], b[3]);
                *(GAS v2u*)(HID + (size_t)row * ldc + col0) = o; } } };
struct EpiPlainSc { static constexpr bool PERM = true; bf16* O; int ldc; float sc;
    __device__ __forceinline__ void operator()(AccRef acc, const Unit& u, int wr, int wc, int fr, int fq) const { EPI_ROWS(u); const int col0 = u.pn * 256 + wc * 32 + 8 * fq;
#pragma unroll
        for (int ai = 0; ai < 2; ++ai)
#pragma unroll
            for (int m = 0; m < 4; ++m) { bf16* rp = O + (size_t)(row0 + ai * 128 + m * 16) * ldc + col0;
#pragma unroll
                for (int bj = 0; bj < 2; ++bj) *(GAS u32x4*)(rp + bj * 128) = pack8(acc[ai][bj][m][0] * sc, acc[ai][bj][m][1] * sc); } } };

struct EpiPart { static constexpr bool PERM = false; float* P; int pm0; float sc;
    __device__ __forceinline__ void operator()(AccRef acc, const Unit& u, int wr, int wc, int fr, int fq) const { const int row0 = (u.pm - pm0) * 256 + wr * 64 + fr, col0 = u.pn * 256 + wc * 32 + 4 * fq;
        float* base = P + (size_t)u.bz * ((size_t)MOE_SPLIT_TILES * 256 * D);
#pragma unroll
        for (int ai = 0; ai < 2; ++ai)
#pragma unroll
            for (int m = 0; m < 4; ++m) { float* rp = base + (size_t)(row0 + ai * 128 + m * 16) * D + col0;
#pragma unroll
                for (int bj = 0; bj < 2; ++bj)
#pragma unroll
                    for (int n = 0; n < 2; ++n) *(GAS f32x4*)(rp + bj * 128 + n * 16) = acc[ai][bj][m][n] * sc; } } };

enum { PH_PRO = 0, PH_N0, PH_WINE, PH_POOLD, PH_SCAN, PH_S5Y, PH_GLU, PH_WOUTE, PH_N1, PH_FFNU, PH_FFND, PH_N2,
       PH_WINO, PH_PREP, PH_GLA1, PH_GLA2, PH_GLA3, PH_ATT, PH_WOUTO, PH_N3, PH_ROUTE, PH_MOEU, PH_MOED, PH_N4, NPH };
constexpr int PH_EMIT = 100;
struct Args { const float* in[N_IN]; float* out; unsigned char* ws; int ph_lo, ph_hi, li, pad; };

__global__ void __launch_bounds__(NTHR, 2) mk_fwd(Args args) {
    extern __shared__ __attribute__((aligned(16))) unsigned char lds[];
    Frame F;
    F.lds = (LAS unsigned char*)lds; F.MISC = (volatile LAS unsigned*)(F.lds + MISC_OFF);
    F.tid = threadIdx.x; F.lane = F.tid & 63; F.wave = __builtin_amdgcn_readfirstlane(F.tid >> 6);
    F.G = gridDim.x; { const int bx = blockIdx.x; F.vcu = (F.G % 8 == 0) ? (bx % 8) * (F.G / 8) + bx / 8 : bx; }
    F.ws = karg_ws(); F.ctl = (gu32*)(F.ws + WS_CTL);
    for (int u = F.tid; u < (LDS_BYTES - LDSCTL_OFF) / 4; u += NTHR) ((LAS unsigned*)(F.lds + LDSCTL_OFF))[u] = 0u;
    __syncthreads();
    XcdBarrier bar = xcd_barrier_post((unsigned*)(F.ctl + CW_BAR) + (karg_i(2) & 7) * XCD_BAR_WORDS, F.MISC + 8);
    const int lo = karg_i(0), hi = karg_i(1);
#define IN(k) (lo <= (k) && (k) < hi)
#define SEAM(k) do { if (IN(k) && IN((k) + 1)) xcd_barrier(bar); if (PROBE_MASK) { const unsigned long long t_ = __builtin_amdgcn_s_memrealtime(); if ((PROBE_MASK >> (k)) & 1ull) pr_acc += t_ - pr_last; pr_last = t_; } } while (0)
    unsigned long long pr_last = PROBE_MASK ? __builtin_amdgcn_s_memrealtime() : 0ull, pr_acc = 0ull;
    PG8_LAS unsigned char* ring = (PG8_LAS unsigned char*)(F.lds + RING_OFF);
    unsigned char* ar = F.ws + WS_ARENA;
    const int bid = (int)blockIdx.x;

    if (lo == PH_EMIT) { ph_emit(F, karg_out()); return; }

    if (IN(PH_PRO)) { p0_prologue(F); } SEAM(PH_PRO);
    if (IN(PH_N0)) { for (int it = bid; it < S5G * 8; it += F.G) { s5_small_tables(F, it >> 3); s5_stage_b(F, it >> 3, it & 7); } ph_norm0(F); } SEAM(PH_N0);
    if (IN(PH_WINE)) {
        pg8::Gemm g{(const bf16*)(ar + A_U), (const bf16*)(F.ws + WS_WINE), D, D, D};
        pg8::PlainSched S; S.o.init(T / 256, D / 256, 1, F.G, bid); S.astr = (size_t)256 * D * 2; S.bstr = (size_t)256 * D * 2; S.zA = 0; S.zB = 0;
        EpiWinE E{(bf16*)(ar + A_ZP), (bf16*)(ar + A_AS5)};
        pg8::gemm_phase(ring, g, S, E);
        conv_work(F, 0, fill_quota(S.o.nwg, F.G, bid, 6));
    } SEAM(PH_WINE);
    if (IN(PH_POOLD)) {
        ph_pooldiff(F);
        __syncthreads();
        pg8::Gemm g{(const bf16*)(ar + A_AS5), (const bf16*)(ar + A_M1T), S5K, 1024, 1024};
        pg8::PlainSched S; S.o.init(S5ROWS / 256, 1, S5G, F.G, bid); S.astr = (size_t)256 * S5K * 2; S.bstr = 0; S.zA = (size_t)S5ROWS * S5K * 2; S.zB = (size_t)256 * 1024 * 2;
        EpiSloc E{(float*)(ar + A_SLOC)};
        pg8::gemm_phase(ring, g, S, E);
        conv_work(F, 0, fill_quota(S.o.nwg, F.G, bid, 3));
    } SEAM(PH_POOLD);
    if (IN(PH_SCAN)) {
        ph_s5scan(F);
        __syncthreads();
        pg8::Gemm g{(const bf16*)(ar + A_DP), (const bf16*)(F.ws + WS_WPOOL), WPOOL, PG, PG};
        pg8::PlainSched S; S.o.init(T / 256, 2, 4, F.G, bid); S.astr = (size_t)256 * WPOOL * 2; S.bstr = (size_t)256 * PG * 2; S.zA = (size_t)PG * 2; S.zB = (size_t)512 * PG * 2;
        EpiPool E{(bf16*)(ar + A_YMIX), inp(I_EPOOLS)};
        pg8::gemm_phase(ring, g, S, E);
        conv_work(F, 0, fill_quota(S.o.nwg, F.G, bid, 1));
    } SEAM(PH_SCAN);
    if (IN(PH_S5Y)) {
        pg8::Gemm g{(const bf16*)(ar + A_AS5), (const bf16*)(ar + A_K3T), S5K, S5K, S5K};
        pg8::PlainSched S; S.o.init(S5ROWS / 256, 4, S5G, F.G, bid); S.astr = (size_t)256 * S5K * 2; S.bstr = (size_t)256 * S5K * 2; S.zA = (size_t)S5ROWS * S5K * 2; S.zB = (size_t)1024 * S5K * 2;
        EpiS5Y E{(const bf16*)(ar + A_AS5), inp(I_S5D), (bf16*)(ar + A_YG)};
        pg8::gemm_phase(ring, g, S, E);
    } SEAM(PH_S5Y);
    if (IN(PH_GLU)) {
        pg8::Gemm g{(const bf16*)(ar + A_YG), (const bf16*)(F.ws + WS_WGLU), WS5, WS5, WS5};
        pg8::PlainSched S; S.o.init(T / 256, 2, 1, F.G, bid); S.astr = (size_t)256 * WS5 * 2; S.bstr = (size_t)256 * WS5 * 2; S.zA = 0; S.zB = 0;
        EpiGlu E{(const bf16*)(ar + A_YG), (bf16*)(ar + A_YMIX)};
        pg8::gemm_phase(ring, g, S, E);
        conv_work(F, 0, fill_quota(S.o.nwg, F.G, bid, 2));
    } SEAM(PH_GLU);
    if (IN(PH_WOUTE)) {
        pg8::Gemm g{(const bf16*)(ar + A_YMIX), (const bf16*)(F.ws + WS_WOUTE), D, D, D};
        pg8::PlainSched S; S.o.init(T / 256, D / 256, 1, F.G, bid); S.astr = (size_t)256 * D * 2; S.bstr = (size_t)256 * D * 2; S.zA = 0; S.zB = 0;
        EpiPlain E{(bf16*)(ar + A_YO), D};
        pg8::gemm_phase(ring, g, S, E);
        conv_work(F, 0, fill_quota(S.o.nwg, F.G, bid, 6));
    } SEAM(PH_WOUTE);
    if (IN(PH_N1)) { ph_norm1(F); conv_work(F, CQ_F2, 0); } SEAM(PH_N1);
    if (IN(PH_FFNU)) {
#if FFN_FP8 == 1
        pg8::Gemm g{(const bf16*)(ar + A_V), (const bf16*)(F.ws + WS_WGU), D / 2, D / 2, D / 2};
        pg8::PlainSched S; S.o.init(T / 256, 14336 / 256, 1, F.G, bid); S.astr = (size_t)256 * D; S.bstr = (size_t)256 * D; S.zA = 0; S.zB = 0;
        EpiGateUp8 E{ar + A_HID, DFF, 1.f / MOE_WSC_GU};
        pg8::gemm_phase<EpiGateUp8, pg8::PlainSched, true>(ring, g, S, E);
#elif FFN_FP8 == 2 && FFNU_K1 < 2048
        constexpr int KEQ = FFNU_K1 + (2048 - FFNU_K1) / 2;
        static_assert(FFNU_K1 % 128 == 0 && (2048 - FFNU_K1) % 256 == 0 && KEQ % 128 == 0 && FFNU_K1 % 256 == 0, "mixed-precision split");
        pg8::Gemm g{(const bf16*)(ar + A_V), (const bf16*)(F.ws + WS_WGU), KEQ, KEQ, KEQ};
        pg8::PlainSched S; S.o.init(T / 256, 14336 / 256, 1, F.G, bid); S.astr = (size_t)256 * KEQ * 2; S.bstr = (size_t)256 * KEQ * 2; S.zA = 0; S.zB = 0;
        EpiGateUp8 E{ar + A_HID, DFF, 1.f};
        pg8::gemm_phase<EpiGateUp8, pg8::PlainSched, false, FFNU_K1 / 64>(ring, g, S, E);
#elif FFN_FP8 == 2
        pg8::Gemm g{(const bf16*)(ar + A_V), (const bf16*)(F.ws + WS_WGU), D, D, D};
        pg8::PlainSched S; S.o.init(T / 256, 14336 / 256, 1, F.G, bid); S.astr = (size_t)256 * D * 2; S.bstr = (size_t)256 * D * 2; S.zA = 0; S.zB = 0;
        EpiGateUp8 E{ar + A_HID, DFF, 1.f};
        pg8::gemm_phase(ring, g, S, E);
#else
        pg8::Gemm g{(const bf16*)(ar + A_V), (const bf16*)(F.ws + WS_WGU), D, D, D};
        pg8::PlainSched S; S.o.init(T / 256, 14336 / 256, 1, F.G, bid); S.astr = (size_t)256 * D * 2; S.bstr = (size_t)256 * D * 2; S.zA = 0; S.zB = 0;
        EpiGateUp E{(bf16*)(ar + A_HID), DFF};
        pg8::gemm_phase(ring, g, S, E);
#endif
        conv_work(F, CQ_F3, fill_quota((T / 256) * (14336 / 256), F.G, bid, 6));
    } SEAM(PH_FFNU);
    if (IN(PH_FFND)) {
#if FFN_FP8
        pg8::Gemm g{(const bf16*)(ar + A_HID), (const bf16*)(F.ws + WS_WDN), DFF / 2, DFF / 2, DFF / 2};
        pg8::PlainSched S; S.o.init(T / 256, D / 256, 1, F.G, bid); S.astr = (size_t)256 * DFF; S.bstr = (size_t)256 * DFF; S.zA = 0; S.zB = 0;
        EpiPlainSc E{(bf16*)(ar + A_F), D, 1.f / (MOE_WSC_DN * MOE_HSC)};
        pg8::gemm_phase<EpiPlainSc, pg8::PlainSched, true>(ring, g, S, E);
#else
        pg8::Gemm g{(const bf16*)(ar + A_HID), (const bf16*)(F.ws + WS_WDN), DFF, DFF, DFF};
        pg8::PlainSched S; S.o.init(T / 256, D / 256, 1, F.G, bid); S.astr = (size_t)256 * DFF * 2; S.bstr = (size_t)256 * DFF * 2; S.zA = 0; S.zB = 0;
        EpiPlain E{(bf16*)(ar + A_F), D};
        pg8::gemm_phase(ring, g, S, E);
#endif
        conv_work(F, CQ_O1, fill_quota((T / 256) * (D / 256), F.G, bid, 11));
    } SEAM(PH_FFND);
    if (IN(PH_N2)) { ph_norm2(F); conv_work(F, CQ_O1, 0); } SEAM(PH_N2);
    if (IN(PH_WINO)) {
        pg8::Gemm g{(const bf16*)(ar + A_U), (const bf16*)(F.ws + WS_WINO), D, D, D};
        pg8::PlainSched S; S.o.init(T / 256, WINO_N / 256, 1, F.G, bid); S.astr = (size_t)256 * D * 2; S.bstr = (size_t)256 * D * 2; S.zA = 0; S.zB = 0;
        EpiWinO E{ar};
        pg8::gemm_phase(ring, g, S, E);
        conv_work(F, CQ_O2, fill_quota(S.o.nwg, F.G, bid, 5));
    } SEAM(PH_WINO);
    if (IN(PH_PREP)) { ph_qknorm(F); ph_vt8(F); for (int u = bid; u < NCH * 4; u += F.G) gla_prepkv_unit(F, u >> 2, u & 3); conv_work(F, 0, fill_quota(NCH * 4, F.G, bid, 4)); } SEAM(PH_PREP);
    if (IN(PH_GLA2)) { ph_gla_scan(F); } SEAM(PH_GLA2);
    if (IN(PH_GLA3)) { for (int u = bid; u < (SEQ / 64) * 4; u += F.G) gla_out_unit(F, u >> 2, u & 3); __syncthreads(); }
    if (IN(PH_ATT)) {
        for (int L = bid; L < 8 * (SEQ / 256); L += F.G) { const int h = L >> 6, qb = L & 63;
            const bf16* Q = (const bf16*)(ar + B_AQ) + (size_t)(CTX + qb * 256) * 1024 + h * 128;
            const unsigned char* Kp = ar + B_KDT + (h >> 2) * 128; const bf16* Vp = (const bf16*)(ar + B_AV) + (h >> 2) * 128;
            bf16* O = (bf16*)(ar + B_YMIX1) + (size_t)(qb * 256) * D + 1024 + h * 128;
            att::attn_dense_body_d(Q, Kp, ar + B_KDT + VT8_OFF + (size_t)(h >> 2) * NCH * 8192, O, T, (LAS char*)F.lds); }
    } SEAM(PH_ATT);
    if (IN(PH_WOUTO)) {
        pg8::Gemm g{(const bf16*)(ar + B_YMIX1), (const bf16*)(F.ws + WS_WOUTO), D, D, D};
        pg8::PlainSched S; S.o.init(SEQ / 256, D / 256, 1, F.G, bid); S.astr = (size_t)256 * D * 2; S.bstr = (size_t)256 * D * 2; S.zA = 0; S.zB = 0;
        EpiPlain E{(bf16*)(ar + B_YO1), D};
        pg8::gemm_phase(ring, g, S, E);
    } SEAM(PH_WOUTO);
    if (IN(PH_N3)) { ph_norm3(F); } SEAM(PH_N3);
    if (IN(PH_ROUTE)) { ph_route(F); conv_work(F, CQ_M2, 0); } SEAM(PH_ROUTE);
    if (IN(PH_MOEU)) {
        const int* TILE = (const int*)(ar + B_TILE); const int nt = __builtin_amdgcn_readfirstlane(TILE[0]);
        pg8::Gemm g{(const bf16*)(ar + B_VG), (const bf16*)(F.ws + WS_WMGU), D / 2, D / 2, D / 2};
        pg8::MoeSched S; S.o.init(nt, 14336 / 256, 1, F.G, bid); S.astr = (size_t)256 * D; S.bstr = (size_t)256 * D; S.zB = (size_t)14336 * D; S.tile_e = TILE + 1;
        EpiGateUp8 E{ar + B_HID2, DFF, 1.f / MOE_WSC_GU};
        pg8::gemm_phase<EpiGateUp8, pg8::MoeSched, true>(ring, g, S, E);
        conv_work(F, CQ_M3, fill_quota(S.o.nwg, F.G, bid, 5));
    } SEAM(PH_MOEU);
    if (IN(PH_MOED)) {
        const int* TILE = (const int*)(ar + B_TILE); const int nt = __builtin_amdgcn_readfirstlane(TILE[0]);
        pg8::Gemm g{(const bf16*)(ar + B_HID2), (const bf16*)(F.ws + WS_WMDN), DFF / 2, DFF / 2, DFF / 2};
        const int nmain = nt < MOE_MAIN_TILES ? nt : MOE_MAIN_TILES;
        pg8::MoeSched S; S.o.init(nmain, D / 256, 1, F.G, bid); S.astr = (size_t)256 * DFF; S.bstr = (size_t)256 * DFF; S.zB = (size_t)D * DFF; S.tile_e = TILE + 1;
        EpiPlainSc E{(bf16*)(ar + B_FS), D, 1.f / (MOE_WSC_DN * MOE_HSC)};
        pg8::gemm_phase<EpiPlainSc, pg8::MoeSched, true>(ring, g, S, E);
        if (nt > MOE_MAIN_TILES) {
            pg8::Gemm g2{(const bf16*)(ar + B_HID2), (const bf16*)(F.ws + WS_WMDN), DFF / 2, DFF / 2, DFF / 8};
            pg8::MoeSplitSched S2; S2.pm0 = MOE_MAIN_TILES; S2.nun = (nt - MOE_MAIN_TILES) * 32; S2.G = F.G; S2.c = bid; S2.astr = (size_t)256 * DFF; S2.bstr = (size_t)256 * DFF; S2.zB = (size_t)D * DFF; S2.kslice = DFF / 4; S2.tile_e = TILE + 1;
            EpiPart E2{(float*)(ar + B_VG), MOE_MAIN_TILES, 1.f / (MOE_WSC_DN * MOE_HSC)};
            pg8::gemm_phase<EpiPart, pg8::MoeSplitSched, true>(ring, g2, S2, E2);
        }
    } SEAM(PH_MOED);
    if (IN(PH_N4)) { ph_norm4(F, karg_out()); }
    if (PROBE_MASK) { const unsigned long long t_ = __builtin_amdgcn_s_memrealtime(); if ((PROBE_MASK >> PH_N4) & 1ull) pr_acc += t_ - pr_last;
        const unsigned long long te_ = t_ + (unsigned long long)PROBE_K * pr_acc; while (__builtin_amdgcn_s_memrealtime() < te_) __builtin_amdgcn_s_sleep(16); }
#undef IN
#undef SEAM
}

extern "C" void kernel_launch(void* const* d_in, const int* in_sizes, int n_in, void* d_out, int out_size, void* d_ws, size_t ws_size, hipStream_t stream) {
    static int grid = 0;
    if (grid == 0) {
        if (n_in != N_IN || out_size != SEQ * D || ws_size < WS_NEED) { fprintf(stderr, "kernel_launch: shape/workspace mismatch (n_in %d out %d ws %zu need %zu)\n", n_in, out_size, ws_size, (size_t)WS_NEED); grid = -1; return; }
        int dev = 0, cus = 0, per_cu = 0;
        if (hipGetDevice(&dev) != hipSuccess || hipDeviceGetAttribute(&cus, hipDeviceAttributeMultiprocessorCount, dev) != hipSuccess) { grid = -1; return; }
        if (hipFuncSetAttribute((const void*)mk_fwd, hipFuncAttributeMaxDynamicSharedMemorySize, LDS_BYTES) != hipSuccess) { fprintf(stderr, "kernel_launch: hipFuncSetAttribute failed\n"); grid = -1; return; }
        if (hipOccupancyMaxActiveBlocksPerMultiprocessor(&per_cu, (const void*)mk_fwd, NTHR, LDS_BYTES) != hipSuccess || per_cu < 1) { fprintf(stderr, "kernel_launch: occupancy query says %d\n", per_cu); }
        (void)hipGetLastError();
        grid = cus;
    }
    if (grid < 0) return;
    (void)hipMemsetAsync((char*)d_ws + WS_CTL, 0, CTL_ZERO_BYTES, stream);
    Args a{};
    for (int i = 0; i < N_IN; ++i) a.in[i] = (const float*)d_in[i];
    a.out = (float*)d_out; a.ws = (unsigned char*)d_ws; a.pad = 0;
    const int last = (MK_STOP < NPH - 1) ? MK_STOP : NPH - 1;
#if MK_SPLIT
    for (int p = 0; p <= last; ++p) { a.ph_lo = p; a.ph_hi = p + 1; a.li = p; hipLaunchKernelGGL(mk_fwd, dim3(grid), dim3(NTHR), LDS_BYTES, stream, a); }
#else
    a.ph_lo = 0; a.ph_hi = last + 1; a.li = 0; hipLaunchKernelGGL(mk_fwd, dim3(grid), dim3(NTHR), LDS_BYTES, stream, a);
#endif
    if (last < NPH - 1) { a.ph_lo = PH_EMIT; a.ph_hi = PH_EMIT + 1; a.li = 7; hipLaunchKernelGGL(mk_fwd, dim3(grid), dim3(NTHR), LDS_BYTES, stream, a); }
    const hipError_t le = hipPeekAtLastError();
    if (le != hipSuccess) fprintf(stderr, "kernel_launch: launch failed: %s\n", hipGetErrorName(le));
}
```

```cpp
#include <hip/hip_runtime.h>
#include <cstdio>
#include <cstdint>

#ifndef PROBE_MASK
#define PROBE_MASK 0ull
#define PROBE_K 1
#endif
#ifndef MK_STOP
#define MK_STOP 99
#endif
#ifndef FFN_FP8
#define FFN_FP8 2
#endif
#ifndef FFNU_K1
#define FFNU_K1 1024
#endif
#ifndef MK_SPLIT
#define MK_SPLIT 0
#endif

namespace pg8 {
#define PG8_LAS __attribute__((address_space(3)))
typedef unsigned short bf16_t;
typedef short bf16x8 __attribute__((ext_vector_type(8)));
typedef float f32x4 __attribute__((ext_vector_type(4)));
typedef unsigned u32x4 __attribute__((ext_vector_type(4)));
typedef int v4i __attribute__((ext_vector_type(4)));
typedef int v8i __attribute__((ext_vector_type(8)));
constexpr int BM = 256, BK = 64, HALF = 128, HTB = HALF * BK * 2, STAGE_BYTES = 8 * HTB, NXCD = 8, WGM = 8;

__host__ __device__ __forceinline__ int lds_byte(int r, int c) { const int st = (r >> 4) * 2 + (c >> 5), rr = r & 15, cc = c & 31, ob = rr * 64 + cc * 2; return st * 1024 + (ob ^ (((ob >> 9) & 1) << 5)); }
__host__ __device__ __forceinline__ void stage_rc(int b, int& R, int& C) { const int st = b / 1024, sb = b % 1024, swz = sb ^ (((sb >> 9) & 1) << 5); R = (st >> 1) * 16 + swz / 64; C = (st & 1) * 32 + (swz % 64) / 2; }
__host__ __device__ __forceinline__ int perm32(int rho) { const int n = rho >> 4, i = rho & 15; return 8 * (i >> 2) + 4 * n + (i & 3); }

struct Unit { int pm, pn, bz; unsigned aoff, boff; };
struct Gemm { const bf16_t* A; const bf16_t* Bt; int lda, ldb, K; };

struct TileOrder {
    int nM, nN, nB, nwg, G, c;
    __device__ void init(int nM_, int nN_, int nB_, int G_, int c_) { nM = nM_; nN = nN_; nB = nB_; nwg = nM * nN * nB; G = G_; c = c_; }
    __device__ bool decode(int i, int& bz, int& pm, int& pn) const {
        const long L = (long)i * G + c; if (L >= nwg) return false;
        int wgid = (int)L; { const int q = nwg / NXCD, r = nwg % NXCD, xcd = wgid % NXCD, off = wgid / NXCD; wgid = (xcd < r ? xcd * (q + 1) : r * (q + 1) + (xcd - r) * q) + off; }
        const int per = nM * nN; bz = wgid / per; const int w = wgid - bz * per;
        const int nig = WGM * nN, gid = w / nig, fm = gid * WGM, gsz = (nM - fm) < WGM ? (nM - fm) : WGM;
        pm = fm + ((w % nig) % gsz); pn = (w % nig) / gsz; return true;
    }
};
struct PlainSched {
    TileOrder o; size_t astr, bstr, zA, zB;
    __device__ bool next(int i, Unit& u) const { if (!o.decode(i, u.bz, u.pm, u.pn)) return false; u.aoff = (unsigned)((size_t)u.bz * zA + (size_t)u.pm * astr); u.boff = (unsigned)((size_t)u.bz * zB + (size_t)u.pn * bstr); return true; }
};
struct MoeSched {
    TileOrder o; size_t astr, bstr, zB; const int* tile_e;
    __device__ bool next(int i, Unit& u) const { int bz; if (!o.decode(i, bz, u.pm, u.pn)) return false; u.bz = __builtin_amdgcn_readfirstlane(tile_e[u.pm]); u.aoff = (unsigned)((size_t)u.pm * astr); u.boff = (unsigned)((size_t)u.bz * zB + (size_t)u.pn * bstr); return true; }
};

struct MoeSplitSched {
    int pm0, nun, G, c; size_t astr, bstr, zB; unsigned kslice; const int* tile_e;
    __device__ bool next(int i, Unit& u) const { const long L = (long)i * G + c; if (L >= nun) return false; const int l = (int)L, ks = l & 3, pn = (l >> 2) & 7, pm = pm0 + (l >> 5);
        u.pm = pm; u.pn = pn; u.bz = ks; const int e = __builtin_amdgcn_readfirstlane(tile_e[pm]);
        u.aoff = (unsigned)((size_t)pm * astr + (size_t)ks * kslice); u.boff = (unsigned)((size_t)e * zB + (size_t)pn * bstr + (size_t)ks * kslice); return true; }
};
__device__ __forceinline__ unsigned cvt_pk_bf16(float lo, float hi) { unsigned r; asm volatile("v_cvt_pk_bf16_f32 %0, %1, %2" : "=v"(r) : "v"(lo), "v"(hi)); return r; }
__device__ __forceinline__ u32x4 pack8(const f32x4& a, const f32x4& b) { u32x4 w; w.x = cvt_pk_bf16(a[0], a[1]); w.y = cvt_pk_bf16(a[2], a[3]); w.z = cvt_pk_bf16(b[0], b[1]); w.w = cvt_pk_bf16(b[2], b[3]); return w; }

template <class Epi, class Sched, bool FP8 = false, int MIXT = -1>
__device__ __forceinline__ void gemm_phase(PG8_LAS unsigned char* lds, const Gemm g, const Sched& S, const Epi& E) {
    const int tid = threadIdx.x, wid = __builtin_amdgcn_readfirstlane(tid >> 6), lane = tid & 63, wr = wid >> 2, wc = wid & 3, fr = lane & 15, fq = lane >> 4;
    const int K = g.K, nt = K / BK;
    unsigned voffA[2], voffB[2];
#pragma unroll
    for (int i = 0; i < 2; ++i) { int R, C; stage_rc(tid * 16 + i * 8192, R, C); const int Rb = Epi::PERM ? ((R & ~31) + perm32(R & 31)) : R;
        voffA[i] = (unsigned)(R * g.lda + C) * 2u; voffB[i] = (unsigned)(Rb * g.ldb + C) * 2u; }
    const unsigned kstep = (unsigned)(BK * 2);
    const unsigned hstepA = (unsigned)HALF * (unsigned)g.lda * 2u, hstepB = (unsigned)HALF * (unsigned)g.ldb * 2u;
    const unsigned ldsw = (unsigned)wid * 1024u;
    const int aoff = lds_byte(wr * 64 + fr, fq * 8), boff = lds_byte(wc * 32 + fr, fq * 8);
    const char* const gA = (const char*)g.A; const char* const gB = (const char*)g.Bt;
#define PG8_SA(b, h) (((b) * 2 + (h)) * HTB)
#define PG8_SB(b, h) ((4 + (b) * 2 + (h)) * HTB)
#define PG8_STAGE(bufoff, gbase, soff, voff) do { _Pragma("unroll") for (int _i = 0; _i < 2; ++_i) \
        __builtin_amdgcn_global_load_lds((const unsigned*)((gbase) + (size_t)((soff) + (voff)[_i])), (PG8_LAS unsigned*)(lds + (bufoff) + ldsw + _i * 8192), 16, 0, 0); } while (0)
#define PG8_LDA(dst, b, h) do { _Pragma("unroll") for (int m = 0; m < 4; ++m) _Pragma("unroll") for (int k = 0; k < 2; ++k) dst[m][k] = *(const PG8_LAS bf16x8*)(lds + PG8_SA(b, h) + aoff + m * 2048 + k * 1024); } while (0)
#define PG8_LDB(dst, b, h) do { _Pragma("unroll") for (int n = 0; n < 2; ++n) _Pragma("unroll") for (int k = 0; k < 2; ++k) dst[n][k] = *(const PG8_LAS bf16x8*)(lds + PG8_SB(b, h) + boff + n * 2048 + k * 1024); } while (0)
#define PG8_CAT(x) __builtin_shufflevector(__builtin_bit_cast(v4i, (x)[0]), __builtin_bit_cast(v4i, (x)[1]), 0, 1, 2, 3, 4, 5, 6, 7)
#define PG8_MMA(ai, bj, At, Bt, IS8) do { __builtin_amdgcn_s_setprio(1); \
        if constexpr (MIXT >= 0) { if (IS8) { \
            _Pragma("unroll") for (int m = 0; m < 4; ++m) { const v8i a8 = PG8_CAT(At[m]); _Pragma("unroll") for (int n = 0; n < 2; ++n) { const v8i b8 = PG8_CAT(Bt[n]); \
                asm volatile("s_nop 1\n\tv_mfma_scale_f32_16x16x128_f8f6f4 %0, %1, %2, %0, %3, %4 op_sel_hi:[0,0,0]" : "+v"(acc[ai][bj][m][n]) : "v"(b8), "v"(a8), "v"(scw), "v"(sc1)); } } \
          } else { _Pragma("unroll") for (int m = 0; m < 4; ++m) _Pragma("unroll") for (int n = 0; n < 2; ++n) _Pragma("unroll") for (int k = 0; k < 2; ++k) \
            acc[ai][bj][m][n] = __builtin_amdgcn_mfma_f32_16x16x32_bf16(Bt[n][k], At[m][k], acc[ai][bj][m][n], 0, 0, 0); } \
        } else if constexpr (FP8) {   \
            _Pragma("unroll") for (int m = 0; m < 4; ++m) { const v8i a8 = PG8_CAT(At[m]); _Pragma("unroll") for (int n = 0; n < 2; ++n) { const v8i b8 = PG8_CAT(Bt[n]); \
                  \
                asm volatile("s_nop 1\n\tv_mfma_scale_f32_16x16x128_f8f6f4 %0, %1, %2, %0, %3, %3 op_sel_hi:[0,0,0]" : "+v"(acc[ai][bj][m][n]) : "v"(b8), "v"(a8), "v"(sc1)); } } \
        } else { _Pragma("unroll") for (int m = 0; m < 4; ++m) _Pragma("unroll") for (int n = 0; n < 2; ++n) _Pragma("unroll") for (int k = 0; k < 2; ++k) \
            acc[ai][bj][m][n] = __builtin_amdgcn_mfma_f32_16x16x32_bf16(Bt[n][k], At[m][k], acc[ai][bj][m][n], 0, 0, 0); } \
        __builtin_amdgcn_s_setprio(0); } while (0)
#define PG8_WAIT_V(n) asm volatile("s_waitcnt vmcnt(" #n ")" ::: "memory")
#define PG8_WAIT_L(n) asm volatile("s_waitcnt lgkmcnt(" #n ")" ::: "memory")
#define PG8_BAR __builtin_amdgcn_s_barrier()
#define PG8_SCHED __builtin_amdgcn_sched_barrier(0)
    Unit cur, nxt; int ui = 0;
    if (!S.next(0, cur)) return;
    const int sc1 = 0x7f7f7f7f, scw = 0x79797979;
    f32x4 acc[2][2][4][2];
#pragma unroll
    for (int a = 0; a < 2; ++a)
#pragma unroll
        for (int b = 0; b < 2; ++b)
#pragma unroll
            for (int m = 0; m < 4; ++m)
#pragma unroll
                for (int n = 0; n < 2; ++n) acc[a][b][m][n] = (f32x4){0.f, 0.f, 0.f, 0.f};
    bf16x8 At[4][2], B0[2][2], B1[2][2];
    unsigned cA = cur.aoff, cB = cur.boff;
    PG8_STAGE(PG8_SB(0, 0), gB, cB, voffB); PG8_STAGE(PG8_SB(0, 1), gB, cB + hstepB, voffB); PG8_STAGE(PG8_SA(0, 0), gA, cA, voffA); PG8_STAGE(PG8_SA(0, 1), gA, cA + hstepA, voffA);
    if (wr == 1) PG8_BAR;
    PG8_WAIT_V(2); PG8_BAR;
    PG8_STAGE(PG8_SB(1, 0), gB, cB + kstep, voffB); PG8_STAGE(PG8_SA(1, 0), gA, cA + kstep, voffA); PG8_STAGE(PG8_SB(1, 1), gB, cB + hstepB + kstep, voffB);
    PG8_WAIT_V(6); PG8_BAR;
    for (;;) {
        const bool has_next = S.next(ui + 1, nxt);
        const unsigned nA = has_next ? nxt.aoff : cA, nB = has_next ? nxt.boff : cB;
#define PG8_KBODY(IS8) do { \
            const bool last = (t == nt - 2); \
            const unsigned a1 = cA + (unsigned)(t + 1) * kstep; \
            const unsigned a2 = last ? nA : cA + (unsigned)(t + 2) * kstep, b2 = last ? nB : cB + (unsigned)(t + 2) * kstep; \
            const unsigned a3 = a2 + kstep, b3 = b2 + kstep; \
            PG8_LDB(B0, 0, 0); PG8_LDB(B1, 0, 1); PG8_SCHED; PG8_LDA(At, 0, 0); PG8_STAGE(PG8_SA(1, 1), gA, a1 + hstepA, voffA); \
            PG8_WAIT_V(8); PG8_WAIT_L(0); PG8_BAR; PG8_MMA(0, 0, At, B0, IS8); PG8_MMA(0, 1, At, B1, IS8); PG8_BAR; PG8_SCHED; \
            PG8_LDA(At, 0, 1); PG8_STAGE(PG8_SB(0, 0), gB, b2, voffB); PG8_STAGE(PG8_SB(0, 1), gB, b2 + hstepB, voffB); PG8_STAGE(PG8_SA(0, 0), gA, a2, voffA); \
            PG8_WAIT_V(8); PG8_WAIT_L(0); PG8_BAR; PG8_MMA(1, 0, At, B0, IS8); PG8_MMA(1, 1, At, B1, IS8); PG8_BAR; PG8_SCHED; \
            PG8_LDB(B0, 1, 0); PG8_LDB(B1, 1, 1); PG8_SCHED; PG8_LDA(At, 1, 0); PG8_STAGE(PG8_SA(0, 1), gA, a2 + hstepA, voffA); \
            PG8_WAIT_V(8); PG8_WAIT_L(0); PG8_BAR; PG8_MMA(0, 0, At, B0, IS8); PG8_MMA(0, 1, At, B1, IS8); PG8_BAR; PG8_SCHED; \
            PG8_LDA(At, 1, 1); PG8_STAGE(PG8_SB(1, 0), gB, b3, voffB); PG8_STAGE(PG8_SB(1, 1), gB, b3 + hstepB, voffB); PG8_STAGE(PG8_SA(1, 0), gA, a3, voffA); \
            PG8_WAIT_V(8); PG8_WAIT_L(0); PG8_BAR; PG8_MMA(1, 0, At, B0, IS8); PG8_MMA(1, 1, At, B1, IS8); PG8_BAR; PG8_SCHED; \
        } while (0)
        if constexpr (MIXT >= 0) {
#pragma unroll 1
            for (int t = 0; t < MIXT; t += 2) PG8_KBODY(false);
#pragma unroll 1
            for (int t = MIXT; t < nt; t += 2) PG8_KBODY(true);
        } else {
#pragma unroll 1
            for (int t = 0; t < nt; t += 2) PG8_KBODY(false);
        }
#undef PG8_KBODY
        if constexpr (FP8 || MIXT >= 0) {
            asm volatile("s_nop 15" : "+v"(acc[0][0][0][0]), "+v"(acc[0][0][0][1]), "+v"(acc[0][0][1][0]), "+v"(acc[0][0][1][1]), "+v"(acc[0][0][2][0]), "+v"(acc[0][0][2][1]), "+v"(acc[0][0][3][0]), "+v"(acc[0][0][3][1]),
                                      "+v"(acc[0][1][0][0]), "+v"(acc[0][1][0][1]), "+v"(acc[0][1][1][0]), "+v"(acc[0][1][1][1]), "+v"(acc[0][1][2][0]), "+v"(acc[0][1][2][1]), "+v"(acc[0][1][3][0]), "+v"(acc[0][1][3][1]));
            asm volatile("" : "+v"(acc[1][0][0][0]), "+v"(acc[1][0][0][1]), "+v"(acc[1][0][1][0]), "+v"(acc[1][0][1][1]), "+v"(acc[1][0][2][0]), "+v"(acc[1][0][2][1]), "+v"(acc[1][0][3][0]), "+v"(acc[1][0][3][1]),
                              "+v"(acc[1][1][0][0]), "+v"(acc[1][1][0][1]), "+v"(acc[1][1][1][0]), "+v"(acc[1][1][1][1]), "+v"(acc[1][1][2][0]), "+v"(acc[1][1][2][1]), "+v"(acc[1][1][3][0]), "+v"(acc[1][1][3][1]));
        }
        if (wr == 0) PG8_BAR;
        E(acc, cur, wr, wc, fr, fq);
        if (!has_next) break;
#pragma unroll
        for (int a = 0; a < 2; ++a)
#pragma unroll
            for (int b = 0; b < 2; ++b)
#pragma unroll
                for (int m = 0; m < 4; ++m)
#pragma unroll
                    for (int n = 0; n < 2; ++n) acc[a][b][m][n] = (f32x4){0.f, 0.f, 0.f, 0.f};
        cur = nxt; cA = nA; cB = nB; ++ui;
        if (wr == 1) PG8_BAR;
    }
    PG8_WAIT_V(0);
    PG8_BAR;
#undef PG8_SA
#undef PG8_SB
#undef PG8_STAGE
#undef PG8_LDA
#undef PG8_LDB
#undef PG8_MMA
#undef PG8_CAT
#undef PG8_WAIT_V
#undef PG8_WAIT_L
#undef PG8_BAR
#undef PG8_SCHED
}
}

constexpr int D = 2048, SEQ = 16384, CTX = 256, T = SEQ + CTX, DFF = 7168, NEXP = 8;
constexpr int NWAVES = 8, NTHR = 512;
constexpr int WPOOL = 1536, WS5 = 512, PG = 384, S5G = 32, S5P = 64, S5N = 16, LC = 64, NCH = T / LC  , NCH_CTX = CTX / LC  ;
constexpr int S5ROWS = 512, S5K = 1280;
constexpr int WINO_N = 4864;
constexpr float EPS = 1e-6f;
constexpr float MOE_WSC_GU = 64.f, MOE_WSC_DN = 128.f, MOE_HSC = 4.f;

enum { I_X = 0, I_C, I_CTX, I_CCTX, I_WMOD, I_BMOD, I_NORMS, I_EWIN, I_EPOOLW, I_EPOOLS, I_LAMRE, I_LAMIM, I_LOGDT, I_BRE, I_BIM, I_CRE, I_CIM, I_S5D, I_WGLU, I_EWOUT,
       I_FFG, I_FFU, I_FFD, I_OWIN, I_GLAWA, I_GLABA, I_GLANORM, I_QNORM, I_KNORM, I_OWOUT, I_ROUTER, I_ROUTERB, I_MOEG, I_MOEU, I_MOED, N_IN };

constexpr size_t MiB = 1u << 20;
constexpr size_t al256(size_t x) { return (x + 255) / 256 * 256; }
constexpr size_t WS_CTL = 0, CTL_ZERO_BYTES = 128 * 1024;
constexpr size_t WS_MODF = 1 * MiB;
constexpr size_t WS_ROPE = WS_MODF + al256(2 * 2 * 6 * 2048 * 4);
constexpr size_t WS_W0 = 2 * MiB;
constexpr size_t SZ_WINE = (size_t)2048 * 2048 * 2, SZ_WPOOL = (size_t)4 * 512 * 384 * 2, SZ_WGLU = (size_t)512 * 512 * 2, SZ_WGU = (size_t)14336 * 2048 * 2,
                 SZ_WDN = (size_t)2048 * 7168 * 2, SZ_WINO = (size_t)WINO_N * 2048 * 2;
constexpr size_t WS_WINE = WS_W0, WS_WPOOL = WS_WINE + SZ_WINE, WS_WGLU = WS_WPOOL + SZ_WPOOL, WS_WOUTE = WS_WGLU + SZ_WGLU, WS_WGU = WS_WOUTE + SZ_WINE,
                 WS_WDN = WS_WGU + SZ_WGU, WS_WINO = WS_WDN + SZ_WDN, WS_WOUTO = WS_WINO + SZ_WINO, WS_WMGU = WS_WOUTO + SZ_WINE, WS_WMDN = WS_WMGU + 8 * SZ_WGU,
                 WS_HRES = WS_WMDN + 8 * SZ_WDN;
constexpr size_t SZ_HRES = (size_t)T * D * 4;
constexpr size_t WS_ARENA = WS_HRES + SZ_HRES;
constexpr size_t SZ_ROWB = (size_t)T * D * 2;
constexpr size_t A_U = 0, A_ZP = A_U + SZ_ROWB, SZ_ZP = (size_t)T * WPOOL * 2, A_DP = A_ZP + SZ_ZP, A_AS5 = A_DP + SZ_ZP, SZ_AS5 = (size_t)S5G * S5ROWS * S5K * 2,
                 A_SLOC = A_AS5 + SZ_AS5, SZ_SLOC = (size_t)S5G * S5ROWS * 256 * 4, A_YG = A_SLOC + SZ_SLOC, SZ_YG = (size_t)T * WS5 * 2, A_YMIX = A_YG + SZ_YG,
                 A_YO = A_YMIX + SZ_ROWB, A_V = A_YO + SZ_ROWB, A_HID = A_V + SZ_ROWB, SZ_HID = (size_t)T * DFF * 2, A_F = A_HID + SZ_HID,
                 A_M1T = A_F + SZ_ROWB, SZ_M1T = (size_t)S5G * 256 * 1024 * 2, A_K3T = A_M1T + SZ_M1T, SZ_K3T = (size_t)S5G * 1024 * S5K * 2,
                 A_TBG = A_K3T + SZ_K3T, SZ_TBG = (size_t)S5G * 2 * 64 * 256 * 4, A_L0_END = A_TBG + SZ_TBG;
constexpr size_t WS_END_L0 = WS_ARENA + A_L0_END;
constexpr int MOE_ROWS = 2 * SEQ + NEXP * 256;
constexpr int MOE_MAIN_TILES = 128, MOE_SPLIT_TILES = MOE_ROWS / 256 - 128;
static_assert((size_t)4 * MOE_SPLIT_TILES * 256 * D * 4 <= (size_t)MOE_ROWS * D * 2, "split-K partials fit in the (dead) VG region");
constexpr size_t SZ_T512 = (size_t)T * 512 * 2, SZ_T1024 = (size_t)T * 1024 * 2, SZ_T256 = (size_t)T * 256 * 2, SZ_SEQB = (size_t)SEQ * D * 2;
constexpr size_t B_GQ = A_U + SZ_ROWB, B_GK = B_GQ + SZ_T512, B_GV = B_GK + SZ_T512, B_R = B_GV + SZ_T1024, B_AQ = B_R + SZ_T1024, B_AK = B_AQ + SZ_T1024, B_AV = B_AK + SZ_T256,
                 B_ALR = B_AV + SZ_T256, B_QE = B_ALR + al256((size_t)T * 16 * 4), B_KE = B_QE + 2 * SZ_T512, B_KDT = B_KE + 2 * SZ_T512, B_VT = B_KDT + 2 * SZ_T512,
                 B_DEC = B_VT + SZ_T1024, B_ST = B_DEC + al256((size_t)2 * NCH * 4 * 128 * 4), SZ_ST = (size_t)2 * NCH * 4 * 256 * 128 * 2, B_YMIX1 = B_ST + SZ_ST,
                 B_YO1 = B_YMIX1 + SZ_SEQB, B_REGA_END = B_YO1 + SZ_SEQB;
constexpr size_t B_HID2 = 0, SZ_HID2 = (size_t)MOE_ROWS * DFF * 2, B_FS = B_HID2 + SZ_HID2, SZ_FS = (size_t)MOE_ROWS * D * 2, B_OVL_END = B_FS + SZ_FS;
constexpr size_t B_REGB = al256(B_REGA_END > B_OVL_END ? B_REGA_END : B_OVL_END);
constexpr size_t B_V1 = B_REGB, B_VG = B_V1 + SZ_SEQB, B_RE = B_VG + SZ_FS, B_RG = B_RE + (size_t)SEQ * 8, B_SLOT = B_RG + (size_t)SEQ * 8, B_CNT = B_SLOT + (size_t)SEQ * 8,
                 B_TILE = B_CNT + 256 * 8 * 4, B_L1_END = B_TILE + 4096;
constexpr size_t WS_END_L1 = WS_ARENA + B_L1_END;
constexpr size_t WS_NEED = WS_END_L0 > WS_END_L1 ? WS_END_L0 : WS_END_L1;
static_assert(WS_NEED <= (size_t)1879048192, "workspace map exceeds the guaranteed size");

constexpr int CW_TMO = 0, CW_CODE = 1, CW_BAR = 4096;

#define GAS __attribute__((address_space(1)))
#define LAS __attribute__((address_space(3)))
typedef unsigned short bf16;
typedef unsigned v4u __attribute__((ext_vector_type(4)));
typedef unsigned v2u __attribute__((ext_vector_type(2)));
typedef float f32x4 __attribute__((ext_vector_type(4)));
typedef float f32x2 __attribute__((ext_vector_type(2)));
typedef short bf16x8 __attribute__((ext_vector_type(8)));
typedef GAS unsigned gu32;
#define RLX_AGENT __ATOMIC_RELAXED, __HIP_MEMORY_SCOPE_AGENT
#define LDS_WAIT() asm volatile("s_waitcnt lgkmcnt(0)" ::: "memory")
#define VM_WAIT() asm volatile("s_waitcnt vmcnt(0)" ::: "memory")
__device__ __forceinline__ unsigned f2bf(float f) { unsigned u = __builtin_bit_cast(unsigned, f); return (u + 0x7fffu + ((u >> 16) & 1u)) >> 16; }
typedef __bf16 bf16x2_t __attribute__((ext_vector_type(2)));
__device__ __forceinline__ unsigned pk2(float lo, float hi) { const f32x2 v = {lo, hi}; return __builtin_bit_cast(unsigned, __builtin_convertvector(v, bf16x2_t)); }
__device__ __forceinline__ float bflo(unsigned w) { return __builtin_bit_cast(float, w << 16); }
__device__ __forceinline__ float bfhi(unsigned w) { return __builtin_bit_cast(float, w & 0xffff0000u); }
__device__ __forceinline__ float bf2f(bf16 b) { return __builtin_bit_cast(float, (unsigned)b << 16); }
__device__ __forceinline__ float sigmoidf_(float x) { return __builtin_amdgcn_rcpf(1.f + __expf(-x)); }
__device__ __forceinline__ float siluf_(float x) { return x * __builtin_amdgcn_rcpf(1.f + __expf(-x)); }
__device__ __forceinline__ float swiglu_fast(float ag, float au, float negsg_log2e, float kk) { const float e = __builtin_amdgcn_exp2f(ag * negsg_log2e); return (ag * au) * (kk * __builtin_amdgcn_rcpf(1.f + e)); }
__device__ __forceinline__ float gelu_tanh(float y) { const float z = 0.7978845608028654f * (y + 0.044715f * y * y * y); const float e = __expf(2.f * z); const float th = 1.f - 2.f * __builtin_amdgcn_rcpf(e + 1.f); return 0.5f * y * (1.f + th); }

#define XB_TMO      128
#define XB_XCNT(j)  (256  + 64 * (j))
#define XB_XSUB(j)  (1280 + 64 * (j))
#define XB_XGEN(j)  (2304 + 64 * (j))
#define XB_TOP      3328
#define XB_TOPGEN   3392
#define XCD_BAR_WORDS 3456
#define XB_SPIN_CAP (1u << 22)
__device__ __forceinline__ unsigned xb_ld(unsigned* p)              { return __hip_atomic_load(p, __ATOMIC_RELAXED, __HIP_MEMORY_SCOPE_AGENT); }
__device__ __forceinline__ unsigned xb_add(unsigned* p, unsigned v) { return __hip_atomic_fetch_add(p, v, __ATOMIC_RELAXED, __HIP_MEMORY_SCOPE_AGENT); }
__device__ __forceinline__ unsigned xb_xcc_id() { return (unsigned)__builtin_amdgcn_s_getreg((3 << 11) | 20) & 0xFu; }
#define XB_SPIN(cond, bar) do { unsigned _sp = 0; while (cond) { __builtin_amdgcn_s_sleep(1); \
    if ((++_sp & 255u) == 0u) { if (xb_ld(&(bar)[XB_TMO])) break; if (_sp > XB_SPIN_CAP) { atomicAdd(&(bar)[XB_TMO], 1u); break; } } } } while (0)
struct XcdBarrier { unsigned* bar; unsigned x; volatile LAS unsigned* st; };
__device__ __forceinline__ XcdBarrier xcd_barrier_post(unsigned* bar, volatile LAS unsigned* st) {
    XcdBarrier b; b.bar = bar; b.x = xb_xcc_id(); b.st = st;
    if (threadIdx.x == 0) (void)xb_add(&bar[XB_XCNT(b.x)], 1u);
    return b;
}
__device__ __forceinline__ void xcd_barrier_complete(unsigned* bar, unsigned x, unsigned& nloc, unsigned& nx) {
    const unsigned G = gridDim.x * gridDim.y * gridDim.z;
    unsigned sum, cnt, mine, sp = 0u;
    for (;;) {
        sum = 0u; cnt = 0u; mine = 0u;
#pragma unroll
        for (unsigned j = 0; j < 16; ++j) { const unsigned c = xb_ld(&bar[XB_XCNT(j)]); sum += c; cnt += (c > 0u) ? 1u : 0u; mine = (j == x) ? c : mine; }
        if (sum == G) break;
        __builtin_amdgcn_s_sleep(1);
        if ((++sp & 255u) == 0u) { if (xb_ld(&bar[XB_TMO])) break; if (sp > XB_SPIN_CAP) { atomicAdd(&bar[XB_TMO], 1u); break; } }
    }
    nloc = mine > 0u ? mine : 1u; nx = cnt > 0u ? cnt : 1u;
}
__device__ __forceinline__ void xcd_barrier(const XcdBarrier& b) {
    asm volatile("s_waitcnt vmcnt(0)" ::: "memory");
    __syncthreads();
    if (threadIdx.x == 0) {
        unsigned* bar = b.bar;
        __builtin_amdgcn_s_waitcnt(0);
        unsigned nloc = b.st[0], nx = b.st[1];
        if (nloc == 0u) { xcd_barrier_complete(bar, b.x, nloc, nx); b.st[0] = nloc; b.st[1] = nx; }
        const unsigned old = xb_add(&bar[XB_XSUB(b.x)], 1u);
        const unsigned gen = old / nloc;
        if (old + 1u == (gen + 1u) * nloc) {
            __builtin_amdgcn_fence(__ATOMIC_RELEASE, "agent");
            asm volatile("s_waitcnt vmcnt(0)" ::: "memory");
            const unsigned og = xb_add(&bar[XB_TOP], 1u);
            const unsigned tg = og / nx;
            if (og + 1u == (tg + 1u) * nx) xb_add(&bar[XB_TOPGEN], 1u);
            else XB_SPIN(xb_ld(&bar[XB_TOPGEN]) == tg, bar);
            __builtin_amdgcn_fence(__ATOMIC_ACQUIRE, "agent");
            xb_add(&bar[XB_XGEN(b.x)], 1u);
            asm volatile("s_waitcnt vmcnt(0)" ::: "memory");
        } else {
            XB_SPIN(xb_ld(&bar[XB_XGEN(b.x)]) == gen, bar);
            __builtin_amdgcn_fence(__ATOMIC_ACQUIRE, "agent");
            asm volatile("s_waitcnt vmcnt(0)" ::: "memory");
        }
    }
    __syncthreads();
}

constexpr int RING_OFF = 0, RING_BYTES = 131072;
constexpr int LDSCTL_OFF = RING_BYTES, MISC_OFF = LDSCTL_OFF + 320;
constexpr int LDS_BYTES = 147456;

#define CAS __attribute__((address_space(4)))
__device__ __forceinline__ const float* inp(int k) { const CAS char* ka = (const CAS char*)__builtin_amdgcn_kernarg_segment_ptr(); return *(const float* const CAS*)(ka + 8 * k); }
__device__ __forceinline__ float* karg_out() { const CAS char* ka = (const CAS char*)__builtin_amdgcn_kernarg_segment_ptr(); return *(float* const CAS*)(ka + 8 * 35); }
__device__ __forceinline__ unsigned char* karg_ws() { const CAS char* ka = (const CAS char*)__builtin_amdgcn_kernarg_segment_ptr(); return *(unsigned char* const CAS*)(ka + 8 * 36); }
__device__ __forceinline__ int karg_i(int k) { const CAS char* ka = (const CAS char*)__builtin_amdgcn_kernarg_segment_ptr(); return *(const CAS int*)(ka + 8 * 37 + 4 * k); }
struct Frame {
    LAS unsigned char* lds;
    volatile LAS unsigned* MISC;
    gu32* ctl;
    int tid, lane, wave, vcu, G;
    unsigned char* ws;
};
__device__ __forceinline__ float wave_sum(float v) {
#pragma unroll
    for (int o = 1; o < 64; o <<= 1) v += __shfl_xor(v, o);
    return v;
}

struct RmIdent { int off; __device__ __forceinline__ int operator()(int n) const { return n + off; } };
struct RmGateUp { int which; __device__ __forceinline__ int operator()(int n) const { return (n >> 7) * 256 + which * 128 + (n & 127); } };
struct RmWinO { __device__ __forceinline__ int operator()(int n) const {
    if (n < 2048) return n; if (n < 2064) return 4608 + (n - 2048); return n - 16; } };
template <class RM> __device__ __forceinline__ void tr_item(const float* W, int K, int N, bf16* WT, int ldt, const RM rm, LAS float* scr, int item, int lane) {
    const int nblk = (N + 31) / 32, kb = item / nblk, nb = item - kb * nblk, k0 = 64 * kb, n0 = 32 * nb;
    const int c4 = (lane & 7) * 4, r8 = lane >> 3; const bool okc = (n0 + c4) < N;
    f32x4 v[8];
#pragma unroll
    for (int i = 0; i < 8; ++i) v[i] = okc ? *(const GAS f32x4*)(W + (size_t)(k0 + 8 * i + r8) * N + n0 + c4) : (f32x4){0.f, 0.f, 0.f, 0.f};
#pragma unroll
    for (int i = 0; i < 8; ++i) { LAS float* s = scr + (8 * i + r8) * 33 + c4; s[0] = v[i][0]; s[1] = v[i][1]; s[2] = v[i][2]; s[3] = v[i][3]; }
    LDS_WAIT(); asm volatile("" ::: "memory");
    const int c = lane & 7;
#pragma unroll
    for (int j = 0; j < 4; ++j) { const int n = (lane >> 3) + 8 * j; const LAS float* s = scr + (8 * c) * 33 + n;
        v4u o; o.x = pk2(s[0 * 33], s[1 * 33]); o.y = pk2(s[2 * 33], s[3 * 33]); o.z = pk2(s[4 * 33], s[5 * 33]); o.w = pk2(s[6 * 33], s[7 * 33]);
        if (n0 + n < N) *(GAS v4u*)(WT + (size_t)rm(n0 + n) * ldt + k0 + 8 * c) = o; }
    LDS_WAIT(); asm volatile("" ::: "memory");
}
__device__ __forceinline__ void zero_rows(bf16* p, size_t nbytes, int gt, int ngt) {
    for (size_t i = (size_t)gt; i < nbytes / 16; i += (size_t)ngt) ((GAS v4u*)p)[i] = (v4u){0u, 0u, 0u, 0u};
}
__device__ __forceinline__ unsigned pk4_fp8(float a, float b, float c, float d) { int w = 0; w = __builtin_amdgcn_cvt_pk_fp8_f32(a, b, w, false); w = __builtin_amdgcn_cvt_pk_fp8_f32(c, d, w, true); return (unsigned)w; }
template <class RM> __device__ __forceinline__ void tr_item8(const float* W, int K, int N, unsigned char* WT, int ldt, const RM rm, float sc, LAS float* scr, int item, int lane) {
    const int nblk = (N + 31) / 32, kb = item / nblk, nb = item - kb * nblk, k0 = 64 * kb, n0 = 32 * nb;
    const int c4 = (lane & 7) * 4, r8 = lane >> 3; const bool okc = (n0 + c4) < N;
    f32x4 v[8];
#pragma unroll
    for (int i = 0; i < 8; ++i) v[i] = okc ? *(const GAS f32x4*)(W + (size_t)(k0 + 8 * i + r8) * N + n0 + c4) : (f32x4){0.f, 0.f, 0.f, 0.f};
#pragma unroll
    for (int i = 0; i < 8; ++i) { LAS float* s = scr + (8 * i + r8) * 33 + c4; s[0] = v[i][0]; s[1] = v[i][1]; s[2] = v[i][2]; s[3] = v[i][3]; }
    LDS_WAIT(); asm volatile("" ::: "memory");
    const int c = lane & 7;
#pragma unroll
    for (int j = 0; j < 4; ++j) { const int n = (lane >> 3) + 8 * j; const LAS float* s = scr + (8 * c) * 33 + n;
        v2u o; o.x = pk4_fp8(s[0 * 33] * sc, s[1 * 33] * sc, s[2 * 33] * sc, s[3 * 33] * sc); o.y = pk4_fp8(s[4 * 33] * sc, s[5 * 33] * sc, s[6 * 33] * sc, s[7 * 33] * sc);
        if (n0 + n < N) *(GAS v2u*)(WT + (size_t)rm(n0 + n) * ldt + k0 + 8 * c) = o; }
    LDS_WAIT(); asm volatile("" ::: "memory");
}
constexpr int items_of(int K, int N) { return (K / 64) * ((N + 31) / 32); }

__device__ __forceinline__ void s5_small_tables(Frame& F, int g) {
    const float* lam_re = inp(I_LAMRE); const float* lam_im = inp(I_LAMIM); const float* log_dt = inp(I_LOGDT);
    const float* b_re = inp(I_BRE); const float* b_im = inp(I_BIM); const float* c_re = inp(I_CRE); const float* c_im = inp(I_CIM);
    LAS f32x2* APOW = (LAS f32x2*)(F.lds); LAS f32x2* BB = (LAS f32x2*)(F.lds + 2 * 64 * 65 * 8); LAS f32x2* CC = BB + 2 * 64 * 16;
    const int tid = F.tid;
    __syncthreads();
    if (tid < 128) {
        const int dir = tid >> 6, p = tid & 63; const int gi = (dir * S5G + g);
        const double dt = exp((double)log_dt[gi]); const double lr = (double)lam_re[gi * 64 + p], li = (double)lam_im[gi * 64 + p];
        const double mag = exp(lr * dt), ar = mag * cos(li * dt), ai = mag * sin(li * dt);
        double pr = 1.0, pi = 0.0;
        for (int k = 0; k <= 64; ++k) { APOW[(dir * 64 + p) * 65 + k] = (f32x2){(float)pr, (float)pi}; const double nr = pr * ar - pi * ai, ni = pr * ai + pi * ar; pr = nr; pi = ni; }
        const double den = lr * lr + li * li, nr = ar - 1.0, ni = ai;
        const double kr = (nr * lr + ni * li) / den, ki = (ni * lr - nr * li) / den;
        for (int n = 0; n < 16; ++n) { const double br = (double)b_re[(gi * 64 + p) * 16 + n], bi = (double)b_im[(gi * 64 + p) * 16 + n];
            BB[(dir * 64 + p) * 16 + n] = (f32x2){(float)(kr * br - ki * bi), (float)(kr * bi + ki * br)}; }
    }
    for (int i = tid; i < 2 * 16 * 64; i += NTHR) { const int dir = i >> 10, r = i & 1023; CC[i] = (f32x2){c_re[(size_t)(dir * S5G + g) * 1024 + r], c_im[(size_t)(dir * S5G + g) * 1024 + r]}; }
    __syncthreads();
}
__device__ __forceinline__ void s5_stage_a(Frame& F, int g, int part) {
    LAS f32x2* APOW = (LAS f32x2*)(F.lds); LAS f32x2* BB = (LAS f32x2*)(F.lds + 2 * 64 * 65 * 8); LAS f32x2* CC = BB + 2 * 64 * 16;
    float* TBG = (float*)(F.ws + WS_ARENA + A_TBG) + (size_t)g * (2 * 64 * 256);
    bf16* M1T = (bf16*)(F.ws + WS_ARENA + A_M1T) + (size_t)g * 256 * 1024;
    const int tid = F.tid;
    {
        const int n = tid & 15, np = (tid >> 4) & 15, dl0 = 8 * part + ((tid >> 8) & 1);
#pragma unroll
        for (int dir = 0; dir < 2; ++dir) { float s[4] = {0.f, 0.f, 0.f, 0.f};
            for (int p = 0; p < 64; ++p) { const f32x2 c = CC[(dir * 16 + np) * 64 + p], b = BB[(dir * 64 + p) * 16 + n];
                const float wr = c.x * b.x - c.y * b.y, wi = c.x * b.y + c.y * b.x;
#pragma unroll
                for (int j = 0; j < 4; ++j) { const f32x2 a = APOW[(dir * 64 + p) * 65 + dl0 + 2 * j]; s[j] += wr * a.x - wi * a.y; } }
#pragma unroll
            for (int j = 0; j < 4; ++j) TBG[((dir * 64 + dl0 + 2 * j) * 16 + np) * 16 + n] = s[j]; }
    }
    for (int i = tid; i < 32 * 128; i += NTHR) {
        const int j = 32 * part + (i >> 7), c8 = (i & 127) * 8, sI = c8 >> 4, n0 = c8 & 15, dir = j >> 7, pt = (j >> 6) & 1, p = j & 63, e = dir ? sI : 63 - sI;
        const f32x2 a = APOW[(dir * 64 + p) * 65 + e]; float v[8];
#pragma unroll
        for (int q = 0; q < 8; ++q) { const f32x2 b = BB[(dir * 64 + p) * 16 + n0 + q]; v[q] = pt ? (a.x * b.y + a.y * b.x) : (a.x * b.x - a.y * b.y); }
        v4u o; o.x = pk2(v[0], v[1]); o.y = pk2(v[2], v[3]); o.z = pk2(v[4], v[5]); o.w = pk2(v[6], v[7]);
        *(GAS v4u*)(M1T + (size_t)j * 1024 + c8) = o;
    }
}
__device__ __forceinline__ void s5_stage_b(Frame& F, int g, int part) {
    LAS f32x2* APOW = (LAS f32x2*)(F.lds); LAS f32x2* CC = (LAS f32x2*)(F.lds + 2 * 64 * 65 * 8) + 2 * 64 * 16;
    const float* TBG = (const float*)(F.ws + WS_ARENA + A_TBG) + (size_t)g * (2 * 64 * 256);
    bf16* K3T = (bf16*)(F.ws + WS_ARENA + A_K3T) + (size_t)g * 1024 * S5K;
#pragma unroll 4
    for (int i = F.tid; i < 128 * (S5K / 8); i += NTHR) {
        const int row = 128 * part + i / (S5K / 8), c8 = (i % (S5K / 8)) * 8, tau = row >> 4, np = row & 15; float v[8];
        if (c8 < 1024) { const int sI = c8 >> 4, n0 = c8 & 15;
            f32x4 f0 = {0.f, 0.f, 0.f, 0.f}, f1 = f0, b0 = f0, b1 = f0;
            if (sI <= tau) { const GAS f32x4* tb = (const GAS f32x4*)(TBG + ((0 * 64 + (tau - sI)) * 16 + np) * 16 + n0); f0 = tb[0]; f1 = tb[1]; }
            if (sI >= tau) { const GAS f32x4* tb = (const GAS f32x4*)(TBG + ((1 * 64 + (sI - tau)) * 16 + np) * 16 + n0); b0 = tb[0]; b1 = tb[1]; }
            f0 += b0; f1 += b1; v[0] = f0[0]; v[1] = f0[1]; v[2] = f0[2]; v[3] = f0[3]; v[4] = f1[0]; v[5] = f1[1]; v[6] = f1[2]; v[7] = f1[3];
        } else { const int j0 = c8 - 1024, dir = j0 >> 7, pt = (j0 >> 6) & 1, e = dir ? 64 - tau : tau + 1;
#pragma unroll
            for (int q = 0; q < 8; ++q) { const int p = (j0 & 63) + q; const f32x2 c = CC[(dir * 16 + np) * 64 + p], a = APOW[(dir * 64 + p) * 65 + e];
                v[q] = pt ? -(c.x * a.y + c.y * a.x) : (c.x * a.x - c.y * a.y); } }
        v4u o; o.x = pk2(v[0], v[1]); o.y = pk2(v[2], v[3]); o.z = pk2(v[4], v[5]); o.w = pk2(v[6], v[7]);
        *(GAS v4u*)(K3T + (size_t)row * S5K + c8) = o;
    }
}

__device__ __forceinline__ void mod_item(Frame& F, int item) {
    const int l = item >> 7, slab = item & 127, col0 = 96 * slab;
    const float* wm = inp(I_WMOD) + (size_t)l * 2048 * 12288; const float* bm = inp(I_BMOD) + (size_t)l * 12288;
    LAS float* sv = (LAS float*)F.lds;
    LAS float* part = sv + 4096;
    __syncthreads();
    { const float* pc = inp(I_C); const float* pcc = inp(I_CCTX); float xv[8];
#pragma unroll
      for (int q = 0; q < 4; ++q) { xv[q] = pc[F.tid + NTHR * q]; xv[4 + q] = pcc[F.tid + NTHR * q]; }
#pragma unroll
      for (int q = 0; q < 8; ++q) sv[F.tid + NTHR * q] = siluf_(xv[q]); }
    __syncthreads();
    const int sub = F.lane / 24, cl = F.lane % 24;
    f32x4 a0 = {0.f, 0.f, 0.f, 0.f}, a1 = {0.f, 0.f, 0.f, 0.f};
    if (sub < 2) {
        const float* wp = wm + (size_t)(256 * F.wave + sub) * 12288 + col0 + 4 * cl;
#pragma unroll 8
        for (int kk = 0; kk < 256; kk += 2) { const f32x4 w = *(const GAS f32x4*)(wp + (size_t)kk * 12288); const int k = 256 * F.wave + kk + sub;
            const float s0 = sv[k], s1 = sv[2048 + k]; a0 += w * s0; a1 += w * s1; }
        LAS float* pp = part + ((F.wave * 2 + sub) * 24 + cl) * 8;
        pp[0] = a0[0]; pp[1] = a0[1]; pp[2] = a0[2]; pp[3] = a0[3]; pp[4] = a1[0]; pp[5] = a1[1]; pp[6] = a1[2]; pp[7] = a1[3];
    }
    __syncthreads();
    if (F.tid < 192) { const int w = F.tid / 96, c = F.tid % 96; float s = 0.f;
        for (int q = 0; q < 16; ++q) s += part[(q * 24 + (c >> 2)) * 8 + w * 4 + (c & 3)];
        float* MODF = (float*)(F.ws + WS_MODF); MODF[(size_t)(l * 2 + w) * 12288 + col0 + c] = s + bm[col0 + c]; }
    __syncthreads();
}

constexpr int units_of(int K, int N) { return (K / 128) * ((N + 255) / 256); }
constexpr int CU_SQ = units_of(2048, 2048), CU_PW = units_of(384, 384), CU_GL = units_of(512, 512), CU_UP = units_of(2048, 7168), CU_DN = units_of(7168, 2048), CU_WO = units_of(2048, 4624);
constexpr int CQ_E0 = 0, CQ_E1 = CQ_E0 + CU_SQ  , CQ_E2 = CQ_E1 + 4 * CU_PW  , CQ_E3 = CQ_E2 + CU_GL  , CQ_E4 = CQ_E3 + CU_SQ  ,
              CQ_F1 = CQ_E4 + CU_UP  , CQ_F2 = CQ_F1 + CU_UP  , CQ_F3 = CQ_F2 + CU_DN  , CQ_O1 = CQ_F3 + CU_WO  , CQ_O2 = CQ_O1 + CU_SQ  ,
              CQ_M1 = CQ_O2 + 8 * CU_UP  , CQ_M2 = CQ_M1 + 8 * CU_UP  , CQ_M3 = CQ_M2 + 8 * CU_DN  , CQ_END = CQ_M3;
constexpr int CW_QUEUE = 2048;
struct ConvDesc { const float* W; unsigned char* WT; int N, ldt, kind, fp8, k0, n0, pitch, kbyte; float sc; };
__device__ __forceinline__ void conv_decode(Frame& F, int it, ConvDesc& d) {
    int r = it; d.kind = 0; d.fp8 = 0; d.sc = 1.f;
    if (r < CQ_E1) { d.W = inp(I_EWIN); d.WT = F.ws + WS_WINE; d.N = 2048; d.ldt = 2048; }
    else if (r < CQ_E2) { r -= CQ_E1; const int g4 = r / CU_PW; d.W = inp(I_EPOOLW) + (size_t)g4 * 384 * 384; d.WT = F.ws + WS_WPOOL + (size_t)g4 * 512 * 384 * 2; d.N = 384; d.ldt = 384; r -= g4 * CU_PW; }
    else if (r < CQ_E3) { d.W = inp(I_WGLU); d.WT = F.ws + WS_WGLU; d.N = 512; d.ldt = 512; r -= CQ_E2; }
    else if (r < CQ_E4) { d.W = inp(I_EWOUT); d.WT = F.ws + WS_WOUTE; d.N = 2048; d.ldt = 2048; r -= CQ_E3; }
    else if (r < CQ_F2) { const int up = r >= CQ_F1; d.W = inp(up ? I_FFU : I_FFG); d.WT = F.ws + WS_WGU; d.N = 7168; d.ldt = 2048; d.kind = 1 + up; r -= (up ? CQ_F1 : CQ_E4);
        if (FFN_FP8 == 1) { d.fp8 = 1; d.sc = MOE_WSC_GU; } }
    else if (r < CQ_F3) { d.W = inp(I_FFD); d.WT = F.ws + WS_WDN; d.N = 2048; d.ldt = 7168; r -= CQ_F2; if (FFN_FP8 != 0) { d.fp8 = 1; d.sc = MOE_WSC_DN; } }
    else if (r < CQ_O1) { d.W = inp(I_OWIN); d.WT = F.ws + WS_WINO; d.N = 4624; d.ldt = 2048; d.kind = 3; r -= CQ_F3; }
    else if (r < CQ_O2) { d.W = inp(I_OWOUT); d.WT = F.ws + WS_WOUTO; d.N = 2048; d.ldt = 2048; r -= CQ_O1; }
    else if (r < CQ_M2) { d.fp8 = 1; const int up = r >= CQ_M1; r -= up ? CQ_M1 : CQ_O2; const int e = r / CU_UP; d.W = inp(up ? I_MOEU : I_MOEG) + (size_t)e * 2048 * 7168; d.WT = F.ws + WS_WMGU + (size_t)e * 14336 * 2048;
        d.N = 7168; d.ldt = 2048; d.kind = 1 + up; d.sc = MOE_WSC_GU; r -= e * CU_UP; }
    else { d.fp8 = 1; r -= CQ_M2; const int e = r / CU_DN; d.W = inp(I_MOED) + (size_t)e * 7168 * 2048; d.WT = F.ws + WS_WMDN + (size_t)e * 2048 * 7168; d.N = 2048; d.ldt = 7168; d.sc = MOE_WSC_DN; r -= e * CU_DN; }
    const int nblk = (d.N + 255) / 256, kb = r / nblk; d.k0 = 128 * kb; d.n0 = 256 * (r - kb * nblk);
    d.pitch = d.fp8 ? d.ldt : 2 * d.ldt; d.kbyte = d.fp8 ? d.k0 : 2 * d.k0;
    if (FFN_FP8 == 2 && FFNU_K1 < 2048 && it >= CQ_E4 && it < CQ_F2) {
        d.pitch = 2 * FFNU_K1 + (2048 - FFNU_K1);
        if (d.k0 >= FFNU_K1) { d.fp8 = 1; d.sc = MOE_WSC_GU; d.kbyte = 2 * FFNU_K1 + (d.k0 - FFNU_K1); } }
}
__device__ __forceinline__ int conv_row(int kind, int n) {
    if (kind == 0) return n; if (kind == 3) return RmWinO{}(n); return (n >> 7) * 256 + (kind - 1) * 128 + (n & 127); }
__device__ __forceinline__ void conv_load(const ConvDesc& d, int wave, int lane, f32x4 (&v)[16]) {
    const bool okc = (d.n0 + 4 * lane) < d.N; const float* p = d.W + (size_t)(d.k0 + 16 * wave) * d.N + d.n0 + 4 * lane;
#pragma unroll
    for (int i = 0; i < 16; ++i) v[i] = okc ? __builtin_nontemporal_load((const GAS f32x4*)(p + (size_t)i * d.N)) : (f32x4){0.f, 0.f, 0.f, 0.f};
}
__device__ __forceinline__ void conv_to_lds(const f32x4 (&v)[16], LAS float* tile, int wave, int lane) {
#pragma unroll
    for (int i = 0; i < 16; ++i) *(LAS f32x4*)(tile + (16 * wave + i) * 256 + ((lane ^ ((2 * wave + (i >> 3)) & 7)) << 2)) = v[i];
}
__device__ __forceinline__ void conv_store(const ConvDesc& d, const LAS float* tile, int tid) {
    const int c = tid & 7;
    if (d.fp8) {
#pragma unroll
        for (int q = 0; q < 4; ++q) { const int nn = (tid >> 3) + 64 * q; float x[16];
#pragma unroll
            for (int j = 0; j < 16; ++j) { const int k = 16 * c + j; x[j] = tile[k * 256 + ((((nn >> 2) ^ ((k >> 3) & 7)) & 63) << 2) + (nn & 3)]; }
            if (d.n0 + nn < d.N) { const size_t row = (size_t)conv_row(d.kind, d.n0 + nn); v4u o;
                o.x = pk4_fp8(x[0] * d.sc, x[1] * d.sc, x[2] * d.sc, x[3] * d.sc); o.y = pk4_fp8(x[4] * d.sc, x[5] * d.sc, x[6] * d.sc, x[7] * d.sc);
                o.z = pk4_fp8(x[8] * d.sc, x[9] * d.sc, x[10] * d.sc, x[11] * d.sc); o.w = pk4_fp8(x[12] * d.sc, x[13] * d.sc, x[14] * d.sc, x[15] * d.sc);
                __builtin_nontemporal_store(o, (GAS v4u*)(d.WT + row * d.pitch + d.kbyte + 16 * c)); } }
    } else {
#pragma unroll
        for (int q = 0; q < 8; ++q) { const int kh = q & 1, nn = (tid >> 3) + 64 * (q >> 1); const LAS float* s = tile + (64 * kh + 8 * c) * 256 + (((nn >> 2) ^ c) << 2) + (nn & 3);
            float x[8];
#pragma unroll
            for (int j = 0; j < 8; ++j) x[j] = s[j * 256];
            if (d.n0 + nn < d.N) { const size_t row = (size_t)conv_row(d.kind, d.n0 + nn);
                v4u o; o.x = pk2(x[0], x[1]); o.y = pk2(x[2], x[3]); o.z = pk2(x[4], x[5]); o.w = pk2(x[6], x[7]);
                __builtin_nontemporal_store(o, (GAS v4u*)(d.WT + row * d.pitch + d.kbyte + (64 * kh + 8 * c) * 2)); } }
    }
}
constexpr int CQ_NONE = 0x7fffffff;
__device__ __forceinline__ int conv_pull(Frame& F) { return (int)__hip_atomic_fetch_add((unsigned*)(F.ctl + CW_QUEUE), 1u, RLX_AGENT); }
__device__ __forceinline__ void conv_work(Frame& F, int dlimit, int quota) {
    LAS float* tile = (LAS float*)(F.lds + RING_OFF);
    volatile LAS int* QW = (volatile LAS int*)(F.lds + LDSCTL_OFF);
    __syncthreads();
    if (F.tid == 0) { int c0 = CQ_NONE, c1 = CQ_NONE; const int head = (int)__hip_atomic_load((unsigned*)(F.ctl + CW_QUEUE), RLX_AGENT);
        if (head < CQ_END && (quota > 0 || head < dlimit)) { c0 = conv_pull(F); if (c0 < CQ_END && (quota > 1 || c0 < dlimit)) c1 = conv_pull(F); }
        QW[0] = c0; QW[1] = c1; }
    __syncthreads();
    int cur = __builtin_amdgcn_readfirstlane(QW[0]), nxt = __builtin_amdgcn_readfirstlane(QW[1]);
    int npull = (cur != CQ_NONE) + (nxt != CQ_NONE);
    __syncthreads();
    if (cur >= CQ_END) return;
    ConvDesc d; f32x4 v[16]; conv_decode(F, cur, d); conv_load(d, F.wave, F.lane, v);
    for (;;) {
        conv_to_lds(v, tile, F.wave, F.lane); LDS_WAIT(); __syncthreads();
        const bool more = nxt < CQ_END; ConvDesc dn = d;
        if (more) { conv_decode(F, nxt, dn); conv_load(dn, F.wave, F.lane, v); }
        const bool pull = more && (npull < quota || nxt < dlimit);
        conv_store(d, tile, F.tid);
        if (pull && F.tid == 0) QW[0] = conv_pull(F);
        LDS_WAIT(); __syncthreads();
        if (!more) break;
        cur = nxt; nxt = pull ? __builtin_amdgcn_readfirstlane(QW[0]) : CQ_NONE; npull += pull ? 1 : 0; d = dn;
    }
}
__device__ __forceinline__ int fill_quota(int nunits, int G, int c, int Q) { const int mine = nunits > c ? (nunits - 1 - c) / G + 1 : 0, most = (nunits + G - 1) / G; return mine < most ? Q : 0; }
__device__ __forceinline__ void p0_prologue(Frame& F) {
    const int gw = F.vcu * NWAVES + F.wave, NGW = F.G * NWAVES, gt = gw * 64 + F.lane, ngt = NGW * 64;
    for (int it = blockIdx.x; it < 256; it += F.G) mod_item(F, it);
    for (int it = blockIdx.x; it < S5G * 8; it += F.G) { s5_small_tables(F, it >> 3); s5_stage_a(F, it >> 3, it & 7); }
    { float* rp = (float*)(F.ws + WS_ROPE); for (int i = gt; i < 256 * 32; i += ngt) { const int pos = i >> 5, fi = i & 31; const float fr = powf(10000.f, -(float)fi / 32.f), ang = (float)pos * fr;
        rp[2 * i] = cosf(ang); rp[2 * i + 1] = sinf(ang); } }
    for (int g4 = 0; g4 < 4; ++g4) zero_rows((bf16*)(F.ws + WS_WPOOL) + ((size_t)g4 * 512 + 384) * 384, (size_t)128 * 384 * 2, gt, ngt);
    zero_rows((bf16*)(F.ws + WS_WINO) + (size_t)4624 * 2048, (size_t)(WINO_N - 4624) * 2048 * 2, gt, ngt);
    __syncthreads();
    conv_work(F, CQ_E4, 0);
    __syncthreads();
}

#define PV(k) ((LAS float*)(F.lds + (k) * 8192))
__device__ __forceinline__ void ld_row_f32(const float* p, int lane, f32x4 (&v)[8]) {
#pragma unroll
    for (int j = 0; j < 8; ++j) v[j] = *(const GAS f32x4*)(p + 4 * lane + 256 * j);
}
__device__ __forceinline__ void st_row_f32(float* p, int lane, const f32x4 (&v)[8]) {
#pragma unroll
    for (int j = 0; j < 8; ++j) *(GAS f32x4*)(p + 4 * lane + 256 * j) = v[j];
}
__device__ __forceinline__ void ld_row_bf16(const bf16* p, int lane, f32x4 (&v)[8]) {
#pragma unroll
    for (int j = 0; j < 8; ++j) { const v2u w = *(const GAS v2u*)(p + 4 * lane + 256 * j); v[j] = (f32x4){bflo(w.x), bfhi(w.x), bflo(w.y), bfhi(w.y)}; }
}
__device__ __forceinline__ void st_row_bf16(bf16* p, int lane, const f32x4 (&v)[8]) {
#pragma unroll
    for (int j = 0; j < 8; ++j) { v2u w; w.x = pk2(v[j][0], v[j][1]); w.y = pk2(v[j][2], v[j][3]); *(GAS v2u*)(p + 4 * lane + 256 * j) = w; }
}
__device__ __forceinline__ float row_sumsq(const f32x4 (&v)[8]) {
    float s = 0.f;
#pragma unroll
    for (int j = 0; j < 8; ++j) s += (v[j][0] * v[j][0] + v[j][1] * v[j][1]) + (v[j][2] * v[j][2] + v[j][3] * v[j][3]);
    return wave_sum(s);
}
__device__ __forceinline__ f32x4 ldp(const LAS float* p, int lane, int j) { return *(const LAS f32x4*)(p + 4 * lane + 256 * j); }
__device__ __forceinline__ const float* modp(Frame& F, int layer, int w, int k) { return (const float*)(F.ws + WS_MODF) + (size_t)(layer * 2 + w) * 12288 + k * 2048; }
__device__ __forceinline__ const float* h0_row(Frame& F, int m) { return m < CTX ? inp(I_CTX) + (size_t)m * D : inp(I_X) + (size_t)(m - CTX) * D; }

__device__ __forceinline__ void ph_norm0(Frame& F) {
    __syncthreads();
    for (int i = F.tid; i < 2 * 2048; i += NTHR) { const int w = i >> 11, c = i & 2047;
        PV(2 * w)[c] = inp(I_NORMS)[0 * 2048 + c] * (1.f + modp(F, 0, w, 1)[c]); PV(2 * w + 1)[c] = modp(F, 0, w, 0)[c]; }
    __syncthreads();
    bf16* U = (bf16*)(F.ws + WS_ARENA + A_U);
    const int gw = F.vcu * NWAVES + F.wave, NGW = F.G * NWAVES;
    for (int m = gw; m < T; m += NGW) { const int w = m < CTX ? 1 : 0; f32x4 v[8]; ld_row_f32(h0_row(F, m), F.lane, v);
        const float rstd = 1.f / sqrtf(row_sumsq(v) * (1.f / D) + EPS);
#pragma unroll
        for (int j = 0; j < 8; ++j) v[j] = v[j] * rstd * ldp(PV(2 * w), F.lane, j) + ldp(PV(2 * w + 1), F.lane, j);
        st_row_bf16(U + (size_t)m * D, F.lane, v); }
}
__device__ __forceinline__ void ph_norm1(Frame& F) {
    __syncthreads();
    for (int i = F.tid; i < 2 * 2048; i += NTHR) { const int w = i >> 11, c = i & 2047;
        PV(3 * w)[c] = modp(F, 0, w, 2)[c] * inp(I_NORMS)[1 * 2048 + c]; PV(3 * w + 1)[c] = inp(I_NORMS)[2 * 2048 + c] * (1.f + modp(F, 0, w, 4)[c]); PV(3 * w + 2)[c] = modp(F, 0, w, 3)[c]; }
    __syncthreads();
    const bf16* YO = (const bf16*)(F.ws + WS_ARENA + A_YO); bf16* V = (bf16*)(F.ws + WS_ARENA + A_V); bf16* HR = (bf16*)(F.ws + WS_HRES);
    const int gw = F.vcu * NWAVES + F.wave, NGW = F.G * NWAVES;
    for (int m = gw; m < T; m += NGW) { const int w = m < CTX ? 1 : 0; f32x4 y[8], h[8]; ld_row_bf16(YO + (size_t)m * D, F.lane, y); ld_row_f32(h0_row(F, m), F.lane, h);
        const float ry = 1.f / sqrtf(row_sumsq(y) * (1.f / D) + EPS);
#pragma unroll
        for (int j = 0; j < 8; ++j) h[j] = h[j] + y[j] * ry * ldp(PV(3 * w), F.lane, j);
        st_row_bf16(HR + (size_t)m * D, F.lane, h);
        const float rh = 1.f / sqrtf(row_sumsq(h) * (1.f / D) + EPS);
#pragma unroll
        for (int j = 0; j < 8; ++j) y[j] = h[j] * rh * ldp(PV(3 * w + 1), F.lane, j) + ldp(PV(3 * w + 2), F.lane, j);
#if FFN_FP8 == 1
        { unsigned char* V8 = (unsigned char*)V + (size_t)m * D;
#pragma unroll
          for (int j = 0; j < 8; ++j) *(GAS unsigned*)(V8 + 4 * F.lane + 256 * j) = pk4_fp8(y[j][0], y[j][1], y[j][2], y[j][3]); }
#elif FFN_FP8 == 2 && FFNU_K1 < 2048
        { unsigned char* Vr = (unsigned char*)V + (size_t)m * (2 * FFNU_K1 + (2048 - FFNU_K1));
#pragma unroll
          for (int j = 0; j < 8; ++j) { const int col = 4 * F.lane + 256 * j;
              if (256 * j < FFNU_K1) { v2u w; w.x = pk2(y[j][0], y[j][1]); w.y = pk2(y[j][2], y[j][3]); *(GAS v2u*)(Vr + 2 * col) = w; }
              else *(GAS unsigned*)(Vr + 2 * FFNU_K1 + (col - FFNU_K1)) = pk4_fp8(y[j][0], y[j][1], y[j][2], y[j][3]); } }
#else
        st_row_bf16(V + (size_t)m * D, F.lane, y);
#endif
    }
}
__device__ __forceinline__ void ph_norm2(Frame& F) {
    __syncthreads();
    for (int i = F.tid; i < 2 * 2048; i += NTHR) { const int w = i >> 11, c = i & 2047;
        PV(3 * w)[c] = modp(F, 0, w, 5)[c] * inp(I_NORMS)[3 * 2048 + c]; PV(3 * w + 1)[c] = inp(I_NORMS)[(4 + 0) * 2048 + c] * (1.f + modp(F, 1, w, 1)[c]); PV(3 * w + 2)[c] = modp(F, 1, w, 0)[c]; }
    __syncthreads();
    const bf16* FB = (const bf16*)(F.ws + WS_ARENA + A_F); bf16* U = (bf16*)(F.ws + WS_ARENA + A_U); bf16* HR = (bf16*)(F.ws + WS_HRES);
    const int gw = F.vcu * NWAVES + F.wave, NGW = F.G * NWAVES;
    for (int m = gw; m < T; m += NGW) { const int w = m < CTX ? 1 : 0; f32x4 y[8], h[8]; ld_row_bf16(FB + (size_t)m * D, F.lane, y); ld_row_bf16(HR + (size_t)m * D, F.lane, h);
        const float ry = 1.f / sqrtf(row_sumsq(y) * (1.f / D) + EPS);
#pragma unroll
        for (int j = 0; j < 8; ++j) h[j] = h[j] + y[j] * ry * ldp(PV(3 * w), F.lane, j);
        st_row_bf16(HR + (size_t)m * D, F.lane, h);
        const float rh = 1.f / sqrtf(row_sumsq(h) * (1.f / D) + EPS);
#pragma unroll
        for (int j = 0; j < 8; ++j) y[j] = h[j] * rh * ldp(PV(3 * w + 1), F.lane, j) + ldp(PV(3 * w + 2), F.lane, j);
        st_row_bf16(U + (size_t)m * D, F.lane, y); }
}
__device__ __forceinline__ void ph_emit(Frame& F, float* out) {
    const bf16* HR = (const bf16*)(F.ws + WS_HRES) + (size_t)CTX * D;
    for (size_t i = (size_t)blockIdx.x * NTHR + F.tid; i < (size_t)SEQ * D / 4; i += (size_t)F.G * NTHR) { const v2u w = ((const GAS v2u*)HR)[i]; ((GAS f32x4*)out)[i] = (f32x4){bflo(w.x), bfhi(w.x), bflo(w.y), bfhi(w.y)}; }
}

template <int W> __device__ __forceinline__ void pooldiff_group(Frame& F, int gi) {
    const bf16* ZP = (const bf16*)(F.ws + WS_ARENA + A_ZP); bf16* DP = (bf16*)(F.ws + WS_ARENA + A_DP);
    constexpr int OG = PG / 8;
    const int nitem = T * OG;
    for (int it = F.vcu * NTHR + F.tid; it < nitem; it += F.G * NTHR) {
        const int t = it / OG, c8 = gi * PG + (it - t * OG) * 8;
        const int s0 = t < CTX ? 0 : CTX, L = t < CTX ? CTX : SEQ, tp = t - s0;
        int lo = tp - W / 2; lo = lo < 0 ? 0 : lo; int hi = tp + (W - W / 2); hi = hi > L ? L : hi;
        v4u x[W];
#pragma unroll
        for (int i = 0; i < W; ++i) { int r = tp - W / 2 + i; r = (r >= 0 && r < L) ? r : tp; x[i] = *(const GAS v4u*)(ZP + (size_t)(s0 + r) * WPOOL + c8); }
        float s[8];
#pragma unroll
        for (int q = 0; q < 8; ++q) s[q] = 0.f;
#pragma unroll
        for (int i = 0; i < W; ++i) { const int r = tp - W / 2 + i; if (r >= 0 && r < L) {
            s[0] += bflo(x[i].x); s[1] += bfhi(x[i].x); s[2] += bflo(x[i].y); s[3] += bfhi(x[i].y); s[4] += bflo(x[i].z); s[5] += bfhi(x[i].z); s[6] += bflo(x[i].w); s[7] += bfhi(x[i].w); } }
        const float inv = 1.f / (float)(hi - lo); const v4u z = x[W / 2];
        v4u o; o.x = pk2(s[0] * inv - bflo(z.x), s[1] * inv - bfhi(z.x)); o.y = pk2(s[2] * inv - bflo(z.y), s[3] * inv - bfhi(z.y));
        o.z = pk2(s[4] * inv - bflo(z.z), s[5] * inv - bfhi(z.z)); o.w = pk2(s[6] * inv - bflo(z.w), s[7] * inv - bfhi(z.w));
        *(GAS v4u*)(DP + (size_t)t * WPOOL + c8) = o;
    }
}
__device__ __forceinline__ void ph_pooldiff(Frame& F) { pooldiff_group<16>(F, 3); pooldiff_group<8>(F, 2); pooldiff_group<4>(F, 1); pooldiff_group<2>(F, 0); }

__device__ __forceinline__ void ph_s5scan(Frame& F) {
    const int gth = blockIdx.x * NTHR + F.tid; if (gth >= S5G * 2 * 64) return;
    const int g = gth >> 7, dir = (gth >> 6) & 1, p = gth & 63, gi = dir * S5G + g;
    const double dt = exp((double)inp(I_LOGDT)[gi]), lr = (double)inp(I_LAMRE)[gi * 64 + p], li = (double)inp(I_LAMIM)[gi * 64 + p];
    const float aLr = (float)(exp(lr * dt * LC) * cos(li * dt * LC)), aLi = (float)(exp(lr * dt * LC) * sin(li * dt * LC));
    const float* SL = (const float*)(F.ws + WS_ARENA + A_SLOC) + (size_t)g * S5ROWS * 256 + dir * 128 + p;
    bf16* CA = (bf16*)(F.ws + WS_ARENA + A_AS5) + (size_t)g * S5ROWS * S5K + 1024 + dir * 128 + p;
    float er = 0.f, ei = 0.f;
    for (int i0 = 0; i0 < NCH; i0 += 4) {
        int cc[4]; float sr[4], si[4];
#pragma unroll
        for (int q = 0; q < 4; ++q) { const int i = i0 + q; cc[q] = dir == 0 ? i : (i < NCH_CTX ? NCH_CTX - 1 - i : NCH - 1 - (i - NCH_CTX));
            sr[q] = SL[(size_t)cc[q] * 256]; si[q] = SL[(size_t)cc[q] * 256 + 64]; }
#pragma unroll
        for (int q = 0; q < 4; ++q) { CA[(size_t)cc[q] * S5K] = (bf16)f2bf(er); CA[(size_t)cc[q] * S5K + 64] = (bf16)f2bf(ei);
            const float nr = aLr * er - aLi * ei + sr[q], ni = aLr * ei + aLi * er + si[q]; er = nr; ei = ni; }
    }
}

typedef unsigned u32x4 __attribute__((ext_vector_type(4)));
using pg8::Unit; using pg8::pack8;
typedef const pg8::f32x4 (&AccRef)[2][2][4][2];
#define EPI_ROWS(u) const int row0 = (u).pm * 256 + wr * 64 + fr
struct EpiPlain { static constexpr bool PERM = true; bf16* O; int ldc;
    __device__ __forceinline__ void operator()(AccRef acc, const Unit& u, int wr, int wc, int fr, int fq) const { EPI_ROWS(u); const int col0 = u.pn * 256 + wc * 32 + 8 * fq;
#pragma unroll
        for (int ai = 0; ai < 2; ++ai)
#pragma unroll
            for (int m = 0; m < 4; ++m) { bf16* rp = O + (size_t)(row0 + ai * 128 + m * 16) * ldc + col0;
#pragma unroll
                for (int bj = 0; bj < 2; ++bj) *(GAS u32x4*)(rp + bj * 128) = pack8(acc[ai][bj][m][0], acc[ai][bj][m][1]); } } };
struct EpiWinE { static constexpr bool PERM = true; bf16* ZP; bf16* AS5;
    __device__ __forceinline__ void operator()(AccRef acc, const Unit& u, int wr, int wc, int fr, int fq) const { EPI_ROWS(u); const int col0 = u.pn * 256 + wc * 32 + 8 * fq;
#pragma unroll
        for (int ai = 0; ai < 2; ++ai)
#pragma unroll
            for (int m = 0; m < 4; ++m) { const int row = row0 + ai * 128 + m * 16;
#pragma unroll
                for (int bj = 0; bj < 2; ++bj) { const int col = col0 + bj * 128; const u32x4 w = pack8(acc[ai][bj][m][0], acc[ai][bj][m][1]);
                    if (u.pn < 6) *(GAS u32x4*)(ZP + (size_t)row * WPOOL + col) = w;
                    else { const int cc = col - WPOOL, g = cc >> 4, n0 = cc & 15, c = row >> 6, s = row & 63; *(GAS u32x4*)(AS5 + ((size_t)(g * S5ROWS + c) * S5K + s * 16 + n0)) = w; } } } } };
struct EpiPool { static constexpr bool PERM = true; bf16* YMIX; const float* scale;
    __device__ __forceinline__ void operator()(AccRef acc, const Unit& u, int wr, int wc, int fr, int fq) const { EPI_ROWS(u); const int lc0 = u.pn * 256 + wc * 32 + 8 * fq;
#pragma unroll
        for (int bj = 0; bj < 2; ++bj) { const int lc = lc0 + bj * 128; if (lc >= PG) continue; const int gc = u.bz * PG + lc;
            const f32x4 s0 = *(const GAS f32x4*)(scale + gc), s1 = *(const GAS f32x4*)(scale + gc + 4);
#pragma unroll
            for (int ai = 0; ai < 2; ++ai)
#pragma unroll
                for (int m = 0; m < 4; ++m) { const int row = row0 + ai * 128 + m * 16; *(GAS u32x4*)(YMIX + (size_t)row * D + gc) = pack8(acc[ai][bj][m][0] * s0, acc[ai][bj][m][1] * s1); } } } };
struct EpiSloc { static constexpr bool PERM = false; float* SL;
    __device__ __forceinline__ void operator()(AccRef acc, const Unit& u, int wr, int wc, int fr, int fq) const { EPI_ROWS(u); const int col0 = u.pn * 256 + wc * 32 + 4 * fq;
#pragma unroll
        for (int ai = 0; ai < 2; ++ai)
#pragma unroll
            for (int m = 0; m < 4; ++m) { float* rp = SL + ((size_t)u.bz * S5ROWS + row0 + ai * 128 + m * 16) * 256 + col0;
#pragma unroll
                for (int bj = 0; bj < 2; ++bj)
#pragma unroll
                    for (int n = 0; n < 2; ++n) *(GAS f32x4*)(rp + bj * 128 + n * 16) = acc[ai][bj][m][n]; } } };
struct EpiS5Y { static constexpr bool PERM = true; const bf16* AS5; const float* dsk; bf16* YG;
    __device__ __forceinline__ void operator()(AccRef acc, const Unit& u, int wr, int wc, int fr, int fq) const { EPI_ROWS(u); const int col0 = u.pn * 256 + wc * 32 + 8 * fq;
#pragma unroll
        for (int bj = 0; bj < 2; ++bj) { const int col = col0 + bj * 128, tau = col >> 4, n0 = col & 15;
            const f32x4 d0 = *(const GAS f32x4*)(dsk + u.bz * 16 + n0), d1 = *(const GAS f32x4*)(dsk + u.bz * 16 + n0 + 4);
#pragma unroll
            for (int ai = 0; ai < 2; ++ai)
#pragma unroll
                for (int m = 0; m < 4; ++m) { const int c = row0 + ai * 128 + m * 16; if (c >= NCH) continue;
                    const v4u x = *(const GAS v4u*)(AS5 + ((size_t)(u.bz * S5ROWS + c) * S5K + col));
                    f32x4 a = acc[ai][bj][m][0], b = acc[ai][bj][m][1];
                    a[0] = gelu_tanh(a[0] + bflo(x.x) * d0[0]); a[1] = gelu_tanh(a[1] + bfhi(x.x) * d0[1]); a[2] = gelu_tanh(a[2] + bflo(x.y) * d0[2]); a[3] = gelu_tanh(a[3] + bfhi(x.y) * d0[3]);
                    b[0] = gelu_tanh(b[0] + bflo(x.z) * d1[0]); b[1] = gelu_tanh(b[1] + bfhi(x.z) * d1[1]); b[2] = gelu_tanh(b[2] + bflo(x.w) * d1[2]); b[3] = gelu_tanh(b[3] + bfhi(x.w) * d1[3]);
                    *(GAS u32x4*)(YG + ((size_t)(c * 64 + tau) * WS5 + u.bz * 16 + n0)) = pack8(a, b); } } } };
struct EpiGlu { static constexpr bool PERM = true; const bf16* YG; bf16* YMIX;
    __device__ __forceinline__ void operator()(AccRef acc, const Unit& u, int wr, int wc, int fr, int fq) const { EPI_ROWS(u); const int col0 = u.pn * 256 + wc * 32 + 8 * fq;
#pragma unroll
        for (int ai = 0; ai < 2; ++ai)
#pragma unroll
            for (int m = 0; m < 4; ++m) { const int row = row0 + ai * 128 + m * 16;
#pragma unroll
                for (int bj = 0; bj < 2; ++bj) { const int col = col0 + bj * 128; const v4u x = *(const GAS v4u*)(YG + (size_t)row * WS5 + col);
                    f32x4 a = acc[ai][bj][m][0], b = acc[ai][bj][m][1];
                    a[0] = bflo(x.x) * sigmoidf_(a[0]); a[1] = bfhi(x.x) * sigmoidf_(a[1]); a[2] = bflo(x.y) * sigmoidf_(a[2]); a[3] = bfhi(x.y) * sigmoidf_(a[3]);
                    b[0] = bflo(x.z) * sigmoidf_(b[0]); b[1] = bfhi(x.z) * sigmoidf_(b[1]); b[2] = bflo(x.w) * sigmoidf_(b[2]); b[3] = bfhi(x.w) * sigmoidf_(b[3]);
                    *(GAS u32x4*)(YMIX + (size_t)row * D + WPOOL + col) = pack8(a, b); } } } };
struct EpiGateUp { static constexpr bool PERM = true; bf16* HID; int ldc;
    __device__ __forceinline__ void operator()(AccRef acc, const Unit& u, int wr, int wc, int fr, int fq) const { EPI_ROWS(u); const int col0 = u.pn * 128 + wc * 32 + 8 * fq;
#pragma unroll
        for (int ai = 0; ai < 2; ++ai)
#pragma unroll
            for (int m = 0; m < 4; ++m) { const int row = row0 + ai * 128 + m * 16; f32x4 a, b;
#pragma unroll
                for (int q = 0; q < 4; ++q) { a[q] = swiglu_fast(acc[ai][0][m][0][q], acc[ai][1][m][0][q], -1.4426950408889634f, 1.f); b[q] = swiglu_fast(acc[ai][0][m][1][q], acc[ai][1][m][1][q], -1.4426950408889634f, 1.f); }
                *(GAS u32x4*)(HID + (size_t)row * ldc + col0) = pack8(a, b); } } };

struct EpiWinO { static constexpr bool PERM = true; unsigned char* ar;
    __device__ __forceinline__ void operator()(AccRef acc, const Unit& u, int wr, int wc, int fr, int fq) const { EPI_ROWS(u); const int pn = u.pn;
        if (pn == 18) { if (wc == 0 && fq < 2) { float* ALR = (float*)(ar + B_ALR);
#pragma unroll
                for (int ai = 0; ai < 2; ++ai)
#pragma unroll
                    for (int m = 0; m < 4; ++m) { float* rp = ALR + (size_t)(row0 + ai * 128 + m * 16) * 16 + 8 * fq; *(GAS f32x4*)rp = acc[ai][0][m][0]; *(GAS f32x4*)(rp + 4) = acc[ai][0][m][1]; } }
            return; }
        bf16* base; int ld, c0;
        if (pn < 2) { base = (bf16*)(ar + B_GQ); ld = 512; c0 = pn * 256; } else if (pn < 4) { base = (bf16*)(ar + B_GK); ld = 512; c0 = (pn - 2) * 256; }
        else if (pn < 8) { base = (bf16*)(ar + B_GV); ld = 1024; c0 = (pn - 4) * 256; } else if (pn < 12) { base = (bf16*)(ar + B_R); ld = 1024; c0 = (pn - 8) * 256; }
        else if (pn < 16) { base = (bf16*)(ar + B_AQ); ld = 1024; c0 = (pn - 12) * 256; } else if (pn == 16) { base = (bf16*)(ar + B_AK); ld = 256; c0 = 0; } else { base = (bf16*)(ar + B_AV); ld = 256; c0 = 0; }
        const int col0 = c0 + wc * 32 + 8 * fq;
#pragma unroll
        for (int ai = 0; ai < 2; ++ai)
#pragma unroll
            for (int m = 0; m < 4; ++m) { bf16* rp = base + (size_t)(row0 + ai * 128 + m * 16) * ld + col0;
#pragma unroll
                for (int bj = 0; bj < 2; ++bj) *(GAS u32x4*)(rp + bj * 128) = pack8(acc[ai][bj][m][0], acc[ai][bj][m][1]); } } };

__device__ __forceinline__ void ph_qknorm(Frame& F) {
    unsigned char* ar = F.ws + WS_ARENA; bf16* AQ = (bf16*)(ar + B_AQ); bf16* AK = (bf16*)(ar + B_AK);
    const float* qn = inp(I_QNORM); const float* kn = inp(I_KNORM); const f32x2* rope = (const f32x2*)(F.ws + WS_ROPE);
    const size_t NQ = (size_t)SEQ * 8 * 8, NK = (size_t)T * 2 * 8;
    for (size_t it = (size_t)F.vcu * NTHR + F.tid; it < NQ + NK; it += (size_t)F.G * NTHR) {
        const bool isq = it < NQ; const size_t r = isq ? it : it - NQ; const int j = (int)(r & 7), hf = j >> 2, sub = j & 3;
        int row, head; bf16* p; const float* nw;
        if (isq) { head = (int)((r >> 3) & 7); row = CTX + (int)(r >> 6); p = AQ + (size_t)row * 1024 + head * 128; nw = qn; }
        else { head = (int)((r >> 3) & 1); row = (int)(r >> 4); p = AK + (size_t)row * 256 + head * 128; nw = kn; }
        const int d1 = 64 * hf + 8 * sub, d2 = d1 + 32;
        const v4u a = *(const GAS v4u*)(p + d1), b = *(const GAS v4u*)(p + d2);
        float x1[8] = {bflo(a.x), bfhi(a.x), bflo(a.y), bfhi(a.y), bflo(a.z), bfhi(a.z), bflo(a.w), bfhi(a.w)};
        float x2[8] = {bflo(b.x), bfhi(b.x), bflo(b.y), bfhi(b.y), bflo(b.z), bfhi(b.z), bflo(b.w), bfhi(b.w)};
        float ss = 0.f;
#pragma unroll
        for (int e = 0; e < 8; ++e) ss += x1[e] * x1[e] + x2[e] * x2[e];
        ss += __shfl_xor(ss, 1); ss += __shfl_xor(ss, 2); ss += __shfl_xor(ss, 4);
        const float rstd = 1.f / sqrtf(ss * (1.f / 128.f) + EPS);
        const bool rot = row >= CTX; const int tl = row - CTX, pos = hf ? (tl & 63) : (tl >> 6);
        float o1[8], o2[8];
#pragma unroll
        for (int e = 0; e < 8; ++e) { const float y1 = x1[e] * rstd * nw[d1 + e], y2 = x2[e] * rstd * nw[d2 + e];
            f32x2 cs = {1.f, 0.f}; if (rot) cs = rope[pos * 32 + 8 * sub + e];
            o1[e] = y1 * cs.x - y2 * cs.y; o2[e] = y1 * cs.y + y2 * cs.x; }
        v4u w1, w2; w1.x = pk2(o1[0], o1[1]); w1.y = pk2(o1[2], o1[3]); w1.z = pk2(o1[4], o1[5]); w1.w = pk2(o1[6], o1[7]);
        w2.x = pk2(o2[0], o2[1]); w2.y = pk2(o2[2], o2[3]); w2.z = pk2(o2[4], o2[5]); w2.w = pk2(o2[6], o2[7]);
        *(GAS v4u*)(p + d1) = w1; *(GAS v4u*)(p + d2) = w2;
        if (!isq) {
            unsigned char* k8 = ar + B_KDT + (size_t)row * 256 + head * 128 + 64 * (sub & 1) + 8 * (4 * hf + (sub >> 1));
            v2u a8, b8; a8.x = pk4_fp8(o1[0], o1[1], o1[2], o1[3]); a8.y = pk4_fp8(o1[4], o1[5], o1[6], o1[7]); b8.x = pk4_fp8(o2[0], o2[1], o2[2], o2[3]); b8.y = pk4_fp8(o2[4], o2[5], o2[6], o2[7]);
            *(GAS v2u*)k8 = a8; *(GAS v2u*)(k8 + 16) = b8; }
    }
}

constexpr size_t VT8_OFF = 8 * MiB;
__device__ __forceinline__ void ph_vt8(Frame& F) {
    unsigned char* ar = F.ws + WS_ARENA; const bf16* AV = (const bf16*)(ar + B_AV); unsigned char* VT8 = ar + B_KDT + VT8_OFF;
    const int ntask = 2 * NCH * 128 * 4;
    for (int it = F.vcu * NTHR + F.tid; it < ntask; it += F.G * NTHR) {
        const int g = it & 3, d = (it >> 2) & 127, tl = (it >> 9) % NCH, kvh = (it >> 9) / NCH, hi = g >> 1, blk = g & 1;
        float x[16];
#pragma unroll
        for (int r = 0; r < 16; ++r) { const int key = 32 * blk + (r & 3) + 8 * (r >> 2) + 4 * hi; x[r] = bf2f(AV[(size_t)(tl * 64 + key) * 256 + kvh * 128 + d]); }
        v4u o; o.x = pk4_fp8(x[0], x[1], x[2], x[3]); o.y = pk4_fp8(x[4], x[5], x[6], x[7]); o.z = pk4_fp8(x[8], x[9], x[10], x[11]); o.w = pk4_fp8(x[12], x[13], x[14], x[15]);
        *(GAS v4u*)(VT8 + ((size_t)(kvh * NCH + tl) * 128 + d) * 64 + g * 16) = o;
    }
}

namespace tri {
using s16x4 = __attribute__((ext_vector_type(4))) short;
__device__ __forceinline__ int st(int k, int c) { const int kk = (k & ~0xC) | ((k & 4) << 1) | ((k & 8) >> 1); return ((kk >> 3) * 4 + (c >> 5)) * 512 + ((kk & 7) * 32 + (c & 31)) * 2; }
__device__ __forceinline__ int rd_base(int lane) { return ((lane & 3) << 3) | (((lane >> 2) & 3) << 6) | (((lane >> 4) & 1) << 5) | (((lane >> 5) & 1) << 8); }
constexpr int rd_off(int d0, int ks, int half) { return d0 * 512 + ks * 4096 + half * 2048; }
template <int OFF> __device__ __forceinline__ s16x4 tr_read(int vb) { s16x4 r; asm volatile("ds_read_b64_tr_b16 %0, %1 offset:%2" : "=&v"(r) : "v"(vb), "i"(OFF) : "memory"); return r; }
struct Frag2 { s16x4 lo, hi; };
template <int D0, int KS> __device__ __forceinline__ Frag2 ld(int vb) { Frag2 f; f.lo = tr_read<rd_off(D0, KS, 0)>(vb); f.hi = tr_read<rd_off(D0, KS, 1)>(vb); return f; }
__device__ __forceinline__ bf16x8 pk(const Frag2& f) { return (bf16x8){f.lo[0], f.lo[1], f.lo[2], f.lo[3], f.hi[0], f.hi[1], f.hi[2], f.hi[3]}; }
#define TRI_WAIT() do { asm volatile("s_waitcnt lgkmcnt(0)" ::: "memory"); __builtin_amdgcn_sched_barrier(0); } while (0)
}
typedef float f32x16 __attribute__((ext_vector_type(16)));
__device__ __forceinline__ int crow(int r, int hi) { return (r & 3) + 8 * (r >> 2) + 4 * hi; }

__device__ __forceinline__ float logsigmoidf_(float z) { return fminf(z, 0.f) - __logf(1.f + __expf(-fabsf(z))); }
__device__ __forceinline__ void gla_prepkv_unit(Frame& F, int c, int h) {
    unsigned char* ar = F.ws + WS_ARENA;
    const bf16* GQ = (const bf16*)(ar + B_GQ); const bf16* GK = (const bf16*)(ar + B_GK); const bf16* GV = (const bf16*)(ar + B_GV); const float* ALR = (const float*)(ar + B_ALR);
    LAS float* ALR_S = (LAS float*)(F.lds);
    LAS float* WA_S = (LAS float*)(F.lds + 4096);
    LAS float* BA_S = (LAS float*)(F.lds + 12288);
    LAS float* SEG_S = (LAS float*)(F.lds + 12800);
    LAS float* GB = (LAS float*)(F.lds + 14848);
    LAS unsigned char* QS = F.lds + 47616;
    LAS unsigned char* KS = F.lds + 64000;
    LAS unsigned char* VIMG = F.lds + 80384;
    LAS unsigned char* KIMG = F.lds + 113152;
    const int tid = F.tid, lane = F.lane, t0 = c * 64;
    __syncthreads();
    for (int i = tid; i < 1024; i += NTHR) ALR_S[i] = ALR[(size_t)t0 * 16 + i];
    for (int i = tid; i < 1024; i += NTHR) { const int r = i >> 4, k8 = (i & 15) * 8;
        *(LAS v4u*)(QS + (r * 128 + k8) * 2) = *(const GAS v4u*)(GQ + (size_t)(t0 + r) * 512 + h * 128 + k8); *(LAS v4u*)(KS + (r * 128 + k8) * 2) = *(const GAS v4u*)(GK + (size_t)(t0 + r) * 512 + h * 128 + k8); }
    for (int i = tid; i < 2048; i += NTHR) { const int r = i >> 5, v8 = (i & 31) * 8;
        *(LAS v4u*)(VIMG + (v8 >> 7) * 16384 + tri::st(r, v8 & 127)) = *(const GAS v4u*)(GV + (size_t)(t0 + r) * 1024 + h * 256 + v8); }
    for (int d = 0; d < 2; ++d) {
        const float* wa = inp(I_GLAWA) + (size_t)d * 16 * 512 + h * 128; const float* ba = inp(I_GLABA) + d * 512 + h * 128;
        __syncthreads();
        for (int i = tid; i < 2048; i += NTHR) WA_S[i] = wa[(size_t)(i >> 7) * 512 + (i & 127)];
        if (tid < 128) BA_S[tid] = ba[tid];
        __syncthreads();
        const int k = tid & 127, seg = tid >> 7;
        float gl[16];
        { float w[16];
#pragma unroll
          for (int r = 0; r < 16; ++r) w[r] = WA_S[r * 128 + k];
          const float b0 = BA_S[k];
#pragma unroll
          for (int ii = 0; ii < 16; ++ii) { const int i = seg * 16 + ii; float z = b0;
#pragma unroll
              for (int r = 0; r < 16; ++r) z += ALR_S[i * 16 + r] * w[r];
              gl[ii] = logsigmoidf_(z) * (1.f / 16.f); } }
        if (d == 0) {
#pragma unroll
            for (int ii = 1; ii < 16; ++ii) gl[ii] += gl[ii - 1];
            SEG_S[seg * 128 + k] = gl[15]; }
        else {
#pragma unroll
            for (int ii = 14; ii >= 0; --ii) gl[ii] += gl[ii + 1];
            SEG_S[seg * 128 + k] = gl[0]; }
        __syncthreads();
        const float s0 = SEG_S[k], s1 = SEG_S[128 + k], s2 = SEG_S[256 + k], s3 = SEG_S[384 + k], tot = (s0 + s1) + (s2 + s3);
        float off;
        if (d == 0) off = seg == 0 ? 0.f : (seg == 1 ? s0 : (seg == 2 ? s0 + s1 : s0 + s1 + s2));
        else off = seg == 3 ? 0.f : (seg == 2 ? s3 : (seg == 1 ? s3 + s2 : s3 + s2 + s1));
#pragma unroll
        for (int ii = 0; ii < 16; ++ii) GB[(seg * 16 + ii) * 128 + k] = gl[ii] + off;
        if (seg == 0) ((float*)(ar + B_DEC))[((size_t)(d * NCH + c) * 4 + h) * 128 + k] = __expf(tot);
        __syncthreads();
        { bf16* QE = (bf16*)(ar + B_QE) + (size_t)d * T * 512; bf16* KE = (bf16*)(ar + B_KE) + (size_t)d * T * 512;
          for (int i2 = tid; i2 < 1024; i2 += NTHR) { const int i = i2 >> 4, k8 = (i2 & 15) * 8; const v4u qw = *(const LAS v4u*)(QS + (i * 128 + k8) * 2), kw = *(const LAS v4u*)(KS + (i * 128 + k8) * 2);
              const f32x4 ba0 = *(const LAS f32x4*)(GB + i * 128 + k8), ba1 = *(const LAS f32x4*)(GB + i * 128 + k8 + 4);
              const f32x4 t0v = *(const LAS f32x4*)(SEG_S + k8), t1v = *(const LAS f32x4*)(SEG_S + 128 + k8), t2v = *(const LAS f32x4*)(SEG_S + 256 + k8), t3v = *(const LAS f32x4*)(SEG_S + 384 + k8);
              const f32x4 u0v = *(const LAS f32x4*)(SEG_S + k8 + 4), u1v = *(const LAS f32x4*)(SEG_S + 128 + k8 + 4), u2v = *(const LAS f32x4*)(SEG_S + 256 + k8 + 4), u3v = *(const LAS f32x4*)(SEG_S + 384 + k8 + 4);
              const f32x4 tt0 = (t0v + t1v) + (t2v + t3v), tt1 = (u0v + u1v) + (u2v + u3v);
              const float b[8] = {ba0[0], ba0[1], ba0[2], ba0[3], ba1[0], ba1[1], ba1[2], ba1[3]}; const float tt[8] = {tt0[0], tt0[1], tt0[2], tt0[3], tt1[0], tt1[1], tt1[2], tt1[3]};
              const unsigned qv[4] = {qw.x, qw.y, qw.z, qw.w}, kv[4] = {kw.x, kw.y, kw.z, kw.w}; float qe[8], ke[8], kd[8];
#pragma unroll
              for (int e = 0; e < 4; ++e) { const float q0 = bflo(qv[e]), q1 = bfhi(qv[e]), k0 = bflo(kv[e]), k1 = bfhi(kv[e]); const float e0 = __expf(b[2 * e]), e1 = __expf(b[2 * e + 1]);
                  const float r0 = __builtin_amdgcn_rcpf(e0), r1 = __builtin_amdgcn_rcpf(e1);
                  qe[2 * e] = q0 * 0.08838834764831845f * e0; qe[2 * e + 1] = q1 * 0.08838834764831845f * e1; ke[2 * e] = k0 * r0; ke[2 * e + 1] = k1 * r1;
                  kd[2 * e] = k0 * __expf(tt[2 * e] - b[2 * e]); kd[2 * e + 1] = k1 * __expf(tt[2 * e + 1] - b[2 * e + 1]); }
              v4u wq, wk, wd; wq.x = pk2(qe[0], qe[1]); wq.y = pk2(qe[2], qe[3]); wq.z = pk2(qe[4], qe[5]); wq.w = pk2(qe[6], qe[7]);
              wk.x = pk2(ke[0], ke[1]); wk.y = pk2(ke[2], ke[3]); wk.z = pk2(ke[4], ke[5]); wk.w = pk2(ke[6], ke[7]);
              wd.x = pk2(kd[0], kd[1]); wd.y = pk2(kd[2], kd[3]); wd.z = pk2(kd[4], kd[5]); wd.w = pk2(kd[6], kd[7]);
              *(GAS v4u*)(QE + (size_t)(t0 + i) * 512 + h * 128 + k8) = wq; *(GAS v4u*)(KE + (size_t)(t0 + i) * 512 + h * 128 + k8) = wk;
              *(LAS v4u*)(KIMG + tri::st(i, k8)) = wd; } }
        __syncthreads();
        {
            const int w = F.wave, r = lane & 31, hi = lane >> 5;
            const int kb_base = (int)(uintptr_t)KIMG + tri::rd_base(lane), vb_base = (int)(uintptr_t)VIMG + (w >> 2) * 16384 + (w & 3) * 512 + tri::rd_base(lane);
            const tri::Frag2 b0 = tri::ld<0, 0>(vb_base), b1 = tri::ld<0, 1>(vb_base), b2 = tri::ld<0, 2>(vb_base), b3 = tri::ld<0, 3>(vb_base);
            const tri::Frag2 a00 = tri::ld<0, 0>(kb_base), a01 = tri::ld<0, 1>(kb_base), a02 = tri::ld<0, 2>(kb_base), a03 = tri::ld<0, 3>(kb_base);
            const tri::Frag2 a10 = tri::ld<1, 0>(kb_base), a11 = tri::ld<1, 1>(kb_base), a12 = tri::ld<1, 2>(kb_base), a13 = tri::ld<1, 3>(kb_base);
            const tri::Frag2 a20 = tri::ld<2, 0>(kb_base), a21 = tri::ld<2, 1>(kb_base), a22 = tri::ld<2, 2>(kb_base), a23 = tri::ld<2, 3>(kb_base);
            const tri::Frag2 a30 = tri::ld<3, 0>(kb_base), a31 = tri::ld<3, 1>(kb_base), a32 = tri::ld<3, 2>(kb_base), a33 = tri::ld<3, 3>(kb_base);
            TRI_WAIT();
            const bf16x8 B0 = tri::pk(b0), B1 = tri::pk(b1), B2 = tri::pk(b2), B3 = tri::pk(b3);
            f32x16 acc[4] = {};
            acc[0] = __builtin_amdgcn_mfma_f32_32x32x16_bf16(tri::pk(a00), B0, acc[0], 0, 0, 0); acc[0] = __builtin_amdgcn_mfma_f32_32x32x16_bf16(tri::pk(a01), B1, acc[0], 0, 0, 0);
            acc[0] = __builtin_amdgcn_mfma_f32_32x32x16_bf16(tri::pk(a02), B2, acc[0], 0, 0, 0); acc[0] = __builtin_amdgcn_mfma_f32_32x32x16_bf16(tri::pk(a03), B3, acc[0], 0, 0, 0);
            acc[1] = __builtin_amdgcn_mfma_f32_32x32x16_bf16(tri::pk(a10), B0, acc[1], 0, 0, 0); acc[1] = __builtin_amdgcn_mfma_f32_32x32x16_bf16(tri::pk(a11), B1, acc[1], 0, 0, 0);
            acc[1] = __builtin_amdgcn_mfma_f32_32x32x16_bf16(tri::pk(a12), B2, acc[1], 0, 0, 0); acc[1] = __builtin_amdgcn_mfma_f32_32x32x16_bf16(tri::pk(a13), B3, acc[1], 0, 0, 0);
            acc[2] = __builtin_amdgcn_mfma_f32_32x32x16_bf16(tri::pk(a20), B0, acc[2], 0, 0, 0); acc[2] = __builtin_amdgcn_mfma_f32_32x32x16_bf16(tri::pk(a21), B1, acc[2], 0, 0, 0);
            acc[2] = __builtin_amdgcn_mfma_f32_32x32x16_bf16(tri::pk(a22), B2, acc[2], 0, 0, 0); acc[2] = __builtin_amdgcn_mfma_f32_32x32x16_bf16(tri::pk(a23), B3, acc[2], 0, 0, 0);
            acc[3] = __builtin_amdgcn_mfma_f32_32x32x16_bf16(tri::pk(a30), B0, acc[3], 0, 0, 0); acc[3] = __builtin_amdgcn_mfma_f32_32x32x16_bf16(tri::pk(a31), B1, acc[3], 0, 0, 0);
            acc[3] = __builtin_amdgcn_mfma_f32_32x32x16_bf16(tri::pk(a32), B2, acc[3], 0, 0, 0); acc[3] = __builtin_amdgcn_mfma_f32_32x32x16_bf16(tri::pk(a33), B3, acc[3], 0, 0, 0);
            bf16* ST = (bf16*)(ar + B_ST) + ((size_t)(d * NCH + c) * 4 + h) * 256 * 128;
#pragma unroll
            for (int kb = 0; kb < 4; ++kb)
#pragma unroll
                for (int q4 = 0; q4 < 4; ++q4) { v2u o; o.x = pk2(acc[kb][4 * q4], acc[kb][4 * q4 + 1]); o.y = pk2(acc[kb][4 * q4 + 2], acc[kb][4 * q4 + 3]);
                    *(GAS v2u*)(ST + (size_t)(32 * w + r) * 128 + 32 * kb + 8 * q4 + 4 * hi) = o; }
        }
    }
}

__device__ __forceinline__ void ph_gla_scan(Frame& F) {
    unsigned char* ar = F.ws + WS_ARENA; const float* DEC = (const float*)(ar + B_DEC);
    for (int gth = blockIdx.x * NTHR + F.tid; gth < 2 * 4 * 256 * 64; gth += F.G * NTHR) {
        const int kp = gth & 63, v = (gth >> 6) & 255, h = (gth >> 14) & 3, d = gth >> 16;
        unsigned* ST = (unsigned*)(ar + B_ST) + ((((size_t)d * NCH) * 4 + h) * 256 + v) * 64 + kp;
        const f32x2* DC = (const f32x2*)DEC + (((size_t)d * NCH) * 4 + h) * 64 + kp;
        float s0 = 0.f, s1 = 0.f;
        for (int i0 = 0; i0 < NCH; i0 += 4) { int cc[4]; unsigned kv[4]; f32x2 dc[4];
#pragma unroll
            for (int q = 0; q < 4; ++q) { const int i = i0 + q; cc[q] = d == 0 ? i : (i < NCH_CTX ? NCH_CTX - 1 - i : NCH - 1 - (i - NCH_CTX));
                kv[q] = ST[(size_t)cc[q] * (4 * 256 * 64)]; dc[q] = DC[(size_t)cc[q] * (4 * 64)]; }
#pragma unroll
            for (int q = 0; q < 4; ++q) { ST[(size_t)cc[q] * (4 * 256 * 64)] = pk2(s0, s1); s0 = dc[q].x * s0 + bflo(kv[q]); s1 = dc[q].y * s1 + bfhi(kv[q]); } }
    }
}

__device__ __forceinline__ void gla_out_unit(Frame& F, int cl, int h) {
    unsigned char* ar = F.ws + WS_ARENA; const int c = cl + NCH_CTX, t0 = c * 64;
    LAS unsigned char* ATT = F.lds;
    LAS float* OS = (LAS float*)(F.lds + 18432);
    LAS unsigned char* VIMG = F.lds + 86016;
    const int lane = F.lane, r = lane & 31, hi = lane >> 5, w = F.wave;
    __syncthreads();
    { const bf16* GV = (const bf16*)(ar + B_GV);
      for (int i = F.tid; i < 2048; i += NTHR) { const int rr = i >> 5, v8 = (i & 31) * 8;
          *(LAS v4u*)(VIMG + (v8 >> 7) * 16384 + tri::st(rr, v8 & 127)) = *(const GAS v4u*)(GV + (size_t)(t0 + rr) * 1024 + h * 256 + v8); } }
    {
        const int d = w >> 2, ib = (w >> 1) & 1, jb = w & 1;
        const bf16* QE = (const bf16*)(ar + B_QE) + (size_t)d * T * 512 + (size_t)(t0 + ib * 32 + r) * 512 + h * 128 + 8 * hi;
        const bf16* KE = (const bf16*)(ar + B_KE) + (size_t)d * T * 512 + (size_t)(t0 + jb * 32 + r) * 512 + h * 128 + 8 * hi;
        bf16x8 a[8], b[8];
#pragma unroll
        for (int s = 0; s < 8; ++s) { a[s] = *(const GAS bf16x8*)(KE + 16 * s); b[s] = *(const GAS bf16x8*)(QE + 16 * s); }
        f32x16 acc = {};
#pragma unroll
        for (int s = 0; s < 8; ++s) acc = __builtin_amdgcn_mfma_f32_32x32x16_bf16(a[s], b[s], acc, 0, 0, 0);
        const int i = ib * 32 + r;
#pragma unroll
        for (int q4 = 0; q4 < 4; ++q4) { float x[4];
#pragma unroll
            for (int e = 0; e < 4; ++e) { const int j = jb * 32 + 8 * q4 + 4 * hi + e; const bool keep = d == 0 ? (j <= i) : (j >= i); x[e] = keep ? acc[4 * q4 + e] : 0.f; }
            v2u o; o.x = pk2(x[0], x[1]); o.y = pk2(x[2], x[3]);
            *(LAS v2u*)(ATT + ((size_t)(d * 64 + i) * 72 + jb * 32 + 8 * q4 + 4 * hi) * 2) = o; }
    }
    __syncthreads();
    {
        const int ib = w >> 2, vq = w & 3; f32x16 o0 = {}, o1 = {};
        const int vb_base = (int)(uintptr_t)VIMG + (vq >> 1) * 16384 + (2 * (vq & 1)) * 512 + tri::rd_base(lane);
        const tri::Frag2 p0 = tri::ld<0, 0>(vb_base), p1 = tri::ld<0, 1>(vb_base), p2 = tri::ld<0, 2>(vb_base), p3 = tri::ld<0, 3>(vb_base);
        const tri::Frag2 q0 = tri::ld<1, 0>(vb_base), q1 = tri::ld<1, 1>(vb_base), q2 = tri::ld<1, 2>(vb_base), q3 = tri::ld<1, 3>(vb_base);
        TRI_WAIT();
        const bf16x8 vb0[4] = {tri::pk(p0), tri::pk(p1), tri::pk(p2), tri::pk(p3)}, vb1[4] = {tri::pk(q0), tri::pk(q1), tri::pk(q2), tri::pk(q3)};
#pragma unroll
        for (int d = 0; d < 2; ++d) {
            bf16x8 a[4];
#pragma unroll
            for (int s = 0; s < 4; ++s) a[s] = *(const LAS bf16x8*)(ATT + ((size_t)(d * 64 + ib * 32 + r) * 72 + 16 * s + 8 * hi) * 2);
#pragma unroll
            for (int s = 0; s < 4; ++s) { o0 = __builtin_amdgcn_mfma_f32_32x32x16_bf16(a[s], vb0[s], o0, 0, 0, 0); o1 = __builtin_amdgcn_mfma_f32_32x32x16_bf16(a[s], vb1[s], o1, 0, 0, 0); }
            const bf16* QE = (const bf16*)(ar + B_QE) + (size_t)d * T * 512 + (size_t)(t0 + ib * 32 + r) * 512 + h * 128 + 8 * hi;
            const bf16* ST = (const bf16*)(ar + B_ST) + ((size_t)(d * NCH + c) * 4 + h) * 256 * 128 + (size_t)(64 * vq + r) * 128 + 8 * hi;
            bf16x8 qa[8], s0[8], s1[8];
#pragma unroll
            for (int s = 0; s < 8; ++s) { qa[s] = *(const GAS bf16x8*)(QE + 16 * s); s0[s] = *(const GAS bf16x8*)(ST + 16 * s); s1[s] = *(const GAS bf16x8*)(ST + 32 * 128 + 16 * s); }
#pragma unroll
            for (int s = 0; s < 8; ++s) { o0 = __builtin_amdgcn_mfma_f32_32x32x16_bf16(qa[s], s0[s], o0, 0, 0, 0); o1 = __builtin_amdgcn_mfma_f32_32x32x16_bf16(qa[s], s1[s], o1, 0, 0, 0); }
        }
#pragma unroll
        for (int q = 0; q < 16; ++q) { const int i = ib * 32 + crow(q, hi); OS[i * 260 + 64 * vq + r] = o0[q]; OS[i * 260 + 64 * vq + 32 + r] = o1[q]; }
    }
    __syncthreads();
    {
        const int i = F.tid >> 3, seg = F.tid & 7; const LAS float* op = OS + i * 260 + 32 * seg; f32x4 x[8]; float ss = 0.f;
#pragma unroll
        for (int e = 0; e < 8; ++e) { x[e] = *(const LAS f32x4*)(op + 4 * e); ss += (x[e][0] * x[e][0] + x[e][1] * x[e][1]) + (x[e][2] * x[e][2] + x[e][3] * x[e][3]); }
        ss += __shfl_xor(ss, 1); ss += __shfl_xor(ss, 2); ss += __shfl_xor(ss, 4);
        const float rstd = 1.f / sqrtf(ss * (1.f / 256.f) + EPS);
        const float* gn = inp(I_GLANORM) + h * 256 + 32 * seg; const bf16* R = (const bf16*)(ar + B_R) + (size_t)(t0 + i) * 1024 + h * 256 + 32 * seg;
        bf16* YM = (bf16*)(ar + B_YMIX1) + (size_t)(t0 - CTX + i) * D + h * 256 + 32 * seg;
#pragma unroll
        for (int e2 = 0; e2 < 4; ++e2) { const v4u rr = *(const GAS v4u*)(R + 8 * e2); const f32x4 g0 = *(const GAS f32x4*)(gn + 8 * e2), g1 = *(const GAS f32x4*)(gn + 8 * e2 + 4);
            const f32x4 a = x[2 * e2] * rstd * g0, b = x[2 * e2 + 1] * rstd * g1; v4u o;
            o.x = pk2(a[0] * siluf_(bflo(rr.x)), a[1] * siluf_(bfhi(rr.x))); o.y = pk2(a[2] * siluf_(bflo(rr.y)), a[3] * siluf_(bfhi(rr.y)));
            o.z = pk2(b[0] * siluf_(bflo(rr.z)), b[1] * siluf_(bfhi(rr.z))); o.w = pk2(b[2] * siluf_(bflo(rr.w)), b[3] * siluf_(bfhi(rr.w)));
            *(GAS v4u*)(YM + 8 * e2) = o; }
    }
}

namespace att {
constexpr int HD = 128, NW = 8, QBLK = 32, KVBLK = 64;
constexpr float SCALE = 0.088388347648318440f;
constexpr float THR = 8.f;
constexpr int LDQ = 1024, LDK = 256, LDO = 2048;
constexpr size_t SHM_V = KVBLK * HD * 2, SHM_K = KVBLK * HD * 2, SHM_ATTN = 2 * SHM_V + 2 * SHM_K + NW * 64 * 4;
using s16x4 = __attribute__((ext_vector_type(4))) short;
#define KSWZ(row, colB) ((row) * 256 + ((colB) ^ (((row) & 7) << 4)))
#define SBAR() __builtin_amdgcn_sched_barrier(0)
__device__ __forceinline__ unsigned cvtpk(float lo, float hi) { unsigned r; asm volatile("v_cvt_pk_bf16_f32 %0, %1, %2" : "=v"(r) : "v"(lo), "v"(hi)); return r; }
__device__ __forceinline__ void partialSM(f32x16& p0, f32x16& p1, float& m_reg, float& mn, float& alpha) {
  constexpr float C = SCALE * 1.4426950408889634f;
  float pmax = p0[0];
#pragma unroll
  for (int r = 1; r < 16; ++r) pmax = fmaxf(pmax, p0[r]);
#pragma unroll
  for (int r = 0; r < 16; ++r) pmax = fmaxf(pmax, p1[r]);
  { auto rr = __builtin_amdgcn_permlane32_swap(__float_as_uint(pmax), __float_as_uint(pmax), false, false);
    pmax = fmaxf(__uint_as_float(rr[0]), __uint_as_float(rr[1])); }
  if (__builtin_expect(__all(pmax - m_reg <= THR / SCALE), 1)) { mn = m_reg; alpha = 1.f; }
  else { mn = fmaxf(m_reg, pmax); alpha = __builtin_amdgcn_exp2f((m_reg - mn) * C); m_reg = mn; }
  float mnC = -mn * C;
#pragma unroll
  for (int r = 0; r < 16; ++r) p0[r] = fmaf(p0[r], C, mnC);
#pragma unroll
  for (int r = 0; r < 16; ++r) p1[r] = fmaf(p1[r], C, mnC);
#pragma unroll
  for (int r = 0; r < 16; ++r) p0[r] = __builtin_amdgcn_exp2f(p0[r]);
}
__device__ __forceinline__ void finishSM(f32x16& p0, f32x16& p1, float alpha, float& l_reg, bf16x8& pa0, bf16x8& pa1, bf16x8& pa2, bf16x8& pa3) {
#pragma unroll
  for (int r = 0; r < 16; ++r) p1[r] = __builtin_amdgcn_exp2f(p1[r]);
  float ps = 0;
#pragma unroll
  for (int r = 0; r < 16; ++r) ps += p0[r];
#pragma unroll
  for (int r = 0; r < 16; ++r) ps += p1[r];
  { auto rr = __builtin_amdgcn_permlane32_swap(__float_as_uint(ps), __float_as_uint(ps), false, false);
    ps = __uint_as_float(rr[0]) + __uint_as_float(rr[1]); }
  l_reg = l_reg * alpha + ps;
#define PK4(P, BASE, OUT) do { unsigned a0 = cvtpk(P[BASE + 0], P[BASE + 1]), a1 = cvtpk(P[BASE + 2], P[BASE + 3]);   \
    unsigned b0 = cvtpk(P[BASE + 4], P[BASE + 5]), b1 = cvtpk(P[BASE + 6], P[BASE + 7]);                              \
    auto r0 = __builtin_amdgcn_permlane32_swap(a0, b0, false, false); auto r1 = __builtin_amdgcn_permlane32_swap(a1, b1, false, false); \
    u32x4 w = {r0[0], r1[0], r0[1], r1[1]}; OUT = *reinterpret_cast<bf16x8*>(&w); } while (0)
  PK4(p0, 0, pa0); PK4(p0, 8, pa1); PK4(p1, 0, pa2); PK4(p1, 8, pa3);
#undef PK4
}
__device__ __forceinline__ void qkt(f32x16& p0, f32x16& p1, const bf16* Ks, const bf16x8* qr, int r32, int hi) {
  p0 = f32x16{}; p1 = f32x16{};
#pragma unroll
  for (int d0 = 0; d0 < 8; ++d0) { int cb = (d0 * 16 + hi * 8) * 2;
    bf16x8 b0 = *reinterpret_cast<const bf16x8*>((const char*)Ks + KSWZ(r32, cb));
    bf16x8 b1 = *reinterpret_cast<const bf16x8*>((const char*)Ks + KSWZ(32 + r32, cb));
    p0 = __builtin_amdgcn_mfma_f32_32x32x16_bf16(b0, qr[d0], p0, 0, 0, 0);
    p1 = __builtin_amdgcn_mfma_f32_32x32x16_bf16(b1, qr[d0], p1, 0, 0, 0); }
}
__device__ __forceinline__ int v_st(int k, int c) { const int kk = (k & ~0xC) | ((k & 4) << 1) | ((k & 8) >> 1); return ((kk >> 3) * 4 + (c >> 5)) * 512 + ((kk & 7) * 32 + (c & 31)) * 2; }
__device__ __forceinline__ int v_rd_base(int lane) { return ((lane & 3) << 3) | (((lane >> 2) & 3) << 6) | (((lane >> 4) & 1) << 5) | (((lane >> 5) & 1) << 8); }
constexpr int v_rd_off(int d0, int ks, int half) { return d0 * 512 + ks * 4096 + half * 2048; }
template <int OFF> __device__ __forceinline__ s16x4 tr_read(int vb) {
  s16x4 r; asm volatile("ds_read_b64_tr_b16 %0, %1 offset:%2" : "=&v"(r) : "v"(vb), "i"(OFF) : "memory"); return r;
}
template <int D0> __device__ __forceinline__ void pv_one(f32x16& od, int vb, bf16x8 pa0, bf16x8 pa1, bf16x8 pa2, bf16x8 pa3) {
  const s16x4 l0 = tr_read<v_rd_off(D0, 0, 0)>(vb), h0 = tr_read<v_rd_off(D0, 0, 1)>(vb), l1 = tr_read<v_rd_off(D0, 1, 0)>(vb), h1 = tr_read<v_rd_off(D0, 1, 1)>(vb);
  const s16x4 l2 = tr_read<v_rd_off(D0, 2, 0)>(vb), h2 = tr_read<v_rd_off(D0, 2, 1)>(vb), l3 = tr_read<v_rd_off(D0, 3, 0)>(vb), h3 = tr_read<v_rd_off(D0, 3, 1)>(vb);
  asm volatile("s_waitcnt lgkmcnt(0)" ::: "memory"); SBAR();
#define PK(L, H) (bf16x8){L[0], L[1], L[2], L[3], H[0], H[1], H[2], H[3]}
  od = __builtin_amdgcn_mfma_f32_32x32x16_bf16(pa0, PK(l0, h0), od, 0, 0, 0);
  od = __builtin_amdgcn_mfma_f32_32x32x16_bf16(pa1, PK(l1, h1), od, 0, 0, 0);
  od = __builtin_amdgcn_mfma_f32_32x32x16_bf16(pa2, PK(l2, h2), od, 0, 0, 0);
  od = __builtin_amdgcn_mfma_f32_32x32x16_bf16(pa3, PK(l3, h3), od, 0, 0, 0);
#undef PK
}
__device__ __forceinline__ void pv_d0(f32x16* o, int vb, bf16x8 pa0, bf16x8 pa1, bf16x8 pa2, bf16x8 pa3) {
  pv_one<0>(o[0], vb, pa0, pa1, pa2, pa3); pv_one<1>(o[1], vb, pa0, pa1, pa2, pa3); pv_one<2>(o[2], vb, pa0, pa1, pa2, pa3); pv_one<3>(o[3], vb, pa0, pa1, pa2, pa3);
}
typedef int v8i __attribute__((ext_vector_type(8)));
typedef int v4i __attribute__((ext_vector_type(4)));
constexpr size_t SHM_K8 = KVBLK * 128;
#define K8ADDR(row, g) ((row) * 128 + ((((g) ^ ((row) >> 1)) & 7) << 4))
__device__ __forceinline__ void qkt8(f32x16& p0, f32x16& p1, const char* Ks, const v8i& q0, const v8i& q1, int r32, int hi, int sc1) {
  p0 = f32x16{}; p1 = f32x16{};
  const int g0 = 4 * hi;
  { const v4i a00 = *reinterpret_cast<const v4i*>(Ks + K8ADDR(r32, g0)), a01 = *reinterpret_cast<const v4i*>(Ks + K8ADDR(r32, g0 + 1));
    const v4i b00 = *reinterpret_cast<const v4i*>(Ks + K8ADDR(32 + r32, g0)), b01 = *reinterpret_cast<const v4i*>(Ks + K8ADDR(32 + r32, g0 + 1));
    const v8i ka0 = __builtin_shufflevector(a00, a01, 0, 1, 2, 3, 4, 5, 6, 7), kb0 = __builtin_shufflevector(b00, b01, 0, 1, 2, 3, 4, 5, 6, 7);
    asm volatile("s_nop 1\n\tv_mfma_scale_f32_32x32x64_f8f6f4 %0, %1, %2, %0, %3, %3 op_sel_hi:[0,0,0]" : "+v"(p0) : "v"(ka0), "v"(q0), "v"(sc1));
    asm volatile("s_nop 1\n\tv_mfma_scale_f32_32x32x64_f8f6f4 %0, %1, %2, %0, %3, %3 op_sel_hi:[0,0,0]" : "+v"(p1) : "v"(kb0), "v"(q0), "v"(sc1) : "memory"); }
  { const v4i a10 = *reinterpret_cast<const v4i*>(Ks + K8ADDR(r32, g0 + 2)), a11 = *reinterpret_cast<const v4i*>(Ks + K8ADDR(r32, g0 + 3));
    const v4i b10 = *reinterpret_cast<const v4i*>(Ks + K8ADDR(32 + r32, g0 + 2)), b11 = *reinterpret_cast<const v4i*>(Ks + K8ADDR(32 + r32, g0 + 3));
    const v8i ka1 = __builtin_shufflevector(a10, a11, 0, 1, 2, 3, 4, 5, 6, 7), kb1 = __builtin_shufflevector(b10, b11, 0, 1, 2, 3, 4, 5, 6, 7);
    asm volatile("s_nop 1\n\tv_mfma_scale_f32_32x32x64_f8f6f4 %0, %1, %2, %0, %3, %3 op_sel_hi:[0,0,0]" : "+v"(p0) : "v"(ka1), "v"(q1), "v"(sc1));
    asm volatile("s_nop 1\n\tv_mfma_scale_f32_32x32x64_f8f6f4 %0, %1, %2, %0, %3, %3 op_sel_hi:[0,0,0]" : "+v"(p1) : "v"(kb1), "v"(q1), "v"(sc1)); }
  asm volatile("s_nop 15\n\ts_nop 7" : "+v"(p0), "+v"(p1));
}
__device__ __forceinline__ void attn_dense_body(const bf16* __restrict__ Qb, const unsigned char* __restrict__ Kh8, const bf16* __restrict__ Vh, bf16* __restrict__ Ob, int seq, char* lds) {
  constexpr int SDEPTH = 2;
  const int tid = threadIdx.x, wid = tid >> 6, lane = tid & 63, r32 = lane & 31, hi = lane >> 5;
  bf16* V_lds = (bf16*)lds; char* K_lds = lds + 2 * SHM_V;
  float* ws = (float*)(lds + 2 * SHM_V + 2 * SHM_K8) + wid * 64; float* li_l = ws; float* al_l = ws + 32;
  float m_reg = -1e30f, l_reg = 0; f32x16 o[4] = {}; bf16x8 qr[8];
  const bf16* Qw = Qb + (long)(wid * QBLK + r32) * LDQ + hi * 8;
#pragma unroll
  for (int d0 = 0; d0 < 8; ++d0) qr[d0] = *reinterpret_cast<const bf16x8*>(Qw + d0 * 16);
  v8i q8a, q8b; const int sc1 = 0x7f7f7f7f;
  { int w[16];
#pragma unroll
    for (int d0 = 0; d0 < 8; ++d0) { const u32x4 x = *reinterpret_cast<const u32x4*>(&qr[d0]);
      w[2 * d0] = (int)pk4_fp8(bflo(x.x), bfhi(x.x), bflo(x.y), bfhi(x.y)); w[2 * d0 + 1] = (int)pk4_fp8(bflo(x.z), bfhi(x.z), bflo(x.w), bfhi(x.w)); }
    q8a = (v8i){w[0], w[1], w[2], w[3], w[4], w[5], w[6], w[7]}; q8b = (v8i){w[8], w[9], w[10], w[11], w[12], w[13], w[14], w[15]}; }
  const int krow = tid >> 3, kg = tid & 7, kst = K8ADDR(krow, kg);
  const int sr = tid >> 4, sc = (tid & 15) * 8, vst0 = v_st(sr, sc), vst1 = v_st(32 + sr, sc);
  const int vb0 = (int)(uintptr_t)V_lds + v_rd_base(lane);
  struct { bf16x8 vs0, vs1; v4i ks; } sr_[SDEPTH];
#define SLOAD(i, k0) do { sr_[i].vs0 = *reinterpret_cast<const bf16x8*>(&Vh[(long)((k0) + sr) * LDK + sc]); sr_[i].vs1 = *reinterpret_cast<const bf16x8*>(&Vh[(long)((k0) + 32 + sr) * LDK + sc]); \
    sr_[i].ks = *reinterpret_cast<const v4i*>(&Kh8[(long)((k0) + krow) * 256 + kg * 16]); } while (0)
#define SWRITE(b, i) do { *(bf16x8*)((char*)V_lds + (b) * SHM_V + vst0) = sr_[i].vs0;          \
    *(bf16x8*)((char*)V_lds + (b) * SHM_V + vst1) = sr_[i].vs1;                                \
    *(v4i*)(K_lds + (b) * SHM_K8 + kst) = sr_[i].ks; } while (0)
#define SWAIT() do { asm volatile("s_waitcnt vmcnt(3)" ::: "memory"); } while (0)
#define RESC(a) do { if (__any((a) < 1.f)) { if (hi == 0) al_l[r32] = (a); asm volatile("s_waitcnt lgkmcnt(0)" ::: "memory"); \
    _Pragma("unroll") for (int d = 0; d < 4; ++d) _Pragma("unroll") for (int r = 0; r < 16; ++r) o[d][r] *= al_l[crow(r, hi)]; } } while (0)
  f32x16 pA0, pA1, pB0, pB1; float mnA, mnB, alA, alB; bf16x8 pa0, pa1, pa2, pa3; const int NT = seq / KVBLK;
  constexpr int SE = 0, SO = SDEPTH - 1;
  SLOAD(SE, 0); asm volatile("s_waitcnt vmcnt(0)" ::: "memory"); SWRITE(0, SE); __syncthreads();
  qkt8(pA0, pA1, K_lds, q8a, q8b, r32, hi, sc1); partialSM(pA0, pA1, m_reg, mnA, alA);
  SLOAD(SO, KVBLK); if (2 < NT) SLOAD(SE, 2 * KVBLK);
  SWAIT(); SWRITE(1, SO); __syncthreads();
  for (int j = 1; j + 1 < NT; j += 2) {
    SBAR(); qkt8(pB0, pB1, K_lds + SHM_K8, q8a, q8b, r32, hi, sc1);
    finishSM(pA0, pA1, alA, l_reg, pa0, pa1, pa2, pa3); SBAR();
    SLOAD(SO, (j + SDEPTH) * KVBLK); SBAR();
    pv_d0(o, vb0, pa0, pa1, pa2, pa3); partialSM(pB0, pB1, m_reg, mnB, alB);
    __syncthreads(); SWAIT(); SWRITE(0, SE);
    RESC(alB); __syncthreads();
    SBAR(); qkt8(pA0, pA1, K_lds, q8a, q8b, r32, hi, sc1);
    finishSM(pB0, pB1, alB, l_reg, pa0, pa1, pa2, pa3); SBAR();
    if (j + 3 < NT) SLOAD(SE, (j + 1 + SDEPTH) * KVBLK); SBAR();
    pv_d0(o, vb0 + (int)SHM_V, pa0, pa1, pa2, pa3); partialSM(pA0, pA1, m_reg, mnA, alA);
    __syncthreads(); SWAIT(); SWRITE(1, SO);
    RESC(alA); __syncthreads();
  }
  SBAR(); qkt8(pB0, pB1, K_lds + SHM_K8, q8a, q8b, r32, hi, sc1);
  finishSM(pA0, pA1, alA, l_reg, pa0, pa1, pa2, pa3); SBAR();
  pv_d0(o, vb0, pa0, pa1, pa2, pa3); partialSM(pB0, pB1, m_reg, mnB, alB);
  __syncthreads(); RESC(alB);
  finishSM(pB0, pB1, alB, l_reg, pa0, pa1, pa2, pa3); SBAR();
  pv_d0(o, vb0 + (int)SHM_V, pa0, pa1, pa2, pa3);
  if (hi == 0) li_l[r32] = l_reg; asm volatile("s_waitcnt lgkmcnt(0)" ::: "memory");
  float rli[16];
#pragma unroll
  for (int r = 0; r < 16; ++r) rli[r] = __builtin_amdgcn_rcpf(li_l[crow(r, hi)]);
  bf16* Ow = Ob + (long)(wid * QBLK) * LDO;
#pragma unroll
  for (int r = 0; r < 16; ++r) { int orow = crow(r, hi);
#pragma unroll
    for (int d0 = 0; d0 < 4; ++d0) Ow[(long)orow * LDO + d0 * 32 + r32] = (bf16)f2bf(o[d0][r] * rli[r]); }
  __syncthreads();
#undef SLOAD
#undef SWRITE
#undef SWAIT
#undef RESC
}
constexpr float THR8 = 6.f;
#define V8ADDR(d, g) ((d) * 64 + ((((g) ^ ((d) >> 2)) & 3) << 4))
__device__ __forceinline__ void partialSM8(f32x16& p0, f32x16& p1, float& m_reg, float& mn, float& alpha) {
  constexpr float C = SCALE * 1.4426950408889634f;
  float pmax = p0[0];
#pragma unroll
  for (int r = 1; r < 16; ++r) pmax = fmaxf(pmax, p0[r]);
#pragma unroll
  for (int r = 0; r < 16; ++r) pmax = fmaxf(pmax, p1[r]);
  { auto rr = __builtin_amdgcn_permlane32_swap(__float_as_uint(pmax), __float_as_uint(pmax), false, false);
    pmax = fmaxf(__uint_as_float(rr[0]), __uint_as_float(rr[1])); }
  if (__builtin_expect(__all(pmax - m_reg <= THR8 / SCALE), 1)) { mn = m_reg; alpha = 1.f; }
  else { mn = fmaxf(m_reg, pmax); alpha = __builtin_amdgcn_exp2f((m_reg - mn) * C); m_reg = mn; }
  float mnC = -mn * C;
#pragma unroll
  for (int r = 0; r < 16; ++r) p0[r] = fmaf(p0[r], C, mnC);
#pragma unroll
  for (int r = 0; r < 16; ++r) p1[r] = fmaf(p1[r], C, mnC);
#pragma unroll
  for (int r = 0; r < 16; ++r) p0[r] = __builtin_amdgcn_exp2f(p0[r]);
}
__device__ __forceinline__ void finishSM8(f32x16& p0, f32x16& p1, float alpha, float& l_reg, v8i& pa) {
#pragma unroll
  for (int r = 0; r < 16; ++r) p1[r] = __builtin_amdgcn_exp2f(p1[r]);
  float ps = 0;
#pragma unroll
  for (int r = 0; r < 16; ++r) ps += p0[r];
#pragma unroll
  for (int r = 0; r < 16; ++r) ps += p1[r];
  { auto rr = __builtin_amdgcn_permlane32_swap(__float_as_uint(ps), __float_as_uint(ps), false, false);
    ps = __uint_as_float(rr[0]) + __uint_as_float(rr[1]); }
  l_reg = l_reg * alpha + ps;
  pa = (v8i){(int)pk4_fp8(p0[0], p0[1], p0[2], p0[3]), (int)pk4_fp8(p0[4], p0[5], p0[6], p0[7]), (int)pk4_fp8(p0[8], p0[9], p0[10], p0[11]), (int)pk4_fp8(p0[12], p0[13], p0[14], p0[15]),
             (int)pk4_fp8(p1[0], p1[1], p1[2], p1[3]), (int)pk4_fp8(p1[4], p1[5], p1[6], p1[7]), (int)pk4_fp8(p1[8], p1[9], p1[10], p1[11]), (int)pk4_fp8(p1[12], p1[13], p1[14], p1[15])};
}
__device__ __forceinline__ void pv8(f32x16* o, const char* Vs, const v8i& pa, int r32, int hi, int sc1) {
#pragma unroll
  for (int d0 = 0; d0 < 4; ++d0) { const int d = 32 * d0 + r32;
    const v4i x0 = *reinterpret_cast<const v4i*>(Vs + V8ADDR(d, 2 * hi)), x1 = *reinterpret_cast<const v4i*>(Vs + V8ADDR(d, 2 * hi + 1));
    const v8i vb = __builtin_shufflevector(x0, x1, 0, 1, 2, 3, 4, 5, 6, 7);
    asm volatile("s_nop 1\n\tv_mfma_scale_f32_32x32x64_f8f6f4 %0, %1, %2, %0, %3, %3 op_sel_hi:[0,0,0]" : "+v"(o[d0]) : "v"(pa), "v"(vb), "v"(sc1)); }
  asm volatile("s_nop 15\n\ts_nop 7" : "+v"(o[0]), "+v"(o[1]), "+v"(o[2]), "+v"(o[3]));
}
__device__ __forceinline__ void attn_dense_body_pv8(const bf16* __restrict__ Qb, const unsigned char* __restrict__ Kh8, const unsigned char* __restrict__ Vt8, bf16* __restrict__ Ob, int seq, char* lds) {
  constexpr int SDEPTH = 2; constexpr size_t SHM_V8 = 8192;
  const int tid = threadIdx.x, wid = tid >> 6, lane = tid & 63, r32 = lane & 31, hi = lane >> 5;
  char* V_lds = lds; char* K_lds = lds + 2 * SHM_V8;
  float* ws = (float*)(lds + 2 * SHM_V8 + 2 * SHM_K8) + wid * 64; float* li_l = ws; float* al_l = ws + 32;
  float m_reg = -1e30f, l_reg = 0; f32x16 o[4] = {}; bf16x8 qr[8];
  const bf16* Qw = Qb + (long)(wid * QBLK + r32) * LDQ + hi * 8;
#pragma unroll
  for (int d0 = 0; d0 < 8; ++d0) qr[d0] = *reinterpret_cast<const bf16x8*>(Qw + d0 * 16);
  v8i q8a, q8b; const int sc1 = 0x7f7f7f7f;
  { int w[16];
#pragma unroll
    for (int d0 = 0; d0 < 8; ++d0) { const u32x4 x = *reinterpret_cast<const u32x4*>(&qr[d0]);
      w[2 * d0] = (int)pk4_fp8(bflo(x.x), bfhi(x.x), bflo(x.y), bfhi(x.y)); w[2 * d0 + 1] = (int)pk4_fp8(bflo(x.z), bfhi(x.z), bflo(x.w), bfhi(x.w)); }
    q8a = (v8i){w[0], w[1], w[2], w[3], w[4], w[5], w[6], w[7]}; q8b = (v8i){w[8], w[9], w[10], w[11], w[12], w[13], w[14], w[15]}; }
  const int krow = tid >> 3, kg = tid & 7, kst = K8ADDR(krow, kg);
  const int vrow = tid >> 2, vg = tid & 3, vst = V8ADDR(vrow, vg);
  struct { v4i vs, ks; } sr_[SDEPTH];
#define SLOAD(i, k0) do { sr_[i].vs = *reinterpret_cast<const v4i*>(&Vt8[(long)((k0) / KVBLK) * 8192 + tid * 16]); sr_[i].ks = *reinterpret_cast<const v4i*>(&Kh8[(long)((k0) + krow) * 256 + kg * 16]); } while (0)
#define SWRITE(b, i) do { *(v4i*)(V_lds + (b) * SHM_V8 + vst) = sr_[i].vs; *(v4i*)(K_lds + (b) * SHM_K8 + kst) = sr_[i].ks; } while (0)
#define SWAIT() do { asm volatile("s_waitcnt vmcnt(2)" ::: "memory"); } while (0)
#define RESC(a) do { if (__any((a) < 1.f)) { if (hi == 0) al_l[r32] = (a); asm volatile("s_waitcnt lgkmcnt(0)" ::: "memory"); \
    _Pragma("unroll") for (int d = 0; d < 4; ++d) _Pragma("unroll") for (int r = 0; r < 16; ++r) o[d][r] *= al_l[crow(r, hi)]; } } while (0)
  f32x16 pA0, pA1, pB0, pB1; float mnA, mnB, alA, alB; v8i pa; const int NT = seq / KVBLK;
  constexpr int SE = 0, SO = SDEPTH - 1;
  SLOAD(SE, 0); asm volatile("s_waitcnt vmcnt(0)" ::: "memory"); SWRITE(0, SE); __syncthreads();
  qkt8(pA0, pA1, K_lds, q8a, q8b, r32, hi, sc1); partialSM8(pA0, pA1, m_reg, mnA, alA);
  SLOAD(SO, KVBLK); if (2 < NT) SLOAD(SE, 2 * KVBLK);
  SWAIT(); SWRITE(1, SO); __syncthreads();
  for (int j = 1; j + 1 < NT; j += 2) {
    SBAR(); qkt8(pB0, pB1, K_lds + SHM_K8, q8a, q8b, r32, hi, sc1);
    finishSM8(pA0, pA1, alA, l_reg, pa); SBAR();
    SLOAD(SO, (j + SDEPTH) * KVBLK); SBAR();
    pv8(o, V_lds, pa, r32, hi, sc1); partialSM8(pB0, pB1, m_reg, mnB, alB);
    __syncthreads(); SWAIT(); SWRITE(0, SE);
    RESC(alB); __syncthreads();
    SBAR(); qkt8(pA0, pA1, K_lds, q8a, q8b, r32, hi, sc1);
    finishSM8(pB0, pB1, alB, l_reg, pa); SBAR();
    if (j + 3 < NT) SLOAD(SE, (j + 1 + SDEPTH) * KVBLK); SBAR();
    pv8(o, V_lds + SHM_V8, pa, r32, hi, sc1); partialSM8(pA0, pA1, m_reg, mnA, alA);
    __syncthreads(); SWAIT(); SWRITE(1, SO);
    RESC(alA); __syncthreads();
  }
  SBAR(); qkt8(pB0, pB1, K_lds + SHM_K8, q8a, q8b, r32, hi, sc1);
  finishSM8(pA0, pA1, alA, l_reg, pa); SBAR();
  pv8(o, V_lds, pa, r32, hi, sc1); partialSM8(pB0, pB1, m_reg, mnB, alB);
  __syncthreads(); RESC(alB);
  finishSM8(pB0, pB1, alB, l_reg, pa); SBAR();
  pv8(o, V_lds + SHM_V8, pa, r32, hi, sc1);
  if (hi == 0) li_l[r32] = l_reg; asm volatile("s_waitcnt lgkmcnt(0)" ::: "memory");
  float rli[16];
#pragma unroll
  for (int r = 0; r < 16; ++r) rli[r] = __builtin_amdgcn_rcpf(li_l[crow(r, hi)]);
  bf16* Ow = Ob + (long)(wid * QBLK) * LDO;
#pragma unroll
  for (int r = 0; r < 16; ++r) { int orow = crow(r, hi);
#pragma unroll
    for (int d0 = 0; d0 < 4; ++d0) Ow[(long)orow * LDO + d0 * 32 + r32] = (bf16)f2bf(o[d0][r] * rli[r]); }
  __syncthreads();
#undef SLOAD
#undef SWRITE
#undef SWAIT
#undef RESC
}
constexpr float QS8 = SCALE * 1.4426950408889634f * 8.f;
constexpr float THR2 = 8.6f;
__device__ __forceinline__ int cvt4_fp8(float a, float b, float c, float d) { int r; asm("v_cvt_pk_fp8_f32 %0, %1, %2" : "=v"(r) : "v"(a), "v"(b)); asm("v_cvt_pk_fp8_f32 %0, %1, %2 op_sel:[0,0,1]" : "+v"(r) : "v"(c), "v"(d)); return r; }
__device__ __forceinline__ void qkt8m(f32x16& p0, f32x16& p1, const f32x16& mi, const char* Ks, const v8i& q0, const v8i& q1, int r32, int hi, int sc1, int scq) {
  const int g0 = 4 * hi;
  { const v4i a00 = *reinterpret_cast<const v4i*>(Ks + K8ADDR(r32, g0)), a01 = *reinterpret_cast<const v4i*>(Ks + K8ADDR(r32, g0 + 1));
    const v4i b00 = *reinterpret_cast<const v4i*>(Ks + K8ADDR(32 + r32, g0)), b01 = *reinterpret_cast<const v4i*>(Ks + K8ADDR(32 + r32, g0 + 1));
    const v8i ka0 = __builtin_shufflevector(a00, a01, 0, 1, 2, 3, 4, 5, 6, 7), kb0 = __builtin_shufflevector(b00, b01, 0, 1, 2, 3, 4, 5, 6, 7);
    asm volatile("s_nop 1\n\tv_mfma_scale_f32_32x32x64_f8f6f4 %0, %1, %2, %3, %4, %5 op_sel_hi:[0,0,0]" : "=&v"(p0) : "v"(ka0), "v"(q0), "v"(mi), "v"(sc1), "v"(scq));
    asm volatile("s_nop 1\n\tv_mfma_scale_f32_32x32x64_f8f6f4 %0, %1, %2, %3, %4, %5 op_sel_hi:[0,0,0]" : "=&v"(p1) : "v"(kb0), "v"(q0), "v"(mi), "v"(sc1), "v"(scq) : "memory"); }
  { const v4i a10 = *reinterpret_cast<const v4i*>(Ks + K8ADDR(r32, g0 + 2)), a11 = *reinterpret_cast<const v4i*>(Ks + K8ADDR(r32, g0 + 3));
    const v4i b10 = *reinterpret_cast<const v4i*>(Ks + K8ADDR(32 + r32, g0 + 2)), b11 = *reinterpret_cast<const v4i*>(Ks + K8ADDR(32 + r32, g0 + 3));
    const v8i ka1 = __builtin_shufflevector(a10, a11, 0, 1, 2, 3, 4, 5, 6, 7), kb1 = __builtin_shufflevector(b10, b11, 0, 1, 2, 3, 4, 5, 6, 7);
    asm volatile("s_nop 1\n\tv_mfma_scale_f32_32x32x64_f8f6f4 %0, %1, %2, %0, %3, %4 op_sel_hi:[0,0,0]" : "+v"(p0) : "v"(ka1), "v"(q1), "v"(sc1), "v"(scq));
    asm volatile("s_nop 1\n\tv_mfma_scale_f32_32x32x64_f8f6f4 %0, %1, %2, %0, %3, %4 op_sel_hi:[0,0,0]" : "+v"(p1) : "v"(kb1), "v"(q1), "v"(sc1), "v"(scq)); }
}
__device__ __forceinline__ void xdl_pad2(f32x16& a, f32x16& b) { asm volatile("s_nop 15\n\ts_nop 7" : "+v"(a), "+v"(b)); }
template <bool FIRST> __device__ __forceinline__ void partialSM8m(f32x16& p0, f32x16& p1, float& M, f32x16& mi, float& alpha) {
  float pmax = p0[0];
#pragma unroll
  for (int r = 1; r < 16; ++r) pmax = fmaxf(pmax, p0[r]);
#pragma unroll
  for (int r = 0; r < 16; ++r) pmax = fmaxf(pmax, p1[r]);
  { auto rr = __builtin_amdgcn_permlane32_swap(__float_as_uint(pmax), __float_as_uint(pmax), false, false);
    pmax = fmaxf(__uint_as_float(rr[0]), __uint_as_float(rr[1])); }
  if (!FIRST && __builtin_expect(__all(pmax <= THR2), 1)) { alpha = 1.f; }
  else { const float d = FIRST ? pmax : fmaxf(pmax, 0.f); alpha = FIRST ? 1.f : __builtin_amdgcn_exp2f(-d); M += d;
#pragma unroll
    for (int r = 0; r < 16; ++r) { p0[r] -= d; p1[r] -= d; }
    const float nm = -M;
#pragma unroll
    for (int r = 0; r < 16; ++r) mi[r] = nm;
    asm volatile("" : "+v"(mi)); }
#pragma unroll
  for (int r = 0; r < 16; ++r) p0[r] = __builtin_amdgcn_exp2f(p0[r]);
}
__device__ __forceinline__ void finishSM8m(f32x16& p0, f32x16& p1, float alpha, float& l_reg, v8i& pa) {
#pragma unroll
  for (int r = 0; r < 16; ++r) p1[r] = __builtin_amdgcn_exp2f(p1[r]);
  float sa = p0[0], sb = p1[0];
#pragma unroll
  for (int r = 1; r < 16; ++r) { sa += p0[r]; sb += p1[r]; }
  float ps = sa + sb;
  { auto rr = __builtin_amdgcn_permlane32_swap(__float_as_uint(ps), __float_as_uint(ps), false, false);
    ps = __uint_as_float(rr[0]) + __uint_as_float(rr[1]); }
  l_reg = l_reg * alpha + ps;
  pa = (v8i){cvt4_fp8(p0[0], p0[1], p0[2], p0[3]), cvt4_fp8(p0[4], p0[5], p0[6], p0[7]), cvt4_fp8(p0[8], p0[9], p0[10], p0[11]), cvt4_fp8(p0[12], p0[13], p0[14], p0[15]),
             cvt4_fp8(p1[0], p1[1], p1[2], p1[3]), cvt4_fp8(p1[4], p1[5], p1[6], p1[7]), cvt4_fp8(p1[8], p1[9], p1[10], p1[11]), cvt4_fp8(p1[12], p1[13], p1[14], p1[15])};
}
__device__ __forceinline__ void pv8m(f32x16* o, const char* Vs, const v8i& pa, int r32, int hi, int sc1) {
#pragma unroll
  for (int d0 = 0; d0 < 4; ++d0) { const int d = 32 * d0 + r32;
    const v4i x0 = *reinterpret_cast<const v4i*>(Vs + V8ADDR(d, 2 * hi)), x1 = *reinterpret_cast<const v4i*>(Vs + V8ADDR(d, 2 * hi + 1));
    const v8i vb = __builtin_shufflevector(x0, x1, 0, 1, 2, 3, 4, 5, 6, 7);
    asm volatile("s_nop 1\n\tv_mfma_scale_f32_32x32x64_f8f6f4 %0, %1, %2, %0, %3, %3 op_sel_hi:[0,0,0]" : "+v"(o[d0]) : "v"(pa), "v"(vb), "v"(sc1)); }
}
__device__ __forceinline__ void attn_dense_body_m(const bf16* __restrict__ Qb, const unsigned char* __restrict__ Kh8, const unsigned char* __restrict__ Vt8, bf16* __restrict__ Ob, int seq, char* lds) {
  constexpr int SDEPTH = 2; constexpr size_t SHM_V8 = 8192;
  const int tid = threadIdx.x, wid = tid >> 6, lane = tid & 63, r32 = lane & 31, hi = lane >> 5;
  char* V_lds = lds; char* K_lds = lds + 2 * SHM_V8;
  float* ws = (float*)(lds + 2 * SHM_V8 + 2 * SHM_K8) + wid * 64; float* li_l = ws; float* al_l = ws + 32;
  float M = 0.f, l_reg = 0; f32x16 o[4] = {}; f32x16 mi = {}; asm volatile("" : "+v"(mi));
  v8i q8a, q8b; const int sc1 = 0x7f7f7f7f, scq = 0x7c7c7c7c;
  { bf16x8 qr[8]; const bf16* Qw = Qb + (long)(wid * QBLK + r32) * LDQ + hi * 8;
#pragma unroll
    for (int d0 = 0; d0 < 8; ++d0) qr[d0] = *reinterpret_cast<const bf16x8*>(Qw + d0 * 16);
    int w[16];
#pragma unroll
    for (int d0 = 0; d0 < 8; ++d0) { const u32x4 x = *reinterpret_cast<const u32x4*>(&qr[d0]);
      w[2 * d0] = (int)pk4_fp8(bflo(x.x) * QS8, bfhi(x.x) * QS8, bflo(x.y) * QS8, bfhi(x.y) * QS8); w[2 * d0 + 1] = (int)pk4_fp8(bflo(x.z) * QS8, bfhi(x.z) * QS8, bflo(x.w) * QS8, bfhi(x.w) * QS8); }
    q8a = (v8i){w[0], w[1], w[2], w[3], w[4], w[5], w[6], w[7]}; q8b = (v8i){w[8], w[9], w[10], w[11], w[12], w[13], w[14], w[15]}; }
  const int krow = tid >> 3, kg = tid & 7, kst = K8ADDR(krow, kg);
  const int vrow = tid >> 2, vg = tid & 3, vst = V8ADDR(vrow, vg);
  struct { v4i vs, ks; } sr_[SDEPTH];
#define SLOAD(i, k0) do { sr_[i].vs = *reinterpret_cast<const v4i*>(&Vt8[(long)((k0) / KVBLK) * 8192 + tid * 16]); sr_[i].ks = *reinterpret_cast<const v4i*>(&Kh8[(long)((k0) + krow) * 256 + kg * 16]); } while (0)
#define SWRITE(b, i) do { *(v4i*)(V_lds + (b) * SHM_V8 + vst) = sr_[i].vs; *(v4i*)(K_lds + (b) * SHM_K8 + kst) = sr_[i].ks; } while (0)
#define SWAIT() do { asm volatile("s_waitcnt vmcnt(2)" ::: "memory"); } while (0)
#define RESC(a) do { if (__any((a) < 1.f)) { if (hi == 0) al_l[r32] = (a); xdl_pad2(o[0], o[1]); xdl_pad2(o[2], o[3]); asm volatile("s_waitcnt lgkmcnt(0)" ::: "memory"); \
    _Pragma("unroll") for (int d = 0; d < 4; ++d) _Pragma("unroll") for (int r = 0; r < 16; ++r) o[d][r] *= al_l[crow(r, hi)]; } } while (0)
  f32x16 pA0, pA1, pB0, pB1; float alA, alB; v8i pa; const int NT = seq / KVBLK;
  constexpr int SE = 0, SO = SDEPTH - 1;
  SLOAD(SE, 0); asm volatile("s_waitcnt vmcnt(0)" ::: "memory"); SWRITE(0, SE); __syncthreads();
  qkt8m(pA0, pA1, mi, K_lds, q8a, q8b, r32, hi, sc1, scq); xdl_pad2(pA0, pA1); partialSM8m<true>(pA0, pA1, M, mi, alA);
  SLOAD(SO, KVBLK); if (2 < NT) SLOAD(SE, 2 * KVBLK);
  SWAIT(); SWRITE(1, SO); __syncthreads();
  for (int j = 1; j + 1 < NT; j += 2) {
    SBAR(); qkt8m(pB0, pB1, mi, K_lds + SHM_K8, q8a, q8b, r32, hi, sc1, scq);
    finishSM8m(pA0, pA1, alA, l_reg, pa); SBAR();
    SLOAD(SO, (j + SDEPTH) * KVBLK); SBAR();
    pv8m(o, V_lds, pa, r32, hi, sc1); partialSM8m<false>(pB0, pB1, M, mi, alB);
    __syncthreads(); SWAIT(); SWRITE(0, SE);
    RESC(alB); __syncthreads();
    SBAR(); qkt8m(pA0, pA1, mi, K_lds, q8a, q8b, r32, hi, sc1, scq);
    finishSM8m(pB0, pB1, alB, l_reg, pa); SBAR();
    if (j + 3 < NT) SLOAD(SE, (j + 1 + SDEPTH) * KVBLK); SBAR();
    pv8m(o, V_lds + SHM_V8, pa, r32, hi, sc1); partialSM8m<false>(pA0, pA1, M, mi, alA);
    __syncthreads(); SWAIT(); SWRITE(1, SO);
    RESC(alA); __syncthreads();
  }
  SBAR(); qkt8m(pB0, pB1, mi, K_lds + SHM_K8, q8a, q8b, r32, hi, sc1, scq);
  finishSM8m(pA0, pA1, alA, l_reg, pa); SBAR();
  pv8m(o, V_lds, pa, r32, hi, sc1); partialSM8m<false>(pB0, pB1, M, mi, alB);
  __syncthreads(); RESC(alB);
  finishSM8m(pB0, pB1, alB, l_reg, pa); SBAR();
  pv8m(o, V_lds + SHM_V8, pa, r32, hi, sc1);
  if (hi == 0) li_l[r32] = l_reg; asm volatile("s_waitcnt lgkmcnt(0)" ::: "memory");
  xdl_pad2(o[0], o[1]); xdl_pad2(o[2], o[3]);
  float rli[16];
#pragma unroll
  for (int r = 0; r < 16; ++r) rli[r] = __builtin_amdgcn_rcpf(li_l[crow(r, hi)]);
  bf16* Ow = Ob + (long)(wid * QBLK) * LDO;
#pragma unroll
  for (int r = 0; r < 16; ++r) { int orow = crow(r, hi);
#pragma unroll
    for (int d0 = 0; d0 < 4; ++d0) Ow[(long)orow * LDO + d0 * 32 + r32] = (bf16)f2bf(o[d0][r] * rli[r]); }
  __syncthreads();
#undef SLOAD
#undef SWRITE
#undef SWAIT
#undef RESC
}
__device__ __forceinline__ void mfma8_init(f32x16& p, const v8i& a, const v8i& b, const f32x16& c, int sa, int sb) {
  asm volatile("s_nop 1\n\tv_mfma_scale_f32_32x32x64_f8f6f4 %0, %1, %2, %3, %4, %5 op_sel_hi:[0,0,0]" : "=&v"(p) : "v"(a), "v"(b), "v"(c), "v"(sa), "v"(sb)); }
__device__ __forceinline__ void mfma8_acc(f32x16& p, const v8i& a, const v8i& b, int sa, int sb) {
  asm volatile("s_nop 1\n\tv_mfma_scale_f32_32x32x64_f8f6f4 %0, %1, %2, %0, %3, %4 op_sel_hi:[0,0,0]" : "+v"(p) : "v"(a), "v"(b), "v"(sa), "v"(sb)); }
__device__ __forceinline__ void attn_dense_body_i(const bf16* __restrict__ Qb, const unsigned char* __restrict__ Kh8, const unsigned char* __restrict__ Vt8, bf16* __restrict__ Ob, int seq, char* lds) {
  constexpr int SDEPTH = 2; constexpr size_t SHM_V8 = 8192;
  const int tid = threadIdx.x, wid = tid >> 6, lane = tid & 63, r32 = lane & 31, hi = lane >> 5;
  char* V_lds = lds; char* K_lds = lds + 2 * SHM_V8;
  float* ws = (float*)(lds + 2 * SHM_V8 + 2 * SHM_K8) + wid * 64; float* li_l = ws; float* al_l = ws + 32;
  float M = 0.f, l_reg = 0; f32x16 o[4] = {}; f32x16 mi = {}; asm volatile("" : "+v"(mi));
  v8i q8a, q8b; const int sc1 = 0x7f7f7f7f, scq = 0x7c7c7c7c;
  { bf16x8 qr[8]; const bf16* Qw = Qb + (long)(wid * QBLK + r32) * LDQ + hi * 8;
#pragma unroll
    for (int d0 = 0; d0 < 8; ++d0) qr[d0] = *reinterpret_cast<const bf16x8*>(Qw + d0 * 16);
    int w[16];
#pragma unroll
    for (int d0 = 0; d0 < 8; ++d0) { const u32x4 x = *reinterpret_cast<const u32x4*>(&qr[d0]);
      w[2 * d0] = (int)pk4_fp8(bflo(x.x) * QS8, bfhi(x.x) * QS8, bflo(x.y) * QS8, bfhi(x.y) * QS8); w[2 * d0 + 1] = (int)pk4_fp8(bflo(x.z) * QS8, bfhi(x.z) * QS8, bflo(x.w) * QS8, bfhi(x.w) * QS8); }
    q8a = (v8i){w[0], w[1], w[2], w[3], w[4], w[5], w[6], w[7]}; q8b = (v8i){w[8], w[9], w[10], w[11], w[12], w[13], w[14], w[15]}; }
  const int krow = tid >> 3, kg = tid & 7, kst = K8ADDR(krow, kg);
  const int vrow = tid >> 2, vg = tid & 3, vst = V8ADDR(vrow, vg);
  const int g0 = 4 * hi;
  struct { v4i vs, ks; } sr_[SDEPTH];
#define SLOAD(i, k0) do { sr_[i].vs = *reinterpret_cast<const v4i*>(&Vt8[(long)((k0) / KVBLK) * 8192 + tid * 16]); sr_[i].ks = *reinterpret_cast<const v4i*>(&Kh8[(long)((k0) + krow) * 256 + kg * 16]); } while (0)
#define SWRITE(b, i) do { *(v4i*)(V_lds + (b) * SHM_V8 + vst) = sr_[i].vs; *(v4i*)(K_lds + (b) * SHM_K8 + kst) = sr_[i].ks; } while (0)
#define SWAIT() do { asm volatile("s_waitcnt vmcnt(2)" ::: "memory"); } while (0)
#define RESC(a) do { if (__any((a) < 1.f)) { if (hi == 0) al_l[r32] = (a); xdl_pad2(o[0], o[1]); xdl_pad2(o[2], o[3]); asm volatile("s_waitcnt lgkmcnt(0)" ::: "memory"); \
    _Pragma("unroll") for (int d = 0; d < 4; ++d) _Pragma("unroll") for (int r = 0; r < 16; ++r) o[d][r] *= al_l[crow(r, hi)]; } } while (0)
#define KFRAG(D0, D1, KB, G) do { const v4i a0_ = *reinterpret_cast<const v4i*>((KB) + K8ADDR(r32, (G))), a1_ = *reinterpret_cast<const v4i*>((KB) + K8ADDR(r32, (G) + 1));             \
    const v4i b0_ = *reinterpret_cast<const v4i*>((KB) + K8ADDR(32 + r32, (G))), b1_ = *reinterpret_cast<const v4i*>((KB) + K8ADDR(32 + r32, (G) + 1));                                \
    D0 = __builtin_shufflevector(a0_, a1_, 0, 1, 2, 3, 4, 5, 6, 7); D1 = __builtin_shufflevector(b0_, b1_, 0, 1, 2, 3, 4, 5, 6, 7); } while (0)
#define VFRAG(Dv, VB, D0) do { const int d_ = 32 * (D0) + r32; const v4i x0_ = *reinterpret_cast<const v4i*>((VB) + V8ADDR(d_, 2 * hi)), x1_ = *reinterpret_cast<const v4i*>((VB) + V8ADDR(d_, 2 * hi + 1)); \
    Dv = __builtin_shufflevector(x0_, x1_, 0, 1, 2, 3, 4, 5, 6, 7); } while (0)
#define EXPR(P, LO, HI) do { _Pragma("unroll") for (int r = (LO); r < (HI); ++r) P[r] = __builtin_amdgcn_exp2f(P[r]); } while (0)
#define ATT_HALF(PB0, PB1, ALB, PA0, PA1, ALA, KB, VA, LOADSTMT) do {                                                                              \
    v8i ka_, kb_, vf_;                                                                                                                             \
    KFRAG(ka_, kb_, KB, g0); EXPR(PA1, 0, 8);                                                                                                      \
    SBAR(); mfma8_init(PB0, ka_, q8a, mi, sc1, scq); SBAR();                                                                                       \
    EXPR(PA1, 8, 16);                                                                                                                              \
    SBAR(); mfma8_init(PB1, kb_, q8a, mi, sc1, scq); SBAR();                                                                                       \
    KFRAG(ka_, kb_, KB, g0 + 2);                                                                                                                   \
    float sa_ = PA0[0], sb_ = PA0[8];                                                                                                              \
    _Pragma("unroll") for (int r = 1; r < 8; ++r) { sa_ += PA0[r]; sb_ += PA0[8 + r]; }                                                            \
    SBAR(); mfma8_acc(PB0, ka_, q8b, sc1, scq); SBAR();                                                                                            \
    VFRAG(vf_, VA, 0);                                                                                                                             \
    { float sc_ = PA1[0], sd_ = PA1[8];                                                                                                            \
      _Pragma("unroll") for (int r = 1; r < 8; ++r) { sc_ += PA1[r]; sd_ += PA1[8 + r]; }                                                          \
      float ps_ = (sa_ + sb_) + (sc_ + sd_);                                                                                                       \
      auto rr_ = __builtin_amdgcn_permlane32_swap(__float_as_uint(ps_), __float_as_uint(ps_), false, false);                                       \
      l_reg = l_reg * (ALA) + (__uint_as_float(rr_[0]) + __uint_as_float(rr_[1])); }                                                               \
    SBAR(); mfma8_acc(PB1, kb_, q8b, sc1, scq); SBAR();                                                                                            \
    pa = (v8i){cvt4_fp8(PA0[0], PA0[1], PA0[2], PA0[3]), cvt4_fp8(PA0[4], PA0[5], PA0[6], PA0[7]), cvt4_fp8(PA0[8], PA0[9], PA0[10], PA0[11]), cvt4_fp8(PA0[12], PA0[13], PA0[14], PA0[15]), \
               cvt4_fp8(PA1[0], PA1[1], PA1[2], PA1[3]), cvt4_fp8(PA1[4], PA1[5], PA1[6], PA1[7]), cvt4_fp8(PA1[8], PA1[9], PA1[10], PA1[11]), cvt4_fp8(PA1[12], PA1[13], PA1[14], PA1[15])}; \
    SBAR(); mfma8_acc(o[0], pa, vf_, sc1, sc1); SBAR();                                                                                            \
    VFRAG(vf_, VA, 1); LOADSTMT;                                                                                                                   \
    float mx_ = PB0[0];                                                                                                                            \
    _Pragma("unroll") for (int r = 1; r < 16; ++r) mx_ = fmaxf(mx_, PB0[r]);                                                                       \
    SBAR(); mfma8_acc(o[1], pa, vf_, sc1, sc1); SBAR();                                                                                            \
    VFRAG(vf_, VA, 2);                                                                                                                             \
    _Pragma("unroll") for (int r = 0; r < 16; ++r) mx_ = fmaxf(mx_, PB1[r]);                                                                       \
    { auto rr_ = __builtin_amdgcn_permlane32_swap(__float_as_uint(mx_), __float_as_uint(mx_), false, false);                                       \
      mx_ = fmaxf(__uint_as_float(rr_[0]), __uint_as_float(rr_[1])); }                                                                             \
    if (__builtin_expect(__all(mx_ <= THR2), 1)) { ALB = 1.f; }                                                                                    \
    else { const float d_ = fmaxf(mx_, 0.f); ALB = __builtin_amdgcn_exp2f(-d_); M += d_;                                                           \
      _Pragma("unroll") for (int r = 0; r < 16; ++r) { PB0[r] -= d_; PB1[r] -= d_; }                                                               \
      const float nm_ = -M;                                                                                                                        \
      _Pragma("unroll") for (int r = 0; r < 16; ++r) mi[r] = nm_;                                                                                  \
      asm volatile("" : "+v"(mi)); }                                                                                                               \
    SBAR(); mfma8_acc(o[2], pa, vf_, sc1, sc1); SBAR();                                                                                            \
    VFRAG(vf_, VA, 3); EXPR(PB0, 0, 8);                                                                                                            \
    SBAR(); mfma8_acc(o[3], pa, vf_, sc1, sc1); SBAR();                                                                                            \
    EXPR(PB0, 8, 16);                                                                                                                              \
  } while (0)
  f32x16 pA0, pA1, pB0, pB1; float alA, alB; v8i pa; const int NT = seq / KVBLK;
  constexpr int SE = 0, SO = SDEPTH - 1;
  SLOAD(SE, 0); asm volatile("s_waitcnt vmcnt(0)" ::: "memory"); SWRITE(0, SE); __syncthreads();
  qkt8m(pA0, pA1, mi, K_lds, q8a, q8b, r32, hi, sc1, scq); xdl_pad2(pA0, pA1); partialSM8m<true>(pA0, pA1, M, mi, alA);
  SLOAD(SO, KVBLK); if (2 < NT) SLOAD(SE, 2 * KVBLK);
  SWAIT(); SWRITE(1, SO); __syncthreads();
  for (int j = 1; j + 1 < NT; j += 2) {
    ATT_HALF(pB0, pB1, alB, pA0, pA1, alA, K_lds + SHM_K8, V_lds, SLOAD(SO, (j + SDEPTH) * KVBLK));
    __syncthreads(); SWAIT(); SWRITE(0, SE);
    RESC(alB); __syncthreads();
    ATT_HALF(pA0, pA1, alA, pB0, pB1, alB, K_lds, V_lds + SHM_V8, if (j + 3 < NT) SLOAD(SE, (j + 1 + SDEPTH) * KVBLK));
    __syncthreads(); SWAIT(); SWRITE(1, SO);
    RESC(alA); __syncthreads();
  }
  ATT_HALF(pB0, pB1, alB, pA0, pA1, alA, K_lds + SHM_K8, V_lds, (void)0);
  __syncthreads(); RESC(alB);
  finishSM8m(pB0, pB1, alB, l_reg, pa); SBAR();
  pv8m(o, V_lds + SHM_V8, pa, r32, hi, sc1);
  if (hi == 0) li_l[r32] = l_reg; asm volatile("s_waitcnt lgkmcnt(0)" ::: "memory");
  xdl_pad2(o[0], o[1]); xdl_pad2(o[2], o[3]);
  float rli[16];
#pragma unroll
  for (int r = 0; r < 16; ++r) rli[r] = __builtin_amdgcn_rcpf(li_l[crow(r, hi)]);
  bf16* Ow = Ob + (long)(wid * QBLK) * LDO;
#pragma unroll
  for (int r = 0; r < 16; ++r) { int orow = crow(r, hi);
#pragma unroll
    for (int d0 = 0; d0 < 4; ++d0) Ow[(long)orow * LDO + d0 * 32 + r32] = (bf16)f2bf(o[d0][r] * rli[r]); }
  __syncthreads();
#undef SLOAD
#undef SWRITE
#undef SWAIT
#undef RESC
#undef KFRAG
#undef VFRAG
#undef EXPR
#undef ATT_HALF
}
__device__ __forceinline__ void attn_dense_body_d(const bf16* __restrict__ Qb, const unsigned char* __restrict__ Kh8, const unsigned char* __restrict__ Vt8, bf16* __restrict__ Ob, int seq, LAS char* lds) {
  const int tid = threadIdx.x, wid = tid >> 6, lane = tid & 63, r32 = lane & 31, hi = lane >> 5;
  LAS char* K_lds = lds; LAS char* V_lds = lds + 4 * 8192;
  LAS float* ws = (LAS float*)(lds + 8 * 8192) + wid * 64; LAS float* li_l = ws; LAS float* al_l = ws + 32;
  float M = 0.f, l_reg = 0; f32x16 o[4] = {}; f32x16 mi = {}; asm volatile("" : "+v"(mi));
  v8i q8a, q8b; const int sc1 = 0x7f7f7f7f, scq = 0x7c7c7c7c;
  { bf16x8 qr[8]; const bf16* Qw = Qb + (long)(wid * QBLK + r32) * LDQ + hi * 8;
#pragma unroll
    for (int d0 = 0; d0 < 8; ++d0) qr[d0] = *reinterpret_cast<const bf16x8*>(Qw + d0 * 16);
    int w[16];
#pragma unroll
    for (int d0 = 0; d0 < 8; ++d0) { const u32x4 x = *reinterpret_cast<const u32x4*>(&qr[d0]);
      w[2 * d0] = (int)pk4_fp8(bflo(x.x) * QS8, bfhi(x.x) * QS8, bflo(x.y) * QS8, bfhi(x.y) * QS8); w[2 * d0 + 1] = (int)pk4_fp8(bflo(x.z) * QS8, bfhi(x.z) * QS8, bflo(x.w) * QS8, bfhi(x.w) * QS8); }
    q8a = (v8i){w[0], w[1], w[2], w[3], w[4], w[5], w[6], w[7]}; q8b = (v8i){w[8], w[9], w[10], w[11], w[12], w[13], w[14], w[15]}; }
  const int g0 = 4 * hi;
  const int kr = wid * 8 + (lane >> 3), vd = wid * 16 + (lane >> 2);
  const unsigned kgo = (unsigned)kr * 256u + (unsigned)((((lane & 7) ^ (kr >> 1)) & 7) << 4), vgo = (unsigned)vd * 64u + (unsigned)((((lane & 3) ^ (vd >> 2)) & 3) << 4);
#define DMA(blk) do { const int b_ = (blk) & 3; unsigned ko_ = (unsigned)(blk) * 16384u, vo_ = (unsigned)(blk) * 8192u; asm volatile("" : "+s"(ko_), "+s"(vo_));     \
    __builtin_amdgcn_global_load_lds((const unsigned*)(Kh8 + (size_t)(ko_ + kgo)), (LAS unsigned*)(K_lds + b_ * 8192 + wid * 1024), 16, 0, 0);                      \
    __builtin_amdgcn_global_load_lds((const unsigned*)(Vt8 + (size_t)(vo_ + vgo)), (LAS unsigned*)(V_lds + b_ * 8192 + wid * 1024), 16, 0, 0); } while (0)
#define VMW(n) asm volatile("s_waitcnt vmcnt(" #n ")" ::: "memory")
#define BAR() __builtin_amdgcn_s_barrier()
#define RESC(a) do { if (__any((a) < 1.f)) { if (hi == 0) al_l[r32] = (a); xdl_pad2(o[0], o[1]); xdl_pad2(o[2], o[3]); asm volatile("s_waitcnt lgkmcnt(0)" ::: "memory"); \
    _Pragma("unroll") for (int d = 0; d < 4; ++d) _Pragma("unroll") for (int r = 0; r < 16; ++r) o[d][r] *= al_l[crow(r, hi)]; } } while (0)
#define KFRAG(D0, D1, KB, G) do { const v4i a0_ = *reinterpret_cast<const LAS v4i*>((KB) + K8ADDR(r32, (G))), a1_ = *reinterpret_cast<const LAS v4i*>((KB) + K8ADDR(r32, (G) + 1));             \
    const v4i b0_ = *reinterpret_cast<const LAS v4i*>((KB) + K8ADDR(r32, (G)) + 4096), b1_ = *reinterpret_cast<const LAS v4i*>((KB) + K8ADDR(r32, (G) + 1) + 4096);     \
    D0 = __builtin_shufflevector(a0_, a1_, 0, 1, 2, 3, 4, 5, 6, 7); D1 = __builtin_shufflevector(b0_, b1_, 0, 1, 2, 3, 4, 5, 6, 7); } while (0)
#define VFRAG(Dv, VB, D0) do { const v4i x0_ = *reinterpret_cast<const LAS v4i*>((VB) + V8ADDR(r32, 2 * hi) + 2048 * (D0)), x1_ = *reinterpret_cast<const LAS v4i*>((VB) + V8ADDR(r32, 2 * hi + 1) + 2048 * (D0));     \
    Dv = __builtin_shufflevector(x0_, x1_, 0, 1, 2, 3, 4, 5, 6, 7); } while (0)
#define EXPR(P, LO, HI) do { _Pragma("unroll") for (int r = (LO); r < (HI); ++r) P[r] = __builtin_amdgcn_exp2f(P[r]); } while (0)
#define ATT_HALF(PB0, PB1, ALB, PA0, PA1, ALA, KB, VA, LOADSTMT) do {                                                                              \
    v8i ka_, kb_, vf_;                                                                                                                             \
    KFRAG(ka_, kb_, KB, g0); EXPR(PA1, 0, 8);                                                                                                      \
    SBAR(); mfma8_init(PB0, ka_, q8a, mi, sc1, scq); SBAR();                                                                                       \
    EXPR(PA1, 8, 16);                                                                                                                              \
    SBAR(); mfma8_init(PB1, kb_, q8a, mi, sc1, scq); SBAR();                                                                                       \
    KFRAG(ka_, kb_, KB, g0 + 2);                                                                                                                   \
    float sa_ = PA0[0], sb_ = PA0[8];                                                                                                              \
    _Pragma("unroll") for (int r = 1; r < 8; ++r) { sa_ += PA0[r]; sb_ += PA0[8 + r]; }                                                            \
    asm volatile("" : "+v"(sa_), "+v"(sb_));                                                                                                       \
    SBAR(); mfma8_acc(PB0, ka_, q8b, sc1, scq); SBAR();                                                                                            \
    VFRAG(vf_, VA, 0);                                                                                                                             \
    { float sc_ = PA1[0], sd_ = PA1[8];                                                                                                            \
      _Pragma("unroll") for (int r = 1; r < 8; ++r) { sc_ += PA1[r]; sd_ += PA1[8 + r]; }                                                          \
      float ps_ = (sa_ + sb_) + (sc_ + sd_);                                                                                                       \
      auto rr_ = __builtin_amdgcn_permlane32_swap(__float_as_uint(ps_), __float_as_uint(ps_), false, false);                                       \
      l_reg = l_reg * (ALA) + (__uint_as_float(rr_[0]) + __uint_as_float(rr_[1])); }                                                               \
    SBAR(); mfma8_acc(PB1, kb_, q8b, sc1, scq); SBAR();                                                                                            \
    pa = (v8i){cvt4_fp8(PA0[0], PA0[1], PA0[2], PA0[3]), cvt4_fp8(PA0[4], PA0[5], PA0[6], PA0[7]), cvt4_fp8(PA0[8], PA0[9], PA0[10], PA0[11]), cvt4_fp8(PA0[12], PA0[13], PA0[14], PA0[15]), \
               cvt4_fp8(PA1[0], PA1[1], PA1[2], PA1[3]), cvt4_fp8(PA1[4], PA1[5], PA1[6], PA1[7]), cvt4_fp8(PA1[8], PA1[9], PA1[10], PA1[11]), cvt4_fp8(PA1[12], PA1[13], PA1[14], PA1[15])}; \
    SBAR(); mfma8_acc(o[0], pa, vf_, sc1, sc1); SBAR();                                                                                            \
    VFRAG(vf_, VA, 1); LOADSTMT;                                                                                                                   \
    float mx_ = PB0[0], my_ = PB0[8];                                                                                                              \
    _Pragma("unroll") for (int r = 1; r < 8; ++r) { mx_ = fmaxf(mx_, PB0[r]); my_ = fmaxf(my_, PB0[8 + r]); }                                      \
    SBAR(); mfma8_acc(o[1], pa, vf_, sc1, sc1); SBAR();                                                                                            \
    VFRAG(vf_, VA, 2);                                                                                                                             \
    _Pragma("unroll") for (int r = 0; r < 8; ++r) { mx_ = fmaxf(mx_, PB1[r]); my_ = fmaxf(my_, PB1[8 + r]); }                                      \
    mx_ = fmaxf(mx_, my_);                                                                                                                         \
    { auto rr_ = __builtin_amdgcn_permlane32_swap(__float_as_uint(mx_), __float_as_uint(mx_), false, false);                                       \
      mx_ = fmaxf(__uint_as_float(rr_[0]), __uint_as_float(rr_[1])); }                                                                             \
    if (__builtin_expect(__all(mx_ <= THR2), 1)) { ALB = 1.f; }                                                                                    \
    else { const float d_ = fmaxf(mx_, 0.f); ALB = __builtin_amdgcn_exp2f(-d_); M += d_;                                                           \
      _Pragma("unroll") for (int r = 0; r < 16; ++r) { PB0[r] -= d_; PB1[r] -= d_; }                                                               \
      const float nm_ = -M;                                                                                                                        \
      _Pragma("unroll") for (int r = 0; r < 16; ++r) mi[r] = nm_;                                                                                  \
      asm volatile("" : "+v"(mi)); }                                                                                                               \
    SBAR(); mfma8_acc(o[2], pa, vf_, sc1, sc1); SBAR();                                                                                            \
    VFRAG(vf_, VA, 3); EXPR(PB0, 0, 8); asm volatile("" : "+v"(PB0));       \
    SBAR(); mfma8_acc(o[3], pa, vf_, sc1, sc1); SBAR();                                                                                            \
    EXPR(PB0, 8, 16); asm volatile("" : "+v"(PB0));                                                                                                \
  } while (0)
  f32x16 pA0, pA1, pB0, pB1; float alA, alB; v8i pa; const int NT = seq / KVBLK;
  if (wid >= 4) __builtin_amdgcn_s_setprio(1);
  DMA(0); DMA(1); VMW(2); BAR();
  { v8i ka_, kb_; KFRAG(ka_, kb_, K_lds, g0); mfma8_init(pA0, ka_, q8a, mi, sc1, scq); mfma8_init(pA1, kb_, q8a, mi, sc1, scq);
    KFRAG(ka_, kb_, K_lds, g0 + 2); mfma8_acc(pA0, ka_, q8b, sc1, scq); mfma8_acc(pA1, kb_, q8b, sc1, scq); }
  xdl_pad2(pA0, pA1); partialSM8m<true>(pA0, pA1, M, mi, alA);
  DMA(2); VMW(2); BAR();
  for (int j = 1; j + 1 < NT; j += 2) {
    DMA(j + 2);
    ATT_HALF(pB0, pB1, alB, pA0, pA1, alA, K_lds + (j & 3) * 8192, V_lds + ((j - 1) & 3) * 8192, (void)0);
    VMW(2); BAR(); RESC(alB);
    const bool more = j + 3 < NT;
    if (more) DMA(j + 3);
    ATT_HALF(pA0, pA1, alA, pB0, pB1, alB, K_lds + ((j + 1) & 3) * 8192, V_lds + (j & 3) * 8192, (void)0);
    if (more) VMW(2); else VMW(0);
    BAR(); RESC(alA);
  }
  ATT_HALF(pB0, pB1, alB, pA0, pA1, alA, K_lds + ((NT - 1) & 3) * 8192, V_lds + ((NT - 2) & 3) * 8192, (void)0);
  RESC(alB);
  { LAS char* Vb = V_lds + ((NT - 1) & 3) * 8192; v8i vf_;
    EXPR(pB1, 0, 16);
    float sa_ = pB0[0], sb_ = pB1[0];
#pragma unroll
    for (int r = 1; r < 16; ++r) { sa_ += pB0[r]; sb_ += pB1[r]; }
    float ps_ = sa_ + sb_;
    auto rr_ = __builtin_amdgcn_permlane32_swap(__float_as_uint(ps_), __float_as_uint(ps_), false, false);
    l_reg = l_reg * alB + (__uint_as_float(rr_[0]) + __uint_as_float(rr_[1]));
    pa = (v8i){cvt4_fp8(pB0[0], pB0[1], pB0[2], pB0[3]), cvt4_fp8(pB0[4], pB0[5], pB0[6], pB0[7]), cvt4_fp8(pB0[8], pB0[9], pB0[10], pB0[11]), cvt4_fp8(pB0[12], pB0[13], pB0[14], pB0[15]),
               cvt4_fp8(pB1[0], pB1[1], pB1[2], pB1[3]), cvt4_fp8(pB1[4], pB1[5], pB1[6], pB1[7]), cvt4_fp8(pB1[8], pB1[9], pB1[10], pB1[11]), cvt4_fp8(pB1[12], pB1[13], pB1[14], pB1[15])};
#pragma unroll
    for (int d0 = 0; d0 < 4; ++d0) { VFRAG(vf_, Vb, d0); mfma8_acc(o[d0], pa, vf_, sc1, sc1); } }
  if (hi == 0) li_l[r32] = l_reg; asm volatile("s_waitcnt lgkmcnt(0)" ::: "memory");
  xdl_pad2(o[0], o[1]); xdl_pad2(o[2], o[3]);
  float rli[16];
#pragma unroll
  for (int r = 0; r < 16; ++r) rli[r] = __builtin_amdgcn_rcpf(li_l[crow(r, hi)]);
  bf16* Ow = Ob + (long)(wid * QBLK) * LDO;
#pragma unroll
  for (int r = 0; r < 16; ++r) { int orow = crow(r, hi);
#pragma unroll
    for (int d0 = 0; d0 < 4; ++d0) Ow[(long)orow * LDO + d0 * 32 + r32] = (bf16)f2bf(o[d0][r] * rli[r]); }
  __builtin_amdgcn_s_setprio(0);
  BAR();
#undef DMA
#undef VMW
#undef BAR
#undef RESC
#undef KFRAG
#undef VFRAG
#undef EXPR
#undef ATT_HALF
}
}

__device__ __forceinline__ void ph_norm3(Frame& F) {
    unsigned char* ar = F.ws + WS_ARENA;
    LAS float* RT = (LAS float*)(F.lds + 3 * 8192);
    LAS int* HIST = (LAS int*)(F.lds + 11 * 8192);
    __syncthreads();
    for (int i = F.tid; i < 2048; i += NTHR) { PV(0)[i] = modp(F, 1, 0, 2)[i] * inp(I_NORMS)[(4 + 1) * 2048 + i]; PV(1)[i] = inp(I_NORMS)[(4 + 2) * 2048 + i] * (1.f + modp(F, 1, 0, 4)[i]); PV(2)[i] = modp(F, 1, 0, 3)[i]; }
    for (int i = F.tid; i < 2048 * 8; i += NTHR) RT[(i & 7) * 2048 + (i >> 3)] = inp(I_ROUTER)[i];
    __syncthreads();
    const bf16* YO = (const bf16*)(ar + B_YO1); bf16* V1 = (bf16*)(ar + B_V1); bf16* HR = (bf16*)(F.ws + WS_HRES) + (size_t)CTX * D;
    int* RE = (int*)(ar + B_RE); float* RG = (float*)(ar + B_RG); int* CNT = (int*)(ar + B_CNT);
    for (int blk = blockIdx.x; blk < SEQ / 64; blk += F.G) {
        if (F.tid < 8) HIST[F.tid] = 0;
        __syncthreads();
        for (int rr = 0; rr < 8; ++rr) { const int t = blk * 64 + F.wave * 8 + rr; f32x4 y[8], h[8];
            ld_row_bf16(YO + (size_t)t * D, F.lane, y); ld_row_bf16(HR + (size_t)t * D, F.lane, h);
            const float ry = 1.f / sqrtf(row_sumsq(y) * (1.f / D) + EPS);
#pragma unroll
            for (int j = 0; j < 8; ++j) h[j] = h[j] + y[j] * ry * ldp(PV(0), F.lane, j);
            st_row_bf16(HR + (size_t)t * D, F.lane, h);
            const float rh = 1.f / sqrtf(row_sumsq(h) * (1.f / D) + EPS);
#pragma unroll
            for (int j = 0; j < 8; ++j) y[j] = h[j] * rh * ldp(PV(1), F.lane, j) + ldp(PV(2), F.lane, j);
            { unsigned char* V8 = (unsigned char*)V1 + (size_t)t * D;
#pragma unroll
              for (int j = 0; j < 8; ++j) *(GAS unsigned*)(V8 + 4 * F.lane + 256 * j) = pk4_fp8(y[j][0], y[j][1], y[j][2], y[j][3]); }
            float lg[8];
#pragma unroll
            for (int e = 0; e < 8; ++e) { float s = 0.f;
#pragma unroll
                for (int j = 0; j < 8; ++j) { const f32x4 w = ldp(RT + e * 2048, F.lane, j); s += (y[j][0] * w[0] + y[j][1] * w[1]) + (y[j][2] * w[2] + y[j][3] * w[3]); }
                lg[e] = wave_sum(s) + inp(I_ROUTERB)[e]; }
            if (F.lane == 0) { int e0 = 0; float v0 = lg[0];
#pragma unroll
                for (int e = 1; e < 8; ++e) if (lg[e] > v0) { v0 = lg[e]; e0 = e; }
                int e1 = -1; float v1 = -3.0e38f;
#pragma unroll
                for (int e = 0; e < 8; ++e) if (e != e0 && lg[e] > v1) { v1 = lg[e]; e1 = e; }
                const float g0 = 1.f / (1.f + __expf(v1 - v0));
                RE[2 * t] = e0; RE[2 * t + 1] = e1; RG[2 * t] = g0; RG[2 * t + 1] = 1.f - g0;
                __hip_atomic_fetch_add((int*)(HIST + e0), 1, __ATOMIC_RELAXED, __HIP_MEMORY_SCOPE_WORKGROUP); __hip_atomic_fetch_add((int*)(HIST + e1), 1, __ATOMIC_RELAXED, __HIP_MEMORY_SCOPE_WORKGROUP); }
        }
        __syncthreads();
        if (F.tid < 8) CNT[blk * 8 + F.tid] = HIST[F.tid];
        __syncthreads();
    }
}
__device__ __forceinline__ void ph_route(Frame& F) {
    unsigned char* ar = F.ws + WS_ARENA;
    LAS int* TOT = (LAS int*)(F.lds); LAS int* PRE = TOT + 8; LAS int* BASE = TOT + 16; LAS int* POS = TOT + 32;
    const int* CNT = (const int*)(ar + B_CNT); const int* RE = (const int*)(ar + B_RE); int* SLOT = (int*)(ar + B_SLOT); int* TILE = (int*)(ar + B_TILE);
    const bf16* V1 = (const bf16*)(ar + B_V1); unsigned char* VG = ar + B_VG;
    for (int blk = blockIdx.x; blk < SEQ / 64; blk += F.G) {
        __syncthreads();
        { const int e = F.wave; int tot = 0, pre = 0;
          for (int q = 0; q < 4; ++q) { const int b = 4 * F.lane + q; const int cv = CNT[b * 8 + e]; tot += cv; pre += (b < blk) ? cv : 0; }
#pragma unroll
          for (int o = 1; o < 64; o <<= 1) { tot += __shfl_xor(tot, o); pre += __shfl_xor(pre, o); }
          if (F.lane == 0) { TOT[e] = tot; PRE[e] = pre; } }
        __syncthreads();
        if (F.tid == 0) { int b = 0; for (int e = 0; e < 8; ++e) { BASE[e] = b; b += (TOT[e] + 255) / 256 * 256; } BASE[8] = b; }
        __syncthreads();
        if (F.wave == 0) { const int t = blk * 64 + F.lane; const int e0 = RE[2 * t], e1 = RE[2 * t + 1]; int p0 = 0, p1 = 0;
            const unsigned long long lt = (1ull << F.lane) - 1ull;
#pragma unroll
            for (int e = 0; e < 8; ++e) { const unsigned long long m0 = __ballot(e0 == e), m1 = __ballot(e1 == e); const int rk = __popcll(m0 & lt) + __popcll(m1 & lt);
                if (e0 == e) p0 = BASE[e] + PRE[e] + rk; if (e1 == e) p1 = BASE[e] + PRE[e] + rk; }
            SLOT[2 * t] = p0; SLOT[2 * t + 1] = p1; POS[2 * F.lane] = p0; POS[2 * F.lane + 1] = p1; }
        __syncthreads();
        for (int idx = F.tid; idx < 128 * 128; idx += NTHR) { const int ri = idx >> 7, seg = idx & 127;
            *(GAS v4u*)(VG + (size_t)POS[ri] * D + seg * 16) = *(const GAS v4u*)((const unsigned char*)V1 + (size_t)(blk * 64 + (ri >> 1)) * D + seg * 16); }
        if (blk < 8) { const int e = blk, r0 = BASE[e] + TOT[e], r1 = BASE[e + 1];
            for (int idx = F.tid; idx < (r1 - r0) * 128; idx += NTHR) *(GAS v4u*)(VG + (size_t)(r0 + (idx >> 7)) * D + (idx & 127) * 16) = (v4u){0u, 0u, 0u, 0u}; }
        if (blk == 0 && F.tid == 0) { int nt = 0; for (int e = 0; e < 8; ++e) { const int n = (BASE[e + 1] - BASE[e]) / 256; for (int q = 0; q < n; ++q) TILE[1 + nt++] = e; } TILE[0] = nt; }
    }
}
__device__ __forceinline__ void ph_norm4(Frame& F, float* out) {
    unsigned char* ar = F.ws + WS_ARENA;
    __syncthreads();
    for (int i = F.tid; i < 2048; i += NTHR) PV(0)[i] = modp(F, 1, 0, 5)[i] * inp(I_NORMS)[(4 + 3) * 2048 + i];
    __syncthreads();
    const bf16* FS = (const bf16*)(ar + B_FS); const bf16* HR = (const bf16*)(F.ws + WS_HRES) + (size_t)CTX * D; const int* SLOT = (const int*)(ar + B_SLOT); const float* RG = (const float*)(ar + B_RG);
    const int gw = F.vcu * NWAVES + F.wave, NGW = F.G * NWAVES;
    for (int t = gw; t < SEQ; t += NGW) { f32x4 a[8], b[8], h[8]; const int p0 = SLOT[2 * t], p1 = SLOT[2 * t + 1]; const float g0 = RG[2 * t], g1 = RG[2 * t + 1];
        const float* PART = (const float*)(ar + B_VG); constexpr size_t PSTR = (size_t)MOE_SPLIT_TILES * 256 * D;
        if (p0 < MOE_MAIN_TILES * 256) ld_row_bf16(FS + (size_t)p0 * D, F.lane, a);
        else { const float* pp = PART + (size_t)(p0 - MOE_MAIN_TILES * 256) * D; f32x4 q1[8], q2[8], q3[8]; ld_row_f32(pp, F.lane, a); ld_row_f32(pp + PSTR, F.lane, q1); ld_row_f32(pp + 2 * PSTR, F.lane, q2); ld_row_f32(pp + 3 * PSTR, F.lane, q3);
#pragma unroll
            for (int j = 0; j < 8; ++j) a[j] = (a[j] + q1[j]) + (q2[j] + q3[j]); }
        if (p1 < MOE_MAIN_TILES * 256) ld_row_bf16(FS + (size_t)p1 * D, F.lane, b);
        else { const float* pp = PART + (size_t)(p1 - MOE_MAIN_TILES * 256) * D; f32x4 q1[8], q2[8], q3[8]; ld_row_f32(pp, F.lane, b); ld_row_f32(pp + PSTR, F.lane, q1); ld_row_f32(pp + 2 * PSTR, F.lane, q2); ld_row_f32(pp + 3 * PSTR, F.lane, q3);
#pragma unroll
            for (int j = 0; j < 8; ++j) b[j] = (b[j] + q1[j]) + (q2[j] + q3[j]); }
        ld_row_bf16(HR + (size_t)t * D, F.lane, h);
#pragma unroll
        for (int j = 0; j < 8; ++j) a[j] = a[j] * g0 + b[j] * g1;
        const float rf = 1.f / sqrtf(row_sumsq(a) * (1.f / D) + EPS);
#pragma unroll
        for (int j = 0; j < 8; ++j) h[j] = h[j] + a[j] * rf * ldp(PV(0), F.lane, j);
        st_row_f32(out + (size_t)t * D, F.lane, h); }
}

struct EpiGateUp8 { static constexpr bool PERM = true; unsigned char* HID; int ldc; float is;
    __device__ __forceinline__ void operator()(AccRef acc, const Unit& u, int wr, int wc, int fr, int fq) const { EPI_ROWS(u); const int col0 = u.pn * 128 + wc * 32 + 8 * fq; const float c1 = -1.4426950408889634f * is, kk = is * is * MOE_HSC;
#pragma unroll
        for (int ai = 0; ai < 2; ++ai)
#pragma unroll
            for (int m = 0; m < 4; ++m) { const int row = row0 + ai * 128 + m * 16; float a[4], b[4];
#pragma unroll
                for (int q = 0; q < 4; ++q) { a[q] = __builtin_amdgcn_fmed3f(swiglu_fast(acc[ai][0][m][0][q], acc[ai][1][m][0][q], c1, kk), -448.f, 448.f);
                                              b[q] = __builtin_amdgcn_fmed3f(swiglu_fast(acc[ai][0][m][1][q], acc[ai][1][m][1][q], c1, kk), -448.f, 448.f); }
                v2u o; o.x = pk4_fp8(a[0], a[1], a[2], a[3]); o.y = pk4_fp8(b[0], b[1], b[2], b[3]);
                *(GAS v2u*)(HID + (size_t)row * ldc + col0) = o; } } };
struct EpiPlainSc { static constexpr bool PERM = true; bf16* O; int ldc; float sc;
    __device__ __forceinline__ void operator()(AccRef acc, const Unit& u, int wr, int wc, int fr, int fq) const { EPI_ROWS(u); const int col0 = u.pn * 256 + wc * 32 + 8 * fq;
#pragma unroll
        for (int ai = 0; ai < 2; ++ai)
#pragma unroll
            for (int m = 0; m < 4; ++m) { bf16* rp = O + (size_t)(row0 + ai * 128 + m * 16) * ldc + col0;
#pragma unroll
                for (int bj = 0; bj < 2; ++bj) *(GAS u32x4*)(rp + bj * 128) = pack8(acc[ai][bj][m][0] * sc, acc[ai][bj][m][1] * sc); } } };

struct EpiPart { static constexpr bool PERM = false; float* P; int pm0; float sc;
    __device__ __forceinline__ void operator()(AccRef acc, const Unit& u, int wr, int wc, int fr, int fq) const { const int row0 = (u.pm - pm0) * 256 + wr * 64 + fr, col0 = u.pn * 256 + wc * 32 + 4 * fq;
        float* base = P + (size_t)u.bz * ((size_t)MOE_SPLIT_TILES * 256 * D);
#pragma unroll
        for (int ai = 0; ai < 2; ++ai)
#pragma unroll
            for (int m = 0; m < 4; ++m) { float* rp = base + (size_t)(row0 + ai * 128 + m * 16) * D + col0;
#pragma unroll
                for (int bj = 0; bj < 2; ++bj)
#pragma unroll
                    for (int n = 0; n < 2; ++n) *(GAS f32x4*)(rp + bj * 128 + n * 16) = acc[ai][bj][m][n] * sc; } } };

enum { PH_PRO = 0, PH_N0, PH_WINE, PH_POOLD, PH_SCAN, PH_S5Y, PH_GLU, PH_WOUTE, PH_N1, PH_FFNU, PH_FFND, PH_N2,
       PH_WINO, PH_PREP, PH_GLA1, PH_GLA2, PH_GLA3, PH_ATT, PH_WOUTO, PH_N3, PH_ROUTE, PH_MOEU, PH_MOED, PH_N4, NPH };
constexpr int PH_EMIT = 100;
struct Args { const float* in[N_IN]; float* out; unsigned char* ws; int ph_lo, ph_hi, li, pad; };

__global__ void __launch_bounds__(NTHR, 2) mk_fwd(Args args) {
    extern __shared__ __attribute__((aligned(16))) unsigned char lds[];
    Frame F;
    F.lds = (LAS unsigned char*)lds; F.MISC = (volatile LAS unsigned*)(F.lds + MISC_OFF);
    F.tid = threadIdx.x; F.lane = F.tid & 63; F.wave = __builtin_amdgcn_readfirstlane(F.tid >> 6);
    F.G = gridDim.x; { const int bx = blockIdx.x; F.vcu = (F.G % 8 == 0) ? (bx % 8) * (F.G / 8) + bx / 8 : bx; }
    F.ws = karg_ws(); F.ctl = (gu32*)(F.ws + WS_CTL);
    for (int u = F.tid; u < (LDS_BYTES - LDSCTL_OFF) / 4; u += NTHR) ((LAS unsigned*)(F.lds + LDSCTL_OFF))[u] = 0u;
    __syncthreads();
    XcdBarrier bar = xcd_barrier_post((unsigned*)(F.ctl + CW_BAR) + (karg_i(2) & 7) * XCD_BAR_WORDS, F.MISC + 8);
    const int lo = karg_i(0), hi = karg_i(1);
#define IN(k) (lo <= (k) && (k) < hi)
#define SEAM(k) do { if (IN(k) && IN((k) + 1)) xcd_barrier(bar); if (PROBE_MASK) { const unsigned long long t_ = __builtin_amdgcn_s_memrealtime(); if ((PROBE_MASK >> (k)) & 1ull) pr_acc += t_ - pr_last; pr_last = t_; } } while (0)
    unsigned long long pr_last = PROBE_MASK ? __builtin_amdgcn_s_memrealtime() : 0ull, pr_acc = 0ull;
    PG8_LAS unsigned char* ring = (PG8_LAS unsigned char*)(F.lds + RING_OFF);
    unsigned char* ar = F.ws + WS_ARENA;
    const int bid = (int)blockIdx.x;

    if (lo == PH_EMIT) { ph_emit(F, karg_out()); return; }

    if (IN(PH_PRO)) { p0_prologue(F); } SEAM(PH_PRO);
    if (IN(PH_N0)) { for (int it = bid; it < S5G * 8; it += F.G) { s5_small_tables(F, it >> 3); s5_stage_b(F, it >> 3, it & 7); } ph_norm0(F); } SEAM(PH_N0);
    if (IN(PH_WINE)) {
        pg8::Gemm g{(const bf16*)(ar + A_U), (const bf16*)(F.ws + WS_WINE), D, D, D};
        pg8::PlainSched S; S.o.init(T / 256, D / 256, 1, F.G, bid); S.astr = (size_t)256 * D * 2; S.bstr = (size_t)256 * D * 2; S.zA = 0; S.zB = 0;
        EpiWinE E{(bf16*)(ar + A_ZP), (bf16*)(ar + A_AS5)};
        pg8::gemm_phase(ring, g, S, E);
        conv_work(F, 0, fill_quota(S.o.nwg, F.G, bid, 6));
    } SEAM(PH_WINE);
    if (IN(PH_POOLD)) {
        ph_pooldiff(F);
        __syncthreads();
        pg8::Gemm g{(const bf16*)(ar + A_AS5), (const bf16*)(ar + A_M1T), S5K, 1024, 1024};
        pg8::PlainSched S; S.o.init(S5ROWS / 256, 1, S5G, F.G, bid); S.astr = (size_t)256 * S5K * 2; S.bstr = 0; S.zA = (size_t)S5ROWS * S5K * 2; S.zB = (size_t)256 * 1024 * 2;
        EpiSloc E{(float*)(ar + A_SLOC)};
        pg8::gemm_phase(ring, g, S, E);
        conv_work(F, 0, fill_quota(S.o.nwg, F.G, bid, 3));
    } SEAM(PH_POOLD);
    if (IN(PH_SCAN)) {
        ph_s5scan(F);
        __syncthreads();
        pg8::Gemm g{(const bf16*)(ar + A_DP), (const bf16*)(F.ws + WS_WPOOL), WPOOL, PG, PG};
        pg8::PlainSched S; S.o.init(T / 256, 2, 4, F.G, bid); S.astr = (size_t)256 * WPOOL * 2; S.bstr = (size_t)256 * PG * 2; S.zA = (size_t)PG * 2; S.zB = (size_t)512 * PG * 2;
        EpiPool E{(bf16*)(ar + A_YMIX), inp(I_EPOOLS)};
        pg8::gemm_phase(ring, g, S, E);
        conv_work(F, 0, fill_quota(S.o.nwg, F.G, bid, 1));
    } SEAM(PH_SCAN);
    if (IN(PH_S5Y)) {
        pg8::Gemm g{(const bf16*)(ar + A_AS5), (const bf16*)(ar + A_K3T), S5K, S5K, S5K};
        pg8::PlainSched S; S.o.init(S5ROWS / 256, 4, S5G, F.G, bid); S.astr = (size_t)256 * S5K * 2; S.bstr = (size_t)256 * S5K * 2; S.zA = (size_t)S5ROWS * S5K * 2; S.zB = (size_t)1024 * S5K * 2;
        EpiS5Y E{(const bf16*)(ar + A_AS5), inp(I_S5D), (bf16*)(ar + A_YG)};
        pg8::gemm_phase(ring, g, S, E);
    } SEAM(PH_S5Y);
    if (IN(PH_GLU)) {
        pg8::Gemm g{(const bf16*)(ar + A_YG), (const bf16*)(F.ws + WS_WGLU), WS5, WS5, WS5};
        pg8::PlainSched S; S.o.init(T / 256, 2, 1, F.G, bid); S.astr = (size_t)256 * WS5 * 2; S.bstr = (size_t)256 * WS5 * 2; S.zA = 0; S.zB = 0;
        EpiGlu E{(const bf16*)(ar + A_YG), (bf16*)(ar + A_YMIX)};
        pg8::gemm_phase(ring, g, S, E);
        conv_work(F, 0, fill_quota(S.o.nwg, F.G, bid, 2));
    } SEAM(PH_GLU);
    if (IN(PH_WOUTE)) {
        pg8::Gemm g{(const bf16*)(ar + A_YMIX), (const bf16*)(F.ws + WS_WOUTE), D, D, D};
        pg8::PlainSched S; S.o.init(T / 256, D / 256, 1, F.G, bid); S.astr = (size_t)256 * D * 2; S.bstr = (size_t)256 * D * 2; S.zA = 0; S.zB = 0;
        EpiPlain E{(bf16*)(ar + A_YO), D};
        pg8::gemm_phase(ring, g, S, E);
        conv_work(F, 0, fill_quota(S.o.nwg, F.G, bid, 6));
    } SEAM(PH_WOUTE);
    if (IN(PH_N1)) { ph_norm1(F); conv_work(F, CQ_F2, 0); } SEAM(PH_N1);
    if (IN(PH_FFNU)) {
#if FFN_FP8 == 1
        pg8::Gemm g{(const bf16*)(ar + A_V), (const bf16*)(F.ws + WS_WGU), D / 2, D / 2, D / 2};
        pg8::PlainSched S; S.o.init(T / 256, 14336 / 256, 1, F.G, bid); S.astr = (size_t)256 * D; S.bstr = (size_t)256 * D; S.zA = 0; S.zB = 0;
        EpiGateUp8 E{ar + A_HID, DFF, 1.f / MOE_WSC_GU};
        pg8::gemm_phase<EpiGateUp8, pg8::PlainSched, true>(ring, g, S, E);
#elif FFN_FP8 == 2 && FFNU_K1 < 2048
        constexpr int KEQ = FFNU_K1 + (2048 - FFNU_K1) / 2;
        static_assert(FFNU_K1 % 128 == 0 && (2048 - FFNU_K1) % 256 == 0 && KEQ % 128 == 0 && FFNU_K1 % 256 == 0, "mixed-precision split");
        pg8::Gemm g{(const bf16*)(ar + A_V), (const bf16*)(F.ws + WS_WGU), KEQ, KEQ, KEQ};
        pg8::PlainSched S; S.o.init(T / 256, 14336 / 256, 1, F.G, bid); S.astr = (size_t)256 * KEQ * 2; S.bstr = (size_t)256 * KEQ * 2; S.zA = 0; S.zB = 0;
        EpiGateUp8 E{ar + A_HID, DFF, 1.f};
        pg8::gemm_phase<EpiGateUp8, pg8::PlainSched, false, FFNU_K1 / 64>(ring, g, S, E);
#elif FFN_FP8 == 2
        pg8::Gemm g{(const bf16*)(ar + A_V), (const bf16*)(F.ws + WS_WGU), D, D, D};
        pg8::PlainSched S; S.o.init(T / 256, 14336 / 256, 1, F.G, bid); S.astr = (size_t)256 * D * 2; S.bstr = (size_t)256 * D * 2; S.zA = 0; S.zB = 0;
        EpiGateUp8 E{ar + A_HID, DFF, 1.f};
        pg8::gemm_phase(ring, g, S, E);
#else
        pg8::Gemm g{(const bf16*)(ar + A_V), (const bf16*)(F.ws + WS_WGU), D, D, D};
        pg8::PlainSched S; S.o.init(T / 256, 14336 / 256, 1, F.G, bid); S.astr = (size_t)256 * D * 2; S.bstr = (size_t)256 * D * 2; S.zA = 0; S.zB = 0;
        EpiGateUp E{(bf16*)(ar + A_HID), DFF};
        pg8::gemm_phase(ring, g, S, E);
#endif
        conv_work(F, CQ_F3, fill_quota((T / 256) * (14336 / 256), F.G, bid, 6));
    } SEAM(PH_FFNU);
    if (IN(PH_FFND)) {
#if FFN_FP8
        pg8::Gemm g{(const bf16*)(ar + A_HID), (const bf16*)(F.ws + WS_WDN), DFF / 2, DFF / 2, DFF / 2};
        pg8::PlainSched S; S.o.init(T / 256, D / 256, 1, F.G, bid); S.astr = (size_t)256 * DFF; S.bstr = (size_t)256 * DFF; S.zA = 0; S.zB = 0;
        EpiPlainSc E{(bf16*)(ar + A_F), D, 1.f / (MOE_WSC_DN * MOE_HSC)};
        pg8::gemm_phase<EpiPlainSc, pg8::PlainSched, true>(ring, g, S, E);
#else
        pg8::Gemm g{(const bf16*)(ar + A_HID), (const bf16*)(F.ws + WS_WDN), DFF, DFF, DFF};
        pg8::PlainSched S; S.o.init(T / 256, D / 256, 1, F.G, bid); S.astr = (size_t)256 * DFF * 2; S.bstr = (size_t)256 * DFF * 2; S.zA = 0; S.zB = 0;
        EpiPlain E{(bf16*)(ar + A_F), D};
        pg8::gemm_phase(ring, g, S, E);
#endif
        conv_work(F, CQ_O1, fill_quota((T / 256) * (D / 256), F.G, bid, 11));
    } SEAM(PH_FFND);
    if (IN(PH_N2)) { ph_norm2(F); conv_work(F, CQ_O1, 0); } SEAM(PH_N2);
    if (IN(PH_WINO)) {
        pg8::Gemm g{(const bf16*)(ar + A_U), (const bf16*)(F.ws + WS_WINO), D, D, D};
        pg8::PlainSched S; S.o.init(T / 256, WINO_N / 256, 1, F.G, bid); S.astr = (size_t)256 * D * 2; S.bstr = (size_t)256 * D * 2; S.zA = 0; S.zB = 0;
        EpiWinO E{ar};
        pg8::gemm_phase(ring, g, S, E);
        conv_work(F, CQ_O2, fill_quota(S.o.nwg, F.G, bid, 5));
    } SEAM(PH_WINO);
    if (IN(PH_PREP)) { ph_qknorm(F); ph_vt8(F); for (int u = bid; u < NCH * 4; u += F.G) gla_prepkv_unit(F, u >> 2, u & 3); conv_work(F, 0, fill_quota(NCH * 4, F.G, bid, 4)); } SEAM(PH_PREP);
    if (IN(PH_GLA2)) { ph_gla_scan(F); } SEAM(PH_GLA2);
    if (IN(PH_GLA3)) { for (int u = bid; u < (SEQ / 64) * 4; u += F.G) gla_out_unit(F, u >> 2, u & 3); __syncthreads(); }
    if (IN(PH_ATT)) {
        for (int L = bid; L < 8 * (SEQ / 256); L += F.G) { const int h = L >> 6, qb = L & 63;
            const bf16* Q = (const bf16*)(ar + B_AQ) + (size_t)(CTX + qb * 256) * 1024 + h * 128;
            const unsigned char* Kp = ar + B_KDT + (h >> 2) * 128; const bf16* Vp = (const bf16*)(ar + B_AV) + (h >> 2) * 128;
            bf16* O = (bf16*)(ar + B_YMIX1) + (size_t)(qb * 256) * D + 1024 + h * 128;
            att::attn_dense_body_d(Q, Kp, ar + B_KDT + VT8_OFF + (size_t)(h >> 2) * NCH * 8192, O, T, (LAS char*)F.lds); }
    } SEAM(PH_ATT);
    if (IN(PH_WOUTO)) {
        pg8::Gemm g{(const bf16*)(ar + B_YMIX1), (const bf16*)(F.ws + WS_WOUTO), D, D, D};
        pg8::PlainSched S; S.o.init(SEQ / 256, D / 256, 1, F.G, bid); S.astr = (size_t)256 * D * 2; S.bstr = (size_t)256 * D * 2; S.zA = 0; S.zB = 0;
        EpiPlain E{(bf16*)(ar + B_YO1), D};
        pg8::gemm_phase(ring, g, S, E);
    } SEAM(PH_WOUTO);
    if (IN(PH_N3)) { ph_norm3(F); } SEAM(PH_N3);
    if (IN(PH_ROUTE)) { ph_route(F); conv_work(F, CQ_M2, 0); } SEAM(PH_ROUTE);
    if (IN(PH_MOEU)) {
        const int* TILE = (const int*)(ar + B_TILE); const int nt = __builtin_amdgcn_readfirstlane(TILE[0]);
        pg8::Gemm g{(const bf16*)(ar + B_VG), (const bf16*)(F.ws + WS_WMGU), D / 2, D / 2, D / 2};
        pg8::MoeSched S; S.o.init(nt, 14336 / 256, 1, F.G, bid); S.astr = (size_t)256 * D; S.bstr = (size_t)256 * D; S.zB = (size_t)14336 * D; S.tile_e = TILE + 1;
        EpiGateUp8 E{ar + B_HID2, DFF, 1.f / MOE_WSC_GU};
        pg8::gemm_phase<EpiGateUp8, pg8::MoeSched, true>(ring, g, S, E);
        conv_work(F, CQ_M3, fill_quota(S.o.nwg, F.G, bid, 5));
    } SEAM(PH_MOEU);
    if (IN(PH_MOED)) {
        const int* TILE = (const int*)(ar + B_TILE); const int nt = __builtin_amdgcn_readfirstlane(TILE[0]);
        pg8::Gemm g{(const bf16*)(ar + B_HID2), (const bf16*)(F.ws + WS_WMDN), DFF / 2, DFF / 2, DFF / 2};
        const int nmain = nt < MOE_MAIN_TILES ? nt : MOE_MAIN_TILES;
        pg8::MoeSched S; S.o.init(nmain, D / 256, 1, F.G, bid); S.astr = (size_t)256 * DFF; S.bstr = (size_t)256 * DFF; S.zB = (size_t)D * DFF; S.tile_e = TILE + 1;
        EpiPlainSc E{(bf16*)(ar + B_FS), D, 1.f / (MOE_WSC_DN * MOE_HSC)};
        pg8::gemm_phase<EpiPlainSc, pg8::MoeSched, true>(ring, g, S, E);
        if (nt > MOE_MAIN_TILES) {
            pg8::Gemm g2{(const bf16*)(ar + B_HID2), (const bf16*)(F.ws + WS_WMDN), DFF / 2, DFF / 2, DFF / 8};
            pg8::MoeSplitSched S2; S2.pm0 = MOE_MAIN_TILES; S2.nun = (nt - MOE_MAIN_TILES) * 32; S2.G = F.G; S2.c = bid; S2.astr = (size_t)256 * DFF; S2.bstr = (size_t)256 * DFF; S2.zB = (size_t)D * DFF; S2.kslice = DFF / 4; S2.tile_e = TILE + 1;
            EpiPart E2{(float*)(ar + B_VG), MOE_MAIN_TILES, 1.f / (MOE_WSC_DN * MOE_HSC)};
            pg8::gemm_phase<EpiPart, pg8::MoeSplitSched, true>(ring, g2, S2, E2);
        }
    } SEAM(PH_MOED);
    if (IN(PH_N4)) { ph_norm4(F, karg_out()); }
    if (PROBE_MASK) { const unsigned long long t_ = __builtin_amdgcn_s_memrealtime(); if ((PROBE_MASK >> PH_N4) & 1ull) pr_acc += t_ - pr_last;
        const unsigned long long te_ = t_ + (unsigned long long)PROBE_K * pr_acc; while (__builtin_amdgcn_s_memrealtime() < te_) __builtin_amdgcn_s_sleep(16); }
#undef IN
#undef SEAM
}

extern "C" void kernel_launch(void* const* d_in, const int* in_sizes, int n_in, void* d_out, int out_size, void* d_ws, size_t ws_size, hipStream_t stream) {
    static int grid = 0;
    if (grid == 0) {
        if (n_in != N_IN || out_size != SEQ * D || ws_size < WS_NEED) { fprintf(stderr, "kernel_launch: shape/workspace mismatch (n_in %d out %d ws %zu need %zu)\n", n_in, out_size, ws_size, (size_t)WS_NEED); grid = -1; return; }
        int dev = 0, cus = 0, per_cu = 0;
        if (hipGetDevice(&dev) != hipSuccess || hipDeviceGetAttribute(&cus, hipDeviceAttributeMultiprocessorCount, dev) != hipSuccess) { grid = -1; return; }
        if (hipFuncSetAttribute((const void*)mk_fwd, hipFuncAttributeMaxDynamicSharedMemorySize, LDS_BYTES) != hipSuccess) { fprintf(stderr, "kernel_launch: hipFuncSetAttribute failed\n"); grid = -1; return; }
        if (hipOccupancyMaxActiveBlocksPerMultiprocessor(&per_cu, (const void*)mk_fwd, NTHR, LDS_BYTES) != hipSuccess || per_cu < 1) { fprintf(stderr, "kernel_launch: occupancy query says %d\n", per_cu); }
        (void)hipGetLastError();
        grid = cus;
    }
    if (grid < 0) return;
    (void)hipMemsetAsync((char*)d_ws + WS_CTL, 0, CTL_ZERO_BYTES, stream);
    Args a{};
    for (int i = 0; i < N_IN; ++i) a.in[i] = (const float*)d_in[i];
    a.out = (float*)d_out; a.ws = (unsigned char*)d_ws; a.pad = 0;
    const int last = (MK_STOP < NPH - 1) ? MK_STOP : NPH - 1;
#if MK_SPLIT
    for (int p = 0; p <= last; ++p) { a.ph_lo = p; a.ph_hi = p + 1; a.li = p; hipLaunchKernelGGL(mk_fwd, dim3(grid), dim3(NTHR), LDS_BYTES, stream, a); }
#else
    a.ph_lo = 0; a.ph_hi = last + 1; a.li = 0; hipLaunchKernelGGL(mk_fwd, dim3(grid), dim3(NTHR), LDS_BYTES, stream, a);
#endif
    if (last < NPH - 1) { a.ph_lo = PH_EMIT; a.ph_hi = PH_EMIT + 1; a.li = 7; hipLaunchKernelGGL(mk_fwd, dim3(grid), dim3(NTHR), LDS_BYTES, stream, a); }
    const hipError_t le = hipPeekAtLastError();
    if (le != hipSuccess) fprintf(stderr, "kernel_launch: launch failed: %s\n", hipGetErrorName(le));
}
```

```cpp
#include <hip/hip_runtime.h>
#include <cstdio>
#include <cstdint>

#ifndef PROBE_MASK
#define PROBE_MASK 0ull
#define PROBE_K 1
#endif
#ifndef MK_STOP
#define MK_STOP 99
#endif
#ifndef FFN_FP8
#define FFN_FP8 2
#endif
#ifndef FFNU_K1
#define FFNU_K1 1024
#endif
#ifndef MK_SPLIT
#define MK_SPLIT 0
#endif

namespace pg8 {
#define PG8_LAS __attribute__((address_space(3)))
typedef unsigned short bf16_t;
typedef short bf16x8 __attribute__((ext_vector_type(8)));
typedef float f32x4 __attribute__((ext_vector_type(4)));
typedef unsigned u32x4 __attribute__((ext_vector_type(4)));
typedef int v4i __attribute__((ext_vector_type(4)));
typedef int v8i __attribute__((ext_vector_type(8)));
constexpr int BM = 256, BK = 64, HALF = 128, HTB = HALF * BK * 2, STAGE_BYTES = 8 * HTB, NXCD = 8, WGM = 8;

__host__ __device__ __forceinline__ int lds_byte(int r, int c) { const int st = (r >> 4) * 2 + (c >> 5), rr = r & 15, cc = c & 31, ob = rr * 64 + cc * 2; return st * 1024 + (ob ^ (((ob >> 9) & 1) << 5)); }
__host__ __device__ __forceinline__ void stage_rc(int b, int& R, int& C) { const int st = b / 1024, sb = b % 1024, swz = sb ^ (((sb >> 9) & 1) << 5); R = (st >> 1) * 16 + swz / 64; C = (st & 1) * 32 + (swz % 64) / 2; }
__host__ __device__ __forceinline__ int perm32(int rho) { const int n = rho >> 4, i = rho & 15; return 8 * (i >> 2) + 4 * n + (i & 3); }

struct Unit { int pm, pn, bz; unsigned aoff, boff; };
struct Gemm { const bf16_t* A; const bf16_t* Bt; int lda, ldb, K; };

struct TileOrder {
    int nM, nN, nB, nwg, G, c;
    __device__ void init(int nM_, int nN_, int nB_, int G_, int c_) { nM = nM_; nN = nN_; nB = nB_; nwg = nM * nN * nB; G = G_; c = c_; }
    __device__ bool decode(int i, int& bz, int& pm, int& pn) const {
        const long L = (long)i * G + c; if (L >= nwg) return false;
        int wgid = (int)L; { const int q = nwg / NXCD, r = nwg % NXCD, xcd = wgid % NXCD, off = wgid / NXCD; wgid = (xcd < r ? xcd * (q + 1) : r * (q + 1) + (xcd - r) * q) + off; }
        const int per = nM * nN; bz = wgid / per; const int w = wgid - bz * per;
        const int nig = WGM * nN, gid = w / nig, fm = gid * WGM, gsz = (nM - fm) < WGM ? (nM - fm) : WGM;
        pm = fm + ((w % nig) % gsz); pn = (w % nig) / gsz; return true;
    }
};
struct PlainSched {
    TileOrder o; size_t astr, bstr, zA, zB;
    __device__ bool next(int i, Unit& u) const { if (!o.decode(i, u.bz, u.pm, u.pn)) return false; u.aoff = (unsigned)((size_t)u.bz * zA + (size_t)u.pm * astr); u.boff = (unsigned)((size_t)u.bz * zB + (size_t)u.pn * bstr); return true; }
};
struct MoeSched {
    TileOrder o; size_t astr, bstr, zB; const int* tile_e;
    __device__ bool next(int i, Unit& u) const { int bz; if (!o.decode(i, bz, u.pm, u.pn)) return false; u.bz = __builtin_amdgcn_readfirstlane(tile_e[u.pm]); u.aoff = (unsigned)((size_t)u.pm * astr); u.boff = (unsigned)((size_t)u.bz * zB + (size_t)u.pn * bstr); return true; }
};

struct MoeSplitSched {
    int pm0, nun, G, c; size_t astr, bstr, zB; unsigned kslice; const int* tile_e;
    __device__ bool next(int i, Unit& u) const { const long L = (long)i * G + c; if (L >= nun) return false; const int l = (int)L, ks = l & 3, pn = (l >> 2) & 7, pm = pm0 + (l >> 5);
        u.pm = pm; u.pn = pn; u.bz = ks; const int e = __builtin_amdgcn_readfirstlane(tile_e[pm]);
        u.aoff = (unsigned)((size_t)pm * astr + (size_t)ks * kslice); u.boff = (unsigned)((size_t)e * zB + (size_t)pn * bstr + (size_t)ks * kslice); return true; }
};
__device__ __forceinline__ unsigned cvt_pk_bf16(float lo, float hi) { unsigned r; asm volatile("v_cvt_pk_bf16_f32 %0, %1, %2" : "=v"(r) : "v"(lo), "v"(hi)); return r; }
__device__ __forceinline__ u32x4 pack8(const f32x4& a, const f32x4& b) { u32x4 w; w.x = cvt_pk_bf16(a[0], a[1]); w.y = cvt_pk_bf16(a[2], a[3]); w.z = cvt_pk_bf16(b[0], b[1]); w.w = cvt_pk_bf16(b[2], b[3]); return w; }

template <class Epi, class Sched, bool FP8 = false, int MIXT = -1>
__device__ __forceinline__ void gemm_phase(PG8_LAS unsigned char* lds, const Gemm g, const Sched& S, const Epi& E) {
    const int tid = threadIdx.x, wid = __builtin_amdgcn_readfirstlane(tid >> 6), lane = tid & 63, wr = wid >> 2, wc = wid & 3, fr = lane & 15, fq = lane >> 4;
    const int K = g.K, nt = K / BK;
    unsigned voffA[2], voffB[2];
#pragma unroll
    for (int i = 0; i < 2; ++i) { int R, C; stage_rc(tid * 16 + i * 8192, R, C); const int Rb = Epi::PERM ? ((R & ~31) + perm32(R & 31)) : R;
        voffA[i] = (unsigned)(R * g.lda + C) * 2u; voffB[i] = (unsigned)(Rb * g.ldb + C) * 2u; }
    const unsigned kstep = (unsigned)(BK * 2);
    const unsigned hstepA = (unsigned)HALF * (unsigned)g.lda * 2u, hstepB = (unsigned)HALF * (unsigned)g.ldb * 2u;
    const unsigned ldsw = (unsigned)wid * 1024u;
    const int aoff = lds_byte(wr * 64 + fr, fq * 8), boff = lds_byte(wc * 32 + fr, fq * 8);
    const char* const gA = (const char*)g.A; const char* const gB = (const char*)g.Bt;
#define PG8_SA(b, h) (((b) * 2 + (h)) * HTB)
#define PG8_SB(b, h) ((4 + (b) * 2 + (h)) * HTB)
#define PG8_STAGE(bufoff, gbase, soff, voff) do { _Pragma("unroll") for (int _i = 0; _i < 2; ++_i) \
        __builtin_amdgcn_global_load_lds((const unsigned*)((gbase) + (size_t)((soff) + (voff)[_i])), (PG8_LAS unsigned*)(lds + (bufoff) + ldsw + _i * 8192), 16, 0, 0); } while (0)
#define PG8_LDA(dst, b, h) do { _Pragma("unroll") for (int m = 0; m < 4; ++m) _Pragma("unroll") for (int k = 0; k < 2; ++k) dst[m][k] = *(const PG8_LAS bf16x8*)(lds + PG8_SA(b, h) + aoff + m * 2048 + k * 1024); } while (0)
#define PG8_LDB(dst, b, h) do { _Pragma("unroll") for (int n = 0; n < 2; ++n) _Pragma("unroll") for (int k = 0; k < 2; ++k) dst[n][k] = *(const PG8_LAS bf16x8*)(lds + PG8_SB(b, h) + boff + n * 2048 + k * 1024); } while (0)
#define PG8_CAT(x) __builtin_shufflevector(__builtin_bit_cast(v4i, (x)[0]), __builtin_bit_cast(v4i, (x)[1]), 0, 1, 2, 3, 4, 5, 6, 7)
#define PG8_MMA(ai, bj, At, Bt, IS8) do { __builtin_amdgcn_s_setprio(1); \
        if constexpr (MIXT >= 0) { if (IS8) { \
            _Pragma("unroll") for (int m = 0; m < 4; ++m) { const v8i a8 = PG8_CAT(At[m]); _Pragma("unroll") for (int n = 0; n < 2; ++n) { const v8i b8 = PG8_CAT(Bt[n]); \
                asm volatile("s_nop 1\n\tv_mfma_scale_f32_16x16x128_f8f6f4 %0, %1, %2, %0, %3, %4 op_sel_hi:[0,0,0]" : "+v"(acc[ai][bj][m][n]) : "v"(b8), "v"(a8), "v"(scw), "v"(sc1)); } } \
          } else { _Pragma("unroll") for (int m = 0; m < 4; ++m) _Pragma("unroll") for (int n = 0; n < 2; ++n) _Pragma("unroll") for (int k = 0; k < 2; ++k) \
            acc[ai][bj][m][n] = __builtin_amdgcn_mfma_f32_16x16x32_bf16(Bt[n][k], At[m][k], acc[ai][bj][m][n], 0, 0, 0); } \
        } else if constexpr (FP8) {   \
            _Pragma("unroll") for (int m = 0; m < 4; ++m) { const v8i a8 = PG8_CAT(At[m]); _Pragma("unroll") for (int n = 0; n < 2; ++n) { const v8i b8 = PG8_CAT(Bt[n]); \
                  \
                asm volatile("s_nop 1\n\tv_mfma_scale_f32_16x16x128_f8f6f4 %0, %1, %2, %0, %3, %3 op_sel_hi:[0,0,0]" : "+v"(acc[ai][bj][m][n]) : "v"(b8), "v"(a8), "v"(sc1)); } } \
        } else { _Pragma("unroll") for (int m = 0; m < 4; ++m) _Pragma("unroll") for (int n = 0; n < 2; ++n) _Pragma("unroll") for (int k = 0; k < 2; ++k) \
            acc[ai][bj][m][n] = __builtin_amdgcn_mfma_f32_16x16x32_bf16(Bt[n][k], At[m][k], acc[ai][bj][m][n], 0, 0, 0); } \
        __builtin_amdgcn_s_setprio(0); } while (0)
#define PG8_WAIT_V(n) asm volatile("s_waitcnt vmcnt(" #n ")" ::: "memory")
#define PG8_WAIT_L(n) asm volatile("s_waitcnt lgkmcnt(" #n ")" ::: "memory")
#define PG8_BAR __builtin_amdgcn_s_barrier()
#define PG8_SCHED __builtin_amdgcn_sched_barrier(0)
    Unit cur, nxt; int ui = 0;
    if (!S.next(0, cur)) return;
    const int sc1 = 0x7f7f7f7f, scw = 0x79797979;
    f32x4 acc[2][2][4][2];
#pragma unroll
    for (int a = 0; a < 2; ++a)
#pragma unroll
        for (int b = 0; b < 2; ++b)
#pragma unroll
            for (int m = 0; m < 4; ++m)
#pragma unroll
                for (int n = 0; n < 2; ++n) acc[a][b][m][n] = (f32x4){0.f, 0.f, 0.f, 0.f};
    bf16x8 At[4][2], B0[2][2], B1[2][2];
    unsigned cA = cur.aoff, cB = cur.boff;
    PG8_STAGE(PG8_SB(0, 0), gB, cB, voffB); PG8_STAGE(PG8_SB(0, 1), gB, cB + hstepB, voffB); PG8_STAGE(PG8_SA(0, 0), gA, cA, voffA); PG8_STAGE(PG8_SA(0, 1), gA, cA + hstepA, voffA);
    if (wr == 1) PG8_BAR;
    PG8_WAIT_V(2); PG8_BAR;
    PG8_STAGE(PG8_SB(1, 0), gB, cB + kstep, voffB); PG8_STAGE(PG8_SA(1, 0), gA, cA + kstep, voffA); PG8_STAGE(PG8_SB(1, 1), gB, cB + hstepB + kstep, voffB);
    PG8_WAIT_V(6); PG8_BAR;
    for (;;) {
        const bool has_next = S.next(ui + 1, nxt);
        const unsigned nA = has_next ? nxt.aoff : cA, nB = has_next ? nxt.boff : cB;
#define PG8_KBODY(IS8) do { \
            const bool last = (t == nt - 2); \
            const unsigned a1 = cA + (unsigned)(t + 1) * kstep; \
            const unsigned a2 = last ? nA : cA + (unsigned)(t + 2) * kstep, b2 = last ? nB : cB + (unsigned)(t + 2) * kstep; \
            const unsigned a3 = a2 + kstep, b3 = b2 + kstep; \
            PG8_LDB(B0, 0, 0); PG8_LDB(B1, 0, 1); PG8_SCHED; PG8_LDA(At, 0, 0); PG8_STAGE(PG8_SA(1, 1), gA, a1 + hstepA, voffA); \
            PG8_WAIT_V(8); PG8_WAIT_L(0); PG8_BAR; PG8_MMA(0, 0, At, B0, IS8); PG8_MMA(0, 1, At, B1, IS8); PG8_BAR; PG8_SCHED; \
            PG8_LDA(At, 0, 1); PG8_STAGE(PG8_SB(0, 0), gB, b2, voffB); PG8_STAGE(PG8_SB(0, 1), gB, b2 + hstepB, voffB); PG8_STAGE(PG8_SA(0, 0), gA, a2, voffA); \
            PG8_WAIT_V(8); PG8_WAIT_L(0); PG8_BAR; PG8_MMA(1, 0, At, B0, IS8); PG8_MMA(1, 1, At, B1, IS8); PG8_BAR; PG8_SCHED; \
            PG8_LDB(B0, 1, 0); PG8_LDB(B1, 1, 1); PG8_SCHED; PG8_LDA(At, 1, 0); PG8_STAGE(PG8_SA(0, 1), gA, a2 + hstepA, voffA); \
            PG8_WAIT_V(8); PG8_WAIT_L(0); PG8_BAR; PG8_MMA(0, 0, At, B0, IS8); PG8_MMA(0, 1, At, B1, IS8); PG8_BAR; PG8_SCHED; \
            PG8_LDA(At, 1, 1); PG8_STAGE(PG8_SB(1, 0), gB, b3, voffB); PG8_STAGE(PG8_SB(1, 1), gB, b3 + hstepB, voffB); PG8_STAGE(PG8_SA(1, 0), gA, a3, voffA); \
            PG8_WAIT_V(8); PG8_WAIT_L(0); PG8_BAR; PG8_MMA(1, 0, At, B0, IS8); PG8_MMA(1, 1, At, B1, IS8); PG8_BAR; PG8_SCHED; \
        } while (0)
        if constexpr (MIXT >= 0) {
#pragma unroll 1
            for (int t = 0; t < MIXT; t += 2) PG8_KBODY(false);
#pragma unroll 1
            for (int t = MIXT; t < nt; t += 2) PG8_KBODY(true);
        } else {
#pragma unroll 1
            for (int t = 0; t < nt; t += 2) PG8_KBODY(false);
        }
#undef PG8_KBODY
        if constexpr (FP8 || MIXT >= 0) {
            asm volatile("s_nop 15" : "+v"(acc[0][0][0][0]), "+v"(acc[0][0][0][1]), "+v"(acc[0][0][1][0]), "+v"(acc[0][0][1][1]), "+v"(acc[0][0][2][0]), "+v"(acc[0][0][2][1]), "+v"(acc[0][0][3][0]), "+v"(acc[0][0][3][1]),
                                      "+v"(acc[0][1][0][0]), "+v"(acc[0][1][0][1]), "+v"(acc[0][1][1][0]), "+v"(acc[0][1][1][1]), "+v"(acc[0][1][2][0]), "+v"(acc[0][1][2][1]), "+v"(acc[0][1][3][0]), "+v"(acc[0][1][3][1]));
            asm volatile("" : "+v"(acc[1][0][0][0]), "+v"(acc[1][0][0][1]), "+v"(acc[1][0][1][0]), "+v"(acc[1][0][1][1]), "+v"(acc[1][0][2][0]), "+v"(acc[1][0][2][1]), "+v"(acc[1][0][3][0]), "+v"(acc[1][0][3][1]),
                              "+v"(acc[1][1][0][0]), "+v"(acc[1][1][0][1]), "+v"(acc[1][1][1][0]), "+v"(acc[1][1][1][1]), "+v"(acc[1][1][2][0]), "+v"(acc[1][1][2][1]), "+v"(acc[1][1][3][0]), "+v"(acc[1][1][3][1]));
        }
        if (wr == 0) PG8_BAR;
        E(acc, cur, wr, wc, fr, fq);
        if (!has_next) break;
#pragma unroll
        for (int a = 0; a < 2; ++a)
#pragma unroll
            for (int b = 0; b < 2; ++b)
#pragma unroll
                for (int m = 0; m < 4; ++m)
#pragma unroll
                    for (int n = 0; n < 2; ++n) acc[a][b][m][n] = (f32x4){0.f, 0.f, 0.f, 0.f};
        cur = nxt; cA = nA; cB = nB; ++ui;
        if (wr == 1) PG8_BAR;
    }
    PG8_WAIT_V(0);
    PG8_BAR;
#undef PG8_SA
#undef PG8_SB
#undef PG8_STAGE
#undef PG8_LDA
#undef PG8_LDB
#undef PG8_MMA
#undef PG8_CAT
#undef PG8_WAIT_V
#undef PG8_WAIT_L
#undef PG8_BAR
#undef PG8_SCHED
}
}

constexpr int D = 2048, SEQ = 16384, CTX = 256, T = SEQ + CTX, DFF = 7168, NEXP = 8;
constexpr int NWAVES = 8, NTHR = 512;
constexpr int WPOOL = 1536, WS5 = 512, PG = 384, S5G = 32, S5P = 64, S5N = 16, LC = 64, NCH = T / LC  , NCH_CTX = CTX / LC  ;
constexpr int S5ROWS = 512, S5K = 1280;
constexpr int WINO_N = 4864;
constexpr float EPS = 1e-6f;
constexpr float MOE_WSC_GU = 64.f, MOE_WSC_DN = 128.f, MOE_HSC = 4.f;

enum { I_X = 0, I_C, I_CTX, I_CCTX, I_WMOD, I_BMOD, I_NORMS, I_EWIN, I_EPOOLW, I_EPOOLS, I_LAMRE, I_LAMIM, I_LOGDT, I_BRE, I_BIM, I_CRE, I_CIM, I_S5D, I_WGLU, I_EWOUT,
       I_FFG, I_FFU, I_FFD, I_OWIN, I_GLAWA, I_GLABA, I_GLANORM, I_QNORM, I_KNORM, I_OWOUT, I_ROUTER, I_ROUTERB, I_MOEG, I_MOEU, I_MOED, N_IN };

constexpr size_t MiB = 1u << 20;
constexpr size_t al256(size_t x) { return (x + 255) / 256 * 256; }
constexpr size_t WS_CTL = 0, CTL_ZERO_BYTES = 128 * 1024;
constexpr size_t WS_MODF = 1 * MiB;
constexpr size_t WS_ROPE = WS_MODF + al256(2 * 2 * 6 * 2048 * 4);
constexpr size_t WS_W0 = 2 * MiB;
constexpr size_t SZ_WINE = (size_t)2048 * 2048 * 2, SZ_WPOOL = (size_t)4 * 512 * 384 * 2, SZ_WGLU = (size_t)512 * 512 * 2, SZ_WGU = (size_t)14336 * 2048 * 2,
                 SZ_WDN = (size_t)2048 * 7168 * 2, SZ_WINO = (size_t)WINO_N * 2048 * 2;
constexpr size_t WS_WINE = WS_W0, WS_WPOOL = WS_WINE + SZ_WINE, WS_WGLU = WS_WPOOL + SZ_WPOOL, WS_WOUTE = WS_WGLU + SZ_WGLU, WS_WGU = WS_WOUTE + SZ_WINE,
                 WS_WDN = WS_WGU + SZ_WGU, WS_WINO = WS_WDN + SZ_WDN, WS_WOUTO = WS_WINO + SZ_WINO, WS_WMGU = WS_WOUTO + SZ_WINE, WS_WMDN = WS_WMGU + 8 * SZ_WGU,
                 WS_HRES = WS_WMDN + 8 * SZ_WDN;
constexpr size_t SZ_HRES = (size_t)T * D * 4;
constexpr size_t WS_ARENA = WS_HRES + SZ_HRES;
constexpr size_t SZ_ROWB = (size_t)T * D * 2;
constexpr size_t A_U = 0, A_ZP = A_U + SZ_ROWB, SZ_ZP = (size_t)T * WPOOL * 2, A_DP = A_ZP + SZ_ZP, A_AS5 = A_DP + SZ_ZP, SZ_AS5 = (size_t)S5G * S5ROWS * S5K * 2,
                 A_SLOC = A_AS5 + SZ_AS5, SZ_SLOC = (size_t)S5G * S5ROWS * 256 * 4, A_YG = A_SLOC + SZ_SLOC, SZ_YG = (size_t)T * WS5 * 2, A_YMIX = A_YG + SZ_YG,
                 A_YO = A_YMIX + SZ_ROWB, A_V = A_YO + SZ_ROWB, A_HID = A_V + SZ_ROWB, SZ_HID = (size_t)T * DFF * 2, A_F = A_HID + SZ_HID,
                 A_M1T = A_F + SZ_ROWB, SZ_M1T = (size_t)S5G * 256 * 1024 * 2, A_K3T = A_M1T + SZ_M1T, SZ_K3T = (size_t)S5G * 1024 * S5K * 2,
                 A_TBG = A_K3T + SZ_K3T, SZ_TBG = (size_t)S5G * 2 * 64 * 256 * 4, A_L0_END = A_TBG + SZ_TBG;
constexpr size_t WS_END_L0 = WS_ARENA + A_L0_END;
constexpr int MOE_ROWS = 2 * SEQ + NEXP * 256;
constexpr int MOE_MAIN_TILES = 128, MOE_SPLIT_TILES = MOE_ROWS / 256 - 128;
static_assert((size_t)4 * MOE_SPLIT_TILES * 256 * D * 4 <= (size_t)MOE_ROWS * D * 2, "split-K partials fit in the (dead) VG region");
constexpr size_t SZ_T512 = (size_t)T * 512 * 2, SZ_T1024 = (size_t)T * 1024 * 2, SZ_T256 = (size_t)T * 256 * 2, SZ_SEQB = (size_t)SEQ * D * 2;
constexpr size_t B_GQ = A_U + SZ_ROWB, B_GK = B_GQ + SZ_T512, B_GV = B_GK + SZ_T512, B_R = B_GV + SZ_T1024, B_AQ = B_R + SZ_T1024, B_AK = B_AQ + SZ_T1024, B_AV = B_AK + SZ_T256,
                 B_ALR = B_AV + SZ_T256, B_QE = B_ALR + al256((size_t)T * 16 * 4), B_KE = B_QE + 2 * SZ_T512, B_KDT = B_KE + 2 * SZ_T512, B_VT = B_KDT + 2 * SZ_T512,
                 B_DEC = B_VT + SZ_T1024, B_ST = B_DEC + al256((size_t)2 * NCH * 4 * 128 * 4), SZ_ST = (size_t)2 * NCH * 4 * 256 * 128 * 2, B_YMIX1 = B_ST + SZ_ST,
                 B_YO1 = B_YMIX1 + SZ_SEQB, B_REGA_END = B_YO1 + SZ_SEQB;
constexpr size_t B_HID2 = 0, SZ_HID2 = (size_t)MOE_ROWS * DFF * 2, B_FS = B_HID2 + SZ_HID2, SZ_FS = (size_t)MOE_ROWS * D * 2, B_OVL_END = B_FS + SZ_FS;
constexpr size_t B_REGB = al256(B_REGA_END > B_OVL_END ? B_REGA_END : B_OVL_END);
constexpr size_t B_V1 = B_REGB, B_VG = B_V1 + SZ_SEQB, B_RE = B_VG + SZ_FS, B_RG = B_RE + (size_t)SEQ * 8, B_SLOT = B_RG + (size_t)SEQ * 8, B_CNT = B_SLOT + (size_t)SEQ * 8,
                 B_TILE = B_CNT + 256 * 8 * 4, B_L1_END = B_TILE + 4096;
constexpr size_t WS_END_L1 = WS_ARENA + B_L1_END;
constexpr size_t WS_NEED = WS_END_L0 > WS_END_L1 ? WS_END_L0 : WS_END_L1;
static_assert(WS_NEED <= (size_t)1879048192, "workspace map exceeds the guaranteed size");

constexpr int CW_TMO = 0, CW_CODE = 1, CW_BAR = 4096;

#define GAS __attribute__((address_space(1)))
#define LAS __attribute__((address_space(3)))
typedef unsigned short bf16;
typedef unsigned v4u __attribute__((ext_vector_type(4)));
typedef unsigned v2u __attribute__((ext_vector_type(2)));
typedef float f32x4 __attribute__((ext_vector_type(4)));
typedef float f32x2 __attribute__((ext_vector_type(2)));
typedef short bf16x8 __attribute__((ext_vector_type(8)));
typedef GAS unsigned gu32;
#define RLX_AGENT __ATOMIC_RELAXED, __HIP_MEMORY_SCOPE_AGENT
#define LDS_WAIT() asm volatile("s_waitcnt lgkmcnt(0)" ::: "memory")
#define VM_WAIT() asm volatile("s_waitcnt vmcnt(0)" ::: "memory")
__device__ __forceinline__ unsigned f2bf(float f) { unsigned u = __builtin_bit_cast(unsigned, f); return (u + 0x7fffu + ((u >> 16) & 1u)) >> 16; }
typedef __bf16 bf16x2_t __attribute__((ext_vector_type(2)));
__device__ __forceinline__ unsigned pk2(float lo, float hi) { const f32x2 v = {lo, hi}; return __builtin_bit_cast(unsigned, __builtin_convertvector(v, bf16x2_t)); }
__device__ __forceinline__ float bflo(unsigned w) { return __builtin_bit_cast(float, w << 16); }
__device__ __forceinline__ float bfhi(unsigned w) { return __builtin_bit_cast(float, w & 0xffff0000u); }
__device__ __forceinline__ float bf2f(bf16 b) { return __builtin_bit_cast(float, (unsigned)b << 16); }
__device__ __forceinline__ float sigmoidf_(float x) { return __builtin_amdgcn_rcpf(1.f + __expf(-x)); }
__device__ __forceinline__ float siluf_(float x) { return x * __builtin_amdgcn_rcpf(1.f + __expf(-x)); }
__device__ __forceinline__ float swiglu_fast(float ag, float au, float negsg_log2e, float kk) { const float e = __builtin_amdgcn_exp2f(ag * negsg_log2e); return (ag * au) * (kk * __builtin_amdgcn_rcpf(1.f + e)); }
__device__ __forceinline__ float gelu_tanh(float y) { const float z = 0.7978845608028654f * (y + 0.044715f * y * y * y); const float e = __expf(2.f * z); const float th = 1.f - 2.f * __builtin_amdgcn_rcpf(e + 1.f); return 0.5f * y * (1.f + th); }

#define XB_TMO      128
#define XB_XCNT(j)  (256  + 64 * (j))
#define XB_XSUB(j)  (1280 + 64 * (j))
#define XB_XGEN(j)  (2304 + 64 * (j))
#define XB_TOP      3328
#define XB_TOPGEN   3392
#define XCD_BAR_WORDS 3456
#define XB_SPIN_CAP (1u << 22)
__device__ __forceinline__ unsigned xb_ld(unsigned* p)              { return __hip_atomic_load(p, __ATOMIC_RELAXED, __HIP_MEMORY_SCOPE_AGENT); }
__device__ __forceinline__ unsigned xb_add(unsigned* p, unsigned v) { return __hip_atomic_fetch_add(p, v, __ATOMIC_RELAXED, __HIP_MEMORY_SCOPE_AGENT); }
__device__ __forceinline__ unsigned xb_xcc_id() { return (unsigned)__builtin_amdgcn_s_getreg((3 << 11) | 20) & 0xFu; }
#define XB_SPIN(cond, bar) do { unsigned _sp = 0; while (cond) { __builtin_amdgcn_s_sleep(1); \
    if ((++_sp & 255u) == 0u) { if (xb_ld(&(bar)[XB_TMO])) break; if (_sp > XB_SPIN_CAP) { atomicAdd(&(bar)[XB_TMO], 1u); break; } } } } while (0)
struct XcdBarrier { unsigned* bar; unsigned x; volatile LAS unsigned* st; };
__device__ __forceinline__ XcdBarrier xcd_barrier_post(unsigned* bar, volatile LAS unsigned* st) {
    XcdBarrier b; b.bar = bar; b.x = xb_xcc_id(); b.st = st;
    if (threadIdx.x == 0) (void)xb_add(&bar[XB_XCNT(b.x)], 1u);
    return b;
}
__device__ __forceinline__ void xcd_barrier_complete(unsigned* bar, unsigned x, unsigned& nloc, unsigned& nx) {
    const unsigned G = gridDim.x * gridDim.y * gridDim.z;
    unsigned sum, cnt, mine, sp = 0u;
    for (;;) {
        sum = 0u; cnt = 0u; mine = 0u;
#pragma unroll
        for (unsigned j = 0; j < 16; ++j) { const unsigned c = xb_ld(&bar[XB_XCNT(j)]); sum += c; cnt += (c > 0u) ? 1u : 0u; mine = (j == x) ? c : mine; }
        if (sum == G) break;
        __builtin_amdgcn_s_sleep(1);
        if ((++sp & 255u) == 0u) { if (xb_ld(&bar[XB_TMO])) break; if (sp > XB_SPIN_CAP) { atomicAdd(&bar[XB_TMO], 1u); break; } }
    }
    nloc = mine > 0u ? mine : 1u; nx = cnt > 0u ? cnt : 1u;
}
__device__ __forceinline__ void xcd_barrier(const XcdBarrier& b) {
    asm volatile("s_waitcnt vmcnt(0)" ::: "memory");
    __syncthreads();
    if (threadIdx.x == 0) {
        unsigned* bar = b.bar;
        __builtin_amdgcn_s_waitcnt(0);
        unsigned nloc = b.st[0], nx = b.st[1];
        if (nloc == 0u) { xcd_barrier_complete(bar, b.x, nloc, nx); b.st[0] = nloc; b.st[1] = nx; }
        const unsigned old = xb_add(&bar[XB_XSUB(b.x)], 1u);
        const unsigned gen = old / nloc;
        if (old + 1u == (gen + 1u) * nloc) {
            __builtin_amdgcn_fence(__ATOMIC_RELEASE, "agent");
            asm volatile("s_waitcnt vmcnt(0)" ::: "memory");
            const unsigned og = xb_add(&bar[XB_TOP], 1u);
            const unsigned tg = og / nx;
            if (og + 1u == (tg + 1u) * nx) xb_add(&bar[XB_TOPGEN], 1u);
            else XB_SPIN(xb_ld(&bar[XB_TOPGEN]) == tg, bar);
            __builtin_amdgcn_fence(__ATOMIC_ACQUIRE, "agent");
            xb_add(&bar[XB_XGEN(b.x)], 1u);
            asm volatile("s_waitcnt vmcnt(0)" ::: "memory");
        } else {
            XB_SPIN(xb_ld(&bar[XB_XGEN(b.x)]) == gen, bar);
            __builtin_amdgcn_fence(__ATOMIC_ACQUIRE, "agent");
            asm volatile("s_waitcnt vmcnt(0)" ::: "memory");
        }
    }
    __syncthreads();
}

constexpr int RING_OFF = 0, RING_BYTES = 131072;
constexpr int LDSCTL_OFF = RING_BYTES, MISC_OFF = LDSCTL_OFF + 320;
constexpr int LDS_BYTES = 147456;

#define CAS __attribute__((address_space(4)))
__device__ __forceinline__ const float* inp(int k) { const CAS char* ka = (const CAS char*)__builtin_amdgcn_kernarg_segment_ptr(); return *(const float* const CAS*)(ka + 8 * k); }
__device__ __forceinline__ float* karg_out() { const CAS char* ka = (const CAS char*)__builtin_amdgcn_kernarg_segment_ptr(); return *(float* const CAS*)(ka + 8 * 35); }
__device__ __forceinline__ unsigned char* karg_ws() { const CAS char* ka = (const CAS char*)__builtin_amdgcn_kernarg_segment_ptr(); return *(unsigned char* const CAS*)(ka + 8 * 36); }
__device__ __forceinline__ int karg_i(int k) { const CAS char* ka = (const CAS char*)__builtin_amdgcn_kernarg_segment_ptr(); return *(const CAS int*)(ka + 8 * 37 + 4 * k); }
struct Frame {
    LAS unsigned char* lds;
    volatile LAS unsigned* MISC;
    gu32* ctl;
    int tid, lane, wave, vcu, G;
    unsigned char* ws;
};
__device__ __forceinline__ float wave_sum(float v) {
#pragma unroll
    for (int o = 1; o < 64; o <<= 1) v += __shfl_xor(v, o);
    return v;
}

struct RmIdent { int off; __device__ __forceinline__ int operator()(int n) const { return n + off; } };
struct RmGateUp { int which; __device__ __forceinline__ int operator()(int n) const { return (n >> 7) * 256 + which * 128 + (n & 127); } };
struct RmWinO { __device__ __forceinline__ int operator()(int n) const {
    if (n < 2048) return n; if (n < 2064) return 4608 + (n - 2048); return n - 16; } };
template <class RM> __device__ __forceinline__ void tr_item(const float* W, int K, int N, bf16* WT, int ldt, const RM rm, LAS float* scr, int item, int lane) {
    const int nblk = (N + 31) / 32, kb = item / nblk, nb = item - kb * nblk, k0 = 64 * kb, n0 = 32 * nb;
    const int c4 = (lane & 7) * 4, r8 = lane >> 3; const bool okc = (n0 + c4) < N;
    f32x4 v[8];
#pragma unroll
    for (int i = 0; i < 8; ++i) v[i] = okc ? *(const GAS f32x4*)(W + (size_t)(k0 + 8 * i + r8) * N + n0 + c4) : (f32x4){0.f, 0.f, 0.f, 0.f};
#pragma unroll
    for (int i = 0; i < 8; ++i) { LAS float* s = scr + (8 * i + r8) * 33 + c4; s[0] = v[i][0]; s[1] = v[i][1]; s[2] = v[i][2]; s[3] = v[i][3]; }
    LDS_WAIT(); asm volatile("" ::: "memory");
    const int c = lane & 7;
#pragma unroll
    for (int j = 0; j < 4; ++j) { const int n = (lane >> 3) + 8 * j; const LAS float* s = scr + (8 * c) * 33 + n;
        v4u o; o.x = pk2(s[0 * 33], s[1 * 33]); o.y = pk2(s[2 * 33], s[3 * 33]); o.z = pk2(s[4 * 33], s[5 * 33]); o.w = pk2(s[6 * 33], s[7 * 33]);
        if (n0 + n < N) *(GAS v4u*)(WT + (size_t)rm(n0 + n) * ldt + k0 + 8 * c) = o; }
    LDS_WAIT(); asm volatile("" ::: "memory");
}
__device__ __forceinline__ void zero_rows(bf16* p, size_t nbytes, int gt, int ngt) {
    for (size_t i = (size_t)gt; i < nbytes / 16; i += (size_t)ngt) ((GAS v4u*)p)[i] = (v4u){0u, 0u, 0u, 0u};
}
__device__ __forceinline__ unsigned pk4_fp8(float a, float b, float c, float d) { int w = 0; w = __builtin_amdgcn_cvt_pk_fp8_f32(a, b, w, false); w = __builtin_amdgcn_cvt_pk_fp8_f32(c, d, w, true); return (unsigned)w; }
template <class RM> __device__ __forceinline__ void tr_item8(const float* W, int K, int N, unsigned char* WT, int ldt, const RM rm, float sc, LAS float* scr, int item, int lane) {
    const int nblk = (N + 31) / 32, kb = item / nblk, nb = item - kb * nblk, k0 = 64 * kb, n0 = 32 * nb;
    const int c4 = (lane & 7) * 4, r8 = lane >> 3; const bool okc = (n0 + c4) < N;
    f32x4 v[8];
#pragma unroll
    for (int i = 0; i < 8; ++i) v[i] = okc ? *(const GAS f32x4*)(W + (size_t)(k0 + 8 * i + r8) * N + n0 + c4) : (f32x4){0.f, 0.f, 0.f, 0.f};
#pragma unroll
    for (int i = 0; i < 8; ++i) { LAS float* s = scr + (8 * i + r8) * 33 + c4; s[0] = v[i][0]; s[1] = v[i][1]; s[2] = v[i][2]; s[3] = v[i][3]; }
    LDS_WAIT(); asm volatile("" ::: "memory");
    const int c = lane & 7;
#pragma unroll
    for (int j = 0; j < 4; ++j) { const int n = (lane >> 3) + 8 * j; const LAS float* s = scr + (8 * c) * 33 + n;
        v2u o; o.x = pk4_fp8(s[0 * 33] * sc, s[1 * 33] * sc, s[2 * 33] * sc, s[3 * 33] * sc); o.y = pk4_fp8(s[4 * 33] * sc, s[5 * 33] * sc, s[6 * 33] * sc, s[7 * 33] * sc);
        if (n0 + n < N) *(GAS v2u*)(WT + (size_t)rm(n0 + n) * ldt + k0 + 8 * c) = o; }
    LDS_WAIT(); asm volatile("" ::: "memory");
}
constexpr int items_of(int K, int N) { return (K / 64) * ((N + 31) / 32); }

__device__ __forceinline__ void s5_small_tables(Frame& F, int g) {
    const float* lam_re = inp(I_LAMRE); const float* lam_im = inp(I_LAMIM); const float* log_dt = inp(I_LOGDT);
    const float* b_re = inp(I_BRE); const float* b_im = inp(I_BIM); const float* c_re = inp(I_CRE); const float* c_im = inp(I_CIM);
    LAS f32x2* APOW = (LAS f32x2*)(F.lds); LAS f32x2* BB = (LAS f32x2*)(F.lds + 2 * 64 * 65 * 8); LAS f32x2* CC = BB + 2 * 64 * 16;
    const int tid = F.tid;
    __syncthreads();
    if (tid < 128) {
        const int dir = tid >> 6, p = tid & 63; const int gi = (dir * S5G + g);
        const double dt = exp((double)log_dt[gi]); const double lr = (double)lam_re[gi * 64 + p], li = (double)lam_im[gi * 64 + p];
        const double mag = exp(lr * dt), ar = mag * cos(li * dt), ai = mag * sin(li * dt);
        double pr = 1.0, pi = 0.0;
        for (int k = 0; k <= 64; ++k) { APOW[(dir * 64 + p) * 65 + k] = (f32x2){(float)pr, (float)pi}; const double nr = pr * ar - pi * ai, ni = pr * ai + pi * ar; pr = nr; pi = ni; }
        const double den = lr * lr + li * li, nr = ar - 1.0, ni = ai;
        const double kr = (nr * lr + ni * li) / den, ki = (ni * lr - nr * li) / den;
        for (int n = 0; n < 16; ++n) { const double br = (double)b_re[(gi * 64 + p) * 16 + n], bi = (double)b_im[(gi * 64 + p) * 16 + n];
            BB[(dir * 64 + p) * 16 + n] = (f32x2){(float)(kr * br - ki * bi), (float)(kr * bi + ki * br)}; }
    }
    for (int i = tid; i < 2 * 16 * 64; i += NTHR) { const int dir = i >> 10, r = i & 1023; CC[i] = (f32x2){c_re[(size_t)(dir * S5G + g) * 1024 + r], c_im[(size_t)(dir * S5G + g) * 1024 + r]}; }
    __syncthreads();
}
__device__ __forceinline__ void s5_stage_a(Frame& F, int g, int part) {
    LAS f32x2* APOW = (LAS f32x2*)(F.lds); LAS f32x2* BB = (LAS f32x2*)(F.lds + 2 * 64 * 65 * 8); LAS f32x2* CC = BB + 2 * 64 * 16;
    float* TBG = (float*)(F.ws + WS_ARENA + A_TBG) + (size_t)g * (2 * 64 * 256);
    bf16* M1T = (bf16*)(F.ws + WS_ARENA + A_M1T) + (size_t)g * 256 * 1024;
    const int tid = F.tid;
    {
        const int n = tid & 15, np = (tid >> 4) & 15, dl0 = 8 * part + ((tid >> 8) & 1);
#pragma unroll
        for (int dir = 0; dir < 2; ++dir) { float s[4] = {0.f, 0.f, 0.f, 0.f};
            for (int p = 0; p < 64; ++p) { const f32x2 c = CC[(dir * 16 + np) * 64 + p], b = BB[(dir * 64 + p) * 16 + n];
                const float wr = c.x * b.x - c.y * b.y, wi = c.x * b.y + c.y * b.x;
#pragma unroll
                for (int j = 0; j < 4; ++j) { const f32x2 a = APOW[(dir * 64 + p) * 65 + dl0 + 2 * j]; s[j] += wr * a.x - wi * a.y; } }
#pragma unroll
            for (int j = 0; j < 4; ++j) TBG[((dir * 64 + dl0 + 2 * j) * 16 + np) * 16 + n] = s[j]; }
    }
    for (int i = tid; i < 32 * 128; i += NTHR) {
        const int j = 32 * part + (i >> 7), c8 = (i & 127) * 8, sI = c8 >> 4, n0 = c8 & 15, dir = j >> 7, pt = (j >> 6) & 1, p = j & 63, e = dir ? sI : 63 - sI;
        const f32x2 a = APOW[(dir * 64 + p) * 65 + e]; float v[8];
#pragma unroll
        for (int q = 0; q < 8; ++q) { const f32x2 b = BB[(dir * 64 + p) * 16 + n0 + q]; v[q] = pt ? (a.x * b.y + a.y * b.x) : (a.x * b.x - a.y * b.y); }
        v4u o; o.x = pk2(v[0], v[1]); o.y = pk2(v[2], v[3]); o.z = pk2(v[4], v[5]); o.w = pk2(v[6], v[7]);
        *(GAS v4u*)(M1T + (size_t)j * 1024 + c8) = o;
    }
}
__device__ __forceinline__ void s5_stage_b(Frame& F, int g, int part) {
    LAS f32x2* APOW = (LAS f32x2*)(F.lds); LAS f32x2* CC = (LAS f32x2*)(F.lds + 2 * 64 * 65 * 8) + 2 * 64 * 16;
    const float* TBG = (const float*)(F.ws + WS_ARENA + A_TBG) + (size_t)g * (2 * 64 * 256);
    bf16* K3T = (bf16*)(F.ws + WS_ARENA + A_K3T) + (size_t)g * 1024 * S5K;
#pragma unroll 4
    for (int i = F.tid; i < 128 * (S5K / 8); i += NTHR) {
        const int row = 128 * part + i / (S5K / 8), c8 = (i % (S5K / 8)) * 8, tau = row >> 4, np = row & 15; float v[8];
        if (c8 < 1024) { const int sI = c8 >> 4, n0 = c8 & 15;
            f32x4 f0 = {0.f, 0.f, 0.f, 0.f}, f1 = f0, b0 = f0, b1 = f0;
            if (sI <= tau) { const GAS f32x4* tb = (const GAS f32x4*)(TBG + ((0 * 64 + (tau - sI)) * 16 + np) * 16 + n0); f0 = tb[0]; f1 = tb[1]; }
            if (sI >= tau) { const GAS f32x4* tb = (const GAS f32x4*)(TBG + ((1 * 64 + (sI - tau)) * 16 + np) * 16 + n0); b0 = tb[0]; b1 = tb[1]; }
            f0 += b0; f1 += b1; v[0] = f0[0]; v[1] = f0[1]; v[2] = f0[2]; v[3] = f0[3]; v[4] = f1[0]; v[5] = f1[1]; v[6] = f1[2]; v[7] = f1[3];
        } else { const int j0 = c8 - 1024, dir = j0 >> 7, pt = (j0 >> 6) & 1, e = dir ? 64 - tau : tau + 1;
#pragma unroll
            for (int q = 0; q < 8; ++q) { const int p = (j0 & 63) + q; const f32x2 c = CC[(dir * 16 + np) * 64 + p], a = APOW[(dir * 64 + p) * 65 + e];
                v[q] = pt ? -(c.x * a.y + c.y * a.x) : (c.x * a.x - c.y * a.y); } }
        v4u o; o.x = pk2(v[0], v[1]); o.y = pk2(v[2], v[3]); o.z = pk2(v[4], v[5]); o.w = pk2(v[6], v[7]);
        *(GAS v4u*)(K3T + (size_t)row * S5K + c8) = o;
    }
}

__device__ __forceinline__ void mod_item(Frame& F, int item) {
    const int l = item >> 7, slab = item & 127, col0 = 96 * slab;
    const float* wm = inp(I_WMOD) + (size_t)l * 2048 * 12288; const float* bm = inp(I_BMOD) + (size_t)l * 12288;
    LAS float* sv = (LAS float*)F.lds;
    LAS float* part = sv + 4096;
    __syncthreads();
    { const float* pc = inp(I_C); const float* pcc = inp(I_CCTX); float xv[8];
#pragma unroll
      for (int q = 0; q < 4; ++q) { xv[q] = pc[F.tid + NTHR * q]; xv[4 + q] = pcc[F.tid + NTHR * q]; }
#pragma unroll
      for (int q = 0; q < 8; ++q) sv[F.tid + NTHR * q] = siluf_(xv[q]); }
    __syncthreads();
    const int sub = F.lane / 24, cl = F.lane % 24;
    f32x4 a0 = {0.f, 0.f, 0.f, 0.f}, a1 = {0.f, 0.f, 0.f, 0.f};
    if (sub < 2) {
        const float* wp = wm + (size_t)(256 * F.wave + sub) * 12288 + col0 + 4 * cl;
#pragma unroll 8
        for (int kk = 0; kk < 256; kk += 2) { const f32x4 w = *(const GAS f32x4*)(wp + (size_t)kk * 12288); const int k = 256 * F.wave + kk + sub;
            const float s0 = sv[k], s1 = sv[2048 + k]; a0 += w * s0; a1 += w * s1; }
        LAS float* pp = part + ((F.wave * 2 + sub) * 24 + cl) * 8;
        pp[0] = a0[0]; pp[1] = a0[1]; pp[2] = a0[2]; pp[3] = a0[3]; pp[4] = a1[0]; pp[5] = a1[1]; pp[6] = a1[2]; pp[7] = a1[3];
    }
    __syncthreads();
    if (F.tid < 192) { const int w = F.tid / 96, c = F.tid % 96; float s = 0.f;
        for (int q = 0; q < 16; ++q) s += part[(q * 24 + (c >> 2)) * 8 + w * 4 + (c & 3)];
        float* MODF = (float*)(F.ws + WS_MODF); MODF[(size_t)(l * 2 + w) * 12288 + col0 + c] = s + bm[col0 + c]; }
    __syncthreads();
}

constexpr int units_of(int K, int N) { return (K / 128) * ((N + 255) / 256); }
constexpr int CU_SQ = units_of(2048, 2048), CU_PW = units_of(384, 384), CU_GL = units_of(512, 512), CU_UP = units_of(2048, 7168), CU_DN = units_of(7168, 2048), CU_WO = units_of(2048, 4624);
constexpr int CQ_E0 = 0, CQ_E1 = CQ_E0 + CU_SQ  , CQ_E2 = CQ_E1 + 4 * CU_PW  , CQ_E3 = CQ_E2 + CU_GL  , CQ_E4 = CQ_E3 + CU_SQ  ,
              CQ_F1 = CQ_E4 + CU_UP  , CQ_F2 = CQ_F1 + CU_UP  , CQ_F3 = CQ_F2 + CU_DN  , CQ_O1 = CQ_F3 + CU_WO  , CQ_O2 = CQ_O1 + CU_SQ  ,
              CQ_M1 = CQ_O2 + 8 * CU_UP  , CQ_M2 = CQ_M1 + 8 * CU_UP  , CQ_M3 = CQ_M2 + 8 * CU_DN  , CQ_END = CQ_M3;
constexpr int CW_QUEUE = 2048;
struct ConvDesc { const float* W; unsigned char* WT; int N, ldt, kind, fp8, k0, n0, pitch, kbyte; float sc; };
__device__ __forceinline__ void conv_decode(Frame& F, int it, ConvDesc& d) {
    int r = it; d.kind = 0; d.fp8 = 0; d.sc = 1.f;
    if (r < CQ_E1) { d.W = inp(I_EWIN); d.WT = F.ws + WS_WINE; d.N = 2048; d.ldt = 2048; }
    else if (r < CQ_E2) { r -= CQ_E1; const int g4 = r / CU_PW; d.W = inp(I_EPOOLW) + (size_t)g4 * 384 * 384; d.WT = F.ws + WS_WPOOL + (size_t)g4 * 512 * 384 * 2; d.N = 384; d.ldt = 384; r -= g4 * CU_PW; }
    else if (r < CQ_E3) { d.W = inp(I_WGLU); d.WT = F.ws + WS_WGLU; d.N = 512; d.ldt = 512; r -= CQ_E2; }
    else if (r < CQ_E4) { d.W = inp(I_EWOUT); d.WT = F.ws + WS_WOUTE; d.N = 2048; d.ldt = 2048; r -= CQ_E3; }
    else if (r < CQ_F2) { const int up = r >= CQ_F1; d.W = inp(up ? I_FFU : I_FFG); d.WT = F.ws + WS_WGU; d.N = 7168; d.ldt = 2048; d.kind = 1 + up; r -= (up ? CQ_F1 : CQ_E4);
        if (FFN_FP8 == 1) { d.fp8 = 1; d.sc = MOE_WSC_GU; } }
    else if (r < CQ_F3) { d.W = inp(I_FFD); d.WT = F.ws + WS_WDN; d.N = 2048; d.ldt = 7168; r -= CQ_F2; if (FFN_FP8 != 0) { d.fp8 = 1; d.sc = MOE_WSC_DN; } }
    else if (r < CQ_O1) { d.W = inp(I_OWIN); d.WT = F.ws + WS_WINO; d.N = 4624; d.ldt = 2048; d.kind = 3; r -= CQ_F3; }
    else if (r < CQ_O2) { d.W = inp(I_OWOUT); d.WT = F.ws + WS_WOUTO; d.N = 2048; d.ldt = 2048; r -= CQ_O1; }
    else if (r < CQ_M2) { d.fp8 = 1; const int up = r >= CQ_M1; r -= up ? CQ_M1 : CQ_O2; const int e = r / CU_UP; d.W = inp(up ? I_MOEU : I_MOEG) + (size_t)e * 2048 * 7168; d.WT = F.ws + WS_WMGU + (size_t)e * 14336 * 2048;
        d.N = 7168; d.ldt = 2048; d.kind = 1 + up; d.sc = MOE_WSC_GU; r -= e * CU_UP; }
    else { d.fp8 = 1; r -= CQ_M2; const int e = r / CU_DN; d.W = inp(I_MOED) + (size_t)e * 7168 * 2048; d.WT = F.ws + WS_WMDN + (size_t)e * 2048 * 7168; d.N = 2048; d.ldt = 7168; d.sc = MOE_WSC_DN; r -= e * CU_DN; }
    const int nblk = (d.N + 255) / 256, kb = r / nblk; d.k0 = 128 * kb; d.n0 = 256 * (r - kb * nblk);
    d.pitch = d.fp8 ? d.ldt : 2 * d.ldt; d.kbyte = d.fp8 ? d.k0 : 2 * d.k0;
    if (FFN_FP8 == 2 && FFNU_K1 < 2048 && it >= CQ_E4 && it < CQ_F2) {
        d.pitch = 2 * FFNU_K1 + (2048 - FFNU_K1);
        if (d.k0 >= FFNU_K1) { d.fp8 = 1; d.sc = MOE_WSC_GU; d.kbyte = 2 * FFNU_K1 + (d.k0 - FFNU_K1); } }
}
__device__ __forceinline__ int conv_row(int kind, int n) {
    if (kind == 0) return n; if (kind == 3) return RmWinO{}(n); return (n >> 7) * 256 + (kind - 1) * 128 + (n & 127); }
__device__ __forceinline__ void conv_load(const ConvDesc& d, int wave, int lane, f32x4 (&v)[16]) {
    const bool okc = (d.n0 + 4 * lane) < d.N; const float* p = d.W + (size_t)(d.k0 + 16 * wave) * d.N + d.n0 + 4 * lane;
#pragma unroll
    for (int i = 0; i < 16; ++i) v[i] = okc ? __builtin_nontemporal_load((const GAS f32x4*)(p + (size_t)i * d.N)) : (f32x4){0.f, 0.f, 0.f, 0.f};
}
__device__ __forceinline__ void conv_to_lds(const f32x4 (&v)[16], LAS float* tile, int wave, int lane) {
#pragma unroll
    for (int i = 0; i < 16; ++i) *(LAS f32x4*)(tile + (16 * wave + i) * 256 + ((lane ^ ((2 * wave + (i >> 3)) & 7)) << 2)) = v[i];
}
__device__ __forceinline__ void conv_store(const ConvDesc& d, const LAS float* tile, int tid) {
    const int c = tid & 7;
    if (d.fp8) {
#pragma unroll
        for (int q = 0; q < 4; ++q) { const int nn = (tid >> 3) + 64 * q; float x[16];
#pragma unroll
            for (int j = 0; j < 16; ++j) { const int k = 16 * c + j; x[j] = tile[k * 256 + ((((nn >> 2) ^ ((k >> 3) & 7)) & 63) << 2) + (nn & 3)]; }
            if (d.n0 + nn < d.N) { const size_t row = (size_t)conv_row(d.kind, d.n0 + nn); v4u o;
                o.x = pk4_fp8(x[0] * d.sc, x[1] * d.sc, x[2] * d.sc, x[3] * d.sc); o.y = pk4_fp8(x[4] * d.sc, x[5] * d.sc, x[6] * d.sc, x[7] * d.sc);
                o.z = pk4_fp8(x[8] * d.sc, x[9] * d.sc, x[10] * d.sc, x[11] * d.sc); o.w = pk4_fp8(x[12] * d.sc, x[13] * d.sc, x[14] * d.sc, x[15] * d.sc);
                __builtin_nontemporal_store(o, (GAS v4u*)(d.WT + row * d.pitch + d.kbyte + 16 * c)); } }
    } else {
#pragma unroll
        for (int q = 0; q < 8; ++q) { const int kh = q & 1, nn = (tid >> 3) + 64 * (q >> 1); const LAS float* s = tile + (64 * kh + 8 * c) * 256 + (((nn >> 2) ^ c) << 2) + (nn & 3);
            float x[8];
#pragma unroll
            for (int j = 0; j < 8; ++j) x[j] = s[j * 256];
            if (d.n0 + nn < d.N) { const size_t row = (size_t)conv_row(d.kind, d.n0 + nn);
                v4u o; o.x = pk2(x[0], x[1]); o.y = pk2(x[2], x[3]); o.z = pk2(x[4], x[5]); o.w = pk2(x[6], x[7]);
                __builtin_nontemporal_store(o, (GAS v4u*)(d.WT + row * d.pitch + d.kbyte + (64 * kh + 8 * c) * 2)); } }
    }
}
constexpr int CQ_NONE = 0x7fffffff;
__device__ __forceinline__ int conv_pull(Frame& F) { return (int)__hip_atomic_fetch_add((unsigned*)(F.ctl + CW_QUEUE), 1u, RLX_AGENT); }
__device__ __forceinline__ void conv_work(Frame& F, int dlimit, int quota) {
    LAS float* tile = (LAS float*)(F.lds + RING_OFF);
    volatile LAS int* QW = (volatile LAS int*)(F.lds + LDSCTL_OFF);
    __syncthreads();
    if (F.tid == 0) { int c0 = CQ_NONE, c1 = CQ_NONE; const int head = (int)__hip_atomic_load((unsigned*)(F.ctl + CW_QUEUE), RLX_AGENT);
        if (head < CQ_END && (quota > 0 || head < dlimit)) { c0 = conv_pull(F); if (c0 < CQ_END && (quota > 1 || c0 < dlimit)) c1 = conv_pull(F); }
        QW[0] = c0; QW[1] = c1; }
    __syncthreads();
    int cur = __builtin_amdgcn_readfirstlane(QW[0]), nxt = __builtin_amdgcn_readfirstlane(QW[1]);
    int npull = (cur != CQ_NONE) + (nxt != CQ_NONE);
    __syncthreads();
    if (cur >= CQ_END) return;
    ConvDesc d; f32x4 v[16]; conv_decode(F, cur, d); conv_load(d, F.wave, F.lane, v);
    for (;;) {
        conv_to_lds(v, tile, F.wave, F.lane); LDS_WAIT(); __syncthreads();
        const bool more = nxt < CQ_END; ConvDesc dn = d;
        if (more) { conv_decode(F, nxt, dn); conv_load(dn, F.wave, F.lane, v); }
        const bool pull = more && (npull < quota || nxt < dlimit);
        conv_store(d, tile, F.tid);
        if (pull && F.tid == 0) QW[0] = conv_pull(F);
        LDS_WAIT(); __syncthreads();
        if (!more) break;
        cur = nxt; nxt = pull ? __builtin_amdgcn_readfirstlane(QW[0]) : CQ_NONE; npull += pull ? 1 : 0; d = dn;
    }
}
__device__ __forceinline__ int fill_quota(int nunits, int G, int c, int Q) { const int mine = nunits > c ? (nunits - 1 - c) / G + 1 : 0, most = (nunits + G - 1) / G; return mine < most ? Q : 0; }
__device__ __forceinline__ void p0_prologue(Frame& F) {
    const int gw = F.vcu * NWAVES + F.wave, NGW = F.G * NWAVES, gt = gw * 64 + F.lane, ngt = NGW * 64;
    if (blockIdx.x & 128) {
        for (int it = blockIdx.x; it < S5G * 8; it += F.G) { s5_small_tables(F, it >> 3); s5_stage_a(F, it >> 3, it & 7); }
        for (int it = blockIdx.x; it < 256; it += F.G) mod_item(F, it);
    } else {
        for (int it = blockIdx.x; it < 256; it += F.G) mod_item(F, it);
        for (int it = blockIdx.x; it < S5G * 8; it += F.G) { s5_small_tables(F, it >> 3); s5_stage_a(F, it >> 3, it & 7); }
    }
    { float* rp = (float*)(F.ws + WS_ROPE); for (int i = gt; i < 256 * 32; i += ngt) { const int pos = i >> 5, fi = i & 31; const float fr = powf(10000.f, -(float)fi / 32.f), ang = (float)pos * fr;
        rp[2 * i] = cosf(ang); rp[2 * i + 1] = sinf(ang); } }
    for (int g4 = 0; g4 < 4; ++g4) zero_rows((bf16*)(F.ws + WS_WPOOL) + ((size_t)g4 * 512 + 384) * 384, (size_t)128 * 384 * 2, gt, ngt);
    zero_rows((bf16*)(F.ws + WS_WINO) + (size_t)4624 * 2048, (size_t)(WINO_N - 4624) * 2048 * 2, gt, ngt);
    __syncthreads();
    conv_work(F, CQ_E4, 0);
    __syncthreads();
}

#define PV(k) ((LAS float*)(F.lds + (k) * 8192))
__device__ __forceinline__ void ld_row_f32(const float* p, int lane, f32x4 (&v)[8]) {
#pragma unroll
    for (int j = 0; j < 8; ++j) v[j] = *(const GAS f32x4*)(p + 4 * lane + 256 * j);
}
__device__ __forceinline__ void st_row_f32(float* p, int lane, const f32x4 (&v)[8]) {
#pragma unroll
    for (int j = 0; j < 8; ++j) *(GAS f32x4*)(p + 4 * lane + 256 * j) = v[j];
}
__device__ __forceinline__ void ld_row_bf16(const bf16* p, int lane, f32x4 (&v)[8]) {
#pragma unroll
    for (int j = 0; j < 8; ++j) { const v2u w = *(const GAS v2u*)(p + 4 * lane + 256 * j); v[j] = (f32x4){bflo(w.x), bfhi(w.x), bflo(w.y), bfhi(w.y)}; }
}
__device__ __forceinline__ void st_row_bf16(bf16* p, int lane, const f32x4 (&v)[8]) {
#pragma unroll
    for (int j = 0; j < 8; ++j) { v2u w; w.x = pk2(v[j][0], v[j][1]); w.y = pk2(v[j][2], v[j][3]); *(GAS v2u*)(p + 4 * lane + 256 * j) = w; }
}
__device__ __forceinline__ float row_sumsq(const f32x4 (&v)[8]) {
    float s = 0.f;
#pragma unroll
    for (int j = 0; j < 8; ++j) s += (v[j][0] * v[j][0] + v[j][1] * v[j][1]) + (v[j][2] * v[j][2] + v[j][3] * v[j][3]);
    return wave_sum(s);
}
__device__ __forceinline__ f32x4 ldp(const LAS float* p, int lane, int j) { return *(const LAS f32x4*)(p + 4 * lane + 256 * j); }
__device__ __forceinline__ const float* modp(Frame& F, int layer, int w, int k) { return (const float*)(F.ws + WS_MODF) + (size_t)(layer * 2 + w) * 12288 + k * 2048; }
__device__ __forceinline__ const float* h0_row(Frame& F, int m) { return m < CTX ? inp(I_CTX) + (size_t)m * D : inp(I_X) + (size_t)(m - CTX) * D; }

__device__ __forceinline__ void ph_norm0(Frame& F) {
    __syncthreads();
    for (int i = F.tid; i < 2 * 2048; i += NTHR) { const int w = i >> 11, c = i & 2047;
        PV(2 * w)[c] = inp(I_NORMS)[0 * 2048 + c] * (1.f + modp(F, 0, w, 1)[c]); PV(2 * w + 1)[c] = modp(F, 0, w, 0)[c]; }
    __syncthreads();
    bf16* U = (bf16*)(F.ws + WS_ARENA + A_U);
    const int gw = F.vcu * NWAVES + F.wave, NGW = F.G * NWAVES;
    for (int m = gw; m < T; m += NGW) { const int w = m < CTX ? 1 : 0; f32x4 v[8]; ld_row_f32(h0_row(F, m), F.lane, v);
        const float rstd = 1.f / sqrtf(row_sumsq(v) * (1.f / D) + EPS);
#pragma unroll
        for (int j = 0; j < 8; ++j) v[j] = v[j] * rstd * ldp(PV(2 * w), F.lane, j) + ldp(PV(2 * w + 1), F.lane, j);
        st_row_bf16(U + (size_t)m * D, F.lane, v); }
}
__device__ __forceinline__ void ph_norm1(Frame& F) {
    __syncthreads();
    for (int i = F.tid; i < 2 * 2048; i += NTHR) { const int w = i >> 11, c = i & 2047;
        PV(3 * w)[c] = modp(F, 0, w, 2)[c] * inp(I_NORMS)[1 * 2048 + c]; PV(3 * w + 1)[c] = inp(I_NORMS)[2 * 2048 + c] * (1.f + modp(F, 0, w, 4)[c]); PV(3 * w + 2)[c] = modp(F, 0, w, 3)[c]; }
    __syncthreads();
    const bf16* YO = (const bf16*)(F.ws + WS_ARENA + A_YO); bf16* V = (bf16*)(F.ws + WS_ARENA + A_V); bf16* HR = (bf16*)(F.ws + WS_HRES);
    const int gw = F.vcu * NWAVES + F.wave, NGW = F.G * NWAVES;
    for (int m = gw; m < T; m += NGW) { const int w = m < CTX ? 1 : 0; f32x4 y[8], h[8]; ld_row_bf16(YO + (size_t)m * D, F.lane, y); ld_row_f32(h0_row(F, m), F.lane, h);
        const float ry = 1.f / sqrtf(row_sumsq(y) * (1.f / D) + EPS);
#pragma unroll
        for (int j = 0; j < 8; ++j) h[j] = h[j] + y[j] * ry * ldp(PV(3 * w), F.lane, j);
        st_row_bf16(HR + (size_t)m * D, F.lane, h);
        const float rh = 1.f / sqrtf(row_sumsq(h) * (1.f / D) + EPS);
#pragma unroll
        for (int j = 0; j < 8; ++j) y[j] = h[j] * rh * ldp(PV(3 * w + 1), F.lane, j) + ldp(PV(3 * w + 2), F.lane, j);
#if FFN_FP8 == 1
        { unsigned char* V8 = (unsigned char*)V + (size_t)m * D;
#pragma unroll
          for (int j = 0; j < 8; ++j) *(GAS unsigned*)(V8 + 4 * F.lane + 256 * j) = pk4_fp8(y[j][0], y[j][1], y[j][2], y[j][3]); }
#elif FFN_FP8 == 2 && FFNU_K1 < 2048
        { unsigned char* Vr = (unsigned char*)V + (size_t)m * (2 * FFNU_K1 + (2048 - FFNU_K1));
#pragma unroll
          for (int j = 0; j < 8; ++j) { const int col = 4 * F.lane + 256 * j;
              if (256 * j < FFNU_K1) { v2u w; w.x = pk2(y[j][0], y[j][1]); w.y = pk2(y[j][2], y[j][3]); *(GAS v2u*)(Vr + 2 * col) = w; }
              else *(GAS unsigned*)(Vr + 2 * FFNU_K1 + (col - FFNU_K1)) = pk4_fp8(y[j][0], y[j][1], y[j][2], y[j][3]); } }
#else
        st_row_bf16(V + (size_t)m * D, F.lane, y);
#endif
    }
}
__device__ __forceinline__ void ph_norm2(Frame& F) {
    __syncthreads();
    for (int i = F.tid; i < 2 * 2048; i += NTHR) { const int w = i >> 11, c = i & 2047;
        PV(3 * w)[c] = modp(F, 0, w, 5)[c] * inp(I_NORMS)[3 * 2048 + c]; PV(3 * w + 1)[c] = inp(I_NORMS)[(4 + 0) * 2048 + c] * (1.f + modp(F, 1, w, 1)[c]); PV(3 * w + 2)[c] = modp(F, 1, w, 0)[c]; }
    __syncthreads();
    const bf16* FB = (const bf16*)(F.ws + WS_ARENA + A_F); bf16* U = (bf16*)(F.ws + WS_ARENA + A_U); bf16* HR = (bf16*)(F.ws + WS_HRES);
    const int gw = F.vcu * NWAVES + F.wave, NGW = F.G * NWAVES;
    for (int m = gw; m < T; m += NGW) { const int w = m < CTX ? 1 : 0; f32x4 y[8], h[8]; ld_row_bf16(FB + (size_t)m * D, F.lane, y); ld_row_bf16(HR + (size_t)m * D, F.lane, h);
        const float ry = 1.f / sqrtf(row_sumsq(y) * (1.f / D) + EPS);
#pragma unroll
        for (int j = 0; j < 8; ++j) h[j] = h[j] + y[j] * ry * ldp(PV(3 * w), F.lane, j);
        st_row_bf16(HR + (size_t)m * D, F.lane, h);
        const float rh = 1.f / sqrtf(row_sumsq(h) * (1.f / D) + EPS);
#pragma unroll
        for (int j = 0; j < 8; ++j) y[j] = h[j] * rh * ldp(PV(3 * w + 1), F.lane, j) + ldp(PV(3 * w + 2), F.lane, j);
        st_row_bf16(U + (size_t)m * D, F.lane, y); }
}
__device__ __forceinline__ void ph_emit(Frame& F, float* out) {
    const bf16* HR = (const bf16*)(F.ws + WS_HRES) + (size_t)CTX * D;
    for (size_t i = (size_t)blockIdx.x * NTHR + F.tid; i < (size_t)SEQ * D / 4; i += (size_t)F.G * NTHR) { const v2u w = ((const GAS v2u*)HR)[i]; ((GAS f32x4*)out)[i] = (f32x4){bflo(w.x), bfhi(w.x), bflo(w.y), bfhi(w.y)}; }
}

template <int W> __device__ __forceinline__ void pooldiff_group(Frame& F, int gi) {
    const bf16* ZP = (const bf16*)(F.ws + WS_ARENA + A_ZP); bf16* DP = (bf16*)(F.ws + WS_ARENA + A_DP);
    constexpr int OG = PG / 8;
    const int nitem = T * OG;
    for (int it = F.vcu * NTHR + F.tid; it < nitem; it += F.G * NTHR) {
        const int t = it / OG, c8 = gi * PG + (it - t * OG) * 8;
        const int s0 = t < CTX ? 0 : CTX, L = t < CTX ? CTX : SEQ, tp = t - s0;
        int lo = tp - W / 2; lo = lo < 0 ? 0 : lo; int hi = tp + (W - W / 2); hi = hi > L ? L : hi;
        v4u x[W];
#pragma unroll
        for (int i = 0; i < W; ++i) { int r = tp - W / 2 + i; r = (r >= 0 && r < L) ? r : tp; x[i] = *(const GAS v4u*)(ZP + (size_t)(s0 + r) * WPOOL + c8); }
        float s[8];
#pragma unroll
        for (int q = 0; q < 8; ++q) s[q] = 0.f;
#pragma unroll
        for (int i = 0; i < W; ++i) { const int r = tp - W / 2 + i; if (r >= 0 && r < L) {
            s[0] += bflo(x[i].x); s[1] += bfhi(x[i].x); s[2] += bflo(x[i].y); s[3] += bfhi(x[i].y); s[4] += bflo(x[i].z); s[5] += bfhi(x[i].z); s[6] += bflo(x[i].w); s[7] += bfhi(x[i].w); } }
        const float inv = 1.f / (float)(hi - lo); const v4u z = x[W / 2];
        v4u o; o.x = pk2(s[0] * inv - bflo(z.x), s[1] * inv - bfhi(z.x)); o.y = pk2(s[2] * inv - bflo(z.y), s[3] * inv - bfhi(z.y));
        o.z = pk2(s[4] * inv - bflo(z.z), s[5] * inv - bfhi(z.z)); o.w = pk2(s[6] * inv - bflo(z.w), s[7] * inv - bfhi(z.w));
        *(GAS v4u*)(DP + (size_t)t * WPOOL + c8) = o;
    }
}
__device__ __forceinline__ void ph_pooldiff(Frame& F) { pooldiff_group<16>(F, 3); pooldiff_group<8>(F, 2); pooldiff_group<4>(F, 1); pooldiff_group<2>(F, 0); }

__device__ __forceinline__ void ph_s5scan(Frame& F) {
    const int gth = blockIdx.x * NTHR + F.tid; if (gth >= S5G * 2 * 64) return;
    const int g = gth >> 7, dir = (gth >> 6) & 1, p = gth & 63, gi = dir * S5G + g;
    const double dt = exp((double)inp(I_LOGDT)[gi]), lr = (double)inp(I_LAMRE)[gi * 64 + p], li = (double)inp(I_LAMIM)[gi * 64 + p];
    const float aLr = (float)(exp(lr * dt * LC) * cos(li * dt * LC)), aLi = (float)(exp(lr * dt * LC) * sin(li * dt * LC));
    const float* SL = (const float*)(F.ws + WS_ARENA + A_SLOC) + (size_t)g * S5ROWS * 256 + dir * 128 + p;
    bf16* CA = (bf16*)(F.ws + WS_ARENA + A_AS5) + (size_t)g * S5ROWS * S5K + 1024 + dir * 128 + p;
    float er = 0.f, ei = 0.f;
    for (int i0 = 0; i0 < NCH; i0 += 4) {
        int cc[4]; float sr[4], si[4];
#pragma unroll
        for (int q = 0; q < 4; ++q) { const int i = i0 + q; cc[q] = dir == 0 ? i : (i < NCH_CTX ? NCH_CTX - 1 - i : NCH - 1 - (i - NCH_CTX));
            sr[q] = SL[(size_t)cc[q] * 256]; si[q] = SL[(size_t)cc[q] * 256 + 64]; }
#pragma unroll
        for (int q = 0; q < 4; ++q) { CA[(size_t)cc[q] * S5K] = (bf16)f2bf(er); CA[(size_t)cc[q] * S5K + 64] = (bf16)f2bf(ei);
            const float nr = aLr * er - aLi * ei + sr[q], ni = aLr * ei + aLi * er + si[q]; er = nr; ei = ni; }
    }
}

typedef unsigned u32x4 __attribute__((ext_vector_type(4)));
using pg8::Unit; using pg8::pack8;
typedef const pg8::f32x4 (&AccRef)[2][2][4][2];
#define EPI_ROWS(u) const int row0 = (u).pm * 256 + wr * 64 + fr
struct EpiPlain { static constexpr bool PERM = true; bf16* O; int ldc;
    __device__ __forceinline__ void operator()(AccRef acc, const Unit& u, int wr, int wc, int fr, int fq) const { EPI_ROWS(u); const int col0 = u.pn * 256 + wc * 32 + 8 * fq;
#pragma unroll
        for (int ai = 0; ai < 2; ++ai)
#pragma unroll
            for (int m = 0; m < 4; ++m) { bf16* rp = O + (size_t)(row0 + ai * 128 + m * 16) * ldc + col0;
#pragma unroll
                for (int bj = 0; bj < 2; ++bj) *(GAS u32x4*)(rp + bj * 128) = pack8(acc[ai][bj][m][0], acc[ai][bj][m][1]); } } };
struct EpiWinE { static constexpr bool PERM = true; bf16* ZP; bf16* AS5;
    __device__ __forceinline__ void operator()(AccRef acc, const Unit& u, int wr, int wc, int fr, int fq) const { EPI_ROWS(u); const int col0 = u.pn * 256 + wc * 32 + 8 * fq;
#pragma unroll
        for (int ai = 0; ai < 2; ++ai)
#pragma unroll
            for (int m = 0; m < 4; ++m) { const int row = row0 + ai * 128 + m * 16;
#pragma unroll
                for (int bj = 0; bj < 2; ++bj) { const int col = col0 + bj * 128; const u32x4 w = pack8(acc[ai][bj][m][0], acc[ai][bj][m][1]);
                    if (u.pn < 6) *(GAS u32x4*)(ZP + (size_t)row * WPOOL + col) = w;
                    else { const int cc = col - WPOOL, g = cc >> 4, n0 = cc & 15, c = row >> 6, s = row & 63; *(GAS u32x4*)(AS5 + ((size_t)(g * S5ROWS + c) * S5K + s * 16 + n0)) = w; } } } } };
struct EpiPool { static constexpr bool PERM = true; bf16* YMIX; const float* scale;
    __device__ __forceinline__ void operator()(AccRef acc, const Unit& u, int wr, int wc, int fr, int fq) const { EPI_ROWS(u); const int lc0 = u.pn * 256 + wc * 32 + 8 * fq;
#pragma unroll
        for (int bj = 0; bj < 2; ++bj) { const int lc = lc0 + bj * 128; if (lc >= PG) continue; const int gc = u.bz * PG + lc;
            const f32x4 s0 = *(const GAS f32x4*)(scale + gc), s1 = *(const GAS f32x4*)(scale + gc + 4);
#pragma unroll
            for (int ai = 0; ai < 2; ++ai)
#pragma unroll
                for (int m = 0; m < 4; ++m) { const int row = row0 + ai * 128 + m * 16; *(GAS u32x4*)(YMIX + (size_t)row * D + gc) = pack8(acc[ai][bj][m][0] * s0, acc[ai][bj][m][1] * s1); } } } };
struct EpiSloc { static constexpr bool PERM = false; float* SL;
    __device__ __forceinline__ void operator()(AccRef acc, const Unit& u, int wr, int wc, int fr, int fq) const { EPI_ROWS(u); const int col0 = u.pn * 256 + wc * 32 + 4 * fq;
#pragma unroll
        for (int ai = 0; ai < 2; ++ai)
#pragma unroll
            for (int m = 0; m < 4; ++m) { float* rp = SL + ((size_t)u.bz * S5ROWS + row0 + ai * 128 + m * 16) * 256 + col0;
#pragma unroll
                for (int bj = 0; bj < 2; ++bj)
#pragma unroll
                    for (int n = 0; n < 2; ++n) *(GAS f32x4*)(rp + bj * 128 + n * 16) = acc[ai][bj][m][n]; } } };
struct EpiS5Y { static constexpr bool PERM = true; const bf16* AS5; const float* dsk; bf16* YG;
    __device__ __forceinline__ void operator()(AccRef acc, const Unit& u, int wr, int wc, int fr, int fq) const { EPI_ROWS(u); const int col0 = u.pn * 256 + wc * 32 + 8 * fq;
#pragma unroll
        for (int bj = 0; bj < 2; ++bj) { const int col = col0 + bj * 128, tau = col >> 4, n0 = col & 15;
            const f32x4 d0 = *(const GAS f32x4*)(dsk + u.bz * 16 + n0), d1 = *(const GAS f32x4*)(dsk + u.bz * 16 + n0 + 4);
#pragma unroll
            for (int ai = 0; ai < 2; ++ai)
#pragma unroll
                for (int m = 0; m < 4; ++m) { const int c = row0 + ai * 128 + m * 16; if (c >= NCH) continue;
                    const v4u x = *(const GAS v4u*)(AS5 + ((size_t)(u.bz * S5ROWS + c) * S5K + col));
                    f32x4 a = acc[ai][bj][m][0], b = acc[ai][bj][m][1];
                    a[0] = gelu_tanh(a[0] + bflo(x.x) * d0[0]); a[1] = gelu_tanh(a[1] + bfhi(x.x) * d0[1]); a[2] = gelu_tanh(a[2] + bflo(x.y) * d0[2]); a[3] = gelu_tanh(a[3] + bfhi(x.y) * d0[3]);
                    b[0] = gelu_tanh(b[0] + bflo(x.z) * d1[0]); b[1] = gelu_tanh(b[1] + bfhi(x.z) * d1[1]); b[2] = gelu_tanh(b[2] + bflo(x.w) * d1[2]); b[3] = gelu_tanh(b[3] + bfhi(x.w) * d1[3]);
                    *(GAS u32x4*)(YG + ((size_t)(c * 64 + tau) * WS5 + u.bz * 16 + n0)) = pack8(a, b); } } } };
struct EpiGlu { static constexpr bool PERM = true; const bf16* YG; bf16* YMIX;
    __device__ __forceinline__ void operator()(AccRef acc, const Unit& u, int wr, int wc, int fr, int fq) const { EPI_ROWS(u); const int col0 = u.pn * 256 + wc * 32 + 8 * fq;
#pragma unroll
        for (int ai = 0; ai < 2; ++ai)
#pragma unroll
            for (int m = 0; m < 4; ++m) { const int row = row0 + ai * 128 + m * 16;
#pragma unroll
                for (int bj = 0; bj < 2; ++bj) { const int col = col0 + bj * 128; const v4u x = *(const GAS v4u*)(YG + (size_t)row * WS5 + col);
                    f32x4 a = acc[ai][bj][m][0], b = acc[ai][bj][m][1];
                    a[0] = bflo(x.x) * sigmoidf_(a[0]); a[1] = bfhi(x.x) * sigmoidf_(a[1]); a[2] = bflo(x.y) * sigmoidf_(a[2]); a[3] = bfhi(x.y) * sigmoidf_(a[3]);
                    b[0] = bflo(x.z) * sigmoidf_(b[0]); b[1] = bfhi(x.z) * sigmoidf_(b[1]); b[2] = bflo(x.w) * sigmoidf_(b[2]); b[3] = bfhi(x.w) * sigmoidf_(b[3]);
                    *(GAS u32x4*)(YMIX + (size_t)row * D + WPOOL + col) = pack8(a, b); } } } };
struct EpiGateUp { static constexpr bool PERM = true; bf16* HID; int ldc;
    __device__ __forceinline__ void operator()(AccRef acc, const Unit& u, int wr, int wc, int fr, int fq) const { EPI_ROWS(u); const int col0 = u.pn * 128 + wc * 32 + 8 * fq;
#pragma unroll
        for (int ai = 0; ai < 2; ++ai)
#pragma unroll
            for (int m = 0; m < 4; ++m) { const int row = row0 + ai * 128 + m * 16; f32x4 a, b;
#pragma unroll
                for (int q = 0; q < 4; ++q) { a[q] = swiglu_fast(acc[ai][0][m][0][q], acc[ai][1][m][0][q], -1.4426950408889634f, 1.f); b[q] = swiglu_fast(acc[ai][0][m][1][q], acc[ai][1][m][1][q], -1.4426950408889634f, 1.f); }
                *(GAS u32x4*)(HID + (size_t)row * ldc + col0) = pack8(a, b); } } };

struct EpiWinO { static constexpr bool PERM = true; unsigned char* ar;
    __device__ __forceinline__ void operator()(AccRef acc, const Unit& u, int wr, int wc, int fr, int fq) const { EPI_ROWS(u); const int pn = u.pn;
        if (pn == 18) { if (wc == 0 && fq < 2) { float* ALR = (float*)(ar + B_ALR);
#pragma unroll
                for (int ai = 0; ai < 2; ++ai)
#pragma unroll
                    for (int m = 0; m < 4; ++m) { float* rp = ALR + (size_t)(row0 + ai * 128 + m * 16) * 16 + 8 * fq; *(GAS f32x4*)rp = acc[ai][0][m][0]; *(GAS f32x4*)(rp + 4) = acc[ai][0][m][1]; } }
            return; }
        bf16* base; int ld, c0;
        if (pn < 2) { base = (bf16*)(ar + B_GQ); ld = 512; c0 = pn * 256; } else if (pn < 4) { base = (bf16*)(ar + B_GK); ld = 512; c0 = (pn - 2) * 256; }
        else if (pn < 8) { base = (bf16*)(ar + B_GV); ld = 1024; c0 = (pn - 4) * 256; } else if (pn < 12) { base = (bf16*)(ar + B_R); ld = 1024; c0 = (pn - 8) * 256; }
        else if (pn < 16) { base = (bf16*)(ar + B_AQ); ld = 1024; c0 = (pn - 12) * 256; } else if (pn == 16) { base = (bf16*)(ar + B_AK); ld = 256; c0 = 0; } else { base = (bf16*)(ar + B_AV); ld = 256; c0 = 0; }
        const int col0 = c0 + wc * 32 + 8 * fq;
#pragma unroll
        for (int ai = 0; ai < 2; ++ai)
#pragma unroll
            for (int m = 0; m < 4; ++m) { bf16* rp = base + (size_t)(row0 + ai * 128 + m * 16) * ld + col0;
#pragma unroll
                for (int bj = 0; bj < 2; ++bj) *(GAS u32x4*)(rp + bj * 128) = pack8(acc[ai][bj][m][0], acc[ai][bj][m][1]); } } };

__device__ __forceinline__ void ph_qknorm(Frame& F) {
    unsigned char* ar = F.ws + WS_ARENA; bf16* AQ = (bf16*)(ar + B_AQ); bf16* AK = (bf16*)(ar + B_AK);
    const float* qn = inp(I_QNORM); const float* kn = inp(I_KNORM); const f32x2* rope = (const f32x2*)(F.ws + WS_ROPE);
    const size_t NQ = (size_t)SEQ * 8 * 8, NK = (size_t)T * 2 * 8;
    for (size_t it = (size_t)F.vcu * NTHR + F.tid; it < NQ + NK; it += (size_t)F.G * NTHR) {
        const bool isq = it < NQ; const size_t r = isq ? it : it - NQ; const int j = (int)(r & 7), hf = j >> 2, sub = j & 3;
        int row, head; bf16* p; const float* nw;
        if (isq) { head = (int)((r >> 3) & 7); row = CTX + (int)(r >> 6); p = AQ + (size_t)row * 1024 + head * 128; nw = qn; }
        else { head = (int)((r >> 3) & 1); row = (int)(r >> 4); p = AK + (size_t)row * 256 + head * 128; nw = kn; }
        const int d1 = 64 * hf + 8 * sub, d2 = d1 + 32;
        const v4u a = *(const GAS v4u*)(p + d1), b = *(const GAS v4u*)(p + d2);
        float x1[8] = {bflo(a.x), bfhi(a.x), bflo(a.y), bfhi(a.y), bflo(a.z), bfhi(a.z), bflo(a.w), bfhi(a.w)};
        float x2[8] = {bflo(b.x), bfhi(b.x), bflo(b.y), bfhi(b.y), bflo(b.z), bfhi(b.z), bflo(b.w), bfhi(b.w)};
        float ss = 0.f;
#pragma unroll
        for (int e = 0; e < 8; ++e) ss += x1[e] * x1[e] + x2[e] * x2[e];
        ss += __shfl_xor(ss, 1); ss += __shfl_xor(ss, 2); ss += __shfl_xor(ss, 4);
        const float rstd = 1.f / sqrtf(ss * (1.f / 128.f) + EPS);
        const bool rot = row >= CTX; const int tl = row - CTX, pos = hf ? (tl & 63) : (tl >> 6);
        float o1[8], o2[8];
#pragma unroll
        for (int e = 0; e < 8; ++e) { const float y1 = x1[e] * rstd * nw[d1 + e], y2 = x2[e] * rstd * nw[d2 + e];
            f32x2 cs = {1.f, 0.f}; if (rot) cs = rope[pos * 32 + 8 * sub + e];
            o1[e] = y1 * cs.x - y2 * cs.y; o2[e] = y1 * cs.y + y2 * cs.x; }
        v4u w1, w2; w1.x = pk2(o1[0], o1[1]); w1.y = pk2(o1[2], o1[3]); w1.z = pk2(o1[4], o1[5]); w1.w = pk2(o1[6], o1[7]);
        w2.x = pk2(o2[0], o2[1]); w2.y = pk2(o2[2], o2[3]); w2.z = pk2(o2[4], o2[5]); w2.w = pk2(o2[6], o2[7]);
        *(GAS v4u*)(p + d1) = w1; *(GAS v4u*)(p + d2) = w2;
        if (!isq) {
            unsigned char* k8 = ar + B_KDT + (size_t)row * 256 + head * 128 + 64 * (sub & 1) + 8 * (4 * hf + (sub >> 1));
            v2u a8, b8; a8.x = pk4_fp8(o1[0], o1[1], o1[2], o1[3]); a8.y = pk4_fp8(o1[4], o1[5], o1[6], o1[7]); b8.x = pk4_fp8(o2[0], o2[1], o2[2], o2[3]); b8.y = pk4_fp8(o2[4], o2[5], o2[6], o2[7]);
            *(GAS v2u*)k8 = a8; *(GAS v2u*)(k8 + 16) = b8; }
    }
}

constexpr size_t VT8_OFF = 8 * MiB;
__device__ __forceinline__ void ph_vt8(Frame& F) {
    unsigned char* ar = F.ws + WS_ARENA; const bf16* AV = (const bf16*)(ar + B_AV); unsigned char* VT8 = ar + B_KDT + VT8_OFF;
    const int ntask = 2 * NCH * 128 * 4;
    for (int it = F.vcu * NTHR + F.tid; it < ntask; it += F.G * NTHR) {
        const int g = it & 3, d = (it >> 2) & 127, tl = (it >> 9) % NCH, kvh = (it >> 9) / NCH, hi = g >> 1, blk = g & 1;
        float x[16];
#pragma unroll
        for (int r = 0; r < 16; ++r) { const int key = 32 * blk + (r & 3) + 8 * (r >> 2) + 4 * hi; x[r] = bf2f(AV[(size_t)(tl * 64 + key) * 256 + kvh * 128 + d]); }
        v4u o; o.x = pk4_fp8(x[0], x[1], x[2], x[3]); o.y = pk4_fp8(x[4], x[5], x[6], x[7]); o.z = pk4_fp8(x[8], x[9], x[10], x[11]); o.w = pk4_fp8(x[12], x[13], x[14], x[15]);
        *(GAS v4u*)(VT8 + ((size_t)(kvh * NCH + tl) * 128 + d) * 64 + g * 16) = o;
    }
}

namespace tri {
using s16x4 = __attribute__((ext_vector_type(4))) short;
__device__ __forceinline__ int st(int k, int c) { const int kk = (k & ~0xC) | ((k & 4) << 1) | ((k & 8) >> 1); return ((kk >> 3) * 4 + (c >> 5)) * 512 + ((kk & 7) * 32 + (c & 31)) * 2; }
__device__ __forceinline__ int rd_base(int lane) { return ((lane & 3) << 3) | (((lane >> 2) & 3) << 6) | (((lane >> 4) & 1) << 5) | (((lane >> 5) & 1) << 8); }
constexpr int rd_off(int d0, int ks, int half) { return d0 * 512 + ks * 4096 + half * 2048; }
template <int OFF> __device__ __forceinline__ s16x4 tr_read(int vb) { s16x4 r; asm volatile("ds_read_b64_tr_b16 %0, %1 offset:%2" : "=&v"(r) : "v"(vb), "i"(OFF) : "memory"); return r; }
struct Frag2 { s16x4 lo, hi; };
template <int D0, int KS> __device__ __forceinline__ Frag2 ld(int vb) { Frag2 f; f.lo = tr_read<rd_off(D0, KS, 0)>(vb); f.hi = tr_read<rd_off(D0, KS, 1)>(vb); return f; }
__device__ __forceinline__ bf16x8 pk(const Frag2& f) { return (bf16x8){f.lo[0], f.lo[1], f.lo[2], f.lo[3], f.hi[0], f.hi[1], f.hi[2], f.hi[3]}; }
#define TRI_WAIT() do { asm volatile("s_waitcnt lgkmcnt(0)" ::: "memory"); __builtin_amdgcn_sched_barrier(0); } while (0)
}
typedef float f32x16 __attribute__((ext_vector_type(16)));
__device__ __forceinline__ int crow(int r, int hi) { return (r & 3) + 8 * (r >> 2) + 4 * hi; }

__device__ __forceinline__ float logsigmoidf_(float z) { return fminf(z, 0.f) - __logf(1.f + __expf(-fabsf(z))); }
__device__ __forceinline__ void gla_prepkv_unit(Frame& F, int c, int h) {
    unsigned char* ar = F.ws + WS_ARENA;
    const bf16* GQ = (const bf16*)(ar + B_GQ); const bf16* GK = (const bf16*)(ar + B_GK); const bf16* GV = (const bf16*)(ar + B_GV); const float* ALR = (const float*)(ar + B_ALR);
    LAS float* ALR_S = (LAS float*)(F.lds);
    LAS float* WA_S = (LAS float*)(F.lds + 4096);
    LAS float* BA_S = (LAS float*)(F.lds + 12288);
    LAS float* SEG_S = (LAS float*)(F.lds + 12800);
    LAS float* GB = (LAS float*)(F.lds + 14848);
    LAS unsigned char* QS = F.lds + 47616;
    LAS unsigned char* KS = F.lds + 64000;
    LAS unsigned char* VIMG = F.lds + 80384;
    LAS unsigned char* KIMG = F.lds + 113152;
    const int tid = F.tid, lane = F.lane, t0 = c * 64;
    __syncthreads();
    for (int i = tid; i < 1024; i += NTHR) ALR_S[i] = ALR[(size_t)t0 * 16 + i];
    for (int i = tid; i < 1024; i += NTHR) { const int r = i >> 4, k8 = (i & 15) * 8;
        *(LAS v4u*)(QS + (r * 128 + k8) * 2) = *(const GAS v4u*)(GQ + (size_t)(t0 + r) * 512 + h * 128 + k8); *(LAS v4u*)(KS + (r * 128 + k8) * 2) = *(const GAS v4u*)(GK + (size_t)(t0 + r) * 512 + h * 128 + k8); }
    for (int i = tid; i < 2048; i += NTHR) { const int r = i >> 5, v8 = (i & 31) * 8;
        *(LAS v4u*)(VIMG + (v8 >> 7) * 16384 + tri::st(r, v8 & 127)) = *(const GAS v4u*)(GV + (size_t)(t0 + r) * 1024 + h * 256 + v8); }
    for (int d = 0; d < 2; ++d) {
        const float* wa = inp(I_GLAWA) + (size_t)d * 16 * 512 + h * 128; const float* ba = inp(I_GLABA) + d * 512 + h * 128;
        __syncthreads();
        for (int i = tid; i < 2048; i += NTHR) WA_S[i] = wa[(size_t)(i >> 7) * 512 + (i & 127)];
        if (tid < 128) BA_S[tid] = ba[tid];
        __syncthreads();
        const int k = tid & 127, seg = tid >> 7;
        float gl[16];
        { float w[16];
#pragma unroll
          for (int r = 0; r < 16; ++r) w[r] = WA_S[r * 128 + k];
          const float b0 = BA_S[k];
#pragma unroll
          for (int ii = 0; ii < 16; ++ii) { const int i = seg * 16 + ii; float z = b0;
#pragma unroll
              for (int r = 0; r < 16; ++r) z += ALR_S[i * 16 + r] * w[r];
              gl[ii] = logsigmoidf_(z) * (1.f / 16.f); } }
        if (d == 0) {
#pragma unroll
            for (int ii = 1; ii < 16; ++ii) gl[ii] += gl[ii - 1];
            SEG_S[seg * 128 + k] = gl[15]; }
        else {
#pragma unroll
            for (int ii = 14; ii >= 0; --ii) gl[ii] += gl[ii + 1];
            SEG_S[seg * 128 + k] = gl[0]; }
        __syncthreads();
        const float s0 = SEG_S[k], s1 = SEG_S[128 + k], s2 = SEG_S[256 + k], s3 = SEG_S[384 + k], tot = (s0 + s1) + (s2 + s3);
        float off;
        if (d == 0) off = seg == 0 ? 0.f : (seg == 1 ? s0 : (seg == 2 ? s0 + s1 : s0 + s1 + s2));
        else off = seg == 3 ? 0.f : (seg == 2 ? s3 : (seg == 1 ? s3 + s2 : s3 + s2 + s1));
#pragma unroll
        for (int ii = 0; ii < 16; ++ii) GB[(seg * 16 + ii) * 128 + k] = gl[ii] + off;
        if (seg == 0) ((float*)(ar + B_DEC))[((size_t)(d * NCH + c) * 4 + h) * 128 + k] = __expf(tot);
        __syncthreads();
        { bf16* QE = (bf16*)(ar + B_QE) + (size_t)d * T * 512; bf16* KE = (bf16*)(ar + B_KE) + (size_t)d * T * 512;
          for (int i2 = tid; i2 < 1024; i2 += NTHR) { const int i = i2 >> 4, k8 = (i2 & 15) * 8; const v4u qw = *(const LAS v4u*)(QS + (i * 128 + k8) * 2), kw = *(const LAS v4u*)(KS + (i * 128 + k8) * 2);
              const f32x4 ba0 = *(const LAS f32x4*)(GB + i * 128 + k8), ba1 = *(const LAS f32x4*)(GB + i * 128 + k8 + 4);
              const f32x4 t0v = *(const LAS f32x4*)(SEG_S + k8), t1v = *(const LAS f32x4*)(SEG_S + 128 + k8), t2v = *(const LAS f32x4*)(SEG_S + 256 + k8), t3v = *(const LAS f32x4*)(SEG_S + 384 + k8);
              const f32x4 u0v = *(const LAS f32x4*)(SEG_S + k8 + 4), u1v = *(const LAS f32x4*)(SEG_S + 128 + k8 + 4), u2v = *(const LAS f32x4*)(SEG_S + 256 + k8 + 4), u3v = *(const LAS f32x4*)(SEG_S + 384 + k8 + 4);
              const f32x4 tt0 = (t0v + t1v) + (t2v + t3v), tt1 = (u0v + u1v) + (u2v + u3v);
              const float b[8] = {ba0[0], ba0[1], ba0[2], ba0[3], ba1[0], ba1[1], ba1[2], ba1[3]}; const float tt[8] = {tt0[0], tt0[1], tt0[2], tt0[3], tt1[0], tt1[1], tt1[2], tt1[3]};
              const unsigned qv[4] = {qw.x, qw.y, qw.z, qw.w}, kv[4] = {kw.x, kw.y, kw.z, kw.w}; float qe[8], ke[8], kd[8];
#pragma unroll
              for (int e = 0; e < 4; ++e) { const float q0 = bflo(qv[e]), q1 = bfhi(qv[e]), k0 = bflo(kv[e]), k1 = bfhi(kv[e]); const float e0 = __expf(b[2 * e]), e1 = __expf(b[2 * e + 1]);
                  const float r0 = __builtin_amdgcn_rcpf(e0), r1 = __builtin_amdgcn_rcpf(e1);
                  qe[2 * e] = q0 * 0.08838834764831845f * e0; qe[2 * e + 1] = q1 * 0.08838834764831845f * e1; ke[2 * e] = k0 * r0; ke[2 * e + 1] = k1 * r1;
                  kd[2 * e] = k0 * __expf(tt[2 * e] - b[2 * e]); kd[2 * e + 1] = k1 * __expf(tt[2 * e + 1] - b[2 * e + 1]); }
              v4u wq, wk, wd; wq.x = pk2(qe[0], qe[1]); wq.y = pk2(qe[2], qe[3]); wq.z = pk2(qe[4], qe[5]); wq.w = pk2(qe[6], qe[7]);
              wk.x = pk2(ke[0], ke[1]); wk.y = pk2(ke[2], ke[3]); wk.z = pk2(ke[4], ke[5]); wk.w = pk2(ke[6], ke[7]);
              wd.x = pk2(kd[0], kd[1]); wd.y = pk2(kd[2], kd[3]); wd.z = pk2(kd[4], kd[5]); wd.w = pk2(kd[6], kd[7]);
              *(GAS v4u*)(QE + (size_t)(t0 + i) * 512 + h * 128 + k8) = wq; *(GAS v4u*)(KE + (size_t)(t0 + i) * 512 + h * 128 + k8) = wk;
              *(LAS v4u*)(KIMG + tri::st(i, k8)) = wd; } }
        __syncthreads();
        {
            const int w = F.wave, r = lane & 31, hi = lane >> 5;
            const int kb_base = (int)(uintptr_t)KIMG + tri::rd_base(lane), vb_base = (int)(uintptr_t)VIMG + (w >> 2) * 16384 + (w & 3) * 512 + tri::rd_base(lane);
            const tri::Frag2 b0 = tri::ld<0, 0>(vb_base), b1 = tri::ld<0, 1>(vb_base), b2 = tri::ld<0, 2>(vb_base), b3 = tri::ld<0, 3>(vb_base);
            const tri::Frag2 a00 = tri::ld<0, 0>(kb_base), a01 = tri::ld<0, 1>(kb_base), a02 = tri::ld<0, 2>(kb_base), a03 = tri::ld<0, 3>(kb_base);
            const tri::Frag2 a10 = tri::ld<1, 0>(kb_base), a11 = tri::ld<1, 1>(kb_base), a12 = tri::ld<1, 2>(kb_base), a13 = tri::ld<1, 3>(kb_base);
            const tri::Frag2 a20 = tri::ld<2, 0>(kb_base), a21 = tri::ld<2, 1>(kb_base), a22 = tri::ld<2, 2>(kb_base), a23 = tri::ld<2, 3>(kb_base);
            const tri::Frag2 a30 = tri::ld<3, 0>(kb_base), a31 = tri::ld<3, 1>(kb_base), a32 = tri::ld<3, 2>(kb_base), a33 = tri::ld<3, 3>(kb_base);
            TRI_WAIT();
            const bf16x8 B0 = tri::pk(b0), B1 = tri::pk(b1), B2 = tri::pk(b2), B3 = tri::pk(b3);
            f32x16 acc[4] = {};
            acc[0] = __builtin_amdgcn_mfma_f32_32x32x16_bf16(tri::pk(a00), B0, acc[0], 0, 0, 0); acc[0] = __builtin_amdgcn_mfma_f32_32x32x16_bf16(tri::pk(a01), B1, acc[0], 0, 0, 0);
            acc[0] = __builtin_amdgcn_mfma_f32_32x32x16_bf16(tri::pk(a02), B2, acc[0], 0, 0, 0); acc[0] = __builtin_amdgcn_mfma_f32_32x32x16_bf16(tri::pk(a03), B3, acc[0], 0, 0, 0);
            acc[1] = __builtin_amdgcn_mfma_f32_32x32x16_bf16(tri::pk(a10), B0, acc[1], 0, 0, 0); acc[1] = __builtin_amdgcn_mfma_f32_32x32x16_bf16(tri::pk(a11), B1, acc[1], 0, 0, 0);
            acc[1] = __builtin_amdgcn_mfma_f32_32x32x16_bf16(tri::pk(a12), B2, acc[1], 0, 0, 0); acc[1] = __builtin_amdgcn_mfma_f32_32x32x16_bf16(tri::pk(a13), B3, acc[1], 0, 0, 0);
            acc[2] = __builtin_amdgcn_mfma_f32_32x32x16_bf16(tri::pk(a20), B0, acc[2], 0, 0, 0); acc[2] = __builtin_amdgcn_mfma_f32_32x32x16_bf16(tri::pk(a21), B1, acc[2], 0, 0, 0);
            acc[2] = __builtin_amdgcn_mfma_f32_32x32x16_bf16(tri::pk(a22), B2, acc[2], 0, 0, 0); acc[2] = __builtin_amdgcn_mfma_f32_32x32x16_bf16(tri::pk(a23), B3, acc[2], 0, 0, 0);
            acc[3] = __builtin_amdgcn_mfma_f32_32x32x16_bf16(tri::pk(a30), B0, acc[3], 0, 0, 0); acc[3] = __builtin_amdgcn_mfma_f32_32x32x16_bf16(tri::pk(a31), B1, acc[3], 0, 0, 0);
            acc[3] = __builtin_amdgcn_mfma_f32_32x32x16_bf16(tri::pk(a32), B2, acc[3], 0, 0, 0); acc[3] = __builtin_amdgcn_mfma_f32_32x32x16_bf16(tri::pk(a33), B3, acc[3], 0, 0, 0);
            bf16* ST = (bf16*)(ar + B_ST) + ((size_t)(d * NCH + c) * 4 + h) * 256 * 128;
#pragma unroll
            for (int kb = 0; kb < 4; ++kb)
#pragma unroll
                for (int q4 = 0; q4 < 4; ++q4) { v2u o; o.x = pk2(acc[kb][4 * q4], acc[kb][4 * q4 + 1]); o.y = pk2(acc[kb][4 * q4 + 2], acc[kb][4 * q4 + 3]);
                    *(GAS v2u*)(ST + (size_t)(32 * w + r) * 128 + 32 * kb + 8 * q4 + 4 * hi) = o; }
        }
    }
}

__device__ __forceinline__ void ph_gla_scan(Frame& F) {
    unsigned char* ar = F.ws + WS_ARENA; const float* DEC = (const float*)(ar + B_DEC);
    for (int gth = blockIdx.x * NTHR + F.tid; gth < 2 * 4 * 256 * 64; gth += F.G * NTHR) {
        const int kp = gth & 63, v = (gth >> 6) & 255, h = (gth >> 14) & 3, d = gth >> 16;
        unsigned* ST = (unsigned*)(ar + B_ST) + ((((size_t)d * NCH) * 4 + h) * 256 + v) * 64 + kp;
        const f32x2* DC = (const f32x2*)DEC + (((size_t)d * NCH) * 4 + h) * 64 + kp;
        float s0 = 0.f, s1 = 0.f;
        for (int i0 = 0; i0 < NCH; i0 += 4) { int cc[4]; unsigned kv[4]; f32x2 dc[4];
#pragma unroll
            for (int q = 0; q < 4; ++q) { const int i = i0 + q; cc[q] = d == 0 ? i : (i < NCH_CTX ? NCH_CTX - 1 - i : NCH - 1 - (i - NCH_CTX));
                kv[q] = ST[(size_t)cc[q] * (4 * 256 * 64)]; dc[q] = DC[(size_t)cc[q] * (4 * 64)]; }
#pragma unroll
            for (int q = 0; q < 4; ++q) { ST[(size_t)cc[q] * (4 * 256 * 64)] = pk2(s0, s1); s0 = dc[q].x * s0 + bflo(kv[q]); s1 = dc[q].y * s1 + bfhi(kv[q]); } }
    }
}

__device__ __forceinline__ void gla_out_unit(Frame& F, int cl, int h) {
    unsigned char* ar = F.ws + WS_ARENA; const int c = cl + NCH_CTX, t0 = c * 64;
    LAS unsigned char* ATT = F.lds;
    LAS float* OS = (LAS float*)(F.lds + 18432);
    LAS unsigned char* VIMG = F.lds + 86016;
    const int lane = F.lane, r = lane & 31, hi = lane >> 5, w = F.wave;
    __syncthreads();
    { const bf16* GV = (const bf16*)(ar + B_GV);
      for (int i = F.tid; i < 2048; i += NTHR) { const int rr = i >> 5, v8 = (i & 31) * 8;
          *(LAS v4u*)(VIMG + (v8 >> 7) * 16384 + tri::st(rr, v8 & 127)) = *(const GAS v4u*)(GV + (size_t)(t0 + rr) * 1024 + h * 256 + v8); } }
    {
        const int d = w >> 2, ib = (w >> 1) & 1, jb = w & 1;
        const bf16* QE = (const bf16*)(ar + B_QE) + (size_t)d * T * 512 + (size_t)(t0 + ib * 32 + r) * 512 + h * 128 + 8 * hi;
        const bf16* KE = (const bf16*)(ar + B_KE) + (size_t)d * T * 512 + (size_t)(t0 + jb * 32 + r) * 512 + h * 128 + 8 * hi;
        bf16x8 a[8], b[8];
#pragma unroll
        for (int s = 0; s < 8; ++s) { a[s] = *(const GAS bf16x8*)(KE + 16 * s); b[s] = *(const GAS bf16x8*)(QE + 16 * s); }
        f32x16 acc = {};
#pragma unroll
        for (int s = 0; s < 8; ++s) acc = __builtin_amdgcn_mfma_f32_32x32x16_bf16(a[s], b[s], acc, 0, 0, 0);
        const int i = ib * 32 + r;
#pragma unroll
        for (int q4 = 0; q4 < 4; ++q4) { float x[4];
#pragma unroll
            for (int e = 0; e < 4; ++e) { const int j = jb * 32 + 8 * q4 + 4 * hi + e; const bool keep = d == 0 ? (j <= i) : (j >= i); x[e] = keep ? acc[4 * q4 + e] : 0.f; }
            v2u o; o.x = pk2(x[0], x[1]); o.y = pk2(x[2], x[3]);
            *(LAS v2u*)(ATT + ((size_t)(d * 64 + i) * 72 + jb * 32 + 8 * q4 + 4 * hi) * 2) = o; }
    }
    __syncthreads();
    {
        const int ib = w >> 2, vq = w & 3; f32x16 o0 = {}, o1 = {};
        const int vb_base = (int)(uintptr_t)VIMG + (vq >> 1) * 16384 + (2 * (vq & 1)) * 512 + tri::rd_base(lane);
        const tri::Frag2 p0 = tri::ld<0, 0>(vb_base), p1 = tri::ld<0, 1>(vb_base), p2 = tri::ld<0, 2>(vb_base), p3 = tri::ld<0, 3>(vb_base);
        const tri::Frag2 q0 = tri::ld<1, 0>(vb_base), q1 = tri::ld<1, 1>(vb_base), q2 = tri::ld<1, 2>(vb_base), q3 = tri::ld<1, 3>(vb_base);
        TRI_WAIT();
        const bf16x8 vb0[4] = {tri::pk(p0), tri::pk(p1), tri::pk(p2), tri::pk(p3)}, vb1[4] = {tri::pk(q0), tri::pk(q1), tri::pk(q2), tri::pk(q3)};
#pragma unroll
        for (int d = 0; d < 2; ++d) {
            bf16x8 a[4];
#pragma unroll
            for (int s = 0; s < 4; ++s) a[s] = *(const LAS bf16x8*)(ATT + ((size_t)(d * 64 + ib * 32 + r) * 72 + 16 * s + 8 * hi) * 2);
#pragma unroll
            for (int s = 0; s < 4; ++s) { o0 = __builtin_amdgcn_mfma_f32_32x32x16_bf16(a[s], vb0[s], o0, 0, 0, 0); o1 = __builtin_amdgcn_mfma_f32_32x32x16_bf16(a[s], vb1[s], o1, 0, 0, 0); }
            const bf16* QE = (const bf16*)(ar + B_QE) + (size_t)d * T * 512 + (size_t)(t0 + ib * 32 + r) * 512 + h * 128 + 8 * hi;
            const bf16* ST = (const bf16*)(ar + B_ST) + ((size_t)(d * NCH + c) * 4 + h) * 256 * 128 + (size_t)(64 * vq + r) * 128 + 8 * hi;
            bf16x8 qa[8], s0[8], s1[8];
#pragma unroll
            for (int s = 0; s < 8; ++s) { qa[s] = *(const GAS bf16x8*)(QE + 16 * s); s0[s] = *(const GAS bf16x8*)(ST + 16 * s); s1[s] = *(const GAS bf16x8*)(ST + 32 * 128 + 16 * s); }
#pragma unroll
            for (int s = 0; s < 8; ++s) { o0 = __builtin_amdgcn_mfma_f32_32x32x16_bf16(qa[s], s0[s], o0, 0, 0, 0); o1 = __builtin_amdgcn_mfma_f32_32x32x16_bf16(qa[s], s1[s], o1, 0, 0, 0); }
        }
#pragma unroll
        for (int q = 0; q < 16; ++q) { const int i = ib * 32 + crow(q, hi); OS[i * 260 + 64 * vq + r] = o0[q]; OS[i * 260 + 64 * vq + 32 + r] = o1[q]; }
    }
    __syncthreads();
    {
        const int i = F.tid >> 3, seg = F.tid & 7; const LAS float* op = OS + i * 260 + 32 * seg; f32x4 x[8]; float ss = 0.f;
#pragma unroll
        for (int e = 0; e < 8; ++e) { x[e] = *(const LAS f32x4*)(op + 4 * e); ss += (x[e][0] * x[e][0] + x[e][1] * x[e][1]) + (x[e][2] * x[e][2] + x[e][3] * x[e][3]); }
        ss += __shfl_xor(ss, 1); ss += __shfl_xor(ss, 2); ss += __shfl_xor(ss, 4);
        const float rstd = 1.f / sqrtf(ss * (1.f / 256.f) + EPS);
        const float* gn = inp(I_GLANORM) + h * 256 + 32 * seg; const bf16* R = (const bf16*)(ar + B_R) + (size_t)(t0 + i) * 1024 + h * 256 + 32 * seg;
        bf16* YM = (bf16*)(ar + B_YMIX1) + (size_t)(t0 - CTX + i) * D + h * 256 + 32 * seg;
#pragma unroll
        for (int e2 = 0; e2 < 4; ++e2) { const v4u rr = *(const GAS v4u*)(R + 8 * e2); const f32x4 g0 = *(const GAS f32x4*)(gn + 8 * e2), g1 = *(const GAS f32x4*)(gn + 8 * e2 + 4);
            const f32x4 a = x[2 * e2] * rstd * g0, b = x[2 * e2 + 1] * rstd * g1; v4u o;
            o.x = pk2(a[0] * siluf_(bflo(rr.x)), a[1] * siluf_(bfhi(rr.x))); o.y = pk2(a[2] * siluf_(bflo(rr.y)), a[3] * siluf_(bfhi(rr.y)));
            o.z = pk2(b[0] * siluf_(bflo(rr.z)), b[1] * siluf_(bfhi(rr.z))); o.w = pk2(b[2] * siluf_(bflo(rr.w)), b[3] * siluf_(bfhi(rr.w)));
            *(GAS v4u*)(YM + 8 * e2) = o; }
    }
}

namespace att {
constexpr int HD = 128, NW = 8, QBLK = 32, KVBLK = 64;
constexpr float SCALE = 0.088388347648318440f;
constexpr float THR = 8.f;
constexpr int LDQ = 1024, LDK = 256, LDO = 2048;
constexpr size_t SHM_V = KVBLK * HD * 2, SHM_K = KVBLK * HD * 2, SHM_ATTN = 2 * SHM_V + 2 * SHM_K + NW * 64 * 4;
using s16x4 = __attribute__((ext_vector_type(4))) short;
#define KSWZ(row, colB) ((row) * 256 + ((colB) ^ (((row) & 7) << 4)))
#define SBAR() __builtin_amdgcn_sched_barrier(0)
__device__ __forceinline__ unsigned cvtpk(float lo, float hi) { unsigned r; asm volatile("v_cvt_pk_bf16_f32 %0, %1, %2" : "=v"(r) : "v"(lo), "v"(hi)); return r; }
__device__ __forceinline__ void partialSM(f32x16& p0, f32x16& p1, float& m_reg, float& mn, float& alpha) {
  constexpr float C = SCALE * 1.4426950408889634f;
  float pmax = p0[0];
#pragma unroll
  for (int r = 1; r < 16; ++r) pmax = fmaxf(pmax, p0[r]);
#pragma unroll
  for (int r = 0; r < 16; ++r) pmax = fmaxf(pmax, p1[r]);
  { auto rr = __builtin_amdgcn_permlane32_swap(__float_as_uint(pmax), __float_as_uint(pmax), false, false);
    pmax = fmaxf(__uint_as_float(rr[0]), __uint_as_float(rr[1])); }
  if (__builtin_expect(__all(pmax - m_reg <= THR / SCALE), 1)) { mn = m_reg; alpha = 1.f; }
  else { mn = fmaxf(m_reg, pmax); alpha = __builtin_amdgcn_exp2f((m_reg - mn) * C); m_reg = mn; }
  float mnC = -mn * C;
#pragma unroll
  for (int r = 0; r < 16; ++r) p0[r] = fmaf(p0[r], C, mnC);
#pragma unroll
  for (int r = 0; r < 16; ++r) p1[r] = fmaf(p1[r], C, mnC);
#pragma unroll
  for (int r = 0; r < 16; ++r) p0[r] = __builtin_amdgcn_exp2f(p0[r]);
}
__device__ __forceinline__ void finishSM(f32x16& p0, f32x16& p1, float alpha, float& l_reg, bf16x8& pa0, bf16x8& pa1, bf16x8& pa2, bf16x8& pa3) {
#pragma unroll
  for (int r = 0; r < 16; ++r) p1[r] = __builtin_amdgcn_exp2f(p1[r]);
  float ps = 0;
#pragma unroll
  for (int r = 0; r < 16; ++r) ps += p0[r];
#pragma unroll
  for (int r = 0; r < 16; ++r) ps += p1[r];
  { auto rr = __builtin_amdgcn_permlane32_swap(__float_as_uint(ps), __float_as_uint(ps), false, false);
    ps = __uint_as_float(rr[0]) + __uint_as_float(rr[1]); }
  l_reg = l_reg * alpha + ps;
#define PK4(P, BASE, OUT) do { unsigned a0 = cvtpk(P[BASE + 0], P[BASE + 1]), a1 = cvtpk(P[BASE + 2], P[BASE + 3]);   \
    unsigned b0 = cvtpk(P[BASE + 4], P[BASE + 5]), b1 = cvtpk(P[BASE + 6], P[BASE + 7]);                              \
    auto r0 = __builtin_amdgcn_permlane32_swap(a0, b0, false, false); auto r1 = __builtin_amdgcn_permlane32_swap(a1, b1, false, false); \
    u32x4 w = {r0[0], r1[0], r0[1], r1[1]}; OUT = *reinterpret_cast<bf16x8*>(&w); } while (0)
  PK4(p0, 0, pa0); PK4(p0, 8, pa1); PK4(p1, 0, pa2); PK4(p1, 8, pa3);
#undef PK4
}
__device__ __forceinline__ void qkt(f32x16& p0, f32x16& p1, const bf16* Ks, const bf16x8* qr, int r32, int hi) {
  p0 = f32x16{}; p1 = f32x16{};
#pragma unroll
  for (int d0 = 0; d0 < 8; ++d0) { int cb = (d0 * 16 + hi * 8) * 2;
    bf16x8 b0 = *reinterpret_cast<const bf16x8*>((const char*)Ks + KSWZ(r32, cb));
    bf16x8 b1 = *reinterpret_cast<const bf16x8*>((const char*)Ks + KSWZ(32 + r32, cb));
    p0 = __builtin_amdgcn_mfma_f32_32x32x16_bf16(b0, qr[d0], p0, 0, 0, 0);
    p1 = __builtin_amdgcn_mfma_f32_32x32x16_bf16(b1, qr[d0], p1, 0, 0, 0); }
}
__device__ __forceinline__ int v_st(int k, int c) { const int kk = (k & ~0xC) | ((k & 4) << 1) | ((k & 8) >> 1); return ((kk >> 3) * 4 + (c >> 5)) * 512 + ((kk & 7) * 32 + (c & 31)) * 2; }
__device__ __forceinline__ int v_rd_base(int lane) { return ((lane & 3) << 3) | (((lane >> 2) & 3) << 6) | (((lane >> 4) & 1) << 5) | (((lane >> 5) & 1) << 8); }
constexpr int v_rd_off(int d0, int ks, int half) { return d0 * 512 + ks * 4096 + half * 2048; }
template <int OFF> __device__ __forceinline__ s16x4 tr_read(int vb) {
  s16x4 r; asm volatile("ds_read_b64_tr_b16 %0, %1 offset:%2" : "=&v"(r) : "v"(vb), "i"(OFF) : "memory"); return r;
}
template <int D0> __device__ __forceinline__ void pv_one(f32x16& od, int vb, bf16x8 pa0, bf16x8 pa1, bf16x8 pa2, bf16x8 pa3) {
  const s16x4 l0 = tr_read<v_rd_off(D0, 0, 0)>(vb), h0 = tr_read<v_rd_off(D0, 0, 1)>(vb), l1 = tr_read<v_rd_off(D0, 1, 0)>(vb), h1 = tr_read<v_rd_off(D0, 1, 1)>(vb);
  const s16x4 l2 = tr_read<v_rd_off(D0, 2, 0)>(vb), h2 = tr_read<v_rd_off(D0, 2, 1)>(vb), l3 = tr_read<v_rd_off(D0, 3, 0)>(vb), h3 = tr_read<v_rd_off(D0, 3, 1)>(vb);
  asm volatile("s_waitcnt lgkmcnt(0)" ::: "memory"); SBAR();
#define PK(L, H) (bf16x8){L[0], L[1], L[2], L[3], H[0], H[1], H[2], H[3]}
  od = __builtin_amdgcn_mfma_f32_32x32x16_bf16(pa0, PK(l0, h0), od, 0, 0, 0);
  od = __builtin_amdgcn_mfma_f32_32x32x16_bf16(pa1, PK(l1, h1), od, 0, 0, 0);
  od = __builtin_amdgcn_mfma_f32_32x32x16_bf16(pa2, PK(l2, h2), od, 0, 0, 0);
  od = __builtin_amdgcn_mfma_f32_32x32x16_bf16(pa3, PK(l3, h3), od, 0, 0, 0);
#undef PK
}
__device__ __forceinline__ void pv_d0(f32x16* o, int vb, bf16x8 pa0, bf16x8 pa1, bf16x8 pa2, bf16x8 pa3) {
  pv_one<0>(o[0], vb, pa0, pa1, pa2, pa3); pv_one<1>(o[1], vb, pa0, pa1, pa2, pa3); pv_one<2>(o[2], vb, pa0, pa1, pa2, pa3); pv_one<3>(o[3], vb, pa0, pa1, pa2, pa3);
}
typedef int v8i __attribute__((ext_vector_type(8)));
typedef int v4i __attribute__((ext_vector_type(4)));
constexpr size_t SHM_K8 = KVBLK * 128;
#define K8ADDR(row, g) ((row) * 128 + ((((g) ^ ((row) >> 1)) & 7) << 4))
__device__ __forceinline__ void qkt8(f32x16& p0, f32x16& p1, const char* Ks, const v8i& q0, const v8i& q1, int r32, int hi, int sc1) {
  p0 = f32x16{}; p1 = f32x16{};
  const int g0 = 4 * hi;
  { const v4i a00 = *reinterpret_cast<const v4i*>(Ks + K8ADDR(r32, g0)), a01 = *reinterpret_cast<const v4i*>(Ks + K8ADDR(r32, g0 + 1));
    const v4i b00 = *reinterpret_cast<const v4i*>(Ks + K8ADDR(32 + r32, g0)), b01 = *reinterpret_cast<const v4i*>(Ks + K8ADDR(32 + r32, g0 + 1));
    const v8i ka0 = __builtin_shufflevector(a00, a01, 0, 1, 2, 3, 4, 5, 6, 7), kb0 = __builtin_shufflevector(b00, b01, 0, 1, 2, 3, 4, 5, 6, 7);
    asm volatile("s_nop 1\n\tv_mfma_scale_f32_32x32x64_f8f6f4 %0, %1, %2, %0, %3, %3 op_sel_hi:[0,0,0]" : "+v"(p0) : "v"(ka0), "v"(q0), "v"(sc1));
    asm volatile("s_nop 1\n\tv_mfma_scale_f32_32x32x64_f8f6f4 %0, %1, %2, %0, %3, %3 op_sel_hi:[0,0,0]" : "+v"(p1) : "v"(kb0), "v"(q0), "v"(sc1) : "memory"); }
  { const v4i a10 = *reinterpret_cast<const v4i*>(Ks + K8ADDR(r32, g0 + 2)), a11 = *reinterpret_cast<const v4i*>(Ks + K8ADDR(r32, g0 + 3));
    const v4i b10 = *reinterpret_cast<const v4i*>(Ks + K8ADDR(32 + r32, g0 + 2)), b11 = *reinterpret_cast<const v4i*>(Ks + K8ADDR(32 + r32, g0 + 3));
    const v8i ka1 = __builtin_shufflevector(a10, a11, 0, 1, 2, 3, 4, 5, 6, 7), kb1 = __builtin_shufflevector(b10, b11, 0, 1, 2, 3, 4, 5, 6, 7);
    asm volatile("s_nop 1\n\tv_mfma_scale_f32_32x32x64_f8f6f4 %0, %1, %2, %0, %3, %3 op_sel_hi:[0,0,0]" : "+v"(p0) : "v"(ka1), "v"(q1), "v"(sc1));
    asm volatile("s_nop 1\n\tv_mfma_scale_f32_32x32x64_f8f6f4 %0, %1, %2, %0, %3, %3 op_sel_hi:[0,0,0]" : "+v"(p1) : "v"(kb1), "v"(q1), "v"(sc1)); }
  asm volatile("s_nop 15\n\ts_nop 7" : "+v"(p0), "+v"(p1));
}
__device__ __forceinline__ void attn_dense_body(const bf16* __restrict__ Qb, const unsigned char* __restrict__ Kh8, const bf16* __restrict__ Vh, bf16* __restrict__ Ob, int seq, char* lds) {
  constexpr int SDEPTH = 2;
  const int tid = threadIdx.x, wid = tid >> 6, lane = tid & 63, r32 = lane & 31, hi = lane >> 5;
  bf16* V_lds = (bf16*)lds; char* K_lds = lds + 2 * SHM_V;
  float* ws = (float*)(lds + 2 * SHM_V + 2 * SHM_K8) + wid * 64; float* li_l = ws; float* al_l = ws + 32;
  float m_reg = -1e30f, l_reg = 0; f32x16 o[4] = {}; bf16x8 qr[8];
  const bf16* Qw = Qb + (long)(wid * QBLK + r32) * LDQ + hi * 8;
#pragma unroll
  for (int d0 = 0; d0 < 8; ++d0) qr[d0] = *reinterpret_cast<const bf16x8*>(Qw + d0 * 16);
  v8i q8a, q8b; const int sc1 = 0x7f7f7f7f;
  { int w[16];
#pragma unroll
    for (int d0 = 0; d0 < 8; ++d0) { const u32x4 x = *reinterpret_cast<const u32x4*>(&qr[d0]);
      w[2 * d0] = (int)pk4_fp8(bflo(x.x), bfhi(x.x), bflo(x.y), bfhi(x.y)); w[2 * d0 + 1] = (int)pk4_fp8(bflo(x.z), bfhi(x.z), bflo(x.w), bfhi(x.w)); }
    q8a = (v8i){w[0], w[1], w[2], w[3], w[4], w[5], w[6], w[7]}; q8b = (v8i){w[8], w[9], w[10], w[11], w[12], w[13], w[14], w[15]}; }
  const int krow = tid >> 3, kg = tid & 7, kst = K8ADDR(krow, kg);
  const int sr = tid >> 4, sc = (tid & 15) * 8, vst0 = v_st(sr, sc), vst1 = v_st(32 + sr, sc);
  const int vb0 = (int)(uintptr_t)V_lds + v_rd_base(lane);
  struct { bf16x8 vs0, vs1; v4i ks; } sr_[SDEPTH];
#define SLOAD(i, k0) do { sr_[i].vs0 = *reinterpret_cast<const bf16x8*>(&Vh[(long)((k0) + sr) * LDK + sc]); sr_[i].vs1 = *reinterpret_cast<const bf16x8*>(&Vh[(long)((k0) + 32 + sr) * LDK + sc]); \
    sr_[i].ks = *reinterpret_cast<const v4i*>(&Kh8[(long)((k0) + krow) * 256 + kg * 16]); } while (0)
#define SWRITE(b, i) do { *(bf16x8*)((char*)V_lds + (b) * SHM_V + vst0) = sr_[i].vs0;          \
    *(bf16x8*)((char*)V_lds + (b) * SHM_V + vst1) = sr_[i].vs1;                                \
    *(v4i*)(K_lds + (b) * SHM_K8 + kst) = sr_[i].ks; } while (0)
#define SWAIT() do { asm volatile("s_waitcnt vmcnt(3)" ::: "memory"); } while (0)
#define RESC(a) do { if (__any((a) < 1.f)) { if (hi == 0) al_l[r32] = (a); asm volatile("s_waitcnt lgkmcnt(0)" ::: "memory"); \
    _Pragma("unroll") for (int d = 0; d < 4; ++d) _Pragma("unroll") for (int r = 0; r < 16; ++r) o[d][r] *= al_l[crow(r, hi)]; } } while (0)
  f32x16 pA0, pA1, pB0, pB1; float mnA, mnB, alA, alB; bf16x8 pa0, pa1, pa2, pa3; const int NT = seq / KVBLK;
  constexpr int SE = 0, SO = SDEPTH - 1;
  SLOAD(SE, 0); asm volatile("s_waitcnt vmcnt(0)" ::: "memory"); SWRITE(0, SE); __syncthreads();
  qkt8(pA0, pA1, K_lds, q8a, q8b, r32, hi, sc1); partialSM(pA0, pA1, m_reg, mnA, alA);
  SLOAD(SO, KVBLK); if (2 < NT) SLOAD(SE, 2 * KVBLK);
  SWAIT(); SWRITE(1, SO); __syncthreads();
  for (int j = 1; j + 1 < NT; j += 2) {
    SBAR(); qkt8(pB0, pB1, K_lds + SHM_K8, q8a, q8b, r32, hi, sc1);
    finishSM(pA0, pA1, alA, l_reg, pa0, pa1, pa2, pa3); SBAR();
    SLOAD(SO, (j + SDEPTH) * KVBLK); SBAR();
    pv_d0(o, vb0, pa0, pa1, pa2, pa3); partialSM(pB0, pB1, m_reg, mnB, alB);
    __syncthreads(); SWAIT(); SWRITE(0, SE);
    RESC(alB); __syncthreads();
    SBAR(); qkt8(pA0, pA1, K_lds, q8a, q8b, r32, hi, sc1);
    finishSM(pB0, pB1, alB, l_reg, pa0, pa1, pa2, pa3); SBAR();
    if (j + 3 < NT) SLOAD(SE, (j + 1 + SDEPTH) * KVBLK); SBAR();
    pv_d0(o, vb0 + (int)SHM_V, pa0, pa1, pa2, pa3); partialSM(pA0, pA1, m_reg, mnA, alA);
    __syncthreads(); SWAIT(); SWRITE(1, SO);
    RESC(alA); __syncthreads();
  }
  SBAR(); qkt8(pB0, pB1, K_lds + SHM_K8, q8a, q8b, r32, hi, sc1);
  finishSM(pA0, pA1, alA, l_reg, pa0, pa1, pa2, pa3); SBAR();
  pv_d0(o, vb0, pa0, pa1, pa2, pa3); partialSM(pB0, pB1, m_reg, mnB, alB);
  __syncthreads(); RESC(alB);
  finishSM(pB0, pB1, alB, l_reg, pa0, pa1, pa2, pa3); SBAR();
  pv_d0(o, vb0 + (int)SHM_V, pa0, pa1, pa2, pa3);
  if (hi == 0) li_l[r32] = l_reg; asm volatile("s_waitcnt lgkmcnt(0)" ::: "memory");
  float rli[16];
#pragma unroll
  for (int r = 0; r < 16; ++r) rli[r] = __builtin_amdgcn_rcpf(li_l[crow(r, hi)]);
  bf16* Ow = Ob + (long)(wid * QBLK) * LDO;
#pragma unroll
  for (int r = 0; r < 16; ++r) { int orow = crow(r, hi);
#pragma unroll
    for (int d0 = 0; d0 < 4; ++d0) Ow[(long)orow * LDO + d0 * 32 + r32] = (bf16)f2bf(o[d0][r] * rli[r]); }
  __syncthreads();
#undef SLOAD
#undef SWRITE
#undef SWAIT
#undef RESC
}
constexpr float THR8 = 6.f;
#define V8ADDR(d, g) ((d) * 64 + ((((g) ^ ((d) >> 2)) & 3) << 4))
__device__ __forceinline__ void partialSM8(f32x16& p0, f32x16& p1, float& m_reg, float& mn, float& alpha) {
  constexpr float C = SCALE * 1.4426950408889634f;
  float pmax = p0[0];
#pragma unroll
  for (int r = 1; r < 16; ++r) pmax = fmaxf(pmax, p0[r]);
#pragma unroll
  for (int r = 0; r < 16; ++r) pmax = fmaxf(pmax, p1[r]);
  { auto rr = __builtin_amdgcn_permlane32_swap(__float_as_uint(pmax), __float_as_uint(pmax), false, false);
    pmax = fmaxf(__uint_as_float(rr[0]), __uint_as_float(rr[1])); }
  if (__builtin_expect(__all(pmax - m_reg <= THR8 / SCALE), 1)) { mn = m_reg; alpha = 1.f; }
  else { mn = fmaxf(m_reg, pmax); alpha = __builtin_amdgcn_exp2f((m_reg - mn) * C); m_reg = mn; }
  float mnC = -mn * C;
#pragma unroll
  for (int r = 0; r < 16; ++r) p0[r] = fmaf(p0[r], C, mnC);
#pragma unroll
  for (int r = 0; r < 16; ++r) p1[r] = fmaf(p1[r], C, mnC);
#pragma unroll
  for (int r = 0; r < 16; ++r) p0[r] = __builtin_amdgcn_exp2f(p0[r]);
}
__device__ __forceinline__ void finishSM8(f32x16& p0, f32x16& p1, float alpha, float& l_reg, v8i& pa) {
#pragma unroll
  for (int r = 0; r < 16; ++r) p1[r] = __builtin_amdgcn_exp2f(p1[r]);
  float ps = 0;
#pragma unroll
  for (int r = 0; r < 16; ++r) ps += p0[r];
#pragma unroll
  for (int r = 0; r < 16; ++r) ps += p1[r];
  { auto rr = __builtin_amdgcn_permlane32_swap(__float_as_uint(ps), __float_as_uint(ps), false, false);
    ps = __uint_as_float(rr[0]) + __uint_as_float(rr[1]); }
  l_reg = l_reg * alpha + ps;
  pa = (v8i){(int)pk4_fp8(p0[0], p0[1], p0[2], p0[3]), (int)pk4_fp8(p0[4], p0[5], p0[6], p0[7]), (int)pk4_fp8(p0[8], p0[9], p0[10], p0[11]), (int)pk4_fp8(p0[12], p0[13], p0[14], p0[15]),
             (int)pk4_fp8(p1[0], p1[1], p1[2], p1[3]), (int)pk4_fp8(p1[4], p1[5], p1[6], p1[7]), (int)pk4_fp8(p1[8], p1[9], p1[10], p1[11]), (int)pk4_fp8(p1[12], p1[13], p1[14], p1[15])};
}
__device__ __forceinline__ void pv8(f32x16* o, const char* Vs, const v8i& pa, int r32, int hi, int sc1) {
#pragma unroll
  for (int d0 = 0; d0 < 4; ++d0) { const int d = 32 * d0 + r32;
    const v4i x0 = *reinterpret_cast<const v4i*>(Vs + V8ADDR(d, 2 * hi)), x1 = *reinterpret_cast<const v4i*>(Vs + V8ADDR(d, 2 * hi + 1));
    const v8i vb = __builtin_shufflevector(x0, x1, 0, 1, 2, 3, 4, 5, 6, 7);
    asm volatile("s_nop 1\n\tv_mfma_scale_f32_32x32x64_f8f6f4 %0, %1, %2, %0, %3, %3 op_sel_hi:[0,0,0]" : "+v"(o[d0]) : "v"(pa), "v"(vb), "v"(sc1)); }
  asm volatile("s_nop 15\n\ts_nop 7" : "+v"(o[0]), "+v"(o[1]), "+v"(o[2]), "+v"(o[3]));
}
__device__ __forceinline__ void attn_dense_body_pv8(const bf16* __restrict__ Qb, const unsigned char* __restrict__ Kh8, const unsigned char* __restrict__ Vt8, bf16* __restrict__ Ob, int seq, char* lds) {
  constexpr int SDEPTH = 2; constexpr size_t SHM_V8 = 8192;
  const int tid = threadIdx.x, wid = tid >> 6, lane = tid & 63, r32 = lane & 31, hi = lane >> 5;
  char* V_lds = lds; char* K_lds = lds + 2 * SHM_V8;
  float* ws = (float*)(lds + 2 * SHM_V8 + 2 * SHM_K8) + wid * 64; float* li_l = ws; float* al_l = ws + 32;
  float m_reg = -1e30f, l_reg = 0; f32x16 o[4] = {}; bf16x8 qr[8];
  const bf16* Qw = Qb + (long)(wid * QBLK + r32) * LDQ + hi * 8;
#pragma unroll
  for (int d0 = 0; d0 < 8; ++d0) qr[d0] = *reinterpret_cast<const bf16x8*>(Qw + d0 * 16);
  v8i q8a, q8b; const int sc1 = 0x7f7f7f7f;
  { int w[16];
#pragma unroll
    for (int d0 = 0; d0 < 8; ++d0) { const u32x4 x = *reinterpret_cast<const u32x4*>(&qr[d0]);
      w[2 * d0] = (int)pk4_fp8(bflo(x.x), bfhi(x.x), bflo(x.y), bfhi(x.y)); w[2 * d0 + 1] = (int)pk4_fp8(bflo(x.z), bfhi(x.z), bflo(x.w), bfhi(x.w)); }
    q8a = (v8i){w[0], w[1], w[2], w[3], w[4], w[5], w[6], w[7]}; q8b = (v8i){w[8], w[9], w[10], w[11], w[12], w[13], w[14], w[15]}; }
  const int krow = tid >> 3, kg = tid & 7, kst = K8ADDR(krow, kg);
  const int vrow = tid >> 2, vg = tid & 3, vst = V8ADDR(vrow, vg);
  struct { v4i vs, ks; } sr_[SDEPTH];
#define SLOAD(i, k0) do { sr_[i].vs = *reinterpret_cast<const v4i*>(&Vt8[(long)((k0) / KVBLK) * 8192 + tid * 16]); sr_[i].ks = *reinterpret_cast<const v4i*>(&Kh8[(long)((k0) + krow) * 256 + kg * 16]); } while (0)
#define SWRITE(b, i) do { *(v4i*)(V_lds + (b) * SHM_V8 + vst) = sr_[i].vs; *(v4i*)(K_lds + (b) * SHM_K8 + kst) = sr_[i].ks; } while (0)
#define SWAIT() do { asm volatile("s_waitcnt vmcnt(2)" ::: "memory"); } while (0)
#define RESC(a) do { if (__any((a) < 1.f)) { if (hi == 0) al_l[r32] = (a); asm volatile("s_waitcnt lgkmcnt(0)" ::: "memory"); \
    _Pragma("unroll") for (int d = 0; d < 4; ++d) _Pragma("unroll") for (int r = 0; r < 16; ++r) o[d][r] *= al_l[crow(r, hi)]; } } while (0)
  f32x16 pA0, pA1, pB0, pB1; float mnA, mnB, alA, alB; v8i pa; const int NT = seq / KVBLK;
  constexpr int SE = 0, SO = SDEPTH - 1;
  SLOAD(SE, 0); asm volatile("s_waitcnt vmcnt(0)" ::: "memory"); SWRITE(0, SE); __syncthreads();
  qkt8(pA0, pA1, K_lds, q8a, q8b, r32, hi, sc1); partialSM8(pA0, pA1, m_reg, mnA, alA);
  SLOAD(SO, KVBLK); if (2 < NT) SLOAD(SE, 2 * KVBLK);
  SWAIT(); SWRITE(1, SO); __syncthreads();
  for (int j = 1; j + 1 < NT; j += 2) {
    SBAR(); qkt8(pB0, pB1, K_lds + SHM_K8, q8a, q8b, r32, hi, sc1);
    finishSM8(pA0, pA1, alA, l_reg, pa); SBAR();
    SLOAD(SO, (j + SDEPTH) * KVBLK); SBAR();
    pv8(o, V_lds, pa, r32, hi, sc1); partialSM8(pB0, pB1, m_reg, mnB, alB);
    __syncthreads(); SWAIT(); SWRITE(0, SE);
    RESC(alB); __syncthreads();
    SBAR(); qkt8(pA0, pA1, K_lds, q8a, q8b, r32, hi, sc1);
    finishSM8(pB0, pB1, alB, l_reg, pa); SBAR();
    if (j + 3 < NT) SLOAD(SE, (j + 1 + SDEPTH) * KVBLK); SBAR();
    pv8(o, V_lds + SHM_V8, pa, r32, hi, sc1); partialSM8(pA0, pA1, m_reg, mnA, alA);
    __syncthreads(); SWAIT(); SWRITE(1, SO);
    RESC(alA); __syncthreads();
  }
  SBAR(); qkt8(pB0, pB1, K_lds + SHM_K8, q8a, q8b, r32, hi, sc1);
  finishSM8(pA0, pA1, alA, l_reg, pa); SBAR();
  pv8(o, V_lds, pa, r32, hi, sc1); partialSM8(pB0, pB1, m_reg, mnB, alB);
  __syncthreads(); RESC(alB);
  finishSM8(pB0, pB1, alB, l_reg, pa); SBAR();
  pv8(o, V_lds + SHM_V8, pa, r32, hi, sc1);
  if (hi == 0) li_l[r32] = l_reg; asm volatile("s_waitcnt lgkmcnt(0)" ::: "memory");
  float rli[16];
#pragma unroll
  for (int r = 0; r < 16; ++r) rli[r] = __builtin_amdgcn_rcpf(li_l[crow(r, hi)]);
  bf16* Ow = Ob + (long)(wid * QBLK) * LDO;
#pragma unroll
  for (int r = 0; r < 16; ++r) { int orow = crow(r, hi);
#pragma unroll
    for (int d0 = 0; d0 < 4; ++d0) Ow[(long)orow * LDO + d0 * 32 + r32] = (bf16)f2bf(o[d0][r] * rli[r]); }
  __syncthreads();
#undef SLOAD
#undef SWRITE
#undef SWAIT
#undef RESC
}
constexpr float QS8 = SCALE * 1.4426950408889634f * 8.f;
constexpr float THR2 = 8.6f;
__device__ __forceinline__ int cvt4_fp8(float a, float b, float c, float d) { int r; asm("v_cvt_pk_fp8_f32 %0, %1, %2" : "=v"(r) : "v"(a), "v"(b)); asm("v_cvt_pk_fp8_f32 %0, %1, %2 op_sel:[0,0,1]" : "+v"(r) : "v"(c), "v"(d)); return r; }
__device__ __forceinline__ void qkt8m(f32x16& p0, f32x16& p1, const f32x16& mi, const char* Ks, const v8i& q0, const v8i& q1, int r32, int hi, int sc1, int scq) {
  const int g0 = 4 * hi;
  { const v4i a00 = *reinterpret_cast<const v4i*>(Ks + K8ADDR(r32, g0)), a01 = *reinterpret_cast<const v4i*>(Ks + K8ADDR(r32, g0 + 1));
    const v4i b00 = *reinterpret_cast<const v4i*>(Ks + K8ADDR(32 + r32, g0)), b01 = *reinterpret_cast<const v4i*>(Ks + K8ADDR(32 + r32, g0 + 1));
    const v8i ka0 = __builtin_shufflevector(a00, a01, 0, 1, 2, 3, 4, 5, 6, 7), kb0 = __builtin_shufflevector(b00, b01, 0, 1, 2, 3, 4, 5, 6, 7);
    asm volatile("s_nop 1\n\tv_mfma_scale_f32_32x32x64_f8f6f4 %0, %1, %2, %3, %4, %5 op_sel_hi:[0,0,0]" : "=&v"(p0) : "v"(ka0), "v"(q0), "v"(mi), "v"(sc1), "v"(scq));
    asm volatile("s_nop 1\n\tv_mfma_scale_f32_32x32x64_f8f6f4 %0, %1, %2, %3, %4, %5 op_sel_hi:[0,0,0]" : "=&v"(p1) : "v"(kb0), "v"(q0), "v"(mi), "v"(sc1), "v"(scq) : "memory"); }
  { const v4i a10 = *reinterpret_cast<const v4i*>(Ks + K8ADDR(r32, g0 + 2)), a11 = *reinterpret_cast<const v4i*>(Ks + K8ADDR(r32, g0 + 3));
    const v4i b10 = *reinterpret_cast<const v4i*>(Ks + K8ADDR(32 + r32, g0 + 2)), b11 = *reinterpret_cast<const v4i*>(Ks + K8ADDR(32 + r32, g0 + 3));
    const v8i ka1 = __builtin_shufflevector(a10, a11, 0, 1, 2, 3, 4, 5, 6, 7), kb1 = __builtin_shufflevector(b10, b11, 0, 1, 2, 3, 4, 5, 6, 7);
    asm volatile("s_nop 1\n\tv_mfma_scale_f32_32x32x64_f8f6f4 %0, %1, %2, %0, %3, %4 op_sel_hi:[0,0,0]" : "+v"(p0) : "v"(ka1), "v"(q1), "v"(sc1), "v"(scq));
    asm volatile("s_nop 1\n\tv_mfma_scale_f32_32x32x64_f8f6f4 %0, %1, %2, %0, %3, %4 op_sel_hi:[0,0,0]" : "+v"(p1) : "v"(kb1), "v"(q1), "v"(sc1), "v"(scq)); }
}
__device__ __forceinline__ void xdl_pad2(f32x16& a, f32x16& b) { asm volatile("s_nop 15\n\ts_nop 7" : "+v"(a), "+v"(b)); }
template <bool FIRST> __device__ __forceinline__ void partialSM8m(f32x16& p0, f32x16& p1, float& M, f32x16& mi, float& alpha) {
  float pmax = p0[0];
#pragma unroll
  for (int r = 1; r < 16; ++r) pmax = fmaxf(pmax, p0[r]);
#pragma unroll
  for (int r = 0; r < 16; ++r) pmax = fmaxf(pmax, p1[r]);
  { auto rr = __builtin_amdgcn_permlane32_swap(__float_as_uint(pmax), __float_as_uint(pmax), false, false);
    pmax = fmaxf(__uint_as_float(rr[0]), __uint_as_float(rr[1])); }
  if (!FIRST && __builtin_expect(__all(pmax <= THR2), 1)) { alpha = 1.f; }
  else { const float d = FIRST ? pmax : fmaxf(pmax, 0.f); alpha = FIRST ? 1.f : __builtin_amdgcn_exp2f(-d); M += d;
#pragma unroll
    for (int r = 0; r < 16; ++r) { p0[r] -= d; p1[r] -= d; }
    const float nm = -M;
#pragma unroll
    for (int r = 0; r < 16; ++r) mi[r] = nm;
    asm volatile("" : "+v"(mi)); }
#pragma unroll
  for (int r = 0; r < 16; ++r) p0[r] = __builtin_amdgcn_exp2f(p0[r]);
}
__device__ __forceinline__ void finishSM8m(f32x16& p0, f32x16& p1, float alpha, float& l_reg, v8i& pa) {
#pragma unroll
  for (int r = 0; r < 16; ++r) p1[r] = __builtin_amdgcn_exp2f(p1[r]);
  float sa = p0[0], sb = p1[0];
#pragma unroll
  for (int r = 1; r < 16; ++r) { sa += p0[r]; sb += p1[r]; }
  float ps = sa + sb;
  { auto rr = __builtin_amdgcn_permlane32_swap(__float_as_uint(ps), __float_as_uint(ps), false, false);
    ps = __uint_as_float(rr[0]) + __uint_as_float(rr[1]); }
  l_reg = l_reg * alpha + ps;
  pa = (v8i){cvt4_fp8(p0[0], p0[1], p0[2], p0[3]), cvt4_fp8(p0[4], p0[5], p0[6], p0[7]), cvt4_fp8(p0[8], p0[9], p0[10], p0[11]), cvt4_fp8(p0[12], p0[13], p0[14], p0[15]),
             cvt4_fp8(p1[0], p1[1], p1[2], p1[3]), cvt4_fp8(p1[4], p1[5], p1[6], p1[7]), cvt4_fp8(p1[8], p1[9], p1[10], p1[11]), cvt4_fp8(p1[12], p1[13], p1[14], p1[15])};
}
__device__ __forceinline__ void pv8m(f32x16* o, const char* Vs, const v8i& pa, int r32, int hi, int sc1) {
#pragma unroll
  for (int d0 = 0; d0 < 4; ++d0) { const int d = 32 * d0 + r32;
    const v4i x0 = *reinterpret_cast<const v4i*>(Vs + V8ADDR(d, 2 * hi)), x1 = *reinterpret_cast<const v4i*>(Vs + V8ADDR(d, 2 * hi + 1));
    const v8i vb = __builtin_shufflevector(x0, x1, 0, 1, 2, 3, 4, 5, 6, 7);
    asm volatile("s_nop 1\n\tv_mfma_scale_f32_32x32x64_f8f6f4 %0, %1, %2, %0, %3, %3 op_sel_hi:[0,0,0]" : "+v"(o[d0]) : "v"(pa), "v"(vb), "v"(sc1)); }
}
__device__ __forceinline__ void attn_dense_body_m(const bf16* __restrict__ Qb, const unsigned char* __restrict__ Kh8, const unsigned char* __restrict__ Vt8, bf16* __restrict__ Ob, int seq, char* lds) {
  constexpr int SDEPTH = 2; constexpr size_t SHM_V8 = 8192;
  const int tid = threadIdx.x, wid = tid >> 6, lane = tid & 63, r32 = lane & 31, hi = lane >> 5;
  char* V_lds = lds; char* K_lds = lds + 2 * SHM_V8;
  float* ws = (float*)(lds + 2 * SHM_V8 + 2 * SHM_K8) + wid * 64; float* li_l = ws; float* al_l = ws + 32;
  float M = 0.f, l_reg = 0; f32x16 o[4] = {}; f32x16 mi = {}; asm volatile("" : "+v"(mi));
  v8i q8a, q8b; const int sc1 = 0x7f7f7f7f, scq = 0x7c7c7c7c;
  { bf16x8 qr[8]; const bf16* Qw = Qb + (long)(wid * QBLK + r32) * LDQ + hi * 8;
#pragma unroll
    for (int d0 = 0; d0 < 8; ++d0) qr[d0] = *reinterpret_cast<const bf16x8*>(Qw + d0 * 16);
    int w[16];
#pragma unroll
    for (int d0 = 0; d0 < 8; ++d0) { const u32x4 x = *reinterpret_cast<const u32x4*>(&qr[d0]);
      w[2 * d0] = (int)pk4_fp8(bflo(x.x) * QS8, bfhi(x.x) * QS8, bflo(x.y) * QS8, bfhi(x.y) * QS8); w[2 * d0 + 1] = (int)pk4_fp8(bflo(x.z) * QS8, bfhi(x.z) * QS8, bflo(x.w) * QS8, bfhi(x.w) * QS8); }
    q8a = (v8i){w[0], w[1], w[2], w[3], w[4], w[5], w[6], w[7]}; q8b = (v8i){w[8], w[9], w[10], w[11], w[12], w[13], w[14], w[15]}; }
  const int krow = tid >> 3, kg = tid & 7, kst = K8ADDR(krow, kg);
  const int vrow = tid >> 2, vg = tid & 3, vst = V8ADDR(vrow, vg);
  struct { v4i vs, ks; } sr_[SDEPTH];
#define SLOAD(i, k0) do { sr_[i].vs = *reinterpret_cast<const v4i*>(&Vt8[(long)((k0) / KVBLK) * 8192 + tid * 16]); sr_[i].ks = *reinterpret_cast<const v4i*>(&Kh8[(long)((k0) + krow) * 256 + kg * 16]); } while (0)
#define SWRITE(b, i) do { *(v4i*)(V_lds + (b) * SHM_V8 + vst) = sr_[i].vs; *(v4i*)(K_lds + (b) * SHM_K8 + kst) = sr_[i].ks; } while (0)
#define SWAIT() do { asm volatile("s_waitcnt vmcnt(2)" ::: "memory"); } while (0)
#define RESC(a) do { if (__any((a) < 1.f)) { if (hi == 0) al_l[r32] = (a); xdl_pad2(o[0], o[1]); xdl_pad2(o[2], o[3]); asm volatile("s_waitcnt lgkmcnt(0)" ::: "memory"); \
    _Pragma("unroll") for (int d = 0; d < 4; ++d) _Pragma("unroll") for (int r = 0; r < 16; ++r) o[d][r] *= al_l[crow(r, hi)]; } } while (0)
  f32x16 pA0, pA1, pB0, pB1; float alA, alB; v8i pa; const int NT = seq / KVBLK;
  constexpr int SE = 0, SO = SDEPTH - 1;
  SLOAD(SE, 0); asm volatile("s_waitcnt vmcnt(0)" ::: "memory"); SWRITE(0, SE); __syncthreads();
  qkt8m(pA0, pA1, mi, K_lds, q8a, q8b, r32, hi, sc1, scq); xdl_pad2(pA0, pA1); partialSM8m<true>(pA0, pA1, M, mi, alA);
  SLOAD(SO, KVBLK); if (2 < NT) SLOAD(SE, 2 * KVBLK);
  SWAIT(); SWRITE(1, SO); __syncthreads();
  for (int j = 1; j + 1 < NT; j += 2) {
    SBAR(); qkt8m(pB0, pB1, mi, K_lds + SHM_K8, q8a, q8b, r32, hi, sc1, scq);
    finishSM8m(pA0, pA1, alA, l_reg, pa); SBAR();
    SLOAD(SO, (j + SDEPTH) * KVBLK); SBAR();
    pv8m(o, V_lds, pa, r32, hi, sc1); partialSM8m<false>(pB0, pB1, M, mi, alB);
    __syncthreads(); SWAIT(); SWRITE(0, SE);
    RESC(alB); __syncthreads();
    SBAR(); qkt8m(pA0, pA1, mi, K_lds, q8a, q8b, r32, hi, sc1, scq);
    finishSM8m(pB0, pB1, alB, l_reg, pa); SBAR();
    if (j + 3 < NT) SLOAD(SE, (j + 1 + SDEPTH) * KVBLK); SBAR();
    pv8m(o, V_lds + SHM_V8, pa, r32, hi, sc1); partialSM8m<false>(pA0, pA1, M, mi, alA);
    __syncthreads(); SWAIT(); SWRITE(1, SO);
    RESC(alA); __syncthreads();
  }
  SBAR(); qkt8m(pB0, pB1, mi, K_lds + SHM_K8, q8a, q8b, r32, hi, sc1, scq);
  finishSM8m(pA0, pA1, alA, l_reg, pa); SBAR();
  pv8m(o, V_lds, pa, r32, hi, sc1); partialSM8m<false>(pB0, pB1, M, mi, alB);
  __syncthreads(); RESC(alB);
  finishSM8m(pB0, pB1, alB, l_reg, pa); SBAR();
  pv8m(o, V_lds + SHM_V8, pa, r32, hi, sc1);
  if (hi == 0) li_l[r32] = l_reg; asm volatile("s_waitcnt lgkmcnt(0)" ::: "memory");
  xdl_pad2(o[0], o[1]); xdl_pad2(o[2], o[3]);
  float rli[16];
#pragma unroll
  for (int r = 0; r < 16; ++r) rli[r] = __builtin_amdgcn_rcpf(li_l[crow(r, hi)]);
  bf16* Ow = Ob + (long)(wid * QBLK) * LDO;
#pragma unroll
  for (int r = 0; r < 16; ++r) { int orow = crow(r, hi);
#pragma unroll
    for (int d0 = 0; d0 < 4; ++d0) Ow[(long)orow * LDO + d0 * 32 + r32] = (bf16)f2bf(o[d0][r] * rli[r]); }
  __syncthreads();
#undef SLOAD
#undef SWRITE
#undef SWAIT
#undef RESC
}
__device__ __forceinline__ void mfma8_init(f32x16& p, const v8i& a, const v8i& b, const f32x16& c, int sa, int sb) {
  asm volatile("s_nop 1\n\tv_mfma_scale_f32_32x32x64_f8f6f4 %0, %1, %2, %3, %4, %5 op_sel_hi:[0,0,0]" : "=&v"(p) : "v"(a), "v"(b), "v"(c), "v"(sa), "v"(sb)); }
__device__ __forceinline__ void mfma8_acc(f32x16& p, const v8i& a, const v8i& b, int sa, int sb) {
  asm volatile("s_nop 1\n\tv_mfma_scale_f32_32x32x64_f8f6f4 %0, %1, %2, %0, %3, %4 op_sel_hi:[0,0,0]" : "+v"(p) : "v"(a), "v"(b), "v"(sa), "v"(sb)); }
__device__ __forceinline__ void attn_dense_body_i(const bf16* __restrict__ Qb, const unsigned char* __restrict__ Kh8, const unsigned char* __restrict__ Vt8, bf16* __restrict__ Ob, int seq, char* lds) {
  constexpr int SDEPTH = 2; constexpr size_t SHM_V8 = 8192;
  const int tid = threadIdx.x, wid = tid >> 6, lane = tid & 63, r32 = lane & 31, hi = lane >> 5;
  char* V_lds = lds; char* K_lds = lds + 2 * SHM_V8;
  float* ws = (float*)(lds + 2 * SHM_V8 + 2 * SHM_K8) + wid * 64; float* li_l = ws; float* al_l = ws + 32;
  float M = 0.f, l_reg = 0; f32x16 o[4] = {}; f32x16 mi = {}; asm volatile("" : "+v"(mi));
  v8i q8a, q8b; const int sc1 = 0x7f7f7f7f, scq = 0x7c7c7c7c;
  { bf16x8 qr[8]; const bf16* Qw = Qb + (long)(wid * QBLK + r32) * LDQ + hi * 8;
#pragma unroll
    for (int d0 = 0; d0 < 8; ++d0) qr[d0] = *reinterpret_cast<const bf16x8*>(Qw + d0 * 16);
    int w[16];
#pragma unroll
    for (int d0 = 0; d0 < 8; ++d0) { const u32x4 x = *reinterpret_cast<const u32x4*>(&qr[d0]);
      w[2 * d0] = (int)pk4_fp8(bflo(x.x) * QS8, bfhi(x.x) * QS8, bflo(x.y) * QS8, bfhi(x.y) * QS8); w[2 * d0 + 1] = (int)pk4_fp8(bflo(x.z) * QS8, bfhi(x.z) * QS8, bflo(x.w) * QS8, bfhi(x.w) * QS8); }
    q8a = (v8i){w[0], w[1], w[2], w[3], w[4], w[5], w[6], w[7]}; q8b = (v8i){w[8], w[9], w[10], w[11], w[12], w[13], w[14], w[15]}; }
  const int krow = tid >> 3, kg = tid & 7, kst = K8ADDR(krow, kg);
  const int vrow = tid >> 2, vg = tid & 3, vst = V8ADDR(vrow, vg);
  const int g0 = 4 * hi;
  struct { v4i vs, ks; } sr_[SDEPTH];
#define SLOAD(i, k0) do { sr_[i].vs = *reinterpret_cast<const v4i*>(&Vt8[(long)((k0) / KVBLK) * 8192 + tid * 16]); sr_[i].ks = *reinterpret_cast<const v4i*>(&Kh8[(long)((k0) + krow) * 256 + kg * 16]); } while (0)
#define SWRITE(b, i) do { *(v4i*)(V_lds + (b) * SHM_V8 + vst) = sr_[i].vs; *(v4i*)(K_lds + (b) * SHM_K8 + kst) = sr_[i].ks; } while (0)
#define SWAIT() do { asm volatile("s_waitcnt vmcnt(2)" ::: "memory"); } while (0)
#define RESC(a) do { if (__any((a) < 1.f)) { if (hi == 0) al_l[r32] = (a); xdl_pad2(o[0], o[1]); xdl_pad2(o[2], o[3]); asm volatile("s_waitcnt lgkmcnt(0)" ::: "memory"); \
    _Pragma("unroll") for (int d = 0; d < 4; ++d) _Pragma("unroll") for (int r = 0; r < 16; ++r) o[d][r] *= al_l[crow(r, hi)]; } } while (0)
#define KFRAG(D0, D1, KB, G) do { const v4i a0_ = *reinterpret_cast<const v4i*>((KB) + K8ADDR(r32, (G))), a1_ = *reinterpret_cast<const v4i*>((KB) + K8ADDR(r32, (G) + 1));             \
    const v4i b0_ = *reinterpret_cast<const v4i*>((KB) + K8ADDR(32 + r32, (G))), b1_ = *reinterpret_cast<const v4i*>((KB) + K8ADDR(32 + r32, (G) + 1));                                \
    D0 = __builtin_shufflevector(a0_, a1_, 0, 1, 2, 3, 4, 5, 6, 7); D1 = __builtin_shufflevector(b0_, b1_, 0, 1, 2, 3, 4, 5, 6, 7); } while (0)
#define VFRAG(Dv, VB, D0) do { const int d_ = 32 * (D0) + r32; const v4i x0_ = *reinterpret_cast<const v4i*>((VB) + V8ADDR(d_, 2 * hi)), x1_ = *reinterpret_cast<const v4i*>((VB) + V8ADDR(d_, 2 * hi + 1)); \
    Dv = __builtin_shufflevector(x0_, x1_, 0, 1, 2, 3, 4, 5, 6, 7); } while (0)
#define EXPR(P, LO, HI) do { _Pragma("unroll") for (int r = (LO); r < (HI); ++r) P[r] = __builtin_amdgcn_exp2f(P[r]); } while (0)
#define ATT_HALF(PB0, PB1, ALB, PA0, PA1, ALA, KB, VA, LOADSTMT) do {                                                                              \
    v8i ka_, kb_, vf_;                                                                                                                             \
    KFRAG(ka_, kb_, KB, g0); EXPR(PA1, 0, 8);                                                                                                      \
    SBAR(); mfma8_init(PB0, ka_, q8a, mi, sc1, scq); SBAR();                                                                                       \
    EXPR(PA1, 8, 16);                                                                                                                              \
    SBAR(); mfma8_init(PB1, kb_, q8a, mi, sc1, scq); SBAR();                                                                                       \
    KFRAG(ka_, kb_, KB, g0 + 2);                                                                                                                   \
    float sa_ = PA0[0], sb_ = PA0[8];                                                                                                              \
    _Pragma("unroll") for (int r = 1; r < 8; ++r) { sa_ += PA0[r]; sb_ += PA0[8 + r]; }                                                            \
    SBAR(); mfma8_acc(PB0, ka_, q8b, sc1, scq); SBAR();                                                                                            \
    VFRAG(vf_, VA, 0);                                                                                                                             \
    { float sc_ = PA1[0], sd_ = PA1[8];                                                                                                            \
      _Pragma("unroll") for (int r = 1; r < 8; ++r) { sc_ += PA1[r]; sd_ += PA1[8 + r]; }                                                          \
      float ps_ = (sa_ + sb_) + (sc_ + sd_);                                                                                                       \
      auto rr_ = __builtin_amdgcn_permlane32_swap(__float_as_uint(ps_), __float_as_uint(ps_), false, false);                                       \
      l_reg = l_reg * (ALA) + (__uint_as_float(rr_[0]) + __uint_as_float(rr_[1])); }                                                               \
    SBAR(); mfma8_acc(PB1, kb_, q8b, sc1, scq); SBAR();                                                                                            \
    pa = (v8i){cvt4_fp8(PA0[0], PA0[1], PA0[2], PA0[3]), cvt4_fp8(PA0[4], PA0[5], PA0[6], PA0[7]), cvt4_fp8(PA0[8], PA0[9], PA0[10], PA0[11]), cvt4_fp8(PA0[12], PA0[13], PA0[14], PA0[15]), \
               cvt4_fp8(PA1[0], PA1[1], PA1[2], PA1[3]), cvt4_fp8(PA1[4], PA1[5], PA1[6], PA1[7]), cvt4_fp8(PA1[8], PA1[9], PA1[10], PA1[11]), cvt4_fp8(PA1[12], PA1[13], PA1[14], PA1[15])}; \
    SBAR(); mfma8_acc(o[0], pa, vf_, sc1, sc1); SBAR();                                                                                            \
    VFRAG(vf_, VA, 1); LOADSTMT;                                                                                                                   \
    float mx_ = PB0[0];                                                                                                                            \
    _Pragma("unroll") for (int r = 1; r < 16; ++r) mx_ = fmaxf(mx_, PB0[r]);                                                                       \
    SBAR(); mfma8_acc(o[1], pa, vf_, sc1, sc1); SBAR();                                                                                            \
    VFRAG(vf_, VA, 2);                                                                                                                             \
    _Pragma("unroll") for (int r = 0; r < 16; ++r) mx_ = fmaxf(mx_, PB1[r]);                                                                       \
    { auto rr_ = __builtin_amdgcn_permlane32_swap(__float_as_uint(mx_), __float_as_uint(mx_), false, false);                                       \
      mx_ = fmaxf(__uint_as_float(rr_[0]), __uint_as_float(rr_[1])); }                                                                             \
    if (__builtin_expect(__all(mx_ <= THR2), 1)) { ALB = 1.f; }                                                                                    \
    else { const float d_ = fmaxf(mx_, 0.f); ALB = __builtin_amdgcn_exp2f(-d_); M += d_;                                                           \
      _Pragma("unroll") for (int r = 0; r < 16; ++r) { PB0[r] -= d_; PB1[r] -= d_; }                                                               \
      const float nm_ = -M;                                                                                                                        \
      _Pragma("unroll") for (int r = 0; r < 16; ++r) mi[r] = nm_;                                                                                  \
      asm volatile("" : "+v"(mi)); }                                                                                                               \
    SBAR(); mfma8_acc(o[2], pa, vf_, sc1, sc1); SBAR();                                                                                            \
    VFRAG(vf_, VA, 3); EXPR(PB0, 0, 8);                                                                                                            \
    SBAR(); mfma8_acc(o[3], pa, vf_, sc1, sc1); SBAR();                                                                                            \
    EXPR(PB0, 8, 16);                                                                                                                              \
  } while (0)
  f32x16 pA0, pA1, pB0, pB1; float alA, alB; v8i pa; const int NT = seq / KVBLK;
  constexpr int SE = 0, SO = SDEPTH - 1;
  SLOAD(SE, 0); asm volatile("s_waitcnt vmcnt(0)" ::: "memory"); SWRITE(0, SE); __syncthreads();
  qkt8m(pA0, pA1, mi, K_lds, q8a, q8b, r32, hi, sc1, scq); xdl_pad2(pA0, pA1); partialSM8m<true>(pA0, pA1, M, mi, alA);
  SLOAD(SO, KVBLK); if (2 < NT) SLOAD(SE, 2 * KVBLK);
  SWAIT(); SWRITE(1, SO); __syncthreads();
  for (int j = 1; j + 1 < NT; j += 2) {
    ATT_HALF(pB0, pB1, alB, pA0, pA1, alA, K_lds + SHM_K8, V_lds, SLOAD(SO, (j + SDEPTH) * KVBLK));
    __syncthreads(); SWAIT(); SWRITE(0, SE);
    RESC(alB); __syncthreads();
    ATT_HALF(pA0, pA1, alA, pB0, pB1, alB, K_lds, V_lds + SHM_V8, if (j + 3 < NT) SLOAD(SE, (j + 1 + SDEPTH) * KVBLK));
    __syncthreads(); SWAIT(); SWRITE(1, SO);
    RESC(alA); __syncthreads();
  }
  ATT_HALF(pB0, pB1, alB, pA0, pA1, alA, K_lds + SHM_K8, V_lds, (void)0);
  __syncthreads(); RESC(alB);
  finishSM8m(pB0, pB1, alB, l_reg, pa); SBAR();
  pv8m(o, V_lds + SHM_V8, pa, r32, hi, sc1);
  if (hi == 0) li_l[r32] = l_reg; asm volatile("s_waitcnt lgkmcnt(0)" ::: "memory");
  xdl_pad2(o[0], o[1]); xdl_pad2(o[2], o[3]);
  float rli[16];
#pragma unroll
  for (int r = 0; r < 16; ++r) rli[r] = __builtin_amdgcn_rcpf(li_l[crow(r, hi)]);
  bf16* Ow = Ob + (long)(wid * QBLK) * LDO;
#pragma unroll
  for (int r = 0; r < 16; ++r) { int orow = crow(r, hi);
#pragma unroll
    for (int d0 = 0; d0 < 4; ++d0) Ow[(long)orow * LDO + d0 * 32 + r32] = (bf16)f2bf(o[d0][r] * rli[r]); }
  __syncthreads();
#undef SLOAD
#undef SWRITE
#undef SWAIT
#undef RESC
#undef KFRAG
#undef VFRAG
#undef EXPR
#undef ATT_HALF
}
__device__ __forceinline__ void attn_dense_body_d(const bf16* __restrict__ Qb, const unsigned char* __restrict__ Kh8, const unsigned char* __restrict__ Vt8, bf16* __restrict__ Ob, int seq, LAS char* lds) {
  const int tid = threadIdx.x, wid = tid >> 6, lane = tid & 63, r32 = lane & 31, hi = lane >> 5;
  LAS char* K_lds = lds; LAS char* V_lds = lds + 4 * 8192;
  LAS float* ws = (LAS float*)(lds + 8 * 8192) + wid * 64; LAS float* li_l = ws; LAS float* al_l = ws + 32;
  float M = 0.f, l_reg = 0; f32x16 o[4] = {}; f32x16 mi = {}; asm volatile("" : "+v"(mi));
  v8i q8a, q8b; const int sc1 = 0x7f7f7f7f, scq = 0x7c7c7c7c;
  { bf16x8 qr[8]; const bf16* Qw = Qb + (long)(wid * QBLK + r32) * LDQ + hi * 8;
#pragma unroll
    for (int d0 = 0; d0 < 8; ++d0) qr[d0] = *reinterpret_cast<const bf16x8*>(Qw + d0 * 16);
    int w[16];
#pragma unroll
    for (int d0 = 0; d0 < 8; ++d0) { const u32x4 x = *reinterpret_cast<const u32x4*>(&qr[d0]);
      w[2 * d0] = (int)pk4_fp8(bflo(x.x) * QS8, bfhi(x.x) * QS8, bflo(x.y) * QS8, bfhi(x.y) * QS8); w[2 * d0 + 1] = (int)pk4_fp8(bflo(x.z) * QS8, bfhi(x.z) * QS8, bflo(x.w) * QS8, bfhi(x.w) * QS8); }
    q8a = (v8i){w[0], w[1], w[2], w[3], w[4], w[5], w[6], w[7]}; q8b = (v8i){w[8], w[9], w[10], w[11], w[12], w[13], w[14], w[15]}; }
  const int g0 = 4 * hi;
  const int kr = wid * 8 + (lane >> 3), vd = wid * 16 + (lane >> 2);
  const unsigned kgo = (unsigned)kr * 256u + (unsigned)((((lane & 7) ^ (kr >> 1)) & 7) << 4), vgo = (unsigned)vd * 64u + (unsigned)((((lane & 3) ^ (vd >> 2)) & 3) << 4);
#define DMA(blk) do { const int b_ = (blk) & 3; unsigned ko_ = (unsigned)(blk) * 16384u, vo_ = (unsigned)(blk) * 8192u; asm volatile("" : "+s"(ko_), "+s"(vo_));     \
    __builtin_amdgcn_global_load_lds((const unsigned*)(Kh8 + (size_t)(ko_ + kgo)), (LAS unsigned*)(K_lds + b_ * 8192 + wid * 1024), 16, 0, 0);                      \
    __builtin_amdgcn_global_load_lds((const unsigned*)(Vt8 + (size_t)(vo_ + vgo)), (LAS unsigned*)(V_lds + b_ * 8192 + wid * 1024), 16, 0, 0); } while (0)
#define VMW(n) asm volatile("s_waitcnt vmcnt(" #n ")" ::: "memory")
#define BAR() __builtin_amdgcn_s_barrier()
#define RESC(a) do { if (__any((a) < 1.f)) { if (hi == 0) al_l[r32] = (a); xdl_pad2(o[0], o[1]); xdl_pad2(o[2], o[3]); asm volatile("s_waitcnt lgkmcnt(0)" ::: "memory"); \
    _Pragma("unroll") for (int d = 0; d < 4; ++d) _Pragma("unroll") for (int r = 0; r < 16; ++r) o[d][r] *= al_l[crow(r, hi)]; } } while (0)
#define KFRAG(D0, D1, KB, G) do { const v4i a0_ = *reinterpret_cast<const LAS v4i*>((KB) + K8ADDR(r32, (G))), a1_ = *reinterpret_cast<const LAS v4i*>((KB) + K8ADDR(r32, (G) + 1));             \
    const v4i b0_ = *reinterpret_cast<const LAS v4i*>((KB) + K8ADDR(r32, (G)) + 4096), b1_ = *reinterpret_cast<const LAS v4i*>((KB) + K8ADDR(r32, (G) + 1) + 4096);     \
    D0 = __builtin_shufflevector(a0_, a1_, 0, 1, 2, 3, 4, 5, 6, 7); D1 = __builtin_shufflevector(b0_, b1_, 0, 1, 2, 3, 4, 5, 6, 7); } while (0)
#define VFRAG(Dv, VB, D0) do { const v4i x0_ = *reinterpret_cast<const LAS v4i*>((VB) + V8ADDR(r32, 2 * hi) + 2048 * (D0)), x1_ = *reinterpret_cast<const LAS v4i*>((VB) + V8ADDR(r32, 2 * hi + 1) + 2048 * (D0));     \
    Dv = __builtin_shufflevector(x0_, x1_, 0, 1, 2, 3, 4, 5, 6, 7); } while (0)
#define EXPR(P, LO, HI) do { _Pragma("unroll") for (int r = (LO); r < (HI); ++r) P[r] = __builtin_amdgcn_exp2f(P[r]); } while (0)
#define ATT_HALF(PB0, PB1, ALB, PA0, PA1, ALA, KB, VA, LOADSTMT) do {                                                                              \
    v8i ka_, kb_, vf_;                                                                                                                             \
    KFRAG(ka_, kb_, KB, g0); EXPR(PA1, 0, 8);                                                                                                      \
    SBAR(); mfma8_init(PB0, ka_, q8a, mi, sc1, scq); SBAR();                                                                                       \
    EXPR(PA1, 8, 16);                                                                                                                              \
    SBAR(); mfma8_init(PB1, kb_, q8a, mi, sc1, scq); SBAR();                                                                                       \
    KFRAG(ka_, kb_, KB, g0 + 2);                                                                                                                   \
    float sa_ = PA0[0], sb_ = PA0[8];                                                                                                              \
    _Pragma("unroll") for (int r = 1; r < 8; ++r) { sa_ += PA0[r]; sb_ += PA0[8 + r]; }                                                            \
    asm volatile("" : "+v"(sa_), "+v"(sb_));                                                                                                       \
    SBAR(); mfma8_acc(PB0, ka_, q8b, sc1, scq); SBAR();                                                                                            \
    VFRAG(vf_, VA, 0);                                                                                                                             \
    { float sc_ = PA1[0], sd_ = PA1[8];                                                                                                            \
      _Pragma("unroll") for (int r = 1; r < 8; ++r) { sc_ += PA1[r]; sd_ += PA1[8 + r]; }                                                          \
      float ps_ = (sa_ + sb_) + (sc_ + sd_);                                                                                                       \
      auto rr_ = __builtin_amdgcn_permlane32_swap(__float_as_uint(ps_), __float_as_uint(ps_), false, false);                                       \
      l_reg = l_reg * (ALA) + (__uint_as_float(rr_[0]) + __uint_as_float(rr_[1])); }                                                               \
    SBAR(); mfma8_acc(PB1, kb_, q8b, sc1, scq); SBAR();                                                                                            \
    pa = (v8i){cvt4_fp8(PA0[0], PA0[1], PA0[2], PA0[3]), cvt4_fp8(PA0[4], PA0[5], PA0[6], PA0[7]), cvt4_fp8(PA0[8], PA0[9], PA0[10], PA0[11]), cvt4_fp8(PA0[12], PA0[13], PA0[14], PA0[15]), \
               cvt4_fp8(PA1[0], PA1[1], PA1[2], PA1[3]), cvt4_fp8(PA1[4], PA1[5], PA1[6], PA1[7]), cvt4_fp8(PA1[8], PA1[9], PA1[10], PA1[11]), cvt4_fp8(PA1[12], PA1[13], PA1[14], PA1[15])}; \
    SBAR(); mfma8_acc(o[0], pa, vf_, sc1, sc1); SBAR();                                                                                            \
    VFRAG(vf_, VA, 1); LOADSTMT;                                                                                                                   \
    float mx_ = PB0[0], my_ = PB0[8];                                                                                                              \
    _Pragma("unroll") for (int r = 1; r < 8; ++r) { mx_ = fmaxf(mx_, PB0[r]); my_ = fmaxf(my_, PB0[8 + r]); }                                      \
    SBAR(); mfma8_acc(o[1], pa, vf_, sc1, sc1); SBAR();                                                                                            \
    VFRAG(vf_, VA, 2);                                                                                                                             \
    _Pragma("unroll") for (int r = 0; r < 8; ++r) { mx_ = fmaxf(mx_, PB1[r]); my_ = fmaxf(my_, PB1[8 + r]); }                                      \
    mx_ = fmaxf(mx_, my_);                                                                                                                         \
    { auto rr_ = __builtin_amdgcn_permlane32_swap(__float_as_uint(mx_), __float_as_uint(mx_), false, false);                                       \
      mx_ = fmaxf(__uint_as_float(rr_[0]), __uint_as_float(rr_[1])); }                                                                             \
    if (__builtin_expect(__all(mx_ <= THR2), 1)) { ALB = 1.f; }                                                                                    \
    else { const float d_ = fmaxf(mx_, 0.f); ALB = __builtin_amdgcn_exp2f(-d_); M += d_;                                                           \
      _Pragma("unroll") for (int r = 0; r < 16; ++r) { PB0[r] -= d_; PB1[r] -= d_; }                                                               \
      const float nm_ = -M;                                                                                                                        \
      _Pragma("unroll") for (int r = 0; r < 16; ++r) mi[r] = nm_;                                                                                  \
      asm volatile("" : "+v"(mi)); }                                                                                                               \
    SBAR(); mfma8_acc(o[2], pa, vf_, sc1, sc1); SBAR();                                                                                            \
    VFRAG(vf_, VA, 3); EXPR(PB0, 0, 8); asm volatile("" : "+v"(PB0));       \
    SBAR(); mfma8_acc(o[3], pa, vf_, sc1, sc1); SBAR();                                                                                            \
    EXPR(PB0, 8, 16); asm volatile("" : "+v"(PB0));                                                                                                \
  } while (0)
  f32x16 pA0, pA1, pB0, pB1; float alA, alB; v8i pa; const int NT = seq / KVBLK;
  DMA(0); DMA(1); VMW(2); BAR();
  { v8i ka_, kb_; KFRAG(ka_, kb_, K_lds, g0); mfma8_init(pA0, ka_, q8a, mi, sc1, scq); mfma8_init(pA1, kb_, q8a, mi, sc1, scq);
    KFRAG(ka_, kb_, K_lds, g0 + 2); mfma8_acc(pA0, ka_, q8b, sc1, scq); mfma8_acc(pA1, kb_, q8b, sc1, scq); }
  xdl_pad2(pA0, pA1); partialSM8m<true>(pA0, pA1, M, mi, alA);
  DMA(2); VMW(2); BAR();
  for (int j = 1; j + 1 < NT; j += 2) {
    DMA(j + 2);
    ATT_HALF(pB0, pB1, alB, pA0, pA1, alA, K_lds + (j & 3) * 8192, V_lds + ((j - 1) & 3) * 8192, (void)0);
    VMW(2); BAR(); RESC(alB);
    const bool more = j + 3 < NT;
    if (more) DMA(j + 3);
    ATT_HALF(pA0, pA1, alA, pB0, pB1, alB, K_lds + ((j + 1) & 3) * 8192, V_lds + (j & 3) * 8192, (void)0);
    if (more) VMW(2); else VMW(0);
    BAR(); RESC(alA);
  }
  ATT_HALF(pB0, pB1, alB, pA0, pA1, alA, K_lds + ((NT - 1) & 3) * 8192, V_lds + ((NT - 2) & 3) * 8192, (void)0);
  RESC(alB);
  { LAS char* Vb = V_lds + ((NT - 1) & 3) * 8192; v8i vf_;
    EXPR(pB1, 0, 16);
    float sa_ = pB0[0], sb_ = pB1[0];
#pragma unroll
    for (int r = 1; r < 16; ++r) { sa_ += pB0[r]; sb_ += pB1[r]; }
    float ps_ = sa_ + sb_;
    auto rr_ = __builtin_amdgcn_permlane32_swap(__float_as_uint(ps_), __float_as_uint(ps_), false, false);
    l_reg = l_reg * alB + (__uint_as_float(rr_[0]) + __uint_as_float(rr_[1]));
    pa = (v8i){cvt4_fp8(pB0[0], pB0[1], pB0[2], pB0[3]), cvt4_fp8(pB0[4], pB0[5], pB0[6], pB0[7]), cvt4_fp8(pB0[8], pB0[9], pB0[10], pB0[11]), cvt4_fp8(pB0[12], pB0[13], pB0[14], pB0[15]),
               cvt4_fp8(pB1[0], pB1[1], pB1[2], pB1[3]), cvt4_fp8(pB1[4], pB1[5], pB1[6], pB1[7]), cvt4_fp8(pB1[8], pB1[9], pB1[10], pB1[11]), cvt4_fp8(pB1[12], pB1[13], pB1[14], pB1[15])};
#pragma unroll
    for (int d0 = 0; d0 < 4; ++d0) { VFRAG(vf_, Vb, d0); mfma8_acc(o[d0], pa, vf_, sc1, sc1); } }
  if (hi == 0) li_l[r32] = l_reg; asm volatile("s_waitcnt lgkmcnt(0)" ::: "memory");
  xdl_pad2(o[0], o[1]); xdl_pad2(o[2], o[3]);
  float rli[16];
#pragma unroll
  for (int r = 0; r < 16; ++r) rli[r] = __builtin_amdgcn_rcpf(li_l[crow(r, hi)]);
  bf16* Ow = Ob + (long)(wid * QBLK) * LDO;
#pragma unroll
  for (int r = 0; r < 16; ++r) { int orow = crow(r, hi);
#pragma unroll
    for (int d0 = 0; d0 < 4; ++d0) Ow[(long)orow * LDO + d0 * 32 + r32] = (bf16)f2bf(o[d0][r] * rli[r]); }
  BAR();
#undef DMA
#undef VMW
#undef BAR
#undef RESC
#undef KFRAG
#undef VFRAG
#undef EXPR
#undef ATT_HALF
}
}

__device__ __forceinline__ void ph_norm3(Frame& F) {
    unsigned char* ar = F.ws + WS_ARENA;
    LAS float* RT = (LAS float*)(F.lds + 3 * 8192);
    LAS int* HIST = (LAS int*)(F.lds + 11 * 8192);
    __syncthreads();
    for (int i = F.tid; i < 2048; i += NTHR) { PV(0)[i] = modp(F, 1, 0, 2)[i] * inp(I_NORMS)[(4 + 1) * 2048 + i]; PV(1)[i] = inp(I_NORMS)[(4 + 2) * 2048 + i] * (1.f + modp(F, 1, 0, 4)[i]); PV(2)[i] = modp(F, 1, 0, 3)[i]; }
    for (int i = F.tid; i < 2048 * 8; i += NTHR) RT[(i & 7) * 2048 + (i >> 3)] = inp(I_ROUTER)[i];
    __syncthreads();
    const bf16* YO = (const bf16*)(ar + B_YO1); bf16* V1 = (bf16*)(ar + B_V1); bf16* HR = (bf16*)(F.ws + WS_HRES) + (size_t)CTX * D;
    int* RE = (int*)(ar + B_RE); float* RG = (float*)(ar + B_RG); int* CNT = (int*)(ar + B_CNT);
    for (int blk = blockIdx.x; blk < SEQ / 64; blk += F.G) {
        if (F.tid < 8) HIST[F.tid] = 0;
        __syncthreads();
        for (int rr = 0; rr < 8; ++rr) { const int t = blk * 64 + F.wave * 8 + rr; f32x4 y[8], h[8];
            ld_row_bf16(YO + (size_t)t * D, F.lane, y); ld_row_bf16(HR + (size_t)t * D, F.lane, h);
            const float ry = 1.f / sqrtf(row_sumsq(y) * (1.f / D) + EPS);
#pragma unroll
            for (int j = 0; j < 8; ++j) h[j] = h[j] + y[j] * ry * ldp(PV(0), F.lane, j);
            st_row_bf16(HR + (size_t)t * D, F.lane, h);
            const float rh = 1.f / sqrtf(row_sumsq(h) * (1.f / D) + EPS);
#pragma unroll
            for (int j = 0; j < 8; ++j) y[j] = h[j] * rh * ldp(PV(1), F.lane, j) + ldp(PV(2), F.lane, j);
            { unsigned char* V8 = (unsigned char*)V1 + (size_t)t * D;
#pragma unroll
              for (int j = 0; j < 8; ++j) *(GAS unsigned*)(V8 + 4 * F.lane + 256 * j) = pk4_fp8(y[j][0], y[j][1], y[j][2], y[j][3]); }
            float lg[8];
#pragma unroll
            for (int e = 0; e < 8; ++e) { float s = 0.f;
#pragma unroll
                for (int j = 0; j < 8; ++j) { const f32x4 w = ldp(RT + e * 2048, F.lane, j); s += (y[j][0] * w[0] + y[j][1] * w[1]) + (y[j][2] * w[2] + y[j][3] * w[3]); }
                lg[e] = wave_sum(s) + inp(I_ROUTERB)[e]; }
            if (F.lane == 0) { int e0 = 0; float v0 = lg[0];
#pragma unroll
                for (int e = 1; e < 8; ++e) if (lg[e] > v0) { v0 = lg[e]; e0 = e; }
                int e1 = -1; float v1 = -3.0e38f;
#pragma unroll
                for (int e = 0; e < 8; ++e) if (e != e0 && lg[e] > v1) { v1 = lg[e]; e1 = e; }
                const float g0 = 1.f / (1.f + __expf(v1 - v0));
                RE[2 * t] = e0; RE[2 * t + 1] = e1; RG[2 * t] = g0; RG[2 * t + 1] = 1.f - g0;
                __hip_atomic_fetch_add((int*)(HIST + e0), 1, __ATOMIC_RELAXED, __HIP_MEMORY_SCOPE_WORKGROUP); __hip_atomic_fetch_add((int*)(HIST + e1), 1, __ATOMIC_RELAXED, __HIP_MEMORY_SCOPE_WORKGROUP); }
        }
        __syncthreads();
        if (F.tid < 8) CNT[blk * 8 + F.tid] = HIST[F.tid];
        __syncthreads();
    }
}
__device__ __forceinline__ void ph_route(Frame& F) {
    unsigned char* ar = F.ws + WS_ARENA;
    LAS int* TOT = (LAS int*)(F.lds); LAS int* PRE = TOT + 8; LAS int* BASE = TOT + 16; LAS int* POS = TOT + 32;
    const int* CNT = (const int*)(ar + B_CNT); const int* RE = (const int*)(ar + B_RE); int* SLOT = (int*)(ar + B_SLOT); int* TILE = (int*)(ar + B_TILE);
    const bf16* V1 = (const bf16*)(ar + B_V1); unsigned char* VG = ar + B_VG;
    for (int blk = blockIdx.x; blk < SEQ / 64; blk += F.G) {
        __syncthreads();
        { const int e = F.wave; int tot = 0, pre = 0;
          for (int q = 0; q < 4; ++q) { const int b = 4 * F.lane + q; const int cv = CNT[b * 8 + e]; tot += cv; pre += (b < blk) ? cv : 0; }
#pragma unroll
          for (int o = 1; o < 64; o <<= 1) { tot += __shfl_xor(tot, o); pre += __shfl_xor(pre, o); }
          if (F.lane == 0) { TOT[e] = tot; PRE[e] = pre; } }
        __syncthreads();
        if (F.tid == 0) { int b = 0; for (int e = 0; e < 8; ++e) { BASE[e] = b; b += (TOT[e] + 255) / 256 * 256; } BASE[8] = b; }
        __syncthreads();
        if (F.wave == 0) { const int t = blk * 64 + F.lane; const int e0 = RE[2 * t], e1 = RE[2 * t + 1]; int p0 = 0, p1 = 0;
            const unsigned long long lt = (1ull << F.lane) - 1ull;
#pragma unroll
            for (int e = 0; e < 8; ++e) { const unsigned long long m0 = __ballot(e0 == e), m1 = __ballot(e1 == e); const int rk = __popcll(m0 & lt) + __popcll(m1 & lt);
                if (e0 == e) p0 = BASE[e] + PRE[e] + rk; if (e1 == e) p1 = BASE[e] + PRE[e] + rk; }
            SLOT[2 * t] = p0; SLOT[2 * t + 1] = p1; POS[2 * F.lane] = p0; POS[2 * F.lane + 1] = p1; }
        __syncthreads();
        for (int idx = F.tid; idx < 128 * 128; idx += NTHR) { const int ri = idx >> 7, seg = idx & 127;
            *(GAS v4u*)(VG + (size_t)POS[ri] * D + seg * 16) = *(const GAS v4u*)((const unsigned char*)V1 + (size_t)(blk * 64 + (ri >> 1)) * D + seg * 16); }
        if (blk < 8) { const int e = blk, r0 = BASE[e] + TOT[e], r1 = BASE[e + 1];
            for (int idx = F.tid; idx < (r1 - r0) * 128; idx += NTHR) *(GAS v4u*)(VG + (size_t)(r0 + (idx >> 7)) * D + (idx & 127) * 16) = (v4u){0u, 0u, 0u, 0u}; }
        if (blk == 0 && F.tid == 0) { int nt = 0; for (int e = 0; e < 8; ++e) { const int n = (BASE[e + 1] - BASE[e]) / 256; for (int q = 0; q < n; ++q) TILE[1 + nt++] = e; } TILE[0] = nt; }
    }
}
__device__ __forceinline__ void ph_norm4(Frame& F, float* out) {
    unsigned char* ar = F.ws + WS_ARENA;
    __syncthreads();
    for (int i = F.tid; i < 2048; i += NTHR) PV(0)[i] = modp(F, 1, 0, 5)[i] * inp(I_NORMS)[(4 + 3) * 2048 + i];
    __syncthreads();
    const bf16* FS = (const bf16*)(ar + B_FS); const bf16* HR = (const bf16*)(F.ws + WS_HRES) + (size_t)CTX * D; const int* SLOT = (const int*)(ar + B_SLOT); const float* RG = (const float*)(ar + B_RG);
    const int gw = F.vcu * NWAVES + F.wave, NGW = F.G * NWAVES;
    for (int t = gw; t < SEQ; t += NGW) { f32x4 a[8], b[8], h[8]; const int p0 = SLOT[2 * t], p1 = SLOT[2 * t + 1]; const float g0 = RG[2 * t], g1 = RG[2 * t + 1];
        const float* PART = (const float*)(ar + B_VG); constexpr size_t PSTR = (size_t)MOE_SPLIT_TILES * 256 * D;
        if (p0 < MOE_MAIN_TILES * 256) ld_row_bf16(FS + (size_t)p0 * D, F.lane, a);
        else { const float* pp = PART + (size_t)(p0 - MOE_MAIN_TILES * 256) * D; f32x4 q1[8], q2[8], q3[8]; ld_row_f32(pp, F.lane, a); ld_row_f32(pp + PSTR, F.lane, q1); ld_row_f32(pp + 2 * PSTR, F.lane, q2); ld_row_f32(pp + 3 * PSTR, F.lane, q3);
#pragma unroll
            for (int j = 0; j < 8; ++j) a[j] = (a[j] + q1[j]) + (q2[j] + q3[j]); }
        if (p1 < MOE_MAIN_TILES * 256) ld_row_bf16(FS + (size_t)p1 * D, F.lane, b);
        else { const float* pp = PART + (size_t)(p1 - MOE_MAIN_TILES * 256) * D; f32x4 q1[8], q2[8], q3[8]; ld_row_f32(pp, F.lane, b); ld_row_f32(pp + PSTR, F.lane, q1); ld_row_f32(pp + 2 * PSTR, F.lane, q2); ld_row_f32(pp + 3 * PSTR, F.lane, q3);
#pragma unroll
            for (int j = 0; j < 8; ++j) b[j] = (b[j] + q1[j]) + (q2[j] + q3[j]); }
        ld_row_bf16(HR + (size_t)t * D, F.lane, h);
#pragma unroll
        for (int j = 0; j < 8; ++j) a[j] = a[j] * g0 + b[j] * g1;
        const float rf = 1.f / sqrtf(row_sumsq(a) * (1.f / D) + EPS);
#pragma unroll
        for (int j = 0; j < 8; ++j) h[j] = h[j] + a[j] * rf * ldp(PV(0), F.lane, j);
        st_row_f32(out + (size_t)t * D, F.lane, h); }
}

struct EpiGateUp8 { static constexpr bool PERM = true; unsigned char* HID; int ldc; float is;
    __device__ __forceinline__ void operator()(AccRef acc, const Unit& u, int wr, int wc, int fr, int fq) const { EPI_ROWS(u); const int col0 = u.pn * 128 + wc * 32 + 8 * fq; const float c1 = -1.4426950408889634f * is, kk = is * is * MOE_HSC;
#pragma unroll
        for (int ai = 0; ai < 2; ++ai)
#pragma unroll
            for (int m = 0; m < 4; ++m) { const int row = row0 + ai * 128 + m * 16; float a[4], b[4];
#pragma unroll
                for (int q = 0; q < 4; ++q) { a[q] = __builtin_amdgcn_fmed3f(swiglu_fast(acc[ai][0][m][0][q], acc[ai][1][m][0][q], c1, kk), -448.f, 448.f);
                                              b[q] = __builtin_amdgcn_fmed3f(swiglu_fast(acc[ai][0][m][1][q], acc[ai][1][m][1][q], c1, kk), -448.f, 448.f); }
                v2u o; o.x = pk4_fp8(a[0], a[1], a[2], a[3]); o.y = pk4_fp8(b[0], b[1], b[2], b[3]);
                *(GAS v2u*)(HID + (size_t)row * ldc + col0) = o; } } };
struct EpiPlainSc { static constexpr bool PERM = true; bf16* O; int ldc; float sc;
    __device__ __forceinline__ void operator()(AccRef acc, const Unit& u, int wr, int wc, int fr, int fq) const { EPI_ROWS(u); const int col0 = u.pn * 256 + wc * 32 + 8 * fq;
#pragma unroll
        for (int ai = 0; ai < 2; ++ai)
#pragma unroll
            for (int m = 0; m < 4; ++m) { bf16* rp = O + (size_t)(row0 + ai * 128 + m * 16) * ldc + col0;
#pragma unroll
                for (int bj = 0; bj < 2; ++bj) *(GAS u32x4*)(rp + bj * 128) = pack8(acc[ai][bj][m][0] * sc, acc[ai][bj][m][1] * sc); } } };

struct EpiPart { static constexpr bool PERM = false; float* P; int pm0; float sc;
    __device__ __forceinline__ void operator()(AccRef acc, const Unit& u, int wr, int wc, int fr, int fq) const { const int row0 = (u.pm - pm0) * 256 + wr * 64 + fr, col0 = u.pn * 256 + wc * 32 + 4 * fq;
        float* base = P + (size_t)u.bz * ((size_t)MOE_SPLIT_TILES * 256 * D);
#pragma unroll
        for (int ai = 0; ai < 2; ++ai)
#pragma unroll
            for (int m = 0; m < 4; ++m) { float* rp = base + (size_t)(row0 + ai * 128 + m * 16) * D + col0;
#pragma unroll
                for (int bj = 0; bj < 2; ++bj)
#pragma unroll
                    for (int n = 0; n < 2; ++n) *(GAS f32x4*)(rp + bj * 128 + n * 16) = acc[ai][bj][m][n] * sc; } } };

enum { PH_PRO = 0, PH_N0, PH_WINE, PH_POOLD, PH_SCAN, PH_S5Y, PH_GLU, PH_WOUTE, PH_N1, PH_FFNU, PH_FFND, PH_N2,
       PH_WINO, PH_PREP, PH_GLA1, PH_GLA2, PH_GLA3, PH_ATT, PH_WOUTO, PH_N3, PH_ROUTE, PH_MOEU, PH_MOED, PH_N4, NPH };
constexpr int PH_EMIT = 100;
struct Args { const float* in[N_IN]; float* out; unsigned char* ws; int ph_lo, ph_hi, li, pad; };

__global__ void __launch_bounds__(NTHR, 2) mk_fwd(Args args) {
    extern __shared__ __attribute__((aligned(16))) unsigned char lds[];
    Frame F;
    F.lds = (LAS unsigned char*)lds; F.MISC = (volatile LAS unsigned*)(F.lds + MISC_OFF);
    F.tid = threadIdx.x; F.lane = F.tid & 63; F.wave = __builtin_amdgcn_readfirstlane(F.tid >> 6);
    F.G = gridDim.x; { const int bx = blockIdx.x; F.vcu = (F.G % 8 == 0) ? (bx % 8) * (F.G / 8) + bx / 8 : bx; }
    F.ws = karg_ws(); F.ctl = (gu32*)(F.ws + WS_CTL);
    for (int u = F.tid; u < (LDS_BYTES - LDSCTL_OFF) / 4; u += NTHR) ((LAS unsigned*)(F.lds + LDSCTL_OFF))[u] = 0u;
    __syncthreads();
    XcdBarrier bar = xcd_barrier_post((unsigned*)(F.ctl + CW_BAR) + (karg_i(2) & 7) * XCD_BAR_WORDS, F.MISC + 8);
    const int lo = karg_i(0), hi = karg_i(1);
#define IN(k) (lo <= (k) && (k) < hi)
#define SEAM(k) do { if (IN(k) && IN((k) + 1)) xcd_barrier(bar); if (PROBE_MASK) { const unsigned long long t_ = __builtin_amdgcn_s_memrealtime(); if ((PROBE_MASK >> (k)) & 1ull) pr_acc += t_ - pr_last; pr_last = t_; } } while (0)
    unsigned long long pr_last = PROBE_MASK ? __builtin_amdgcn_s_memrealtime() : 0ull, pr_acc = 0ull;
    PG8_LAS unsigned char* ring = (PG8_LAS unsigned char*)(F.lds + RING_OFF);
    unsigned char* ar = F.ws + WS_ARENA;
    const int bid = (int)blockIdx.x;

    if (lo == PH_EMIT) { ph_emit(F, karg_out()); return; }

    if (IN(PH_PRO)) { p0_prologue(F); } SEAM(PH_PRO);
    if (IN(PH_N0)) { for (int it = bid; it < S5G * 8; it += F.G) { s5_small_tables(F, it >> 3); s5_stage_b(F, it >> 3, it & 7); } ph_norm0(F); } SEAM(PH_N0);
    if (IN(PH_WINE)) {
        pg8::Gemm g{(const bf16*)(ar + A_U), (const bf16*)(F.ws + WS_WINE), D, D, D};
        pg8::PlainSched S; S.o.init(T / 256, D / 256, 1, F.G, bid); S.astr = (size_t)256 * D * 2; S.bstr = (size_t)256 * D * 2; S.zA = 0; S.zB = 0;
        EpiWinE E{(bf16*)(ar + A_ZP), (bf16*)(ar + A_AS5)};
        pg8::gemm_phase(ring, g, S, E);
        conv_work(F, 0, fill_quota(S.o.nwg, F.G, bid, 6));
    } SEAM(PH_WINE);
    if (IN(PH_POOLD)) {
        ph_pooldiff(F);
        __syncthreads();
        pg8::Gemm g{(const bf16*)(ar + A_AS5), (const bf16*)(ar + A_M1T), S5K, 1024, 1024};
        pg8::PlainSched S; S.o.init(S5ROWS / 256, 1, S5G, F.G, bid); S.astr = (size_t)256 * S5K * 2; S.bstr = 0; S.zA = (size_t)S5ROWS * S5K * 2; S.zB = (size_t)256 * 1024 * 2;
        EpiSloc E{(float*)(ar + A_SLOC)};
        pg8::gemm_phase(ring, g, S, E);
        conv_work(F, 0, fill_quota(S.o.nwg, F.G, bid, 3));
    } SEAM(PH_POOLD);
    if (IN(PH_SCAN)) {
        ph_s5scan(F);
        __syncthreads();
        pg8::Gemm g{(const bf16*)(ar + A_DP), (const bf16*)(F.ws + WS_WPOOL), WPOOL, PG, PG};
        pg8::PlainSched S; S.o.init(T / 256, 2, 4, F.G, bid); S.astr = (size_t)256 * WPOOL * 2; S.bstr = (size_t)256 * PG * 2; S.zA = (size_t)PG * 2; S.zB = (size_t)512 * PG * 2;
        EpiPool E{(bf16*)(ar + A_YMIX), inp(I_EPOOLS)};
        pg8::gemm_phase(ring, g, S, E);
        conv_work(F, 0, fill_quota(S.o.nwg, F.G, bid, 1));
    } SEAM(PH_SCAN);
    if (IN(PH_S5Y)) {
        pg8::Gemm g{(const bf16*)(ar + A_AS5), (const bf16*)(ar + A_K3T), S5K, S5K, S5K};
        pg8::PlainSched S; S.o.init(S5ROWS / 256, 4, S5G, F.G, bid); S.astr = (size_t)256 * S5K * 2; S.bstr = (size_t)256 * S5K * 2; S.zA = (size_t)S5ROWS * S5K * 2; S.zB = (size_t)1024 * S5K * 2;
        EpiS5Y E{(const bf16*)(ar + A_AS5), inp(I_S5D), (bf16*)(ar + A_YG)};
        pg8::gemm_phase(ring, g, S, E);
    } SEAM(PH_S5Y);
    if (IN(PH_GLU)) {
        pg8::Gemm g{(const bf16*)(ar + A_YG), (const bf16*)(F.ws + WS_WGLU), WS5, WS5, WS5};
        pg8::PlainSched S; S.o.init(T / 256, 2, 1, F.G, bid); S.astr = (size_t)256 * WS5 * 2; S.bstr = (size_t)256 * WS5 * 2; S.zA = 0; S.zB = 0;
        EpiGlu E{(const bf16*)(ar + A_YG), (bf16*)(ar + A_YMIX)};
        pg8::gemm_phase(ring, g, S, E);
        conv_work(F, 0, fill_quota(S.o.nwg, F.G, bid, 2));
    } SEAM(PH_GLU);
    if (IN(PH_WOUTE)) {
        pg8::Gemm g{(const bf16*)(ar + A_YMIX), (const bf16*)(F.ws + WS_WOUTE), D, D, D};
        pg8::PlainSched S; S.o.init(T / 256, D / 256, 1, F.G, bid); S.astr = (size_t)256 * D * 2; S.bstr = (size_t)256 * D * 2; S.zA = 0; S.zB = 0;
        EpiPlain E{(bf16*)(ar + A_YO), D};
        pg8::gemm_phase(ring, g, S, E);
        conv_work(F, 0, fill_quota(S.o.nwg, F.G, bid, 6));
    } SEAM(PH_WOUTE);
    if (IN(PH_N1)) { ph_norm1(F); conv_work(F, CQ_F2, 0); } SEAM(PH_N1);
    if (IN(PH_FFNU)) {
#if FFN_FP8 == 1
        pg8::Gemm g{(const bf16*)(ar + A_V), (const bf16*)(F.ws + WS_WGU), D / 2, D / 2, D / 2};
        pg8::PlainSched S; S.o.init(T / 256, 14336 / 256, 1, F.G, bid); S.astr = (size_t)256 * D; S.bstr = (size_t)256 * D; S.zA = 0; S.zB = 0;
        EpiGateUp8 E{ar + A_HID, DFF, 1.f / MOE_WSC_GU};
        pg8::gemm_phase<EpiGateUp8, pg8::PlainSched, true>(ring, g, S, E);
#elif FFN_FP8 == 2 && FFNU_K1 < 2048
        constexpr int KEQ = FFNU_K1 + (2048 - FFNU_K1) / 2;
        static_assert(FFNU_K1 % 128 == 0 && (2048 - FFNU_K1) % 256 == 0 && KEQ % 128 == 0 && FFNU_K1 % 256 == 0, "mixed-precision split");
        pg8::Gemm g{(const bf16*)(ar + A_V), (const bf16*)(F.ws + WS_WGU), KEQ, KEQ, KEQ};
        pg8::PlainSched S; S.o.init(T / 256, 14336 / 256, 1, F.G, bid); S.astr = (size_t)256 * KEQ * 2; S.bstr = (size_t)256 * KEQ * 2; S.zA = 0; S.zB = 0;
        EpiGateUp8 E{ar + A_HID, DFF, 1.f};
        pg8::gemm_phase<EpiGateUp8, pg8::PlainSched, false, FFNU_K1 / 64>(ring, g, S, E);
#elif FFN_FP8 == 2
        pg8::Gemm g{(const bf16*)(ar + A_V), (const bf16*)(F.ws + WS_WGU), D, D, D};
        pg8::PlainSched S; S.o.init(T / 256, 14336 / 256, 1, F.G, bid); S.astr = (size_t)256 * D * 2; S.bstr = (size_t)256 * D * 2; S.zA = 0; S.zB = 0;
        EpiGateUp8 E{ar + A_HID, DFF, 1.f};
        pg8::gemm_phase(ring, g, S, E);
#else
        pg8::Gemm g{(const bf16*)(ar + A_V), (const bf16*)(F.ws + WS_WGU), D, D, D};
        pg8::PlainSched S; S.o.init(T / 256, 14336 / 256, 1, F.G, bid); S.astr = (size_t)256 * D * 2; S.bstr = (size_t)256 * D * 2; S.zA = 0; S.zB = 0;
        EpiGateUp E{(bf16*)(ar + A_HID), DFF};
        pg8::gemm_phase(ring, g, S, E);
#endif
        conv_work(F, CQ_F3, fill_quota((T / 256) * (14336 / 256), F.G, bid, 6));
    } SEAM(PH_FFNU);
    if (IN(PH_FFND)) {
#if FFN_FP8
        pg8::Gemm g{(const bf16*)(ar + A_HID), (const bf16*)(F.ws + WS_WDN), DFF / 2, DFF / 2, DFF / 2};
        pg8::PlainSched S; S.o.init(T / 256, D / 256, 1, F.G, bid); S.astr = (size_t)256 * DFF; S.bstr = (size_t)256 * DFF; S.zA = 0; S.zB = 0;
        EpiPlainSc E{(bf16*)(ar + A_F), D, 1.f / (MOE_WSC_DN * MOE_HSC)};
        pg8::gemm_phase<EpiPlainSc, pg8::PlainSched, true>(ring, g, S, E);
#else
        pg8::Gemm g{(const bf16*)(ar + A_HID), (const bf16*)(F.ws + WS_WDN), DFF, DFF, DFF};
        pg8::PlainSched S; S.o.init(T / 256, D / 256, 1, F.G, bid); S.astr = (size_t)256 * DFF * 2; S.bstr = (size_t)256 * DFF * 2; S.zA = 0; S.zB = 0;
        EpiPlain E{(bf16*)(ar + A_F), D};
        pg8::gemm_phase(ring, g, S, E);
#endif
        conv_work(F, CQ_O1, fill_quota((T / 256) * (D / 256), F.G, bid, 11));
    } SEAM(PH_FFND);
    if (IN(PH_N2)) { ph_norm2(F); conv_work(F, CQ_O1, 0); } SEAM(PH_N2);
    if (IN(PH_WINO)) {
        pg8::Gemm g{(const bf16*)(ar + A_U), (const bf16*)(F.ws + WS_WINO), D, D, D};
        pg8::PlainSched S; S.o.init(T / 256, WINO_N / 256, 1, F.G, bid); S.astr = (size_t)256 * D * 2; S.bstr = (size_t)256 * D * 2; S.zA = 0; S.zB = 0;
        EpiWinO E{ar};
        pg8::gemm_phase(ring, g, S, E);
        conv_work(F, CQ_O2, fill_quota(S.o.nwg, F.G, bid, 5));
    } SEAM(PH_WINO);
    if (IN(PH_PREP)) { ph_qknorm(F); ph_vt8(F); for (int u = bid; u < NCH * 4; u += F.G) gla_prepkv_unit(F, u >> 2, u & 3); conv_work(F, 0, fill_quota(NCH * 4, F.G, bid, 4)); } SEAM(PH_PREP);
    if (IN(PH_GLA2)) { ph_gla_scan(F); } SEAM(PH_GLA2);
    if (IN(PH_GLA3)) { for (int u = bid; u < (SEQ / 64) * 4; u += F.G) gla_out_unit(F, u >> 2, u & 3); __syncthreads(); }
    if (IN(PH_ATT)) {
        for (int L = bid; L < 8 * (SEQ / 256); L += F.G) { const int h = L >> 6, qb = L & 63;
            const bf16* Q = (const bf16*)(ar + B_AQ) + (size_t)(CTX + qb * 256) * 1024 + h * 128;
            const unsigned char* Kp = ar + B_KDT + (h >> 2) * 128; const bf16* Vp = (const bf16*)(ar + B_AV) + (h >> 2) * 128;
            bf16* O = (bf16*)(ar + B_YMIX1) + (size_t)(qb * 256) * D + 1024 + h * 128;
            att::attn_dense_body_d(Q, Kp, ar + B_KDT + VT8_OFF + (size_t)(h >> 2) * NCH * 8192, O, T, (LAS char*)F.lds); }
    } SEAM(PH_ATT);
    if (IN(PH_WOUTO)) {
        pg8::Gemm g{(const bf16*)(ar + B_YMIX1), (const bf16*)(F.ws + WS_WOUTO), D, D, D};
        pg8::PlainSched S; S.o.init(SEQ / 256, D / 256, 1, F.G, bid); S.astr = (size_t)256 * D * 2; S.bstr = (size_t)256 * D * 2; S.zA = 0; S.zB = 0;
        EpiPlain E{(bf16*)(ar + B_YO1), D};
        pg8::gemm_phase(ring, g, S, E);
    } SEAM(PH_WOUTO);
    if (IN(PH_N3)) { ph_norm3(F); } SEAM(PH_N3);
    if (IN(PH_ROUTE)) { ph_route(F); conv_work(F, CQ_M2, 0); } SEAM(PH_ROUTE);
    if (IN(PH_MOEU)) {
        const int* TILE = (const int*)(ar + B_TILE); const int nt = __builtin_amdgcn_readfirstlane(TILE[0]);
        pg8::Gemm g{(const bf16*)(ar + B_VG), (const bf16*)(F.ws + WS_WMGU), D / 2, D / 2, D / 2};
        pg8::MoeSched S; S.o.init(nt, 14336 / 256, 1, F.G, bid); S.astr = (size_t)256 * D; S.bstr = (size_t)256 * D; S.zB = (size_t)14336 * D; S.tile_e = TILE + 1;
        EpiGateUp8 E{ar + B_HID2, DFF, 1.f / MOE_WSC_GU};
        pg8::gemm_phase<EpiGateUp8, pg8::MoeSched, true>(ring, g, S, E);
        conv_work(F, CQ_M3, fill_quota(S.o.nwg, F.G, bid, 5));
    } SEAM(PH_MOEU);
    if (IN(PH_MOED)) {
        const int* TILE = (const int*)(ar + B_TILE); const int nt = __builtin_amdgcn_readfirstlane(TILE[0]);
        pg8::Gemm g{(const bf16*)(ar + B_HID2), (const bf16*)(F.ws + WS_WMDN), DFF / 2, DFF / 2, DFF / 2};
        const int nmain = nt < MOE_MAIN_TILES ? nt : MOE_MAIN_TILES;
        pg8::MoeSched S; S.o.init(nmain, D / 256, 1, F.G, bid); S.astr = (size_t)256 * DFF; S.bstr = (size_t)256 * DFF; S.zB = (size_t)D * DFF; S.tile_e = TILE + 1;
        EpiPlainSc E{(bf16*)(ar + B_FS), D, 1.f / (MOE_WSC_DN * MOE_HSC)};
        pg8::gemm_phase<EpiPlainSc, pg8::MoeSched, true>(ring, g, S, E);
        if (nt > MOE_MAIN_TILES) {
            pg8::Gemm g2{(const bf16*)(ar + B_HID2), (const bf16*)(F.ws + WS_WMDN), DFF / 2, DFF / 2, DFF / 8};
            pg8::MoeSplitSched S2; S2.pm0 = MOE_MAIN_TILES; S2.nun = (nt - MOE_MAIN_TILES) * 32; S2.G = F.G; S2.c = bid; S2.astr = (size_t)256 * DFF; S2.bstr = (size_t)256 * DFF; S2.zB = (size_t)D * DFF; S2.kslice = DFF / 4; S2.tile_e = TILE + 1;
            EpiPart E2{(float*)(ar + B_VG), MOE_MAIN_TILES, 1.f / (MOE_WSC_DN * MOE_HSC)};
            pg8::gemm_phase<EpiPart, pg8::MoeSplitSched, true>(ring, g2, S2, E2);
        }
    } SEAM(PH_MOED);
    if (IN(PH_N4)) { ph_norm4(F, karg_out()); }
    if (PROBE_MASK) { const unsigned long long t_ = __builtin_amdgcn_s_memrealtime(); if ((PROBE_MASK >> PH_N4) & 1ull) pr_acc += t_ - pr_last;
        const unsigned long long te_ = t_ + (unsigned long long)PROBE_K * pr_acc; while (__builtin_amdgcn_s_memrealtime() < te_) __builtin_amdgcn_s_sleep(16); }
#undef IN
#undef SEAM
}

extern "C" void kernel_launch(void* const* d_in, const int* in_sizes, int n_in, void* d_out, int out_size, void* d_ws, size_t ws_size, hipStream_t stream) {
    static int grid = 0;
    if (grid == 0) {
        if (n_in != N_IN || out_size != SEQ * D || ws_size < WS_NEED) { fprintf(stderr, "kernel_launch: shape/workspace mismatch (n_in %d out %d ws %zu need %zu)\n", n_in, out_size, ws_size, (size_t)WS_NEED); grid = -1; return; }
        int dev = 0, cus = 0, per_cu = 0;
        if (hipGetDevice(&dev) != hipSuccess || hipDeviceGetAttribute(&cus, hipDeviceAttributeMultiprocessorCount, dev) != hipSuccess) { grid = -1; return; }
        if (hipFuncSetAttribute((const void*)mk_fwd, hipFuncAttributeMaxDynamicSharedMemorySize, LDS_BYTES) != hipSuccess) { fprintf(stderr, "kernel_launch: hipFuncSetAttribute failed\n"); grid = -1; return; }
        if (hipOccupancyMaxActiveBlocksPerMultiprocessor(&per_cu, (const void*)mk_fwd, NTHR, LDS_BYTES) != hipSuccess || per_cu < 1) { fprintf(stderr, "kernel_launch: occupancy query says %d\n", per_cu); }
        (void)hipGetLastError();
        grid = cus;
    }
    if (grid < 0) return;
    (void)hipMemsetAsync((char*)d_ws + WS_CTL, 0, CTL_ZERO_BYTES, stream);
    Args a{};
    for (int i = 0; i < N_IN; ++i) a.in[i] = (const float*)d_in[i];
    a.out = (float*)d_out; a.ws = (unsigned char*)d_ws; a.pad = 0;
    const int last = (MK_STOP < NPH - 1) ? MK_STOP : NPH - 1;
#if MK_SPLIT
    for (int p = 0; p <= last; ++p) { a.ph_lo = p; a.ph_hi = p + 1; a.li = p; hipLaunchKernelGGL(mk_fwd, dim3(grid), dim3(NTHR), LDS_BYTES, stream, a); }
#else
    a.ph_lo = 0; a.ph_hi = last + 1; a.li = 0; hipLaunchKernelGGL(mk_fwd, dim3(grid), dim3(NTHR), LDS_BYTES, stream, a);
#endif
    if (last < NPH - 1) { a.ph_lo = PH_EMIT; a.ph_hi = PH_EMIT + 1; a.li = 7; hipLaunchKernelGGL(mk_fwd, dim3(grid), dim3(NTHR), LDS_BYTES, stream, a); }
    const hipError_t le = hipPeekAtLastError();
    if (le != hipSuccess) fprintf(stderr, "kernel_launch: launch failed: %s\n", hipGetErrorName(le));
}
```
